# Optimizing an MI355X kernel written in HIP

```python
import math
import jax, jax.numpy as jnp
from jax import lax
import numpy as np

D_MODEL = 1024
BATCH = 16
SEQ = 2048
DEPTH = 1

CHUNK = 64
Q_BLOCK = 128

CONV_WIDTH = 512
CONV_GROUPS = 8
CONV_K = 3

MLA_HEADS = 4
QK_NOPE = 128
QK_ROPE = 64
QK_HEAD = QK_NOPE + QK_ROPE
V_HEAD = 128
Q_LORA = 384
KV_LORA = 256
MLA_WIDTH = MLA_HEADS * V_HEAD
ROPE_THETA = 10000.0

MIX_WIDTH = CONV_WIDTH + MLA_WIDTH
IN_PROJ = 3 * CONV_WIDTH + Q_LORA + KV_LORA + QK_ROPE

N_EXPERTS = 32
TOP_K = 4
D_FF = 1024
SWIGLU_LIMIT = 7.0
SWIGLU_ALPHA = 1.702

EPS = 1e-6

kernel_name = "hymba_conv_mla_moe_streaming_block"


def rmsnorm(x, g):
    xf = x.astype(jnp.float32)
    y = xf * lax.rsqrt(jnp.mean(xf * xf, axis=-1, keepdims=True) + EPS)
    return (y * g.astype(jnp.float32)).astype(x.dtype)


def rope(x, pos):
    half = QK_ROPE // 2
    inv_freq = ROPE_THETA ** (-jnp.arange(half, dtype=jnp.float32) / half)
    ang = pos.astype(jnp.float32)[:, None] * inv_freq[None, :]
    cos = jnp.cos(ang)[None, :, None, :].astype(x.dtype)
    sin = jnp.sin(ang)[None, :, None, :].astype(x.dtype)
    x1, x2 = x[..., :half], x[..., half:]
    return jnp.concatenate([x1 * cos - x2 * sin, x1 * sin + x2 * cos], axis=-1)


def short_conv_mixer(b_gate, c_gate, x_in, conv_w):
    u = c_gate * x_in
    y = lax.conv_general_dilated(
        u, conv_w[:, None, :],
        window_strides=(1,), padding=[(CONV_K - 1, 0)],
        dimension_numbers=("NWC", "WIO", "NWC"),
        feature_group_count=CONV_WIDTH)
    return b_gate * y


def mla_mixer(c_q, c_kv, k_pe, q_norm, w_uq, kv_norm, w_ukv, q_head_norm, k_head_norm):
    bsz, seq = c_q.shape[0], c_q.shape[1]
    pos = jnp.arange(seq)
    q = (rmsnorm(c_q, q_norm) @ w_uq).reshape(bsz, seq, MLA_HEADS, QK_HEAD)
    kv = (rmsnorm(c_kv, kv_norm) @ w_ukv).reshape(bsz, seq, MLA_HEADS, QK_NOPE + V_HEAD)
    k_nope, v = kv[..., :QK_NOPE], kv[..., QK_NOPE:]
    k_pe_h = jnp.broadcast_to(k_pe[:, :, None, :], (bsz, seq, MLA_HEADS, QK_ROPE))
    k = jnp.concatenate([k_nope, k_pe_h], axis=-1)
    q = rmsnorm(q, q_head_norm)
    k = rmsnorm(k, k_head_norm)
    q = jnp.concatenate([q[..., :QK_NOPE], rope(q[..., QK_NOPE:], pos)], axis=-1)
    k = jnp.concatenate([k[..., :QK_NOPE], rope(k[..., QK_NOPE:], pos)], axis=-1)

    scale = 1.0 / math.sqrt(QK_HEAD)
    n_blk = seq // Q_BLOCK
    q_blocks = jnp.moveaxis(q.reshape(bsz, n_blk, Q_BLOCK, MLA_HEADS, QK_HEAD), 1, 0)
    k_chunk = jnp.arange(seq) // CHUNK
    neg = jnp.finfo(jnp.float32).min

    def attend(args):
        qb, i = args
        q_chunk = (i * Q_BLOCK + jnp.arange(Q_BLOCK)) // CHUNK
        allowed = k_chunk[None, :] <= q_chunk[:, None]
        s = jnp.einsum("bqhd,bkhd->bhqk", qb, k,
                       preferred_element_type=jnp.float32) * scale
        s = jnp.where(allowed[None, None], s, neg)
        p = jax.nn.softmax(s, axis=-1).astype(v.dtype)
        return jnp.einsum("bhqk,bkhd->bqhd", p, v)

    o = lax.map(attend, (q_blocks, jnp.arange(n_blk)))
    return jnp.moveaxis(o, 0, 1).reshape(bsz, seq, MLA_WIDTH)


def moe_ffn(h, w_router, b_router, w_gate_up, b_gate_up, w_down, b_down):
    bsz, seq, d = h.shape
    n_tok = bsz * seq
    hf = h.reshape(n_tok, d)
    logits = (hf @ w_router + b_router).astype(jnp.float32)
    top_vals, top_idx = lax.top_k(logits, TOP_K)
    gates = jax.nn.softmax(top_vals, axis=-1).astype(h.dtype)
    flat_e = top_idx.reshape(-1)
    order = jnp.argsort(flat_e)
    token_of = order // TOP_K
    e_sorted = flat_e[order]
    xs = hf[token_of]
    sizes = jnp.bincount(flat_e, length=N_EXPERTS).astype(jnp.int32)
    gu = lax.ragged_dot(xs, w_gate_up, sizes) + b_gate_up[e_sorted]
    gate = jnp.minimum(gu[:, :D_FF], SWIGLU_LIMIT)
    up = jnp.clip(gu[:, D_FF:], -SWIGLU_LIMIT, SWIGLU_LIMIT)
    act = (up + 1.0) * (gate * jax.nn.sigmoid(SWIGLU_ALPHA * gate))
    out = lax.ragged_dot(act, w_down, sizes) + b_down[e_sorted]
    out = out * gates.reshape(-1)[order][:, None]
    y = jax.ops.segment_sum(out, token_of, num_segments=n_tok)
    return y.reshape(bsz, seq, d)


def setup_inputs(seed: int = 0) -> dict:
    key = jax.random.key(seed)
    ks = jax.random.split(key, 18)

    def nrm(k, shape, scale):
        return jax.random.normal(k, shape, jnp.float32) * scale

    def gain(k, shape):
        return 1.0 + 0.02 * jax.random.normal(k, shape, jnp.float32)

    L = DEPTH
    return {
        "x": nrm(ks[0], (BATCH, SEQ, D_MODEL), 1.0),
        "norm_mix": gain(ks[1], (L, D_MODEL)),
        "w_in": nrm(ks[2], (L, D_MODEL, IN_PROJ), D_MODEL ** -0.5),
        "conv_w": nrm(ks[3], (L, CONV_K, CONV_WIDTH), CONV_K ** -0.5),
        "q_norm": gain(ks[4], (L, Q_LORA)),
        "w_uq": nrm(ks[5], (L, Q_LORA, MLA_HEADS * QK_HEAD), Q_LORA ** -0.5),
        "kv_norm": gain(ks[6], (L, KV_LORA)),
        "w_ukv": nrm(ks[7], (L, KV_LORA, MLA_HEADS * (QK_NOPE + V_HEAD)), KV_LORA ** -0.5),
        "q_head_norm": gain(ks[8], (L, QK_HEAD)),
        "k_head_norm": gain(ks[9], (L, QK_HEAD)),
        "w_o": nrm(ks[10], (L, MIX_WIDTH, D_MODEL), MIX_WIDTH ** -0.5),
        "norm_ffn": gain(ks[11], (L, D_MODEL)),
        "w_router": nrm(ks[12], (L, D_MODEL, N_EXPERTS), D_MODEL ** -0.5),
        "b_router": nrm(ks[13], (L, N_EXPERTS), 0.01),
        "w_gate_up": nrm(ks[14], (L, N_EXPERTS, D_MODEL, 2 * D_FF), D_MODEL ** -0.5),
        "b_gate_up": nrm(ks[15], (L, N_EXPERTS, 2 * D_FF), 0.02),
        "w_down": nrm(ks[16], (L, N_EXPERTS, D_FF, D_MODEL), D_FF ** -0.5),
        "b_down": nrm(ks[17], (L, N_EXPERTS, D_MODEL), 0.02),
    }


def reference(x, norm_mix, w_in, conv_w, q_norm, w_uq, kv_norm, w_ukv, q_head_norm,
              k_head_norm, w_o, norm_ffn, w_router, b_router, w_gate_up, b_gate_up,
              w_down, b_down):
    h = x
    splits = np.cumsum([CONV_WIDTH, CONV_WIDTH, CONV_WIDTH, Q_LORA, KV_LORA]).tolist()
    for l in range(DEPTH):
        hn = rmsnorm(h, norm_mix[l])
        proj = hn @ w_in[l]
        b_gate, c_gate, x_in, c_q, c_kv, k_pe = jnp.split(proj, splits, axis=-1)
        conv_out = short_conv_mixer(b_gate, c_gate, x_in, conv_w[l])
        attn_out = mla_mixer(c_q, c_kv, k_pe, q_norm[l], w_uq[l], kv_norm[l],
                             w_ukv[l], q_head_norm[l], k_head_norm[l])
        h = h + jnp.concatenate([conv_out, attn_out], axis=-1) @ w_o[l]
        h = h + moe_ffn(rmsnorm(h, norm_ffn[l]), w_router[l], b_router[l],
                        w_gate_up[l], b_gate_up[l], w_down[l], b_down[l])
    return h
```

```cpp
#include <hip/hip_runtime.h>
#include <cstdio>
#include <cstdint>

#ifndef MK_N_LAUNCHES
#define MK_N_LAUNCHES 1
#endif

#define LAS __attribute__((address_space(3)))
#define GAS __attribute__((address_space(1)))
typedef unsigned short bf16_t;
typedef short bf16x8 __attribute__((ext_vector_type(8)));
typedef short s16x4 __attribute__((ext_vector_type(4)));
typedef float f32x2 __attribute__((ext_vector_type(2)));
typedef float f32x4 __attribute__((ext_vector_type(4)));
typedef float f32x16 __attribute__((ext_vector_type(16)));
typedef unsigned u32x2 __attribute__((ext_vector_type(2)));
typedef unsigned u32x4 __attribute__((ext_vector_type(4)));
typedef int v4i16_dummy;

constexpr int NB = 16, SEQ = 2048, NTOK = NB * SEQ, DM = 1024;
constexpr int CONVW = 512, QL = 384, KVL = 256, ROPE = 64, NH = 4, QKN = 128, QKH = 192, VH = 128;
constexpr int NPROJ = 2240, NPP = 2304;
constexpr int PB_B = 0, PB_C = 512, PB_X = 1024, PB_CQ = 1536, PB_CKV = 1920, PB_KPE = 2176;
constexpr int NE = 32, TOPK = 4, DFF = 1024, NSLOT = NTOK * TOPK;
constexpr int CAP = NTOK;
constexpr int MAXTILES = NSLOT / 256 + NE;
constexpr float EPS = 1e-6f;
constexpr float QSCALE = 0.07216878364870322f * 1.4426950408889634f;
constexpr float SWI_LIMIT = 7.0f, SWI_ALPHA = 1.702f;

constexpr size_t MiB = 1u << 20;
constexpr size_t WS_CTL = 0, CTL_ZERO_BYTES = 1 * MiB;
constexpr size_t WS_ROPE = 1 * MiB;
constexpr size_t WS_WRH = 1 * MiB + 512 * 1024, WS_WRL = WS_WRH + 64 * 1024;
constexpr size_t WS_WIN = 2 * MiB;
constexpr size_t WS_WUQ = 8 * MiB, WS_WUKV = 9 * MiB, WS_WO = 10 * MiB;
constexpr size_t WS_SSQ = 12 * MiB;
constexpr size_t WS_RS2 = 14 * MiB, WS_GATE = 14 * MiB + 512 * 1024;
constexpr size_t WS_TOS = 16 * MiB;
constexpr size_t WS_WGU = 32 * MiB, WS_WDN = 160 * MiB;
constexpr size_t WS_HB = 224 * MiB;
constexpr size_t WS_Q = 288 * MiB, WS_K = 336 * MiB, WS_V = 384 * MiB, WS_MIX = 416 * MiB;
constexpr size_t WS_OSLOT = 288 * MiB;
constexpr size_t WS_HN = 544 * MiB, WS_PB = 608 * MiB, WS_QRAW = 752 * MiB, WS_KVRAW = 800 * MiB;
constexpr size_t WS_ACT = 544 * MiB;
constexpr size_t WS_END = 864 * MiB;
constexpr int CW_BAR = 4096;
constexpr int CW_CNT = 16384;

constexpr int RING_BYTES = 131072;
constexpr int MISC_OFF = RING_BYTES;
constexpr int LDS_BYTES = 147456;

__device__ __forceinline__ unsigned cvt_pk_bf16(float lo, float hi) { unsigned r; asm volatile("v_cvt_pk_bf16_f32 %0, %1, %2" : "=v"(r) : "v"(lo), "v"(hi)); return r; }
__device__ __forceinline__ unsigned f2bf(float f) { unsigned u = __builtin_bit_cast(unsigned, f); return (u + 0x7fffu + ((u >> 16) & 1u)) >> 16; }
__device__ __forceinline__ unsigned pk2(float lo, float hi) { return f2bf(lo) | (f2bf(hi) << 16); }
__device__ __forceinline__ float bf_lo(unsigned w) { return __builtin_bit_cast(float, w << 16); }
__device__ __forceinline__ float bf_hi(unsigned w) { return __builtin_bit_cast(float, w & 0xffff0000u); }
__device__ __forceinline__ void unpack8(const u32x4 w, float* f) { f[0] = bf_lo(w.x); f[1] = bf_hi(w.x); f[2] = bf_lo(w.y); f[3] = bf_hi(w.y); f[4] = bf_lo(w.z); f[5] = bf_hi(w.z); f[6] = bf_lo(w.w); f[7] = bf_hi(w.w); }
__device__ __forceinline__ u32x4 pack8(const float* f) { u32x4 w; w.x = cvt_pk_bf16(f[0], f[1]); w.y = cvt_pk_bf16(f[2], f[3]); w.z = cvt_pk_bf16(f[4], f[5]); w.w = cvt_pk_bf16(f[6], f[7]); return w; }
__device__ __forceinline__ float wave_sum(float v) {
#pragma unroll
    for (int o = 1; o < 64; o <<= 1) v += __shfl_xor(v, o);
    return v;
}
__device__ __forceinline__ float half_sum(float v) {
#pragma unroll
    for (int o = 1; o < 32; o <<= 1) v += __shfl_xor(v, o);
    return v;
}
#define LDS_WAIT() asm volatile("s_waitcnt lgkmcnt(0)" ::: "memory")
#define VM_WAIT() asm volatile("s_waitcnt vmcnt(0)" ::: "memory")

namespace pg8 {
constexpr int BM = 256, BK = 64, HALF = 128, HTB = HALF * BK * 2, STAGE_BYTES = 8 * HTB, NXCD = 8, WGM = 8;
__host__ __device__ __forceinline__ int lds_byte(int r, int c) { const int st = (r >> 4) * 2 + (c >> 5), rr = r & 15, cc = c & 31, ob = rr * 64 + cc * 2; return st * 1024 + (ob ^ (((ob >> 9) & 1) << 5)); }
__host__ __device__ __forceinline__ void stage_rc(int b, int& R, int& C) { const int st = b / 1024, sb = b % 1024, swz = sb ^ (((sb >> 9) & 1) << 5); R = (st >> 1) * 16 + swz / 64; C = (st & 1) * 32 + (swz % 64) / 2; }
__host__ __device__ __forceinline__ int perm32(int rho) { const int n = rho >> 4, i = rho & 15; return 8 * (i >> 2) + 4 * n + (i & 3); }

struct Unit { int pm, pn, e, p0, cnt; };

struct DenseSched {
    const bf16_t* A; const bf16_t* Bt; int lda, K, nM, nN, nwg, G, c;
    __device__ void init(const bf16_t* A_, int lda_, const bf16_t* Bt_, int M, int N, int K_, int G_, int c_) { A = A_; Bt = Bt_; lda = lda_; K = K_; nM = M / BM; nN = N / BM; nwg = nM * nN; G = G_; c = c_; }
    __device__ __forceinline__ bool next(int i, Unit& u) const {
        const long L = (long)i * G + c; if (L >= nwg) return false;
        int wgid = (int)L; { const int q = nwg / NXCD, r = nwg % NXCD, xcd = wgid % NXCD, off = wgid / NXCD; wgid = (xcd < r ? xcd * (q + 1) : r * (q + 1) + (xcd - r) * q) + off; }
        const int nig = WGM * nN, gid = wgid / nig, fm = gid * WGM, gsz = (nM - fm) < WGM ? (nM - fm) : WGM;
        u.pm = fm + ((wgid % nig) % gsz); u.pn = (wgid % nig) / gsz; u.e = 0; u.p0 = 0; u.cnt = 0; return true;
    }
    __device__ __forceinline__ const char* a_tile(const Unit& u) const { return (const char*)A + (size_t)u.pm * BM * lda * 2; }
    __device__ __forceinline__ const char* b_tile(const Unit& u) const { return (const char*)Bt + (size_t)u.pn * BM * K * 2; }
    __device__ __forceinline__ unsigned a_rowoff(const Unit&, int) const { return 0u; }
};
struct MoeSched {
    const bf16_t* A; const bf16_t* Bt; int lda, K, nN, G, c; size_t estride; const LAS int* tab; const int* tos;
    __device__ __forceinline__ bool next(int i, Unit& u) const {
        const int T = __builtin_amdgcn_readfirstlane(tab[32]), nwg = T * nN;
        const long L = (long)i * G + c; if (L >= nwg) return false;
        int wgid = (int)L; { const int q = nwg / NXCD, r = nwg % NXCD, xcd = wgid % NXCD, off = wgid / NXCD; wgid = (xcd < r ? xcd * (q + 1) : r * (q + 1) + (xcd - r) * q) + off; }
        const int nig = WGM * nN, gid = wgid / nig, fm = gid * WGM, gsz = (T - fm) < WGM ? (T - fm) : WGM;
        const int mt = fm + ((wgid % nig) % gsz); u.pm = mt; u.pn = (wgid % nig) / gsz;
        int e = 0; while (e < NE - 1 && __builtin_amdgcn_readfirstlane(tab[e + 1]) <= mt) ++e;
        u.e = e; u.p0 = (mt - __builtin_amdgcn_readfirstlane(tab[e])) * BM; u.cnt = __builtin_amdgcn_readfirstlane(tab[48 + e]); return true;
    }
    __device__ __forceinline__ const char* a_tile(const Unit& u) const { return (const char*)A + (size_t)u.pm * BM * lda * 2; }
    __device__ __forceinline__ const char* b_tile(const Unit& u) const { return (const char*)Bt + ((size_t)u.e * estride + (size_t)u.pn * BM * K) * 2; }
    __device__ __forceinline__ unsigned a_rowoff(const Unit& u, int r) const {
        const int p = u.p0 + r; int slot = 0; if (p < u.cnt) slot = tos[(size_t)u.e * CAP + p];
        return (unsigned)(slot >> 2) * (unsigned)(lda * 2);
    }
};

template <class Epi, class Sched, bool GATHER>
__device__ __forceinline__ void gemm_phase(LAS unsigned char* lds, const Sched& S, const Epi& E) {
    const int tid = threadIdx.x, wid = __builtin_amdgcn_readfirstlane(tid >> 6), lane = tid & 63, wr = wid >> 2, wc = wid & 3, fr = lane & 15, fq = lane >> 4;
    const int K = S.K, lda = S.lda, nt = K / BK;
    unsigned voffB[2], aoc[2][2]; int RA[2], CA[2];
    LAS u32x4* aon_l = (LAS u32x4*)(lds + STAGE_BYTES + 1024) + tid;
#pragma unroll
    for (int i = 0; i < 2; ++i) { int R, C; stage_rc(tid * 16 + i * 8192, R, C); const int Rb = (R & ~31) + perm32(R & 31);
        voffB[i] = (unsigned)(Rb * K + C) * 2u; RA[i] = R; CA[i] = C;
        aoc[0][i] = (unsigned)(R * lda + C) * 2u; aoc[1][i] = (unsigned)((R + HALF) * lda + C) * 2u; }
    const size_t kstep = (size_t)(BK * 2);
    const size_t hstepB = (size_t)HALF * K * 2;
    const unsigned ldsw = (unsigned)wid * 1024u;
    const int aoff = lds_byte(wr * 64 + fr, fq * 8), boff = lds_byte(wc * 32 + fr, fq * 8);
#define PG8_SA(b, h) (((b) * 2 + (h)) * HTB)
#define PG8_SB(b, h) ((4 + (b) * 2 + (h)) * HTB)
#define PG8_STAGE_B(bufoff, gbase) do { _Pragma("unroll") for (int _i = 0; _i < 2; ++_i) \
        __builtin_amdgcn_global_load_lds((const unsigned*)((const char*)(gbase) + voffB[_i]), (LAS unsigned*)(lds + (bufoff) + ldsw + _i * 8192), 16, 0, 0); } while (0)
#define PG8_STAGE_A(bufoff, gbase, h) do { _Pragma("unroll") for (int _i = 0; _i < 2; ++_i) \
        __builtin_amdgcn_global_load_lds((const unsigned*)((const char*)(gbase) + aoc[h][_i]), (LAS unsigned*)(lds + (bufoff) + ldsw + _i * 8192), 16, 0, 0); } while (0)
#define PG8_LDA(dst, b, h) do { _Pragma("unroll") for (int m = 0; m < 4; ++m) _Pragma("unroll") for (int k = 0; k < 2; ++k) dst[m][k] = *(const LAS bf16x8*)(lds + PG8_SA(b, h) + aoff + m * 2048 + k * 1024); } while (0)
#define PG8_LDB(dst, b, h) do { _Pragma("unroll") for (int n = 0; n < 2; ++n) _Pragma("unroll") for (int k = 0; k < 2; ++k) dst[n][k] = *(const LAS bf16x8*)(lds + PG8_SB(b, h) + boff + n * 2048 + k * 1024); } while (0)
#define PG8_MMA(ai, bj, At, Bt) do { __builtin_amdgcn_s_setprio(1); _Pragma("unroll") for (int m = 0; m < 4; ++m) _Pragma("unroll") for (int n = 0; n < 2; ++n) _Pragma("unroll") for (int k = 0; k < 2; ++k) \
        acc[ai][bj][m][n] = __builtin_amdgcn_mfma_f32_16x16x32_bf16(Bt[n][k], At[m][k], acc[ai][bj][m][n], 0, 0, 0); __builtin_amdgcn_s_setprio(0); } while (0)
#define PG8_WAIT_V(n) asm volatile("s_waitcnt vmcnt(" #n ")" ::: "memory")
#define PG8_WAIT_L(n) asm volatile("s_waitcnt lgkmcnt(" #n ")" ::: "memory")
#define PG8_BAR __builtin_amdgcn_s_barrier()
#define PG8_SCHED __builtin_amdgcn_sched_barrier(0)
    Unit cur, nxt; int ui = 0;
    if (!S.next(0, cur)) return;
    f32x4 acc[2][2][4][2];
#pragma unroll
    for (int a = 0; a < 2; ++a)
#pragma unroll
        for (int b = 0; b < 2; ++b)
#pragma unroll
            for (int m = 0; m < 4; ++m)
#pragma unroll
                for (int n = 0; n < 2; ++n) acc[a][b][m][n] = (f32x4){0.f, 0.f, 0.f, 0.f};
    bf16x8 At[4][2], B0[2][2], B1[2][2];
    const char* cA = GATHER ? (const char*)S.A : S.a_tile(cur); const char* cB = S.b_tile(cur);
    if constexpr (GATHER) {
#pragma unroll
        for (int h = 0; h < 2; ++h)
#pragma unroll
            for (int i = 0; i < 2; ++i) aoc[h][i] = S.a_rowoff(cur, h * HALF + RA[i]) + (unsigned)CA[i] * 2u;
    }
    PG8_STAGE_B(PG8_SB(0, 0), cB); PG8_STAGE_B(PG8_SB(0, 1), cB + hstepB); PG8_STAGE_A(PG8_SA(0, 0), cA, 0); PG8_STAGE_A(PG8_SA(0, 1), cA, 1);
    if (wr == 1) PG8_BAR;
    PG8_WAIT_V(2); PG8_BAR;
    PG8_STAGE_B(PG8_SB(1, 0), cB + kstep); PG8_STAGE_A(PG8_SA(1, 0), cA + kstep, 0); PG8_STAGE_B(PG8_SB(1, 1), cB + hstepB + kstep);
    PG8_WAIT_V(6); PG8_BAR;
    for (;;) {
        const bool has_next = S.next(ui + 1, nxt);
        const char* nA = GATHER ? cA : (has_next ? S.a_tile(nxt) : cA); const char* nB = has_next ? S.b_tile(nxt) : cB;
        if constexpr (GATHER) {
            u32x4 an = {aoc[0][0], aoc[0][1], aoc[1][0], aoc[1][1]};
            if (has_next) { an.x = S.a_rowoff(nxt, RA[0]) + (unsigned)CA[0] * 2u; an.y = S.a_rowoff(nxt, RA[1]) + (unsigned)CA[1] * 2u;
                            an.z = S.a_rowoff(nxt, HALF + RA[0]) + (unsigned)CA[0] * 2u; an.w = S.a_rowoff(nxt, HALF + RA[1]) + (unsigned)CA[1] * 2u; }
            *aon_l = an;
        }
        for (int t = 0; t < nt; t += 2) {
            const bool last = (t == nt - 2);
            const char* a1 = cA + (size_t)(t + 1) * kstep;
            const char* a2 = last ? nA : cA + (size_t)(t + 2) * kstep; const char* b2 = last ? nB : cB + (size_t)(t + 2) * kstep;
            const char* a3 = a2 + kstep; const char* b3 = b2 + kstep;
            PG8_LDB(B0, 0, 0); PG8_LDB(B1, 0, 1); PG8_SCHED; PG8_LDA(At, 0, 0); PG8_STAGE_A(PG8_SA(1, 1), a1, 1);
            PG8_WAIT_V(8); PG8_WAIT_L(0); PG8_BAR; PG8_MMA(0, 0, At, B0); PG8_MMA(0, 1, At, B1); PG8_BAR; PG8_SCHED;
            if constexpr (GATHER) { if (last) { const u32x4 an = *aon_l; aoc[0][0] = an.x; aoc[0][1] = an.y; aoc[1][0] = an.z; aoc[1][1] = an.w; } }
            PG8_LDA(At, 0, 1); PG8_STAGE_B(PG8_SB(0, 0), b2); PG8_STAGE_B(PG8_SB(0, 1), b2 + hstepB); PG8_STAGE_A(PG8_SA(0, 0), a2, 0);
            PG8_WAIT_V(8); PG8_WAIT_L(0); PG8_BAR; PG8_MMA(1, 0, At, B0); PG8_MMA(1, 1, At, B1); PG8_BAR; PG8_SCHED;
            PG8_LDB(B0, 1, 0); PG8_LDB(B1, 1, 1); PG8_SCHED; PG8_LDA(At, 1, 0); PG8_STAGE_A(PG8_SA(0, 1), a2, 1);
            PG8_WAIT_V(8); PG8_WAIT_L(0); PG8_BAR; PG8_MMA(0, 0, At, B0); PG8_MMA(0, 1, At, B1); PG8_BAR; PG8_SCHED;
            PG8_LDA(At, 1, 1); PG8_STAGE_B(PG8_SB(1, 0), b3); PG8_STAGE_B(PG8_SB(1, 1), b3 + hstepB); PG8_STAGE_A(PG8_SA(1, 0), a3, 0);
            PG8_WAIT_V(8); PG8_WAIT_L(0); PG8_BAR; PG8_MMA(1, 0, At, B0); PG8_MMA(1, 1, At, B1); PG8_BAR; PG8_SCHED;
        }
        if (wr == 0) PG8_BAR;
        E(acc, cur, wr, wc, fr, fq);
        if (!has_next) break;
#pragma unroll
        for (int a = 0; a < 2; ++a)
#pragma unroll
            for (int b = 0; b < 2; ++b)
#pragma unroll
                for (int m = 0; m < 4; ++m)
#pragma unroll
                    for (int n = 0; n < 2; ++n) acc[a][b][m][n] = (f32x4){0.f, 0.f, 0.f, 0.f};
        cur = nxt; cA = nA; cB = nB; ++ui;
        if (wr == 1) PG8_BAR;
    }
    PG8_WAIT_V(0);
    PG8_BAR;
#undef PG8_SA
#undef PG8_SB
#undef PG8_STAGE_A
#undef PG8_STAGE_B
#undef PG8_LDA
#undef PG8_LDB
#undef PG8_MMA
#undef PG8_WAIT_V
#undef PG8_WAIT_L
#undef PG8_BAR
#undef PG8_SCHED
}

struct EpiBf16 {
    bf16_t* O; int ldc;
    __device__ __forceinline__ void operator()(const f32x4 (&acc)[2][2][4][2], const Unit& u, int wr, int wc, int fr, int fq) const {
        asm volatile("" : "+v"(fr), "+v"(fq));
        const int row0 = u.pm * BM + wr * 64 + fr, col0 = u.pn * BM + wc * 32 + 8 * fq;
#pragma unroll
        for (int ai = 0; ai < 2; ++ai)
#pragma unroll
            for (int m = 0; m < 4; ++m) { bf16_t* rowp = O + (size_t)(row0 + ai * HALF + m * 16) * ldc + col0;
#pragma unroll
                for (int bj = 0; bj < 2; ++bj) { const f32x4 v0 = acc[ai][bj][m][0], v1 = acc[ai][bj][m][1];
                    u32x4 w; w.x = cvt_pk_bf16(v0[0], v0[1]); w.y = cvt_pk_bf16(v0[2], v0[3]); w.z = cvt_pk_bf16(v1[0], v1[1]); w.w = cvt_pk_bf16(v1[2], v1[3]);
                    *(u32x4*)(rowp + bj * HALF) = w; } }
    }
};
struct EpiOut {
    const float* x; float* out; bf16_t* hb; float* ssq;
    __device__ __forceinline__ void operator()(const f32x4 (&acc)[2][2][4][2], const Unit& u, int wr, int wc, int fr, int fq) const {
        asm volatile("" : "+v"(fr), "+v"(fq));
        const int row0 = u.pm * BM + wr * 64 + fr, col0 = u.pn * BM + wc * 32 + 8 * fq;
#pragma unroll
        for (int ai = 0; ai < 2; ++ai)
#pragma unroll
            for (int m = 0; m < 4; ++m) { const int row = row0 + ai * HALF + m * 16; const size_t off = (size_t)row * DM + col0; float ss = 0.f;
#pragma unroll
                for (int bj = 0; bj < 2; ++bj) { const f32x4 x0 = *(const f32x4*)(x + off + bj * HALF), x1 = *(const f32x4*)(x + off + bj * HALF + 4);
                    const f32x4 v0 = acc[ai][bj][m][0] + x0, v1 = acc[ai][bj][m][1] + x1;
                    *(f32x4*)(out + off + bj * HALF) = v0; *(f32x4*)(out + off + bj * HALF + 4) = v1;
                    u32x4 w; w.x = cvt_pk_bf16(v0[0], v0[1]); w.y = cvt_pk_bf16(v0[2], v0[3]); w.z = cvt_pk_bf16(v1[0], v1[1]); w.w = cvt_pk_bf16(v1[2], v1[3]);
                    *(u32x4*)(hb + off + bj * HALF) = w;
                    ss += (v0[0] * v0[0] + v0[1] * v0[1]) + (v0[2] * v0[2] + v0[3] * v0[3]) + (v1[0] * v1[0] + v1[1] * v1[1]) + (v1[2] * v1[2] + v1[3] * v1[3]); }
                ss += __shfl_xor(ss, 16); ss += __shfl_xor(ss, 32);
                if (fq == 0) ssq[(size_t)(u.pn * 4 + wc) * NTOK + row] = ss; }
    }
};
struct EpiSwiglu {
    bf16_t* act; const float* bgu; const float* rs2; const int* tos;
    __device__ __forceinline__ void operator()(const f32x4 (&acc)[2][2][4][2], const Unit& u, int wr, int wc, int fr, int fq) const {
        asm volatile("" : "+v"(fr), "+v"(fq));
        const int rt0 = wr * 64 + fr, j0 = wc * 32 + 8 * fq;
        const float* bg = bgu + (size_t)u.e * (2 * DFF) + u.pn * HALF + j0;
        const f32x4 bg0 = *(const f32x4*)bg, bg1 = *(const f32x4*)(bg + 4), bu0 = *(const f32x4*)(bg + DFF), bu1 = *(const f32x4*)(bg + DFF + 4);
#pragma unroll
        for (int ai = 0; ai < 2; ++ai)
#pragma unroll
            for (int m = 0; m < 4; ++m) { const int rt = rt0 + ai * HALF + m * 16, p = u.p0 + rt;
                int slot = 0; if (p < u.cnt) slot = tos[(size_t)u.e * CAP + p];
                const float rs = rs2[slot >> 2];
                float o[8];
#pragma unroll
                for (int n = 0; n < 2; ++n) { const f32x4 g4 = acc[ai][0][m][n] * rs + (n ? bg1 : bg0), u4 = acc[ai][1][m][n] * rs + (n ? bu1 : bu0);
#pragma unroll
                    for (int i = 0; i < 4; ++i) { const float g = fminf(g4[i], SWI_LIMIT), uu = fminf(fmaxf(u4[i], -SWI_LIMIT), SWI_LIMIT);
                        const float sg = __builtin_amdgcn_rcpf(1.f + __builtin_amdgcn_exp2f(g * (-SWI_ALPHA * 1.4426950408889634f)));
                        o[n * 4 + i] = (uu + 1.f) * (g * sg); } }
                *(u32x4*)(act + ((size_t)u.pm * BM + rt) * DFF + u.pn * HALF + j0) = pack8(o);
                asm volatile("" ::: "memory"); }
    }
};
struct EpiDown {
    bf16_t* oslot; const float* bdn; const float* gate; const int* tos;
    __device__ __forceinline__ void operator()(const f32x4 (&acc)[2][2][4][2], const Unit& u, int wr, int wc, int fr, int fq) const {
        asm volatile("" : "+v"(fr), "+v"(fq));
        const int rt0 = wr * 64 + fr, col0 = u.pn * BM + wc * 32 + 8 * fq;
        const float* bp = bdn + (size_t)u.e * DM + col0;
        f32x4 bv[2][2];
#pragma unroll
        for (int bj = 0; bj < 2; ++bj) { bv[bj][0] = *(const f32x4*)(bp + bj * HALF); bv[bj][1] = *(const f32x4*)(bp + bj * HALF + 4); }
#pragma unroll
        for (int ai = 0; ai < 2; ++ai)
#pragma unroll
            for (int m = 0; m < 4; ++m) { const int rt = rt0 + ai * HALF + m * 16, p = u.p0 + rt;
                if (p < u.cnt) { const int slot = tos[(size_t)u.e * CAP + p]; const float g = gate[slot];
#pragma unroll
                    for (int bj = 0; bj < 2; ++bj) { const f32x4 v0 = (acc[ai][bj][m][0] + bv[bj][0]) * g, v1 = (acc[ai][bj][m][1] + bv[bj][1]) * g;
                        u32x4 w; w.x = cvt_pk_bf16(v0[0], v0[1]); w.y = cvt_pk_bf16(v0[2], v0[3]); w.z = cvt_pk_bf16(v1[0], v1[1]); w.w = cvt_pk_bf16(v1[2], v1[3]);
                        *(u32x4*)(oslot + (size_t)slot * DM + col0 + bj * HALF) = w; } } }
    }
};
}

namespace att {
constexpr int LDQ = NH * QKH, LDK = NH * QKH, LDV = NH * VH, LDO = DM;
constexpr int KT_BYTES = 64 * QKH * 2, VT_BYTES = 64 * VH * 2;
constexpr int L_K = 0, L_V = 2 * KT_BYTES, L_WS = L_V + 2 * VT_BYTES, L_END = L_WS + 8 * 256;
constexpr float THRL = 8.f * 1.4426950408889634f;
__device__ __forceinline__ int crow(int r, int hi) { return (r & 3) + 8 * (r >> 2) + 4 * hi; }
#define SBAR() __builtin_amdgcn_sched_barrier(0)
__device__ __forceinline__ int v_rd_base(int lane) { return ((lane & 3) << 3) | (((lane >> 2) & 3) << 6) | (((lane >> 4) & 1) << 5) | (((lane >> 5) & 1) << 8); }
constexpr int v_rd_off(int d0, int ks, int half) { return d0 * 512 + ks * 4096 + half * 2048; }
template <int OFF> __device__ __forceinline__ s16x4 tr_read(int vb) {
    s16x4 r; asm volatile("ds_read_b64_tr_b16 %0, %1 offset:%2" : "=&v"(r) : "v"(vb), "i"(OFF) : "memory"); return r;
}
template <int D0> __device__ __forceinline__ void pv_one(f32x16& od, int vb, bf16x8 pa0, bf16x8 pa1, bf16x8 pa2, bf16x8 pa3) {
    const s16x4 l0 = tr_read<v_rd_off(D0, 0, 0)>(vb), h0 = tr_read<v_rd_off(D0, 0, 1)>(vb), l1 = tr_read<v_rd_off(D0, 1, 0)>(vb), h1 = tr_read<v_rd_off(D0, 1, 1)>(vb);
    const s16x4 l2 = tr_read<v_rd_off(D0, 2, 0)>(vb), h2 = tr_read<v_rd_off(D0, 2, 1)>(vb), l3 = tr_read<v_rd_off(D0, 3, 0)>(vb), h3 = tr_read<v_rd_off(D0, 3, 1)>(vb);
    asm volatile("s_waitcnt lgkmcnt(0)" ::: "memory"); SBAR();
#define PK(L, H) (bf16x8){L[0], L[1], L[2], L[3], H[0], H[1], H[2], H[3]}
    od = __builtin_amdgcn_mfma_f32_32x32x16_bf16(pa0, PK(l0, h0), od, 0, 0, 0);
    od = __builtin_amdgcn_mfma_f32_32x32x16_bf16(pa1, PK(l1, h1), od, 0, 0, 0);
    od = __builtin_amdgcn_mfma_f32_32x32x16_bf16(pa2, PK(l2, h2), od, 0, 0, 0);
    od = __builtin_amdgcn_mfma_f32_32x32x16_bf16(pa3, PK(l3, h3), od, 0, 0, 0);
#undef PK
}
__device__ __forceinline__ void glds16(const void* gsrc, LAS unsigned char* dst) {
    __builtin_amdgcn_global_load_lds((const unsigned*)gsrc, (LAS unsigned*)dst, 16, 0, 0);
}
__device__ __forceinline__ void attn_unit(int b, int h, int qb, const bf16_t* Q, const bf16_t* Kg, const bf16_t* Vg, bf16_t* O, LAS unsigned char* lds) {
    const int tid = threadIdx.x, wid = __builtin_amdgcn_readfirstlane(tid >> 6), lane = tid & 63, r32 = lane & 31, hi = lane >> 5;
    const size_t tok0 = (size_t)b * SEQ;
    bf16x8 qr[12];
    { const bf16_t* Qw = Q + (tok0 + (size_t)qb * 256 + wid * 32 + r32) * LDQ + h * QKH + hi * 8;
#pragma unroll
      for (int d0 = 0; d0 < 12; ++d0) qr[d0] = *(const bf16x8*)(Qw + d0 * 16); }
    unsigned koff[3], voff[2];
#pragma unroll
    for (int i = 0; i < 3; ++i) { const int G = 64 * (wid + 8 * i) + lane, row = G / 24, cgs = G % 24, cg = (cgs & ~7) | ((cgs & 7) ^ ((row >> 1) & 7)); koff[i] = (unsigned)(row * LDK * 2 + cg * 16); }
#pragma unroll
    for (int i = 0; i < 2; ++i) { const int p = wid + 8 * i, sub = 2 * p + (lane >> 5), kkh = sub >> 2, cblk = sub & 3, kkl = (lane & 31) >> 2, cl = (lane & 3) * 8, kk = kkh * 8 + kkl;
        const int k = (kk & ~0xC) | ((kk & 4) << 1) | ((kk & 8) >> 1), c = cblk * 32 + cl; voff[i] = (unsigned)(k * LDV * 2 + c * 2); }
    const char* Kh = (const char*)(Kg + tok0 * LDK + h * QKH); const char* Vh = (const char*)(Vg + tok0 * LDV + h * VH);
#define ATT_DMA(j, buf) do { const char* kp_ = Kh + (size_t)(j) * 64 * LDK * 2; const char* vp_ = Vh + (size_t)(j) * 64 * LDV * 2; \
        _Pragma("unroll") for (int i_ = 0; i_ < 3; ++i_) glds16(kp_ + koff[i_], lds + L_K + (buf) * KT_BYTES + (wid + 8 * i_) * 1024); \
        _Pragma("unroll") for (int i_ = 0; i_ < 2; ++i_) glds16(vp_ + voff[i_], lds + L_V + (buf) * VT_BYTES + (wid + 8 * i_) * 1024); } while (0)
    const int swz = (r32 >> 1) & 7; int kx[4];
#pragma unroll
    for (int dd = 0; dd < 4; ++dd) kx[dd] = r32 * (QKH * 2) + (((2 * dd + hi) ^ swz) << 4);
    LAS float* ws = (LAS float*)(lds + L_WS) + wid * 64; LAS float* li_l = ws; LAS float* al_l = ws + 32;
    const int vb0 = L_V + v_rd_base(lane);
    float m_reg = -1e30f, l_reg = 0.f; f32x16 o[4];
#pragma unroll
    for (int d = 0; d < 4; ++d)
#pragma unroll
        for (int r = 0; r < 16; ++r) o[d][r] = 0.f;
    const int NT = 4 * qb + 4, my_last = 4 * qb + (wid >> 1);
    ATT_DMA(0, 0);
    for (int j = 0; j < NT; ++j) {
        const int buf = j & 1;
        asm volatile("s_waitcnt vmcnt(0)" ::: "memory"); __builtin_amdgcn_s_barrier(); asm volatile("" ::: "memory");
        if (j + 1 < NT) ATT_DMA(j + 1, buf ^ 1);
        if (j <= my_last) {
            const LAS unsigned char* Ks = lds + L_K + buf * KT_BYTES;
            f32x16 p0, p1;
#pragma unroll
            for (int r = 0; r < 16; ++r) { p0[r] = 0.f; p1[r] = 0.f; }
#pragma unroll
            for (int d0 = 0; d0 < 12; ++d0) {
                const bf16x8 b0 = *(const LAS bf16x8*)(Ks + kx[d0 & 3] + (d0 >> 2) * 128);
                const bf16x8 b1 = *(const LAS bf16x8*)(Ks + kx[d0 & 3] + (d0 >> 2) * 128 + 32 * QKH * 2);
                p0 = __builtin_amdgcn_mfma_f32_32x32x16_bf16(b0, qr[d0], p0, 0, 0, 0);
                p1 = __builtin_amdgcn_mfma_f32_32x32x16_bf16(b1, qr[d0], p1, 0, 0, 0);
            }
            float pmax = p0[0];
#pragma unroll
            for (int r = 1; r < 16; ++r) pmax = fmaxf(pmax, p0[r]);
#pragma unroll
            for (int r = 0; r < 16; ++r) pmax = fmaxf(pmax, p1[r]);
            { auto rr = __builtin_amdgcn_permlane32_swap(__float_as_uint(pmax), __float_as_uint(pmax), false, false);
              pmax = fmaxf(__uint_as_float(rr[0]), __uint_as_float(rr[1])); }
            float mn, alpha;
            if (__builtin_expect(__all(pmax - m_reg <= THRL), 1)) { mn = m_reg; alpha = 1.f; }
            else { mn = fmaxf(m_reg, pmax); alpha = __builtin_amdgcn_exp2f(m_reg - mn); m_reg = mn; }
#pragma unroll
            for (int r = 0; r < 16; ++r) { p0[r] = __builtin_amdgcn_exp2f(p0[r] - mn); p1[r] = __builtin_amdgcn_exp2f(p1[r] - mn); }
            float ps = 0.f;
#pragma unroll
            for (int r = 0; r < 16; ++r) ps += p0[r];
#pragma unroll
            for (int r = 0; r < 16; ++r) ps += p1[r];
            { auto rr = __builtin_amdgcn_permlane32_swap(__float_as_uint(ps), __float_as_uint(ps), false, false);
              ps = __uint_as_float(rr[0]) + __uint_as_float(rr[1]); }
            l_reg = l_reg * alpha + ps;
            if (__any(alpha < 1.f)) { if (hi == 0) al_l[r32] = alpha; asm volatile("s_waitcnt lgkmcnt(0)" ::: "memory");
#pragma unroll
                for (int r = 0; r < 16; ++r) { const float a = al_l[crow(r, hi)];
#pragma unroll
                    for (int d = 0; d < 4; ++d) o[d][r] *= a; } }
            bf16x8 pa0, pa1, pa2, pa3;
#define PK4(P, BASE, OUT) do { unsigned a0 = cvt_pk_bf16(P[BASE + 0], P[BASE + 1]), a1 = cvt_pk_bf16(P[BASE + 2], P[BASE + 3]);   \
    unsigned b0_ = cvt_pk_bf16(P[BASE + 4], P[BASE + 5]), b1_ = cvt_pk_bf16(P[BASE + 6], P[BASE + 7]);                              \
    auto r0 = __builtin_amdgcn_permlane32_swap(a0, b0_, false, false); auto r1 = __builtin_amdgcn_permlane32_swap(a1, b1_, false, false); \
    u32x4 w = {r0[0], r1[0], r0[1], r1[1]}; OUT = __builtin_bit_cast(bf16x8, w); } while (0)
            PK4(p0, 0, pa0); PK4(p0, 8, pa1); PK4(p1, 0, pa2); PK4(p1, 8, pa3);
#undef PK4
            const int vb = vb0 + buf * VT_BYTES;
            pv_one<0>(o[0], vb, pa0, pa1, pa2, pa3); pv_one<1>(o[1], vb, pa0, pa1, pa2, pa3); pv_one<2>(o[2], vb, pa0, pa1, pa2, pa3); pv_one<3>(o[3], vb, pa0, pa1, pa2, pa3);
        }
    }
    if (hi == 0) li_l[r32] = l_reg; asm volatile("s_waitcnt lgkmcnt(0)" ::: "memory");
    bf16_t* Ow = O + (tok0 + (size_t)qb * 256 + wid * 32) * LDO + h * VH;
#pragma unroll
    for (int r = 0; r < 16; ++r) { const int orow = crow(r, hi); const float rl = __builtin_amdgcn_rcpf(li_l[orow]);
#pragma unroll
        for (int d0 = 0; d0 < 4; ++d0) Ow[(size_t)orow * LDO + d0 * 32 + r32] = (bf16_t)f2bf(o[d0][r] * rl); }
    asm volatile("s_waitcnt lgkmcnt(0)" ::: "memory"); __builtin_amdgcn_s_barrier(); asm volatile("" ::: "memory");
#undef ATT_DMA
}
#undef SBAR
}

#define XB_TMO      128
#define XB_XCNT(j)  (256  + 64 * (j))
#define XB_XSUB(j)  (1280 + 64 * (j))
#define XB_XGEN(j)  (2304 + 64 * (j))
#define XB_TOP      3328
#define XB_TOPGEN   3392
#define XCD_BAR_WORDS 3456
#define XB_SPIN_CAP (1u << 18)
__device__ __forceinline__ unsigned xb_ld(unsigned* p)              { return __hip_atomic_load(p, __ATOMIC_RELAXED, __HIP_MEMORY_SCOPE_AGENT); }
__device__ __forceinline__ unsigned xb_add(unsigned* p, unsigned v) { return __hip_atomic_fetch_add(p, v, __ATOMIC_RELAXED, __HIP_MEMORY_SCOPE_AGENT); }
__device__ __forceinline__ unsigned xb_xcc_id() { return (unsigned)__builtin_amdgcn_s_getreg((3 << 11) | 20) & 0xFu; }
#define XB_SPIN(cond, bar) do { unsigned _sp = 0; while (cond) { __builtin_amdgcn_s_sleep(1); \
    if ((++_sp & 255u) == 0u) { if (xb_ld(&(bar)[XB_TMO])) break; if (_sp > XB_SPIN_CAP) { atomicAdd(&(bar)[XB_TMO], 1u); break; } } } } while (0)
struct XcdBarrier { unsigned* bar; unsigned x; volatile LAS unsigned* st; };
__device__ __forceinline__ XcdBarrier xcd_barrier_post(unsigned* bar, volatile LAS unsigned* st) {
    XcdBarrier b; b.bar = bar; b.x = xb_xcc_id(); b.st = st;
    if (threadIdx.x == 0) (void)xb_add(&bar[XB_XCNT(b.x)], 1u);
    return b;
}
__device__ __forceinline__ void xcd_barrier_complete(unsigned* bar, unsigned x, unsigned& nloc, unsigned& nx) {
    const unsigned G = gridDim.x * gridDim.y * gridDim.z;
    unsigned sum, cnt, mine, sp = 0u;
    for (;;) {
        sum = 0u; cnt = 0u; mine = 0u;
#pragma unroll
        for (unsigned j = 0; j < 16; ++j) { const unsigned c = xb_ld(&bar[XB_XCNT(j)]); sum += c; cnt += (c > 0u) ? 1u : 0u; mine = (j == x) ? c : mine; }
        if (sum == G) break;
        __builtin_amdgcn_s_sleep(1);
        if ((++sp & 255u) == 0u) { if (xb_ld(&bar[XB_TMO])) break; if (sp > XB_SPIN_CAP) { atomicAdd(&bar[XB_TMO], 1u); break; } }
    }
    nloc = mine > 0u ? mine : 1u; nx = cnt > 0u ? cnt : 1u;
}
__device__ __forceinline__ void xcd_barrier(const XcdBarrier& b) {
    asm volatile("s_waitcnt vmcnt(0)" ::: "memory");
    __syncthreads();
    if (threadIdx.x == 0) {
        unsigned* bar = b.bar;
        __builtin_amdgcn_s_waitcnt(0);
        unsigned nloc = b.st[0], nx = b.st[1];
        if (nloc == 0u) { xcd_barrier_complete(bar, b.x, nloc, nx); b.st[0] = nloc; b.st[1] = nx; }
        const unsigned old = xb_add(&bar[XB_XSUB(b.x)], 1u);
        const unsigned gen = old / nloc;
        if (old + 1u == (gen + 1u) * nloc) {
            __builtin_amdgcn_fence(__ATOMIC_RELEASE, "agent");
            asm volatile("s_waitcnt vmcnt(0)" ::: "memory");
            const unsigned og = xb_add(&bar[XB_TOP], 1u);
            const unsigned tg = og / nx;
            if (og + 1u == (tg + 1u) * nx) xb_add(&bar[XB_TOPGEN], 1u);
            else XB_SPIN(xb_ld(&bar[XB_TOPGEN]) == tg, bar);
            __builtin_amdgcn_fence(__ATOMIC_ACQUIRE, "agent");
            xb_add(&bar[XB_XGEN(b.x)], 1u);
            asm volatile("s_waitcnt vmcnt(0)" ::: "memory");
        } else {
            XB_SPIN(xb_ld(&bar[XB_XGEN(b.x)]) == gen, bar);
            __builtin_amdgcn_fence(__ATOMIC_ACQUIRE, "agent");
            asm volatile("s_waitcnt vmcnt(0)" ::: "memory");
        }
    }
    __syncthreads();
}

constexpr int NWAVES = 8;
constexpr int N_LAUNCHES = MK_N_LAUNCHES;
constexpr int N_PHASES = 10;
struct Args { const float* in[18]; float* out; unsigned char* ws; int ph_lo, ph_hi; };

__device__ __forceinline__ void p0_transpose_item(const float* W, int K, int N, bf16_t* WT, int drow0, const float* kscale, LAS float* scr, int k0, int n0, int lane) {
#pragma unroll 8
    for (int i = 0; i < 32; ++i) { const int kk = 2 * i + (lane >> 5); float v = W[(size_t)(k0 + kk) * N + n0 + (lane & 31)]; if (kscale) v *= kscale[k0 + kk]; scr[kk * 33 + (lane & 31)] = v; }
    LDS_WAIT(); asm volatile("" ::: "memory");
    const int c = lane & 7;
#pragma unroll
    for (int j = 0; j < 4; ++j) { const int n = (lane >> 3) + 8 * j; const LAS float* s = scr + (8 * c) * 33 + n;
        u32x4 o; o.x = pk2(s[0 * 33], s[1 * 33]); o.y = pk2(s[2 * 33], s[3 * 33]); o.z = pk2(s[4 * 33], s[5 * 33]); o.w = pk2(s[6 * 33], s[7 * 33]);
        *(u32x4*)(WT + (size_t)(drow0 + n) * K + k0 + 8 * c) = o; }
    LDS_WAIT(); asm volatile("" ::: "memory");
}

template <int PHMASK> __global__ void __launch_bounds__(NWAVES * 64, 2) fwd_kernel_t(Args args) {
    extern __shared__ __attribute__((aligned(16))) unsigned char lds_raw[];
    LAS unsigned char* lds = (LAS unsigned char*)lds_raw;
    volatile LAS unsigned* MISC = (volatile LAS unsigned*)(lds + MISC_OFF);
    const int tid = threadIdx.x, lane = tid & 63, wave = __builtin_amdgcn_readfirstlane(tid >> 6);
    const int G = gridDim.x; const int bx = blockIdx.x; const int vcu = (G % 8 == 0) ? (bx % 8) * (G / 8) + bx / 8 : bx;
    unsigned char* ws = args.ws;
    unsigned* ctl = (unsigned*)(ws + WS_CTL);
    const float* x = args.in[0]; const float* norm_mix = args.in[1]; const float* w_in = args.in[2]; const float* conv_w = args.in[3];
    const float* q_norm = args.in[4]; const float* w_uq = args.in[5]; const float* kv_norm = args.in[6]; const float* w_ukv = args.in[7];
    const float* q_head_norm = args.in[8]; const float* k_head_norm = args.in[9]; const float* w_o = args.in[10]; const float* norm_ffn = args.in[11];
    const float* w_router = args.in[12]; const float* b_router = args.in[13]; const float* w_gate_up = args.in[14]; const float* b_gate_up = args.in[15];
    const float* w_down = args.in[16]; const float* b_down = args.in[17];
    float* out = args.out;
    f32x2* rope_t = (f32x2*)(ws + WS_ROPE);
    bf16_t* WrH = (bf16_t*)(ws + WS_WRH); bf16_t* WrL = (bf16_t*)(ws + WS_WRL);
    bf16_t* Win_t = (bf16_t*)(ws + WS_WIN); bf16_t* Wuq_t = (bf16_t*)(ws + WS_WUQ); bf16_t* Wukv_t = (bf16_t*)(ws + WS_WUKV); bf16_t* Wo_t = (bf16_t*)(ws + WS_WO);
    float* ssq = (float*)(ws + WS_SSQ); float* rs2 = (float*)(ws + WS_RS2); float* gate = (float*)(ws + WS_GATE); int* tos = (int*)(ws + WS_TOS);
    bf16_t* Wgu_t = (bf16_t*)(ws + WS_WGU); bf16_t* Wdn_t = (bf16_t*)(ws + WS_WDN);
    bf16_t* hb = (bf16_t*)(ws + WS_HB); bf16_t* qb_ = (bf16_t*)(ws + WS_Q); bf16_t* kb_ = (bf16_t*)(ws + WS_K); bf16_t* vb_ = (bf16_t*)(ws + WS_V); bf16_t* mix = (bf16_t*)(ws + WS_MIX);
    bf16_t* oslot = (bf16_t*)(ws + WS_OSLOT); bf16_t* hn = (bf16_t*)(ws + WS_HN); bf16_t* pbuf = (bf16_t*)(ws + WS_PB); bf16_t* qraw = (bf16_t*)(ws + WS_QRAW); bf16_t* kvraw = (bf16_t*)(ws + WS_KVRAW);
    bf16_t* act = (bf16_t*)(ws + WS_ACT);

    for (int u = tid; u < (LDS_BYTES - MISC_OFF) / 4; u += NWAVES * 64) ((LAS unsigned*)(lds + MISC_OFF))[u] = 0u;
    __syncthreads();
    XcdBarrier bar; bar.bar = ctl + CW_BAR; bar.x = 0; bar.st = nullptr;
    if (N_LAUNCHES == 1) bar = xcd_barrier_post(ctl + CW_BAR, MISC + 8);
#define GRID_BAR() do { if (N_LAUNCHES == 1) xcd_barrier(bar); } while (0)
    const int lo = args.ph_lo, hi = args.ph_hi;
#define IN(k) (((PHMASK >> (k)) & 1) && lo <= (k) && (k) < hi)
#define BOTH(k) (IN(k) && IN((k) + 1))
    const int gw = vcu * NWAVES + wave, NGW = G * NWAVES;

    if (IN(0)) {
        LAS float* scr = (LAS float*)(lds + wave * 16384);
        constexpr int I_IN = (DM / 64) * (NPROJ / 32), I_UQ = (QL / 64) * (768 / 32), I_UKV = (KVL / 64) * (1024 / 32), I_O = (DM / 64) * (DM / 32);
        constexpr int I_GU1 = (DM / 64) * (2 * DFF / 32), I_GU = NE * I_GU1, I_DN1 = (DFF / 64) * (DM / 32), I_DN = NE * I_DN1;
        constexpr int NITEMS = I_IN + I_UQ + I_UKV + I_O + I_GU + I_DN;
        for (int it = gw; it < NITEMS; it += NGW) {
            int r = it;
            if (r < I_GU) { const int e = r / I_GU1, q = r % I_GU1, nblk = 2 * DFF / 32, kb = q / nblk, nb = q % nblk, n0 = nb * 32, j = n0 & (DFF - 1), up = n0 >= DFF;
                p0_transpose_item(w_gate_up + (size_t)e * DM * 2 * DFF, DM, 2 * DFF, Wgu_t + (size_t)e * 2 * DFF * DM, (j >> 7) * 256 + (j & 127) + (up ? 128 : 0), norm_ffn, scr, kb * 64, n0, lane); continue; } r -= I_GU;
            if (r < I_DN) { const int e = r / I_DN1, q = r % I_DN1, nblk = DM / 32, kb = q / nblk, nb = q % nblk;
                p0_transpose_item(w_down + (size_t)e * DFF * DM, DFF, DM, Wdn_t + (size_t)e * DM * DFF, nb * 32, nullptr, scr, kb * 64, nb * 32, lane); continue; } r -= I_DN;
            if (r < I_IN) { const int nblk = NPROJ / 32, kb = r / nblk, nb = r % nblk; p0_transpose_item(w_in, DM, NPROJ, Win_t, nb * 32, nullptr, scr, kb * 64, nb * 32, lane); continue; } r -= I_IN;
            if (r < I_UQ) { const int nblk = 768 / 32, kb = r / nblk, nb = r % nblk; p0_transpose_item(w_uq, QL, 768, Wuq_t, nb * 32, q_norm, scr, kb * 64, nb * 32, lane); continue; } r -= I_UQ;
            if (r < I_UKV) { const int nblk = 1024 / 32, kb = r / nblk, nb = r % nblk; p0_transpose_item(w_ukv, KVL, 1024, Wukv_t, nb * 32, kv_norm, scr, kb * 64, nb * 32, lane); continue; } r -= I_UKV;
            { const int nblk = DM / 32, kb = r / nblk, nb = r % nblk; p0_transpose_item(w_o, DM, DM, Wo_t, nb * 32, nullptr, scr, kb * 64, nb * 32, lane); }
        }
        const int gt = vcu * (NWAVES * 64) + tid, NGT = G * NWAVES * 64;
        for (int i = gt; i < (NPP - NPROJ) * DM / 8; i += NGT) *(u32x4*)(Win_t + (size_t)NPROJ * DM + (size_t)i * 8) = (u32x4){0u, 0u, 0u, 0u};
        for (int i = gt; i < NE * DM; i += NGT) { const int e = i / DM, k = i % DM; const float v = w_router[(size_t)k * NE + e] * norm_ffn[k]; const unsigned h = f2bf(v); const float hf = __builtin_bit_cast(float, h << 16);
            WrH[i] = (bf16_t)h; WrL[i] = (bf16_t)f2bf(v - hf); }
        for (int i = gt; i < SEQ * 32; i += NGT) { const int pos = i >> 5, fi = i & 31; const float inv = exp2f(-(float)fi * (13.287712379549449f / 32.f)); const float ang = (float)pos * inv; float s, c; sincosf(ang, &s, &c); rope_t[i] = (f32x2){c, s}; }
        for (int m = gw; m < NTOK; m += NGW) {
            const f32x4* xr = (const f32x4*)(x + (size_t)m * DM) + lane; const f32x4* gr = (const f32x4*)norm_mix + lane;
            f32x4 v[4]; float s = 0.f;
#pragma unroll
            for (int j = 0; j < 4; ++j) { v[j] = xr[64 * j]; s += (v[j].x * v[j].x + v[j].y * v[j].y) + (v[j].z * v[j].z + v[j].w * v[j].w); }
            const float rstd = 1.0f / sqrtf(wave_sum(s) * (1.f / DM) + EPS);
            u32x2* o8 = (u32x2*)(hn + (size_t)m * DM) + lane;
#pragma unroll
            for (int j = 0; j < 4; ++j) { const f32x4 g = gr[64 * j]; u32x2 w; w.x = pk2(v[j].x * rstd * g.x, v[j].y * rstd * g.y); w.y = pk2(v[j].z * rstd * g.z, v[j].w * rstd * g.w); o8[64 * j] = w; }
        }
        if (BOTH(0)) GRID_BAR();
    }

    if (IN(1)) {
        pg8::DenseSched S; S.init(hn, DM, Win_t, NTOK, NPP, DM, G, bx);
        pg8::EpiBf16 E{pbuf, NPP};
        pg8::gemm_phase<pg8::EpiBf16, pg8::DenseSched, false>(lds, S, E);
        if (BOTH(1)) GRID_BAR();
    }

    if (IN(2)) {
        {
            const int gt = vcu * (NWAVES * 64) + tid, NGT = G * NWAVES * 64;
            for (int it = gt; it < (NTOK / 16) * 64; it += NGT) {
                const int run = it >> 6, gr = it & 63, t0 = run * 16, ch = gr * 8;
                float w0[8], w1[8], w2[8];
#pragma unroll
                for (int i = 0; i < 8; ++i) { w0[i] = conv_w[ch + i]; w1[i] = conv_w[CONVW + ch + i]; w2[i] = conv_w[2 * CONVW + ch + i]; }
                float um2[8], um1[8];
#pragma unroll
                for (int i = 0; i < 8; ++i) { um2[i] = 0.f; um1[i] = 0.f; }
                if ((t0 & (SEQ - 1)) != 0) {
                    float c8[8], x8[8];
                    unpack8(*(const u32x4*)(pbuf + (size_t)(t0 - 2) * NPP + PB_C + ch), c8); unpack8(*(const u32x4*)(pbuf + (size_t)(t0 - 2) * NPP + PB_X + ch), x8);
#pragma unroll
                    for (int i = 0; i < 8; ++i) um2[i] = c8[i] * x8[i];
                    unpack8(*(const u32x4*)(pbuf + (size_t)(t0 - 1) * NPP + PB_C + ch), c8); unpack8(*(const u32x4*)(pbuf + (size_t)(t0 - 1) * NPP + PB_X + ch), x8);
#pragma unroll
                    for (int i = 0; i < 8; ++i) um1[i] = c8[i] * x8[i];
                }
#pragma unroll 4
                for (int t = 0; t < 16; ++t) {
                    const bf16_t* pr = pbuf + (size_t)(t0 + t) * NPP + ch;
                    float b8[8], c8[8], x8[8], o8[8];
                    unpack8(*(const u32x4*)(pr + PB_B), b8); unpack8(*(const u32x4*)(pr + PB_C), c8); unpack8(*(const u32x4*)(pr + PB_X), x8);
#pragma unroll
                    for (int i = 0; i < 8; ++i) { const float uu = c8[i] * x8[i]; o8[i] = b8[i] * (w0[i] * um2[i] + w1[i] * um1[i] + w2[i] * uu); um2[i] = um1[i]; um1[i] = uu; }
                    *(u32x4*)(mix + (size_t)(t0 + t) * DM + ch) = pack8(o8);
                }
            }
        }
        { pg8::DenseSched S; S.init(pbuf + PB_CQ, NPP, Wuq_t, NTOK, 768, QL, G, bx); pg8::EpiBf16 E{qraw, 768};
          pg8::gemm_phase<pg8::EpiBf16, pg8::DenseSched, false>(lds, S, E); }
        { pg8::DenseSched S; S.init(pbuf + PB_CKV, NPP, Wukv_t, NTOK, 1024, KVL, G, G - 1 - bx); pg8::EpiBf16 E{kvraw, 1024};
          pg8::gemm_phase<pg8::EpiBf16, pg8::DenseSched, false>(lds, S, E); }
        if (BOTH(2)) GRID_BAR();
    }

    if (IN(3)) {
        const int li = lane & 31, hsel = lane >> 5; const bool actv = li < 24;
        for (int m = gw; m < NTOK; m += NGW) {
            const bf16_t* pb = pbuf + (size_t)m * NPP; const int pos = m & (SEQ - 1);
            float t8[8]; float sq = 0.f, skv = 0.f;
            if (lane < 48) { unpack8(*(const u32x4*)(pb + PB_CQ + lane * 8), t8);
#pragma unroll
                for (int i = 0; i < 8; ++i) sq += t8[i] * t8[i]; }
            if (lane < 32) { unpack8(*(const u32x4*)(pb + PB_CKV + lane * 8), t8);
#pragma unroll
                for (int i = 0; i < 8; ++i) skv += t8[i] * t8[i]; }
            const float rs_q = 1.0f / sqrtf(wave_sum(sq) * (1.f / QL) + EPS), rs_kv = 1.0f / sqrtf(wave_sum(skv) * (1.f / KVL) + EPS);
            f32x2 cs[8];
#pragma unroll
            for (int i = 0; i < 8; ++i) cs[i] = (actv && li >= 16) ? rope_t[pos * 32 + (li & 3) * 8 + i] : (f32x2){1.f, 0.f};
            const int partner = (li < 20) ? lane + 4 : lane - 4;
#pragma unroll
            for (int hp = 0; hp < 2; ++hp) {
                const int hh = 2 * hp + hsel;
                float v[8];
#pragma unroll
                for (int i = 0; i < 8; ++i) v[i] = 0.f;
                if (actv) { unpack8(*(const u32x4*)(qraw + (size_t)m * 768 + hh * QKH + li * 8), v);
#pragma unroll
                    for (int i = 0; i < 8; ++i) v[i] *= rs_q; }
                float ss = 0.f;
#pragma unroll
                for (int i = 0; i < 8; ++i) ss += v[i] * v[i];
                float r = 1.0f / sqrtf(half_sum(ss) * (1.f / QKH) + EPS);
                if (actv) {
#pragma unroll
                    for (int i = 0; i < 8; ++i) v[i] = v[i] * r * q_head_norm[li * 8 + i]; }
                float ot[8];
#pragma unroll
                for (int i = 0; i < 8; ++i) ot[i] = __shfl(v[i], partner);
                if (actv && li >= 16) {
                    if (li < 20) {
#pragma unroll
                        for (int i = 0; i < 8; ++i) v[i] = v[i] * cs[i].x - ot[i] * cs[i].y; }
                    else {
#pragma unroll
                        for (int i = 0; i < 8; ++i) v[i] = ot[i] * cs[i].y + v[i] * cs[i].x; }
                }
                if (actv) {
#pragma unroll
                    for (int i = 0; i < 8; ++i) v[i] *= QSCALE;
                    *(u32x4*)(qb_ + (size_t)m * 768 + hh * QKH + li * 8) = pack8(v); }
#pragma unroll
                for (int i = 0; i < 8; ++i) v[i] = 0.f;
                if (li < 16) { unpack8(*(const u32x4*)(kvraw + (size_t)m * 1024 + hh * 256 + li * 8), v);
#pragma unroll
                    for (int i = 0; i < 8; ++i) v[i] *= rs_kv; }
                else if (actv) unpack8(*(const u32x4*)(pb + PB_KPE + (li - 16) * 8), v);
                ss = 0.f;
#pragma unroll
                for (int i = 0; i < 8; ++i) ss += v[i] * v[i];
                r = 1.0f / sqrtf(half_sum(ss) * (1.f / QKH) + EPS);
                if (actv) {
#pragma unroll
                    for (int i = 0; i < 8; ++i) v[i] = v[i] * r * k_head_norm[li * 8 + i]; }
#pragma unroll
                for (int i = 0; i < 8; ++i) ot[i] = __shfl(v[i], partner);
                if (actv && li >= 16) {
                    if (li < 20) {
#pragma unroll
                        for (int i = 0; i < 8; ++i) v[i] = v[i] * cs[i].x - ot[i] * cs[i].y; }
                    else {
#pragma unroll
                        for (int i = 0; i < 8; ++i) v[i] = ot[i] * cs[i].y + v[i] * cs[i].x; }
                }
                if (actv) *(u32x4*)(kb_ + (size_t)m * 768 + hh * QKH + li * 8) = pack8(v);
                if (li < 16) { float vv[8]; unpack8(*(const u32x4*)(kvraw + (size_t)m * 1024 + hh * 256 + 128 + li * 8), vv);
#pragma unroll
                    for (int i = 0; i < 8; ++i) vv[i] *= rs_kv;
                    *(u32x4*)(vb_ + (size_t)m * 512 + hh * VH + li * 8) = pack8(vv); }
            }
        }
        if (BOTH(3)) GRID_BAR();
    }

    if (IN(4)) {
        for (int u = vcu; u < NB * NH * 4; u += G) {
            const int bh = u >> 2, pr = u & 3, b = bh >> 2, h = bh & 3;
            att::attn_unit(b, h, 7 - pr, qb_, kb_, vb_, mix + CONVW, lds);
            att::attn_unit(b, h, pr, qb_, kb_, vb_, mix + CONVW, lds);
        }
        if (BOTH(4)) GRID_BAR();
    }

    if (IN(5)) {
        pg8::DenseSched S; S.init(mix, DM, Wo_t, NTOK, DM, DM, G, bx);
        pg8::EpiOut E{x, out, hb, ssq};
        pg8::gemm_phase<pg8::EpiOut, pg8::DenseSched, false>(lds, S, E);
        if (BOTH(5)) GRID_BAR();
    }

    if (IN(6)) {
        LAS unsigned* hist = (LAS unsigned*)(lds + MISC_OFF) + 128; LAS unsigned* base = (LAS unsigned*)(lds + MISC_OFF) + 160;
        const int tj = lane & 15, q = lane >> 4;
        for (int tile = vcu; tile < NTOK / 128; tile += G) {
            if (tid < 32) hist[tid] = 0u;
            __syncthreads();
            const int token = tile * 128 + wave * 16 + tj;
            const float* hrow = out + (size_t)token * DM + q * 8;
            const bf16_t* wh0 = WrH + (size_t)tj * DM + q * 8; const bf16_t* wl0 = WrL + (size_t)tj * DM + q * 8;
            f32x4 a0 = {0.f, 0.f, 0.f, 0.f}, a1 = {0.f, 0.f, 0.f, 0.f};
#pragma unroll 4
            for (int ks = 0; ks < DM / 32; ++ks) {
                const f32x4 h0 = *(const f32x4*)(hrow + ks * 32), h1 = *(const f32x4*)(hrow + ks * 32 + 4);
                float hf[8] = {h0[0], h0[1], h0[2], h0[3], h1[0], h1[1], h1[2], h1[3]}; float lf[8];
                u32x4 hw; hw.x = pk2(hf[0], hf[1]); hw.y = pk2(hf[2], hf[3]); hw.z = pk2(hf[4], hf[5]); hw.w = pk2(hf[6], hf[7]);
                { float hb8[8]; unpack8(hw, hb8);
#pragma unroll
                  for (int i = 0; i < 8; ++i) lf[i] = hf[i] - hb8[i]; }
                const bf16x8 bh = __builtin_bit_cast(bf16x8, hw), bl = __builtin_bit_cast(bf16x8, pack8(lf));
                const bf16x8 wh_a = *(const bf16x8*)(wh0 + ks * 32), wh_b = *(const bf16x8*)(wh0 + 16 * DM + ks * 32);
                const bf16x8 wl_a = *(const bf16x8*)(wl0 + ks * 32), wl_b = *(const bf16x8*)(wl0 + 16 * DM + ks * 32);
                a0 = __builtin_amdgcn_mfma_f32_16x16x32_bf16(wh_a, bh, a0, 0, 0, 0); a0 = __builtin_amdgcn_mfma_f32_16x16x32_bf16(wl_a, bh, a0, 0, 0, 0); a0 = __builtin_amdgcn_mfma_f32_16x16x32_bf16(wh_a, bl, a0, 0, 0, 0);
                a1 = __builtin_amdgcn_mfma_f32_16x16x32_bf16(wh_b, bh, a1, 0, 0, 0); a1 = __builtin_amdgcn_mfma_f32_16x16x32_bf16(wl_b, bh, a1, 0, 0, 0); a1 = __builtin_amdgcn_mfma_f32_16x16x32_bf16(wh_b, bl, a1, 0, 0, 0);
            }
            float s2 = 0.f;
#pragma unroll
            for (int p = 0; p < 16; ++p) s2 += ssq[(size_t)p * NTOK + token];
            const float rs = 1.0f / sqrtf(s2 * (1.f / DM) + EPS);
            float lv[8]; int le[8];
#pragma unroll
            for (int i = 0; i < 4; ++i) { le[i] = 4 * q + i; le[4 + i] = 16 + 4 * q + i; lv[i] = a0[i] * rs + b_router[le[i]]; lv[4 + i] = a1[i] * rs + b_router[le[4 + i]]; }
            float tv[4]; int te[4];
#pragma unroll
            for (int k = 0; k < TOPK; ++k) {
                float bv = lv[0]; int be = le[0];
#pragma unroll
                for (int i = 1; i < 8; ++i) if (lv[i] > bv) { bv = lv[i]; be = le[i]; }
#pragma unroll
                for (int o = 16; o < 64; o <<= 1) { const float ov = __shfl_xor(bv, o); const int oe = __shfl_xor(be, o); if (ov > bv || (ov == bv && oe < be)) { bv = ov; be = oe; } }
                tv[k] = bv; te[k] = be;
#pragma unroll
                for (int i = 0; i < 8; ++i) if (le[i] == be) lv[i] = -3.0e38f;
            }
            float ge[4]; float gs = 0.f;
#pragma unroll
            for (int k = 0; k < TOPK; ++k) { ge[k] = __expf(tv[k] - tv[0]); gs += ge[k]; }
            const float ginv = 1.0f / gs;
            int my_e = te[0]; float my_g = ge[0];
#pragma unroll
            for (int k = 1; k < TOPK; ++k) if (q == k) { my_e = te[k]; my_g = ge[k]; }
            my_g *= ginv;
            const unsigned pl = atomicAdd((unsigned*)(hist + my_e), 1u);
            __syncthreads();
            if (tid < 32) base[tid] = __hip_atomic_fetch_add(ctl + CW_CNT + 64 * tid, hist[tid], __ATOMIC_RELAXED, __HIP_MEMORY_SCOPE_AGENT);
            __syncthreads();
            const unsigned pos = base[my_e] + pl; const int slot = token * 4 + q;
            tos[(size_t)my_e * CAP + pos] = slot; gate[slot] = my_g;
            if (q == 0) rs2[token] = rs;
            __syncthreads();
        }
        if (BOTH(6)) GRID_BAR();
    }

    LAS int* tab = (LAS int*)(lds + MISC_OFF) + 16;
    if (IN(7) || IN(8)) {
        if (tid < 32) { const int c = (int)__hip_atomic_load(ctl + CW_CNT + 64 * tid, __ATOMIC_RELAXED, __HIP_MEMORY_SCOPE_AGENT); tab[48 + tid] = c; }
        __syncthreads();
        if (tid == 0) { int s = 0; for (int e = 0; e < NE; ++e) { tab[e] = s; s += (tab[48 + e] + 255) >> 8; } tab[32] = s; }
        __syncthreads();
    }

    if (IN(7)) {
        pg8::MoeSched S{hb, Wgu_t, DM, DM, 2 * DFF / 256, G, bx, (size_t)2 * DFF * DM, tab, tos};
        pg8::EpiSwiglu E{act, b_gate_up, rs2, tos};
        pg8::gemm_phase<pg8::EpiSwiglu, pg8::MoeSched, true>(lds, S, E);
        if (BOTH(7)) GRID_BAR();
    }

    if (IN(8)) {
        pg8::MoeSched S{act, Wdn_t, DFF, DFF, DM / 256, G, bx, (size_t)DM * DFF, tab, tos};
        pg8::EpiDown E{oslot, b_down, gate, tos};
        pg8::gemm_phase<pg8::EpiDown, pg8::MoeSched, false>(lds, S, E);
        if (BOTH(8)) GRID_BAR();
    }

    if (IN(9)) {
        for (int m = gw; m < NTOK; m += NGW) {
            f32x4* orow = (f32x4*)(out + (size_t)m * DM) + lane;
            const u32x2* s0 = (const u32x2*)(oslot + (size_t)m * 4 * DM) + lane;
#pragma unroll
            for (int j = 0; j < 4; ++j) { f32x4 v = orow[64 * j];
#pragma unroll
                for (int k = 0; k < 4; ++k) { const u32x2 w = s0[(size_t)k * (DM / 4) + 64 * j]; v.x += bf_lo(w.x); v.y += bf_hi(w.x); v.z += bf_lo(w.y); v.w += bf_hi(w.y); }
                orow[64 * j] = v; }
        }
    }
#undef IN
#undef BOTH
#undef GRID_BAR
}

#ifdef DIAG_PHASES
template __global__ void fwd_kernel_t<1>(Args); template __global__ void fwd_kernel_t<2>(Args); template __global__ void fwd_kernel_t<4>(Args); template __global__ void fwd_kernel_t<8>(Args);
template __global__ void fwd_kernel_t<16>(Args); template __global__ void fwd_kernel_t<32>(Args); template __global__ void fwd_kernel_t<64>(Args); template __global__ void fwd_kernel_t<128>(Args);
template __global__ void fwd_kernel_t<256>(Args); template __global__ void fwd_kernel_t<512>(Args);
#endif
#define fwd_kernel fwd_kernel_t<1023>
extern "C" void kernel_launch(void* const* d_in, const int* in_sizes, int n_in, void* d_out, int out_size, void* d_ws, size_t ws_size, hipStream_t stream) {
    static int grid = 0;
    if (grid == 0) {
        if (n_in != 18 || in_sizes[0] != NTOK * DM || out_size != NTOK * DM || ws_size < WS_END) { fprintf(stderr, "kernel_launch: shape/workspace mismatch (n_in %d, in0 %d, out %d, ws %zu, need %zu)\n", n_in, n_in > 0 ? in_sizes[0] : -1, out_size, ws_size, (size_t)WS_END); grid = -1; return; }
        int dev = 0, cus = 0, per_cu = 0;
        if (hipGetDevice(&dev) != hipSuccess || hipDeviceGetAttribute(&cus, hipDeviceAttributeMultiprocessorCount, dev) != hipSuccess) { grid = -1; return; }
        if (hipFuncSetAttribute((const void*)fwd_kernel, hipFuncAttributeMaxDynamicSharedMemorySize, LDS_BYTES) != hipSuccess) { fprintf(stderr, "kernel_launch: hipFuncSetAttribute failed\n"); grid = -1; return; }
        if (hipOccupancyMaxActiveBlocksPerMultiprocessor(&per_cu, (const void*)fwd_kernel, NWAVES * 64, LDS_BYTES) != hipSuccess || per_cu < 1) { fprintf(stderr, "kernel_launch: occupancy query says %d\n", per_cu); }
        (void)hipGetLastError();
        grid = cus;
    }
    if (grid < 0) return;
    if (hipMemsetAsync((char*)d_ws + WS_CTL, 0, CTL_ZERO_BYTES, stream) != hipSuccess) return;
    Args a{};
    for (int i = 0; i < 18; ++i) a.in[i] = (const float*)d_in[i];
    a.out = (float*)d_out; a.ws = (unsigned char*)d_ws;
    if (N_LAUNCHES == 1) { a.ph_lo = 0; a.ph_hi = N_PHASES; hipLaunchKernelGGL(fwd_kernel, dim3(grid), dim3(NWAVES * 64), LDS_BYTES, stream, a); }
    else { for (int p = 0; p < N_PHASES; ++p) { a.ph_lo = p; a.ph_hi = p + 1; hipLaunchKernelGGL(fwd_kernel, dim3(grid), dim3(NWAVES * 64), LDS_BYTES, stream, a); } }
}
```

```cpp
#include <hip/hip_runtime.h>
#include <cstdio>
#include <cstdint>

#ifndef MK_N_LAUNCHES
#define MK_N_LAUNCHES 1
#endif

#ifndef PROBE_DOUBLE
#define PROBE_DOUBLE 0
#endif
#define LAS __attribute__((address_space(3)))
#define GAS __attribute__((address_space(1)))
typedef unsigned short bf16_t;
typedef short bf16x8 __attribute__((ext_vector_type(8)));
typedef short s16x4 __attribute__((ext_vector_type(4)));
typedef float f32x2 __attribute__((ext_vector_type(2)));
typedef float f32x4 __attribute__((ext_vector_type(4)));
typedef float f32x16 __attribute__((ext_vector_type(16)));
typedef unsigned u32x2 __attribute__((ext_vector_type(2)));
typedef unsigned u32x4 __attribute__((ext_vector_type(4)));
typedef int v4i16_dummy;

constexpr int NB = 16, SEQ = 2048, NTOK = NB * SEQ, DM = 1024;
constexpr int CONVW = 512, QL = 384, KVL = 256, ROPE = 64, NH = 4, QKN = 128, QKH = 192, VH = 128;
constexpr int NPROJ = 2240, NPP = 2304;
constexpr int PB_B = 0, PB_C = 512, PB_X = 1024, PB_CQ = 1536, PB_CKV = 1920, PB_KPE = 2176;
constexpr int NE = 32, TOPK = 4, DFF = 1024, NSLOT = NTOK * TOPK;
constexpr int CAP = NTOK;
constexpr int MAXTILES = NSLOT / 256 + NE;
constexpr float EPS = 1e-6f;
constexpr float QSCALE = 0.07216878364870322f * 1.4426950408889634f;
constexpr float SWI_LIMIT = 7.0f, SWI_ALPHA = 1.702f;

constexpr size_t MiB = 1u << 20;
constexpr size_t WS_CTL = 0, CTL_ZERO_BYTES = 1 * MiB;
constexpr size_t WS_ROPE = 1 * MiB;
constexpr size_t WS_WRH = 1 * MiB + 512 * 1024, WS_WRL = WS_WRH + 64 * 1024;
constexpr size_t WS_WIN = 2 * MiB;
constexpr size_t WS_WUQ = 8 * MiB, WS_WUKV = 9 * MiB, WS_WO = 10 * MiB;
constexpr size_t WS_SSQ = 12 * MiB;
constexpr size_t WS_RS2 = 14 * MiB, WS_GATE = 14 * MiB + 512 * 1024;
constexpr size_t WS_TOS = 16 * MiB;
constexpr size_t WS_WGU = 32 * MiB, WS_WDN = 160 * MiB;
constexpr size_t WS_HB = 224 * MiB;
constexpr size_t WS_Q = 288 * MiB, WS_K = 336 * MiB, WS_V = 384 * MiB, WS_MIX = 416 * MiB;
constexpr size_t WS_OSLOT = 288 * MiB;
constexpr size_t WS_HN = 544 * MiB, WS_PB = 608 * MiB, WS_QRAW = 752 * MiB, WS_KVRAW = 800 * MiB;
constexpr size_t WS_ACT = 544 * MiB;
constexpr size_t WS_END = 864 * MiB;
constexpr int CW_BAR = 4096;
constexpr int CW_CNT = 16384;

constexpr int RING_BYTES = 131072;
constexpr int MISC_OFF = RING_BYTES;
constexpr int LDS_BYTES = 147456;

__device__ __forceinline__ unsigned cvt_pk_bf16(float lo, float hi) { unsigned r; asm volatile("v_cvt_pk_bf16_f32 %0, %1, %2" : "=v"(r) : "v"(lo), "v"(hi)); return r; }
__device__ __forceinline__ unsigned f2bf(float f) { unsigned u = __builtin_bit_cast(unsigned, f); return (u + 0x7fffu + ((u >> 16) & 1u)) >> 16; }
__device__ __forceinline__ unsigned pk2(float lo, float hi) { return f2bf(lo) | (f2bf(hi) << 16); }
__device__ __forceinline__ float bf_lo(unsigned w) { return __builtin_bit_cast(float, w << 16); }
__device__ __forceinline__ float bf_hi(unsigned w) { return __builtin_bit_cast(float, w & 0xffff0000u); }
__device__ __forceinline__ void unpack8(const u32x4 w, float* f) { f[0] = bf_lo(w.x); f[1] = bf_hi(w.x); f[2] = bf_lo(w.y); f[3] = bf_hi(w.y); f[4] = bf_lo(w.z); f[5] = bf_hi(w.z); f[6] = bf_lo(w.w); f[7] = bf_hi(w.w); }
__device__ __forceinline__ u32x4 pack8(const float* f) { u32x4 w; w.x = cvt_pk_bf16(f[0], f[1]); w.y = cvt_pk_bf16(f[2], f[3]); w.z = cvt_pk_bf16(f[4], f[5]); w.w = cvt_pk_bf16(f[6], f[7]); return w; }
__device__ __forceinline__ float wave_sum(float v) {
#pragma unroll
    for (int o = 1; o < 64; o <<= 1) v += __shfl_xor(v, o);
    return v;
}
__device__ __forceinline__ float half_sum(float v) {
#pragma unroll
    for (int o = 1; o < 32; o <<= 1) v += __shfl_xor(v, o);
    return v;
}
#define LDS_WAIT() asm volatile("s_waitcnt lgkmcnt(0)" ::: "memory")
#define VM_WAIT() asm volatile("s_waitcnt vmcnt(0)" ::: "memory")

namespace pg8 {
constexpr int BM = 256, BK = 64, HALF = 128, HTB = HALF * BK * 2, STAGE_BYTES = 8 * HTB, NXCD = 8, WGM = 8;
__host__ __device__ __forceinline__ int lds_byte(int r, int c) { const int st = (r >> 4) * 2 + (c >> 5), rr = r & 15, cc = c & 31, ob = rr * 64 + cc * 2; return st * 1024 + (ob ^ (((ob >> 9) & 1) << 5)); }
__host__ __device__ __forceinline__ void stage_rc(int b, int& R, int& C) { const int st = b / 1024, sb = b % 1024, swz = sb ^ (((sb >> 9) & 1) << 5); R = (st >> 1) * 16 + swz / 64; C = (st & 1) * 32 + (swz % 64) / 2; }
__host__ __device__ __forceinline__ int perm32(int rho) { const int n = rho >> 4, i = rho & 15; return 8 * (i >> 2) + 4 * n + (i & 3); }

struct Unit { int pm, pn, e, p0, cnt; };

struct DenseSched {
    const bf16_t* A; const bf16_t* Bt; int lda, K, nM, nN, nwg, G, c;
    __device__ void init(const bf16_t* A_, int lda_, const bf16_t* Bt_, int M, int N, int K_, int G_, int c_) { A = A_; Bt = Bt_; lda = lda_; K = K_; nM = M / BM; nN = N / BM; nwg = nM * nN; G = G_; c = c_; }
    __device__ __forceinline__ bool next(int i, Unit& u) const {
        const long L = (long)i * G + c; if (L >= nwg) return false;
        int wgid = (int)L; { const int q = nwg / NXCD, r = nwg % NXCD, xcd = wgid % NXCD, off = wgid / NXCD; wgid = (xcd < r ? xcd * (q + 1) : r * (q + 1) + (xcd - r) * q) + off; }
        const int nig = WGM * nN, gid = wgid / nig, fm = gid * WGM, gsz = (nM - fm) < WGM ? (nM - fm) : WGM;
        u.pm = fm + ((wgid % nig) % gsz); u.pn = (wgid % nig) / gsz; u.e = 0; u.p0 = 0; u.cnt = 0; return true;
    }
    __device__ __forceinline__ const char* a_tile(const Unit& u) const { return (const char*)A + (size_t)u.pm * BM * lda * 2; }
    __device__ __forceinline__ const char* b_tile(const Unit& u) const { return (const char*)Bt + (size_t)u.pn * BM * K * 2; }
    __device__ __forceinline__ unsigned a_rowoff(const Unit&, int) const { return 0u; }
};
struct MoeSched {
    const bf16_t* A; const bf16_t* Bt; int lda, K, nN, G, c; size_t estride; const LAS int* tab; const int* tos;
    __device__ __forceinline__ bool next(int i, Unit& u) const {
        const int T = __builtin_amdgcn_readfirstlane(tab[32]), nwg = T * nN;
        const long L = (long)i * G + c; if (L >= nwg) return false;
        int wgid = (int)L; { const int q = nwg / NXCD, r = nwg % NXCD, xcd = wgid % NXCD, off = wgid / NXCD; wgid = (xcd < r ? xcd * (q + 1) : r * (q + 1) + (xcd - r) * q) + off; }
        const int nig = WGM * nN, gid = wgid / nig, fm = gid * WGM, gsz = (T - fm) < WGM ? (T - fm) : WGM;
        const int mt = fm + ((wgid % nig) % gsz); u.pm = mt; u.pn = (wgid % nig) / gsz;
        int e = 0; while (e < NE - 1 && __builtin_amdgcn_readfirstlane(tab[e + 1]) <= mt) ++e;
        u.e = e; u.p0 = (mt - __builtin_amdgcn_readfirstlane(tab[e])) * BM; u.cnt = __builtin_amdgcn_readfirstlane(tab[48 + e]); return true;
    }
    __device__ __forceinline__ const char* a_tile(const Unit& u) const { return (const char*)A + (size_t)u.pm * BM * lda * 2; }
    __device__ __forceinline__ const char* b_tile(const Unit& u) const { return (const char*)Bt + ((size_t)u.e * estride + (size_t)u.pn * BM * K) * 2; }
    __device__ __forceinline__ unsigned a_rowoff(const Unit& u, int r) const {
        const int p = u.p0 + r; int slot = 0; if (p < u.cnt) slot = tos[(size_t)u.e * CAP + p];
        return (unsigned)(slot >> 2) * (unsigned)(lda * 2);
    }
};

template <class Epi, class Sched, bool GATHER>
__device__ __forceinline__ void gemm_phase(LAS unsigned char* lds, const Sched& S, const Epi& E) {
    const int tid = threadIdx.x, wid = __builtin_amdgcn_readfirstlane(tid >> 6), lane = tid & 63, wr = wid >> 2, wc = wid & 3, fr = lane & 15, fq = lane >> 4;
    const int K = S.K, lda = S.lda, nt = K / BK;
    unsigned voffB[2], aoc[2][2]; int RA[2], CA[2];
    LAS u32x4* aon_l = (LAS u32x4*)(lds + STAGE_BYTES + 1024) + tid;
#pragma unroll
    for (int i = 0; i < 2; ++i) { int R, C; stage_rc(tid * 16 + i * 8192, R, C); const int Rb = (R & ~31) + perm32(R & 31);
        voffB[i] = (unsigned)(Rb * K + C) * 2u; RA[i] = R; CA[i] = C;
        aoc[0][i] = (unsigned)(R * lda + C) * 2u; aoc[1][i] = (unsigned)((R + HALF) * lda + C) * 2u; }
    const size_t kstep = (size_t)(BK * 2);
    const size_t hstepB = (size_t)HALF * K * 2;
    const unsigned ldsw = (unsigned)wid * 1024u;
    const int aoff = lds_byte(wr * 64 + fr, fq * 8), boff = lds_byte(wc * 32 + fr, fq * 8);
#define PG8_SA(b, h) (((b) * 2 + (h)) * HTB)
#define PG8_SB(b, h) ((4 + (b) * 2 + (h)) * HTB)
#define PG8_STAGE_B(bufoff, gbase) do { _Pragma("unroll") for (int _i = 0; _i < 2; ++_i) \
        __builtin_amdgcn_global_load_lds((const unsigned*)((const char*)(gbase) + voffB[_i]), (LAS unsigned*)(lds + (bufoff) + ldsw + _i * 8192), 16, 0, 0); } while (0)
#define PG8_STAGE_A(bufoff, gbase, h) do { _Pragma("unroll") for (int _i = 0; _i < 2; ++_i) \
        __builtin_amdgcn_global_load_lds((const unsigned*)((const char*)(gbase) + aoc[h][_i]), (LAS unsigned*)(lds + (bufoff) + ldsw + _i * 8192), 16, 0, 0); } while (0)
#define PG8_LDA(dst, b, h) do { _Pragma("unroll") for (int m = 0; m < 4; ++m) _Pragma("unroll") for (int k = 0; k < 2; ++k) dst[m][k] = *(const LAS bf16x8*)(lds + PG8_SA(b, h) + aoff + m * 2048 + k * 1024); } while (0)
#define PG8_LDB(dst, b, h) do { _Pragma("unroll") for (int n = 0; n < 2; ++n) _Pragma("unroll") for (int k = 0; k < 2; ++k) dst[n][k] = *(const LAS bf16x8*)(lds + PG8_SB(b, h) + boff + n * 2048 + k * 1024); } while (0)
#define PG8_MMA(ai, bj, At, Bt) do { __builtin_amdgcn_s_setprio(1); _Pragma("unroll") for (int m = 0; m < 4; ++m) _Pragma("unroll") for (int n = 0; n < 2; ++n) _Pragma("unroll") for (int k = 0; k < 2; ++k) \
        acc[ai][bj][m][n] = __builtin_amdgcn_mfma_f32_16x16x32_bf16(Bt[n][k], At[m][k], acc[ai][bj][m][n], 0, 0, 0); __builtin_amdgcn_s_setprio(0); } while (0)
#define PG8_WAIT_V(n) asm volatile("s_waitcnt vmcnt(" #n ")" ::: "memory")
#define PG8_WAIT_L(n) asm volatile("s_waitcnt lgkmcnt(" #n ")" ::: "memory")
#define PG8_BAR __builtin_amdgcn_s_barrier()
#define PG8_SCHED __builtin_amdgcn_sched_barrier(0)
    Unit cur, nxt; int ui = 0;
    if (!S.next(0, cur)) return;
    f32x4 acc[2][2][4][2];
#pragma unroll
    for (int a = 0; a < 2; ++a)
#pragma unroll
        for (int b = 0; b < 2; ++b)
#pragma unroll
            for (int m = 0; m < 4; ++m)
#pragma unroll
                for (int n = 0; n < 2; ++n) acc[a][b][m][n] = (f32x4){0.f, 0.f, 0.f, 0.f};
    bf16x8 At[4][2], B0[2][2], B1[2][2];
    const char* cA = GATHER ? (const char*)S.A : S.a_tile(cur); const char* cB = S.b_tile(cur);
    if constexpr (GATHER) {
#pragma unroll
        for (int h = 0; h < 2; ++h)
#pragma unroll
            for (int i = 0; i < 2; ++i) aoc[h][i] = S.a_rowoff(cur, h * HALF + RA[i]) + (unsigned)CA[i] * 2u;
    }
    PG8_STAGE_B(PG8_SB(0, 0), cB); PG8_STAGE_B(PG8_SB(0, 1), cB + hstepB); PG8_STAGE_A(PG8_SA(0, 0), cA, 0); PG8_STAGE_A(PG8_SA(0, 1), cA, 1);
    if (wr == 1) PG8_BAR;
    PG8_WAIT_V(2); PG8_BAR;
    PG8_STAGE_B(PG8_SB(1, 0), cB + kstep); PG8_STAGE_A(PG8_SA(1, 0), cA + kstep, 0); PG8_STAGE_B(PG8_SB(1, 1), cB + hstepB + kstep);
    PG8_WAIT_V(6); PG8_BAR;
    for (;;) {
        const bool has_next = S.next(ui + 1, nxt);
        const char* nA = GATHER ? cA : (has_next ? S.a_tile(nxt) : cA); const char* nB = has_next ? S.b_tile(nxt) : cB;
        if constexpr (GATHER) {
            u32x4 an = {aoc[0][0], aoc[0][1], aoc[1][0], aoc[1][1]};
            if (has_next) { an.x = S.a_rowoff(nxt, RA[0]) + (unsigned)CA[0] * 2u; an.y = S.a_rowoff(nxt, RA[1]) + (unsigned)CA[1] * 2u;
                            an.z = S.a_rowoff(nxt, HALF + RA[0]) + (unsigned)CA[0] * 2u; an.w = S.a_rowoff(nxt, HALF + RA[1]) + (unsigned)CA[1] * 2u; }
            *aon_l = an;
        }
        for (int t = 0; t < nt; t += 2) {
            const bool last = (t == nt - 2);
            const char* a1 = cA + (size_t)(t + 1) * kstep;
            const char* a2 = last ? nA : cA + (size_t)(t + 2) * kstep; const char* b2 = last ? nB : cB + (size_t)(t + 2) * kstep;
            const char* a3 = a2 + kstep; const char* b3 = b2 + kstep;
            PG8_LDB(B0, 0, 0); PG8_LDB(B1, 0, 1); PG8_SCHED; PG8_LDA(At, 0, 0); PG8_STAGE_A(PG8_SA(1, 1), a1, 1);
            PG8_WAIT_V(8); PG8_WAIT_L(0); PG8_BAR; PG8_MMA(0, 0, At, B0); PG8_MMA(0, 1, At, B1); PG8_BAR; PG8_SCHED;
            if constexpr (GATHER) { if (last) { const u32x4 an = *aon_l; aoc[0][0] = an.x; aoc[0][1] = an.y; aoc[1][0] = an.z; aoc[1][1] = an.w; } }
            PG8_LDA(At, 0, 1); PG8_STAGE_B(PG8_SB(0, 0), b2); PG8_STAGE_B(PG8_SB(0, 1), b2 + hstepB); PG8_STAGE_A(PG8_SA(0, 0), a2, 0);
            PG8_WAIT_V(8); PG8_WAIT_L(0); PG8_BAR; PG8_MMA(1, 0, At, B0); PG8_MMA(1, 1, At, B1); PG8_BAR; PG8_SCHED;
            PG8_LDB(B0, 1, 0); PG8_LDB(B1, 1, 1); PG8_SCHED; PG8_LDA(At, 1, 0); PG8_STAGE_A(PG8_SA(0, 1), a2, 1);
            PG8_WAIT_V(8); PG8_WAIT_L(0); PG8_BAR; PG8_MMA(0, 0, At, B0); PG8_MMA(0, 1, At, B1); PG8_BAR; PG8_SCHED;
            PG8_LDA(At, 1, 1); PG8_STAGE_B(PG8_SB(1, 0), b3); PG8_STAGE_B(PG8_SB(1, 1), b3 + hstepB); PG8_STAGE_A(PG8_SA(1, 0), a3, 0);
            PG8_WAIT_V(8); PG8_WAIT_L(0); PG8_BAR; PG8_MMA(1, 0, At, B0); PG8_MMA(1, 1, At, B1); PG8_BAR; PG8_SCHED;
        }
        if (wr == 0) PG8_BAR;
        E(acc, cur, wr, wc, fr, fq);
        if (!has_next) break;
#pragma unroll
        for (int a = 0; a < 2; ++a)
#pragma unroll
            for (int b = 0; b < 2; ++b)
#pragma unroll
                for (int m = 0; m < 4; ++m)
#pragma unroll
                    for (int n = 0; n < 2; ++n) acc[a][b][m][n] = (f32x4){0.f, 0.f, 0.f, 0.f};
        cur = nxt; cA = nA; cB = nB; ++ui;
        if (wr == 1) PG8_BAR;
    }
    PG8_WAIT_V(0);
    PG8_BAR;
#undef PG8_SA
#undef PG8_SB
#undef PG8_STAGE_A
#undef PG8_STAGE_B
#undef PG8_LDA
#undef PG8_LDB
#undef PG8_MMA
#undef PG8_WAIT_V
#undef PG8_WAIT_L
#undef PG8_BAR
#undef PG8_SCHED
}

struct EpiBf16 {
    bf16_t* O; int ldc;
    __device__ __forceinline__ void operator()(const f32x4 (&acc)[2][2][4][2], const Unit& u, int wr, int wc, int fr, int fq) const {
        asm volatile("" : "+v"(fr), "+v"(fq));
        const int row0 = u.pm * BM + wr * 64 + fr, col0 = u.pn * BM + wc * 32 + 8 * fq;
#pragma unroll
        for (int ai = 0; ai < 2; ++ai)
#pragma unroll
            for (int m = 0; m < 4; ++m) { bf16_t* rowp = O + (size_t)(row0 + ai * HALF + m * 16) * ldc + col0;
#pragma unroll
                for (int bj = 0; bj < 2; ++bj) { const f32x4 v0 = acc[ai][bj][m][0], v1 = acc[ai][bj][m][1];
                    u32x4 w; w.x = cvt_pk_bf16(v0[0], v0[1]); w.y = cvt_pk_bf16(v0[2], v0[3]); w.z = cvt_pk_bf16(v1[0], v1[1]); w.w = cvt_pk_bf16(v1[2], v1[3]);
                    *(u32x4*)(rowp + bj * HALF) = w; } }
    }
};
struct EpiOut {
    const float* x; float* out; bf16_t* hb; float* ssq;
    __device__ __forceinline__ void operator()(const f32x4 (&acc)[2][2][4][2], const Unit& u, int wr, int wc, int fr, int fq) const {
        asm volatile("" : "+v"(fr), "+v"(fq));
        const int row0 = u.pm * BM + wr * 64 + fr, col0 = u.pn * BM + wc * 32 + 8 * fq;
#pragma unroll
        for (int ai = 0; ai < 2; ++ai)
#pragma unroll
            for (int m = 0; m < 4; ++m) { const int row = row0 + ai * HALF + m * 16; const size_t off = (size_t)row * DM + col0; float ss = 0.f;
#pragma unroll
                for (int bj = 0; bj < 2; ++bj) { const f32x4 x0 = *(const f32x4*)(x + off + bj * HALF), x1 = *(const f32x4*)(x + off + bj * HALF + 4);
                    const f32x4 v0 = acc[ai][bj][m][0] + x0, v1 = acc[ai][bj][m][1] + x1;
                    *(f32x4*)(out + off + bj * HALF) = v0; *(f32x4*)(out + off + bj * HALF + 4) = v1;
                    u32x4 w; w.x = cvt_pk_bf16(v0[0], v0[1]); w.y = cvt_pk_bf16(v0[2], v0[3]); w.z = cvt_pk_bf16(v1[0], v1[1]); w.w = cvt_pk_bf16(v1[2], v1[3]);
                    *(u32x4*)(hb + off + bj * HALF) = w;
                    ss += (v0[0] * v0[0] + v0[1] * v0[1]) + (v0[2] * v0[2] + v0[3] * v0[3]) + (v1[0] * v1[0] + v1[1] * v1[1]) + (v1[2] * v1[2] + v1[3] * v1[3]); }
                ss += __shfl_xor(ss, 16); ss += __shfl_xor(ss, 32);
                if (fq == 0) ssq[(size_t)(u.pn * 4 + wc) * NTOK + row] = ss; }
    }
};
struct EpiSwiglu {
    bf16_t* act; const float* bgu; const float* rs2; const int* tos;
    __device__ __forceinline__ void operator()(const f32x4 (&acc)[2][2][4][2], const Unit& u, int wr, int wc, int fr, int fq) const {
        asm volatile("" : "+v"(fr), "+v"(fq));
        const int rt0 = wr * 64 + fr, j0 = wc * 32 + 8 * fq;
        const float* bg = bgu + (size_t)u.e * (2 * DFF) + u.pn * HALF + j0;
        const f32x4 bg0 = *(const f32x4*)bg, bg1 = *(const f32x4*)(bg + 4), bu0 = *(const f32x4*)(bg + DFF), bu1 = *(const f32x4*)(bg + DFF + 4);
#pragma unroll
        for (int ai = 0; ai < 2; ++ai)
#pragma unroll
            for (int m = 0; m < 4; ++m) { const int rt = rt0 + ai * HALF + m * 16, p = u.p0 + rt;
                int slot = 0; if (p < u.cnt) slot = tos[(size_t)u.e * CAP + p];
                const float rs = rs2[slot >> 2];
                float o[8];
#pragma unroll
                for (int n = 0; n < 2; ++n) { const f32x4 g4 = acc[ai][0][m][n] * rs + (n ? bg1 : bg0), u4 = acc[ai][1][m][n] * rs + (n ? bu1 : bu0);
#pragma unroll
                    for (int i = 0; i < 4; ++i) { const float g = fminf(g4[i], SWI_LIMIT), uu = fminf(fmaxf(u4[i], -SWI_LIMIT), SWI_LIMIT);
                        const float sg = __builtin_amdgcn_rcpf(1.f + __builtin_amdgcn_exp2f(g * (-SWI_ALPHA * 1.4426950408889634f)));
                        o[n * 4 + i] = (uu + 1.f) * (g * sg); } }
                *(u32x4*)(act + ((size_t)u.pm * BM + rt) * DFF + u.pn * HALF + j0) = pack8(o);
                asm volatile("" ::: "memory"); }
    }
};
struct EpiDown {
    bf16_t* oslot; const float* bdn; const float* gate; const int* tos;
    __device__ __forceinline__ void operator()(const f32x4 (&acc)[2][2][4][2], const Unit& u, int wr, int wc, int fr, int fq) const {
        asm volatile("" : "+v"(fr), "+v"(fq));
        const int rt0 = wr * 64 + fr, col0 = u.pn * BM + wc * 32 + 8 * fq;
        const float* bp = bdn + (size_t)u.e * DM + col0;
        f32x4 bv[2][2];
#pragma unroll
        for (int bj = 0; bj < 2; ++bj) { bv[bj][0] = *(const f32x4*)(bp + bj * HALF); bv[bj][1] = *(const f32x4*)(bp + bj * HALF + 4); }
#pragma unroll
        for (int ai = 0; ai < 2; ++ai)
#pragma unroll
            for (int m = 0; m < 4; ++m) { const int rt = rt0 + ai * HALF + m * 16, p = u.p0 + rt;
                if (p < u.cnt) { const int slot = tos[(size_t)u.e * CAP + p]; const float g = gate[slot];
#pragma unroll
                    for (int bj = 0; bj < 2; ++bj) { const f32x4 v0 = (acc[ai][bj][m][0] + bv[bj][0]) * g, v1 = (acc[ai][bj][m][1] + bv[bj][1]) * g;
                        u32x4 w; w.x = cvt_pk_bf16(v0[0], v0[1]); w.y = cvt_pk_bf16(v0[2], v0[3]); w.z = cvt_pk_bf16(v1[0], v1[1]); w.w = cvt_pk_bf16(v1[2], v1[3]);
                        *(u32x4*)(oslot + (size_t)slot * DM + col0 + bj * HALF) = w; } } }
    }
};
}

namespace att {
constexpr int LDQ = NH * QKH, LDK = NH * QKH, LDV = NH * VH, LDO = DM;
constexpr int KT_BYTES = 64 * QKH * 2, VT_BYTES = 64 * VH * 2;
constexpr int L_K = 0, L_V = 2 * KT_BYTES, L_WS = L_V + 2 * VT_BYTES, L_END = L_WS + 8 * 256;
constexpr float THRL = 8.f * 1.4426950408889634f;
__device__ __forceinline__ int crow(int r, int hi) { return (r & 3) + 8 * (r >> 2) + 4 * hi; }
#define SBAR() __builtin_amdgcn_sched_barrier(0)
__device__ __forceinline__ int v_rd_base(int lane) { return ((lane & 3) << 3) | (((lane >> 2) & 3) << 6) | (((lane >> 4) & 1) << 5) | (((lane >> 5) & 1) << 8); }
constexpr int v_rd_off(int d0, int ks, int half) { return d0 * 512 + ks * 4096 + half * 2048; }
template <int OFF> __device__ __forceinline__ s16x4 tr_read(int vb) {
    s16x4 r; asm volatile("ds_read_b64_tr_b16 %0, %1 offset:%2" : "=&v"(r) : "v"(vb), "i"(OFF) : "memory"); return r;
}
template <int D0> __device__ __forceinline__ void pv_one(f32x16& od, int vb, bf16x8 pa0, bf16x8 pa1, bf16x8 pa2, bf16x8 pa3) {
    const s16x4 l0 = tr_read<v_rd_off(D0, 0, 0)>(vb), h0 = tr_read<v_rd_off(D0, 0, 1)>(vb), l1 = tr_read<v_rd_off(D0, 1, 0)>(vb), h1 = tr_read<v_rd_off(D0, 1, 1)>(vb);
    const s16x4 l2 = tr_read<v_rd_off(D0, 2, 0)>(vb), h2 = tr_read<v_rd_off(D0, 2, 1)>(vb), l3 = tr_read<v_rd_off(D0, 3, 0)>(vb), h3 = tr_read<v_rd_off(D0, 3, 1)>(vb);
    asm volatile("s_waitcnt lgkmcnt(0)" ::: "memory"); SBAR();
#define PK(L, H) (bf16x8){L[0], L[1], L[2], L[3], H[0], H[1], H[2], H[3]}
    od = __builtin_amdgcn_mfma_f32_32x32x16_bf16(pa0, PK(l0, h0), od, 0, 0, 0);
    od = __builtin_amdgcn_mfma_f32_32x32x16_bf16(pa1, PK(l1, h1), od, 0, 0, 0);
    od = __builtin_amdgcn_mfma_f32_32x32x16_bf16(pa2, PK(l2, h2), od, 0, 0, 0);
    od = __builtin_amdgcn_mfma_f32_32x32x16_bf16(pa3, PK(l3, h3), od, 0, 0, 0);
#undef PK
}
__device__ __forceinline__ void glds16(const void* gsrc, LAS unsigned char* dst) {
    __builtin_amdgcn_global_load_lds((const unsigned*)gsrc, (LAS unsigned*)dst, 16, 0, 0);
}
__device__ __forceinline__ void attn_unit(int b, int h, int qb, const bf16_t* Q, const bf16_t* Kg, const bf16_t* Vg, bf16_t* O, LAS unsigned char* lds) {
    const int tid = threadIdx.x, wid = __builtin_amdgcn_readfirstlane(tid >> 6), lane = tid & 63, r32 = lane & 31, hi = lane >> 5;
    const size_t tok0 = (size_t)b * SEQ;
    bf16x8 qr[12];
    { const bf16_t* Qw = Q + (tok0 + (size_t)qb * 256 + wid * 32 + r32) * LDQ + h * QKH + hi * 8;
#pragma unroll
      for (int d0 = 0; d0 < 12; ++d0) qr[d0] = *(const bf16x8*)(Qw + d0 * 16); }
    unsigned koff[3], voff[2];
#pragma unroll
    for (int i = 0; i < 3; ++i) { const int G = 64 * (wid + 8 * i) + lane, row = G / 24, cgs = G % 24, cg = (cgs & ~7) | ((cgs & 7) ^ ((row >> 1) & 7)); koff[i] = (unsigned)(row * LDK * 2 + cg * 16); }
#pragma unroll
    for (int i = 0; i < 2; ++i) { const int p = wid + 8 * i, sub = 2 * p + (lane >> 5), kkh = sub >> 2, cblk = sub & 3, kkl = (lane & 31) >> 2, cl = (lane & 3) * 8, kk = kkh * 8 + kkl;
        const int k = (kk & ~0xC) | ((kk & 4) << 1) | ((kk & 8) >> 1), c = cblk * 32 + cl; voff[i] = (unsigned)(k * LDV * 2 + c * 2); }
    const char* Kh = (const char*)(Kg + tok0 * LDK + h * QKH); const char* Vh = (const char*)(Vg + tok0 * LDV + h * VH);
#define ATT_DMA(j, buf) do { const char* kp_ = Kh + (size_t)(j) * 64 * LDK * 2; const char* vp_ = Vh + (size_t)(j) * 64 * LDV * 2; \
        _Pragma("unroll") for (int i_ = 0; i_ < 3; ++i_) glds16(kp_ + koff[i_], lds + L_K + (buf) * KT_BYTES + (wid + 8 * i_) * 1024); \
        _Pragma("unroll") for (int i_ = 0; i_ < 2; ++i_) glds16(vp_ + voff[i_], lds + L_V + (buf) * VT_BYTES + (wid + 8 * i_) * 1024); } while (0)
    const int swz = (r32 >> 1) & 7; int kx[4];
#pragma unroll
    for (int dd = 0; dd < 4; ++dd) kx[dd] = r32 * (QKH * 2) + (((2 * dd + hi) ^ swz) << 4);
    LAS float* ws = (LAS float*)(lds + L_WS) + wid * 64; LAS float* li_l = ws; LAS float* al_l = ws + 32;
    const int vb0 = L_V + v_rd_base(lane);
    float m_reg = -1e30f, l_reg = 0.f; f32x16 o[4];
#pragma unroll
    for (int d = 0; d < 4; ++d)
#pragma unroll
        for (int r = 0; r < 16; ++r) o[d][r] = 0.f;
    const int NT = 4 * qb + 4, my_last = 4 * qb + (wid >> 1);
    ATT_DMA(0, 0);
    for (int j = 0; j < NT; ++j) {
        const int buf = j & 1;
        asm volatile("s_waitcnt vmcnt(0)" ::: "memory"); __builtin_amdgcn_s_barrier(); asm volatile("" ::: "memory");
        if (j + 1 < NT) ATT_DMA(j + 1, buf ^ 1);
        if (j <= my_last) {
            const LAS unsigned char* Ks = lds + L_K + buf * KT_BYTES;
            f32x16 p0, p1;
#pragma unroll
            for (int r = 0; r < 16; ++r) { p0[r] = 0.f; p1[r] = 0.f; }
#pragma unroll
            for (int d0 = 0; d0 < 12; ++d0) {
                const bf16x8 b0 = *(const LAS bf16x8*)(Ks + kx[d0 & 3] + (d0 >> 2) * 128);
                const bf16x8 b1 = *(const LAS bf16x8*)(Ks + kx[d0 & 3] + (d0 >> 2) * 128 + 32 * QKH * 2);
                p0 = __builtin_amdgcn_mfma_f32_32x32x16_bf16(b0, qr[d0], p0, 0, 0, 0);
                p1 = __builtin_amdgcn_mfma_f32_32x32x16_bf16(b1, qr[d0], p1, 0, 0, 0);
            }
            float pmax = p0[0];
#pragma unroll
            for (int r = 1; r < 16; ++r) pmax = fmaxf(pmax, p0[r]);
#pragma unroll
            for (int r = 0; r < 16; ++r) pmax = fmaxf(pmax, p1[r]);
            { auto rr = __builtin_amdgcn_permlane32_swap(__float_as_uint(pmax), __float_as_uint(pmax), false, false);
              pmax = fmaxf(__uint_as_float(rr[0]), __uint_as_float(rr[1])); }
            float mn, alpha;
            if (__builtin_expect(__all(pmax - m_reg <= THRL), 1)) { mn = m_reg; alpha = 1.f; }
            else { mn = fmaxf(m_reg, pmax); alpha = __builtin_amdgcn_exp2f(m_reg - mn); m_reg = mn; }
#pragma unroll
            for (int r = 0; r < 16; ++r) { p0[r] = __builtin_amdgcn_exp2f(p0[r] - mn); p1[r] = __builtin_amdgcn_exp2f(p1[r] - mn); }
            float ps = 0.f;
#pragma unroll
            for (int r = 0; r < 16; ++r) ps += p0[r];
#pragma unroll
            for (int r = 0; r < 16; ++r) ps += p1[r];
            { auto rr = __builtin_amdgcn_permlane32_swap(__float_as_uint(ps), __float_as_uint(ps), false, false);
              ps = __uint_as_float(rr[0]) + __uint_as_float(rr[1]); }
            l_reg = l_reg * alpha + ps;
            if (__any(alpha < 1.f)) { if (hi == 0) al_l[r32] = alpha; asm volatile("s_waitcnt lgkmcnt(0)" ::: "memory");
#pragma unroll
                for (int r = 0; r < 16; ++r) { const float a = al_l[crow(r, hi)];
#pragma unroll
                    for (int d = 0; d < 4; ++d) o[d][r] *= a; } }
            bf16x8 pa0, pa1, pa2, pa3;
#define PK4(P, BASE, OUT) do { unsigned a0 = cvt_pk_bf16(P[BASE + 0], P[BASE + 1]), a1 = cvt_pk_bf16(P[BASE + 2], P[BASE + 3]);   \
    unsigned b0_ = cvt_pk_bf16(P[BASE + 4], P[BASE + 5]), b1_ = cvt_pk_bf16(P[BASE + 6], P[BASE + 7]);                              \
    auto r0 = __builtin_amdgcn_permlane32_swap(a0, b0_, false, false); auto r1 = __builtin_amdgcn_permlane32_swap(a1, b1_, false, false); \
    u32x4 w = {r0[0], r1[0], r0[1], r1[1]}; OUT = __builtin_bit_cast(bf16x8, w); } while (0)
            PK4(p0, 0, pa0); PK4(p0, 8, pa1); PK4(p1, 0, pa2); PK4(p1, 8, pa3);
#undef PK4
            const int vb = vb0 + buf * VT_BYTES;
            pv_one<0>(o[0], vb, pa0, pa1, pa2, pa3); pv_one<1>(o[1], vb, pa0, pa1, pa2, pa3); pv_one<2>(o[2], vb, pa0, pa1, pa2, pa3); pv_one<3>(o[3], vb, pa0, pa1, pa2, pa3);
        }
    }
    if (hi == 0) li_l[r32] = l_reg; asm volatile("s_waitcnt lgkmcnt(0)" ::: "memory");
    bf16_t* Ow = O + (tok0 + (size_t)qb * 256 + wid * 32) * LDO + h * VH;
#pragma unroll
    for (int r = 0; r < 16; ++r) { const int orow = crow(r, hi); const float rl = __builtin_amdgcn_rcpf(li_l[orow]);
#pragma unroll
        for (int d0 = 0; d0 < 4; ++d0) Ow[(size_t)orow * LDO + d0 * 32 + r32] = (bf16_t)f2bf(o[d0][r] * rl); }
    asm volatile("s_waitcnt lgkmcnt(0)" ::: "memory"); __builtin_amdgcn_s_barrier(); asm volatile("" ::: "memory");
#undef ATT_DMA
}
#undef SBAR
}

#define XB_TMO      128
#define XB_XCNT(j)  (256  + 64 * (j))
#define XB_XSUB(j)  (1280 + 64 * (j))
#define XB_XGEN(j)  (2304 + 64 * (j))
#define XB_TOP      3328
#define XB_TOPGEN   3392
#define XCD_BAR_WORDS 3456
#define XB_SPIN_CAP (1u << 18)
__device__ __forceinline__ unsigned xb_ld(unsigned* p)              { return __hip_atomic_load(p, __ATOMIC_RELAXED, __HIP_MEMORY_SCOPE_AGENT); }
__device__ __forceinline__ unsigned xb_add(unsigned* p, unsigned v) { return __hip_atomic_fetch_add(p, v, __ATOMIC_RELAXED, __HIP_MEMORY_SCOPE_AGENT); }
__device__ __forceinline__ unsigned xb_xcc_id() { return (unsigned)__builtin_amdgcn_s_getreg((3 << 11) | 20) & 0xFu; }
#define XB_SPIN(cond, bar) do { unsigned _sp = 0; while (cond) { __builtin_amdgcn_s_sleep(1); \
    if ((++_sp & 255u) == 0u) { if (xb_ld(&(bar)[XB_TMO])) break; if (_sp > XB_SPIN_CAP) { atomicAdd(&(bar)[XB_TMO], 1u); break; } } } } while (0)
struct XcdBarrier { unsigned* bar; unsigned x; volatile LAS unsigned* st; };
__device__ __forceinline__ XcdBarrier xcd_barrier_post(unsigned* bar, volatile LAS unsigned* st) {
    XcdBarrier b; b.bar = bar; b.x = xb_xcc_id(); b.st = st;
    if (threadIdx.x == 0) (void)xb_add(&bar[XB_XCNT(b.x)], 1u);
    return b;
}
__device__ __forceinline__ void xcd_barrier_complete(unsigned* bar, unsigned x, unsigned& nloc, unsigned& nx) {
    const unsigned G = gridDim.x * gridDim.y * gridDim.z;
    unsigned sum, cnt, mine, sp = 0u;
    for (;;) {
        sum = 0u; cnt = 0u; mine = 0u;
#pragma unroll
        for (unsigned j = 0; j < 16; ++j) { const unsigned c = xb_ld(&bar[XB_XCNT(j)]); sum += c; cnt += (c > 0u) ? 1u : 0u; mine = (j == x) ? c : mine; }
        if (sum == G) break;
        __builtin_amdgcn_s_sleep(1);
        if ((++sp & 255u) == 0u) { if (xb_ld(&bar[XB_TMO])) break; if (sp > XB_SPIN_CAP) { atomicAdd(&bar[XB_TMO], 1u); break; } }
    }
    nloc = mine > 0u ? mine : 1u; nx = cnt > 0u ? cnt : 1u;
}
__device__ __forceinline__ void xcd_barrier(const XcdBarrier& b) {
    asm volatile("s_waitcnt vmcnt(0)" ::: "memory");
    __syncthreads();
    if (threadIdx.x == 0) {
        unsigned* bar = b.bar;
        __builtin_amdgcn_s_waitcnt(0);
        unsigned nloc = b.st[0], nx = b.st[1];
        if (nloc == 0u) { xcd_barrier_complete(bar, b.x, nloc, nx); b.st[0] = nloc; b.st[1] = nx; }
        const unsigned old = xb_add(&bar[XB_XSUB(b.x)], 1u);
        const unsigned gen = old / nloc;
        if (old + 1u == (gen + 1u) * nloc) {
            __builtin_amdgcn_fence(__ATOMIC_RELEASE, "agent");
            asm volatile("s_waitcnt vmcnt(0)" ::: "memory");
            const unsigned og = xb_add(&bar[XB_TOP], 1u);
            const unsigned tg = og / nx;
            if (og + 1u == (tg + 1u) * nx) xb_add(&bar[XB_TOPGEN], 1u);
            else XB_SPIN(xb_ld(&bar[XB_TOPGEN]) == tg, bar);
            __builtin_amdgcn_fence(__ATOMIC_ACQUIRE, "agent");
            xb_add(&bar[XB_XGEN(b.x)], 1u);
            asm volatile("s_waitcnt vmcnt(0)" ::: "memory");
        } else {
            XB_SPIN(xb_ld(&bar[XB_XGEN(b.x)]) == gen, bar);
            __builtin_amdgcn_fence(__ATOMIC_ACQUIRE, "agent");
            asm volatile("s_waitcnt vmcnt(0)" ::: "memory");
        }
    }
    __syncthreads();
}

constexpr int NWAVES = 8;
constexpr int N_LAUNCHES = MK_N_LAUNCHES;
constexpr int N_PHASES = 10;
struct Args { const float* in[18]; float* out; unsigned char* ws; int ph_lo, ph_hi; };

__device__ __forceinline__ void p0_transpose_item(const float* W, int K, int N, bf16_t* WT, int drow0, const float* kscale, LAS unsigned* scr, int k0, int n0, int lane) {
    const int g = lane >> 4, l16 = lane & 15;
    f32x4 v[16];
#pragma unroll
    for (int i = 0; i < 16; ++i) { const int kk = (i >> 1) * 8 + g * 2 + (i & 1); v[i] = *(const f32x4*)(W + (size_t)(k0 + kk) * N + n0 + 4 * l16); }
    if (kscale) {
#pragma unroll
        for (int i = 0; i < 16; ++i) { const int kk = (i >> 1) * 8 + g * 2 + (i & 1); v[i] = v[i] * kscale[k0 + kk]; } }
#pragma unroll
    for (int j = 0; j < 8; ++j) { const int kp = j * 4 + g;
#pragma unroll
        for (int c = 0; c < 4; ++c) scr[(4 * l16 + c) * 33 + kp] = cvt_pk_bf16(v[2 * j][c], v[2 * j + 1][c]); }
    LDS_WAIT(); asm volatile("" ::: "memory");
    const int c8 = lane & 7;
#pragma unroll
    for (int jj = 0; jj < 8; ++jj) { const int n = jj * 8 + (lane >> 3); const LAS unsigned* t = scr + n * 33 + 4 * c8;
        u32x4 o; o.x = t[0]; o.y = t[1]; o.z = t[2]; o.w = t[3];
        *(u32x4*)(WT + (size_t)(drow0 + n) * K + k0 + 8 * c8) = o; }
    LDS_WAIT(); asm volatile("" ::: "memory");
}

template <int PHMASK> __global__ void __launch_bounds__(NWAVES * 64, 2) fwd_kernel_t(Args args) {
    extern __shared__ __attribute__((aligned(16))) unsigned char lds_raw[];
    LAS unsigned char* lds = (LAS unsigned char*)lds_raw;
    volatile LAS unsigned* MISC = (volatile LAS unsigned*)(lds + MISC_OFF);
    const int tid = threadIdx.x, lane = tid & 63, wave = __builtin_amdgcn_readfirstlane(tid >> 6);
    const int G = gridDim.x; const int bx = blockIdx.x; const int vcu = (G % 8 == 0) ? (bx % 8) * (G / 8) + bx / 8 : bx;
    unsigned char* ws = args.ws;
    unsigned* ctl = (unsigned*)(ws + WS_CTL);
    const float* x = args.in[0]; const float* norm_mix = args.in[1]; const float* w_in = args.in[2]; const float* conv_w = args.in[3];
    const float* q_norm = args.in[4]; const float* w_uq = args.in[5]; const float* kv_norm = args.in[6]; const float* w_ukv = args.in[7];
    const float* q_head_norm = args.in[8]; const float* k_head_norm = args.in[9]; const float* w_o = args.in[10]; const float* norm_ffn = args.in[11];
    const float* w_router = args.in[12]; const float* b_router = args.in[13]; const float* w_gate_up = args.in[14]; const float* b_gate_up = args.in[15];
    const float* w_down = args.in[16]; const float* b_down = args.in[17];
    float* out = args.out;
    f32x2* rope_t = (f32x2*)(ws + WS_ROPE);
    bf16_t* WrH = (bf16_t*)(ws + WS_WRH); bf16_t* WrL = (bf16_t*)(ws + WS_WRL);
    bf16_t* Win_t = (bf16_t*)(ws + WS_WIN); bf16_t* Wuq_t = (bf16_t*)(ws + WS_WUQ); bf16_t* Wukv_t = (bf16_t*)(ws + WS_WUKV); bf16_t* Wo_t = (bf16_t*)(ws + WS_WO);
    float* ssq = (float*)(ws + WS_SSQ); float* rs2 = (float*)(ws + WS_RS2); float* gate = (float*)(ws + WS_GATE); int* tos = (int*)(ws + WS_TOS);
    bf16_t* Wgu_t = (bf16_t*)(ws + WS_WGU); bf16_t* Wdn_t = (bf16_t*)(ws + WS_WDN);
    bf16_t* hb = (bf16_t*)(ws + WS_HB); bf16_t* qb_ = (bf16_t*)(ws + WS_Q); bf16_t* kb_ = (bf16_t*)(ws + WS_K); bf16_t* vb_ = (bf16_t*)(ws + WS_V); bf16_t* mix = (bf16_t*)(ws + WS_MIX);
    bf16_t* oslot = (bf16_t*)(ws + WS_OSLOT); bf16_t* hn = (bf16_t*)(ws + WS_HN); bf16_t* pbuf = (bf16_t*)(ws + WS_PB); bf16_t* qraw = (bf16_t*)(ws + WS_QRAW); bf16_t* kvraw = (bf16_t*)(ws + WS_KVRAW);
    bf16_t* act = (bf16_t*)(ws + WS_ACT);

    for (int u = tid; u < (LDS_BYTES - MISC_OFF) / 4; u += NWAVES * 64) ((LAS unsigned*)(lds + MISC_OFF))[u] = 0u;
    __syncthreads();
    XcdBarrier bar; bar.bar = ctl + CW_BAR; bar.x = 0; bar.st = nullptr;
    if (N_LAUNCHES == 1) bar = xcd_barrier_post(ctl + CW_BAR, MISC + 8);
#define GRID_BAR() do { if (N_LAUNCHES == 1) xcd_barrier(bar); } while (0)
    const int lo = args.ph_lo, hi = args.ph_hi;
#define IN(k) (((PHMASK >> (k)) & 1) && lo <= (k) && (k) < hi)
#define BOTH(k) (IN(k) && IN((k) + 1))
    const int gw = vcu * NWAVES + wave, NGW = G * NWAVES;

    if (IN(0)) {
        LAS unsigned* scr = (LAS unsigned*)(lds + wave * 16384);
        constexpr int I_IN = (DM / 64) * (NPROJ / 64), I_UQ = (QL / 64) * (768 / 64), I_UKV = (KVL / 64) * (1024 / 64), I_O = (DM / 64) * (DM / 64);
        constexpr int I_GU1 = (DM / 64) * (2 * DFF / 64), I_GU = NE * I_GU1, I_DN1 = (DFF / 64) * (DM / 64), I_DN = NE * I_DN1;
        constexpr int NITEMS = I_IN + I_UQ + I_UKV + I_O + I_GU + I_DN;
        for (int it = gw; it < NITEMS; it += NGW) {
            int r = it;
            if (r < I_GU) { const int e = r / I_GU1, q = r % I_GU1, nblk = 2 * DFF / 64, kb = q / nblk, nb = q % nblk, n0 = nb * 64, j = n0 & (DFF - 1), up = n0 >= DFF;
                p0_transpose_item(w_gate_up + (size_t)e * DM * 2 * DFF, DM, 2 * DFF, Wgu_t + (size_t)e * 2 * DFF * DM, (j >> 7) * 256 + (j & 127) + (up ? 128 : 0), norm_ffn, scr, kb * 64, n0, lane); continue; } r -= I_GU;
            if (r < I_DN) { const int e = r / I_DN1, q = r % I_DN1, nblk = DM / 64, kb = q / nblk, nb = q % nblk;
                p0_transpose_item(w_down + (size_t)e * DFF * DM, DFF, DM, Wdn_t + (size_t)e * DM * DFF, nb * 64, nullptr, scr, kb * 64, nb * 64, lane); continue; } r -= I_DN;
            if (r < I_IN) { const int nblk = NPROJ / 64, kb = r / nblk, nb = r % nblk; p0_transpose_item(w_in, DM, NPROJ, Win_t, nb * 64, nullptr, scr, kb * 64, nb * 64, lane); continue; } r -= I_IN;
            if (r < I_UQ) { const int nblk = 768 / 64, kb = r / nblk, nb = r % nblk; p0_transpose_item(w_uq, QL, 768, Wuq_t, nb * 64, q_norm, scr, kb * 64, nb * 64, lane); continue; } r -= I_UQ;
            if (r < I_UKV) { const int nblk = 1024 / 64, kb = r / nblk, nb = r % nblk; p0_transpose_item(w_ukv, KVL, 1024, Wukv_t, nb * 64, kv_norm, scr, kb * 64, nb * 64, lane); continue; } r -= I_UKV;
            { const int nblk = DM / 64, kb = r / nblk, nb = r % nblk; p0_transpose_item(w_o, DM, DM, Wo_t, nb * 64, nullptr, scr, kb * 64, nb * 64, lane); }
        }
        const int gt = vcu * (NWAVES * 64) + tid, NGT = G * NWAVES * 64;
        for (int i = gt; i < (NPP - NPROJ) * DM / 8; i += NGT) *(u32x4*)(Win_t + (size_t)NPROJ * DM + (size_t)i * 8) = (u32x4){0u, 0u, 0u, 0u};
        for (int i = gt; i < NE * DM; i += NGT) { const int e = i / DM, k = i % DM; const float v = w_router[(size_t)k * NE + e] * norm_ffn[k]; const unsigned h = f2bf(v); const float hf = __builtin_bit_cast(float, h << 16);
            WrH[i] = (bf16_t)h; WrL[i] = (bf16_t)f2bf(v - hf); }
        for (int i = gt; i < SEQ * 32; i += NGT) { const int pos = i >> 5, fi = i & 31; const float inv = exp2f(-(float)fi * (13.287712379549449f / 32.f)); const float ang = (float)pos * inv; float s, c; sincosf(ang, &s, &c); rope_t[i] = (f32x2){c, s}; }
        for (int m = 2 * gw; m < NTOK; m += 2 * NGW) {
            const f32x4* xr = (const f32x4*)(x + (size_t)m * DM) + lane; const f32x4* gr = (const f32x4*)norm_mix + lane;
            f32x4 v[2][4]; float s0 = 0.f, s1 = 0.f;
#pragma unroll
            for (int j = 0; j < 4; ++j) { v[0][j] = xr[64 * j]; v[1][j] = xr[DM / 4 + 64 * j]; }
#pragma unroll
            for (int j = 0; j < 4; ++j) { s0 += (v[0][j].x * v[0][j].x + v[0][j].y * v[0][j].y) + (v[0][j].z * v[0][j].z + v[0][j].w * v[0][j].w);
                                          s1 += (v[1][j].x * v[1][j].x + v[1][j].y * v[1][j].y) + (v[1][j].z * v[1][j].z + v[1][j].w * v[1][j].w); }
            const float r0 = 1.0f / sqrtf(wave_sum(s0) * (1.f / DM) + EPS), r1 = 1.0f / sqrtf(wave_sum(s1) * (1.f / DM) + EPS);
            u32x2* o8 = (u32x2*)(hn + (size_t)m * DM) + lane;
#pragma unroll
            for (int j = 0; j < 4; ++j) { const f32x4 g = gr[64 * j]; u32x2 w;
                w.x = cvt_pk_bf16(v[0][j].x * r0 * g.x, v[0][j].y * r0 * g.y); w.y = cvt_pk_bf16(v[0][j].z * r0 * g.z, v[0][j].w * r0 * g.w); o8[64 * j] = w;
                w.x = cvt_pk_bf16(v[1][j].x * r1 * g.x, v[1][j].y * r1 * g.y); w.y = cvt_pk_bf16(v[1][j].z * r1 * g.z, v[1][j].w * r1 * g.w); o8[DM / 4 + 64 * j] = w; }
        }
        if (BOTH(0)) GRID_BAR();
    }

    if (IN(1)) {
        pg8::DenseSched S; S.init(hn, DM, Win_t, NTOK, NPP, DM, G, bx);
        pg8::EpiBf16 E{pbuf, NPP};
        pg8::gemm_phase<pg8::EpiBf16, pg8::DenseSched, false>(lds, S, E);
        if (BOTH(1)) GRID_BAR();
    }

    if (IN(2)) {
        {
            const int gt = vcu * (NWAVES * 64) + tid, NGT = G * NWAVES * 64;
            for (int it = gt; it < (NTOK / 16) * 64; it += NGT) {
                const int run = it >> 6, gr = it & 63, t0 = run * 16, ch = gr * 8;
                float w0[8], w1[8], w2[8];
#pragma unroll
                for (int i = 0; i < 8; ++i) { w0[i] = conv_w[ch + i]; w1[i] = conv_w[CONVW + ch + i]; w2[i] = conv_w[2 * CONVW + ch + i]; }
                float um2[8], um1[8];
#pragma unroll
                for (int i = 0; i < 8; ++i) { um2[i] = 0.f; um1[i] = 0.f; }
                if ((t0 & (SEQ - 1)) != 0) {
                    float c8[8], x8[8];
                    unpack8(*(const u32x4*)(pbuf + (size_t)(t0 - 2) * NPP + PB_C + ch), c8); unpack8(*(const u32x4*)(pbuf + (size_t)(t0 - 2) * NPP + PB_X + ch), x8);
#pragma unroll
                    for (int i = 0; i < 8; ++i) um2[i] = c8[i] * x8[i];
                    unpack8(*(const u32x4*)(pbuf + (size_t)(t0 - 1) * NPP + PB_C + ch), c8); unpack8(*(const u32x4*)(pbuf + (size_t)(t0 - 1) * NPP + PB_X + ch), x8);
#pragma unroll
                    for (int i = 0; i < 8; ++i) um1[i] = c8[i] * x8[i];
                }
#pragma unroll 4
                for (int t = 0; t < 16; ++t) {
                    const bf16_t* pr = pbuf + (size_t)(t0 + t) * NPP + ch;
                    float b8[8], c8[8], x8[8], o8[8];
                    unpack8(*(const u32x4*)(pr + PB_B), b8); unpack8(*(const u32x4*)(pr + PB_C), c8); unpack8(*(const u32x4*)(pr + PB_X), x8);
#pragma unroll
                    for (int i = 0; i < 8; ++i) { const float uu = c8[i] * x8[i]; o8[i] = b8[i] * (w0[i] * um2[i] + w1[i] * um1[i] + w2[i] * uu); um2[i] = um1[i]; um1[i] = uu; }
                    *(u32x4*)(mix + (size_t)(t0 + t) * DM + ch) = pack8(o8);
                }
            }
        }
        { pg8::DenseSched S; S.init(pbuf + PB_CQ, NPP, Wuq_t, NTOK, 768, QL, G, bx); pg8::EpiBf16 E{qraw, 768};
          pg8::gemm_phase<pg8::EpiBf16, pg8::DenseSched, false>(lds, S, E); }
        { pg8::DenseSched S; S.init(pbuf + PB_CKV, NPP, Wukv_t, NTOK, 1024, KVL, G, G - 1 - bx); pg8::EpiBf16 E{kvraw, 1024};
          pg8::gemm_phase<pg8::EpiBf16, pg8::DenseSched, false>(lds, S, E); }
        if (BOTH(2)) GRID_BAR();
    }

    if (IN(3)) {
        const int li = lane & 31, hsel = lane >> 5; const bool actv = li < 24, roped = actv && li >= 16;
        const int partner = (li < 20) ? lane + 4 : lane - 4;
        float qg[8], kg[8];
#pragma unroll
        for (int i = 0; i < 8; ++i) { qg[i] = actv ? q_head_norm[li * 8 + i] * QSCALE : 0.f; kg[i] = actv ? k_head_norm[li * 8 + i] : 0.f; }
        struct RowBuf { u32x4 cq, ckv, qr[2], ks[2], vs[2]; f32x4 cs[4]; };
        const u32x4 z4 = {0u, 0u, 0u, 0u};
#define P3_LOAD(B, m_) do { const int mm_ = (m_); const bf16_t* pb_ = pbuf + (size_t)mm_ * NPP; \
            B.cq = (lane < 48) ? *(const u32x4*)(pb_ + PB_CQ + lane * 8) : z4; B.ckv = (lane < 32) ? *(const u32x4*)(pb_ + PB_CKV + lane * 8) : z4; \
            _Pragma("unroll") for (int hp_ = 0; hp_ < 2; ++hp_) { const int hh_ = 2 * hp_ + hsel; \
                B.qr[hp_] = actv ? *(const u32x4*)(qraw + (size_t)mm_ * 768 + hh_ * QKH + li * 8) : z4; \
                B.ks[hp_] = (li < 16) ? *(const u32x4*)(kvraw + (size_t)mm_ * 1024 + hh_ * 256 + li * 8) : (actv ? *(const u32x4*)(pb_ + PB_KPE + (li - 16) * 8) : z4); \
                B.vs[hp_] = (li < 16) ? *(const u32x4*)(kvraw + (size_t)mm_ * 1024 + hh_ * 256 + 128 + li * 8) : z4; } \
            _Pragma("unroll") for (int c_ = 0; c_ < 4; ++c_) B.cs[c_] = roped ? *((const f32x4*)(rope_t + (mm_ & (SEQ - 1)) * 32 + (li & 3) * 8) + c_) : (f32x4){1.f, 0.f, 1.f, 0.f}; } while (0)
#define P3_ROPE(v) do { float ot_[8]; _Pragma("unroll") for (int i = 0; i < 8; ++i) ot_[i] = __shfl(v[i], partner); \
            if (roped) { if (li < 20) { _Pragma("unroll") for (int i = 0; i < 8; ++i) v[i] = v[i] * cs[2 * i] - ot_[i] * cs[2 * i + 1]; } \
                         else { _Pragma("unroll") for (int i = 0; i < 8; ++i) v[i] = ot_[i] * cs[2 * i + 1] + v[i] * cs[2 * i]; } } } while (0)
#define P3_COMPUTE(B, m_) do { const int mm_ = (m_); float t8[8]; float sq = 0.f, skv = 0.f; \
            unpack8(B.cq, t8); _Pragma("unroll") for (int i = 0; i < 8; ++i) sq += t8[i] * t8[i]; \
            unpack8(B.ckv, t8); _Pragma("unroll") for (int i = 0; i < 8; ++i) skv += t8[i] * t8[i]; \
            const float rs_q = 1.0f / sqrtf(wave_sum(sq) * (1.f / QL) + EPS), rs_kv = 1.0f / sqrtf(wave_sum(skv) * (1.f / KVL) + EPS); \
            float cs[16]; _Pragma("unroll") for (int c_ = 0; c_ < 4; ++c_) { cs[4 * c_] = B.cs[c_][0]; cs[4 * c_ + 1] = B.cs[c_][1]; cs[4 * c_ + 2] = B.cs[c_][2]; cs[4 * c_ + 3] = B.cs[c_][3]; } \
            _Pragma("unroll") for (int hp_ = 0; hp_ < 2; ++hp_) { const int hh_ = 2 * hp_ + hsel; float v[8]; \
                unpack8(B.qr[hp_], v); _Pragma("unroll") for (int i = 0; i < 8; ++i) v[i] *= rs_q; \
                float ss = 0.f; _Pragma("unroll") for (int i = 0; i < 8; ++i) ss += v[i] * v[i]; \
                float r = 1.0f / sqrtf(half_sum(ss) * (1.f / QKH) + EPS); \
                _Pragma("unroll") for (int i = 0; i < 8; ++i) v[i] = v[i] * r * qg[i]; \
                P3_ROPE(v); \
                if (actv) *(u32x4*)(qb_ + (size_t)mm_ * 768 + hh_ * QKH + li * 8) = pack8(v); \
                unpack8(B.ks[hp_], v); if (li < 16) { _Pragma("unroll") for (int i = 0; i < 8; ++i) v[i] *= rs_kv; } \
                ss = 0.f; _Pragma("unroll") for (int i = 0; i < 8; ++i) ss += v[i] * v[i]; \
                r = 1.0f / sqrtf(half_sum(ss) * (1.f / QKH) + EPS); \
                _Pragma("unroll") for (int i = 0; i < 8; ++i) v[i] = v[i] * r * kg[i]; \
                P3_ROPE(v); \
                if (actv) *(u32x4*)(kb_ + (size_t)mm_ * 768 + hh_ * QKH + li * 8) = pack8(v); \
                if (li < 16) { unpack8(B.vs[hp_], v); _Pragma("unroll") for (int i = 0; i < 8; ++i) v[i] *= rs_kv; \
                    *(u32x4*)(vb_ + (size_t)mm_ * 512 + hh_ * VH + li * 8) = pack8(v); } } } while (0)
        RowBuf A, B;
        int m = gw;
        if (m < NTOK) P3_LOAD(A, m);
        while (m < NTOK) {
            const int m1 = m + NGW, m2 = m + 2 * NGW;
            if (m1 < NTOK) P3_LOAD(B, m1);
            P3_COMPUTE(A, m);
            if (m1 >= NTOK) break;
            if (m2 < NTOK) P3_LOAD(A, m2);
            P3_COMPUTE(B, m1);
            m = m2;
        }
#undef P3_LOAD
#undef P3_ROPE
#undef P3_COMPUTE
        if (BOTH(3)) GRID_BAR();
    }

    if (IN(4)) {
        for (int u = vcu; u < NB * NH * 4; u += G) {
            const int bh = u >> 2, pr = u & 3, b = bh >> 2, h = bh & 3;
            att::attn_unit(b, h, 7 - pr, qb_, kb_, vb_, mix + CONVW, lds);
            att::attn_unit(b, h, pr, qb_, kb_, vb_, mix + CONVW, lds);
        }
        if (BOTH(4)) GRID_BAR();
    }

    if (IN(5)) {
        pg8::DenseSched S; S.init(mix, DM, Wo_t, NTOK, DM, DM, G, bx);
        pg8::EpiOut E{x, out, hb, ssq};
        pg8::gemm_phase<pg8::EpiOut, pg8::DenseSched, false>(lds, S, E);
        if (BOTH(5)) GRID_BAR();
    }

    if (IN(6)) {
        LAS unsigned* hist = (LAS unsigned*)(lds + MISC_OFF) + 128; LAS unsigned* base = (LAS unsigned*)(lds + MISC_OFF) + 160;
        const int tj = lane & 15, q = lane >> 4;
        for (int tile = vcu; tile < NTOK / 128; tile += G) {
            if (tid < 32) hist[tid] = 0u;
            __syncthreads();
            const int token = tile * 128 + wave * 16 + tj;
            const float* hrow = out + (size_t)token * DM + q * 8;
            const bf16_t* wh0 = WrH + (size_t)tj * DM + q * 8; const bf16_t* wl0 = WrL + (size_t)tj * DM + q * 8;
            f32x4 a0 = {0.f, 0.f, 0.f, 0.f}, a1 = {0.f, 0.f, 0.f, 0.f};
#pragma unroll 4
            for (int ks = 0; ks < DM / 32; ++ks) {
                const f32x4 h0 = *(const f32x4*)(hrow + ks * 32), h1 = *(const f32x4*)(hrow + ks * 32 + 4);
                float hf[8] = {h0[0], h0[1], h0[2], h0[3], h1[0], h1[1], h1[2], h1[3]}; float lf[8];
                u32x4 hw; hw.x = pk2(hf[0], hf[1]); hw.y = pk2(hf[2], hf[3]); hw.z = pk2(hf[4], hf[5]); hw.w = pk2(hf[6], hf[7]);
                { float hb8[8]; unpack8(hw, hb8);
#pragma unroll
                  for (int i = 0; i < 8; ++i) lf[i] = hf[i] - hb8[i]; }
                const bf16x8 bh = __builtin_bit_cast(bf16x8, hw), bl = __builtin_bit_cast(bf16x8, pack8(lf));
                const bf16x8 wh_a = *(const bf16x8*)(wh0 + ks * 32), wh_b = *(const bf16x8*)(wh0 + 16 * DM + ks * 32);
                const bf16x8 wl_a = *(const bf16x8*)(wl0 + ks * 32), wl_b = *(const bf16x8*)(wl0 + 16 * DM + ks * 32);
                a0 = __builtin_amdgcn_mfma_f32_16x16x32_bf16(wh_a, bh, a0, 0, 0, 0); a0 = __builtin_amdgcn_mfma_f32_16x16x32_bf16(wl_a, bh, a0, 0, 0, 0); a0 = __builtin_amdgcn_mfma_f32_16x16x32_bf16(wh_a, bl, a0, 0, 0, 0);
                a1 = __builtin_amdgcn_mfma_f32_16x16x32_bf16(wh_b, bh, a1, 0, 0, 0); a1 = __builtin_amdgcn_mfma_f32_16x16x32_bf16(wl_b, bh, a1, 0, 0, 0); a1 = __builtin_amdgcn_mfma_f32_16x16x32_bf16(wh_b, bl, a1, 0, 0, 0);
            }
            float s2 = 0.f;
#pragma unroll
            for (int p = 0; p < 16; ++p) s2 += ssq[(size_t)p * NTOK + token];
            const float rs = 1.0f / sqrtf(s2 * (1.f / DM) + EPS);
            float lv[8]; int le[8];
#pragma unroll
            for (int i = 0; i < 4; ++i) { le[i] = 4 * q + i; le[4 + i] = 16 + 4 * q + i; lv[i] = a0[i] * rs + b_router[le[i]]; lv[4 + i] = a1[i] * rs + b_router[le[4 + i]]; }
            float tv[4]; int te[4];
#pragma unroll
            for (int k = 0; k < TOPK; ++k) {
                float bv = lv[0]; int be = le[0];
#pragma unroll
                for (int i = 1; i < 8; ++i) if (lv[i] > bv) { bv = lv[i]; be = le[i]; }
#pragma unroll
                for (int o = 16; o < 64; o <<= 1) { const float ov = __shfl_xor(bv, o); const int oe = __shfl_xor(be, o); if (ov > bv || (ov == bv && oe < be)) { bv = ov; be = oe; } }
                tv[k] = bv; te[k] = be;
#pragma unroll
                for (int i = 0; i < 8; ++i) if (le[i] == be) lv[i] = -3.0e38f;
            }
            float ge[4]; float gs = 0.f;
#pragma unroll
            for (int k = 0; k < TOPK; ++k) { ge[k] = __expf(tv[k] - tv[0]); gs += ge[k]; }
            const float ginv = 1.0f / gs;
            int my_e = te[0]; float my_g = ge[0];
#pragma unroll
            for (int k = 1; k < TOPK; ++k) if (q == k) { my_e = te[k]; my_g = ge[k]; }
            my_g *= ginv;
            const unsigned pl = atomicAdd((unsigned*)(hist + my_e), 1u);
            __syncthreads();
            if (tid < 32) base[tid] = __hip_atomic_fetch_add(ctl + CW_CNT + 64 * tid, hist[tid], __ATOMIC_RELAXED, __HIP_MEMORY_SCOPE_AGENT);
            __syncthreads();
            const unsigned pos = base[my_e] + pl; const int slot = token * 4 + q;
            tos[(size_t)my_e * CAP + pos] = slot; gate[slot] = my_g;
            if (q == 0) rs2[token] = rs;
            __syncthreads();
        }
        if (BOTH(6)) GRID_BAR();
    }

    LAS int* tab = (LAS int*)(lds + MISC_OFF) + 16;
    if (IN(7) || IN(8)) {
        if (tid < 32) { const int c = (int)__hip_atomic_load(ctl + CW_CNT + 64 * tid, __ATOMIC_RELAXED, __HIP_MEMORY_SCOPE_AGENT); tab[48 + tid] = c; }
        __syncthreads();
        if (tid == 0) { int s = 0; for (int e = 0; e < NE; ++e) { tab[e] = s; s += (tab[48 + e] + 255) >> 8; } tab[32] = s; }
        __syncthreads();
    }

    if (IN(7)) {
        pg8::MoeSched S{hb, Wgu_t, DM, DM, 2 * DFF / 256, G, bx, (size_t)2 * DFF * DM, tab, tos};
        pg8::EpiSwiglu E{act, b_gate_up, rs2, tos};
        pg8::gemm_phase<pg8::EpiSwiglu, pg8::MoeSched, true>(lds, S, E);
        if (BOTH(7)) GRID_BAR();
    }

    if (IN(8)) {
        pg8::MoeSched S{act, Wdn_t, DFF, DFF, DM / 256, G, bx, (size_t)DM * DFF, tab, tos};
        pg8::EpiDown E{oslot, b_down, gate, tos};
        pg8::gemm_phase<pg8::EpiDown, pg8::MoeSched, false>(lds, S, E);
        if (BOTH(8)) GRID_BAR();
    }

    if (IN(9)) {
        for (int m = gw; m < NTOK; m += NGW) {
            f32x4* orow = (f32x4*)(out + (size_t)m * DM) + lane;
            const u32x2* s0 = (const u32x2*)(oslot + (size_t)m * 4 * DM) + lane;
#pragma unroll
            for (int j = 0; j < 4; ++j) { f32x4 v = orow[64 * j];
#pragma unroll
                for (int k = 0; k < 4; ++k) { const u32x2 w = s0[(size_t)k * (DM / 4) + 64 * j]; v.x += bf_lo(w.x); v.y += bf_hi(w.x); v.z += bf_lo(w.y); v.w += bf_hi(w.y); }
                orow[64 * j] = v; }
        }
    }
#undef IN
#undef BOTH
#undef GRID_BAR
}

#ifdef DIAG_PHASES
template __global__ void fwd_kernel_t<1>(Args); template __global__ void fwd_kernel_t<2>(Args); template __global__ void fwd_kernel_t<4>(Args); template __global__ void fwd_kernel_t<8>(Args);
template __global__ void fwd_kernel_t<16>(Args); template __global__ void fwd_kernel_t<32>(Args); template __global__ void fwd_kernel_t<64>(Args); template __global__ void fwd_kernel_t<128>(Args);
template __global__ void fwd_kernel_t<256>(Args); template __global__ void fwd_kernel_t<512>(Args);
#endif
#define fwd_kernel fwd_kernel_t<1023>
extern "C" void kernel_launch(void* const* d_in, const int* in_sizes, int n_in, void* d_out, int out_size, void* d_ws, size_t ws_size, hipStream_t stream) {
    static int grid = 0;
    if (grid == 0) {
        if (n_in != 18 || in_sizes[0] != NTOK * DM || out_size != NTOK * DM || ws_size < WS_END) { fprintf(stderr, "kernel_launch: shape/workspace mismatch (n_in %d, in0 %d, out %d, ws %zu, need %zu)\n", n_in, n_in > 0 ? in_sizes[0] : -1, out_size, ws_size, (size_t)WS_END); grid = -1; return; }
        int dev = 0, cus = 0, per_cu = 0;
        if (hipGetDevice(&dev) != hipSuccess || hipDeviceGetAttribute(&cus, hipDeviceAttributeMultiprocessorCount, dev) != hipSuccess) { grid = -1; return; }
        if (hipFuncSetAttribute((const void*)fwd_kernel, hipFuncAttributeMaxDynamicSharedMemorySize, LDS_BYTES) != hipSuccess) { fprintf(stderr, "kernel_launch: hipFuncSetAttribute failed\n"); grid = -1; return; }
        if (hipOccupancyMaxActiveBlocksPerMultiprocessor(&per_cu, (const void*)fwd_kernel, NWAVES * 64, LDS_BYTES) != hipSuccess || per_cu < 1) { fprintf(stderr, "kernel_launch: occupancy query says %d\n", per_cu); }
        (void)hipGetLastError();
        grid = cus;
    }
    if (grid < 0) return;
    if (hipMemsetAsync((char*)d_ws + WS_CTL, 0, CTL_ZERO_BYTES, stream) != hipSuccess) return;
    Args a{};
    for (int i = 0; i < 18; ++i) a.in[i] = (const float*)d_in[i];
    a.out = (float*)d_out; a.ws = (unsigned char*)d_ws;
    if (N_LAUNCHES == 1) { a.ph_lo = 0; a.ph_hi = N_PHASES; hipLaunchKernelGGL(fwd_kernel, dim3(grid), dim3(NWAVES * 64), LDS_BYTES, stream, a); }
    else { for (int p = 0; p < N_PHASES; ++p) { a.ph_lo = p; a.ph_hi = p + 1; const int reps = ((PROBE_DOUBLE >> p) & 1) ? 2 : 1;
            for (int r = 0; r < reps; ++r) hipLaunchKernelGGL(fwd_kernel, dim3(grid), dim3(NWAVES * 64), LDS_BYTES, stream, a); } }
}
```

```cpp
#include <hip/hip_runtime.h>
#include <cstdio>
#include <cstdint>

#ifndef MK_N_LAUNCHES
#define MK_N_LAUNCHES 1
#endif

#ifndef PROBE_DOUBLE
#define PROBE_DOUBLE 0
#endif
#define LAS __attribute__((address_space(3)))
#define GAS __attribute__((address_space(1)))
typedef unsigned short bf16_t;
typedef short bf16x8 __attribute__((ext_vector_type(8)));
typedef short s16x4 __attribute__((ext_vector_type(4)));
typedef float f32x2 __attribute__((ext_vector_type(2)));
typedef float f32x4 __attribute__((ext_vector_type(4)));
typedef float f32x16 __attribute__((ext_vector_type(16)));
typedef unsigned u32x2 __attribute__((ext_vector_type(2)));
typedef unsigned u32x4 __attribute__((ext_vector_type(4)));
typedef int v4i_t __attribute__((ext_vector_type(4)));
typedef int v8i_t __attribute__((ext_vector_type(8)));

constexpr int NB = 16, SEQ = 2048, NTOK = NB * SEQ, DM = 1024;
constexpr int CONVW = 512, QL = 384, KVL = 256, ROPE = 64, NH = 4, QKN = 128, QKH = 192, VH = 128;
constexpr int NPROJ = 2240, NPP = 2304;
constexpr int PB_B = 0, PB_C = 512, PB_X = 1024, PB_CQ = 1536, PB_CKV = 1920, PB_KPE = 2176;
constexpr int NE = 32, TOPK = 4, DFF = 1024, NSLOT = NTOK * TOPK;
constexpr int CAP = NTOK;
constexpr int MAXTILES = NSLOT / 256 + NE;
constexpr float EPS = 1e-6f;
constexpr float QSCALE = 0.07216878364870322f * 1.4426950408889634f;
constexpr float SWI_LIMIT = 7.0f, SWI_ALPHA = 1.702f;
constexpr float W8_SCALE = 64.f, ACT8_SCALE = 4.f;

constexpr size_t MiB = 1u << 20;
constexpr size_t WS_CTL = 0, CTL_ZERO_BYTES = 1 * MiB;
constexpr size_t WS_ROPE = 1 * MiB;
constexpr size_t WS_WRH = 1 * MiB + 512 * 1024, WS_WRL = WS_WRH + 64 * 1024;
constexpr size_t WS_WIN = 2 * MiB;
constexpr size_t WS_WUQ = 8 * MiB, WS_WUKV = 9 * MiB, WS_WO = 10 * MiB;
constexpr size_t WS_SSQ = 12 * MiB;
constexpr size_t WS_RS2 = 14 * MiB, WS_GATE = 14 * MiB + 512 * 1024;
constexpr size_t WS_TOS = 16 * MiB;
constexpr size_t WS_WGU = 32 * MiB, WS_WDN = 160 * MiB;
constexpr size_t WS_HB = 224 * MiB;
constexpr size_t WS_Q = 288 * MiB, WS_K = 336 * MiB, WS_V = 384 * MiB, WS_MIX = 416 * MiB;
constexpr size_t WS_OSLOT = 288 * MiB;
constexpr size_t WS_HN = 544 * MiB, WS_PB = 608 * MiB, WS_QRAW = 752 * MiB, WS_KVRAW = 800 * MiB;
constexpr size_t WS_ACT = 544 * MiB;
constexpr size_t WS_END = 864 * MiB;
constexpr int CW_BAR = 4096;
constexpr int CW_CNT = 16384;

constexpr int RING_BYTES = 131072;
constexpr int MISC_OFF = RING_BYTES;
constexpr int LDS_BYTES = 147456;

__device__ __forceinline__ unsigned cvt_pk_bf16(float lo, float hi) { unsigned r; asm volatile("v_cvt_pk_bf16_f32 %0, %1, %2" : "=v"(r) : "v"(lo), "v"(hi)); return r; }
__device__ __forceinline__ unsigned f2bf(float f) { unsigned u = __builtin_bit_cast(unsigned, f); return (u + 0x7fffu + ((u >> 16) & 1u)) >> 16; }
__device__ __forceinline__ unsigned pk2(float lo, float hi) { return f2bf(lo) | (f2bf(hi) << 16); }
__device__ __forceinline__ float bf_lo(unsigned w) { return __builtin_bit_cast(float, w << 16); }
__device__ __forceinline__ float bf_hi(unsigned w) { return __builtin_bit_cast(float, w & 0xffff0000u); }
__device__ __forceinline__ void unpack8(const u32x4 w, float* f) { f[0] = bf_lo(w.x); f[1] = bf_hi(w.x); f[2] = bf_lo(w.y); f[3] = bf_hi(w.y); f[4] = bf_lo(w.z); f[5] = bf_hi(w.z); f[6] = bf_lo(w.w); f[7] = bf_hi(w.w); }
__device__ __forceinline__ u32x4 pack8(const float* f) { u32x4 w; w.x = cvt_pk_bf16(f[0], f[1]); w.y = cvt_pk_bf16(f[2], f[3]); w.z = cvt_pk_bf16(f[4], f[5]); w.w = cvt_pk_bf16(f[6], f[7]); return w; }
__device__ __forceinline__ float wave_sum(float v) {
#pragma unroll
    for (int o = 1; o < 64; o <<= 1) v += __shfl_xor(v, o);
    return v;
}
__device__ __forceinline__ float half_sum(float v) {
#pragma unroll
    for (int o = 1; o < 32; o <<= 1) v += __shfl_xor(v, o);
    return v;
}
__device__ __forceinline__ float clamp448(float v) { return __builtin_amdgcn_fmed3f(v, -448.f, 448.f); }
__device__ __forceinline__ unsigned pk4_fp8(float a, float b, float c, float d) {
    unsigned w = 0u; w = (unsigned)__builtin_amdgcn_cvt_pk_fp8_f32(clamp448(a), clamp448(b), (int)w, false); w = (unsigned)__builtin_amdgcn_cvt_pk_fp8_f32(clamp448(c), clamp448(d), (int)w, true); return w; }
#define LDS_WAIT() asm volatile("s_waitcnt lgkmcnt(0)" ::: "memory")
#define VM_WAIT() asm volatile("s_waitcnt vmcnt(0)" ::: "memory")

namespace pg8 {
constexpr int BM = 256, BK = 64, HALF = 128, HTB = HALF * BK * 2, STAGE_BYTES = 8 * HTB, NXCD = 8, WGM = 8;
__host__ __device__ __forceinline__ int lds_byte(int r, int c) { const int st = (r >> 4) * 2 + (c >> 5), rr = r & 15, cc = c & 31, ob = rr * 64 + cc * 2; return st * 1024 + (ob ^ (((ob >> 9) & 1) << 5)); }
__host__ __device__ __forceinline__ void stage_rc(int b, int& R, int& C) { const int st = b / 1024, sb = b % 1024, swz = sb ^ (((sb >> 9) & 1) << 5); R = (st >> 1) * 16 + swz / 64; C = (st & 1) * 32 + (swz % 64) / 2; }
__host__ __device__ __forceinline__ int perm32(int rho) { const int n = rho >> 4, i = rho & 15; return 8 * (i >> 2) + 4 * n + (i & 3); }

struct Unit { int pm, pn, e, p0, cnt; };

struct DenseSched {
    static constexpr int ESZ = 2;
    const bf16_t* A; const bf16_t* Bt; int lda, K, nM, nN, nwg, G, c;
    __device__ void init(const bf16_t* A_, int lda_, const bf16_t* Bt_, int M, int N, int K_, int G_, int c_) { A = A_; Bt = Bt_; lda = lda_; K = K_; nM = M / BM; nN = N / BM; nwg = nM * nN; G = G_; c = c_; }
    __device__ __forceinline__ bool next(int i, Unit& u) const {
        const long L = (long)i * G + c; if (L >= nwg) return false;
        int wgid = (int)L; { const int q = nwg / NXCD, r = nwg % NXCD, xcd = wgid % NXCD, off = wgid / NXCD; wgid = (xcd < r ? xcd * (q + 1) : r * (q + 1) + (xcd - r) * q) + off; }
        const int nig = WGM * nN, gid = wgid / nig, fm = gid * WGM, gsz = (nM - fm) < WGM ? (nM - fm) : WGM;
        u.pm = fm + ((wgid % nig) % gsz); u.pn = (wgid % nig) / gsz; u.e = 0; u.p0 = 0; u.cnt = 0; return true;
    }
    __device__ __forceinline__ unsigned a_off(const Unit& u) const { return (unsigned)u.pm * (unsigned)(BM * lda * 2); }
    __device__ __forceinline__ unsigned b_off(const Unit& u) const { return (unsigned)u.pn * (unsigned)(BM * K * 2); }
    __device__ __forceinline__ unsigned a_rowoff(const Unit&, int) const { return 0u; }
};
struct MoeSched {
    static constexpr int ESZ = 1;
    const unsigned char* A; const unsigned char* Bt; int lda, K, nN, G, c; size_t estride; const LAS int* tab; const int* tos;
    __device__ __forceinline__ bool next(int i, Unit& u) const {
        const int T = __builtin_amdgcn_readfirstlane(tab[32]), nwg = T * nN;
        const long L = (long)i * G + c; if (L >= nwg) return false;
        int wgid = (int)L; { const int q = nwg / NXCD, r = nwg % NXCD, xcd = wgid % NXCD, off = wgid / NXCD; wgid = (xcd < r ? xcd * (q + 1) : r * (q + 1) + (xcd - r) * q) + off; }
        const int nig = WGM * nN, gid = wgid / nig, fm = gid * WGM, gsz = (T - fm) < WGM ? (T - fm) : WGM;
        const int mt = fm + ((wgid % nig) % gsz); u.pm = mt; u.pn = (wgid % nig) / gsz;
        int e = 0; while (e < NE - 1 && __builtin_amdgcn_readfirstlane(tab[e + 1]) <= mt) ++e;
        u.e = e; u.p0 = (mt - __builtin_amdgcn_readfirstlane(tab[e])) * BM; u.cnt = __builtin_amdgcn_readfirstlane(tab[48 + e]); return true;
    }
    __device__ __forceinline__ unsigned a_off(const Unit& u) const { return (unsigned)u.pm * (unsigned)(BM * lda); }
    __device__ __forceinline__ unsigned b_off(const Unit& u) const { return (unsigned)u.e * (unsigned)estride + (unsigned)u.pn * (unsigned)(BM * K); }
    __device__ __forceinline__ unsigned a_rowoff(const Unit& u, int r) const {
        const int p = u.p0 + r; int slot = 0; if (p < u.cnt) slot = tos[(size_t)u.e * CAP + p];
        return (unsigned)(slot >> 2) * (unsigned)lda;
    }
};

template <class Epi, class Sched, bool GATHER>
__device__ __forceinline__ void gemm_phase(LAS unsigned char* lds, const Sched& S, const Epi& E) {
    const int tid = threadIdx.x, wid = __builtin_amdgcn_readfirstlane(tid >> 6), lane = tid & 63, wr = wid >> 2, wc = wid & 3, fr = lane & 15, fq = lane >> 4;
    constexpr int ESZ = Sched::ESZ; constexpr bool F8 = (ESZ == 1);
    const int K = S.K * ESZ / 2, lda = S.lda * ESZ / 2, nt = K / BK;
    unsigned voffB[2], aoc[2][2]; int RA[2], CA[2];
    LAS u32x4* aon_l = (LAS u32x4*)(lds + STAGE_BYTES + 1024) + tid;
#pragma unroll
    for (int i = 0; i < 2; ++i) { int R, C; stage_rc(tid * 16 + i * 8192, R, C); const int Rb = (R & ~31) + perm32(R & 31);
        voffB[i] = (unsigned)(Rb * K + C) * 2u; RA[i] = R; CA[i] = C;
        aoc[0][i] = (unsigned)(R * lda + C) * 2u; aoc[1][i] = (unsigned)((R + HALF) * lda + C) * 2u; }
    const unsigned kstep = (unsigned)(BK * 2);
    const unsigned hstepB = (unsigned)(HALF * K * 2), hstepA = GATHER ? 0u : (unsigned)(HALF * lda * 2);
    const __amdgpu_buffer_rsrc_t rA = __builtin_amdgcn_make_buffer_rsrc((void*)S.A, 0, -1, 0x00020000), rB = __builtin_amdgcn_make_buffer_rsrc((void*)S.Bt, 0, -1, 0x00020000);
    const unsigned ldsw = (unsigned)wid * 1024u;
    const int aoff = lds_byte(wr * 64 + fr, fq * 8), boff = lds_byte(wc * 32 + fr, fq * 8);
#define PG8_SA(b, h) (((b) * 2 + (h)) * HTB)
#define PG8_SB(b, h) ((4 + (b) * 2 + (h)) * HTB)
#define PG8_STAGE_B(bufoff, soff) do { _Pragma("unroll") for (int _i = 0; _i < 2; ++_i) \
        __builtin_amdgcn_raw_ptr_buffer_load_lds(rB, (LAS void*)(lds + (bufoff) + ldsw + _i * 8192), 16, voffB[_i], (soff), 0, 0); } while (0)
#define PG8_STAGE_A(bufoff, soff, h) do { _Pragma("unroll") for (int _i = 0; _i < 2; ++_i) \
        __builtin_amdgcn_raw_ptr_buffer_load_lds(rA, (LAS void*)(lds + (bufoff) + ldsw + _i * 8192), 16, aoc[GATHER ? (h) : 0][_i], (soff) + (h) * hstepA, 0, 0); } while (0)
#define PG8_LDA(dst, b, h) do { _Pragma("unroll") for (int m = 0; m < 4; ++m) _Pragma("unroll") for (int k = 0; k < 2; ++k) dst[m][k] = *(const LAS bf16x8*)(lds + PG8_SA(b, h) + aoff + m * 2048 + k * 1024); } while (0)
#define PG8_LDB(dst, b, h) do { _Pragma("unroll") for (int n = 0; n < 2; ++n) _Pragma("unroll") for (int k = 0; k < 2; ++k) dst[n][k] = *(const LAS bf16x8*)(lds + PG8_SB(b, h) + boff + n * 2048 + k * 1024); } while (0)
#define PG8_CAT(x) __builtin_shufflevector(__builtin_bit_cast(v4i_t, x[0]), __builtin_bit_cast(v4i_t, x[1]), 0, 1, 2, 3, 4, 5, 6, 7)
#define PG8_MMA(ai, bj, At, Bt) do { __builtin_amdgcn_s_setprio(1); _Pragma("unroll") for (int m = 0; m < 4; ++m) _Pragma("unroll") for (int n = 0; n < 2; ++n) { \
        if constexpr (F8) acc[ai][bj][m][n] = __builtin_amdgcn_mfma_scale_f32_16x16x128_f8f6f4(PG8_CAT(Bt[n]), PG8_CAT(At[m]), acc[ai][bj][m][n], 0, 0, 0, 0x7f7f7f7f, 0, 0x7f7f7f7f); \
        else { _Pragma("unroll") for (int k = 0; k < 2; ++k) acc[ai][bj][m][n] = __builtin_amdgcn_mfma_f32_16x16x32_bf16(Bt[n][k], At[m][k], acc[ai][bj][m][n], 0, 0, 0); } } \
        __builtin_amdgcn_s_setprio(0); } while (0)
#define PG8_WAIT_V(n) asm volatile("s_waitcnt vmcnt(" #n ")" ::: "memory")
#define PG8_WAIT_L(n) asm volatile("s_waitcnt lgkmcnt(" #n ")" ::: "memory")
#define PG8_BAR __builtin_amdgcn_s_barrier()
#define PG8_SCHED __builtin_amdgcn_sched_barrier(0)
    Unit cur, nxt; int ui = 0;
    if (!S.next(0, cur)) return;
    f32x4 acc[2][2][4][2];
#pragma unroll
    for (int a = 0; a < 2; ++a)
#pragma unroll
        for (int b = 0; b < 2; ++b)
#pragma unroll
            for (int m = 0; m < 4; ++m)
#pragma unroll
                for (int n = 0; n < 2; ++n) acc[a][b][m][n] = (f32x4){0.f, 0.f, 0.f, 0.f};
    bf16x8 At[4][2], B0[2][2], B1[2][2];
    unsigned cA = GATHER ? 0u : S.a_off(cur), cB = S.b_off(cur);
    if constexpr (GATHER) {
#pragma unroll
        for (int h = 0; h < 2; ++h)
#pragma unroll
            for (int i = 0; i < 2; ++i) aoc[h][i] = S.a_rowoff(cur, h * HALF + RA[i]) + (unsigned)CA[i] * 2u;
    }
    PG8_STAGE_B(PG8_SB(0, 0), cB); PG8_STAGE_B(PG8_SB(0, 1), cB + hstepB); PG8_STAGE_A(PG8_SA(0, 0), cA, 0); PG8_STAGE_A(PG8_SA(0, 1), cA, 1);
    if (wr == 1) PG8_BAR;
    PG8_WAIT_V(2); PG8_BAR;
    PG8_STAGE_B(PG8_SB(1, 0), cB + kstep); PG8_STAGE_A(PG8_SA(1, 0), cA + kstep, 0); PG8_STAGE_B(PG8_SB(1, 1), cB + hstepB + kstep);
    PG8_WAIT_V(6); PG8_BAR;
    for (;;) {
        const bool has_next = S.next(ui + 1, nxt);
        const unsigned nA = GATHER ? 0u : (has_next ? S.a_off(nxt) : cA), nB = has_next ? S.b_off(nxt) : cB;
        if constexpr (GATHER) {
            u32x4 an = {aoc[0][0], aoc[0][1], aoc[1][0], aoc[1][1]};
            if (has_next) { an.x = S.a_rowoff(nxt, RA[0]) + (unsigned)CA[0] * 2u; an.y = S.a_rowoff(nxt, RA[1]) + (unsigned)CA[1] * 2u;
                            an.z = S.a_rowoff(nxt, HALF + RA[0]) + (unsigned)CA[0] * 2u; an.w = S.a_rowoff(nxt, HALF + RA[1]) + (unsigned)CA[1] * 2u; }
            *aon_l = an;
        }
        for (int t = 0; t < nt; t += 2) {
            const bool last = (t == nt - 2);
            const unsigned a1 = cA + (unsigned)(t + 1) * kstep;
            const unsigned a2 = last ? nA : cA + (unsigned)(t + 2) * kstep, b2 = last ? nB : cB + (unsigned)(t + 2) * kstep;
            const unsigned a3 = a2 + kstep, b3 = b2 + kstep;
            PG8_LDB(B0, 0, 0); PG8_LDB(B1, 0, 1); PG8_SCHED; PG8_LDA(At, 0, 0); PG8_STAGE_A(PG8_SA(1, 1), a1, 1);
            PG8_WAIT_V(8); PG8_WAIT_L(0); PG8_BAR; PG8_MMA(0, 0, At, B0); PG8_MMA(0, 1, At, B1); PG8_BAR; PG8_SCHED;
            if constexpr (GATHER) { if (last) { const u32x4 an = *aon_l; aoc[0][0] = an.x; aoc[0][1] = an.y; aoc[1][0] = an.z; aoc[1][1] = an.w; } }
            PG8_LDA(At, 0, 1); PG8_STAGE_B(PG8_SB(0, 0), b2); PG8_STAGE_B(PG8_SB(0, 1), b2 + hstepB); PG8_STAGE_A(PG8_SA(0, 0), a2, 0);
            PG8_WAIT_V(8); PG8_WAIT_L(0); PG8_BAR; PG8_MMA(1, 0, At, B0); PG8_MMA(1, 1, At, B1); PG8_BAR; PG8_SCHED;
            PG8_LDB(B0, 1, 0); PG8_LDB(B1, 1, 1); PG8_SCHED; PG8_LDA(At, 1, 0); PG8_STAGE_A(PG8_SA(0, 1), a2, 1);
            PG8_WAIT_V(8); PG8_WAIT_L(0); PG8_BAR; PG8_MMA(0, 0, At, B0); PG8_MMA(0, 1, At, B1); PG8_BAR; PG8_SCHED;
            PG8_LDA(At, 1, 1); PG8_STAGE_B(PG8_SB(1, 0), b3); PG8_STAGE_B(PG8_SB(1, 1), b3 + hstepB); PG8_STAGE_A(PG8_SA(1, 0), a3, 0);
            PG8_WAIT_V(8); PG8_WAIT_L(0); PG8_BAR; PG8_MMA(1, 0, At, B0); PG8_MMA(1, 1, At, B1); PG8_BAR; PG8_SCHED;
        }
        if (wr == 0) PG8_BAR;
        E(acc, cur, wr, wc, fr, fq);
        if (!has_next) break;
#pragma unroll
        for (int a = 0; a < 2; ++a)
#pragma unroll
            for (int b = 0; b < 2; ++b)
#pragma unroll
                for (int m = 0; m < 4; ++m)
#pragma unroll
                    for (int n = 0; n < 2; ++n) acc[a][b][m][n] = (f32x4){0.f, 0.f, 0.f, 0.f};
        cur = nxt; cA = nA; cB = nB; ++ui;
        if (wr == 1) PG8_BAR;
    }
    PG8_WAIT_V(0);
    PG8_BAR;
#undef PG8_SA
#undef PG8_SB
#undef PG8_STAGE_A
#undef PG8_STAGE_B
#undef PG8_LDA
#undef PG8_LDB
#undef PG8_MMA
#undef PG8_CAT
#undef PG8_WAIT_V
#undef PG8_WAIT_L
#undef PG8_BAR
#undef PG8_SCHED
}

struct EpiBf16 {
    bf16_t* O; int ldc;
    __device__ __forceinline__ void operator()(const f32x4 (&acc)[2][2][4][2], const Unit& u, int wr, int wc, int fr, int fq) const {
        asm volatile("" : "+v"(fr), "+v"(fq));
        const int row0 = u.pm * BM + wr * 64 + fr, col0 = u.pn * BM + wc * 32 + 8 * fq;
#pragma unroll
        for (int ai = 0; ai < 2; ++ai)
#pragma unroll
            for (int m = 0; m < 4; ++m) { bf16_t* rowp = O + (size_t)(row0 + ai * HALF + m * 16) * ldc + col0;
#pragma unroll
                for (int bj = 0; bj < 2; ++bj) { const f32x4 v0 = acc[ai][bj][m][0], v1 = acc[ai][bj][m][1];
                    u32x4 w; w.x = cvt_pk_bf16(v0[0], v0[1]); w.y = cvt_pk_bf16(v0[2], v0[3]); w.z = cvt_pk_bf16(v1[0], v1[1]); w.w = cvt_pk_bf16(v1[2], v1[3]);
                    *(u32x4*)(rowp + bj * HALF) = w; } }
    }
};
struct EpiOut {
    const float* x; float* out; float* ssq;
    __device__ __forceinline__ void operator()(const f32x4 (&acc)[2][2][4][2], const Unit& u, int wr, int wc, int fr, int fq) const {
        asm volatile("" : "+v"(fr), "+v"(fq));
        const int row0 = u.pm * BM + wr * 64 + fr, col0 = u.pn * BM + wc * 32 + 8 * fq;
#pragma unroll
        for (int ai = 0; ai < 2; ++ai)
#pragma unroll
            for (int m = 0; m < 4; ++m) { const int row = row0 + ai * HALF + m * 16; const size_t off = (size_t)row * DM + col0; float ss = 0.f;
#pragma unroll
                for (int bj = 0; bj < 2; ++bj) { const f32x4 x0 = *(const f32x4*)(x + off + bj * HALF), x1 = *(const f32x4*)(x + off + bj * HALF + 4);
                    const f32x4 v0 = acc[ai][bj][m][0] + x0, v1 = acc[ai][bj][m][1] + x1;
                    *(f32x4*)(out + off + bj * HALF) = v0; *(f32x4*)(out + off + bj * HALF + 4) = v1;
                    ss += (v0[0] * v0[0] + v0[1] * v0[1]) + (v0[2] * v0[2] + v0[3] * v0[3]) + (v1[0] * v1[0] + v1[1] * v1[1]) + (v1[2] * v1[2] + v1[3] * v1[3]); }
                ss += __shfl_xor(ss, 16); ss += __shfl_xor(ss, 32);
                if (fq == 0) ssq[(size_t)(u.pn * 4 + wc) * NTOK + row] = ss; }
    }
};
struct EpiSwiglu {
    unsigned char* act; const float* bgu;
    __device__ __forceinline__ void operator()(const f32x4 (&acc)[2][2][4][2], const Unit& u, int wr, int wc, int fr, int fq) const {
        asm volatile("" : "+v"(fr), "+v"(fq));
        const int rt0 = wr * 64 + fr, j0 = wc * 32 + 8 * fq;
        const float* bg = bgu + (size_t)u.e * (2 * DFF) + u.pn * HALF + j0;
        const f32x4 bg0 = *(const f32x4*)bg, bg1 = *(const f32x4*)(bg + 4), bu0 = *(const f32x4*)(bg + DFF), bu1 = *(const f32x4*)(bg + DFF + 4);
        constexpr float WI = 1.f / W8_SCALE;
#pragma unroll
        for (int ai = 0; ai < 2; ++ai)
#pragma unroll
            for (int m = 0; m < 4; ++m) { const int rt = rt0 + ai * HALF + m * 16;
                float o[8];
#pragma unroll
                for (int n = 0; n < 2; ++n) { const f32x4 g4 = acc[ai][0][m][n] * WI + (n ? bg1 : bg0), u4 = acc[ai][1][m][n] * WI + (n ? bu1 : bu0);
#pragma unroll
                    for (int i = 0; i < 4; ++i) { const float g = fminf(g4[i], SWI_LIMIT), uu = fminf(fmaxf(u4[i], -SWI_LIMIT), SWI_LIMIT);
                        const float sg = __builtin_amdgcn_rcpf(1.f + __builtin_amdgcn_exp2f(g * (-SWI_ALPHA * 1.4426950408889634f)));
                        o[n * 4 + i] = (uu + 1.f) * (g * sg) * ACT8_SCALE; } }
                u32x2 w; w.x = pk4_fp8(o[0], o[1], o[2], o[3]); w.y = pk4_fp8(o[4], o[5], o[6], o[7]);
                *(u32x2*)(act + ((size_t)u.pm * BM + rt) * DFF + u.pn * HALF + j0) = w; }
    }
};
struct EpiDown {
    bf16_t* oslot; const float* bdn; const float* gate; const int* tos;
    __device__ __forceinline__ void operator()(const f32x4 (&acc)[2][2][4][2], const Unit& u, int wr, int wc, int fr, int fq) const {
        asm volatile("" : "+v"(fr), "+v"(fq));
        const int rt0 = wr * 64 + fr, col0 = u.pn * BM + wc * 32 + 8 * fq;
        const float* bp = bdn + (size_t)u.e * DM + col0;
        f32x4 bv[2][2];
#pragma unroll
        for (int bj = 0; bj < 2; ++bj) { bv[bj][0] = *(const f32x4*)(bp + bj * HALF); bv[bj][1] = *(const f32x4*)(bp + bj * HALF + 4); }
        constexpr float WI = 1.f / (W8_SCALE * ACT8_SCALE);
#pragma unroll
        for (int ai = 0; ai < 2; ++ai)
#pragma unroll
            for (int m = 0; m < 4; ++m) { const int rt = rt0 + ai * HALF + m * 16, p = u.p0 + rt;
                if (p < u.cnt) { const int slot = tos[(size_t)u.e * CAP + p]; const float g = gate[slot];
#pragma unroll
                    for (int bj = 0; bj < 2; ++bj) { const f32x4 v0 = (acc[ai][bj][m][0] * WI + bv[bj][0]) * g, v1 = (acc[ai][bj][m][1] * WI + bv[bj][1]) * g;
                        u32x4 w; w.x = cvt_pk_bf16(v0[0], v0[1]); w.y = cvt_pk_bf16(v0[2], v0[3]); w.z = cvt_pk_bf16(v1[0], v1[1]); w.w = cvt_pk_bf16(v1[2], v1[3]);
                        *(u32x4*)(oslot + (size_t)slot * DM + col0 + bj * HALF) = w; } }
                asm volatile("" ::: "memory"); }
    }
};
}

namespace att {
constexpr int LDQ = NH * QKH, LDK = NH * QKH, LDV = NH * VH, LDO = DM;
constexpr int KT_BYTES = 64 * QKH * 2, VT_BYTES = 64 * VH * 2;
constexpr int L_K = 0, L_V = 2 * KT_BYTES, L_WS = L_V + 2 * VT_BYTES, L_END = L_WS + 8 * 256;
constexpr float THRL = 8.f * 1.4426950408889634f;
__device__ __forceinline__ int crow(int r, int hi) { return (r & 3) + 8 * (r >> 2) + 4 * hi; }
#define SBAR() __builtin_amdgcn_sched_barrier(0)
__device__ __forceinline__ int v_rd_base(int lane) { return ((lane & 3) << 3) | (((lane >> 2) & 3) << 6) | (((lane >> 4) & 1) << 5) | (((lane >> 5) & 1) << 8); }
constexpr int v_rd_off(int d0, int ks, int half) { return d0 * 512 + ks * 4096 + half * 2048; }
template <int OFF> __device__ __forceinline__ s16x4 tr_read(int vb) {
    s16x4 r; asm volatile("ds_read_b64_tr_b16 %0, %1 offset:%2" : "=&v"(r) : "v"(vb), "i"(OFF) : "memory"); return r;
}
template <int D0> __device__ __forceinline__ void pv_one(f32x16& od, int vb, bf16x8 pa0, bf16x8 pa1, bf16x8 pa2, bf16x8 pa3) {
    const s16x4 l0 = tr_read<v_rd_off(D0, 0, 0)>(vb), h0 = tr_read<v_rd_off(D0, 0, 1)>(vb), l1 = tr_read<v_rd_off(D0, 1, 0)>(vb), h1 = tr_read<v_rd_off(D0, 1, 1)>(vb);
    const s16x4 l2 = tr_read<v_rd_off(D0, 2, 0)>(vb), h2 = tr_read<v_rd_off(D0, 2, 1)>(vb), l3 = tr_read<v_rd_off(D0, 3, 0)>(vb), h3 = tr_read<v_rd_off(D0, 3, 1)>(vb);
    asm volatile("s_waitcnt lgkmcnt(0)" ::: "memory"); SBAR();
#define PK(L, H) (bf16x8){L[0], L[1], L[2], L[3], H[0], H[1], H[2], H[3]}
    od = __builtin_amdgcn_mfma_f32_32x32x16_bf16(pa0, PK(l0, h0), od, 0, 0, 0);
    od = __builtin_amdgcn_mfma_f32_32x32x16_bf16(pa1, PK(l1, h1), od, 0, 0, 0);
    od = __builtin_amdgcn_mfma_f32_32x32x16_bf16(pa2, PK(l2, h2), od, 0, 0, 0);
    od = __builtin_amdgcn_mfma_f32_32x32x16_bf16(pa3, PK(l3, h3), od, 0, 0, 0);
#undef PK
}
__device__ __forceinline__ void glds16(const void* gsrc, LAS unsigned char* dst) {
    __builtin_amdgcn_global_load_lds((const unsigned*)gsrc, (LAS unsigned*)dst, 16, 0, 0);
}
__device__ __forceinline__ void attn_unit(int b, int h, int qb, const bf16_t* Q, const bf16_t* Kg, const bf16_t* Vg, bf16_t* O, LAS unsigned char* lds) {
    const int tid = threadIdx.x, wid = __builtin_amdgcn_readfirstlane(tid >> 6), lane = tid & 63, r32 = lane & 31, hi = lane >> 5;
    const size_t tok0 = (size_t)b * SEQ;
    bf16x8 qr[12];
    { const bf16_t* Qw = Q + (tok0 + (size_t)qb * 256 + wid * 32 + r32) * LDQ + h * QKH + hi * 8;
#pragma unroll
      for (int d0 = 0; d0 < 12; ++d0) qr[d0] = *(const bf16x8*)(Qw + d0 * 16); }
    unsigned koff[3], voff[2];
#pragma unroll
    for (int i = 0; i < 3; ++i) { const int G = 64 * (wid + 8 * i) + lane, row = G / 24, cgs = G % 24, cg = (cgs & ~7) | ((cgs & 7) ^ ((row >> 1) & 7)); koff[i] = (unsigned)(row * LDK * 2 + cg * 16); }
#pragma unroll
    for (int i = 0; i < 2; ++i) { const int p = wid + 8 * i, sub = 2 * p + (lane >> 5), kkh = sub >> 2, cblk = sub & 3, kkl = (lane & 31) >> 2, cl = (lane & 3) * 8, kk = kkh * 8 + kkl;
        const int k = (kk & ~0xC) | ((kk & 4) << 1) | ((kk & 8) >> 1), c = cblk * 32 + cl; voff[i] = (unsigned)(k * LDV * 2 + c * 2); }
    const char* Kh = (const char*)(Kg + tok0 * LDK + h * QKH); const char* Vh = (const char*)(Vg + tok0 * LDV + h * VH);
#define ATT_DMA(j, buf) do { const char* kp_ = Kh + (size_t)(j) * 64 * LDK * 2; const char* vp_ = Vh + (size_t)(j) * 64 * LDV * 2; \
        _Pragma("unroll") for (int i_ = 0; i_ < 3; ++i_) glds16(kp_ + koff[i_], lds + L_K + (buf) * KT_BYTES + (wid + 8 * i_) * 1024); \
        _Pragma("unroll") for (int i_ = 0; i_ < 2; ++i_) glds16(vp_ + voff[i_], lds + L_V + (buf) * VT_BYTES + (wid + 8 * i_) * 1024); } while (0)
    const int swz = (r32 >> 1) & 7; int kx[4];
#pragma unroll
    for (int dd = 0; dd < 4; ++dd) kx[dd] = r32 * (QKH * 2) + (((2 * dd + hi) ^ swz) << 4);
    LAS float* ws = (LAS float*)(lds + L_WS) + wid * 64; LAS float* li_l = ws; LAS float* al_l = ws + 32;
    const int vb0 = L_V + v_rd_base(lane);
    float m_reg = -1e30f, l_reg = 0.f; f32x16 o[4];
#pragma unroll
    for (int d = 0; d < 4; ++d)
#pragma unroll
        for (int r = 0; r < 16; ++r) o[d][r] = 0.f;
    const int NT = 4 * qb + 4, my_last = 4 * qb + (wid >> 1);
    ATT_DMA(0, 0);
    for (int j = 0; j < NT; ++j) {
        const int buf = j & 1;
        asm volatile("s_waitcnt vmcnt(0)" ::: "memory"); __builtin_amdgcn_s_barrier(); asm volatile("" ::: "memory");
        if (j + 1 < NT) ATT_DMA(j + 1, buf ^ 1);
        if (j <= my_last) {
            const LAS unsigned char* Ks = lds + L_K + buf * KT_BYTES;
            f32x16 p0, p1;
#pragma unroll
            for (int r = 0; r < 16; ++r) { p0[r] = 0.f; p1[r] = 0.f; }
#pragma unroll
            for (int d0 = 0; d0 < 12; ++d0) {
                const bf16x8 b0 = *(const LAS bf16x8*)(Ks + kx[d0 & 3] + (d0 >> 2) * 128);
                const bf16x8 b1 = *(const LAS bf16x8*)(Ks + kx[d0 & 3] + (d0 >> 2) * 128 + 32 * QKH * 2);
                p0 = __builtin_amdgcn_mfma_f32_32x32x16_bf16(b0, qr[d0], p0, 0, 0, 0);
                p1 = __builtin_amdgcn_mfma_f32_32x32x16_bf16(b1, qr[d0], p1, 0, 0, 0);
            }
            float pmax = p0[0];
#pragma unroll
            for (int r = 1; r < 16; ++r) pmax = fmaxf(pmax, p0[r]);
#pragma unroll
            for (int r = 0; r < 16; ++r) pmax = fmaxf(pmax, p1[r]);
            { auto rr = __builtin_amdgcn_permlane32_swap(__float_as_uint(pmax), __float_as_uint(pmax), false, false);
              pmax = fmaxf(__uint_as_float(rr[0]), __uint_as_float(rr[1])); }
            float mn, alpha;
            if (__builtin_expect(__all(pmax - m_reg <= THRL), 1)) { mn = m_reg; alpha = 1.f; }
            else { mn = fmaxf(m_reg, pmax); alpha = __builtin_amdgcn_exp2f(m_reg - mn); m_reg = mn; }
#pragma unroll
            for (int r = 0; r < 16; ++r) { p0[r] = __builtin_amdgcn_exp2f(p0[r] - mn); p1[r] = __builtin_amdgcn_exp2f(p1[r] - mn); }
            float ps = 0.f;
#pragma unroll
            for (int r = 0; r < 16; ++r) ps += p0[r];
#pragma unroll
            for (int r = 0; r < 16; ++r) ps += p1[r];
            { auto rr = __builtin_amdgcn_permlane32_swap(__float_as_uint(ps), __float_as_uint(ps), false, false);
              ps = __uint_as_float(rr[0]) + __uint_as_float(rr[1]); }
            l_reg = l_reg * alpha + ps;
            if (__any(alpha < 1.f)) { if (hi == 0) al_l[r32] = alpha; asm volatile("s_waitcnt lgkmcnt(0)" ::: "memory");
#pragma unroll
                for (int r = 0; r < 16; ++r) { const float a = al_l[crow(r, hi)];
#pragma unroll
                    for (int d = 0; d < 4; ++d) o[d][r] *= a; } }
            bf16x8 pa0, pa1, pa2, pa3;
#define PK4(P, BASE, OUT) do { unsigned a0 = cvt_pk_bf16(P[BASE + 0], P[BASE + 1]), a1 = cvt_pk_bf16(P[BASE + 2], P[BASE + 3]);   \
    unsigned b0_ = cvt_pk_bf16(P[BASE + 4], P[BASE + 5]), b1_ = cvt_pk_bf16(P[BASE + 6], P[BASE + 7]);                              \
    auto r0 = __builtin_amdgcn_permlane32_swap(a0, b0_, false, false); auto r1 = __builtin_amdgcn_permlane32_swap(a1, b1_, false, false); \
    u32x4 w = {r0[0], r1[0], r0[1], r1[1]}; OUT = __builtin_bit_cast(bf16x8, w); } while (0)
            PK4(p0, 0, pa0); PK4(p0, 8, pa1); PK4(p1, 0, pa2); PK4(p1, 8, pa3);
#undef PK4
            const int vb = vb0 + buf * VT_BYTES;
            pv_one<0>(o[0], vb, pa0, pa1, pa2, pa3); pv_one<1>(o[1], vb, pa0, pa1, pa2, pa3); pv_one<2>(o[2], vb, pa0, pa1, pa2, pa3); pv_one<3>(o[3], vb, pa0, pa1, pa2, pa3);
        }
    }
    if (hi == 0) li_l[r32] = l_reg; asm volatile("s_waitcnt lgkmcnt(0)" ::: "memory");
    bf16_t* Ow = O + (tok0 + (size_t)qb * 256 + wid * 32) * LDO + h * VH;
#pragma unroll
    for (int r = 0; r < 16; ++r) { const int orow = crow(r, hi); const float rl = __builtin_amdgcn_rcpf(li_l[orow]);
#pragma unroll
        for (int d0 = 0; d0 < 4; ++d0) Ow[(size_t)orow * LDO + d0 * 32 + r32] = (bf16_t)f2bf(o[d0][r] * rl); }
    asm volatile("s_waitcnt lgkmcnt(0)" ::: "memory"); __builtin_amdgcn_s_barrier(); asm volatile("" ::: "memory");
#undef ATT_DMA
}
#undef SBAR
}

#define XB_TMO      128
#define XB_XCNT(j)  (256  + 64 * (j))
#define XB_XSUB(j)  (1280 + 64 * (j))
#define XB_XGEN(j)  (2304 + 64 * (j))
#define XB_TOP      3328
#define XB_TOPGEN   3392
#define XCD_BAR_WORDS 3456
#define XB_SPIN_CAP (1u << 18)
__device__ __forceinline__ unsigned xb_ld(unsigned* p)              { return __hip_atomic_load(p, __ATOMIC_RELAXED, __HIP_MEMORY_SCOPE_AGENT); }
__device__ __forceinline__ unsigned xb_add(unsigned* p, unsigned v) { return __hip_atomic_fetch_add(p, v, __ATOMIC_RELAXED, __HIP_MEMORY_SCOPE_AGENT); }
__device__ __forceinline__ unsigned xb_xcc_id() { return (unsigned)__builtin_amdgcn_s_getreg((3 << 11) | 20) & 0xFu; }
#define XB_SPIN(cond, bar) do { unsigned _sp = 0; while (cond) { __builtin_amdgcn_s_sleep(1); \
    if ((++_sp & 255u) == 0u) { if (xb_ld(&(bar)[XB_TMO])) break; if (_sp > XB_SPIN_CAP) { atomicAdd(&(bar)[XB_TMO], 1u); break; } } } } while (0)
struct XcdBarrier { unsigned* bar; unsigned x; volatile LAS unsigned* st; };
__device__ __forceinline__ XcdBarrier xcd_barrier_post(unsigned* bar, volatile LAS unsigned* st) {
    XcdBarrier b; b.bar = bar; b.x = xb_xcc_id(); b.st = st;
    if (threadIdx.x == 0) (void)xb_add(&bar[XB_XCNT(b.x)], 1u);
    return b;
}
__device__ __forceinline__ void xcd_barrier_complete(unsigned* bar, unsigned x, unsigned& nloc, unsigned& nx) {
    const unsigned G = gridDim.x * gridDim.y * gridDim.z;
    unsigned sum, cnt, mine, sp = 0u;
    for (;;) {
        sum = 0u; cnt = 0u; mine = 0u;
#pragma unroll
        for (unsigned j = 0; j < 16; ++j) { const unsigned c = xb_ld(&bar[XB_XCNT(j)]); sum += c; cnt += (c > 0u) ? 1u : 0u; mine = (j == x) ? c : mine; }
        if (sum == G) break;
        __builtin_amdgcn_s_sleep(1);
        if ((++sp & 255u) == 0u) { if (xb_ld(&bar[XB_TMO])) break; if (sp > XB_SPIN_CAP) { atomicAdd(&bar[XB_TMO], 1u); break; } }
    }
    nloc = mine > 0u ? mine : 1u; nx = cnt > 0u ? cnt : 1u;
}
__device__ __forceinline__ void xcd_barrier(const XcdBarrier& b) {
    asm volatile("s_waitcnt vmcnt(0)" ::: "memory");
    __syncthreads();
    if (threadIdx.x == 0) {
        unsigned* bar = b.bar;
        __builtin_amdgcn_s_waitcnt(0);
        unsigned nloc = b.st[0], nx = b.st[1];
        if (nloc == 0u) { xcd_barrier_complete(bar, b.x, nloc, nx); b.st[0] = nloc; b.st[1] = nx; }
        const unsigned old = xb_add(&bar[XB_XSUB(b.x)], 1u);
        const unsigned gen = old / nloc;
        if (old + 1u == (gen + 1u) * nloc) {
            __builtin_amdgcn_fence(__ATOMIC_RELEASE, "agent");
            asm volatile("s_waitcnt vmcnt(0)" ::: "memory");
            const unsigned og = xb_add(&bar[XB_TOP], 1u);
            const unsigned tg = og / nx;
            if (og + 1u == (tg + 1u) * nx) xb_add(&bar[XB_TOPGEN], 1u);
            else XB_SPIN(xb_ld(&bar[XB_TOPGEN]) == tg, bar);
            __builtin_amdgcn_fence(__ATOMIC_ACQUIRE, "agent");
            xb_add(&bar[XB_XGEN(b.x)], 1u);
            asm volatile("s_waitcnt vmcnt(0)" ::: "memory");
        } else {
            XB_SPIN(xb_ld(&bar[XB_XGEN(b.x)]) == gen, bar);
            __builtin_amdgcn_fence(__ATOMIC_ACQUIRE, "agent");
            asm volatile("s_waitcnt vmcnt(0)" ::: "memory");
        }
    }
    __syncthreads();
}

constexpr int NWAVES = 8;
constexpr int N_LAUNCHES = MK_N_LAUNCHES;
constexpr int N_PHASES = 10;
struct Args { const float* in[18]; float* out; unsigned char* ws; int ph_lo, ph_hi; };

__device__ __forceinline__ void p0_transpose_item(const float* W, int K, int N, bf16_t* WT, int drow0, const float* kscale, LAS unsigned* scr, int k0, int n0, int lane) {
    const int g = lane >> 4, l16 = lane & 15;
    f32x4 v[16];
#pragma unroll
    for (int i = 0; i < 16; ++i) { const int kk = (i >> 1) * 8 + g * 2 + (i & 1); v[i] = *(const f32x4*)(W + (size_t)(k0 + kk) * N + n0 + 4 * l16); }
    if (kscale) {
#pragma unroll
        for (int i = 0; i < 16; ++i) { const int kk = (i >> 1) * 8 + g * 2 + (i & 1); v[i] = v[i] * kscale[k0 + kk]; } }
#pragma unroll
    for (int j = 0; j < 8; ++j) { const int kp = j * 4 + g;
#pragma unroll
        for (int c = 0; c < 4; ++c) scr[(4 * l16 + c) * 33 + kp] = cvt_pk_bf16(v[2 * j][c], v[2 * j + 1][c]); }
    LDS_WAIT(); asm volatile("" ::: "memory");
    const int c8 = lane & 7;
#pragma unroll
    for (int jj = 0; jj < 8; ++jj) { const int n = jj * 8 + (lane >> 3); const LAS unsigned* t = scr + n * 33 + 4 * c8;
        u32x4 o; o.x = t[0]; o.y = t[1]; o.z = t[2]; o.w = t[3];
        *(u32x4*)(WT + (size_t)(drow0 + n) * K + k0 + 8 * c8) = o; }
    LDS_WAIT(); asm volatile("" ::: "memory");
}

__device__ __forceinline__ void p0_transpose_item8(const float* W, int K, int N, unsigned char* WT, int drow0, const float* kscale, LAS unsigned* scr, int k0, int n0, int lane) {
    const int g = lane >> 4, l16 = lane & 15;
    f32x4 v[32];
#pragma unroll
    for (int i = 0; i < 32; ++i) { const int kk = (i >> 2) * 16 + g * 4 + (i & 3); v[i] = *(const f32x4*)(W + (size_t)(k0 + kk) * N + n0 + 4 * l16); }
#pragma unroll
    for (int i = 0; i < 32; ++i) { const int kk = (i >> 2) * 16 + g * 4 + (i & 3); v[i] = v[i] * (kscale ? kscale[k0 + kk] * W8_SCALE : W8_SCALE); }
#pragma unroll
    for (int j = 0; j < 8; ++j) { const int kd = j * 4 + g;
#pragma unroll
        for (int c = 0; c < 4; ++c) scr[(4 * l16 + c) * 33 + kd] = pk4_fp8(v[4 * j][c], v[4 * j + 1][c], v[4 * j + 2][c], v[4 * j + 3][c]); }
    LDS_WAIT(); asm volatile("" ::: "memory");
    const int c8 = lane & 7;
#pragma unroll
    for (int jj = 0; jj < 8; ++jj) { const int n = jj * 8 + (lane >> 3); const LAS unsigned* t = scr + n * 33 + 4 * c8;
        u32x4 o; o.x = t[0]; o.y = t[1]; o.z = t[2]; o.w = t[3];
        *(u32x4*)(WT + (size_t)(drow0 + n) * K + k0 + 16 * c8) = o; }
    LDS_WAIT(); asm volatile("" ::: "memory");
}

template <int PHMASK> __global__ void __launch_bounds__(NWAVES * 64, 2) fwd_kernel_t(Args args) {
    extern __shared__ __attribute__((aligned(16))) unsigned char lds_raw[];
    LAS unsigned char* lds = (LAS unsigned char*)lds_raw;
    volatile LAS unsigned* MISC = (volatile LAS unsigned*)(lds + MISC_OFF);
    const int tid = threadIdx.x, lane = tid & 63, wave = __builtin_amdgcn_readfirstlane(tid >> 6);
    const int G = gridDim.x; const int bx = blockIdx.x; const int vcu = (G % 8 == 0) ? (bx % 8) * (G / 8) + bx / 8 : bx;
    unsigned char* ws = args.ws;
    unsigned* ctl = (unsigned*)(ws + WS_CTL);
    const float* x = args.in[0]; const float* norm_mix = args.in[1]; const float* w_in = args.in[2]; const float* conv_w = args.in[3];
    const float* q_norm = args.in[4]; const float* w_uq = args.in[5]; const float* kv_norm = args.in[6]; const float* w_ukv = args.in[7];
    const float* q_head_norm = args.in[8]; const float* k_head_norm = args.in[9]; const float* w_o = args.in[10]; const float* norm_ffn = args.in[11];
    const float* w_router = args.in[12]; const float* b_router = args.in[13]; const float* w_gate_up = args.in[14]; const float* b_gate_up = args.in[15];
    const float* w_down = args.in[16]; const float* b_down = args.in[17];
    float* out = args.out;
    f32x2* rope_t = (f32x2*)(ws + WS_ROPE);
    bf16_t* WrH = (bf16_t*)(ws + WS_WRH); bf16_t* WrL = (bf16_t*)(ws + WS_WRL);
    bf16_t* Win_t = (bf16_t*)(ws + WS_WIN); bf16_t* Wuq_t = (bf16_t*)(ws + WS_WUQ); bf16_t* Wukv_t = (bf16_t*)(ws + WS_WUKV); bf16_t* Wo_t = (bf16_t*)(ws + WS_WO);
    float* ssq = (float*)(ws + WS_SSQ); float* rs2 = (float*)(ws + WS_RS2); float* gate = (float*)(ws + WS_GATE); int* tos = (int*)(ws + WS_TOS);
    unsigned char* Wgu_t = ws + WS_WGU; unsigned char* Wdn_t = ws + WS_WDN;
    unsigned char* hq = ws + WS_HB;
    bf16_t* qb_ = (bf16_t*)(ws + WS_Q); bf16_t* kb_ = (bf16_t*)(ws + WS_K); bf16_t* vb_ = (bf16_t*)(ws + WS_V); bf16_t* mix = (bf16_t*)(ws + WS_MIX);
    bf16_t* oslot = (bf16_t*)(ws + WS_OSLOT); bf16_t* hn = (bf16_t*)(ws + WS_HN); bf16_t* pbuf = (bf16_t*)(ws + WS_PB); bf16_t* qraw = (bf16_t*)(ws + WS_QRAW); bf16_t* kvraw = (bf16_t*)(ws + WS_KVRAW);
    unsigned char* act = ws + WS_ACT;

    for (int u = tid; u < (LDS_BYTES - MISC_OFF) / 4; u += NWAVES * 64) ((LAS unsigned*)(lds + MISC_OFF))[u] = 0u;
    __syncthreads();
    XcdBarrier bar; bar.bar = ctl + CW_BAR; bar.x = 0; bar.st = nullptr;
    if (N_LAUNCHES == 1) bar = xcd_barrier_post(ctl + CW_BAR, MISC + 8);
#define GRID_BAR() do { if (N_LAUNCHES == 1) xcd_barrier(bar); } while (0)
    const int lo = args.ph_lo, hi = args.ph_hi;
#define IN(k) (((PHMASK >> (k)) & 1) && lo <= (k) && (k) < hi)
#define BOTH(k) (IN(k) && IN((k) + 1))
    const int gw = vcu * NWAVES + wave, NGW = G * NWAVES;

    if (IN(0)) {
        LAS unsigned* scr = (LAS unsigned*)(lds + wave * 16384);
        constexpr int I_IN = (DM / 64) * (NPROJ / 64), I_UQ = (QL / 64) * (768 / 64), I_UKV = (KVL / 64) * (1024 / 64), I_O = (DM / 64) * (DM / 64);
        constexpr int I_GU1 = (DM / 128) * (2 * DFF / 64), I_GU = NE * I_GU1, I_DN1 = (DFF / 128) * (DM / 64), I_DN = NE * I_DN1;
        constexpr int NITEMS = I_IN + I_UQ + I_UKV + I_O + I_GU + I_DN;
        for (int it = gw; it < NITEMS; it += NGW) {
            int r = it;
            if (r < I_GU) { const int e = r / I_GU1, q = r % I_GU1, nblk = 2 * DFF / 64, kb = q / nblk, nb = q % nblk, n0 = nb * 64, j = n0 & (DFF - 1), up = n0 >= DFF;
                p0_transpose_item8(w_gate_up + (size_t)e * DM * 2 * DFF, DM, 2 * DFF, Wgu_t + (size_t)e * 2 * DFF * DM, (j >> 7) * 256 + (j & 127) + (up ? 128 : 0), norm_ffn, scr, kb * 128, n0, lane); continue; } r -= I_GU;
            if (r < I_DN) { const int e = r / I_DN1, q = r % I_DN1, nblk = DM / 64, kb = q / nblk, nb = q % nblk;
                p0_transpose_item8(w_down + (size_t)e * DFF * DM, DFF, DM, Wdn_t + (size_t)e * DM * DFF, nb * 64, nullptr, scr, kb * 128, nb * 64, lane); continue; } r -= I_DN;
            if (r < I_IN) { const int nblk = NPROJ / 64, kb = r / nblk, nb = r % nblk; p0_transpose_item(w_in, DM, NPROJ, Win_t, nb * 64, nullptr, scr, kb * 64, nb * 64, lane); continue; } r -= I_IN;
            if (r < I_UQ) { const int nblk = 768 / 64, kb = r / nblk, nb = r % nblk; p0_transpose_item(w_uq, QL, 768, Wuq_t, nb * 64, q_norm, scr, kb * 64, nb * 64, lane); continue; } r -= I_UQ;
            if (r < I_UKV) { const int nblk = 1024 / 64, kb = r / nblk, nb = r % nblk; p0_transpose_item(w_ukv, KVL, 1024, Wukv_t, nb * 64, kv_norm, scr, kb * 64, nb * 64, lane); continue; } r -= I_UKV;
            { const int nblk = DM / 64, kb = r / nblk, nb = r % nblk; p0_transpose_item(w_o, DM, DM, Wo_t, nb * 64, nullptr, scr, kb * 64, nb * 64, lane); }
        }
        const int gt = vcu * (NWAVES * 64) + tid, NGT = G * NWAVES * 64;
        for (int i = gt; i < (NPP - NPROJ) * DM / 8; i += NGT) *(u32x4*)(Win_t + (size_t)NPROJ * DM + (size_t)i * 8) = (u32x4){0u, 0u, 0u, 0u};
        for (int i = gt; i < NE * DM; i += NGT) { const int e = i / DM, k = i % DM; const float v = w_router[(size_t)k * NE + e] * norm_ffn[k]; const unsigned h = f2bf(v); const float hf = __builtin_bit_cast(float, h << 16);
            WrH[i] = (bf16_t)h; WrL[i] = (bf16_t)f2bf(v - hf); }
        for (int i = gt; i < SEQ * 32; i += NGT) { const int pos = i >> 5, fi = i & 31; const float inv = exp2f(-(float)fi * (13.287712379549449f / 32.f)); const float ang = (float)pos * inv; float s, c; sincosf(ang, &s, &c); rope_t[i] = (f32x2){c, s}; }
        for (int m = 2 * gw; m < NTOK; m += 2 * NGW) {
            const f32x4* xr = (const f32x4*)(x + (size_t)m * DM) + lane; const f32x4* gr = (const f32x4*)norm_mix + lane;
            f32x4 v[2][4]; float s0 = 0.f, s1 = 0.f;
#pragma unroll
            for (int j = 0; j < 4; ++j) { v[0][j] = xr[64 * j]; v[1][j] = xr[DM / 4 + 64 * j]; }
#pragma unroll
            for (int j = 0; j < 4; ++j) { s0 += (v[0][j].x * v[0][j].x + v[0][j].y * v[0][j].y) + (v[0][j].z * v[0][j].z + v[0][j].w * v[0][j].w);
                                          s1 += (v[1][j].x * v[1][j].x + v[1][j].y * v[1][j].y) + (v[1][j].z * v[1][j].z + v[1][j].w * v[1][j].w); }
            const float r0 = 1.0f / sqrtf(wave_sum(s0) * (1.f / DM) + EPS), r1 = 1.0f / sqrtf(wave_sum(s1) * (1.f / DM) + EPS);
            u32x2* o8 = (u32x2*)(hn + (size_t)m * DM) + lane;
#pragma unroll
            for (int j = 0; j < 4; ++j) { const f32x4 g = gr[64 * j]; u32x2 w;
                w.x = cvt_pk_bf16(v[0][j].x * r0 * g.x, v[0][j].y * r0 * g.y); w.y = cvt_pk_bf16(v[0][j].z * r0 * g.z, v[0][j].w * r0 * g.w); o8[64 * j] = w;
                w.x = cvt_pk_bf16(v[1][j].x * r1 * g.x, v[1][j].y * r1 * g.y); w.y = cvt_pk_bf16(v[1][j].z * r1 * g.z, v[1][j].w * r1 * g.w); o8[DM / 4 + 64 * j] = w; }
        }
        if (BOTH(0)) GRID_BAR();
    }

    if (IN(1)) {
        pg8::DenseSched S; S.init(hn, DM, Win_t, NTOK, NPP, DM, G, bx);
        pg8::EpiBf16 E{pbuf, NPP};
        pg8::gemm_phase<pg8::EpiBf16, pg8::DenseSched, false>(lds, S, E);
        if (BOTH(1)) GRID_BAR();
    }

    if (IN(2)) {
        {
            const int gt = vcu * (NWAVES * 64) + tid, NGT = G * NWAVES * 64;
            for (int it = gt; it < (NTOK / 16) * 64; it += NGT) {
                const int run = it >> 6, gr = it & 63, t0 = run * 16, ch = gr * 8;
                float w0[8], w1[8], w2[8];
#pragma unroll
                for (int i = 0; i < 8; ++i) { w0[i] = conv_w[ch + i]; w1[i] = conv_w[CONVW + ch + i]; w2[i] = conv_w[2 * CONVW + ch + i]; }
                float um2[8], um1[8];
#pragma unroll
                for (int i = 0; i < 8; ++i) { um2[i] = 0.f; um1[i] = 0.f; }
                if ((t0 & (SEQ - 1)) != 0) {
                    float c8[8], x8[8];
                    unpack8(*(const u32x4*)(pbuf + (size_t)(t0 - 2) * NPP + PB_C + ch), c8); unpack8(*(const u32x4*)(pbuf + (size_t)(t0 - 2) * NPP + PB_X + ch), x8);
#pragma unroll
                    for (int i = 0; i < 8; ++i) um2[i] = c8[i] * x8[i];
                    unpack8(*(const u32x4*)(pbuf + (size_t)(t0 - 1) * NPP + PB_C + ch), c8); unpack8(*(const u32x4*)(pbuf + (size_t)(t0 - 1) * NPP + PB_X + ch), x8);
#pragma unroll
                    for (int i = 0; i < 8; ++i) um1[i] = c8[i] * x8[i];
                }
#pragma unroll 4
                for (int t = 0; t < 16; ++t) {
                    const bf16_t* pr = pbuf + (size_t)(t0 + t) * NPP + ch;
                    float b8[8], c8[8], x8[8], o8[8];
                    unpack8(*(const u32x4*)(pr + PB_B), b8); unpack8(*(const u32x4*)(pr + PB_C), c8); unpack8(*(const u32x4*)(pr + PB_X), x8);
#pragma unroll
                    for (int i = 0; i < 8; ++i) { const float uu = c8[i] * x8[i]; o8[i] = b8[i] * (w0[i] * um2[i] + w1[i] * um1[i] + w2[i] * uu); um2[i] = um1[i]; um1[i] = uu; }
                    *(u32x4*)(mix + (size_t)(t0 + t) * DM + ch) = pack8(o8);
                }
            }
        }
        { pg8::DenseSched S; S.init(pbuf + PB_CQ, NPP, Wuq_t, NTOK, 768, QL, G, bx); pg8::EpiBf16 E{qraw, 768};
          pg8::gemm_phase<pg8::EpiBf16, pg8::DenseSched, false>(lds, S, E); }
        { pg8::DenseSched S; S.init(pbuf + PB_CKV, NPP, Wukv_t, NTOK, 1024, KVL, G, G - 1 - bx); pg8::EpiBf16 E{kvraw, 1024};
          pg8::gemm_phase<pg8::EpiBf16, pg8::DenseSched, false>(lds, S, E); }
        if (BOTH(2)) GRID_BAR();
    }

    if (IN(3)) {
        const int li = lane & 31, hsel = lane >> 5; const bool actv = li < 24, roped = actv && li >= 16;
        const int partner = (li < 20) ? lane + 4 : lane - 4;
        float qg[8], kg[8];
#pragma unroll
        for (int i = 0; i < 8; ++i) { qg[i] = actv ? q_head_norm[li * 8 + i] * QSCALE : 0.f; kg[i] = actv ? k_head_norm[li * 8 + i] : 0.f; }
        struct RowBuf { u32x4 cq, ckv, qr[2], ks[2], vs[2]; f32x4 cs[4]; };
        const u32x4 z4 = {0u, 0u, 0u, 0u};
#define P3_LOAD(B, m_) do { const int mm_ = (m_); const bf16_t* pb_ = pbuf + (size_t)mm_ * NPP; \
            B.cq = (lane < 48) ? *(const u32x4*)(pb_ + PB_CQ + lane * 8) : z4; B.ckv = (lane < 32) ? *(const u32x4*)(pb_ + PB_CKV + lane * 8) : z4; \
            _Pragma("unroll") for (int hp_ = 0; hp_ < 2; ++hp_) { const int hh_ = 2 * hp_ + hsel; \
                B.qr[hp_] = actv ? *(const u32x4*)(qraw + (size_t)mm_ * 768 + hh_ * QKH + li * 8) : z4; \
                B.ks[hp_] = (li < 16) ? *(const u32x4*)(kvraw + (size_t)mm_ * 1024 + hh_ * 256 + li * 8) : (actv ? *(const u32x4*)(pb_ + PB_KPE + (li - 16) * 8) : z4); \
                B.vs[hp_] = (li < 16) ? *(const u32x4*)(kvraw + (size_t)mm_ * 1024 + hh_ * 256 + 128 + li * 8) : z4; } \
            _Pragma("unroll") for (int c_ = 0; c_ < 4; ++c_) B.cs[c_] = roped ? *((const f32x4*)(rope_t + (mm_ & (SEQ - 1)) * 32 + (li & 3) * 8) + c_) : (f32x4){1.f, 0.f, 1.f, 0.f}; } while (0)
#define P3_ROPE(v) do { float ot_[8]; _Pragma("unroll") for (int i = 0; i < 8; ++i) ot_[i] = __shfl(v[i], partner); \
            if (roped) { if (li < 20) { _Pragma("unroll") for (int i = 0; i < 8; ++i) v[i] = v[i] * cs[2 * i] - ot_[i] * cs[2 * i + 1]; } \
                         else { _Pragma("unroll") for (int i = 0; i < 8; ++i) v[i] = ot_[i] * cs[2 * i + 1] + v[i] * cs[2 * i]; } } } while (0)
#define P3_COMPUTE(B, m_) do { const int mm_ = (m_); float t8[8]; float sq = 0.f, skv = 0.f; \
            unpack8(B.cq, t8); _Pragma("unroll") for (int i = 0; i < 8; ++i) sq += t8[i] * t8[i]; \
            unpack8(B.ckv, t8); _Pragma("unroll") for (int i = 0; i < 8; ++i) skv += t8[i] * t8[i]; \
            const float rs_q = 1.0f / sqrtf(wave_sum(sq) * (1.f / QL) + EPS), rs_kv = 1.0f / sqrtf(wave_sum(skv) * (1.f / KVL) + EPS); \
            float cs[16]; _Pragma("unroll") for (int c_ = 0; c_ < 4; ++c_) { cs[4 * c_] = B.cs[c_][0]; cs[4 * c_ + 1] = B.cs[c_][1]; cs[4 * c_ + 2] = B.cs[c_][2]; cs[4 * c_ + 3] = B.cs[c_][3]; } \
            _Pragma("unroll") for (int hp_ = 0; hp_ < 2; ++hp_) { const int hh_ = 2 * hp_ + hsel; float v[8]; \
                unpack8(B.qr[hp_], v); _Pragma("unroll") for (int i = 0; i < 8; ++i) v[i] *= rs_q; \
                float ss = 0.f; _Pragma("unroll") for (int i = 0; i < 8; ++i) ss += v[i] * v[i]; \
                float r = 1.0f / sqrtf(half_sum(ss) * (1.f / QKH) + EPS); \
                _Pragma("unroll") for (int i = 0; i < 8; ++i) v[i] = v[i] * r * qg[i]; \
                P3_ROPE(v); \
                if (actv) *(u32x4*)(qb_ + (size_t)mm_ * 768 + hh_ * QKH + li * 8) = pack8(v); \
                unpack8(B.ks[hp_], v); if (li < 16) { _Pragma("unroll") for (int i = 0; i < 8; ++i) v[i] *= rs_kv; } \
                ss = 0.f; _Pragma("unroll") for (int i = 0; i < 8; ++i) ss += v[i] * v[i]; \
                r = 1.0f / sqrtf(half_sum(ss) * (1.f / QKH) + EPS); \
                _Pragma("unroll") for (int i = 0; i < 8; ++i) v[i] = v[i] * r * kg[i]; \
                P3_ROPE(v); \
                if (actv) *(u32x4*)(kb_ + (size_t)mm_ * 768 + hh_ * QKH + li * 8) = pack8(v); \
                if (li < 16) { unpack8(B.vs[hp_], v); _Pragma("unroll") for (int i = 0; i < 8; ++i) v[i] *= rs_kv; \
                    *(u32x4*)(vb_ + (size_t)mm_ * 512 + hh_ * VH + li * 8) = pack8(v); } } } while (0)
        RowBuf A, B;
        int m = gw;
        if (m < NTOK) P3_LOAD(A, m);
        while (m < NTOK) {
            const int m1 = m + NGW, m2 = m + 2 * NGW;
            if (m1 < NTOK) P3_LOAD(B, m1);
            P3_COMPUTE(A, m);
            if (m1 >= NTOK) break;
            if (m2 < NTOK) P3_LOAD(A, m2);
            P3_COMPUTE(B, m1);
            m = m2;
        }
#undef P3_LOAD
#undef P3_ROPE
#undef P3_COMPUTE
        if (BOTH(3)) GRID_BAR();
    }

    if (IN(4)) {
        for (int u = vcu; u < NB * NH * 4; u += G) {
            const int bh = u >> 2, pr = u & 3, b = bh >> 2, h = bh & 3;
            att::attn_unit(b, h, 7 - pr, qb_, kb_, vb_, mix + CONVW, lds);
            att::attn_unit(b, h, pr, qb_, kb_, vb_, mix + CONVW, lds);
        }
        if (BOTH(4)) GRID_BAR();
    }

    if (IN(5)) {
        pg8::DenseSched S; S.init(mix, DM, Wo_t, NTOK, DM, DM, G, bx);
        pg8::EpiOut E{x, out, ssq};
        pg8::gemm_phase<pg8::EpiOut, pg8::DenseSched, false>(lds, S, E);
        if (BOTH(5)) GRID_BAR();
    }

    if (IN(6)) {
        LAS unsigned* hist = (LAS unsigned*)(lds + MISC_OFF) + 128; LAS unsigned* base = (LAS unsigned*)(lds + MISC_OFF) + 160;
        const int tj = lane & 15, q = lane >> 4;
        for (int tile = vcu; tile < NTOK / 128; tile += G) {
            if (tid < 32) hist[tid] = 0u;
            __syncthreads();
            const int token = tile * 128 + wave * 16 + tj;
            const float* hrow = out + (size_t)token * DM + q * 8;
            const bf16_t* wh0 = WrH + (size_t)tj * DM + q * 8; const bf16_t* wl0 = WrL + (size_t)tj * DM + q * 8;
            f32x4 a0 = {0.f, 0.f, 0.f, 0.f}, a1 = {0.f, 0.f, 0.f, 0.f};
            float s2 = 0.f;
#pragma unroll
            for (int p = 0; p < 16; ++p) s2 += ssq[(size_t)p * NTOK + token];
            const float rs = 1.0f / sqrtf(s2 * (1.f / DM) + EPS);
            unsigned char* hqrow = hq + (size_t)token * DM + q * 8;
#pragma unroll 4
            for (int ks = 0; ks < DM / 32; ++ks) {
                const f32x4 h0 = *(const f32x4*)(hrow + ks * 32), h1 = *(const f32x4*)(hrow + ks * 32 + 4);
                float hf[8] = {h0[0], h0[1], h0[2], h0[3], h1[0], h1[1], h1[2], h1[3]}; float lf[8];
                { u32x2 w8; w8.x = pk4_fp8(hf[0] * rs, hf[1] * rs, hf[2] * rs, hf[3] * rs); w8.y = pk4_fp8(hf[4] * rs, hf[5] * rs, hf[6] * rs, hf[7] * rs); *(u32x2*)(hqrow + ks * 32) = w8; }
                u32x4 hw; hw.x = pk2(hf[0], hf[1]); hw.y = pk2(hf[2], hf[3]); hw.z = pk2(hf[4], hf[5]); hw.w = pk2(hf[6], hf[7]);
                { float hb8[8]; unpack8(hw, hb8);
#pragma unroll
                  for (int i = 0; i < 8; ++i) lf[i] = hf[i] - hb8[i]; }
                const bf16x8 bh = __builtin_bit_cast(bf16x8, hw), bl = __builtin_bit_cast(bf16x8, pack8(lf));
                const bf16x8 wh_a = *(const bf16x8*)(wh0 + ks * 32), wh_b = *(const bf16x8*)(wh0 + 16 * DM + ks * 32);
                const bf16x8 wl_a = *(const bf16x8*)(wl0 + ks * 32), wl_b = *(const bf16x8*)(wl0 + 16 * DM + ks * 32);
                a0 = __builtin_amdgcn_mfma_f32_16x16x32_bf16(wh_a, bh, a0, 0, 0, 0); a0 = __builtin_amdgcn_mfma_f32_16x16x32_bf16(wl_a, bh, a0, 0, 0, 0); a0 = __builtin_amdgcn_mfma_f32_16x16x32_bf16(wh_a, bl, a0, 0, 0, 0);
                a1 = __builtin_amdgcn_mfma_f32_16x16x32_bf16(wh_b, bh, a1, 0, 0, 0); a1 = __builtin_amdgcn_mfma_f32_16x16x32_bf16(wl_b, bh, a1, 0, 0, 0); a1 = __builtin_amdgcn_mfma_f32_16x16x32_bf16(wh_b, bl, a1, 0, 0, 0);
            }
            float lv[8]; int le[8];
#pragma unroll
            for (int i = 0; i < 4; ++i) { le[i] = 4 * q + i; le[4 + i] = 16 + 4 * q + i; lv[i] = a0[i] * rs + b_router[le[i]]; lv[4 + i] = a1[i] * rs + b_router[le[4 + i]]; }
            float tv[4]; int te[4];
#pragma unroll
            for (int k = 0; k < TOPK; ++k) {
                float bv = lv[0]; int be = le[0];
#pragma unroll
                for (int i = 1; i < 8; ++i) if (lv[i] > bv) { bv = lv[i]; be = le[i]; }
#pragma unroll
                for (int o = 16; o < 64; o <<= 1) { const float ov = __shfl_xor(bv, o); const int oe = __shfl_xor(be, o); if (ov > bv || (ov == bv && oe < be)) { bv = ov; be = oe; } }
                tv[k] = bv; te[k] = be;
#pragma unroll
                for (int i = 0; i < 8; ++i) if (le[i] == be) lv[i] = -3.0e38f;
            }
            float ge[4]; float gs = 0.f;
#pragma unroll
            for (int k = 0; k < TOPK; ++k) { ge[k] = __expf(tv[k] - tv[0]); gs += ge[k]; }
            const float ginv = 1.0f / gs;
            int my_e = te[0]; float my_g = ge[0];
#pragma unroll
            for (int k = 1; k < TOPK; ++k) if (q == k) { my_e = te[k]; my_g = ge[k]; }
            my_g *= ginv;
            const unsigned pl = atomicAdd((unsigned*)(hist + my_e), 1u);
            __syncthreads();
            if (tid < 32) base[tid] = __hip_atomic_fetch_add(ctl + CW_CNT + 64 * tid, hist[tid], __ATOMIC_RELAXED, __HIP_MEMORY_SCOPE_AGENT);
            __syncthreads();
            const unsigned pos = base[my_e] + pl; const int slot = token * 4 + q;
            tos[(size_t)my_e * CAP + pos] = slot; gate[slot] = my_g;
            __syncthreads();
        }
        if (BOTH(6)) GRID_BAR();
    }

    LAS int* tab = (LAS int*)(lds + MISC_OFF) + 16;
    if (IN(7) || IN(8)) {
        if (tid < 32) { const int c = (int)__hip_atomic_load(ctl + CW_CNT + 64 * tid, __ATOMIC_RELAXED, __HIP_MEMORY_SCOPE_AGENT); tab[48 + tid] = c; }
        __syncthreads();
        if (tid == 0) { int s = 0; for (int e = 0; e < NE; ++e) { tab[e] = s; s += (tab[48 + e] + 255) >> 8; } tab[32] = s; }
        __syncthreads();
    }

    if (IN(7)) {
        pg8::MoeSched S{hq, Wgu_t, DM, DM, 2 * DFF / 256, G, bx, (size_t)2 * DFF * DM, tab, tos};
        pg8::EpiSwiglu E{act, b_gate_up};
        pg8::gemm_phase<pg8::EpiSwiglu, pg8::MoeSched, true>(lds, S, E);
        if (BOTH(7)) GRID_BAR();
    }

    if (IN(8)) {
        pg8::MoeSched S{act, Wdn_t, DFF, DFF, DM / 256, G, bx, (size_t)DM * DFF, tab, tos};
        pg8::EpiDown E{oslot, b_down, gate, tos};
        pg8::gemm_phase<pg8::EpiDown, pg8::MoeSched, false>(lds, S, E);
        if (BOTH(8)) GRID_BAR();
    }

    if (IN(9)) {
        for (int m = gw; m < NTOK; m += NGW) {
            f32x4* orow = (f32x4*)(out + (size_t)m * DM) + lane;
            const u32x2* s0 = (const u32x2*)(oslot + (size_t)m * 4 * DM) + lane;
#pragma unroll
            for (int j = 0; j < 4; ++j) { f32x4 v = orow[64 * j];
#pragma unroll
                for (int k = 0; k < 4; ++k) { const u32x2 w = s0[(size_t)k * (DM / 4) + 64 * j]; v.x += bf_lo(w.x); v.y += bf_hi(w.x); v.z += bf_lo(w.y); v.w += bf_hi(w.y); }
                orow[64 * j] = v; }
        }
    }
#undef IN
#undef BOTH
#undef GRID_BAR
}

#ifdef DIAG_PHASES
template __global__ void fwd_kernel_t<1>(Args); template __global__ void fwd_kernel_t<2>(Args); template __global__ void fwd_kernel_t<4>(Args); template __global__ void fwd_kernel_t<8>(Args);
template __global__ void fwd_kernel_t<16>(Args); template __global__ void fwd_kernel_t<32>(Args); template __global__ void fwd_kernel_t<64>(Args); template __global__ void fwd_kernel_t<128>(Args);
template __global__ void fwd_kernel_t<256>(Args); template __global__ void fwd_kernel_t<512>(Args);
#endif
#define fwd_kernel fwd_kernel_t<1023>
extern "C" void kernel_launch(void* const* d_in, const int* in_sizes, int n_in, void* d_out, int out_size, void* d_ws, size_t ws_size, hipStream_t stream) {
    static int grid = 0;
    if (grid == 0) {
        if (n_in != 18 || in_sizes[0] != NTOK * DM || out_size != NTOK * DM || ws_size < WS_END) { fprintf(stderr, "kernel_launch: shape/workspace mismatch (n_in %d, in0 %d, out %d, ws %zu, need %zu)\n", n_in, n_in > 0 ? in_sizes[0] : -1, out_size, ws_size, (size_t)WS_END); grid = -1; return; }
        int dev = 0, cus = 0, per_cu = 0;
        if (hipGetDevice(&dev) != hipSuccess || hipDeviceGetAttribute(&cus, hipDeviceAttributeMultiprocessorCount, dev) != hipSuccess) { grid = -1; return; }
        if (hipFuncSetAttribute((const void*)fwd_kernel, hipFuncAttributeMaxDynamicSharedMemorySize, LDS_BYTES) != hipSuccess) { fprintf(stderr, "kernel_launch: hipFuncSetAttribute failed\n"); grid = -1; return; }
        if (hipOccupancyMaxActiveBlocksPerMultiprocessor(&per_cu, (const void*)fwd_kernel, NWAVES * 64, LDS_BYTES) != hipSuccess || per_cu < 1) { fprintf(stderr, "kernel_launch: occupancy query says %d\n", per_cu); }
        (void)hipGetLastError();
        grid = cus;
    }
    if (grid < 0) return;
    if (hipMemsetAsync((char*)d_ws + WS_CTL, 0, CTL_ZERO_BYTES, stream) != hipSuccess) return;
    Args a{};
    for (int i = 0; i < 18; ++i) a.in[i] = (const float*)d_in[i];
    a.out = (float*)d_out; a.ws = (unsigned char*)d_ws;
    if (N_LAUNCHES == 1) { a.ph_lo = 0; a.ph_hi = N_PHASES; hipLaunchKernelGGL(fwd_kernel, dim3(grid), dim3(NWAVES * 64), LDS_BYTES, stream, a); }
    else { for (int p = 0; p < N_PHASES; ++p) { a.ph_lo = p; a.ph_hi = p + 1; const int reps = ((PROBE_DOUBLE >> p) & 1) ? 2 : 1;
            for (int r = 0; r < reps; ++r) hipLaunchKernelGGL(fwd_kernel, dim3(grid), dim3(NWAVES * 64), LDS_BYTES, stream, a); } }
}
```

```cpp
#include <hip/hip_runtime.h>
#include <cstdio>
#include <cstdint>

#ifndef MK_N_LAUNCHES
#define MK_N_LAUNCHES 1
#endif

#ifndef PROBE_DOUBLE
#define PROBE_DOUBLE 0
#endif
#define LAS __attribute__((address_space(3)))
#define GAS __attribute__((address_space(1)))
typedef unsigned short bf16_t;
typedef short bf16x8 __attribute__((ext_vector_type(8)));
typedef short s16x4 __attribute__((ext_vector_type(4)));
typedef float f32x2 __attribute__((ext_vector_type(2)));
typedef float f32x4 __attribute__((ext_vector_type(4)));
typedef float f32x16 __attribute__((ext_vector_type(16)));
typedef unsigned u32x2 __attribute__((ext_vector_type(2)));
typedef unsigned u32x4 __attribute__((ext_vector_type(4)));
typedef int v4i_t __attribute__((ext_vector_type(4)));
typedef int v8i_t __attribute__((ext_vector_type(8)));

constexpr int NB = 16, SEQ = 2048, NTOK = NB * SEQ, DM = 1024;
constexpr int CONVW = 512, QL = 384, KVL = 256, ROPE = 64, NH = 4, QKN = 128, QKH = 192, VH = 128;
constexpr int NPROJ = 2240, NPP = 2304;
constexpr int PB_B = 0, PB_C = 512, PB_X = 1024, PB_CKV = 1536, PB_CQ = 1792, PB_KPE = 2176;
constexpr int NQP = 1024;
constexpr int NE = 32, TOPK = 4, DFF = 1024, NSLOT = NTOK * TOPK;
constexpr int CAP = NTOK;
constexpr int MAXTILES = NSLOT / 256 + NE;
constexpr float EPS = 1e-6f;
constexpr float QSCALE = 0.07216878364870322f * 1.4426950408889634f;
constexpr float SWI_LIMIT = 7.0f, SWI_ALPHA = 1.702f;
constexpr float W8_SCALE = 64.f, ACT8_SCALE = 4.f;

constexpr size_t MiB = 1u << 20;
constexpr size_t WS_CTL = 0, CTL_ZERO_BYTES = 1 * MiB;
constexpr size_t WS_ROPE = 1 * MiB;
constexpr size_t WS_WRH = 1 * MiB + 512 * 1024, WS_WRL = WS_WRH + 64 * 1024;
constexpr size_t WS_WIN = 2 * MiB;
constexpr size_t WS_WUQ = 8 * MiB, WS_WUKV = 9 * MiB, WS_WO = 10 * MiB;
constexpr size_t WS_SSQ = 12 * MiB;
constexpr size_t WS_RS2 = 14 * MiB, WS_GATE = 14 * MiB + 512 * 1024;
constexpr size_t WS_TOS = 16 * MiB;
constexpr size_t WS_WGU = 32 * MiB, WS_WDN = 160 * MiB;
constexpr size_t WS_HB = 224 * MiB;
constexpr size_t WS_Q = 288 * MiB, WS_K = 336 * MiB, WS_V = 384 * MiB, WS_MIX = 416 * MiB;
constexpr size_t WS_OSLOT = 288 * MiB;
constexpr size_t WS_HN = 544 * MiB, WS_PB = 608 * MiB, WS_QRAW = 752 * MiB, WS_KVRAW = 800 * MiB;
constexpr size_t WS_ACT = 544 * MiB;
constexpr size_t WS_END = 864 * MiB;
constexpr int CW_BAR = 4096;
constexpr int CW_CNT = 16384;

constexpr int RING_BYTES = 131072;
constexpr int MISC_OFF = RING_BYTES;
constexpr int LDS_BYTES = 155648;
constexpr int EPI_TAB_OFF = MISC_OFF + 3072 * 4;

__device__ __forceinline__ unsigned cvt_pk_bf16(float lo, float hi) { unsigned r; asm volatile("v_cvt_pk_bf16_f32 %0, %1, %2" : "=v"(r) : "v"(lo), "v"(hi)); return r; }
__device__ __forceinline__ unsigned f2bf(float f) { unsigned u = __builtin_bit_cast(unsigned, f); return (u + 0x7fffu + ((u >> 16) & 1u)) >> 16; }
__device__ __forceinline__ unsigned pk2(float lo, float hi) { return f2bf(lo) | (f2bf(hi) << 16); }
__device__ __forceinline__ float bf_lo(unsigned w) { return __builtin_bit_cast(float, w << 16); }
__device__ __forceinline__ float bf_hi(unsigned w) { return __builtin_bit_cast(float, w & 0xffff0000u); }
__device__ __forceinline__ void unpack8(const u32x4 w, float* f) { f[0] = bf_lo(w.x); f[1] = bf_hi(w.x); f[2] = bf_lo(w.y); f[3] = bf_hi(w.y); f[4] = bf_lo(w.z); f[5] = bf_hi(w.z); f[6] = bf_lo(w.w); f[7] = bf_hi(w.w); }
__device__ __forceinline__ u32x4 pack8(const float* f) { u32x4 w; w.x = cvt_pk_bf16(f[0], f[1]); w.y = cvt_pk_bf16(f[2], f[3]); w.z = cvt_pk_bf16(f[4], f[5]); w.w = cvt_pk_bf16(f[6], f[7]); return w; }
__device__ __forceinline__ float wave_sum(float v) {
#pragma unroll
    for (int o = 1; o < 64; o <<= 1) v += __shfl_xor(v, o);
    return v;
}
__device__ __forceinline__ float half_sum(float v) {
#pragma unroll
    for (int o = 1; o < 32; o <<= 1) v += __shfl_xor(v, o);
    return v;
}
__device__ __forceinline__ float clamp448(float v) { return __builtin_amdgcn_fmed3f(v, -448.f, 448.f); }
__device__ __forceinline__ unsigned pk4_fp8(float a, float b, float c, float d) {
    unsigned w = 0u; w = (unsigned)__builtin_amdgcn_cvt_pk_fp8_f32(clamp448(a), clamp448(b), (int)w, false); w = (unsigned)__builtin_amdgcn_cvt_pk_fp8_f32(clamp448(c), clamp448(d), (int)w, true); return w; }
#define LDS_WAIT() asm volatile("s_waitcnt lgkmcnt(0)" ::: "memory")
#define VM_WAIT() asm volatile("s_waitcnt vmcnt(0)" ::: "memory")

namespace pg8 {
constexpr int BM = 256, BK = 64, HALF = 128, HTB = HALF * BK * 2, STAGE_BYTES = 8 * HTB, NXCD = 8, WGM = 8;
__host__ __device__ __forceinline__ int lds_byte(int r, int c) { const int st = (r >> 4) * 2 + (c >> 5), rr = r & 15, cc = c & 31, ob = rr * 64 + cc * 2; return st * 1024 + (ob ^ (((ob >> 9) & 1) << 5)); }
__host__ __device__ __forceinline__ void stage_rc(int b, int& R, int& C) { const int st = b / 1024, sb = b % 1024, swz = sb ^ (((sb >> 9) & 1) << 5); R = (st >> 1) * 16 + swz / 64; C = (st & 1) * 32 + (swz % 64) / 2; }
__host__ __device__ __forceinline__ int perm32(int rho) { const int n = rho >> 4, i = rho & 15; return 8 * (i >> 2) + 4 * n + (i & 3); }

struct Unit { int pm, pn, e, p0, cnt; };

struct DenseSched {
    static constexpr int ESZ = 2;
    const bf16_t* A; const bf16_t* Bt; int lda, K, nM, nN, nwg, G, c;
    __device__ void init(const bf16_t* A_, int lda_, const bf16_t* Bt_, int M, int N, int K_, int G_, int c_) { A = A_; Bt = Bt_; lda = lda_; K = K_; nM = M / BM; nN = N / BM; nwg = nM * nN; G = G_; c = c_; }
    __device__ __forceinline__ bool next(int i, Unit& u) const {
        const long L = (long)i * G + c; if (L >= nwg) return false;
        int wgid = (int)L; { const int q = nwg / NXCD, r = nwg % NXCD, xcd = wgid % NXCD, off = wgid / NXCD; wgid = (xcd < r ? xcd * (q + 1) : r * (q + 1) + (xcd - r) * q) + off; }
        const int nig = WGM * nN, gid = wgid / nig, fm = gid * WGM, gsz = (nM - fm) < WGM ? (nM - fm) : WGM;
        u.pm = fm + ((wgid % nig) % gsz); u.pn = (wgid % nig) / gsz; u.e = 0; u.p0 = 0; u.cnt = 0; return true;
    }
    __device__ __forceinline__ unsigned a_off(const Unit& u) const { return (unsigned)u.pm * (unsigned)(BM * lda * 2); }
    __device__ __forceinline__ unsigned b_off(const Unit& u) const { return (unsigned)u.pn * (unsigned)(BM * K * 2); }
    __device__ __forceinline__ unsigned a_rowoff(const Unit&, int) const { return 0u; }
};
struct MoeSched {
    static constexpr int ESZ = 1;
    const unsigned char* A; const unsigned char* Bt; int lda, K, nN, G, c; size_t estride; const LAS int* tab; const int* tos;
    __device__ __forceinline__ bool next(int i, Unit& u) const {
        const int T = __builtin_amdgcn_readfirstlane(tab[32]), nwg = T * nN;
        const long L = (long)i * G + c; if (L >= nwg) return false;
        int wgid = (int)L; { const int q = nwg / NXCD, r = nwg % NXCD, xcd = wgid % NXCD, off = wgid / NXCD; wgid = (xcd < r ? xcd * (q + 1) : r * (q + 1) + (xcd - r) * q) + off; }
        const int nig = WGM * nN, gid = wgid / nig, fm = gid * WGM, gsz = (T - fm) < WGM ? (T - fm) : WGM;
        const int mt = fm + ((wgid % nig) % gsz); u.pm = mt; u.pn = (wgid % nig) / gsz;
        const int e = __builtin_amdgcn_readfirstlane(tab[2288 + mt]);
        u.e = e; u.p0 = (mt - __builtin_amdgcn_readfirstlane(tab[e])) * BM; u.cnt = __builtin_amdgcn_readfirstlane(tab[48 + e]); return true;
    }
    __device__ __forceinline__ unsigned a_off(const Unit& u) const { return (unsigned)u.pm * (unsigned)(BM * lda); }
    __device__ __forceinline__ unsigned b_off(const Unit& u) const { return (unsigned)u.e * (unsigned)estride + (unsigned)u.pn * (unsigned)(BM * K); }
    __device__ __forceinline__ unsigned a_rowoff(const Unit& u, int r) const {
        const int p = u.p0 + r; const int sv = tos[(size_t)u.e * CAP + p];
        const int slot = (p < u.cnt) ? sv : 0;
        return (unsigned)(slot >> 2) * (unsigned)lda;
    }
};

template <class Epi, class Sched, bool GATHER>
__device__ __forceinline__ void gemm_phase(LAS unsigned char* lds, const Sched& S, const Epi& E) {
    const int tid = threadIdx.x, wid = __builtin_amdgcn_readfirstlane(tid >> 6), lane = tid & 63, wr = wid >> 2, wc = wid & 3, fr = lane & 15, fq = lane >> 4;
    constexpr int ESZ = Sched::ESZ; constexpr bool F8 = (ESZ == 1);
    const int K = S.K * ESZ / 2, lda = S.lda * ESZ / 2, nt = K / BK;
    unsigned voffB[2], aoc[2][2]; int RA[2], CA[2];
    LAS u32x4* aon_l = (LAS u32x4*)(lds + STAGE_BYTES + 1024) + tid;
#pragma unroll
    for (int i = 0; i < 2; ++i) { int R, C; stage_rc(tid * 16 + i * 8192, R, C); const int Rb = (R & ~31) + perm32(R & 31);
        voffB[i] = (unsigned)(Rb * K + C) * 2u; RA[i] = R; CA[i] = C;
        aoc[0][i] = (unsigned)(R * lda + C) * 2u; aoc[1][i] = (unsigned)((R + HALF) * lda + C) * 2u; }
    const unsigned kstep = (unsigned)(BK * 2);
    const unsigned hstepB = (unsigned)(HALF * K * 2), hstepA = GATHER ? 0u : (unsigned)(HALF * lda * 2);
    const __amdgpu_buffer_rsrc_t rA = __builtin_amdgcn_make_buffer_rsrc((void*)S.A, 0, -1, 0x00020000), rB = __builtin_amdgcn_make_buffer_rsrc((void*)S.Bt, 0, -1, 0x00020000);
    const unsigned ldsw = (unsigned)wid * 1024u;
    const int aoff = lds_byte(wr * 64 + fr, fq * 8), boff = lds_byte(wc * 32 + fr, fq * 8);
#define PG8_SA(b, h) (((b) * 2 + (h)) * HTB)
#define PG8_SB(b, h) ((4 + (b) * 2 + (h)) * HTB)
#define PG8_STAGE_B(bufoff, soff) do { _Pragma("unroll") for (int _i = 0; _i < 2; ++_i) \
        __builtin_amdgcn_raw_ptr_buffer_load_lds(rB, (LAS void*)(lds + (bufoff) + ldsw + _i * 8192), 16, voffB[_i], (soff), 0, 0); } while (0)
#define PG8_STAGE_A(bufoff, soff, h) do { _Pragma("unroll") for (int _i = 0; _i < 2; ++_i) \
        __builtin_amdgcn_raw_ptr_buffer_load_lds(rA, (LAS void*)(lds + (bufoff) + ldsw + _i * 8192), 16, aoc[GATHER ? (h) : 0][_i], (soff) + (h) * hstepA, 0, 0); } while (0)
#define PG8_LDA(dst, b, h) do { _Pragma("unroll") for (int m = 0; m < 4; ++m) _Pragma("unroll") for (int k = 0; k < 2; ++k) dst[m][k] = *(const LAS bf16x8*)(lds + PG8_SA(b, h) + aoff + m * 2048 + k * 1024); } while (0)
#define PG8_LDB(dst, b, h) do { _Pragma("unroll") for (int n = 0; n < 2; ++n) _Pragma("unroll") for (int k = 0; k < 2; ++k) dst[n][k] = *(const LAS bf16x8*)(lds + PG8_SB(b, h) + boff + n * 2048 + k * 1024); } while (0)
#define PG8_CAT(x) __builtin_shufflevector(__builtin_bit_cast(v4i_t, x[0]), __builtin_bit_cast(v4i_t, x[1]), 0, 1, 2, 3, 4, 5, 6, 7)
#define PG8_MMA(ai, bj, At, Bt) do { __builtin_amdgcn_s_setprio(1); _Pragma("unroll") for (int m = 0; m < 4; ++m) _Pragma("unroll") for (int n = 0; n < 2; ++n) { \
        if constexpr (F8) acc[ai][bj][m][n] = __builtin_amdgcn_mfma_scale_f32_16x16x128_f8f6f4(PG8_CAT(Bt[n]), PG8_CAT(At[m]), acc[ai][bj][m][n], 0, 0, 0, 0x7f7f7f7f, 0, 0x7f7f7f7f); \
        else { _Pragma("unroll") for (int k = 0; k < 2; ++k) acc[ai][bj][m][n] = __builtin_amdgcn_mfma_f32_16x16x32_bf16(Bt[n][k], At[m][k], acc[ai][bj][m][n], 0, 0, 0); } } \
        __builtin_amdgcn_s_setprio(0); } while (0)
#define PG8_WAIT_V(n) asm volatile("s_waitcnt vmcnt(" #n ")" ::: "memory")
#define PG8_WAIT_L(n) asm volatile("s_waitcnt lgkmcnt(" #n ")" ::: "memory")
#define PG8_BAR __builtin_amdgcn_s_barrier()
#define PG8_SCHED __builtin_amdgcn_sched_barrier(0)
    Unit cur, nxt; int ui = 0;
    if (!S.next(0, cur)) return;
    f32x4 acc[2][2][4][2];
#pragma unroll
    for (int a = 0; a < 2; ++a)
#pragma unroll
        for (int b = 0; b < 2; ++b)
#pragma unroll
            for (int m = 0; m < 4; ++m)
#pragma unroll
                for (int n = 0; n < 2; ++n) acc[a][b][m][n] = (f32x4){0.f, 0.f, 0.f, 0.f};
    bf16x8 At[4][2], B0[2][2], B1[2][2];
    unsigned cA = GATHER ? 0u : S.a_off(cur), cB = S.b_off(cur);
    if constexpr (GATHER) {
#pragma unroll
        for (int h = 0; h < 2; ++h)
#pragma unroll
            for (int i = 0; i < 2; ++i) aoc[h][i] = S.a_rowoff(cur, h * HALF + RA[i]) + (unsigned)CA[i] * 2u;
    }
    PG8_STAGE_B(PG8_SB(0, 0), cB); PG8_STAGE_B(PG8_SB(0, 1), cB + hstepB); PG8_STAGE_A(PG8_SA(0, 0), cA, 0); PG8_STAGE_A(PG8_SA(0, 1), cA, 1);
    if (wr == 1) PG8_BAR;
    PG8_WAIT_V(2); PG8_BAR;
    PG8_STAGE_B(PG8_SB(1, 0), cB + kstep); PG8_STAGE_A(PG8_SA(1, 0), cA + kstep, 0); PG8_STAGE_B(PG8_SB(1, 1), cB + hstepB + kstep);
    PG8_WAIT_V(6); PG8_BAR;
    for (;;) {
        const bool has_next = S.next(ui + 1, nxt);
        const unsigned nA = GATHER ? 0u : (has_next ? S.a_off(nxt) : cA), nB = has_next ? S.b_off(nxt) : cB;
        if constexpr (GATHER) {
            u32x4 an = {aoc[0][0], aoc[0][1], aoc[1][0], aoc[1][1]};
            if (has_next) { an.x = S.a_rowoff(nxt, RA[0]) + (unsigned)CA[0] * 2u; an.y = S.a_rowoff(nxt, RA[1]) + (unsigned)CA[1] * 2u;
                            an.z = S.a_rowoff(nxt, HALF + RA[0]) + (unsigned)CA[0] * 2u; an.w = S.a_rowoff(nxt, HALF + RA[1]) + (unsigned)CA[1] * 2u; }
            *aon_l = an;
        }
        for (int t = 0; t < nt; t += 2) {
            const bool last = (t == nt - 2);
            const unsigned a1 = cA + (unsigned)(t + 1) * kstep;
            const unsigned a2 = last ? nA : cA + (unsigned)(t + 2) * kstep, b2 = last ? nB : cB + (unsigned)(t + 2) * kstep;
            const unsigned a3 = a2 + kstep, b3 = b2 + kstep;
            PG8_LDB(B0, 0, 0); PG8_LDB(B1, 0, 1); PG8_SCHED; PG8_LDA(At, 0, 0); PG8_STAGE_A(PG8_SA(1, 1), a1, 1);
            PG8_WAIT_V(8); PG8_WAIT_L(0); PG8_BAR; PG8_MMA(0, 0, At, B0); PG8_MMA(0, 1, At, B1); PG8_BAR; PG8_SCHED;
            if constexpr (GATHER) { if (last) { const u32x4 an = *aon_l; aoc[0][0] = an.x; aoc[0][1] = an.y; aoc[1][0] = an.z; aoc[1][1] = an.w; } }
            PG8_LDA(At, 0, 1); PG8_STAGE_B(PG8_SB(0, 0), b2); PG8_STAGE_B(PG8_SB(0, 1), b2 + hstepB); PG8_STAGE_A(PG8_SA(0, 0), a2, 0);
            PG8_WAIT_V(8); PG8_WAIT_L(0); PG8_BAR; PG8_MMA(1, 0, At, B0); PG8_MMA(1, 1, At, B1); PG8_BAR; PG8_SCHED;
            PG8_LDB(B0, 1, 0); PG8_LDB(B1, 1, 1); PG8_SCHED; PG8_LDA(At, 1, 0); PG8_STAGE_A(PG8_SA(0, 1), a2, 1);
            PG8_WAIT_V(8); PG8_WAIT_L(0); PG8_BAR; PG8_MMA(0, 0, At, B0); PG8_MMA(0, 1, At, B1); PG8_BAR; PG8_SCHED;
            PG8_LDA(At, 1, 1); PG8_STAGE_B(PG8_SB(1, 0), b3); PG8_STAGE_B(PG8_SB(1, 1), b3 + hstepB); PG8_STAGE_A(PG8_SA(1, 0), a3, 0);
            PG8_WAIT_V(8); PG8_WAIT_L(0); PG8_BAR; PG8_MMA(1, 0, At, B0); PG8_MMA(1, 1, At, B1); PG8_BAR; PG8_SCHED;
        }
        if (wr == 0) PG8_BAR;
        E(acc, cur, wr, wc, fr, fq);
        if (!has_next) break;
#pragma unroll
        for (int a = 0; a < 2; ++a)
#pragma unroll
            for (int b = 0; b < 2; ++b)
#pragma unroll
                for (int m = 0; m < 4; ++m)
#pragma unroll
                    for (int n = 0; n < 2; ++n) acc[a][b][m][n] = (f32x4){0.f, 0.f, 0.f, 0.f};
        cur = nxt; cA = nA; cB = nB; ++ui;
        if (wr == 1) PG8_BAR;
    }
    PG8_WAIT_V(0);
    PG8_BAR;
#undef PG8_SA
#undef PG8_SB
#undef PG8_STAGE_A
#undef PG8_STAGE_B
#undef PG8_LDA
#undef PG8_LDB
#undef PG8_MMA
#undef PG8_CAT
#undef PG8_WAIT_V
#undef PG8_WAIT_L
#undef PG8_BAR
#undef PG8_SCHED
}

struct EpiBf16 {
    bf16_t* O; int ldc;
    __device__ __forceinline__ void operator()(const f32x4 (&acc)[2][2][4][2], const Unit& u, int wr, int wc, int fr, int fq) const {
        asm volatile("" : "+v"(fr), "+v"(fq));
        const int row0 = u.pm * BM + wr * 64 + fr, col0 = u.pn * BM + wc * 32 + 8 * fq;
#pragma unroll
        for (int ai = 0; ai < 2; ++ai)
#pragma unroll
            for (int m = 0; m < 4; ++m) { bf16_t* rowp = O + (size_t)(row0 + ai * HALF + m * 16) * ldc + col0;
#pragma unroll
                for (int bj = 0; bj < 2; ++bj) { const f32x4 v0 = acc[ai][bj][m][0], v1 = acc[ai][bj][m][1];
                    u32x4 w; w.x = cvt_pk_bf16(v0[0], v0[1]); w.y = cvt_pk_bf16(v0[2], v0[3]); w.z = cvt_pk_bf16(v1[0], v1[1]); w.w = cvt_pk_bf16(v1[2], v1[3]);
                    *(u32x4*)(rowp + bj * HALF) = w; } }
    }
};
struct EpiProj {
    bf16_t* O; float* st;
    __device__ __forceinline__ void operator()(const f32x4 (&acc)[2][2][4][2], const Unit& u, int wr, int wc, int fr, int fq) const {
        asm volatile("" : "+v"(fr), "+v"(fq));
        const int row0 = u.pm * BM + wr * 64 + fr, col0 = u.pn * BM + wc * 32 + 8 * fq;
#pragma unroll
        for (int ai = 0; ai < 2; ++ai)
#pragma unroll
            for (int m = 0; m < 4; ++m) { const int row = row0 + ai * HALF + m * 16; bf16_t* rowp = O + (size_t)row * NPP + col0; float ss[2];
#pragma unroll
                for (int bj = 0; bj < 2; ++bj) { const f32x4 v0 = acc[ai][bj][m][0], v1 = acc[ai][bj][m][1];
                    u32x4 w; w.x = cvt_pk_bf16(v0[0], v0[1]); w.y = cvt_pk_bf16(v0[2], v0[3]); w.z = cvt_pk_bf16(v1[0], v1[1]); w.w = cvt_pk_bf16(v1[2], v1[3]);
                    *(u32x4*)(rowp + bj * HALF) = w;
                    ss[bj] = (v0[0] * v0[0] + v0[1] * v0[1]) + (v0[2] * v0[2] + v0[3] * v0[3]) + (v1[0] * v1[0] + v1[1] * v1[1]) + (v1[2] * v1[2] + v1[3] * v1[3]); }
                if (u.pn >= 6) {
                    float s0 = ss[0], s1 = ss[1]; s0 += __shfl_xor(s0, 16); s0 += __shfl_xor(s0, 32); s1 += __shfl_xor(s1, 16); s1 += __shfl_xor(s1, 32);
                    if (fq == 0) { if (u.pn == 6) st[(size_t)wc * NTOK + row] = s0 + s1; else if (u.pn == 7) st[(size_t)(4 + wc) * NTOK + row] = s0 + s1;
                                   else { st[(size_t)(8 + wc) * NTOK + row] = s0; st[(size_t)(12 + wc) * NTOK + row] = s1; } } } }
    }
};
struct EpiQ {
    bf16_t* q; const float* st; const float* qhn; const f32x2* rope; LAS float* tabs;
    __device__ __forceinline__ void operator()(const f32x4 (&acc)[2][2][4][2], const Unit& u, int wr, int wc, int fr, int fq) const {
        asm volatile("" : "+v"(fr), "+v"(fq));
        LAS float* rs_tab = tabs; LAS float* part = tabs + 512;
        { const int t = threadIdx.x; if (t < BM) { const size_t r = (size_t)u.pm * BM + t; float s = 0.f;
#pragma unroll
            for (int k = 4; k < 12; ++k) s += st[(size_t)k * NTOK + r];
            rs_tab[t] = 1.0f / sqrtf(s * (1.f / QL) + EPS); } }
        const int rt0 = wr * 64 + fr;
#pragma unroll
        for (int ai = 0; ai < 2; ++ai)
#pragma unroll
            for (int m = 0; m < 4; ++m) { float ss = 0.f;
#pragma unroll
                for (int bj = 0; bj < 2; ++bj)
#pragma unroll
                    for (int n = 0; n < 2; ++n) { const f32x4 v = acc[ai][bj][m][n]; ss += (v[0] * v[0] + v[1] * v[1]) + (v[2] * v[2] + v[3] * v[3]); }
                ss += __shfl_xor(ss, 16); ss += __shfl_xor(ss, 32);
                if (fq == 0) part[(rt0 + ai * HALF + m * 16) * 4 + wc] = ss; }
        asm volatile("s_waitcnt lgkmcnt(0)" ::: "memory"); __builtin_amdgcn_s_barrier(); asm volatile("" ::: "memory");
        const int c0 = wc * 32 + 8 * fq;
        f32x4 g0[2], g1[2];
        g0[0] = *(const f32x4*)(qhn + c0) * QSCALE; g0[1] = *(const f32x4*)(qhn + c0 + 4) * QSCALE;
        const int i0 = c0 >> 1;
        if (wc < 2) { g1[0] = (f32x4){qhn[128 + i0], qhn[160 + i0], qhn[129 + i0], qhn[161 + i0]} * QSCALE; g1[1] = (f32x4){qhn[130 + i0], qhn[162 + i0], qhn[131 + i0], qhn[163 + i0]} * QSCALE; }
        else { g1[0] = (f32x4){0.f, 0.f, 0.f, 0.f}; g1[1] = g1[0]; }
#pragma unroll
        for (int ai = 0; ai < 2; ++ai)
#pragma unroll
            for (int m = 0; m < 4; ++m) { const int rt = rt0 + ai * HALF + m * 16; const size_t row = (size_t)u.pm * BM + rt;
                const f32x4 pp = *(const LAS f32x4*)(part + rt * 4); const float rs = rs_tab[rt];
                const float r = rs / sqrtf(rs * rs * ((pp[0] + pp[1]) + (pp[2] + pp[3])) * (1.f / QKH) + EPS);
                bf16_t* qp = q + row * (NH * QKH) + u.pn * QKH + c0;
                { const f32x4 v0 = acc[ai][0][m][0] * g0[0] * r, v1 = acc[ai][0][m][1] * g0[1] * r;
                  u32x4 w; w.x = cvt_pk_bf16(v0[0], v0[1]); w.y = cvt_pk_bf16(v0[2], v0[3]); w.z = cvt_pk_bf16(v1[0], v1[1]); w.w = cvt_pk_bf16(v1[2], v1[3]); *(u32x4*)qp = w; }
                if (wc < 2) { const f32x4 cs0 = *(const f32x4*)(rope + (row & (SEQ - 1)) * 32 + i0), cs1 = *(const f32x4*)(rope + (row & (SEQ - 1)) * 32 + i0 + 2);
                    const f32x4 a0 = acc[ai][1][m][0] * g1[0] * r, a1 = acc[ai][1][m][1] * g1[1] * r;
                    f32x4 o0, o1;
                    o0[0] = a0[0] * cs0[0] - a0[1] * cs0[1]; o0[1] = a0[0] * cs0[1] + a0[1] * cs0[0]; o0[2] = a0[2] * cs0[2] - a0[3] * cs0[3]; o0[3] = a0[2] * cs0[3] + a0[3] * cs0[2];
                    o1[0] = a1[0] * cs1[0] - a1[1] * cs1[1]; o1[1] = a1[0] * cs1[1] + a1[1] * cs1[0]; o1[2] = a1[2] * cs1[2] - a1[3] * cs1[3]; o1[3] = a1[2] * cs1[3] + a1[3] * cs1[2];
                    u32x4 w; w.x = cvt_pk_bf16(o0[0], o0[1]); w.y = cvt_pk_bf16(o0[2], o0[3]); w.z = cvt_pk_bf16(o1[0], o1[1]); w.w = cvt_pk_bf16(o1[2], o1[3]); *(u32x4*)(qp + HALF) = w; } }
    }
};
struct EpiKV {
    bf16_t* k; bf16_t* v; const float* st; const float* khn; const f32x2* rope; const bf16_t* pb; LAS float* tabs;
    __device__ __forceinline__ void operator()(const f32x4 (&acc)[2][2][4][2], const Unit& u, int wr, int wc, int fr, int fq) const {
        asm volatile("" : "+v"(fr), "+v"(fq));
        LAS float* rs_tab = tabs; LAS float* kpe_tab = tabs + 256; LAS float* part = tabs + 512;
        { const int t = threadIdx.x; if (t < BM) { const size_t r = (size_t)u.pm * BM + t;
            const float s = (st[r] + st[(size_t)NTOK + r]) + (st[(size_t)2 * NTOK + r] + st[(size_t)3 * NTOK + r]);
            const float p = (st[(size_t)12 * NTOK + r] + st[(size_t)13 * NTOK + r]) + (st[(size_t)14 * NTOK + r] + st[(size_t)15 * NTOK + r]);
            rs_tab[t] = 1.0f / sqrtf(s * (1.f / KVL) + EPS); kpe_tab[t] = p; } }
        const int rt0 = wr * 64 + fr;
#pragma unroll
        for (int ai = 0; ai < 2; ++ai)
#pragma unroll
            for (int m = 0; m < 4; ++m) { float ss = 0.f;
#pragma unroll
                for (int n = 0; n < 2; ++n) { const f32x4 x = acc[ai][0][m][n]; ss += (x[0] * x[0] + x[1] * x[1]) + (x[2] * x[2] + x[3] * x[3]); }
                ss += __shfl_xor(ss, 16); ss += __shfl_xor(ss, 32);
                if (fq == 0) part[(rt0 + ai * HALF + m * 16) * 4 + wc] = ss; }
        asm volatile("s_waitcnt lgkmcnt(0)" ::: "memory"); __builtin_amdgcn_s_barrier(); asm volatile("" ::: "memory");
        const int c0 = wc * 32 + 8 * fq;
        const f32x4 g0 = *(const f32x4*)(khn + c0), g1 = *(const f32x4*)(khn + c0 + 4);
        const int i0 = 8 * wc + 2 * fq;
        const float gx0 = khn[128 + i0], gy0 = khn[160 + i0], gx1 = khn[129 + i0], gy1 = khn[161 + i0];
#pragma unroll
        for (int ai = 0; ai < 2; ++ai)
#pragma unroll
            for (int m = 0; m < 4; ++m) { const int rt = rt0 + ai * HALF + m * 16; const size_t row = (size_t)u.pm * BM + rt;
                const f32x4 pp = *(const LAS f32x4*)(part + rt * 4); const float rs = rs_tab[rt];
                const float rh = 1.0f / sqrtf((rs * rs * ((pp[0] + pp[1]) + (pp[2] + pp[3])) + kpe_tab[rt]) * (1.f / QKH) + EPS);
                const float r = rs * rh;
                bf16_t* kp = k + row * (NH * QKH) + u.pn * QKH;
                { const f32x4 v0 = acc[ai][0][m][0] * g0 * r, v1 = acc[ai][0][m][1] * g1 * r;
                  u32x4 w; w.x = cvt_pk_bf16(v0[0], v0[1]); w.y = cvt_pk_bf16(v0[2], v0[3]); w.z = cvt_pk_bf16(v1[0], v1[1]); w.w = cvt_pk_bf16(v1[2], v1[3]); *(u32x4*)(kp + c0) = w; }
                { const f32x4 v0 = acc[ai][1][m][0] * rs, v1 = acc[ai][1][m][1] * rs;
                  u32x4 w; w.x = cvt_pk_bf16(v0[0], v0[1]); w.y = cvt_pk_bf16(v0[2], v0[3]); w.z = cvt_pk_bf16(v1[0], v1[1]); w.w = cvt_pk_bf16(v1[2], v1[3]); *(u32x4*)(v + row * (NH * VH) + u.pn * VH + c0) = w; }
                { const unsigned xa = *(const unsigned*)(pb + row * NPP + PB_KPE + i0), xb = *(const unsigned*)(pb + row * NPP + PB_KPE + 32 + i0);
                  const f32x4 cs = *(const f32x4*)(rope + (row & (SEQ - 1)) * 32 + i0);
                  const float x10 = bf_lo(xa) * gx0 * rh, x11 = bf_hi(xa) * gx1 * rh, x20 = bf_lo(xb) * gy0 * rh, x21 = bf_hi(xb) * gy1 * rh;
                  u32x2 w; w.x = cvt_pk_bf16(x10 * cs[0] - x20 * cs[1], x10 * cs[1] + x20 * cs[0]); w.y = cvt_pk_bf16(x11 * cs[2] - x21 * cs[3], x11 * cs[3] + x21 * cs[2]);
                  *(u32x2*)(kp + 128 + 2 * i0) = w; } }
    }
};
struct EpiOut {
    const float* x; float* out; float* ssq;
    __device__ __forceinline__ void operator()(const f32x4 (&acc)[2][2][4][2], const Unit& u, int wr, int wc, int fr, int fq) const {
        asm volatile("" : "+v"(fr), "+v"(fq));
        const int row0 = u.pm * BM + wr * 64 + fr, col0 = u.pn * BM + wc * 32 + 8 * fq;
#pragma unroll
        for (int ai = 0; ai < 2; ++ai)
#pragma unroll
            for (int m = 0; m < 4; ++m) { const int row = row0 + ai * HALF + m * 16; const size_t off = (size_t)row * DM + col0; float ss = 0.f;
#pragma unroll
                for (int bj = 0; bj < 2; ++bj) { const f32x4 x0 = __builtin_nontemporal_load((const f32x4*)(x + off + bj * HALF)), x1 = __builtin_nontemporal_load((const f32x4*)(x + off + bj * HALF + 4));
                    const f32x4 v0 = acc[ai][bj][m][0] + x0, v1 = acc[ai][bj][m][1] + x1;
                    *(f32x4*)(out + off + bj * HALF) = v0; *(f32x4*)(out + off + bj * HALF + 4) = v1;
                    ss += (v0[0] * v0[0] + v0[1] * v0[1]) + (v0[2] * v0[2] + v0[3] * v0[3]) + (v1[0] * v1[0] + v1[1] * v1[1]) + (v1[2] * v1[2] + v1[3] * v1[3]); }
                ss += __shfl_xor(ss, 16); ss += __shfl_xor(ss, 32);
                if (fq == 0) ssq[(size_t)(u.pn * 4 + wc) * NTOK + row] = ss; }
    }
};
struct EpiSwiglu {
    unsigned char* act; const float* bgu;
    __device__ __forceinline__ void operator()(const f32x4 (&acc)[2][2][4][2], const Unit& u, int wr, int wc, int fr, int fq) const {
        asm volatile("" : "+v"(fr), "+v"(fq));
        const int rt0 = wr * 64 + fr, j0 = wc * 32 + 8 * fq;
        const float* bg = bgu + (size_t)u.e * (2 * DFF) + u.pn * HALF + j0;
        const f32x4 bg0 = *(const f32x4*)bg, bg1 = *(const f32x4*)(bg + 4), bu0 = *(const f32x4*)(bg + DFF), bu1 = *(const f32x4*)(bg + DFF + 4);
        constexpr float WI = 1.f / W8_SCALE;
#pragma unroll
        for (int ai = 0; ai < 2; ++ai)
#pragma unroll
            for (int m = 0; m < 4; ++m) { const int rt = rt0 + ai * HALF + m * 16;
                float o[8];
#pragma unroll
                for (int n = 0; n < 2; ++n) { const f32x4 g4 = acc[ai][0][m][n] * WI + (n ? bg1 : bg0), u4 = acc[ai][1][m][n] * WI + (n ? bu1 : bu0);
#pragma unroll
                    for (int i = 0; i < 4; ++i) { const float g = fminf(g4[i], SWI_LIMIT), uu = fminf(fmaxf(u4[i], -SWI_LIMIT), SWI_LIMIT);
                        const float sg = __builtin_amdgcn_rcpf(1.f + __builtin_amdgcn_exp2f(g * (-SWI_ALPHA * 1.4426950408889634f)));
                        o[n * 4 + i] = (uu + 1.f) * (g * sg) * ACT8_SCALE; } }
                u32x2 w; w.x = pk4_fp8(o[0], o[1], o[2], o[3]); w.y = pk4_fp8(o[4], o[5], o[6], o[7]);
                *(u32x2*)(act + ((size_t)u.pm * BM + rt) * DFF + u.pn * HALF + j0) = w; }
    }
};
struct EpiDown {
    bf16_t* oslot; const float* bdn; const float* gate; const int* tos; bf16_t* dummy;
    __device__ __forceinline__ void operator()(const f32x4 (&acc)[2][2][4][2], const Unit& u, int wr, int wc, int fr, int fq) const {
        asm volatile("" : "+v"(fr), "+v"(fq));
        const int rt0 = wr * 64 + fr, col0 = u.pn * BM + wc * 32 + 8 * fq;
        const float* bp = bdn + (size_t)u.e * DM + col0;
        f32x4 bv[2][2];
#pragma unroll
        for (int bj = 0; bj < 2; ++bj) { bv[bj][0] = *(const f32x4*)(bp + bj * HALF); bv[bj][1] = *(const f32x4*)(bp + bj * HALF + 4); }
        constexpr float WI = 1.f / (W8_SCALE * ACT8_SCALE);
#pragma unroll
        for (int ai = 0; ai < 2; ++ai)
#pragma unroll
            for (int m = 0; m < 4; ++m) { const int rt = rt0 + ai * HALF + m * 16, p = u.p0 + rt;
                const int sv = tos[(size_t)u.e * CAP + p]; const bool valid = p < u.cnt; const int slot = valid ? sv : 0; const float g = gate[slot];
                bf16_t* rowp = valid ? oslot + (size_t)slot * DM + col0 : dummy + col0;
#pragma unroll
                for (int bj = 0; bj < 2; ++bj) { const f32x4 v0 = (acc[ai][bj][m][0] * WI + bv[bj][0]) * g, v1 = (acc[ai][bj][m][1] * WI + bv[bj][1]) * g;
                    u32x4 w; w.x = cvt_pk_bf16(v0[0], v0[1]); w.y = cvt_pk_bf16(v0[2], v0[3]); w.z = cvt_pk_bf16(v1[0], v1[1]); w.w = cvt_pk_bf16(v1[2], v1[3]);
                    *(u32x4*)(rowp + bj * HALF) = w; } }
    }
};
struct EpiNull {
    float* dummy;
    __device__ __forceinline__ void operator()(const f32x4 (&acc)[2][2][4][2], const Unit& u, int wr, int wc, int fr, int fq) const {
        float sacc = 0.f;
#pragma unroll
        for (int ai = 0; ai < 2; ++ai)
#pragma unroll
            for (int bj = 0; bj < 2; ++bj)
#pragma unroll
                for (int m = 0; m < 4; ++m)
#pragma unroll
                    for (int n = 0; n < 2; ++n) sacc += (acc[ai][bj][m][n][0] + acc[ai][bj][m][n][1]) + (acc[ai][bj][m][n][2] + acc[ai][bj][m][n][3]);
        dummy[(size_t)blockIdx.x * 512 + threadIdx.x] = sacc;
    }
};
}

namespace att {
constexpr int LDQ = NH * QKH, LDK = NH * QKH, LDV = NH * VH, LDO = DM;
constexpr int KT_BYTES = 64 * QKH * 2, VT_BYTES = 64 * VH * 2;
constexpr int L_K = 0, L_V = 2 * KT_BYTES, L_WS = L_V + 2 * VT_BYTES, L_END = L_WS + 8 * 256;
constexpr float THRL = 8.f * 1.4426950408889634f;
__device__ __forceinline__ int crow(int r, int hi) { return (r & 3) + 8 * (r >> 2) + 4 * hi; }
#define SBAR() __builtin_amdgcn_sched_barrier(0)
__device__ __forceinline__ int v_rd_base(int lane) { return ((lane & 3) << 3) | (((lane >> 2) & 3) << 6) | (((lane >> 4) & 1) << 5) | (((lane >> 5) & 1) << 8); }
constexpr int v_rd_off(int d0, int ks, int half) { return d0 * 512 + ks * 4096 + half * 2048; }
template <int OFF> __device__ __forceinline__ s16x4 tr_read(int vb) {
    s16x4 r; asm volatile("ds_read_b64_tr_b16 %0, %1 offset:%2" : "=&v"(r) : "v"(vb), "i"(OFF) : "memory"); return r;
}
template <int D0> __device__ __forceinline__ void pv_one(f32x16& od, int vb, bf16x8 pa0, bf16x8 pa1, bf16x8 pa2, bf16x8 pa3) {
    const s16x4 l0 = tr_read<v_rd_off(D0, 0, 0)>(vb), h0 = tr_read<v_rd_off(D0, 0, 1)>(vb), l1 = tr_read<v_rd_off(D0, 1, 0)>(vb), h1 = tr_read<v_rd_off(D0, 1, 1)>(vb);
    const s16x4 l2 = tr_read<v_rd_off(D0, 2, 0)>(vb), h2 = tr_read<v_rd_off(D0, 2, 1)>(vb), l3 = tr_read<v_rd_off(D0, 3, 0)>(vb), h3 = tr_read<v_rd_off(D0, 3, 1)>(vb);
    asm volatile("s_waitcnt lgkmcnt(0)" ::: "memory"); SBAR();
#define PK(L, H) (bf16x8){L[0], L[1], L[2], L[3], H[0], H[1], H[2], H[3]}
    od = __builtin_amdgcn_mfma_f32_32x32x16_bf16(pa0, PK(l0, h0), od, 0, 0, 0);
    od = __builtin_amdgcn_mfma_f32_32x32x16_bf16(pa1, PK(l1, h1), od, 0, 0, 0);
    od = __builtin_amdgcn_mfma_f32_32x32x16_bf16(pa2, PK(l2, h2), od, 0, 0, 0);
    od = __builtin_amdgcn_mfma_f32_32x32x16_bf16(pa3, PK(l3, h3), od, 0, 0, 0);
#undef PK
}
__device__ __forceinline__ void glds16(const void* gsrc, LAS unsigned char* dst) {
    __builtin_amdgcn_global_load_lds((const unsigned*)gsrc, (LAS unsigned*)dst, 16, 0, 0);
}
__device__ __forceinline__ void attn_unit(int b, int h, int qb, const bf16_t* Q, const bf16_t* Kg, const bf16_t* Vg, bf16_t* O, LAS unsigned char* lds) {
    const int tid = threadIdx.x, wid = __builtin_amdgcn_readfirstlane(tid >> 6), lane = tid & 63, r32 = lane & 31, hi = lane >> 5;
    const size_t tok0 = (size_t)b * SEQ;
    bf16x8 qr[12];
    { const bf16_t* Qw = Q + (tok0 + (size_t)qb * 256 + wid * 32 + r32) * LDQ + h * QKH + hi * 8;
#pragma unroll
      for (int d0 = 0; d0 < 12; ++d0) qr[d0] = *(const bf16x8*)(Qw + d0 * 16); }
    unsigned koff[3], voff[2];
#pragma unroll
    for (int i = 0; i < 3; ++i) { const int G = 64 * (wid + 8 * i) + lane, row = G / 24, cgs = G % 24, cg = (cgs & ~7) | ((cgs & 7) ^ ((row >> 1) & 7)); koff[i] = (unsigned)(row * LDK * 2 + cg * 16); }
#pragma unroll
    for (int i = 0; i < 2; ++i) { const int p = wid + 8 * i, sub = 2 * p + (lane >> 5), kkh = sub >> 2, cblk = sub & 3, kkl = (lane & 31) >> 2, cl = (lane & 3) * 8, kk = kkh * 8 + kkl;
        const int k = (kk & ~0xC) | ((kk & 4) << 1) | ((kk & 8) >> 1), c = cblk * 32 + cl; voff[i] = (unsigned)(k * LDV * 2 + c * 2); }
    const char* Kh = (const char*)(Kg + tok0 * LDK + h * QKH); const char* Vh = (const char*)(Vg + tok0 * LDV + h * VH);
#define ATT_DMA(j, buf) do { const char* kp_ = Kh + (size_t)(j) * 64 * LDK * 2; const char* vp_ = Vh + (size_t)(j) * 64 * LDV * 2; \
        _Pragma("unroll") for (int i_ = 0; i_ < 3; ++i_) glds16(kp_ + koff[i_], lds + L_K + (buf) * KT_BYTES + (wid + 8 * i_) * 1024); \
        _Pragma("unroll") for (int i_ = 0; i_ < 2; ++i_) glds16(vp_ + voff[i_], lds + L_V + (buf) * VT_BYTES + (wid + 8 * i_) * 1024); } while (0)
    const int swz = (r32 >> 1) & 7; int kx[4];
#pragma unroll
    for (int dd = 0; dd < 4; ++dd) kx[dd] = r32 * (QKH * 2) + (((2 * dd + hi) ^ swz) << 4);
    LAS float* ws = (LAS float*)(lds + L_WS) + wid * 64; LAS float* li_l = ws; LAS float* al_l = ws + 32;
    const int vb0 = L_V + v_rd_base(lane);
    float m_reg = -1e30f, l_reg = 0.f; f32x16 o[4];
#pragma unroll
    for (int d = 0; d < 4; ++d)
#pragma unroll
        for (int r = 0; r < 16; ++r) o[d][r] = 0.f;
    const int NT = 4 * qb + 4, my_last = 4 * qb + (wid >> 1);
    ATT_DMA(0, 0);
    for (int j = 0; j < NT; ++j) {
        const int buf = j & 1;
        asm volatile("s_waitcnt vmcnt(0)" ::: "memory"); __builtin_amdgcn_s_barrier(); asm volatile("" ::: "memory");
        if (j + 1 < NT) ATT_DMA(j + 1, buf ^ 1);
        if (j <= my_last) {
            const LAS unsigned char* Ks = lds + L_K + buf * KT_BYTES;
            f32x16 p0, p1;
#pragma unroll
            for (int r = 0; r < 16; ++r) { p0[r] = 0.f; p1[r] = 0.f; }
#pragma unroll
            for (int d0 = 0; d0 < 12; ++d0) {
                const bf16x8 b0 = *(const LAS bf16x8*)(Ks + kx[d0 & 3] + (d0 >> 2) * 128);
                const bf16x8 b1 = *(const LAS bf16x8*)(Ks + kx[d0 & 3] + (d0 >> 2) * 128 + 32 * QKH * 2);
                p0 = __builtin_amdgcn_mfma_f32_32x32x16_bf16(b0, qr[d0], p0, 0, 0, 0);
                p1 = __builtin_amdgcn_mfma_f32_32x32x16_bf16(b1, qr[d0], p1, 0, 0, 0);
            }
            float pmax = p0[0];
#pragma unroll
            for (int r = 1; r < 16; ++r) pmax = fmaxf(pmax, p0[r]);
#pragma unroll
            for (int r = 0; r < 16; ++r) pmax = fmaxf(pmax, p1[r]);
            { auto rr = __builtin_amdgcn_permlane32_swap(__float_as_uint(pmax), __float_as_uint(pmax), false, false);
              pmax = fmaxf(__uint_as_float(rr[0]), __uint_as_float(rr[1])); }
            float mn, alpha;
            if (__builtin_expect(__all(pmax - m_reg <= THRL), 1)) { mn = m_reg; alpha = 1.f; }
            else { mn = fmaxf(m_reg, pmax); alpha = __builtin_amdgcn_exp2f(m_reg - mn); m_reg = mn; }
#pragma unroll
            for (int r = 0; r < 16; ++r) { p0[r] = __builtin_amdgcn_exp2f(p0[r] - mn); p1[r] = __builtin_amdgcn_exp2f(p1[r] - mn); }
            float ps = 0.f;
#pragma unroll
            for (int r = 0; r < 16; ++r) ps += p0[r];
#pragma unroll
            for (int r = 0; r < 16; ++r) ps += p1[r];
            { auto rr = __builtin_amdgcn_permlane32_swap(__float_as_uint(ps), __float_as_uint(ps), false, false);
              ps = __uint_as_float(rr[0]) + __uint_as_float(rr[1]); }
            l_reg = l_reg * alpha + ps;
            if (__any(alpha < 1.f)) { if (hi == 0) al_l[r32] = alpha; asm volatile("s_waitcnt lgkmcnt(0)" ::: "memory");
#pragma unroll
                for (int r = 0; r < 16; ++r) { const float a = al_l[crow(r, hi)];
#pragma unroll
                    for (int d = 0; d < 4; ++d) o[d][r] *= a; } }
            bf16x8 pa0, pa1, pa2, pa3;
#define PK4(P, BASE, OUT) do { unsigned a0 = cvt_pk_bf16(P[BASE + 0], P[BASE + 1]), a1 = cvt_pk_bf16(P[BASE + 2], P[BASE + 3]);   \
    unsigned b0_ = cvt_pk_bf16(P[BASE + 4], P[BASE + 5]), b1_ = cvt_pk_bf16(P[BASE + 6], P[BASE + 7]);                              \
    auto r0 = __builtin_amdgcn_permlane32_swap(a0, b0_, false, false); auto r1 = __builtin_amdgcn_permlane32_swap(a1, b1_, false, false); \
    u32x4 w = {r0[0], r1[0], r0[1], r1[1]}; OUT = __builtin_bit_cast(bf16x8, w); } while (0)
            PK4(p0, 0, pa0); PK4(p0, 8, pa1); PK4(p1, 0, pa2); PK4(p1, 8, pa3);
#undef PK4
            const int vb = vb0 + buf * VT_BYTES;
            pv_one<0>(o[0], vb, pa0, pa1, pa2, pa3); pv_one<1>(o[1], vb, pa0, pa1, pa2, pa3); pv_one<2>(o[2], vb, pa0, pa1, pa2, pa3); pv_one<3>(o[3], vb, pa0, pa1, pa2, pa3);
        }
    }
    if (hi == 0) li_l[r32] = l_reg; asm volatile("s_waitcnt lgkmcnt(0)" ::: "memory");
    bf16_t* Ow = O + (tok0 + (size_t)qb * 256 + wid * 32) * LDO + h * VH;
#pragma unroll
    for (int r = 0; r < 16; ++r) { const int orow = crow(r, hi); const float rl = __builtin_amdgcn_rcpf(li_l[orow]);
#pragma unroll
        for (int d0 = 0; d0 < 4; ++d0) Ow[(size_t)orow * LDO + d0 * 32 + r32] = (bf16_t)f2bf(o[d0][r] * rl); }
    asm volatile("s_waitcnt lgkmcnt(0)" ::: "memory"); __builtin_amdgcn_s_barrier(); asm volatile("" ::: "memory");
#undef ATT_DMA
}
#undef SBAR
}

#define XB_TMO      128
#define XB_XCNT(j)  (256  + 64 * (j))
#define XB_XSUB(j)  (1280 + 64 * (j))
#define XB_XGEN(j)  (2304 + 64 * (j))
#define XB_TOP      3328
#define XB_TOPGEN   3392
#define XCD_BAR_WORDS 3456
#define XB_SPIN_CAP (1u << 18)
__device__ __forceinline__ unsigned xb_ld(unsigned* p)              { return __hip_atomic_load(p, __ATOMIC_RELAXED, __HIP_MEMORY_SCOPE_AGENT); }
__device__ __forceinline__ unsigned xb_add(unsigned* p, unsigned v) { return __hip_atomic_fetch_add(p, v, __ATOMIC_RELAXED, __HIP_MEMORY_SCOPE_AGENT); }
__device__ __forceinline__ unsigned xb_xcc_id() { return (unsigned)__builtin_amdgcn_s_getreg((3 << 11) | 20) & 0xFu; }
#define XB_SPIN(cond, bar) do { unsigned _sp = 0; while (cond) { __builtin_amdgcn_s_sleep(1); \
    if ((++_sp & 255u) == 0u) { if (xb_ld(&(bar)[XB_TMO])) break; if (_sp > XB_SPIN_CAP) { atomicAdd(&(bar)[XB_TMO], 1u); break; } } } } while (0)
struct XcdBarrier { unsigned* bar; unsigned x; volatile LAS unsigned* st; };
__device__ __forceinline__ XcdBarrier xcd_barrier_post(unsigned* bar, volatile LAS unsigned* st) {
    XcdBarrier b; b.bar = bar; b.x = xb_xcc_id(); b.st = st;
    if (threadIdx.x == 0) (void)xb_add(&bar[XB_XCNT(b.x)], 1u);
    return b;
}
__device__ __forceinline__ void xcd_barrier_complete(unsigned* bar, unsigned x, unsigned& nloc, unsigned& nx) {
    const unsigned G = gridDim.x * gridDim.y * gridDim.z;
    unsigned sum, cnt, mine, sp = 0u;
    for (;;) {
        sum = 0u; cnt = 0u; mine = 0u;
#pragma unroll
        for (unsigned j = 0; j < 16; ++j) { const unsigned c = xb_ld(&bar[XB_XCNT(j)]); sum += c; cnt += (c > 0u) ? 1u : 0u; mine = (j == x) ? c : mine; }
        if (sum == G) break;
        __builtin_amdgcn_s_sleep(1);
        if ((++sp & 255u) == 0u) { if (xb_ld(&bar[XB_TMO])) break; if (sp > XB_SPIN_CAP) { atomicAdd(&bar[XB_TMO], 1u); break; } }
    }
    nloc = mine > 0u ? mine : 1u; nx = cnt > 0u ? cnt : 1u;
}
__device__ __forceinline__ void xcd_barrier(const XcdBarrier& b) {
    asm volatile("s_waitcnt vmcnt(0)" ::: "memory");
    __syncthreads();
    if (threadIdx.x == 0) {
        unsigned* bar = b.bar;
        __builtin_amdgcn_s_waitcnt(0);
        unsigned nloc = b.st[0], nx = b.st[1];
        if (nloc == 0u) { xcd_barrier_complete(bar, b.x, nloc, nx); b.st[0] = nloc; b.st[1] = nx; }
        const unsigned old = xb_add(&bar[XB_XSUB(b.x)], 1u);
        const unsigned gen = old / nloc;
        if (old + 1u == (gen + 1u) * nloc) {
            __builtin_amdgcn_fence(__ATOMIC_RELEASE, "agent");
            asm volatile("s_waitcnt vmcnt(0)" ::: "memory");
            const unsigned og = xb_add(&bar[XB_TOP], 1u);
            const unsigned tg = og / nx;
            if (og + 1u == (tg + 1u) * nx) xb_add(&bar[XB_TOPGEN], 1u);
            else XB_SPIN(xb_ld(&bar[XB_TOPGEN]) == tg, bar);
            __builtin_amdgcn_fence(__ATOMIC_ACQUIRE, "agent");
            xb_add(&bar[XB_XGEN(b.x)], 1u);
            asm volatile("s_waitcnt vmcnt(0)" ::: "memory");
        } else {
            XB_SPIN(xb_ld(&bar[XB_XGEN(b.x)]) == gen, bar);
            __builtin_amdgcn_fence(__ATOMIC_ACQUIRE, "agent");
            asm volatile("s_waitcnt vmcnt(0)" ::: "memory");
        }
    }
    __syncthreads();
}

constexpr int NWAVES = 8;
constexpr int N_LAUNCHES = MK_N_LAUNCHES;
constexpr int N_PHASES = 10;
struct Args { const float* in[18]; float* out; unsigned char* ws; int ph_lo, ph_hi; };

__device__ __forceinline__ void p0_transpose_item(const float* W, int K, int N, bf16_t* WT, int drow0, const float* kscale, LAS unsigned* scr, int k0, int n0, int lane, bool ileave = false) {
    const int g = lane >> 4, l16 = lane & 15;
    f32x4 v[16];
#pragma unroll
    for (int i = 0; i < 16; ++i) { const int kk = (i >> 1) * 8 + g * 2 + (i & 1); v[i] = __builtin_nontemporal_load((const f32x4*)(W + (size_t)(k0 + kk) * N + n0 + 4 * l16)); }
    if (kscale) {
#pragma unroll
        for (int i = 0; i < 16; ++i) { const int kk = (i >> 1) * 8 + g * 2 + (i & 1); v[i] = v[i] * kscale[k0 + kk]; } }
#pragma unroll
    for (int j = 0; j < 8; ++j) { const int kp = j * 4 + g;
#pragma unroll
        for (int c = 0; c < 4; ++c) scr[(4 * l16 + c) * 33 + kp] = cvt_pk_bf16(v[2 * j][c], v[2 * j + 1][c]); }
    LDS_WAIT(); asm volatile("" ::: "memory");
    const int c8 = lane & 7;
#pragma unroll
    for (int jj = 0; jj < 8; ++jj) { const int n = jj * 8 + (lane >> 3); const LAS unsigned* t = scr + n * 33 + 4 * c8;
        u32x4 o; o.x = t[0]; o.y = t[1]; o.z = t[2]; o.w = t[3];
        const int dn = ileave ? ((n < 32) ? 2 * n : 2 * (n - 32) + 1) : n;
        *(u32x4*)(WT + (size_t)(drow0 + dn) * K + k0 + 8 * c8) = o; }
    LDS_WAIT(); asm volatile("" ::: "memory");
}

__device__ __forceinline__ void p0_transpose_item8(const float* W, int K, int N, unsigned char* WT, int drow0, const float* kscale, LAS unsigned* scr, int k0, int n0, int lane) {
    const int g = lane >> 4, l16 = lane & 15;
    f32x4 v[32];
#pragma unroll
    for (int i = 0; i < 32; ++i) { const int kk = (i >> 2) * 16 + g * 4 + (i & 3); v[i] = __builtin_nontemporal_load((const f32x4*)(W + (size_t)(k0 + kk) * N + n0 + 4 * l16)); }
#pragma unroll
    for (int i = 0; i < 32; ++i) { const int kk = (i >> 2) * 16 + g * 4 + (i & 3); v[i] = v[i] * (kscale ? kscale[k0 + kk] * W8_SCALE : W8_SCALE); }
#pragma unroll
    for (int j = 0; j < 8; ++j) { const int kd = j * 4 + g;
#pragma unroll
        for (int c = 0; c < 4; ++c) scr[(4 * l16 + c) * 33 + kd] = pk4_fp8(v[4 * j][c], v[4 * j + 1][c], v[4 * j + 2][c], v[4 * j + 3][c]); }
    LDS_WAIT(); asm volatile("" ::: "memory");
    const int c8 = lane & 7;
#pragma unroll
    for (int jj = 0; jj < 8; ++jj) { const int n = jj * 8 + (lane >> 3); const LAS unsigned* t = scr + n * 33 + 4 * c8;
        u32x4 o; o.x = t[0]; o.y = t[1]; o.z = t[2]; o.w = t[3];
        *(u32x4*)(WT + (size_t)(drow0 + n) * K + k0 + 16 * c8) = o; }
    LDS_WAIT(); asm volatile("" ::: "memory");
}

template <int PHMASK> __global__ void __launch_bounds__(NWAVES * 64, 2) fwd_kernel_t(Args args) {
    extern __shared__ __attribute__((aligned(16))) unsigned char lds_raw[];
    LAS unsigned char* lds = (LAS unsigned char*)lds_raw;
    volatile LAS unsigned* MISC = (volatile LAS unsigned*)(lds + MISC_OFF);
    const int tid = threadIdx.x, lane = tid & 63, wave = __builtin_amdgcn_readfirstlane(tid >> 6);
    const int G = gridDim.x; const int bx = blockIdx.x; const int vcu = (G % 8 == 0) ? (bx % 8) * (G / 8) + bx / 8 : bx;
    unsigned char* ws = args.ws;
    unsigned* ctl = (unsigned*)(ws + WS_CTL);
    const float* x = args.in[0]; const float* norm_mix = args.in[1]; const float* w_in = args.in[2]; const float* conv_w = args.in[3];
    const float* q_norm = args.in[4]; const float* w_uq = args.in[5]; const float* kv_norm = args.in[6]; const float* w_ukv = args.in[7];
    const float* q_head_norm = args.in[8]; const float* k_head_norm = args.in[9]; const float* w_o = args.in[10]; const float* norm_ffn = args.in[11];
    const float* w_router = args.in[12]; const float* b_router = args.in[13]; const float* w_gate_up = args.in[14]; const float* b_gate_up = args.in[15];
    const float* w_down = args.in[16]; const float* b_down = args.in[17];
    float* out = args.out;
    f32x2* rope_t = (f32x2*)(ws + WS_ROPE);
    bf16_t* WrH = (bf16_t*)(ws + WS_WRH); bf16_t* WrL = (bf16_t*)(ws + WS_WRL);
    bf16_t* Win_t = (bf16_t*)(ws + WS_WIN); bf16_t* Wuq_t = (bf16_t*)(ws + WS_WUQ); bf16_t* Wukv_t = (bf16_t*)(ws + WS_WUKV); bf16_t* Wo_t = (bf16_t*)(ws + WS_WO);
    float* ssq = (float*)(ws + WS_SSQ); float* rs2 = (float*)(ws + WS_RS2); float* gate = (float*)(ws + WS_GATE); int* tos = (int*)(ws + WS_TOS);
    unsigned char* Wgu_t = ws + WS_WGU; unsigned char* Wdn_t = ws + WS_WDN;
    unsigned char* hq = ws + WS_HB;
    bf16_t* qb_ = (bf16_t*)(ws + WS_Q); bf16_t* kb_ = (bf16_t*)(ws + WS_K); bf16_t* vb_ = (bf16_t*)(ws + WS_V); bf16_t* mix = (bf16_t*)(ws + WS_MIX);
    bf16_t* oslot = (bf16_t*)(ws + WS_OSLOT); bf16_t* hn = (bf16_t*)(ws + WS_HN); bf16_t* pbuf = (bf16_t*)(ws + WS_PB); bf16_t* qraw = (bf16_t*)(ws + WS_QRAW); bf16_t* kvraw = (bf16_t*)(ws + WS_KVRAW);
    unsigned char* act = ws + WS_ACT;

    for (int u = tid; u < (LDS_BYTES - MISC_OFF) / 4; u += NWAVES * 64) ((LAS unsigned*)(lds + MISC_OFF))[u] = 0u;
    __syncthreads();
    XcdBarrier bar; bar.bar = ctl + CW_BAR; bar.x = 0; bar.st = nullptr;
    if (N_LAUNCHES == 1) bar = xcd_barrier_post(ctl + CW_BAR, MISC + 8);
#define GRID_BAR() do { if (N_LAUNCHES == 1) xcd_barrier(bar); } while (0)
    const int lo = args.ph_lo, hi = args.ph_hi;
#define IN(k) (((PHMASK >> (k)) & 1) && lo <= (k) && (k) < hi)
#define BOTH(k) (IN(k) && IN((k) + 1))
    const int gw = vcu * NWAVES + wave, NGW = G * NWAVES;

    if (IN(0)) {
        LAS unsigned* scr = (LAS unsigned*)(lds + wave * 16384);
        constexpr int I_IN = (DM / 64) * (NPROJ / 64), I_UQ = (QL / 64) * (768 / 64), I_UKV = (KVL / 64) * (1024 / 64), I_O = (DM / 64) * (DM / 64);
        constexpr int I_GU1 = (DM / 128) * (2 * DFF / 64), I_GU = NE * I_GU1, I_DN1 = (DFF / 128) * (DM / 64), I_DN = NE * I_DN1;
        constexpr int NITEMS = I_IN + I_UQ + I_UKV + I_O + I_GU + I_DN;
        for (int it = gw; it < NITEMS; it += NGW) {
            int r = it;
            if (r < I_GU) { const int e = r / I_GU1, q = r % I_GU1, nblk = 2 * DFF / 64, kb = q / nblk, nb = q % nblk, n0 = nb * 64, j = n0 & (DFF - 1), up = n0 >= DFF;
                p0_transpose_item8(w_gate_up + (size_t)e * DM * 2 * DFF, DM, 2 * DFF, Wgu_t + (size_t)e * 2 * DFF * DM, (j >> 7) * 256 + (j & 127) + (up ? 128 : 0), norm_ffn, scr, kb * 128, n0, lane); continue; } r -= I_GU;
            if (r < I_DN) { const int e = r / I_DN1, q = r % I_DN1, nblk = DM / 64, kb = q / nblk, nb = q % nblk;
                p0_transpose_item8(w_down + (size_t)e * DFF * DM, DFF, DM, Wdn_t + (size_t)e * DM * DFF, nb * 64, nullptr, scr, kb * 128, nb * 64, lane); continue; } r -= I_DN;
            if (r < I_IN) { const int nblk = NPROJ / 64, kb = r / nblk, nb = r % nblk, n0 = nb * 64;
                const int d0 = (n0 < 1536) ? n0 : (n0 < 1920 ? n0 + (PB_CQ - 1536) : (n0 < 2176 ? n0 - (1920 - PB_CKV) : n0));
                p0_transpose_item(w_in, DM, NPROJ, Win_t, d0, nullptr, scr, kb * 64, n0, lane); continue; } r -= I_IN;
            if (r < I_UQ) { const int nblk = 768 / 64, kb = r / nblk, nb = r % nblk, h = nb / 3, part = nb % 3;
                p0_transpose_item(w_uq, QL, 768, Wuq_t, h * 256 + part * 64, q_norm, scr, kb * 64, nb * 64, lane, part == 2); continue; } r -= I_UQ;
            if (r < I_UKV) { const int nblk = 1024 / 64, kb = r / nblk, nb = r % nblk; p0_transpose_item(w_ukv, KVL, 1024, Wukv_t, nb * 64, kv_norm, scr, kb * 64, nb * 64, lane); continue; } r -= I_UKV;
            { const int nblk = DM / 64, kb = r / nblk, nb = r % nblk; p0_transpose_item(w_o, DM, DM, Wo_t, nb * 64, nullptr, scr, kb * 64, nb * 64, lane); }
        }
        const int gt = vcu * (NWAVES * 64) + tid, NGT = G * NWAVES * 64;
        for (int i = gt; i < (NPP - NPROJ) * DM / 8; i += NGT) *(u32x4*)(Win_t + (size_t)NPROJ * DM + (size_t)i * 8) = (u32x4){0u, 0u, 0u, 0u};
        for (int i = gt; i < NH * 64 * QL / 8; i += NGT) { const int h = i / (64 * QL / 8), j = i % (64 * QL / 8); *(u32x4*)(Wuq_t + (size_t)(h * 256 + 192) * QL + (size_t)j * 8) = (u32x4){0u, 0u, 0u, 0u}; }
        for (int i = gt; i < NE * DM; i += NGT) { const int e = i / DM, k = i % DM; const float v = w_router[(size_t)k * NE + e] * norm_ffn[k]; const unsigned h = f2bf(v); const float hf = __builtin_bit_cast(float, h << 16);
            WrH[i] = (bf16_t)h; WrL[i] = (bf16_t)f2bf(v - hf); }
        for (int i = gt; i < SEQ * 32; i += NGT) { const int pos = i >> 5, fi = i & 31; const float inv = exp2f(-(float)fi * (13.287712379549449f / 32.f)); const float ang = (float)pos * inv; float s, c; sincosf(ang, &s, &c); rope_t[i] = (f32x2){c, s}; }
        for (int m = 2 * gw; m < NTOK; m += 2 * NGW) {
            const f32x4* xr = (const f32x4*)(x + (size_t)m * DM) + lane; const f32x4* gr = (const f32x4*)norm_mix + lane;
            f32x4 v[2][4]; float s0 = 0.f, s1 = 0.f;
#pragma unroll
            for (int j = 0; j < 4; ++j) { v[0][j] = __builtin_nontemporal_load(xr + 64 * j); v[1][j] = __builtin_nontemporal_load(xr + DM / 4 + 64 * j); }
#pragma unroll
            for (int j = 0; j < 4; ++j) { s0 += (v[0][j].x * v[0][j].x + v[0][j].y * v[0][j].y) + (v[0][j].z * v[0][j].z + v[0][j].w * v[0][j].w);
                                          s1 += (v[1][j].x * v[1][j].x + v[1][j].y * v[1][j].y) + (v[1][j].z * v[1][j].z + v[1][j].w * v[1][j].w); }
            const float r0 = 1.0f / sqrtf(wave_sum(s0) * (1.f / DM) + EPS), r1 = 1.0f / sqrtf(wave_sum(s1) * (1.f / DM) + EPS);
            u32x2* o8 = (u32x2*)(hn + (size_t)m * DM) + lane;
#pragma unroll
            for (int j = 0; j < 4; ++j) { const f32x4 g = gr[64 * j]; u32x2 w;
                w.x = cvt_pk_bf16(v[0][j].x * r0 * g.x, v[0][j].y * r0 * g.y); w.y = cvt_pk_bf16(v[0][j].z * r0 * g.z, v[0][j].w * r0 * g.w); o8[64 * j] = w;
                w.x = cvt_pk_bf16(v[1][j].x * r1 * g.x, v[1][j].y * r1 * g.y); w.y = cvt_pk_bf16(v[1][j].z * r1 * g.z, v[1][j].w * r1 * g.w); o8[DM / 4 + 64 * j] = w; }
        }
        if (BOTH(0)) GRID_BAR();
    }

    if (IN(1)) {
        pg8::DenseSched S; S.init(hn, DM, Win_t, NTOK, NPP, DM, G, bx);
        pg8::EpiProj E{pbuf, ssq};
        pg8::gemm_phase<pg8::EpiProj, pg8::DenseSched, false>(lds, S, E);
        if (BOTH(1)) GRID_BAR();
    }

    if (IN(2)) {
        {
            const int gt = vcu * (NWAVES * 64) + tid, NGT = G * NWAVES * 64;
            for (int it = gt; it < (NTOK / 16) * 64; it += NGT) {
                const int run = it >> 6, gr = it & 63, t0 = run * 16, ch = gr * 8;
                float w0[8], w1[8], w2[8];
#pragma unroll
                for (int i = 0; i < 8; ++i) { w0[i] = conv_w[ch + i]; w1[i] = conv_w[CONVW + ch + i]; w2[i] = conv_w[2 * CONVW + ch + i]; }
                float um2[8], um1[8];
#pragma unroll
                for (int i = 0; i < 8; ++i) { um2[i] = 0.f; um1[i] = 0.f; }
                if ((t0 & (SEQ - 1)) != 0) {
                    float c8[8], x8[8];
                    unpack8(*(const u32x4*)(pbuf + (size_t)(t0 - 2) * NPP + PB_C + ch), c8); unpack8(*(const u32x4*)(pbuf + (size_t)(t0 - 2) * NPP + PB_X + ch), x8);
#pragma unroll
                    for (int i = 0; i < 8; ++i) um2[i] = c8[i] * x8[i];
                    unpack8(*(const u32x4*)(pbuf + (size_t)(t0 - 1) * NPP + PB_C + ch), c8); unpack8(*(const u32x4*)(pbuf + (size_t)(t0 - 1) * NPP + PB_X + ch), x8);
#pragma unroll
                    for (int i = 0; i < 8; ++i) um1[i] = c8[i] * x8[i];
                }
#pragma unroll 4
                for (int t = 0; t < 16; ++t) {
                    const bf16_t* pr = pbuf + (size_t)(t0 + t) * NPP + ch;
                    float b8[8], c8[8], x8[8], o8[8];
                    unpack8(__builtin_nontemporal_load((const u32x4*)(pr + PB_B)), b8); unpack8(__builtin_nontemporal_load((const u32x4*)(pr + PB_C)), c8); unpack8(__builtin_nontemporal_load((const u32x4*)(pr + PB_X)), x8);
#pragma unroll
                    for (int i = 0; i < 8; ++i) { const float uu = c8[i] * x8[i]; o8[i] = b8[i] * (w0[i] * um2[i] + w1[i] * um1[i] + w2[i] * uu); um2[i] = um1[i]; um1[i] = uu; }
                    *(u32x4*)(mix + (size_t)(t0 + t) * DM + ch) = pack8(o8);
                }
            }
        }
        LAS float* etab = (LAS float*)(lds + EPI_TAB_OFF);
        { pg8::DenseSched S; S.init(pbuf + PB_CQ, NPP, Wuq_t, NTOK, NQP, QL, G, bx); pg8::EpiQ E{qb_, ssq, q_head_norm, rope_t, etab};
          pg8::gemm_phase<pg8::EpiQ, pg8::DenseSched, false>(lds, S, E); }
        { pg8::DenseSched S; S.init(pbuf + PB_CKV, NPP, Wukv_t, NTOK, 1024, KVL, G, bx); pg8::EpiKV E{kb_, vb_, ssq, k_head_norm, rope_t, pbuf, etab};
          pg8::gemm_phase<pg8::EpiKV, pg8::DenseSched, false>(lds, S, E); }
        if (BOTH(2)) GRID_BAR();
    }


    if (IN(4)) {
        for (int u = vcu; u < NB * NH * 4; u += G) {
            const int bh = u >> 2, pr = u & 3, b = bh >> 2, h = bh & 3;
            att::attn_unit(b, h, 7 - pr, qb_, kb_, vb_, mix + CONVW, lds);
            att::attn_unit(b, h, pr, qb_, kb_, vb_, mix + CONVW, lds);
        }
        if (BOTH(4)) GRID_BAR();
    }

    if (IN(5)) {
        pg8::DenseSched S; S.init(mix, DM, Wo_t, NTOK, DM, DM, G, bx);
        pg8::EpiOut E{x, out, ssq};
        pg8::gemm_phase<pg8::EpiOut, pg8::DenseSched, false>(lds, S, E);
        if (BOTH(5)) GRID_BAR();
    }

    if (IN(6)) {
        LAS unsigned* hist = (LAS unsigned*)(lds + MISC_OFF) + 128; LAS unsigned* base = (LAS unsigned*)(lds + MISC_OFF) + 160;
        const int tj = lane & 15, q = lane >> 4;
        for (int tile = vcu; tile < NTOK / 128; tile += G) {
            if (tid < 32) hist[tid] = 0u;
            __syncthreads();
            const int token = tile * 128 + wave * 16 + tj;
            const float* hrow = out + (size_t)token * DM + q * 8;
            const bf16_t* wh0 = WrH + (size_t)tj * DM + q * 8; const bf16_t* wl0 = WrL + (size_t)tj * DM + q * 8;
            f32x4 a0 = {0.f, 0.f, 0.f, 0.f}, a1 = {0.f, 0.f, 0.f, 0.f};
            float s2 = 0.f;
#pragma unroll
            for (int p = 0; p < 16; ++p) s2 += ssq[(size_t)p * NTOK + token];
            const float rs = 1.0f / sqrtf(s2 * (1.f / DM) + EPS);
            unsigned char* hqrow = hq + (size_t)token * DM + q * 8;
#pragma unroll 4
            for (int ks = 0; ks < DM / 32; ++ks) {
                const f32x4 h0 = *(const f32x4*)(hrow + ks * 32), h1 = *(const f32x4*)(hrow + ks * 32 + 4);
                float hf[8] = {h0[0], h0[1], h0[2], h0[3], h1[0], h1[1], h1[2], h1[3]}; float lf[8];
                { u32x2 w8; w8.x = pk4_fp8(hf[0] * rs, hf[1] * rs, hf[2] * rs, hf[3] * rs); w8.y = pk4_fp8(hf[4] * rs, hf[5] * rs, hf[6] * rs, hf[7] * rs); *(u32x2*)(hqrow + ks * 32) = w8; }
                u32x4 hw; hw.x = pk2(hf[0], hf[1]); hw.y = pk2(hf[2], hf[3]); hw.z = pk2(hf[4], hf[5]); hw.w = pk2(hf[6], hf[7]);
                { float hb8[8]; unpack8(hw, hb8);
#pragma unroll
                  for (int i = 0; i < 8; ++i) lf[i] = hf[i] - hb8[i]; }
                const bf16x8 bh = __builtin_bit_cast(bf16x8, hw), bl = __builtin_bit_cast(bf16x8, pack8(lf));
                const bf16x8 wh_a = *(const bf16x8*)(wh0 + ks * 32), wh_b = *(const bf16x8*)(wh0 + 16 * DM + ks * 32);
                const bf16x8 wl_a = *(const bf16x8*)(wl0 + ks * 32), wl_b = *(const bf16x8*)(wl0 + 16 * DM + ks * 32);
                a0 = __builtin_amdgcn_mfma_f32_16x16x32_bf16(wh_a, bh, a0, 0, 0, 0); a0 = __builtin_amdgcn_mfma_f32_16x16x32_bf16(wl_a, bh, a0, 0, 0, 0); a0 = __builtin_amdgcn_mfma_f32_16x16x32_bf16(wh_a, bl, a0, 0, 0, 0);
                a1 = __builtin_amdgcn_mfma_f32_16x16x32_bf16(wh_b, bh, a1, 0, 0, 0); a1 = __builtin_amdgcn_mfma_f32_16x16x32_bf16(wl_b, bh, a1, 0, 0, 0); a1 = __builtin_amdgcn_mfma_f32_16x16x32_bf16(wh_b, bl, a1, 0, 0, 0);
            }
            float lv[8]; int le[8];
#pragma unroll
            for (int i = 0; i < 4; ++i) { le[i] = 4 * q + i; le[4 + i] = 16 + 4 * q + i; lv[i] = a0[i] * rs + b_router[le[i]]; lv[4 + i] = a1[i] * rs + b_router[le[4 + i]]; }
            float tv[4]; int te[4];
#pragma unroll
            for (int k = 0; k < TOPK; ++k) {
                float bv = lv[0]; int be = le[0];
#pragma unroll
                for (int i = 1; i < 8; ++i) if (lv[i] > bv) { bv = lv[i]; be = le[i]; }
#pragma unroll
                for (int o = 16; o < 64; o <<= 1) { const float ov = __shfl_xor(bv, o); const int oe = __shfl_xor(be, o); if (ov > bv || (ov == bv && oe < be)) { bv = ov; be = oe; } }
                tv[k] = bv; te[k] = be;
#pragma unroll
                for (int i = 0; i < 8; ++i) if (le[i] == be) lv[i] = -3.0e38f;
            }
            float ge[4]; float gs = 0.f;
#pragma unroll
            for (int k = 0; k < TOPK; ++k) { ge[k] = __expf(tv[k] - tv[0]); gs += ge[k]; }
            const float ginv = 1.0f / gs;
            int my_e = te[0]; float my_g = ge[0];
#pragma unroll
            for (int k = 1; k < TOPK; ++k) if (q == k) { my_e = te[k]; my_g = ge[k]; }
            my_g *= ginv;
            const unsigned pl = atomicAdd((unsigned*)(hist + my_e), 1u);
            __syncthreads();
            if (tid < 32) base[tid] = __hip_atomic_fetch_add(ctl + CW_CNT + 64 * tid, hist[tid], __ATOMIC_RELAXED, __HIP_MEMORY_SCOPE_AGENT);
            __syncthreads();
            const unsigned pos = base[my_e] + pl; const int slot = token * 4 + q;
            tos[(size_t)my_e * CAP + pos] = slot; gate[slot] = my_g;
            __syncthreads();
        }
        if (BOTH(6)) GRID_BAR();
    }

    LAS int* tab = (LAS int*)(lds + MISC_OFF) + 16;
    if (IN(7) || IN(8) || IN(10) || IN(11) || IN(12)) {
        if (tid < 32) { const int c = (int)__hip_atomic_load(ctl + CW_CNT + 64 * tid, __ATOMIC_RELAXED, __HIP_MEMORY_SCOPE_AGENT); tab[48 + tid] = c; }
        __syncthreads();
        if (tid == 0) { int s = 0; for (int e = 0; e < NE; ++e) { tab[e] = s; s += (tab[48 + e] + 255) >> 8; } tab[32] = s; }
        __syncthreads();
        for (int t = tid; t < tab[32]; t += NWAVES * 64) { int e = 0; while (e < NE - 1 && tab[e + 1] <= t) ++e; tab[2288 + t] = e; }
        __syncthreads();
    }

    if (IN(7)) {
        pg8::MoeSched S{hq, Wgu_t, DM, DM, 2 * DFF / 256, G, bx, (size_t)2 * DFF * DM, tab, tos};
        pg8::EpiSwiglu E{act, b_gate_up};
        pg8::gemm_phase<pg8::EpiSwiglu, pg8::MoeSched, true>(lds, S, E);
        if (BOTH(7)) GRID_BAR();
    }

    if (IN(8)) {
        pg8::MoeSched S{act, Wdn_t, DFF, DFF, DM / 256, G, bx, (size_t)DM * DFF, tab, tos};
        pg8::EpiDown E{oslot, b_down, gate, tos, (bf16_t*)(ws + WS_SSQ)};
        pg8::gemm_phase<pg8::EpiDown, pg8::MoeSched, false>(lds, S, E);
        if (BOTH(8)) GRID_BAR();
    }

#if PROBE_DOUBLE
    if (IN(10)) { pg8::MoeSched S{hq, Wgu_t, DM, DM, 2 * DFF / 256, G, bx, (size_t)2 * DFF * DM, tab, tos}; pg8::EpiNull E{(float*)(ws + WS_SSQ)};
        pg8::gemm_phase<pg8::EpiNull, pg8::MoeSched, true>(lds, S, E); }
    if (IN(11)) { pg8::MoeSched S{act, Wgu_t, DM, DM, 2 * DFF / 256, G, bx, (size_t)2 * DFF * DM, tab, tos}; pg8::EpiNull E{(float*)(ws + WS_SSQ)};
        pg8::gemm_phase<pg8::EpiNull, pg8::MoeSched, false>(lds, S, E); }
    if (IN(12)) { pg8::MoeSched S{act, Wdn_t, DFF, DFF, DM / 256, G, bx, (size_t)DM * DFF, tab, tos}; pg8::EpiNull E{(float*)(ws + WS_SSQ)};
        pg8::gemm_phase<pg8::EpiNull, pg8::MoeSched, false>(lds, S, E); }
#endif
    if (IN(9)) {
        for (int m = gw; m < NTOK; m += NGW) {
            f32x4* orow = (f32x4*)(out + (size_t)m * DM) + lane;
            const u32x2* s0 = (const u32x2*)(oslot + (size_t)m * 4 * DM) + lane;
#pragma unroll
            for (int j = 0; j < 4; ++j) { f32x4 v = __builtin_nontemporal_load(orow + 64 * j);
#pragma unroll
                for (int k = 0; k < 4; ++k) { const u32x2 w = __builtin_nontemporal_load(s0 + (size_t)k * (DM / 4) + 64 * j); v.x += bf_lo(w.x); v.y += bf_hi(w.x); v.z += bf_lo(w.y); v.w += bf_hi(w.y); }
                __builtin_nontemporal_store(v, orow + 64 * j); }
        }
    }
#undef IN
#undef BOTH
#undef GRID_BAR
}

#ifdef DIAG_PHASES
template __global__ void fwd_kernel_t<1>(Args); template __global__ void fwd_kernel_t<2>(Args); template __global__ void fwd_kernel_t<4>(Args); template __global__ void fwd_kernel_t<8>(Args);
template __global__ void fwd_kernel_t<16>(Args); template __global__ void fwd_kernel_t<32>(Args); template __global__ void fwd_kernel_t<64>(Args); template __global__ void fwd_kernel_t<128>(Args);
template __global__ void fwd_kernel_t<256>(Args); template __global__ void fwd_kernel_t<512>(Args);
#endif
#define fwd_kernel fwd_kernel_t<(PROBE_DOUBLE ? 0x1fff : 1023)>
extern "C" void kernel_launch(void* const* d_in, const int* in_sizes, int n_in, void* d_out, int out_size, void* d_ws, size_t ws_size, hipStream_t stream) {
    static int grid = 0;
    if (grid == 0) {
        if (n_in != 18 || in_sizes[0] != NTOK * DM || out_size != NTOK * DM || ws_size < WS_END) { fprintf(stderr, "kernel_launch: shape/workspace mismatch (n_in %d, in0 %d, out %d, ws %zu, need %zu)\n", n_in, n_in > 0 ? in_sizes[0] : -1, out_size, ws_size, (size_t)WS_END); grid = -1; return; }
        int dev = 0, cus = 0, per_cu = 0;
        if (hipGetDevice(&dev) != hipSuccess || hipDeviceGetAttribute(&cus, hipDeviceAttributeMultiprocessorCount, dev) != hipSuccess) { grid = -1; return; }
        if (hipFuncSetAttribute((const void*)fwd_kernel, hipFuncAttributeMaxDynamicSharedMemorySize, LDS_BYTES) != hipSuccess) { fprintf(stderr, "kernel_launch: hipFuncSetAttribute failed\n"); grid = -1; return; }
        if (hipOccupancyMaxActiveBlocksPerMultiprocessor(&per_cu, (const void*)fwd_kernel, NWAVES * 64, LDS_BYTES) != hipSuccess || per_cu < 1) { fprintf(stderr, "kernel_launch: occupancy query says %d\n", per_cu); }
        (void)hipGetLastError();
        grid = cus;
    }
    if (grid < 0) return;
    if (hipMemsetAsync((char*)d_ws + WS_CTL, 0, CTL_ZERO_BYTES, stream) != hipSuccess) return;
    Args a{};
    for (int i = 0; i < 18; ++i) a.in[i] = (const float*)d_in[i];
    a.out = (float*)d_out; a.ws = (unsigned char*)d_ws;
    if (N_LAUNCHES == 1) { a.ph_lo = 0; a.ph_hi = N_PHASES; hipLaunchKernelGGL(fwd_kernel, dim3(grid), dim3(NWAVES * 64), LDS_BYTES, stream, a); }
    else { for (int p = 0; p < N_PHASES; ++p) { a.ph_lo = p; a.ph_hi = p + 1; const int reps = ((PROBE_DOUBLE >> p) & 1) ? 2 : 1;
            for (int r = 0; r < reps; ++r) hipLaunchKernelGGL(fwd_kernel, dim3(grid), dim3(NWAVES * 64), LDS_BYTES, stream, a);
            if (p == 8) for (int pp = 10; pp < 13; ++pp) if ((PROBE_DOUBLE >> pp) & 1) { a.ph_lo = pp; a.ph_hi = pp + 1; hipLaunchKernelGGL(fwd_kernel, dim3(grid), dim3(NWAVES * 64), LDS_BYTES, stream, a); } } }
}
```

```cpp
#include <hip/hip_runtime.h>
#include <cstdio>
#include <cstdint>

#ifndef MK_N_LAUNCHES
#define MK_N_LAUNCHES 1
#endif

#ifndef PROBE_DOUBLE
#define PROBE_DOUBLE 0
#endif
#define LAS __attribute__((address_space(3)))
#define GAS __attribute__((address_space(1)))
typedef unsigned short bf16_t;
typedef short bf16x8 __attribute__((ext_vector_type(8)));
typedef short s16x4 __attribute__((ext_vector_type(4)));
typedef float f32x2 __attribute__((ext_vector_type(2)));
typedef float f32x4 __attribute__((ext_vector_type(4)));
typedef float f32x16 __attribute__((ext_vector_type(16)));
typedef unsigned u32x2 __attribute__((ext_vector_type(2)));
typedef unsigned u32x4 __attribute__((ext_vector_type(4)));
typedef int v4i_t __attribute__((ext_vector_type(4)));
typedef int v8i_t __attribute__((ext_vector_type(8)));

constexpr int NB = 16, SEQ = 2048, NTOK = NB * SEQ, DM = 1024;
constexpr int CONVW = 512, QL = 384, KVL = 256, ROPE = 64, NH = 4, QKN = 128, QKH = 192, VH = 128;
constexpr int NPROJ = 2240, NPP = 2304;
constexpr int PB_B = 0, PB_C = 512, PB_X = 1024, PB_CKV = 1536, PB_CQ = 1792, PB_KPE = 2176;
constexpr int NQP = 1024;
constexpr int NE = 32, TOPK = 4, DFF = 1024, NSLOT = NTOK * TOPK;
constexpr int CAP = NTOK;
constexpr int MAXTILES = NSLOT / 256 + NE;
constexpr float EPS = 1e-6f;
constexpr float QSCALE = 0.07216878364870322f * 1.4426950408889634f;
constexpr float SWI_LIMIT = 7.0f, SWI_ALPHA = 1.702f;
constexpr float W8_SCALE = 64.f, ACT8_SCALE = 4.f, OS8_SCALE = 16.f;

constexpr size_t MiB = 1u << 20;
constexpr size_t WS_CTL = 0, CTL_ZERO_BYTES = 1 * MiB;
constexpr size_t WS_ROPE = 1 * MiB;
constexpr size_t WS_WRH = 1 * MiB + 512 * 1024, WS_WRL = WS_WRH + 64 * 1024;
constexpr size_t WS_WIN = 2 * MiB;
constexpr size_t WS_WUQ = 8 * MiB, WS_WUKV = 9 * MiB, WS_WO = 10 * MiB;
constexpr size_t WS_SSQ = 12 * MiB;
constexpr size_t WS_RS2 = 14 * MiB, WS_GATE = 14 * MiB + 512 * 1024;
constexpr size_t WS_TOS = 16 * MiB;
constexpr size_t WS_WGU = 32 * MiB, WS_WDN = 160 * MiB;
constexpr size_t WS_HB = 224 * MiB;
constexpr size_t WS_Q = 288 * MiB, WS_K = 336 * MiB, WS_V = 384 * MiB, WS_MIX = 416 * MiB;
constexpr size_t WS_OSLOT = 288 * MiB;
constexpr size_t WS_HN = 544 * MiB, WS_PB = 608 * MiB, WS_QRAW = 752 * MiB, WS_KVRAW = 800 * MiB;
constexpr size_t WS_ACT = 544 * MiB;
constexpr size_t WS_END = 864 * MiB;
constexpr int CW_BAR = 4096;
constexpr int CW_CNT = 16384;

constexpr int RING_BYTES = 131072;
constexpr int MISC_OFF = RING_BYTES;
constexpr int LDS_BYTES = 155648;
constexpr int EPI_TAB_OFF = MISC_OFF + 3072 * 4;

__device__ __forceinline__ unsigned cvt_pk_bf16(float lo, float hi) { unsigned r; asm volatile("v_cvt_pk_bf16_f32 %0, %1, %2" : "=v"(r) : "v"(lo), "v"(hi)); return r; }
__device__ __forceinline__ unsigned f2bf(float f) { unsigned u = __builtin_bit_cast(unsigned, f); return (u + 0x7fffu + ((u >> 16) & 1u)) >> 16; }
__device__ __forceinline__ unsigned pk2(float lo, float hi) { return f2bf(lo) | (f2bf(hi) << 16); }
__device__ __forceinline__ float bf_lo(unsigned w) { return __builtin_bit_cast(float, w << 16); }
__device__ __forceinline__ float bf_hi(unsigned w) { return __builtin_bit_cast(float, w & 0xffff0000u); }
__device__ __forceinline__ void unpack8(const u32x4 w, float* f) { f[0] = bf_lo(w.x); f[1] = bf_hi(w.x); f[2] = bf_lo(w.y); f[3] = bf_hi(w.y); f[4] = bf_lo(w.z); f[5] = bf_hi(w.z); f[6] = bf_lo(w.w); f[7] = bf_hi(w.w); }
__device__ __forceinline__ u32x4 pack8(const float* f) { u32x4 w; w.x = cvt_pk_bf16(f[0], f[1]); w.y = cvt_pk_bf16(f[2], f[3]); w.z = cvt_pk_bf16(f[4], f[5]); w.w = cvt_pk_bf16(f[6], f[7]); return w; }
__device__ __forceinline__ float wave_sum(float v) {
#pragma unroll
    for (int o = 1; o < 64; o <<= 1) v += __shfl_xor(v, o);
    return v;
}
__device__ __forceinline__ float half_sum(float v) {
#pragma unroll
    for (int o = 1; o < 32; o <<= 1) v += __shfl_xor(v, o);
    return v;
}
__device__ __forceinline__ float clamp448(float v) { return __builtin_amdgcn_fmed3f(v, -448.f, 448.f); }
__device__ __forceinline__ unsigned pk4_fp8(float a, float b, float c, float d) {
    unsigned w = 0u; w = (unsigned)__builtin_amdgcn_cvt_pk_fp8_f32(clamp448(a), clamp448(b), (int)w, false); w = (unsigned)__builtin_amdgcn_cvt_pk_fp8_f32(clamp448(c), clamp448(d), (int)w, true); return w; }
#define LDS_WAIT() asm volatile("s_waitcnt lgkmcnt(0)" ::: "memory")
#define VM_WAIT() asm volatile("s_waitcnt vmcnt(0)" ::: "memory")

namespace pg8 {
constexpr int BM = 256, BK = 64, HALF = 128, HTB = HALF * BK * 2, STAGE_BYTES = 8 * HTB, NXCD = 8, WGM = 8;
__host__ __device__ __forceinline__ int lds_byte(int r, int c) { const int st = (r >> 4) * 2 + (c >> 5), rr = r & 15, cc = c & 31, ob = rr * 64 + cc * 2; return st * 1024 + (ob ^ (((ob >> 9) & 1) << 5)); }
__host__ __device__ __forceinline__ void stage_rc(int b, int& R, int& C) { const int st = b / 1024, sb = b % 1024, swz = sb ^ (((sb >> 9) & 1) << 5); R = (st >> 1) * 16 + swz / 64; C = (st & 1) * 32 + (swz % 64) / 2; }
__host__ __device__ __forceinline__ int perm32(int rho) { const int n = rho >> 4, i = rho & 15; return 8 * (i >> 2) + 4 * n + (i & 3); }

struct Unit { int pm, pn, e, p0, cnt, par; };

struct DenseSched {
    static constexpr int ESZ = 2;
    const bf16_t* A; const bf16_t* Bt; int lda, K, nM, nN, nwg, G, c;
    __device__ void init(const bf16_t* A_, int lda_, const bf16_t* Bt_, int M, int N, int K_, int G_, int c_) { A = A_; Bt = Bt_; lda = lda_; K = K_; nM = M / BM; nN = N / BM; nwg = nM * nN; G = G_; c = c_; }
    __device__ __forceinline__ bool next(int i, Unit& u) const {
        const long L = (long)i * G + c; if (L >= nwg) return false;
        int wgid = (int)L; { const int q = nwg / NXCD, r = nwg % NXCD, xcd = wgid % NXCD, off = wgid / NXCD; wgid = (xcd < r ? xcd * (q + 1) : r * (q + 1) + (xcd - r) * q) + off; }
        const int nig = WGM * nN, gid = wgid / nig, fm = gid * WGM, gsz = (nM - fm) < WGM ? (nM - fm) : WGM;
        u.pm = fm + ((wgid % nig) % gsz); u.pn = (wgid % nig) / gsz; u.e = 0; u.p0 = 0; u.cnt = 0; return true;
    }
    __device__ __forceinline__ unsigned a_off(const Unit& u) const { return (unsigned)u.pm * (unsigned)(BM * lda * 2); }
    __device__ __forceinline__ unsigned b_off(const Unit& u) const { return (unsigned)u.pn * (unsigned)(BM * K * 2); }
    __device__ __forceinline__ unsigned a_rowoff(const Unit&, int) const { return 0u; }
    static constexpr bool META = false;
    __device__ __forceinline__ void meta_first(const Unit&, LAS unsigned char*) const {}
    __device__ __forceinline__ void meta_issue(const Unit&, unsigned (&)[4], const int (&)[2]) const {}
    __device__ __forceinline__ void meta_commit(const Unit&, unsigned (&)[4], LAS unsigned char*) const {}
    __device__ __forceinline__ unsigned meta_rowoff(const Unit&, unsigned, int) const { return 0u; }
};
struct MoeSched {
    static constexpr int ESZ = 1;
    const unsigned char* A; const unsigned char* Bt; int lda, K, nN, G, c; size_t estride; const LAS int* tab; const int* tos;
    static constexpr bool META = true;
    static constexpr int META_OFF = MISC_OFF + 4608 * 4;
    __device__ __forceinline__ bool next(int i, Unit& u) const {
        const int T = __builtin_amdgcn_readfirstlane(tab[32]), nwg = T * nN;
        const long L = (long)i * G + c; if (L >= nwg) return false;
        int wgid = (int)L; { const int q = nwg / NXCD, r = nwg % NXCD, xcd = wgid % NXCD, off = wgid / NXCD; wgid = (xcd < r ? xcd * (q + 1) : r * (q + 1) + (xcd - r) * q) + off; }
        const int nig = WGM * nN, gid = wgid / nig, fm = gid * WGM, gsz = (T - fm) < WGM ? (T - fm) : WGM;
        const int mt = fm + ((wgid % nig) % gsz); u.pm = mt; u.pn = (wgid % nig) / gsz;
        const int e = __builtin_amdgcn_readfirstlane(tab[2288 + mt]);
        u.e = e; u.p0 = (mt - __builtin_amdgcn_readfirstlane(tab[e])) * BM; u.cnt = __builtin_amdgcn_readfirstlane(tab[48 + e]); return true;
    }
    __device__ __forceinline__ unsigned a_off(const Unit& u) const { return (unsigned)u.pm * (unsigned)(BM * lda); }
    __device__ __forceinline__ unsigned b_off(const Unit& u) const { return (unsigned)u.e * (unsigned)estride + (unsigned)u.pn * (unsigned)(BM * K); }
    __device__ __forceinline__ unsigned a_rowoff(const Unit& u, int r) const {
        const int p = u.p0 + r; const int sv = tos[((size_t)u.e * CAP + p) * 2];
        const int slot = (p < u.cnt) ? sv : 0;
        return (unsigned)(slot >> 2) * (unsigned)lda;
    }
    __device__ __forceinline__ void meta_first(const Unit& u, LAS unsigned char* lds) const {
        if (threadIdx.x < BM) { const u32x2 v = *(const u32x2*)(tos + ((size_t)u.e * CAP + u.p0 + threadIdx.x) * 2); *(LAS u32x2*)(lds + META_OFF + u.par * 2048 + threadIdx.x * 8) = v; }
    }
    __device__ __forceinline__ void meta_issue(const Unit& u, unsigned (&mreg)[4], const int (&RA)[2]) const {
        const unsigned base = ((unsigned)u.e * (unsigned)CAP + (unsigned)u.p0) * 8u;
        if (nN == 8) {
#pragma unroll
            for (int k = 0; k < 4; ++k) { const unsigned off = base + (unsigned)((k >> 1) * HALF + RA[k & 1]) * 8u;
                asm volatile("global_load_dword %0, %1, %2" : "=v"(mreg[k]) : "v"(off), "s"(tos) : "memory"); }
        } else {
            const unsigned off = base + (threadIdx.x & 255u) * 8u; u32x2 v;
            asm volatile("global_load_dwordx2 %0, %1, %2" : "=v"(v) : "v"(off), "s"(tos) : "memory"); mreg[0] = v.x; mreg[1] = v.y;
        }
    }
    __device__ __forceinline__ void meta_commit(const Unit& u, unsigned (&mreg)[4], LAS unsigned char* lds) const {
        asm volatile("" : "+v"(mreg[0]), "+v"(mreg[1]) :: "memory");
        if (threadIdx.x < BM) *(LAS u32x2*)(lds + META_OFF + u.par * 2048 + threadIdx.x * 8) = (u32x2){mreg[0], mreg[1]};
    }
    __device__ __forceinline__ unsigned meta_rowoff(const Unit& u, unsigned sv, int r) const {
        asm volatile("" : "+v"(sv) :: "memory");
        const int slot = (u.p0 + r < u.cnt) ? (int)sv : 0;
        return (unsigned)(slot >> 2) * (unsigned)lda;
    }
};

template <class Epi, class Sched, bool GATHER, int KREP = 1>
__device__ __forceinline__ void gemm_phase(LAS unsigned char* lds, const Sched& S, const Epi& E) {
    const int tid = threadIdx.x, wid = __builtin_amdgcn_readfirstlane(tid >> 6), lane = tid & 63, wr = wid >> 2, wc = wid & 3, fr = lane & 15, fq = lane >> 4;
    constexpr int ESZ = Sched::ESZ; constexpr bool F8 = (ESZ == 1);
    const int K = S.K * ESZ / 2, lda = S.lda * ESZ / 2, nt0 = K / BK, nt = nt0 * KREP;
    unsigned voffB[2], aoc[2][2], mreg[4] = {0u, 0u, 0u, 0u}; int RA[2], CA[2];
#pragma unroll
    for (int i = 0; i < 2; ++i) { int R, C; stage_rc(tid * 16 + i * 8192, R, C); const int Rb = (R & ~31) + perm32(R & 31);
        voffB[i] = (unsigned)(Rb * K + C) * 2u; RA[i] = R; CA[i] = C;
        aoc[0][i] = (unsigned)(R * lda + C) * 2u; aoc[1][i] = (unsigned)((R + HALF) * lda + C) * 2u; }
    const unsigned kstep = (unsigned)(BK * 2);
    const unsigned hstepB = (unsigned)(HALF * K * 2), hstepA = GATHER ? 0u : (unsigned)(HALF * lda * 2);
    const __amdgpu_buffer_rsrc_t rA = __builtin_amdgcn_make_buffer_rsrc((void*)S.A, 0, -1, 0x00020000), rB = __builtin_amdgcn_make_buffer_rsrc((void*)S.Bt, 0, -1, 0x00020000);
    const unsigned ldsw = (unsigned)wid * 1024u;
    const int aoff = lds_byte(wr * 64 + fr, fq * 8), boff = lds_byte(wc * 32 + fr, fq * 8);
#define PG8_SA(b, h) (((b) * 2 + (h)) * HTB)
#define PG8_SB(b, h) ((4 + (b) * 2 + (h)) * HTB)
#define PG8_STAGE_B(bufoff, soff) do { _Pragma("unroll") for (int _i = 0; _i < 2; ++_i) \
        __builtin_amdgcn_raw_ptr_buffer_load_lds(rB, (LAS void*)(lds + (bufoff) + ldsw + _i * 8192), 16, voffB[_i], (soff), 0, 0); } while (0)
#define PG8_STAGE_A(bufoff, soff, h) do { _Pragma("unroll") for (int _i = 0; _i < 2; ++_i) \
        __builtin_amdgcn_raw_ptr_buffer_load_lds(rA, (LAS void*)(lds + (bufoff) + ldsw + _i * 8192), 16, aoc[GATHER ? (h) : 0][_i], (soff) + (h) * hstepA, 0, 0); } while (0)
#define PG8_LDA(dst, b, h) do { _Pragma("unroll") for (int m = 0; m < 4; ++m) _Pragma("unroll") for (int k = 0; k < 2; ++k) dst[m][k] = *(const LAS bf16x8*)(lds + PG8_SA(b, h) + aoff + m * 2048 + k * 1024); } while (0)
#define PG8_LDB(dst, b, h) do { _Pragma("unroll") for (int n = 0; n < 2; ++n) _Pragma("unroll") for (int k = 0; k < 2; ++k) dst[n][k] = *(const LAS bf16x8*)(lds + PG8_SB(b, h) + boff + n * 2048 + k * 1024); } while (0)
#define PG8_CAT(x) __builtin_shufflevector(__builtin_bit_cast(v4i_t, x[0]), __builtin_bit_cast(v4i_t, x[1]), 0, 1, 2, 3, 4, 5, 6, 7)
#define PG8_MMA(ai, bj, At, Bt) do { __builtin_amdgcn_s_setprio(1); _Pragma("unroll") for (int m = 0; m < 4; ++m) _Pragma("unroll") for (int n = 0; n < 2; ++n) { \
        if constexpr (F8) { asm volatile("v_mfma_scale_f32_16x16x128_f8f6f4 %0, %1, %2, %0, %3, %3 op_sel_hi:[0,0,0]" : "+v"(acc[ai][bj][m][n]) : "v"(PG8_CAT(Bt[n])), "v"(PG8_CAT(At[m])), "v"(0x7f7f7f7f)); } \
        else { _Pragma("unroll") for (int k = 0; k < 2; ++k) acc[ai][bj][m][n] = __builtin_amdgcn_mfma_f32_16x16x32_bf16(Bt[n][k], At[m][k], acc[ai][bj][m][n], 0, 0, 0); } } \
        __builtin_amdgcn_s_setprio(0); } while (0)
#define PG8_WAIT_V(n) asm volatile("s_waitcnt vmcnt(" #n ")" ::: "memory")
#define PG8_WAIT_L(n) asm volatile("s_waitcnt lgkmcnt(" #n ")" ::: "memory")
#define PG8_BAR __builtin_amdgcn_s_barrier()
#define PG8_SCHED __builtin_amdgcn_sched_barrier(0)
    Unit cur, nxt; int ui = 0;
    if (!S.next(0, cur)) return;
    cur.par = 0; if constexpr (Sched::META && !GATHER) S.meta_first(cur, lds);
    f32x4 acc[2][2][4][2];
#pragma unroll
    for (int a = 0; a < 2; ++a)
#pragma unroll
        for (int b = 0; b < 2; ++b)
#pragma unroll
            for (int m = 0; m < 4; ++m)
#pragma unroll
                for (int n = 0; n < 2; ++n) acc[a][b][m][n] = (f32x4){0.f, 0.f, 0.f, 0.f};
    bf16x8 At[4][2], B0[2][2], B1[2][2];
    unsigned cA = GATHER ? 0u : S.a_off(cur), cB = S.b_off(cur);
    if constexpr (GATHER) {
#pragma unroll
        for (int h = 0; h < 2; ++h)
#pragma unroll
            for (int i = 0; i < 2; ++i) aoc[h][i] = S.a_rowoff(cur, h * HALF + RA[i]) + (unsigned)CA[i] * 2u;
    }
    PG8_STAGE_B(PG8_SB(0, 0), cB); PG8_STAGE_B(PG8_SB(0, 1), cB + hstepB); PG8_STAGE_A(PG8_SA(0, 0), cA, 0); PG8_STAGE_A(PG8_SA(0, 1), cA, 1);
    if (wr == 1) PG8_BAR;
    PG8_WAIT_V(2); PG8_BAR;
    PG8_STAGE_B(PG8_SB(1, 0), cB + kstep); PG8_STAGE_A(PG8_SA(1, 0), cA + kstep, 0); PG8_STAGE_B(PG8_SB(1, 1), cB + hstepB + kstep);
    PG8_WAIT_V(6); PG8_BAR;
    for (;;) {
        const bool has_next = S.next(ui + 1, nxt);
        const unsigned nA = GATHER ? 0u : (has_next ? S.a_off(nxt) : cA), nB = has_next ? S.b_off(nxt) : cB;
        nxt.par = (ui + 1) & 1;
        for (int t = 0; t < nt; t += 2) {
            const bool last = (t == nt - 2);
            const unsigned a1 = cA + (unsigned)((t + 1) % nt0) * kstep;
            const unsigned a2 = last ? nA : cA + (unsigned)((t + 2) % nt0) * kstep, b2 = last ? nB : cB + (unsigned)((t + 2) % nt0) * kstep;
            const unsigned a3 = a2 + kstep, b3 = b2 + kstep;
            PG8_LDB(B0, 0, 0); PG8_LDB(B1, 0, 1); PG8_SCHED; PG8_LDA(At, 0, 0); PG8_STAGE_A(PG8_SA(1, 1), a1, 1);
            PG8_WAIT_V(8); PG8_WAIT_L(0); PG8_BAR;
            if constexpr (Sched::META) { if (t == 0 && has_next) S.meta_issue(nxt, mreg, RA); }
            PG8_MMA(0, 0, At, B0); PG8_MMA(0, 1, At, B1); PG8_BAR; PG8_SCHED;
            if constexpr (Sched::META) { if (last && has_next) {
                if constexpr (GATHER) {
#pragma unroll
                    for (int h = 0; h < 2; ++h)
#pragma unroll
                        for (int i = 0; i < 2; ++i) aoc[h][i] = S.meta_rowoff(nxt, mreg[h * 2 + i], h * HALF + RA[i]) + (unsigned)CA[i] * 2u;
                } else S.meta_commit(nxt, mreg, lds); } }
            PG8_LDA(At, 0, 1); PG8_STAGE_B(PG8_SB(0, 0), b2); PG8_STAGE_B(PG8_SB(0, 1), b2 + hstepB); PG8_STAGE_A(PG8_SA(0, 0), a2, 0);
            PG8_WAIT_V(8); PG8_WAIT_L(0); PG8_BAR; PG8_MMA(1, 0, At, B0); PG8_MMA(1, 1, At, B1); PG8_BAR; PG8_SCHED;
            PG8_LDB(B0, 1, 0); PG8_LDB(B1, 1, 1); PG8_SCHED; PG8_LDA(At, 1, 0); PG8_STAGE_A(PG8_SA(0, 1), a2, 1);
            PG8_WAIT_V(8); PG8_WAIT_L(0); PG8_BAR; PG8_MMA(0, 0, At, B0); PG8_MMA(0, 1, At, B1); PG8_BAR; PG8_SCHED;
            PG8_LDA(At, 1, 1); PG8_STAGE_B(PG8_SB(1, 0), b3); PG8_STAGE_B(PG8_SB(1, 1), b3 + hstepB); PG8_STAGE_A(PG8_SA(1, 0), a3, 0);
            PG8_WAIT_V(8); PG8_WAIT_L(0); PG8_BAR; PG8_MMA(1, 0, At, B0); PG8_MMA(1, 1, At, B1); PG8_BAR; PG8_SCHED;
        }
        if (wr == 0) PG8_BAR;
        E(acc, cur, wr, wc, fr, fq);
        if (!has_next) break;
#pragma unroll
        for (int a = 0; a < 2; ++a)
#pragma unroll
            for (int b = 0; b < 2; ++b)
#pragma unroll
                for (int m = 0; m < 4; ++m)
#pragma unroll
                    for (int n = 0; n < 2; ++n) acc[a][b][m][n] = (f32x4){0.f, 0.f, 0.f, 0.f};
        cur = nxt; cA = nA; cB = nB; ++ui;
        if (wr == 1) PG8_BAR;
    }
    PG8_WAIT_V(0);
    PG8_BAR;
#undef PG8_SA
#undef PG8_SB
#undef PG8_STAGE_A
#undef PG8_STAGE_B
#undef PG8_LDA
#undef PG8_LDB
#undef PG8_MMA
#undef PG8_CAT
#undef PG8_WAIT_V
#undef PG8_WAIT_L
#undef PG8_BAR
#undef PG8_SCHED
}

struct EpiBf16 {
    bf16_t* O; int ldc;
    __device__ __forceinline__ void operator()(const f32x4 (&acc)[2][2][4][2], const Unit& u, int wr, int wc, int fr, int fq) const {
        asm volatile("" : "+v"(fr), "+v"(fq));
        const int row0 = u.pm * BM + wr * 64 + fr, col0 = u.pn * BM + wc * 32 + 8 * fq;
#pragma unroll
        for (int ai = 0; ai < 2; ++ai)
#pragma unroll
            for (int m = 0; m < 4; ++m) { bf16_t* rowp = O + (size_t)(row0 + ai * HALF + m * 16) * ldc + col0;
#pragma unroll
                for (int bj = 0; bj < 2; ++bj) { const f32x4 v0 = acc[ai][bj][m][0], v1 = acc[ai][bj][m][1];
                    u32x4 w; w.x = cvt_pk_bf16(v0[0], v0[1]); w.y = cvt_pk_bf16(v0[2], v0[3]); w.z = cvt_pk_bf16(v1[0], v1[1]); w.w = cvt_pk_bf16(v1[2], v1[3]);
                    *(u32x4*)(rowp + bj * HALF) = w; } }
    }
};
struct EpiProj {
    bf16_t* O; float* st;
    __device__ __forceinline__ void operator()(const f32x4 (&acc)[2][2][4][2], const Unit& u, int wr, int wc, int fr, int fq) const {
        asm volatile("" : "+v"(fr), "+v"(fq));
        const int row0 = u.pm * BM + wr * 64 + fr, col0 = u.pn * BM + wc * 32 + 8 * fq;
#pragma unroll
        for (int ai = 0; ai < 2; ++ai)
#pragma unroll
            for (int m = 0; m < 4; ++m) { const int row = row0 + ai * HALF + m * 16; bf16_t* rowp = O + (size_t)row * NPP + col0; float ss[2];
#pragma unroll
                for (int bj = 0; bj < 2; ++bj) { const f32x4 v0 = acc[ai][bj][m][0], v1 = acc[ai][bj][m][1];
                    u32x4 w; w.x = cvt_pk_bf16(v0[0], v0[1]); w.y = cvt_pk_bf16(v0[2], v0[3]); w.z = cvt_pk_bf16(v1[0], v1[1]); w.w = cvt_pk_bf16(v1[2], v1[3]);
                    *(u32x4*)(rowp + bj * HALF) = w;
                    ss[bj] = (v0[0] * v0[0] + v0[1] * v0[1]) + (v0[2] * v0[2] + v0[3] * v0[3]) + (v1[0] * v1[0] + v1[1] * v1[1]) + (v1[2] * v1[2] + v1[3] * v1[3]); }
                if (u.pn >= 6) {
                    float s0 = ss[0], s1 = ss[1]; s0 += __shfl_xor(s0, 16); s0 += __shfl_xor(s0, 32); s1 += __shfl_xor(s1, 16); s1 += __shfl_xor(s1, 32);
                    if (fq == 0) { if (u.pn == 6) st[(size_t)wc * NTOK + row] = s0 + s1; else if (u.pn == 7) st[(size_t)(4 + wc) * NTOK + row] = s0 + s1;
                                   else { st[(size_t)(8 + wc) * NTOK + row] = s0; st[(size_t)(12 + wc) * NTOK + row] = s1; } } } }
    }
};
struct EpiQ {
    bf16_t* q; const float* st; const float* qhn; const f32x2* rope; LAS float* tabs;
    __device__ __forceinline__ void operator()(const f32x4 (&acc)[2][2][4][2], const Unit& u, int wr, int wc, int fr, int fq) const {
        asm volatile("" : "+v"(fr), "+v"(fq));
        LAS float* rs_tab = tabs; LAS float* part = tabs + 512;
        { const int t = threadIdx.x; if (t < BM) { const size_t r = (size_t)u.pm * BM + t; float s = 0.f;
#pragma unroll
            for (int k = 4; k < 12; ++k) s += st[(size_t)k * NTOK + r];
            rs_tab[t] = 1.0f / sqrtf(s * (1.f / QL) + EPS); } }
        const int rt0 = wr * 64 + fr;
#pragma unroll
        for (int ai = 0; ai < 2; ++ai)
#pragma unroll
            for (int m = 0; m < 4; ++m) { float ss = 0.f;
#pragma unroll
                for (int bj = 0; bj < 2; ++bj)
#pragma unroll
                    for (int n = 0; n < 2; ++n) { const f32x4 v = acc[ai][bj][m][n]; ss += (v[0] * v[0] + v[1] * v[1]) + (v[2] * v[2] + v[3] * v[3]); }
                ss += __shfl_xor(ss, 16); ss += __shfl_xor(ss, 32);
                if (fq == 0) part[(rt0 + ai * HALF + m * 16) * 4 + wc] = ss; }
        asm volatile("s_waitcnt lgkmcnt(0)" ::: "memory"); __builtin_amdgcn_s_barrier(); asm volatile("" ::: "memory");
        const int c0 = wc * 32 + 8 * fq;
        f32x4 g0[2], g1[2];
        g0[0] = *(const f32x4*)(qhn + c0) * QSCALE; g0[1] = *(const f32x4*)(qhn + c0 + 4) * QSCALE;
        const int i0 = c0 >> 1;
        if (wc < 2) { g1[0] = (f32x4){qhn[128 + i0], qhn[160 + i0], qhn[129 + i0], qhn[161 + i0]} * QSCALE; g1[1] = (f32x4){qhn[130 + i0], qhn[162 + i0], qhn[131 + i0], qhn[163 + i0]} * QSCALE; }
        else { g1[0] = (f32x4){0.f, 0.f, 0.f, 0.f}; g1[1] = g1[0]; }
        f32x4 csa[2][4][2];
        if (wc < 2) {
#pragma unroll
            for (int ai = 0; ai < 2; ++ai)
#pragma unroll
                for (int m = 0; m < 4; ++m) { const size_t row = (size_t)u.pm * BM + rt0 + ai * HALF + m * 16;
                    csa[ai][m][0] = *(const f32x4*)(rope + (row & (SEQ - 1)) * 32 + i0); csa[ai][m][1] = *(const f32x4*)(rope + (row & (SEQ - 1)) * 32 + i0 + 2); }
        }
        asm volatile("" ::: "memory");
#pragma unroll
        for (int ai = 0; ai < 2; ++ai)
#pragma unroll
            for (int m = 0; m < 4; ++m) { const int rt = rt0 + ai * HALF + m * 16; const size_t row = (size_t)u.pm * BM + rt;
                const f32x4 pp = *(const LAS f32x4*)(part + rt * 4); const float rs = rs_tab[rt];
                const float r = rs / sqrtf(rs * rs * ((pp[0] + pp[1]) + (pp[2] + pp[3])) * (1.f / QKH) + EPS);
                bf16_t* qp = q + row * (NH * QKH) + u.pn * QKH + c0;
                { const f32x4 v0 = acc[ai][0][m][0] * g0[0] * r, v1 = acc[ai][0][m][1] * g0[1] * r;
                  u32x4 w; w.x = cvt_pk_bf16(v0[0], v0[1]); w.y = cvt_pk_bf16(v0[2], v0[3]); w.z = cvt_pk_bf16(v1[0], v1[1]); w.w = cvt_pk_bf16(v1[2], v1[3]); *(u32x4*)qp = w; }
                if (wc < 2) { const f32x4 cs0 = csa[ai][m][0], cs1 = csa[ai][m][1];
                    const f32x4 a0 = acc[ai][1][m][0] * g1[0] * r, a1 = acc[ai][1][m][1] * g1[1] * r;
                    f32x4 o0, o1;
                    o0[0] = a0[0] * cs0[0] - a0[1] * cs0[1]; o0[1] = a0[0] * cs0[1] + a0[1] * cs0[0]; o0[2] = a0[2] * cs0[2] - a0[3] * cs0[3]; o0[3] = a0[2] * cs0[3] + a0[3] * cs0[2];
                    o1[0] = a1[0] * cs1[0] - a1[1] * cs1[1]; o1[1] = a1[0] * cs1[1] + a1[1] * cs1[0]; o1[2] = a1[2] * cs1[2] - a1[3] * cs1[3]; o1[3] = a1[2] * cs1[3] + a1[3] * cs1[2];
                    u32x4 w; w.x = cvt_pk_bf16(o0[0], o0[1]); w.y = cvt_pk_bf16(o0[2], o0[3]); w.z = cvt_pk_bf16(o1[0], o1[1]); w.w = cvt_pk_bf16(o1[2], o1[3]); *(u32x4*)(qp + HALF) = w; } }
    }
};
struct EpiKV {
    bf16_t* k; bf16_t* v; const float* st; const float* khn; const f32x2* rope; const bf16_t* pb; LAS float* tabs;
    __device__ __forceinline__ void operator()(const f32x4 (&acc)[2][2][4][2], const Unit& u, int wr, int wc, int fr, int fq) const {
        asm volatile("" : "+v"(fr), "+v"(fq));
        LAS float* rs_tab = tabs; LAS float* kpe_tab = tabs + 256; LAS float* part = tabs + 512;
        { const int t = threadIdx.x; if (t < BM) { const size_t r = (size_t)u.pm * BM + t;
            const float s = (st[r] + st[(size_t)NTOK + r]) + (st[(size_t)2 * NTOK + r] + st[(size_t)3 * NTOK + r]);
            const float p = (st[(size_t)12 * NTOK + r] + st[(size_t)13 * NTOK + r]) + (st[(size_t)14 * NTOK + r] + st[(size_t)15 * NTOK + r]);
            rs_tab[t] = 1.0f / sqrtf(s * (1.f / KVL) + EPS); kpe_tab[t] = p; } }
        const int rt0 = wr * 64 + fr;
#pragma unroll
        for (int ai = 0; ai < 2; ++ai)
#pragma unroll
            for (int m = 0; m < 4; ++m) { float ss = 0.f;
#pragma unroll
                for (int n = 0; n < 2; ++n) { const f32x4 x = acc[ai][0][m][n]; ss += (x[0] * x[0] + x[1] * x[1]) + (x[2] * x[2] + x[3] * x[3]); }
                ss += __shfl_xor(ss, 16); ss += __shfl_xor(ss, 32);
                if (fq == 0) part[(rt0 + ai * HALF + m * 16) * 4 + wc] = ss; }
        asm volatile("s_waitcnt lgkmcnt(0)" ::: "memory"); __builtin_amdgcn_s_barrier(); asm volatile("" ::: "memory");
        const int c0 = wc * 32 + 8 * fq;
        const f32x4 g0 = *(const f32x4*)(khn + c0), g1 = *(const f32x4*)(khn + c0 + 4);
        const int i0 = 8 * wc + 2 * fq;
        const float gx0 = khn[128 + i0], gy0 = khn[160 + i0], gx1 = khn[129 + i0], gy1 = khn[161 + i0];
        unsigned xas[2][4], xbs[2][4]; f32x4 css[2][4];
#pragma unroll
        for (int ai = 0; ai < 2; ++ai)
#pragma unroll
            for (int m = 0; m < 4; ++m) { const size_t row = (size_t)u.pm * BM + rt0 + ai * HALF + m * 16;
                xas[ai][m] = *(const unsigned*)(pb + row * NPP + PB_KPE + i0); xbs[ai][m] = *(const unsigned*)(pb + row * NPP + PB_KPE + 32 + i0);
                css[ai][m] = *(const f32x4*)(rope + (row & (SEQ - 1)) * 32 + i0); }
        asm volatile("" ::: "memory");
#pragma unroll
        for (int ai = 0; ai < 2; ++ai)
#pragma unroll
            for (int m = 0; m < 4; ++m) { const int rt = rt0 + ai * HALF + m * 16; const size_t row = (size_t)u.pm * BM + rt;
                const f32x4 pp = *(const LAS f32x4*)(part + rt * 4); const float rs = rs_tab[rt];
                const float rh = 1.0f / sqrtf((rs * rs * ((pp[0] + pp[1]) + (pp[2] + pp[3])) + kpe_tab[rt]) * (1.f / QKH) + EPS);
                const float r = rs * rh;
                bf16_t* kp = k + row * (NH * QKH) + u.pn * QKH;
                { const f32x4 v0 = acc[ai][0][m][0] * g0 * r, v1 = acc[ai][0][m][1] * g1 * r;
                  u32x4 w; w.x = cvt_pk_bf16(v0[0], v0[1]); w.y = cvt_pk_bf16(v0[2], v0[3]); w.z = cvt_pk_bf16(v1[0], v1[1]); w.w = cvt_pk_bf16(v1[2], v1[3]); *(u32x4*)(kp + c0) = w; }
                { const f32x4 v0 = acc[ai][1][m][0] * rs, v1 = acc[ai][1][m][1] * rs;
                  u32x4 w; w.x = cvt_pk_bf16(v0[0], v0[1]); w.y = cvt_pk_bf16(v0[2], v0[3]); w.z = cvt_pk_bf16(v1[0], v1[1]); w.w = cvt_pk_bf16(v1[2], v1[3]); *(u32x4*)(v + row * (NH * VH) + u.pn * VH + c0) = w; }
                { const unsigned xa = xas[ai][m], xb = xbs[ai][m];
                  const f32x4 cs = css[ai][m];
                  const float x10 = bf_lo(xa) * gx0 * rh, x11 = bf_hi(xa) * gx1 * rh, x20 = bf_lo(xb) * gy0 * rh, x21 = bf_hi(xb) * gy1 * rh;
                  u32x2 w; w.x = cvt_pk_bf16(x10 * cs[0] - x20 * cs[1], x10 * cs[1] + x20 * cs[0]); w.y = cvt_pk_bf16(x11 * cs[2] - x21 * cs[3], x11 * cs[3] + x21 * cs[2]);
                  *(u32x2*)(kp + 128 + 2 * i0) = w; } }
    }
};
struct EpiOut {
    const float* x; float* out; float* ssq;
    __device__ __forceinline__ void operator()(const f32x4 (&acc)[2][2][4][2], const Unit& u, int wr, int wc, int fr, int fq) const {
        asm volatile("" : "+v"(fr), "+v"(fq));
        const int row0 = u.pm * BM + wr * 64 + fr, col0 = u.pn * BM + wc * 32 + 8 * fq;
#pragma unroll
        for (int ai = 0; ai < 2; ++ai) {
            f32x4 xv[4][2][2];
#pragma unroll
            for (int m = 0; m < 4; ++m) { const size_t off = (size_t)(row0 + ai * HALF + m * 16) * DM + col0;
#pragma unroll
                for (int bj = 0; bj < 2; ++bj) { xv[m][bj][0] = __builtin_nontemporal_load((const f32x4*)(x + off + bj * HALF)); xv[m][bj][1] = __builtin_nontemporal_load((const f32x4*)(x + off + bj * HALF + 4)); } }
            asm volatile("" ::: "memory");
#pragma unroll
            for (int m = 0; m < 4; ++m) { const int row = row0 + ai * HALF + m * 16; const size_t off = (size_t)row * DM + col0; float ss = 0.f;
#pragma unroll
                for (int bj = 0; bj < 2; ++bj) { const f32x4 v0 = acc[ai][bj][m][0] + xv[m][bj][0], v1 = acc[ai][bj][m][1] + xv[m][bj][1];
                    *(f32x4*)(out + off + bj * HALF) = v0; *(f32x4*)(out + off + bj * HALF + 4) = v1;
                    ss += (v0[0] * v0[0] + v0[1] * v0[1]) + (v0[2] * v0[2] + v0[3] * v0[3]) + (v1[0] * v1[0] + v1[1] * v1[1]) + (v1[2] * v1[2] + v1[3] * v1[3]); }
                ss += __shfl_xor(ss, 16); ss += __shfl_xor(ss, 32);
                if (fq == 0) ssq[(size_t)(u.pn * 4 + wc) * NTOK + row] = ss; }
        }
    }
};
struct EpiSwiglu {
    unsigned char* act; const float* bgu;
    __device__ __forceinline__ void operator()(const f32x4 (&acc)[2][2][4][2], const Unit& u, int wr, int wc, int fr, int fq) const {
        asm volatile("" : "+v"(fr), "+v"(fq));
        const int rt0 = wr * 64 + fr, j0 = wc * 32 + 8 * fq;
        const float* bg = bgu + (size_t)u.e * (2 * DFF) + u.pn * HALF + j0;
        const f32x4 bg0 = *(const f32x4*)bg, bg1 = *(const f32x4*)(bg + 4), bu0 = *(const f32x4*)(bg + DFF), bu1 = *(const f32x4*)(bg + DFF + 4);
        constexpr float WI = 1.f / W8_SCALE;
#pragma unroll
        for (int ai = 0; ai < 2; ++ai)
#pragma unroll
            for (int m = 0; m < 4; ++m) { const int rt = rt0 + ai * HALF + m * 16;
                float o[8];
#pragma unroll
                for (int n = 0; n < 2; ++n) { const f32x4 g4 = acc[ai][0][m][n] * WI + (n ? bg1 : bg0), u4 = acc[ai][1][m][n] * WI + (n ? bu1 : bu0);
#pragma unroll
                    for (int i = 0; i < 4; ++i) { const float g = fminf(g4[i], SWI_LIMIT), uu = fminf(fmaxf(u4[i], -SWI_LIMIT), SWI_LIMIT);
                        const float sg = __builtin_amdgcn_rcpf(1.f + __builtin_amdgcn_exp2f(g * (-SWI_ALPHA * 1.4426950408889634f)));
                        o[n * 4 + i] = (uu + 1.f) * (g * sg) * ACT8_SCALE; } }
                u32x2 w; w.x = pk4_fp8(o[0], o[1], o[2], o[3]); w.y = pk4_fp8(o[4], o[5], o[6], o[7]);
                *(u32x2*)(act + ((size_t)u.pm * BM + rt) * DFF + u.pn * HALF + j0) = w; }
    }
};
struct EpiDown {
    unsigned char* oslot; const float* bdn; unsigned char* dummy; LAS unsigned char* lds;
    __device__ __forceinline__ void operator()(const f32x4 (&acc)[2][2][4][2], const Unit& u, int wr, int wc, int fr, int fq) const {
        asm volatile("" : "+v"(fr), "+v"(fq));
        const int rt0 = wr * 64 + fr, col0 = u.pn * BM + wc * 32 + 8 * fq;
        const float* bp = bdn + (size_t)u.e * DM + col0;
        f32x4 bv[2][2];
#pragma unroll
        for (int bj = 0; bj < 2; ++bj) { bv[bj][0] = *(const f32x4*)(bp + bj * HALF); bv[bj][1] = *(const f32x4*)(bp + bj * HALF + 4); }
        constexpr float WI = 1.f / (W8_SCALE * ACT8_SCALE);
#pragma unroll
        for (int ai = 0; ai < 2; ++ai)
#pragma unroll
            for (int m = 0; m < 4; ++m) { const int rt = rt0 + ai * HALF + m * 16, p = u.p0 + rt;
                const u32x2 mt = *(const LAS u32x2*)(lds + MoeSched::META_OFF + u.par * 2048 + rt * 8);
                const bool valid = p < u.cnt; const int slot = valid ? (int)mt.x : 0; const unsigned gbits = mt.y; const float g = __builtin_bit_cast(float, gbits);
                unsigned char* rowp = valid ? oslot + (size_t)slot * DM + col0 : dummy + col0;
                const float gs = g * OS8_SCALE;
#pragma unroll
                for (int bj = 0; bj < 2; ++bj) { const f32x4 v0 = (acc[ai][bj][m][0] * WI + bv[bj][0]) * gs, v1 = (acc[ai][bj][m][1] * WI + bv[bj][1]) * gs;
                    u32x2 w; w.x = pk4_fp8(v0[0], v0[1], v0[2], v0[3]); w.y = pk4_fp8(v1[0], v1[1], v1[2], v1[3]);
                    *(u32x2*)(rowp + bj * HALF) = w; } }
    }
};
struct EpiNull {
    float* dummy;
    __device__ __forceinline__ void operator()(const f32x4 (&acc)[2][2][4][2], const Unit& u, int wr, int wc, int fr, int fq) const {
        float sacc = 0.f;
#pragma unroll
        for (int ai = 0; ai < 2; ++ai)
#pragma unroll
            for (int bj = 0; bj < 2; ++bj)
#pragma unroll
                for (int m = 0; m < 4; ++m)
#pragma unroll
                    for (int n = 0; n < 2; ++n) sacc += (acc[ai][bj][m][n][0] + acc[ai][bj][m][n][1]) + (acc[ai][bj][m][n][2] + acc[ai][bj][m][n][3]);
        dummy[(size_t)blockIdx.x * 512 + threadIdx.x] = sacc;
    }
};
}

namespace att {
constexpr int LDQ = NH * QKH, LDK = NH * QKH, LDV = NH * VH, LDO = DM;
constexpr int KT_BYTES = 64 * QKH * 2, VT_BYTES = 64 * VH * 2;
constexpr int L_K = 0, L_V = 3 * KT_BYTES, L_WS = L_V + 3 * VT_BYTES, L_END = L_WS + 8 * 256;
constexpr float THRL = 8.f * 1.4426950408889634f;
__device__ __forceinline__ int crow(int r, int hi) { return (r & 3) + 8 * (r >> 2) + 4 * hi; }
#define SBAR() __builtin_amdgcn_sched_barrier(0)
__device__ __forceinline__ int v_rd_base(int lane) { return ((lane & 3) << 3) | (((lane >> 2) & 3) << 6) | (((lane >> 4) & 1) << 5) | (((lane >> 5) & 1) << 8); }
constexpr int v_rd_off(int d0, int ks, int half) { return d0 * 512 + ks * 4096 + half * 2048; }
template <int OFF> __device__ __forceinline__ s16x4 tr_read(int vb) {
    s16x4 r; asm volatile("ds_read_b64_tr_b16 %0, %1 offset:%2" : "=&v"(r) : "v"(vb), "i"(OFF) : "memory"); return r;
}
template <int D0> __device__ __forceinline__ void pv_one(f32x16& od, int vb, bf16x8 pa0, bf16x8 pa1, bf16x8 pa2, bf16x8 pa3) {
    const s16x4 l0 = tr_read<v_rd_off(D0, 0, 0)>(vb), h0 = tr_read<v_rd_off(D0, 0, 1)>(vb), l1 = tr_read<v_rd_off(D0, 1, 0)>(vb), h1 = tr_read<v_rd_off(D0, 1, 1)>(vb);
    const s16x4 l2 = tr_read<v_rd_off(D0, 2, 0)>(vb), h2 = tr_read<v_rd_off(D0, 2, 1)>(vb), l3 = tr_read<v_rd_off(D0, 3, 0)>(vb), h3 = tr_read<v_rd_off(D0, 3, 1)>(vb);
    asm volatile("s_waitcnt lgkmcnt(0)" ::: "memory"); SBAR();
#define PK(L, H) (bf16x8){L[0], L[1], L[2], L[3], H[0], H[1], H[2], H[3]}
    od = __builtin_amdgcn_mfma_f32_32x32x16_bf16(pa0, PK(l0, h0), od, 0, 0, 0);
    od = __builtin_amdgcn_mfma_f32_32x32x16_bf16(pa1, PK(l1, h1), od, 0, 0, 0);
    od = __builtin_amdgcn_mfma_f32_32x32x16_bf16(pa2, PK(l2, h2), od, 0, 0, 0);
    od = __builtin_amdgcn_mfma_f32_32x32x16_bf16(pa3, PK(l3, h3), od, 0, 0, 0);
#undef PK
}
__device__ __forceinline__ void glds16(const void* gsrc, LAS unsigned char* dst) {
    __builtin_amdgcn_global_load_lds((const unsigned*)gsrc, (LAS unsigned*)dst, 16, 0, 0);
}
__device__ __forceinline__ void attn_unit(int b, int h, int qb, const bf16_t* Q, const bf16_t* Kg, const bf16_t* Vg, bf16_t* O, LAS unsigned char* lds) {
    const int tid = threadIdx.x, wid = __builtin_amdgcn_readfirstlane(tid >> 6), lane = tid & 63, r32 = lane & 31, hi = lane >> 5;
    const int grp = wid >> 2;
    const size_t tok0 = (size_t)b * SEQ;
    bf16x8 qr[12];
    { const bf16_t* Qw = Q + (tok0 + (size_t)qb * 256 + wid * 32 + r32) * LDQ + h * QKH + hi * 8;
#pragma unroll
      for (int d0 = 0; d0 < 12; ++d0) qr[d0] = *(const bf16x8*)(Qw + d0 * 16); }
    unsigned koff[3], voff[2];
#pragma unroll
    for (int i = 0; i < 3; ++i) { const int G = 64 * (wid + 8 * i) + lane, row = G / 24, cgs = G % 24, cg = (cgs & ~7) | ((cgs & 7) ^ ((row >> 1) & 7)); koff[i] = (unsigned)(row * LDK * 2 + cg * 16); }
#pragma unroll
    for (int i = 0; i < 2; ++i) { const int p = wid + 8 * i, sub = 2 * p + (lane >> 5), kkh = sub >> 2, cblk = sub & 3, kkl = (lane & 31) >> 2, cl = (lane & 3) * 8, kk = kkh * 8 + kkl;
        const int k = (kk & ~0xC) | ((kk & 4) << 1) | ((kk & 8) >> 1), c = cblk * 32 + cl; voff[i] = (unsigned)(k * LDV * 2 + c * 2); }
    const __amdgpu_buffer_rsrc_t rK = __builtin_amdgcn_make_buffer_rsrc((void*)(Kg + tok0 * LDK + h * QKH), 0, -1, 0x00020000), rV = __builtin_amdgcn_make_buffer_rsrc((void*)(Vg + tok0 * LDV + h * VH), 0, -1, 0x00020000);
#define ATT_DMA(j, buf) do { \
        _Pragma("unroll") for (int i_ = 0; i_ < 3; ++i_) __builtin_amdgcn_raw_ptr_buffer_load_lds(rK, (LAS void*)(lds + L_K + (buf) * KT_BYTES + (wid + 8 * i_) * 1024), 16, koff[i_], (unsigned)(j) * (64u * LDK * 2u), 0, 0); \
        _Pragma("unroll") for (int i_ = 0; i_ < 2; ++i_) __builtin_amdgcn_raw_ptr_buffer_load_lds(rV, (LAS void*)(lds + L_V + (buf) * VT_BYTES + (wid + 8 * i_) * 1024), 16, voff[i_], (unsigned)(j) * (64u * LDV * 2u), 0, 0); } while (0)
#define ATT_BAR() do { asm volatile("" ::: "memory"); __builtin_amdgcn_s_barrier(); asm volatile("" ::: "memory"); } while (0)
    const int swz = (r32 >> 1) & 7; int kx[4];
#pragma unroll
    for (int dd = 0; dd < 4; ++dd) kx[dd] = r32 * (QKH * 2) + (((2 * dd + hi) ^ swz) << 4);
    LAS float* ws = (LAS float*)(lds + L_WS) + wid * 64; LAS float* li_l = ws; LAS float* al_l = ws + 32;
    const int vb0 = L_V + v_rd_base(lane);
    float m_reg = -1e30f, l_reg = 0.f; f32x16 o[4];
#pragma unroll
    for (int d = 0; d < 4; ++d)
#pragma unroll
        for (int r = 0; r < 16; ++r) o[d][r] = 0.f;
    const int NT = 4 * qb + 4, my_last = 4 * qb + (wid >> 1);
    ATT_DMA(0, 0); ATT_DMA(1, 1);
    asm volatile("s_waitcnt vmcnt(5)" ::: "memory"); ATT_BAR();
    if (grp == 1) ATT_BAR();
    int kb = 0, nb = 2;
    for (int j = 0; j < NT; ++j) {
        const bool live = (j <= my_last), more = (j + 2 < NT);
        f32x16 p0, p1;
        if (grp == 1 && more) ATT_DMA(j + 2, nb);
        if (live) {
            const LAS unsigned char* Ks = lds + L_K + kb * KT_BYTES;
#pragma unroll
            for (int r = 0; r < 16; ++r) { p0[r] = 0.f; p1[r] = 0.f; }
#pragma unroll
            for (int d0 = 0; d0 < 12; ++d0) {
                const bf16x8 b0 = *(const LAS bf16x8*)(Ks + kx[d0 & 3] + (d0 >> 2) * 128);
                const bf16x8 b1 = *(const LAS bf16x8*)(Ks + kx[d0 & 3] + (d0 >> 2) * 128 + 32 * QKH * 2);
                p0 = __builtin_amdgcn_mfma_f32_32x32x16_bf16(b0, qr[d0], p0, 0, 0, 0);
                p1 = __builtin_amdgcn_mfma_f32_32x32x16_bf16(b1, qr[d0], p1, 0, 0, 0);
            }
        }
        if (grp == 1) { if (j + 1 < NT) { if (more) asm volatile("s_waitcnt vmcnt(5)" ::: "memory"); else asm volatile("s_waitcnt vmcnt(0)" ::: "memory"); } }
        ATT_BAR();
        if (grp == 0 && more) ATT_DMA(j + 2, nb);
        if (live) {
            float pmax = p0[0];
#pragma unroll
            for (int r = 1; r < 16; ++r) pmax = fmaxf(pmax, p0[r]);
#pragma unroll
            for (int r = 0; r < 16; ++r) pmax = fmaxf(pmax, p1[r]);
            { auto rr = __builtin_amdgcn_permlane32_swap(__float_as_uint(pmax), __float_as_uint(pmax), false, false);
              pmax = fmaxf(__uint_as_float(rr[0]), __uint_as_float(rr[1])); }
            float mn, alpha;
            if (__builtin_expect(__all(pmax - m_reg <= THRL), 1)) { mn = m_reg; alpha = 1.f; }
            else { mn = fmaxf(m_reg, pmax); alpha = __builtin_amdgcn_exp2f(m_reg - mn); m_reg = mn; }
#pragma unroll
            for (int r = 0; r < 16; ++r) { p0[r] = __builtin_amdgcn_exp2f(p0[r] - mn); p1[r] = __builtin_amdgcn_exp2f(p1[r] - mn); }
            float ps = 0.f;
#pragma unroll
            for (int r = 0; r < 16; ++r) ps += p0[r];
#pragma unroll
            for (int r = 0; r < 16; ++r) ps += p1[r];
            { auto rr = __builtin_amdgcn_permlane32_swap(__float_as_uint(ps), __float_as_uint(ps), false, false);
              ps = __uint_as_float(rr[0]) + __uint_as_float(rr[1]); }
            l_reg = l_reg * alpha + ps;
            if (__any(alpha < 1.f)) { if (hi == 0) al_l[r32] = alpha; asm volatile("s_waitcnt lgkmcnt(0)" ::: "memory");
#pragma unroll
                for (int r = 0; r < 16; ++r) { const float a = al_l[crow(r, hi)];
#pragma unroll
                    for (int d = 0; d < 4; ++d) o[d][r] *= a; } }
            bf16x8 pa0, pa1, pa2, pa3;
#define PK4(P, BASE, OUT) do { unsigned a0 = cvt_pk_bf16(P[BASE + 0], P[BASE + 1]), a1 = cvt_pk_bf16(P[BASE + 2], P[BASE + 3]);   \
    unsigned b0_ = cvt_pk_bf16(P[BASE + 4], P[BASE + 5]), b1_ = cvt_pk_bf16(P[BASE + 6], P[BASE + 7]);                              \
    auto r0 = __builtin_amdgcn_permlane32_swap(a0, b0_, false, false); auto r1 = __builtin_amdgcn_permlane32_swap(a1, b1_, false, false); \
    u32x4 w = {r0[0], r1[0], r0[1], r1[1]}; OUT = __builtin_bit_cast(bf16x8, w); } while (0)
            PK4(p0, 0, pa0); PK4(p0, 8, pa1); PK4(p1, 0, pa2); PK4(p1, 8, pa3);
#undef PK4
            const int vb = vb0 + kb * VT_BYTES;
            pv_one<0>(o[0], vb, pa0, pa1, pa2, pa3); pv_one<1>(o[1], vb, pa0, pa1, pa2, pa3); pv_one<2>(o[2], vb, pa0, pa1, pa2, pa3); pv_one<3>(o[3], vb, pa0, pa1, pa2, pa3);
        }
        if (grp == 0) { if (j + 1 < NT) { if (more) asm volatile("s_waitcnt vmcnt(5)" ::: "memory"); else asm volatile("s_waitcnt vmcnt(0)" ::: "memory"); } }
        ATT_BAR();
        kb = (kb == 2) ? 0 : kb + 1; nb = (nb == 2) ? 0 : nb + 1;
    }
    if (grp == 0) ATT_BAR();
    if (hi == 0) li_l[r32] = l_reg; asm volatile("s_waitcnt lgkmcnt(0)" ::: "memory");
    bf16_t* Ow = O + (tok0 + (size_t)qb * 256 + wid * 32) * LDO + h * VH;
#pragma unroll
    for (int r = 0; r < 16; ++r) { const int orow = crow(r, hi); const float rl = __builtin_amdgcn_rcpf(li_l[orow]);
#pragma unroll
        for (int d0 = 0; d0 < 4; ++d0) Ow[(size_t)orow * LDO + d0 * 32 + r32] = (bf16_t)f2bf(o[d0][r] * rl); }
    asm volatile("s_waitcnt lgkmcnt(0)" ::: "memory"); ATT_BAR();
#undef ATT_DMA
#undef ATT_BAR
}
#undef SBAR
}

#define XB_TMO      128
#define XB_XCNT(j)  (256  + 64 * (j))
#define XB_XSUB(j)  (1280 + 64 * (j))
#define XB_XGEN(j)  (2304 + 64 * (j))
#define XB_TOP      3328
#define XB_TOPGEN   3392
#define XCD_BAR_WORDS 3456
#define XB_SPIN_CAP (1u << 18)
__device__ __forceinline__ unsigned xb_ld(unsigned* p)              { return __hip_atomic_load(p, __ATOMIC_RELAXED, __HIP_MEMORY_SCOPE_AGENT); }
__device__ __forceinline__ unsigned xb_add(unsigned* p, unsigned v) { return __hip_atomic_fetch_add(p, v, __ATOMIC_RELAXED, __HIP_MEMORY_SCOPE_AGENT); }
__device__ __forceinline__ unsigned xb_xcc_id() { return (unsigned)__builtin_amdgcn_s_getreg((3 << 11) | 20) & 0xFu; }
#define XB_SPIN(cond, bar) do { unsigned _sp = 0; while (cond) { __builtin_amdgcn_s_sleep(1); \
    if ((++_sp & 255u) == 0u) { if (xb_ld(&(bar)[XB_TMO])) break; if (_sp > XB_SPIN_CAP) { atomicAdd(&(bar)[XB_TMO], 1u); break; } } } } while (0)
struct XcdBarrier { unsigned* bar; unsigned x; volatile LAS unsigned* st; };
__device__ __forceinline__ XcdBarrier xcd_barrier_post(unsigned* bar, volatile LAS unsigned* st) {
    XcdBarrier b; b.bar = bar; b.x = xb_xcc_id(); b.st = st;
    if (threadIdx.x == 0) (void)xb_add(&bar[XB_XCNT(b.x)], 1u);
    return b;
}
__device__ __forceinline__ void xcd_barrier_complete(unsigned* bar, unsigned x, unsigned& nloc, unsigned& nx) {
    const unsigned G = gridDim.x * gridDim.y * gridDim.z;
    unsigned sum, cnt, mine, sp = 0u;
    for (;;) {
        sum = 0u; cnt = 0u; mine = 0u;
#pragma unroll
        for (unsigned j = 0; j < 16; ++j) { const unsigned c = xb_ld(&bar[XB_XCNT(j)]); sum += c; cnt += (c > 0u) ? 1u : 0u; mine = (j == x) ? c : mine; }
        if (sum == G) break;
        __builtin_amdgcn_s_sleep(1);
        if ((++sp & 255u) == 0u) { if (xb_ld(&bar[XB_TMO])) break; if (sp > XB_SPIN_CAP) { atomicAdd(&bar[XB_TMO], 1u); break; } }
    }
    nloc = mine > 0u ? mine : 1u; nx = cnt > 0u ? cnt : 1u;
}
__device__ __forceinline__ void xcd_barrier(const XcdBarrier& b) {
    asm volatile("s_waitcnt vmcnt(0)" ::: "memory");
    __syncthreads();
    if (threadIdx.x == 0) {
        unsigned* bar = b.bar;
        __builtin_amdgcn_s_waitcnt(0);
        unsigned nloc = b.st[0], nx = b.st[1];
        if (nloc == 0u) { xcd_barrier_complete(bar, b.x, nloc, nx); b.st[0] = nloc; b.st[1] = nx; }
        const unsigned old = xb_add(&bar[XB_XSUB(b.x)], 1u);
        const unsigned gen = old / nloc;
        if (old + 1u == (gen + 1u) * nloc) {
            __builtin_amdgcn_fence(__ATOMIC_RELEASE, "agent");
            asm volatile("s_waitcnt vmcnt(0)" ::: "memory");
            const unsigned og = xb_add(&bar[XB_TOP], 1u);
            const unsigned tg = og / nx;
            if (og + 1u == (tg + 1u) * nx) xb_add(&bar[XB_TOPGEN], 1u);
            else XB_SPIN(xb_ld(&bar[XB_TOPGEN]) == tg, bar);
            __builtin_amdgcn_fence(__ATOMIC_ACQUIRE, "agent");
            xb_add(&bar[XB_XGEN(b.x)], 1u);
            asm volatile("s_waitcnt vmcnt(0)" ::: "memory");
        } else {
            XB_SPIN(xb_ld(&bar[XB_XGEN(b.x)]) == gen, bar);
            __builtin_amdgcn_fence(__ATOMIC_ACQUIRE, "agent");
            asm volatile("s_waitcnt vmcnt(0)" ::: "memory");
        }
    }
    __syncthreads();
}

constexpr int NWAVES = 8;
constexpr int N_LAUNCHES = MK_N_LAUNCHES;
constexpr int N_PHASES = 10;
struct Args { const float* in[18]; float* out; unsigned char* ws; int ph_lo, ph_hi; };

__device__ __forceinline__ void p0_transpose_item(const float* W, int K, int N, bf16_t* WT, int drow0, const float* kscale, LAS unsigned* scr, int k0, int n0, int lane, bool ileave = false) {
    const int g = lane >> 4, l16 = lane & 15;
    f32x4 v[16];
#pragma unroll
    for (int i = 0; i < 16; ++i) { const int kk = (i >> 1) * 8 + g * 2 + (i & 1); v[i] = __builtin_nontemporal_load((const f32x4*)(W + (size_t)(k0 + kk) * N + n0 + 4 * l16)); }
    if (kscale) {
#pragma unroll
        for (int i = 0; i < 16; ++i) { const int kk = (i >> 1) * 8 + g * 2 + (i & 1); v[i] = v[i] * kscale[k0 + kk]; } }
#pragma unroll
    for (int j = 0; j < 8; ++j) { const int kp = j * 4 + g;
#pragma unroll
        for (int c = 0; c < 4; ++c) scr[(4 * l16 + c) * 33 + kp] = cvt_pk_bf16(v[2 * j][c], v[2 * j + 1][c]); }
    LDS_WAIT(); asm volatile("" ::: "memory");
    const int c8 = lane & 7;
#pragma unroll
    for (int jj = 0; jj < 8; ++jj) { const int n = jj * 8 + (lane >> 3); const LAS unsigned* t = scr + n * 33 + 4 * c8;
        u32x4 o; o.x = t[0]; o.y = t[1]; o.z = t[2]; o.w = t[3];
        const int dn = ileave ? ((n < 32) ? 2 * n : 2 * (n - 32) + 1) : n;
        *(u32x4*)(WT + (size_t)(drow0 + dn) * K + k0 + 8 * c8) = o; }
    LDS_WAIT(); asm volatile("" ::: "memory");
}

__device__ __forceinline__ void p0_transpose_item8(const float* W, int K, int N, unsigned char* WT, int drow0, const float* kscale, LAS unsigned* scr, int k0, int n0, int lane) {
    const int g = lane >> 4, l16 = lane & 15;
    f32x4 v[32];
#pragma unroll
    for (int i = 0; i < 32; ++i) { const int kk = (i >> 2) * 16 + g * 4 + (i & 3); v[i] = __builtin_nontemporal_load((const f32x4*)(W + (size_t)(k0 + kk) * N + n0 + 4 * l16)); }
#pragma unroll
    for (int i = 0; i < 32; ++i) { const int kk = (i >> 2) * 16 + g * 4 + (i & 3); v[i] = v[i] * (kscale ? kscale[k0 + kk] * W8_SCALE : W8_SCALE); }
#pragma unroll
    for (int j = 0; j < 8; ++j) { const int kd = j * 4 + g;
#pragma unroll
        for (int c = 0; c < 4; ++c) scr[(4 * l16 + c) * 33 + kd] = pk4_fp8(v[4 * j][c], v[4 * j + 1][c], v[4 * j + 2][c], v[4 * j + 3][c]); }
    LDS_WAIT(); asm volatile("" ::: "memory");
    const int c8 = lane & 7;
#pragma unroll
    for (int jj = 0; jj < 8; ++jj) { const int n = jj * 8 + (lane >> 3); const LAS unsigned* t = scr + n * 33 + 4 * c8;
        u32x4 o; o.x = t[0]; o.y = t[1]; o.z = t[2]; o.w = t[3];
        *(u32x4*)(WT + (size_t)(drow0 + n) * K + k0 + 16 * c8) = o; }
    LDS_WAIT(); asm volatile("" ::: "memory");
}

template <int PHMASK> __global__ void __launch_bounds__(NWAVES * 64, 2) fwd_kernel_t(Args args) {
    extern __shared__ __attribute__((aligned(16))) unsigned char lds_raw[];
    LAS unsigned char* lds = (LAS unsigned char*)lds_raw;
    volatile LAS unsigned* MISC = (volatile LAS unsigned*)(lds + MISC_OFF);
    const int tid = threadIdx.x, lane = tid & 63, wave = __builtin_amdgcn_readfirstlane(tid >> 6);
    const int G = gridDim.x; const int bx = blockIdx.x; const int vcu = (G % 8 == 0) ? (bx % 8) * (G / 8) + bx / 8 : bx;
    unsigned char* ws = args.ws;
    unsigned* ctl = (unsigned*)(ws + WS_CTL);
    const float* x = args.in[0]; const float* norm_mix = args.in[1]; const float* w_in = args.in[2]; const float* conv_w = args.in[3];
    const float* q_norm = args.in[4]; const float* w_uq = args.in[5]; const float* kv_norm = args.in[6]; const float* w_ukv = args.in[7];
    const float* q_head_norm = args.in[8]; const float* k_head_norm = args.in[9]; const float* w_o = args.in[10]; const float* norm_ffn = args.in[11];
    const float* w_router = args.in[12]; const float* b_router = args.in[13]; const float* w_gate_up = args.in[14]; const float* b_gate_up = args.in[15];
    const float* w_down = args.in[16]; const float* b_down = args.in[17];
    float* out = args.out;
    f32x2* rope_t = (f32x2*)(ws + WS_ROPE);
    bf16_t* WrH = (bf16_t*)(ws + WS_WRH); bf16_t* WrL = (bf16_t*)(ws + WS_WRL);
    bf16_t* Win_t = (bf16_t*)(ws + WS_WIN); bf16_t* Wuq_t = (bf16_t*)(ws + WS_WUQ); bf16_t* Wukv_t = (bf16_t*)(ws + WS_WUKV); bf16_t* Wo_t = (bf16_t*)(ws + WS_WO);
    float* ssq = (float*)(ws + WS_SSQ); float* rs2 = (float*)(ws + WS_RS2); float* gate = (float*)(ws + WS_GATE); int* tos = (int*)(ws + WS_TOS);
    unsigned char* Wgu_t = ws + WS_WGU; unsigned char* Wdn_t = ws + WS_WDN;
    unsigned char* hq = ws + WS_HB;
    bf16_t* qb_ = (bf16_t*)(ws + WS_Q); bf16_t* kb_ = (bf16_t*)(ws + WS_K); bf16_t* vb_ = (bf16_t*)(ws + WS_V); bf16_t* mix = (bf16_t*)(ws + WS_MIX);
    bf16_t* oslot = (bf16_t*)(ws + WS_OSLOT); bf16_t* hn = (bf16_t*)(ws + WS_HN); bf16_t* pbuf = (bf16_t*)(ws + WS_PB); bf16_t* qraw = (bf16_t*)(ws + WS_QRAW); bf16_t* kvraw = (bf16_t*)(ws + WS_KVRAW);
    unsigned char* act = ws + WS_ACT;

    for (int u = tid; u < (LDS_BYTES - MISC_OFF) / 4; u += NWAVES * 64) ((LAS unsigned*)(lds + MISC_OFF))[u] = 0u;
    __syncthreads();
    XcdBarrier bar; bar.bar = ctl + CW_BAR; bar.x = 0; bar.st = nullptr;
    if (N_LAUNCHES == 1) bar = xcd_barrier_post(ctl + CW_BAR, MISC + 8);
#define GRID_BAR() do { if (N_LAUNCHES == 1) xcd_barrier(bar); } while (0)
    const int lo = args.ph_lo, hi = args.ph_hi;
#define IN(k) (((PHMASK >> (k)) & 1) && lo <= (k) && (k) < hi)
#define BOTH(k) (IN(k) && IN((k) + 1))
    const int gw = vcu * NWAVES + wave, NGW = G * NWAVES;

    if (IN(0)) {
        LAS unsigned* scr = (LAS unsigned*)(lds + wave * 16384);
        constexpr int I_IN = (DM / 64) * (NPROJ / 64), I_UQ = (QL / 64) * (768 / 64), I_UKV = (KVL / 64) * (1024 / 64), I_O = (DM / 64) * (DM / 64);
        constexpr int I_GU1 = (DM / 128) * (2 * DFF / 64), I_GU = NE * I_GU1, I_DN1 = (DFF / 128) * (DM / 64), I_DN = NE * I_DN1;
        constexpr int NITEMS = I_IN + I_UQ + I_UKV + I_O + I_GU + I_DN;
        for (int it = gw; it < NITEMS; it += NGW) {
            int r = it;
            if (r < I_GU) { const int e = r / I_GU1, q = r % I_GU1, nblk = 2 * DFF / 64, kb = q / nblk, nb = q % nblk, n0 = nb * 64, j = n0 & (DFF - 1), up = n0 >= DFF;
                p0_transpose_item8(w_gate_up + (size_t)e * DM * 2 * DFF, DM, 2 * DFF, Wgu_t + (size_t)e * 2 * DFF * DM, (j >> 7) * 256 + (j & 127) + (up ? 128 : 0), norm_ffn, scr, kb * 128, n0, lane); continue; } r -= I_GU;
            if (r < I_DN) { const int e = r / I_DN1, q = r % I_DN1, nblk = DM / 64, kb = q / nblk, nb = q % nblk;
                p0_transpose_item8(w_down + (size_t)e * DFF * DM, DFF, DM, Wdn_t + (size_t)e * DM * DFF, nb * 64, nullptr, scr, kb * 128, nb * 64, lane); continue; } r -= I_DN;
            if (r < I_IN) { const int nblk = NPROJ / 64, kb = r / nblk, nb = r % nblk, n0 = nb * 64;
                const int d0 = (n0 < 1536) ? n0 : (n0 < 1920 ? n0 + (PB_CQ - 1536) : (n0 < 2176 ? n0 - (1920 - PB_CKV) : n0));
                p0_transpose_item(w_in, DM, NPROJ, Win_t, d0, nullptr, scr, kb * 64, n0, lane); continue; } r -= I_IN;
            if (r < I_UQ) { const int nblk = 768 / 64, kb = r / nblk, nb = r % nblk, h = nb / 3, part = nb % 3;
                p0_transpose_item(w_uq, QL, 768, Wuq_t, h * 256 + part * 64, q_norm, scr, kb * 64, nb * 64, lane, part == 2); continue; } r -= I_UQ;
            if (r < I_UKV) { const int nblk = 1024 / 64, kb = r / nblk, nb = r % nblk; p0_transpose_item(w_ukv, KVL, 1024, Wukv_t, nb * 64, kv_norm, scr, kb * 64, nb * 64, lane); continue; } r -= I_UKV;
            { const int nblk = DM / 64, kb = r / nblk, nb = r % nblk; p0_transpose_item(w_o, DM, DM, Wo_t, nb * 64, nullptr, scr, kb * 64, nb * 64, lane); }
        }
        const int gt = vcu * (NWAVES * 64) + tid, NGT = G * NWAVES * 64;
        for (int i = gt; i < (NPP - NPROJ) * DM / 8; i += NGT) *(u32x4*)(Win_t + (size_t)NPROJ * DM + (size_t)i * 8) = (u32x4){0u, 0u, 0u, 0u};
        for (int i = gt; i < NH * 64 * QL / 8; i += NGT) { const int h = i / (64 * QL / 8), j = i % (64 * QL / 8); *(u32x4*)(Wuq_t + (size_t)(h * 256 + 192) * QL + (size_t)j * 8) = (u32x4){0u, 0u, 0u, 0u}; }
        for (int i = gt; i < NE * DM; i += NGT) { const int e = i / DM, k = i % DM; const float v = w_router[(size_t)k * NE + e] * norm_ffn[k]; const unsigned h = f2bf(v); const float hf = __builtin_bit_cast(float, h << 16);
            WrH[i] = (bf16_t)h; WrL[i] = (bf16_t)f2bf(v - hf); }
        for (int i = gt; i < SEQ * 32; i += NGT) { const int pos = i >> 5, fi = i & 31; const float inv = exp2f(-(float)fi * (13.287712379549449f / 32.f)); const float ang = (float)pos * inv; float s, c; sincosf(ang, &s, &c); rope_t[i] = (f32x2){c, s}; }
        for (int m = 2 * gw; m < NTOK; m += 2 * NGW) {
            const f32x4* xr = (const f32x4*)(x + (size_t)m * DM) + lane; const f32x4* gr = (const f32x4*)norm_mix + lane;
            f32x4 v[2][4]; float s0 = 0.f, s1 = 0.f;
#pragma unroll
            for (int j = 0; j < 4; ++j) { v[0][j] = __builtin_nontemporal_load(xr + 64 * j); v[1][j] = __builtin_nontemporal_load(xr + DM / 4 + 64 * j); }
#pragma unroll
            for (int j = 0; j < 4; ++j) { s0 += (v[0][j].x * v[0][j].x + v[0][j].y * v[0][j].y) + (v[0][j].z * v[0][j].z + v[0][j].w * v[0][j].w);
                                          s1 += (v[1][j].x * v[1][j].x + v[1][j].y * v[1][j].y) + (v[1][j].z * v[1][j].z + v[1][j].w * v[1][j].w); }
            const float r0 = 1.0f / sqrtf(wave_sum(s0) * (1.f / DM) + EPS), r1 = 1.0f / sqrtf(wave_sum(s1) * (1.f / DM) + EPS);
            u32x2* o8 = (u32x2*)(hn + (size_t)m * DM) + lane;
#pragma unroll
            for (int j = 0; j < 4; ++j) { const f32x4 g = gr[64 * j]; u32x2 w;
                w.x = cvt_pk_bf16(v[0][j].x * r0 * g.x, v[0][j].y * r0 * g.y); w.y = cvt_pk_bf16(v[0][j].z * r0 * g.z, v[0][j].w * r0 * g.w); o8[64 * j] = w;
                w.x = cvt_pk_bf16(v[1][j].x * r1 * g.x, v[1][j].y * r1 * g.y); w.y = cvt_pk_bf16(v[1][j].z * r1 * g.z, v[1][j].w * r1 * g.w); o8[DM / 4 + 64 * j] = w; }
        }
        if (BOTH(0)) GRID_BAR();
    }

    if (IN(1)) {
        pg8::DenseSched S; S.init(hn, DM, Win_t, NTOK, NPP, DM, G, bx);
        pg8::EpiProj E{pbuf, ssq};
        pg8::gemm_phase<pg8::EpiProj, pg8::DenseSched, false>(lds, S, E);
        if (BOTH(1)) GRID_BAR();
    }

    if (IN(2)) {
        {
            const int gt = vcu * (NWAVES * 64) + tid, NGT = G * NWAVES * 64;
            for (int it = gt; it < (NTOK / 16) * 64; it += NGT) {
                const int run = it >> 6, gr = it & 63, t0 = run * 16, ch = gr * 8;
                float w0[8], w1[8], w2[8];
#pragma unroll
                for (int i = 0; i < 8; ++i) { w0[i] = conv_w[ch + i]; w1[i] = conv_w[CONVW + ch + i]; w2[i] = conv_w[2 * CONVW + ch + i]; }
                float um2[8], um1[8];
#pragma unroll
                for (int i = 0; i < 8; ++i) { um2[i] = 0.f; um1[i] = 0.f; }
                if ((t0 & (SEQ - 1)) != 0) {
                    float c8[8], x8[8];
                    unpack8(*(const u32x4*)(pbuf + (size_t)(t0 - 2) * NPP + PB_C + ch), c8); unpack8(*(const u32x4*)(pbuf + (size_t)(t0 - 2) * NPP + PB_X + ch), x8);
#pragma unroll
                    for (int i = 0; i < 8; ++i) um2[i] = c8[i] * x8[i];
                    unpack8(*(const u32x4*)(pbuf + (size_t)(t0 - 1) * NPP + PB_C + ch), c8); unpack8(*(const u32x4*)(pbuf + (size_t)(t0 - 1) * NPP + PB_X + ch), x8);
#pragma unroll
                    for (int i = 0; i < 8; ++i) um1[i] = c8[i] * x8[i];
                }
#pragma unroll 4
                for (int t = 0; t < 16; ++t) {
                    const bf16_t* pr = pbuf + (size_t)(t0 + t) * NPP + ch;
                    float b8[8], c8[8], x8[8], o8[8];
                    unpack8(__builtin_nontemporal_load((const u32x4*)(pr + PB_B)), b8); unpack8(__builtin_nontemporal_load((const u32x4*)(pr + PB_C)), c8); unpack8(__builtin_nontemporal_load((const u32x4*)(pr + PB_X)), x8);
#pragma unroll
                    for (int i = 0; i < 8; ++i) { const float uu = c8[i] * x8[i]; o8[i] = b8[i] * (w0[i] * um2[i] + w1[i] * um1[i] + w2[i] * uu); um2[i] = um1[i]; um1[i] = uu; }
                    *(u32x4*)(mix + (size_t)(t0 + t) * DM + ch) = pack8(o8);
                }
            }
        }
        LAS float* etab = (LAS float*)(lds + EPI_TAB_OFF);
        { pg8::DenseSched S; S.init(pbuf + PB_CQ, NPP, Wuq_t, NTOK, NQP, QL, G, bx); pg8::EpiQ E{qb_, ssq, q_head_norm, rope_t, etab};
          pg8::gemm_phase<pg8::EpiQ, pg8::DenseSched, false>(lds, S, E); }
        { pg8::DenseSched S; S.init(pbuf + PB_CKV, NPP, Wukv_t, NTOK, 1024, KVL, G, bx); pg8::EpiKV E{kb_, vb_, ssq, k_head_norm, rope_t, pbuf, etab};
          pg8::gemm_phase<pg8::EpiKV, pg8::DenseSched, false>(lds, S, E); }
        if (BOTH(2)) GRID_BAR();
    }


    if (IN(4)) {
        for (int u = vcu; u < NB * NH * 4; u += G) {
            const int bh = u >> 2, pr = u & 3, b = bh >> 2, h = bh & 3;
            att::attn_unit(b, h, 7 - pr, qb_, kb_, vb_, mix + CONVW, lds);
            att::attn_unit(b, h, pr, qb_, kb_, vb_, mix + CONVW, lds);
        }
        if (BOTH(4)) GRID_BAR();
    }

    if (IN(5)) {
        pg8::DenseSched S; S.init(mix, DM, Wo_t, NTOK, DM, DM, G, bx);
        pg8::EpiOut E{x, out, ssq};
        pg8::gemm_phase<pg8::EpiOut, pg8::DenseSched, false>(lds, S, E);
        if (BOTH(5)) GRID_BAR();
    }

    if (IN(6)) {
        LAS unsigned* hist = (LAS unsigned*)(lds + MISC_OFF) + 128; LAS unsigned* base = (LAS unsigned*)(lds + MISC_OFF) + 160;
        const int tj = lane & 15, q = lane >> 4;
        for (int tile = vcu; tile < NTOK / 128; tile += G) {
            if (tid < 32) hist[tid] = 0u;
            __syncthreads();
            const int token = tile * 128 + wave * 16 + tj;
            const float* hrow = out + (size_t)token * DM + q * 8;
            const bf16_t* wh0 = WrH + (size_t)tj * DM + q * 8; const bf16_t* wl0 = WrL + (size_t)tj * DM + q * 8;
            f32x4 a0 = {0.f, 0.f, 0.f, 0.f}, a1 = {0.f, 0.f, 0.f, 0.f};
            float s2 = 0.f;
#pragma unroll
            for (int p = 0; p < 16; ++p) s2 += ssq[(size_t)p * NTOK + token];
            const float rs = 1.0f / sqrtf(s2 * (1.f / DM) + EPS);
            unsigned char* hqrow = hq + (size_t)token * DM + q * 8;
#pragma unroll 4
            for (int ks = 0; ks < DM / 32; ++ks) {
                const f32x4 h0 = *(const f32x4*)(hrow + ks * 32), h1 = *(const f32x4*)(hrow + ks * 32 + 4);
                float hf[8] = {h0[0], h0[1], h0[2], h0[3], h1[0], h1[1], h1[2], h1[3]}; float lf[8];
                { u32x2 w8; w8.x = pk4_fp8(hf[0] * rs, hf[1] * rs, hf[2] * rs, hf[3] * rs); w8.y = pk4_fp8(hf[4] * rs, hf[5] * rs, hf[6] * rs, hf[7] * rs); *(u32x2*)(hqrow + ks * 32) = w8; }
                u32x4 hw; hw.x = pk2(hf[0], hf[1]); hw.y = pk2(hf[2], hf[3]); hw.z = pk2(hf[4], hf[5]); hw.w = pk2(hf[6], hf[7]);
                { float hb8[8]; unpack8(hw, hb8);
#pragma unroll
                  for (int i = 0; i < 8; ++i) lf[i] = hf[i] - hb8[i]; }
                const bf16x8 bh = __builtin_bit_cast(bf16x8, hw), bl = __builtin_bit_cast(bf16x8, pack8(lf));
                const bf16x8 wh_a = *(const bf16x8*)(wh0 + ks * 32), wh_b = *(const bf16x8*)(wh0 + 16 * DM + ks * 32);
                const bf16x8 wl_a = *(const bf16x8*)(wl0 + ks * 32), wl_b = *(const bf16x8*)(wl0 + 16 * DM + ks * 32);
                a0 = __builtin_amdgcn_mfma_f32_16x16x32_bf16(wh_a, bh, a0, 0, 0, 0); a0 = __builtin_amdgcn_mfma_f32_16x16x32_bf16(wl_a, bh, a0, 0, 0, 0); a0 = __builtin_amdgcn_mfma_f32_16x16x32_bf16(wh_a, bl, a0, 0, 0, 0);
                a1 = __builtin_amdgcn_mfma_f32_16x16x32_bf16(wh_b, bh, a1, 0, 0, 0); a1 = __builtin_amdgcn_mfma_f32_16x16x32_bf16(wl_b, bh, a1, 0, 0, 0); a1 = __builtin_amdgcn_mfma_f32_16x16x32_bf16(wh_b, bl, a1, 0, 0, 0);
            }
            float lv[8]; int le[8];
#pragma unroll
            for (int i = 0; i < 4; ++i) { le[i] = 4 * q + i; le[4 + i] = 16 + 4 * q + i; lv[i] = a0[i] * rs + b_router[le[i]]; lv[4 + i] = a1[i] * rs + b_router[le[4 + i]]; }
            float tv[4]; int te[4];
#pragma unroll
            for (int k = 0; k < TOPK; ++k) {
                float bv = lv[0]; int be = le[0];
#pragma unroll
                for (int i = 1; i < 8; ++i) if (lv[i] > bv) { bv = lv[i]; be = le[i]; }
#pragma unroll
                for (int o = 16; o < 64; o <<= 1) { const float ov = __shfl_xor(bv, o); const int oe = __shfl_xor(be, o); if (ov > bv || (ov == bv && oe < be)) { bv = ov; be = oe; } }
                tv[k] = bv; te[k] = be;
#pragma unroll
                for (int i = 0; i < 8; ++i) if (le[i] == be) lv[i] = -3.0e38f;
            }
            float ge[4]; float gs = 0.f;
#pragma unroll
            for (int k = 0; k < TOPK; ++k) { ge[k] = __expf(tv[k] - tv[0]); gs += ge[k]; }
            const float ginv = 1.0f / gs;
            int my_e = te[0]; float my_g = ge[0];
#pragma unroll
            for (int k = 1; k < TOPK; ++k) if (q == k) { my_e = te[k]; my_g = ge[k]; }
            my_g *= ginv;
            const unsigned pl = atomicAdd((unsigned*)(hist + my_e), 1u);
            __syncthreads();
            if (tid < 32) base[tid] = __hip_atomic_fetch_add(ctl + CW_CNT + 64 * tid, hist[tid], __ATOMIC_RELAXED, __HIP_MEMORY_SCOPE_AGENT);
            __syncthreads();
            const unsigned pos = base[my_e] + pl; const int slot = token * 4 + q;
            *(u32x2*)(tos + ((size_t)my_e * CAP + pos) * 2) = (u32x2){(unsigned)slot, __builtin_bit_cast(unsigned, my_g)};
            __syncthreads();
        }
        if (BOTH(6)) GRID_BAR();
    }

    LAS int* tab = (LAS int*)(lds + MISC_OFF) + 16;
    if (IN(7) || IN(8) || IN(10) || IN(11) || IN(12)) {
        if (tid < 32) { const int c = (int)__hip_atomic_load(ctl + CW_CNT + 64 * tid, __ATOMIC_RELAXED, __HIP_MEMORY_SCOPE_AGENT); tab[48 + tid] = c; }
        __syncthreads();
        if (tid == 0) { int s = 0; for (int e = 0; e < NE; ++e) { tab[e] = s; s += (tab[48 + e] + 255) >> 8; } tab[32] = s; }
        __syncthreads();
        for (int t = tid; t < tab[32]; t += NWAVES * 64) { int e = 0; while (e < NE - 1 && tab[e + 1] <= t) ++e; tab[2288 + t] = e; }
        __syncthreads();
    }

    if (IN(7)) {
        pg8::MoeSched S{hq, Wgu_t, DM, DM, 2 * DFF / 256, G, bx, (size_t)2 * DFF * DM, tab, tos};
        pg8::EpiSwiglu E{act, b_gate_up};
        pg8::gemm_phase<pg8::EpiSwiglu, pg8::MoeSched, true>(lds, S, E);
        if (BOTH(7)) GRID_BAR();
    }

    if (IN(8)) {
        pg8::MoeSched S{act, Wdn_t, DFF, DFF, DM / 256, G, bx, (size_t)DM * DFF, tab, tos};
        pg8::EpiDown E{(unsigned char*)oslot, b_down, ws + WS_SSQ, lds};
        pg8::gemm_phase<pg8::EpiDown, pg8::MoeSched, false>(lds, S, E);
        if (BOTH(8)) GRID_BAR();
    }

#if PROBE_DOUBLE
    if (IN(10)) { pg8::MoeSched S{hq, Wgu_t, DM, DM, 2 * DFF / 256, G, bx, (size_t)2 * DFF * DM, tab, tos}; pg8::EpiNull E{(float*)(ws + WS_SSQ)};
        pg8::gemm_phase<pg8::EpiNull, pg8::MoeSched, true>(lds, S, E); }
    if (IN(11)) { pg8::MoeSched S{act, Wdn_t, DFF, DFF, DM / 256, G, bx, (size_t)DM * DFF, tab, tos}; pg8::EpiNull E{(float*)(ws + WS_SSQ)};
        pg8::gemm_phase<pg8::EpiNull, pg8::MoeSched, false, 2>(lds, S, E); }
    if (IN(12)) { pg8::MoeSched S{act, Wdn_t, DFF, DFF, DM / 256, G, bx, (size_t)DM * DFF, tab, tos}; pg8::EpiNull E{(float*)(ws + WS_SSQ)};
        pg8::gemm_phase<pg8::EpiNull, pg8::MoeSched, false>(lds, S, E); }
#endif
    if (IN(9)) {
        const unsigned char* os8 = (const unsigned char*)oslot;
        constexpr float OI = 1.f / OS8_SCALE;
        for (int m = gw; m < NTOK; m += NGW) {
            f32x4* orow = (f32x4*)(out + (size_t)m * DM) + lane;
            const unsigned* s0 = (const unsigned*)(os8 + (size_t)m * 4 * DM) + lane;
            unsigned w[4][4]; f32x4 hv[4];
#pragma unroll
            for (int j = 0; j < 4; ++j) { hv[j] = __builtin_nontemporal_load(orow + 64 * j);
#pragma unroll
                for (int k = 0; k < 4; ++k) w[j][k] = __builtin_nontemporal_load(s0 + (size_t)k * (DM / 4) + 64 * j); }
#pragma unroll
            for (int j = 0; j < 4; ++j) { f32x4 a = {0.f, 0.f, 0.f, 0.f};
#pragma unroll
                for (int k = 0; k < 4; ++k) { const f32x2 lo = __builtin_amdgcn_cvt_pk_f32_fp8(w[j][k], false), hi2 = __builtin_amdgcn_cvt_pk_f32_fp8(w[j][k], true); a.x += lo.x; a.y += lo.y; a.z += hi2.x; a.w += hi2.y; }
                __builtin_nontemporal_store(hv[j] + a * OI, orow + 64 * j); }
        }
    }
#undef IN
#undef BOTH
#undef GRID_BAR
}

#ifdef DIAG_PHASES
template __global__ void fwd_kernel_t<1>(Args); template __global__ void fwd_kernel_t<2>(Args); template __global__ void fwd_kernel_t<4>(Args); template __global__ void fwd_kernel_t<8>(Args);
template __global__ void fwd_kernel_t<16>(Args); template __global__ void fwd_kernel_t<32>(Args); template __global__ void fwd_kernel_t<64>(Args); template __global__ void fwd_kernel_t<128>(Args);
template __global__ void fwd_kernel_t<256>(Args); template __global__ void fwd_kernel_t<512>(Args);
#endif
#define fwd_kernel fwd_kernel_t<(PROBE_DOUBLE ? 0x1fff : 1023)>
extern "C" void kernel_launch(void* const* d_in, const int* in_sizes, int n_in, void* d_out, int out_size, void* d_ws, size_t ws_size, hipStream_t stream) {
    static int grid = 0;
    if (grid == 0) {
        if (n_in != 18 || in_sizes[0] != NTOK * DM || out_size != NTOK * DM || ws_size < WS_END) { fprintf(stderr, "kernel_launch: shape/workspace mismatch (n_in %d, in0 %d, out %d, ws %zu, need %zu)\n", n_in, n_in > 0 ? in_sizes[0] : -1, out_size, ws_size, (size_t)WS_END); grid = -1; return; }
        int dev = 0, cus = 0, per_cu = 0;
        if (hipGetDevice(&dev) != hipSuccess || hipDeviceGetAttribute(&cus, hipDeviceAttributeMultiprocessorCount, dev) != hipSuccess) { grid = -1; return; }
        if (hipFuncSetAttribute((const void*)fwd_kernel, hipFuncAttributeMaxDynamicSharedMemorySize, LDS_BYTES) != hipSuccess) { fprintf(stderr, "kernel_launch: hipFuncSetAttribute failed\n"); grid = -1; return; }
        if (hipOccupancyMaxActiveBlocksPerMultiprocessor(&per_cu, (const void*)fwd_kernel, NWAVES * 64, LDS_BYTES) != hipSuccess || per_cu < 1) { fprintf(stderr, "kernel_launch: occupancy query says %d\n", per_cu); }
        (void)hipGetLastError();
        grid = cus;
    }
    if (grid < 0) return;
    if (hipMemsetAsync((char*)d_ws + WS_CTL, 0, CTL_ZERO_BYTES, stream) != hipSuccess) return;
    Args a{};
    for (int i = 0; i < 18; ++i) a.in[i] = (const float*)d_in[i];
    a.out = (float*)d_out; a.ws = (unsigned char*)d_ws;
    if (N_LAUNCHES == 1) { a.ph_lo = 0; a.ph_hi = N_PHASES; hipLaunchKernelGGL(fwd_kernel, dim3(grid), dim3(NWAVES * 64), LDS_BYTES, stream, a); }
    else { for (int p = 0; p < N_PHASES; ++p) { a.ph_lo = p; a.ph_hi = p + 1; const int reps = ((PROBE_DOUBLE >> p) & 1) ? 2 : 1;
            for (int r = 0; r < reps; ++r) hipLaunchKernelGGL(fwd_kernel, dim3(grid), dim3(NWAVES * 64), LDS_BYTES, stream, a);
            if (p == 8) for (int pp = 10; pp < 13; ++pp) if ((PROBE_DOUBLE >> pp) & 1) { a.ph_lo = pp; a.ph_hi = pp + 1; hipLaunchKernelGGL(fwd_kernel, dim3(grid), dim3(NWAVES * 64), LDS_BYTES, stream, a); } } }
}
```

```cpp
#include <hip/hip_runtime.h>
#include <cstdio>
#include <cstdint>

#ifndef MK_N_LAUNCHES
#define MK_N_LAUNCHES 1
#endif

#ifndef PROBE_DOUBLE
#define PROBE_DOUBLE 0
#endif
#define LAS __attribute__((address_space(3)))
#define GAS __attribute__((address_space(1)))
typedef unsigned short bf16_t;
typedef short bf16x8 __attribute__((ext_vector_type(8)));
typedef short s16x4 __attribute__((ext_vector_type(4)));
typedef float f32x2 __attribute__((ext_vector_type(2)));
typedef float f32x4 __attribute__((ext_vector_type(4)));
typedef float f32x16 __attribute__((ext_vector_type(16)));
typedef unsigned u32x2 __attribute__((ext_vector_type(2)));
typedef unsigned u32x4 __attribute__((ext_vector_type(4)));
typedef int v4i_t __attribute__((ext_vector_type(4)));
typedef int v8i_t __attribute__((ext_vector_type(8)));

constexpr int NB = 16, SEQ = 2048, NTOK = NB * SEQ, DM = 1024;
constexpr int CONVW = 512, QL = 384, KVL = 256, ROPE = 64, NH = 4, QKN = 128, QKH = 192, VH = 128;
constexpr int NPROJ = 2240, NPP = 2304;
constexpr int PB_B = 0, PB_C = 512, PB_X = 1024, PB_CKV = 1536, PB_CQ = 1792, PB_KPE = 2176;
constexpr int NQP = 1024;
constexpr int NE = 32, TOPK = 4, DFF = 1024, NSLOT = NTOK * TOPK;
constexpr int CAP = NTOK;
constexpr int MAXTILES = NSLOT / 256 + NE;
constexpr float EPS = 1e-6f;
constexpr float QSCALE = 0.07216878364870322f * 1.4426950408889634f;
constexpr float SWI_LIMIT = 7.0f, SWI_ALPHA = 1.702f;
constexpr float W8_SCALE = 64.f, ACT8_SCALE = 4.f, OS8_SCALE = 16.f;

constexpr size_t MiB = 1u << 20;
constexpr size_t WS_CTL = 0, CTL_ZERO_BYTES = 1 * MiB;
constexpr size_t WS_ROPE = 1 * MiB;
constexpr size_t WS_WRH = 1 * MiB + 512 * 1024, WS_WRL = WS_WRH + 64 * 1024;
constexpr size_t WS_WIN = 2 * MiB;
constexpr size_t WS_WUQ = 8 * MiB, WS_WUKV = 9 * MiB, WS_WO = 10 * MiB;
constexpr size_t WS_SSQ = 12 * MiB;
constexpr size_t WS_RS2 = 14 * MiB, WS_GATE = 14 * MiB + 512 * 1024;
constexpr size_t WS_TOS = 16 * MiB;
constexpr size_t WS_WGU = 32 * MiB, WS_WDN = 160 * MiB;
constexpr size_t WS_HB = 224 * MiB;
constexpr size_t WS_Q = 288 * MiB, WS_K = 336 * MiB, WS_V = 384 * MiB, WS_MIX = 416 * MiB;
constexpr size_t WS_OSLOT = 288 * MiB;
constexpr size_t WS_HN = 544 * MiB, WS_PB = 608 * MiB, WS_QRAW = 752 * MiB, WS_KVRAW = 800 * MiB;
constexpr size_t WS_ACT = 544 * MiB;
constexpr size_t WS_END = 864 * MiB;
constexpr int CW_BAR = 4096;
constexpr int CW_CNT = 16384;

constexpr int RING_BYTES = 131072;
constexpr int MISC_OFF = RING_BYTES;
constexpr int LDS_BYTES = 155648;
constexpr int EPI_TAB_OFF = MISC_OFF + 3072 * 4;

__device__ __forceinline__ unsigned cvt_pk_bf16(float lo, float hi) { unsigned r; asm volatile("v_cvt_pk_bf16_f32 %0, %1, %2" : "=v"(r) : "v"(lo), "v"(hi)); return r; }
__device__ __forceinline__ unsigned f2bf(float f) { unsigned u = __builtin_bit_cast(unsigned, f); return (u + 0x7fffu + ((u >> 16) & 1u)) >> 16; }
__device__ __forceinline__ unsigned pk2(float lo, float hi) { return f2bf(lo) | (f2bf(hi) << 16); }
__device__ __forceinline__ float bf_lo(unsigned w) { return __builtin_bit_cast(float, w << 16); }
__device__ __forceinline__ float bf_hi(unsigned w) { return __builtin_bit_cast(float, w & 0xffff0000u); }
__device__ __forceinline__ void unpack8(const u32x4 w, float* f) { f[0] = bf_lo(w.x); f[1] = bf_hi(w.x); f[2] = bf_lo(w.y); f[3] = bf_hi(w.y); f[4] = bf_lo(w.z); f[5] = bf_hi(w.z); f[6] = bf_lo(w.w); f[7] = bf_hi(w.w); }
__device__ __forceinline__ u32x4 pack8(const float* f) { u32x4 w; w.x = cvt_pk_bf16(f[0], f[1]); w.y = cvt_pk_bf16(f[2], f[3]); w.z = cvt_pk_bf16(f[4], f[5]); w.w = cvt_pk_bf16(f[6], f[7]); return w; }
__device__ __forceinline__ float wave_sum(float v) {
#pragma unroll
    for (int o = 1; o < 64; o <<= 1) v += __shfl_xor(v, o);
    return v;
}
__device__ __forceinline__ float half_sum(float v) {
#pragma unroll
    for (int o = 1; o < 32; o <<= 1) v += __shfl_xor(v, o);
    return v;
}
__device__ __forceinline__ float clamp448(float v) { return __builtin_amdgcn_fmed3f(v, -448.f, 448.f); }
__device__ __forceinline__ unsigned pk4_fp8_nc(float a, float b, float c, float d) {
    unsigned w = 0u; w = (unsigned)__builtin_amdgcn_cvt_pk_fp8_f32(a, b, (int)w, false); w = (unsigned)__builtin_amdgcn_cvt_pk_fp8_f32(c, d, (int)w, true); return w; }
__device__ __forceinline__ unsigned pk4_fp8(float a, float b, float c, float d) {
    unsigned w = 0u; w = (unsigned)__builtin_amdgcn_cvt_pk_fp8_f32(clamp448(a), clamp448(b), (int)w, false); w = (unsigned)__builtin_amdgcn_cvt_pk_fp8_f32(clamp448(c), clamp448(d), (int)w, true); return w; }
#define LDS_WAIT() asm volatile("s_waitcnt lgkmcnt(0)" ::: "memory")
#define VM_WAIT() asm volatile("s_waitcnt vmcnt(0)" ::: "memory")

namespace pg8 {
constexpr int BM = 256, BK = 64, HALF = 128, HTB = HALF * BK * 2, STAGE_BYTES = 8 * HTB, NXCD = 8, WGM = 8;
__host__ __device__ __forceinline__ int lds_byte(int r, int c) { const int st = (r >> 4) * 2 + (c >> 5), rr = r & 15, cc = c & 31, ob = rr * 64 + cc * 2; return st * 1024 + (ob ^ (((ob >> 9) & 1) << 5)); }
__host__ __device__ __forceinline__ void stage_rc(int b, int& R, int& C) { const int st = b / 1024, sb = b % 1024, swz = sb ^ (((sb >> 9) & 1) << 5); R = (st >> 1) * 16 + swz / 64; C = (st & 1) * 32 + (swz % 64) / 2; }
__host__ __device__ __forceinline__ int perm32(int rho) { const int n = rho >> 4, i = rho & 15; return 8 * (i >> 2) + 4 * n + (i & 3); }

struct Unit { int pm, pn, e, p0, cnt, par; };

struct DenseSched {
    static constexpr int ESZ = 2;
    const bf16_t* A; const bf16_t* Bt; int lda, K, nM, nN, nwg, G, c;
    __device__ void init(const bf16_t* A_, int lda_, const bf16_t* Bt_, int M, int N, int K_, int G_, int c_) { A = A_; Bt = Bt_; lda = lda_; K = K_; nM = M / BM; nN = N / BM; nwg = nM * nN; G = G_; c = c_; }
    __device__ __forceinline__ bool next(int i, Unit& u) const {
        const long L = (long)i * G + c; if (L >= nwg) return false;
        int wgid = (int)L; { const int q = nwg / NXCD, r = nwg % NXCD, xcd = wgid % NXCD, off = wgid / NXCD; wgid = (xcd < r ? xcd * (q + 1) : r * (q + 1) + (xcd - r) * q) + off; }
        const int nig = WGM * nN, gid = wgid / nig, fm = gid * WGM, gsz = (nM - fm) < WGM ? (nM - fm) : WGM;
        u.pm = fm + ((wgid % nig) % gsz); u.pn = (wgid % nig) / gsz; u.e = 0; u.p0 = 0; u.cnt = 0; return true;
    }
    __device__ __forceinline__ unsigned a_off(const Unit& u) const { return (unsigned)u.pm * (unsigned)(BM * lda * 2); }
    __device__ __forceinline__ unsigned b_off(const Unit& u) const { return (unsigned)u.pn * (unsigned)(BM * K * 2); }
    __device__ __forceinline__ unsigned a_rowoff(const Unit&, int) const { return 0u; }
    static constexpr bool META = false;
    __device__ __forceinline__ void meta_first(const Unit&, LAS unsigned char*) const {}
    __device__ __forceinline__ void meta_issue(const Unit&, unsigned (&)[4], const int (&)[2]) const {}
    __device__ __forceinline__ void meta_commit(const Unit&, unsigned (&)[4], LAS unsigned char*) const {}
    __device__ __forceinline__ unsigned meta_rowoff(const Unit&, unsigned, int) const { return 0u; }
    __device__ __forceinline__ void pre_issue(const Unit&, f32x4 (&)[4], int, int) const {}
};
struct MoeSched {
    static constexpr int ESZ = 1;
    const unsigned char* A; const unsigned char* Bt; int lda, K, nN, G, c; size_t estride; const LAS int* tab; const int* tos; const float* bias;
    static constexpr bool META = true;
    static constexpr int META_OFF = MISC_OFF + 4608 * 4;
    __device__ __forceinline__ bool next(int i, Unit& u) const {
        const int T = __builtin_amdgcn_readfirstlane(tab[32]), nwg = T * nN;
        const long L = (long)i * G + c; if (L >= nwg) return false;
        int wgid = (int)L; { const int q = nwg / NXCD, r = nwg % NXCD, xcd = wgid % NXCD, off = wgid / NXCD; wgid = (xcd < r ? xcd * (q + 1) : r * (q + 1) + (xcd - r) * q) + off; }
        const int nig = WGM * nN, gid = wgid / nig, fm = gid * WGM, gsz = (T - fm) < WGM ? (T - fm) : WGM;
        const int mt = fm + ((wgid % nig) % gsz); u.pm = mt; u.pn = (wgid % nig) / gsz;
        const int e = __builtin_amdgcn_readfirstlane(tab[2288 + mt]);
        u.e = e; u.p0 = (mt - __builtin_amdgcn_readfirstlane(tab[e])) * BM; u.cnt = __builtin_amdgcn_readfirstlane(tab[48 + e]); return true;
    }
    __device__ __forceinline__ unsigned a_off(const Unit& u) const { return (unsigned)u.pm * (unsigned)(BM * lda); }
    __device__ __forceinline__ unsigned b_off(const Unit& u) const { return (unsigned)u.e * (unsigned)estride + (unsigned)u.pn * (unsigned)(BM * K); }
    __device__ __forceinline__ unsigned a_rowoff(const Unit& u, int r) const {
        const int p = u.p0 + r; const int sv = tos[((size_t)u.e * CAP + p) * 2];
        const int slot = (p < u.cnt) ? sv : 0;
        return (unsigned)(slot >> 2) * (unsigned)lda;
    }
    __device__ __forceinline__ void meta_first(const Unit& u, LAS unsigned char* lds) const {
        if (threadIdx.x < BM) { const u32x2 v = *(const u32x2*)(tos + ((size_t)u.e * CAP + u.p0 + threadIdx.x) * 2); *(LAS u32x2*)(lds + META_OFF + u.par * 2048 + threadIdx.x * 8) = v; }
    }
    __device__ __forceinline__ void meta_issue(const Unit& u, unsigned (&mreg)[4], const int (&RA)[2]) const {
        const unsigned base = ((unsigned)u.e * (unsigned)CAP + (unsigned)u.p0) * 8u;
        if (nN == 8) {
#pragma unroll
            for (int k = 0; k < 4; ++k) { const unsigned off = base + (unsigned)((k >> 1) * HALF + RA[k & 1]) * 8u;
                asm volatile("global_load_dword %0, %1, %2" : "=v"(mreg[k]) : "v"(off), "s"(tos) : "memory"); }
        } else {
            const unsigned off = base + (threadIdx.x & 255u) * 8u; u32x2 v;
            asm volatile("global_load_dwordx2 %0, %1, %2" : "=v"(v) : "v"(off), "s"(tos) : "memory"); mreg[0] = v.x; mreg[1] = v.y;
        }
    }
    __device__ __forceinline__ void pre_issue(const Unit& u, f32x4 (&pre)[4], int wc, int fq) const {
        const unsigned j0 = (unsigned)(wc * 32 + 8 * fq) * 4u;
        if (nN == 8) { const unsigned o0 = ((unsigned)u.e * (2u * DFF) + (unsigned)u.pn * HALF) * 4u + j0, o1 = o0 + DFF * 4u;
            asm volatile("global_load_dwordx4 %0, %1, %2" : "=v"(pre[0]) : "v"(o0), "s"(bias) : "memory"); asm volatile("global_load_dwordx4 %0, %1, %2 offset:16" : "=v"(pre[1]) : "v"(o0), "s"(bias) : "memory");
            asm volatile("global_load_dwordx4 %0, %1, %2" : "=v"(pre[2]) : "v"(o1), "s"(bias) : "memory"); asm volatile("global_load_dwordx4 %0, %1, %2 offset:16" : "=v"(pre[3]) : "v"(o1), "s"(bias) : "memory");
        } else { const unsigned o0 = ((unsigned)u.e * DM + (unsigned)u.pn * BM) * 4u + j0;
            asm volatile("global_load_dwordx4 %0, %1, %2" : "=v"(pre[0]) : "v"(o0), "s"(bias) : "memory"); asm volatile("global_load_dwordx4 %0, %1, %2 offset:16" : "=v"(pre[1]) : "v"(o0), "s"(bias) : "memory");
            asm volatile("global_load_dwordx4 %0, %1, %2 offset:512" : "=v"(pre[2]) : "v"(o0), "s"(bias) : "memory"); asm volatile("global_load_dwordx4 %0, %1, %2 offset:528" : "=v"(pre[3]) : "v"(o0), "s"(bias) : "memory");
        }
    }
    __device__ __forceinline__ void meta_commit(const Unit& u, unsigned (&mreg)[4], LAS unsigned char* lds) const {
        asm volatile("" : "+v"(mreg[0]), "+v"(mreg[1]) :: "memory");
        if (threadIdx.x < BM) *(LAS u32x2*)(lds + META_OFF + u.par * 2048 + threadIdx.x * 8) = (u32x2){mreg[0], mreg[1]};
    }
    __device__ __forceinline__ unsigned meta_rowoff(const Unit& u, unsigned sv, int r) const {
        asm volatile("" : "+v"(sv) :: "memory");
        const int slot = (u.p0 + r < u.cnt) ? (int)sv : 0;
        return (unsigned)(slot >> 2) * (unsigned)lda;
    }
};

template <class Epi, class Sched, bool GATHER, int KREP = 1>
__device__ __forceinline__ void gemm_phase(LAS unsigned char* lds, const Sched& S, const Epi& E) {
    const int tid = threadIdx.x, wid = __builtin_amdgcn_readfirstlane(tid >> 6), lane = tid & 63, wr = wid >> 2, wc = wid & 3, fr = lane & 15, fq = lane >> 4;
    constexpr int ESZ = Sched::ESZ; constexpr bool F8 = (ESZ == 1);
    const int K = S.K * ESZ / 2, lda = S.lda * ESZ / 2, nt0 = K / BK, nt = nt0 * KREP;
    unsigned voffB[2], aoc[2][2], mreg[4] = {0u, 0u, 0u, 0u}; int RA[2], CA[2]; f32x4 pre[4];
#pragma unroll
    for (int i = 0; i < 2; ++i) { int R, C; stage_rc(tid * 16 + i * 8192, R, C); const int Rb = (R & ~31) + perm32(R & 31);
        voffB[i] = (unsigned)(Rb * K + C) * 2u; RA[i] = R; CA[i] = C;
        aoc[0][i] = (unsigned)(R * lda + C) * 2u; aoc[1][i] = (unsigned)((R + HALF) * lda + C) * 2u; }
    const unsigned kstep = (unsigned)(BK * 2);
    const unsigned hstepB = (unsigned)(HALF * K * 2), hstepA = GATHER ? 0u : (unsigned)(HALF * lda * 2);
    const __amdgpu_buffer_rsrc_t rA = __builtin_amdgcn_make_buffer_rsrc((void*)S.A, 0, -1, 0x00020000), rB = __builtin_amdgcn_make_buffer_rsrc((void*)S.Bt, 0, -1, 0x00020000);
    const unsigned ldsw = (unsigned)wid * 1024u;
    const int aoff = lds_byte(wr * 64 + fr, fq * 8), boff = lds_byte(wc * 32 + fr, fq * 8);
#define PG8_SA(b, h) (((b) * 2 + (h)) * HTB)
#define PG8_SB(b, h) ((4 + (b) * 2 + (h)) * HTB)
#define PG8_STAGE_B(bufoff, soff) do { _Pragma("unroll") for (int _i = 0; _i < 2; ++_i) \
        __builtin_amdgcn_raw_ptr_buffer_load_lds(rB, (LAS void*)(lds + (bufoff) + ldsw + _i * 8192), 16, voffB[_i], (soff), 0, 0); } while (0)
#define PG8_STAGE_A(bufoff, soff, h) do { _Pragma("unroll") for (int _i = 0; _i < 2; ++_i) \
        __builtin_amdgcn_raw_ptr_buffer_load_lds(rA, (LAS void*)(lds + (bufoff) + ldsw + _i * 8192), 16, aoc[GATHER ? (h) : 0][_i], (soff) + (h) * hstepA, 0, 0); } while (0)
#define PG8_LDA(dst, b, h) do { _Pragma("unroll") for (int m = 0; m < 4; ++m) _Pragma("unroll") for (int k = 0; k < 2; ++k) dst[m][k] = *(const LAS bf16x8*)(lds + PG8_SA(b, h) + aoff + m * 2048 + k * 1024); } while (0)
#define PG8_LDB(dst, b, h) do { _Pragma("unroll") for (int n = 0; n < 2; ++n) _Pragma("unroll") for (int k = 0; k < 2; ++k) dst[n][k] = *(const LAS bf16x8*)(lds + PG8_SB(b, h) + boff + n * 2048 + k * 1024); } while (0)
#define PG8_CAT(x) __builtin_shufflevector(__builtin_bit_cast(v4i_t, x[0]), __builtin_bit_cast(v4i_t, x[1]), 0, 1, 2, 3, 4, 5, 6, 7)
#define PG8_MMA(ai, bj, At, Bt) do { __builtin_amdgcn_s_setprio(1); _Pragma("unroll") for (int m = 0; m < 4; ++m) _Pragma("unroll") for (int n = 0; n < 2; ++n) { \
        if constexpr (F8) { asm volatile("v_mfma_scale_f32_16x16x128_f8f6f4 %0, %1, %2, %0, %3, %3 op_sel_hi:[0,0,0]" : "+v"(acc[ai][bj][m][n]) : "v"(PG8_CAT(Bt[n])), "v"(PG8_CAT(At[m])), "v"(0x7f7f7f7f)); } \
        else { _Pragma("unroll") for (int k = 0; k < 2; ++k) acc[ai][bj][m][n] = __builtin_amdgcn_mfma_f32_16x16x32_bf16(Bt[n][k], At[m][k], acc[ai][bj][m][n], 0, 0, 0); } } \
        __builtin_amdgcn_s_setprio(0); } while (0)
#define PG8_WAIT_V(n) asm volatile("s_waitcnt vmcnt(" #n ")" ::: "memory")
#define PG8_WAIT_L(n) asm volatile("s_waitcnt lgkmcnt(" #n ")" ::: "memory")
#define PG8_BAR __builtin_amdgcn_s_barrier()
#define PG8_SCHED __builtin_amdgcn_sched_barrier(0)
    Unit cur, nxt; int ui = 0;
    if (!S.next(0, cur)) return;
    cur.par = 0; if constexpr (Sched::META && !GATHER) S.meta_first(cur, lds);
    f32x4 acc[2][2][4][2];
#pragma unroll
    for (int a = 0; a < 2; ++a)
#pragma unroll
        for (int b = 0; b < 2; ++b)
#pragma unroll
            for (int m = 0; m < 4; ++m)
#pragma unroll
                for (int n = 0; n < 2; ++n) acc[a][b][m][n] = (f32x4){0.f, 0.f, 0.f, 0.f};
    bf16x8 At[4][2], B0[2][2], B1[2][2];
    unsigned cA = GATHER ? 0u : S.a_off(cur), cB = S.b_off(cur);
    if constexpr (GATHER) {
#pragma unroll
        for (int h = 0; h < 2; ++h)
#pragma unroll
            for (int i = 0; i < 2; ++i) aoc[h][i] = S.a_rowoff(cur, h * HALF + RA[i]) + (unsigned)CA[i] * 2u;
    }
    PG8_STAGE_B(PG8_SB(0, 0), cB); PG8_STAGE_B(PG8_SB(0, 1), cB + hstepB); PG8_STAGE_A(PG8_SA(0, 0), cA, 0); PG8_STAGE_A(PG8_SA(0, 1), cA, 1);
    if (wr == 1) PG8_BAR;
    PG8_WAIT_V(2); PG8_BAR;
    PG8_STAGE_B(PG8_SB(1, 0), cB + kstep); PG8_STAGE_A(PG8_SA(1, 0), cA + kstep, 0); PG8_STAGE_B(PG8_SB(1, 1), cB + hstepB + kstep);
    PG8_WAIT_V(6); PG8_BAR;
    for (;;) {
        const bool has_next = S.next(ui + 1, nxt);
        const unsigned nA = GATHER ? 0u : (has_next ? S.a_off(nxt) : cA), nB = has_next ? S.b_off(nxt) : cB;
        nxt.par = (ui + 1) & 1;
        for (int t = 0; t < nt; t += 2) {
            const bool last = (t == nt - 2);
            const unsigned a1 = cA + (unsigned)((t + 1) % nt0) * kstep;
            const unsigned a2 = last ? nA : cA + (unsigned)((t + 2) % nt0) * kstep, b2 = last ? nB : cB + (unsigned)((t + 2) % nt0) * kstep;
            const unsigned a3 = a2 + kstep, b3 = b2 + kstep;
            PG8_LDB(B0, 0, 0); PG8_LDB(B1, 0, 1); PG8_SCHED; PG8_LDA(At, 0, 0); PG8_STAGE_A(PG8_SA(1, 1), a1, 1);
            PG8_WAIT_V(8); PG8_WAIT_L(0); PG8_BAR;
            if constexpr (Sched::META) { if (t == 0) { S.pre_issue(cur, pre, wc, fq); if (has_next) S.meta_issue(nxt, mreg, RA); } }
            PG8_MMA(0, 0, At, B0); PG8_MMA(0, 1, At, B1); PG8_BAR; PG8_SCHED;
            if constexpr (Sched::META) { if (last && has_next) {
                if constexpr (GATHER) {
#pragma unroll
                    for (int h = 0; h < 2; ++h)
#pragma unroll
                        for (int i = 0; i < 2; ++i) aoc[h][i] = S.meta_rowoff(nxt, mreg[h * 2 + i], h * HALF + RA[i]) + (unsigned)CA[i] * 2u;
                } else S.meta_commit(nxt, mreg, lds); } }
            PG8_LDA(At, 0, 1); PG8_STAGE_B(PG8_SB(0, 0), b2); PG8_STAGE_B(PG8_SB(0, 1), b2 + hstepB); PG8_STAGE_A(PG8_SA(0, 0), a2, 0);
            PG8_WAIT_V(8); PG8_WAIT_L(0); PG8_BAR; PG8_MMA(1, 0, At, B0); PG8_MMA(1, 1, At, B1); PG8_BAR; PG8_SCHED;
            PG8_LDB(B0, 1, 0); PG8_LDB(B1, 1, 1); PG8_SCHED; PG8_LDA(At, 1, 0); PG8_STAGE_A(PG8_SA(0, 1), a2, 1);
            PG8_WAIT_V(8); PG8_WAIT_L(0); PG8_BAR; PG8_MMA(0, 0, At, B0); PG8_MMA(0, 1, At, B1); PG8_BAR; PG8_SCHED;
            PG8_LDA(At, 1, 1); PG8_STAGE_B(PG8_SB(1, 0), b3); PG8_STAGE_B(PG8_SB(1, 1), b3 + hstepB); PG8_STAGE_A(PG8_SA(1, 0), a3, 0);
            PG8_WAIT_V(8); PG8_WAIT_L(0); PG8_BAR; PG8_MMA(1, 0, At, B0); PG8_MMA(1, 1, At, B1); PG8_BAR; PG8_SCHED;
        }
        if (wr == 0) PG8_BAR;
        if constexpr (Sched::META) E(acc, cur, wr, wc, fr, fq, pre); else E(acc, cur, wr, wc, fr, fq);
        if (!has_next) break;
#pragma unroll
        for (int a = 0; a < 2; ++a)
#pragma unroll
            for (int b = 0; b < 2; ++b)
#pragma unroll
                for (int m = 0; m < 4; ++m)
#pragma unroll
                    for (int n = 0; n < 2; ++n) acc[a][b][m][n] = (f32x4){0.f, 0.f, 0.f, 0.f};
        cur = nxt; cA = nA; cB = nB; ++ui;
        if (wr == 1) PG8_BAR;
    }
    PG8_WAIT_V(0);
    PG8_BAR;
#undef PG8_SA
#undef PG8_SB
#undef PG8_STAGE_A
#undef PG8_STAGE_B
#undef PG8_LDA
#undef PG8_LDB
#undef PG8_MMA
#undef PG8_CAT
#undef PG8_WAIT_V
#undef PG8_WAIT_L
#undef PG8_BAR
#undef PG8_SCHED
}

struct EpiBf16 {
    bf16_t* O; int ldc;
    __device__ __forceinline__ void operator()(const f32x4 (&acc)[2][2][4][2], const Unit& u, int wr, int wc, int fr, int fq) const {
        asm volatile("" : "+v"(fr), "+v"(fq));
        const int row0 = u.pm * BM + wr * 64 + fr, col0 = u.pn * BM + wc * 32 + 8 * fq;
#pragma unroll
        for (int ai = 0; ai < 2; ++ai)
#pragma unroll
            for (int m = 0; m < 4; ++m) { bf16_t* rowp = O + (size_t)(row0 + ai * HALF + m * 16) * ldc + col0;
#pragma unroll
                for (int bj = 0; bj < 2; ++bj) { const f32x4 v0 = acc[ai][bj][m][0], v1 = acc[ai][bj][m][1];
                    u32x4 w; w.x = cvt_pk_bf16(v0[0], v0[1]); w.y = cvt_pk_bf16(v0[2], v0[3]); w.z = cvt_pk_bf16(v1[0], v1[1]); w.w = cvt_pk_bf16(v1[2], v1[3]);
                    *(u32x4*)(rowp + bj * HALF) = w; } }
    }
};
struct EpiProj {
    bf16_t* O; float* st;
    __device__ __forceinline__ void operator()(const f32x4 (&acc)[2][2][4][2], const Unit& u, int wr, int wc, int fr, int fq) const {
        asm volatile("" : "+v"(fr), "+v"(fq));
        const int row0 = u.pm * BM + wr * 64 + fr, col0 = u.pn * BM + wc * 32 + 8 * fq;
#pragma unroll
        for (int ai = 0; ai < 2; ++ai)
#pragma unroll
            for (int m = 0; m < 4; ++m) { const int row = row0 + ai * HALF + m * 16; bf16_t* rowp = O + (size_t)row * NPP + col0; float ss[2];
#pragma unroll
                for (int bj = 0; bj < 2; ++bj) { const f32x4 v0 = acc[ai][bj][m][0], v1 = acc[ai][bj][m][1];
                    u32x4 w; w.x = cvt_pk_bf16(v0[0], v0[1]); w.y = cvt_pk_bf16(v0[2], v0[3]); w.z = cvt_pk_bf16(v1[0], v1[1]); w.w = cvt_pk_bf16(v1[2], v1[3]);
                    *(u32x4*)(rowp + bj * HALF) = w;
                    ss[bj] = (v0[0] * v0[0] + v0[1] * v0[1]) + (v0[2] * v0[2] + v0[3] * v0[3]) + (v1[0] * v1[0] + v1[1] * v1[1]) + (v1[2] * v1[2] + v1[3] * v1[3]); }
                if (u.pn >= 6) {
                    float s0 = ss[0], s1 = ss[1]; s0 += __shfl_xor(s0, 16); s0 += __shfl_xor(s0, 32); s1 += __shfl_xor(s1, 16); s1 += __shfl_xor(s1, 32);
                    if (fq == 0) { if (u.pn == 6) st[(size_t)wc * NTOK + row] = s0 + s1; else if (u.pn == 7) st[(size_t)(4 + wc) * NTOK + row] = s0 + s1;
                                   else { st[(size_t)(8 + wc) * NTOK + row] = s0; st[(size_t)(12 + wc) * NTOK + row] = s1; } } } }
    }
};
struct EpiQ {
    bf16_t* q; const float* st; const float* qhn; const f32x2* rope; LAS float* tabs;
    __device__ __forceinline__ void operator()(const f32x4 (&acc)[2][2][4][2], const Unit& u, int wr, int wc, int fr, int fq) const {
        asm volatile("" : "+v"(fr), "+v"(fq));
        LAS float* rs_tab = tabs; LAS float* part = tabs + 512;
        const int rt0 = wr * 64 + fr;
        const int c0 = wc * 32 + 8 * fq;
        const int i0 = c0 >> 1;
        f32x4 csa[2][4][2];
        if (wc < 2) {
#pragma unroll
            for (int ai = 0; ai < 2; ++ai)
#pragma unroll
                for (int m = 0; m < 4; ++m) { const size_t row = (size_t)u.pm * BM + rt0 + ai * HALF + m * 16;
                    csa[ai][m][0] = *(const f32x4*)(rope + (row & (SEQ - 1)) * 32 + i0); csa[ai][m][1] = *(const f32x4*)(rope + (row & (SEQ - 1)) * 32 + i0 + 2); }
        }
        f32x4 g0[2], g1[2];
        g0[0] = *(const f32x4*)(qhn + c0) * QSCALE; g0[1] = *(const f32x4*)(qhn + c0 + 4) * QSCALE;
        if (wc < 2) { g1[0] = (f32x4){qhn[128 + i0], qhn[160 + i0], qhn[129 + i0], qhn[161 + i0]} * QSCALE; g1[1] = (f32x4){qhn[130 + i0], qhn[162 + i0], qhn[131 + i0], qhn[163 + i0]} * QSCALE; }
        else { g1[0] = (f32x4){0.f, 0.f, 0.f, 0.f}; g1[1] = g1[0]; }
        { const int t = threadIdx.x; if (t < BM) { const size_t r = (size_t)u.pm * BM + t; float s = 0.f;
#pragma unroll
            for (int k = 4; k < 12; ++k) s += st[(size_t)k * NTOK + r];
            rs_tab[t] = 1.0f / sqrtf(s * (1.f / QL) + EPS); } }
#pragma unroll
        for (int ai = 0; ai < 2; ++ai)
#pragma unroll
            for (int m = 0; m < 4; ++m) { float ss = 0.f;
#pragma unroll
                for (int bj = 0; bj < 2; ++bj)
#pragma unroll
                    for (int n = 0; n < 2; ++n) { const f32x4 v = acc[ai][bj][m][n]; ss += (v[0] * v[0] + v[1] * v[1]) + (v[2] * v[2] + v[3] * v[3]); }
                ss += __shfl_xor(ss, 16); ss += __shfl_xor(ss, 32);
                if (fq == 0) part[(rt0 + ai * HALF + m * 16) * 4 + wc] = ss; }
        asm volatile("s_waitcnt lgkmcnt(0)" ::: "memory"); __builtin_amdgcn_s_barrier(); asm volatile("" ::: "memory");
#pragma unroll
        for (int ai = 0; ai < 2; ++ai)
#pragma unroll
            for (int m = 0; m < 4; ++m) { const int rt = rt0 + ai * HALF + m * 16; const size_t row = (size_t)u.pm * BM + rt;
                const f32x4 pp = *(const LAS f32x4*)(part + rt * 4); const float rs = rs_tab[rt];
                const float r = rs / sqrtf(rs * rs * ((pp[0] + pp[1]) + (pp[2] + pp[3])) * (1.f / QKH) + EPS);
                bf16_t* qp = q + row * (NH * QKH) + u.pn * QKH + c0;
                { const f32x4 v0 = acc[ai][0][m][0] * g0[0] * r, v1 = acc[ai][0][m][1] * g0[1] * r;
                  u32x4 w; w.x = cvt_pk_bf16(v0[0], v0[1]); w.y = cvt_pk_bf16(v0[2], v0[3]); w.z = cvt_pk_bf16(v1[0], v1[1]); w.w = cvt_pk_bf16(v1[2], v1[3]); *(u32x4*)qp = w; }
                if (wc < 2) { const f32x4 cs0 = csa[ai][m][0], cs1 = csa[ai][m][1];
                    const f32x4 a0 = acc[ai][1][m][0] * g1[0] * r, a1 = acc[ai][1][m][1] * g1[1] * r;
                    f32x4 o0, o1;
                    o0[0] = a0[0] * cs0[0] - a0[1] * cs0[1]; o0[1] = a0[0] * cs0[1] + a0[1] * cs0[0]; o0[2] = a0[2] * cs0[2] - a0[3] * cs0[3]; o0[3] = a0[2] * cs0[3] + a0[3] * cs0[2];
                    o1[0] = a1[0] * cs1[0] - a1[1] * cs1[1]; o1[1] = a1[0] * cs1[1] + a1[1] * cs1[0]; o1[2] = a1[2] * cs1[2] - a1[3] * cs1[3]; o1[3] = a1[2] * cs1[3] + a1[3] * cs1[2];
                    u32x4 w; w.x = cvt_pk_bf16(o0[0], o0[1]); w.y = cvt_pk_bf16(o0[2], o0[3]); w.z = cvt_pk_bf16(o1[0], o1[1]); w.w = cvt_pk_bf16(o1[2], o1[3]); *(u32x4*)(qp + HALF) = w; } }
    }
};
struct EpiKV {
    bf16_t* k; bf16_t* v; const float* st; const float* khn; const f32x2* rope; const bf16_t* pb; LAS float* tabs;
    __device__ __forceinline__ void operator()(const f32x4 (&acc)[2][2][4][2], const Unit& u, int wr, int wc, int fr, int fq) const {
        asm volatile("" : "+v"(fr), "+v"(fq));
        LAS float* rs_tab = tabs; LAS float* kpe_tab = tabs + 256; LAS float* part = tabs + 512;
        const int rt0 = wr * 64 + fr;
        const int c0 = wc * 32 + 8 * fq;
        const int i0 = 8 * wc + 2 * fq;
        unsigned xas[2][4], xbs[2][4]; f32x4 css[2][4];
#pragma unroll
        for (int ai = 0; ai < 2; ++ai)
#pragma unroll
            for (int m = 0; m < 4; ++m) { const size_t row = (size_t)u.pm * BM + rt0 + ai * HALF + m * 16;
                xas[ai][m] = *(const unsigned*)(pb + row * NPP + PB_KPE + i0); xbs[ai][m] = *(const unsigned*)(pb + row * NPP + PB_KPE + 32 + i0);
                css[ai][m] = *(const f32x4*)(rope + (row & (SEQ - 1)) * 32 + i0); }
        const f32x4 g0 = *(const f32x4*)(khn + c0), g1 = *(const f32x4*)(khn + c0 + 4);
        const float gx0 = khn[128 + i0], gy0 = khn[160 + i0], gx1 = khn[129 + i0], gy1 = khn[161 + i0];
        { const int t = threadIdx.x; if (t < BM) { const size_t r = (size_t)u.pm * BM + t;
            const float s = (st[r] + st[(size_t)NTOK + r]) + (st[(size_t)2 * NTOK + r] + st[(size_t)3 * NTOK + r]);
            const float p = (st[(size_t)12 * NTOK + r] + st[(size_t)13 * NTOK + r]) + (st[(size_t)14 * NTOK + r] + st[(size_t)15 * NTOK + r]);
            rs_tab[t] = 1.0f / sqrtf(s * (1.f / KVL) + EPS); kpe_tab[t] = p; } }
#pragma unroll
        for (int ai = 0; ai < 2; ++ai)
#pragma unroll
            for (int m = 0; m < 4; ++m) { float ss = 0.f;
#pragma unroll
                for (int n = 0; n < 2; ++n) { const f32x4 x = acc[ai][0][m][n]; ss += (x[0] * x[0] + x[1] * x[1]) + (x[2] * x[2] + x[3] * x[3]); }
                ss += __shfl_xor(ss, 16); ss += __shfl_xor(ss, 32);
                if (fq == 0) part[(rt0 + ai * HALF + m * 16) * 4 + wc] = ss; }
        asm volatile("s_waitcnt lgkmcnt(0)" ::: "memory"); __builtin_amdgcn_s_barrier(); asm volatile("" ::: "memory");
#pragma unroll
        for (int ai = 0; ai < 2; ++ai)
#pragma unroll
            for (int m = 0; m < 4; ++m) { const int rt = rt0 + ai * HALF + m * 16; const size_t row = (size_t)u.pm * BM + rt;
                const f32x4 pp = *(const LAS f32x4*)(part + rt * 4); const float rs = rs_tab[rt];
                const float rh = 1.0f / sqrtf((rs * rs * ((pp[0] + pp[1]) + (pp[2] + pp[3])) + kpe_tab[rt]) * (1.f / QKH) + EPS);
                const float r = rs * rh;
                bf16_t* kp = k + row * (NH * QKH) + u.pn * QKH;
                { const f32x4 v0 = acc[ai][0][m][0] * g0 * r, v1 = acc[ai][0][m][1] * g1 * r;
                  u32x4 w; w.x = cvt_pk_bf16(v0[0], v0[1]); w.y = cvt_pk_bf16(v0[2], v0[3]); w.z = cvt_pk_bf16(v1[0], v1[1]); w.w = cvt_pk_bf16(v1[2], v1[3]); *(u32x4*)(kp + c0) = w; }
                { const f32x4 v0 = acc[ai][1][m][0] * rs, v1 = acc[ai][1][m][1] * rs;
                  u32x4 w; w.x = cvt_pk_bf16(v0[0], v0[1]); w.y = cvt_pk_bf16(v0[2], v0[3]); w.z = cvt_pk_bf16(v1[0], v1[1]); w.w = cvt_pk_bf16(v1[2], v1[3]); *(u32x4*)(v + row * (NH * VH) + u.pn * VH + c0) = w; }
                { const unsigned xa = xas[ai][m], xb = xbs[ai][m];
                  const f32x4 cs = css[ai][m];
                  const float x10 = bf_lo(xa) * gx0 * rh, x11 = bf_hi(xa) * gx1 * rh, x20 = bf_lo(xb) * gy0 * rh, x21 = bf_hi(xb) * gy1 * rh;
                  u32x2 w; w.x = cvt_pk_bf16(x10 * cs[0] - x20 * cs[1], x10 * cs[1] + x20 * cs[0]); w.y = cvt_pk_bf16(x11 * cs[2] - x21 * cs[3], x11 * cs[3] + x21 * cs[2]);
                  *(u32x2*)(kp + 128 + 2 * i0) = w; } }
    }
};
struct EpiOut {
    const float* x; float* out; float* ssq;
    __device__ __forceinline__ void operator()(const f32x4 (&acc)[2][2][4][2], const Unit& u, int wr, int wc, int fr, int fq) const {
        asm volatile("" : "+v"(fr), "+v"(fq));
        const int row0 = u.pm * BM + wr * 64 + fr, col0 = u.pn * BM + wc * 32 + 8 * fq;
#pragma unroll
        for (int ai = 0; ai < 2; ++ai) {
            f32x4 xv[4][2][2];
#pragma unroll
            for (int m = 0; m < 4; ++m) { const size_t off = (size_t)(row0 + ai * HALF + m * 16) * DM + col0;
#pragma unroll
                for (int bj = 0; bj < 2; ++bj) { xv[m][bj][0] = __builtin_nontemporal_load((const f32x4*)(x + off + bj * HALF)); xv[m][bj][1] = __builtin_nontemporal_load((const f32x4*)(x + off + bj * HALF + 4)); } }
            asm volatile("" ::: "memory");
#pragma unroll
            for (int m = 0; m < 4; ++m) { const int row = row0 + ai * HALF + m * 16; const size_t off = (size_t)row * DM + col0; float ss = 0.f;
#pragma unroll
                for (int bj = 0; bj < 2; ++bj) { const f32x4 v0 = acc[ai][bj][m][0] + xv[m][bj][0], v1 = acc[ai][bj][m][1] + xv[m][bj][1];
                    *(f32x4*)(out + off + bj * HALF) = v0; *(f32x4*)(out + off + bj * HALF + 4) = v1;
                    ss += (v0[0] * v0[0] + v0[1] * v0[1]) + (v0[2] * v0[2] + v0[3] * v0[3]) + (v1[0] * v1[0] + v1[1] * v1[1]) + (v1[2] * v1[2] + v1[3] * v1[3]); }
                ss += __shfl_xor(ss, 16); ss += __shfl_xor(ss, 32);
                if (fq == 0) ssq[(size_t)(u.pn * 4 + wc) * NTOK + row] = ss; }
        }
    }
};
struct EpiSwiglu {
    unsigned char* act; const float* bgu;
    __device__ __forceinline__ void operator()(const f32x4 (&acc)[2][2][4][2], const Unit& u, int wr, int wc, int fr, int fq, f32x4 (&pre)[4]) const {
        asm volatile("" : "+v"(fr), "+v"(fq));
        const int rt0 = wr * 64 + fr, j0 = wc * 32 + 8 * fq;
        asm volatile("" : "+v"(pre[0]), "+v"(pre[1]), "+v"(pre[2]), "+v"(pre[3]) :: "memory");
        const f32x4 bg0 = pre[0], bg1 = pre[1], bu0 = pre[2], bu1 = pre[3];
        constexpr float WI = 1.f / W8_SCALE;
#pragma unroll
        for (int ai = 0; ai < 2; ++ai)
#pragma unroll
            for (int m = 0; m < 4; ++m) { const int rt = rt0 + ai * HALF + m * 16;
                float o[8];
#pragma unroll
                for (int n = 0; n < 2; ++n) { const f32x4 g4 = acc[ai][0][m][n] * WI + (n ? bg1 : bg0), u4 = acc[ai][1][m][n] * WI + (n ? bu1 : bu0);
#pragma unroll
                    for (int i = 0; i < 4; i += 2) {
                        f32x2 g, uu; g.x = fminf(g4[i], SWI_LIMIT); g.y = fminf(g4[i + 1], SWI_LIMIT);
                        uu.x = __builtin_amdgcn_fmed3f(u4[i], -SWI_LIMIT, SWI_LIMIT); uu.y = __builtin_amdgcn_fmed3f(u4[i + 1], -SWI_LIMIT, SWI_LIMIT);
                        const f32x2 t = g * (-SWI_ALPHA * 1.4426950408889634f);
                        f32x2 e; e.x = __builtin_amdgcn_exp2f(t.x); e.y = __builtin_amdgcn_exp2f(t.y);
                        const f32x2 d = e + 1.f;
                        f32x2 sg; sg.x = __builtin_amdgcn_rcpf(d.x); sg.y = __builtin_amdgcn_rcpf(d.y);
                        const f32x2 r = (uu * ACT8_SCALE + ACT8_SCALE) * (g * sg);
                        o[n * 4 + i] = r.x; o[n * 4 + i + 1] = r.y; } }
                u32x2 w; w.x = pk4_fp8_nc(o[0], o[1], o[2], o[3]); w.y = pk4_fp8_nc(o[4], o[5], o[6], o[7]);
                *(u32x2*)(act + ((size_t)u.pm * BM + rt) * DFF + u.pn * HALF + j0) = w; }
    }
};
struct EpiDown {
    unsigned char* oslot; const float* bdn; unsigned char* dummy; LAS unsigned char* lds;
    __device__ __forceinline__ void operator()(const f32x4 (&acc)[2][2][4][2], const Unit& u, int wr, int wc, int fr, int fq, f32x4 (&pre)[4]) const {
        asm volatile("" : "+v"(fr), "+v"(fq));
        const int rt0 = wr * 64 + fr, col0 = u.pn * BM + wc * 32 + 8 * fq;
        asm volatile("" : "+v"(pre[0]), "+v"(pre[1]), "+v"(pre[2]), "+v"(pre[3]) :: "memory");
        f32x4 bv[2][2]; bv[0][0] = pre[0]; bv[0][1] = pre[1]; bv[1][0] = pre[2]; bv[1][1] = pre[3];
        constexpr float WI = 1.f / (W8_SCALE * ACT8_SCALE);
#pragma unroll
        for (int ai = 0; ai < 2; ++ai)
#pragma unroll
            for (int m = 0; m < 4; ++m) { const int rt = rt0 + ai * HALF + m * 16, p = u.p0 + rt;
                const u32x2 mt = *(const LAS u32x2*)(lds + MoeSched::META_OFF + u.par * 2048 + rt * 8);
                const bool valid = p < u.cnt; const int slot = valid ? (int)mt.x : 0; const unsigned gbits = mt.y; const float g = __builtin_bit_cast(float, gbits);
                unsigned char* rowp = valid ? oslot + (size_t)slot * DM + col0 : dummy + col0;
                const float gs = g * OS8_SCALE;
#pragma unroll
                for (int bj = 0; bj < 2; ++bj) { const f32x4 v0 = (acc[ai][bj][m][0] * WI + bv[bj][0]) * gs, v1 = (acc[ai][bj][m][1] * WI + bv[bj][1]) * gs;
                    u32x2 w; w.x = pk4_fp8(v0[0], v0[1], v0[2], v0[3]); w.y = pk4_fp8(v1[0], v1[1], v1[2], v1[3]);
                    *(u32x2*)(rowp + bj * HALF) = w; } }
    }
};
struct EpiNull {
    float* dummy;
    __device__ __forceinline__ void operator()(const f32x4 (&acc)[2][2][4][2], const Unit& u, int wr, int wc, int fr, int fq, f32x4 (&)[4]) const {
        float sacc = 0.f;
#pragma unroll
        for (int ai = 0; ai < 2; ++ai)
#pragma unroll
            for (int bj = 0; bj < 2; ++bj)
#pragma unroll
                for (int m = 0; m < 4; ++m)
#pragma unroll
                    for (int n = 0; n < 2; ++n) sacc += (acc[ai][bj][m][n][0] + acc[ai][bj][m][n][1]) + (acc[ai][bj][m][n][2] + acc[ai][bj][m][n][3]);
        dummy[(size_t)blockIdx.x * 512 + threadIdx.x] = sacc;
    }
};
}

namespace att {
constexpr int LDQ = NH * QKH, LDK = NH * QKH, LDV = NH * VH, LDO = DM;
constexpr int KT_BYTES = 64 * QKH * 2, VT_BYTES = 64 * VH * 2;
constexpr int L_K = 0, L_V = 3 * KT_BYTES, L_WS = L_V + 3 * VT_BYTES, L_END = L_WS + 8 * 256;
constexpr float THRL = 8.f * 1.4426950408889634f;
__device__ __forceinline__ int crow(int r, int hi) { return (r & 3) + 8 * (r >> 2) + 4 * hi; }
#define SBAR() __builtin_amdgcn_sched_barrier(0)
__device__ __forceinline__ int v_rd_base(int lane) { return ((lane & 3) << 3) | (((lane >> 2) & 3) << 6) | (((lane >> 4) & 1) << 5) | (((lane >> 5) & 1) << 8); }
constexpr int v_rd_off(int d0, int ks, int half) { return d0 * 512 + ks * 4096 + half * 2048; }
template <int OFF> __device__ __forceinline__ s16x4 tr_read(int vb) {
    s16x4 r; asm volatile("ds_read_b64_tr_b16 %0, %1 offset:%2" : "=&v"(r) : "v"(vb), "i"(OFF) : "memory"); return r;
}
template <int D0> __device__ __forceinline__ void pv_one(f32x16& od, int vb, bf16x8 pa0, bf16x8 pa1, bf16x8 pa2, bf16x8 pa3) {
    const s16x4 l0 = tr_read<v_rd_off(D0, 0, 0)>(vb), h0 = tr_read<v_rd_off(D0, 0, 1)>(vb), l1 = tr_read<v_rd_off(D0, 1, 0)>(vb), h1 = tr_read<v_rd_off(D0, 1, 1)>(vb);
    const s16x4 l2 = tr_read<v_rd_off(D0, 2, 0)>(vb), h2 = tr_read<v_rd_off(D0, 2, 1)>(vb), l3 = tr_read<v_rd_off(D0, 3, 0)>(vb), h3 = tr_read<v_rd_off(D0, 3, 1)>(vb);
    asm volatile("s_waitcnt lgkmcnt(0)" ::: "memory"); SBAR();
#define PK(L, H) (bf16x8){L[0], L[1], L[2], L[3], H[0], H[1], H[2], H[3]}
    od = __builtin_amdgcn_mfma_f32_32x32x16_bf16(pa0, PK(l0, h0), od, 0, 0, 0);
    od = __builtin_amdgcn_mfma_f32_32x32x16_bf16(pa1, PK(l1, h1), od, 0, 0, 0);
    od = __builtin_amdgcn_mfma_f32_32x32x16_bf16(pa2, PK(l2, h2), od, 0, 0, 0);
    od = __builtin_amdgcn_mfma_f32_32x32x16_bf16(pa3, PK(l3, h3), od, 0, 0, 0);
#undef PK
}
__device__ __forceinline__ void glds16(const void* gsrc, LAS unsigned char* dst) {
    __builtin_amdgcn_global_load_lds((const unsigned*)gsrc, (LAS unsigned*)dst, 16, 0, 0);
}
__device__ __forceinline__ void attn_unit(int b, int h, int qb, const bf16_t* Q, const bf16_t* Kg, const bf16_t* Vg, bf16_t* O, LAS unsigned char* lds) {
    const int tid = threadIdx.x, wid = __builtin_amdgcn_readfirstlane(tid >> 6), lane = tid & 63, r32 = lane & 31, hi = lane >> 5;
    const int grp = wid >> 2;
    const size_t tok0 = (size_t)b * SEQ;
    bf16x8 qr[12];
    { const bf16_t* Qw = Q + (tok0 + (size_t)qb * 256 + wid * 32 + r32) * LDQ + h * QKH + hi * 8;
#pragma unroll
      for (int d0 = 0; d0 < 12; ++d0) qr[d0] = *(const bf16x8*)(Qw + d0 * 16); }
    unsigned koff[3], voff[2];
#pragma unroll
    for (int i = 0; i < 3; ++i) { const int G = 64 * (wid + 8 * i) + lane, row = G / 24, cgs = G % 24, cg = (cgs & ~7) | ((cgs & 7) ^ ((row >> 1) & 7)); koff[i] = (unsigned)(row * LDK * 2 + cg * 16); }
#pragma unroll
    for (int i = 0; i < 2; ++i) { const int p = wid + 8 * i, sub = 2 * p + (lane >> 5), kkh = sub >> 2, cblk = sub & 3, kkl = (lane & 31) >> 2, cl = (lane & 3) * 8, kk = kkh * 8 + kkl;
        const int k = (kk & ~0xC) | ((kk & 4) << 1) | ((kk & 8) >> 1), c = cblk * 32 + cl; voff[i] = (unsigned)(k * LDV * 2 + c * 2); }
    const __amdgpu_buffer_rsrc_t rK = __builtin_amdgcn_make_buffer_rsrc((void*)(Kg + tok0 * LDK + h * QKH), 0, -1, 0x00020000), rV = __builtin_amdgcn_make_buffer_rsrc((void*)(Vg + tok0 * LDV + h * VH), 0, -1, 0x00020000);
#define ATT_DMA(j, buf) do { \
        _Pragma("unroll") for (int i_ = 0; i_ < 3; ++i_) __builtin_amdgcn_raw_ptr_buffer_load_lds(rK, (LAS void*)(lds + L_K + (buf) * KT_BYTES + (wid + 8 * i_) * 1024), 16, koff[i_], (unsigned)(j) * (64u * LDK * 2u), 0, 0); \
        _Pragma("unroll") for (int i_ = 0; i_ < 2; ++i_) __builtin_amdgcn_raw_ptr_buffer_load_lds(rV, (LAS void*)(lds + L_V + (buf) * VT_BYTES + (wid + 8 * i_) * 1024), 16, voff[i_], (unsigned)(j) * (64u * LDV * 2u), 0, 0); } while (0)
#define ATT_BAR() do { asm volatile("" ::: "memory"); __builtin_amdgcn_s_barrier(); asm volatile("" ::: "memory"); } while (0)
    const int swz = (r32 >> 1) & 7; int kx[4];
#pragma unroll
    for (int dd = 0; dd < 4; ++dd) kx[dd] = r32 * (QKH * 2) + (((2 * dd + hi) ^ swz) << 4);
    LAS float* ws = (LAS float*)(lds + L_WS) + wid * 64; LAS float* li_l = ws; LAS float* al_l = ws + 32;
    const int vb0 = L_V + v_rd_base(lane);
    float m_reg = -1e30f, l_reg = 0.f; f32x16 o[4];
#pragma unroll
    for (int d = 0; d < 4; ++d)
#pragma unroll
        for (int r = 0; r < 16; ++r) o[d][r] = 0.f;
    const int NT = 4 * qb + 4, my_last = 4 * qb + (wid >> 1);
    ATT_DMA(0, 0); ATT_DMA(1, 1);
    asm volatile("s_waitcnt vmcnt(5)" ::: "memory"); ATT_BAR();
    if (grp == 1) ATT_BAR();
    int kb = 0, nb = 2;
    for (int j = 0; j < NT; ++j) {
        const bool live = (j <= my_last), more = (j + 2 < NT);
        f32x16 p0, p1;
        if (grp == 1 && more) ATT_DMA(j + 2, nb);
        if (live) {
            const LAS unsigned char* Ks = lds + L_K + kb * KT_BYTES;
#pragma unroll
            for (int r = 0; r < 16; ++r) { p0[r] = 0.f; p1[r] = 0.f; }
#pragma unroll
            for (int d0 = 0; d0 < 12; ++d0) {
                const bf16x8 b0 = *(const LAS bf16x8*)(Ks + kx[d0 & 3] + (d0 >> 2) * 128);
                const bf16x8 b1 = *(const LAS bf16x8*)(Ks + kx[d0 & 3] + (d0 >> 2) * 128 + 32 * QKH * 2);
                p0 = __builtin_amdgcn_mfma_f32_32x32x16_bf16(b0, qr[d0], p0, 0, 0, 0);
                p1 = __builtin_amdgcn_mfma_f32_32x32x16_bf16(b1, qr[d0], p1, 0, 0, 0);
            }
        }
        if (grp == 1) { if (j + 1 < NT) { if (more) asm volatile("s_waitcnt vmcnt(5)" ::: "memory"); else asm volatile("s_waitcnt vmcnt(0)" ::: "memory"); } }
        ATT_BAR();
        if (grp == 0 && more) ATT_DMA(j + 2, nb);
        if (live) {
            float pmax = p0[0];
#pragma unroll
            for (int r = 1; r < 16; ++r) pmax = fmaxf(pmax, p0[r]);
#pragma unroll
            for (int r = 0; r < 16; ++r) pmax = fmaxf(pmax, p1[r]);
            { auto rr = __builtin_amdgcn_permlane32_swap(__float_as_uint(pmax), __float_as_uint(pmax), false, false);
              pmax = fmaxf(__uint_as_float(rr[0]), __uint_as_float(rr[1])); }
            float mn, alpha;
            if (__builtin_expect(__all(pmax - m_reg <= THRL), 1)) { mn = m_reg; alpha = 1.f; }
            else { mn = fmaxf(m_reg, pmax); alpha = __builtin_amdgcn_exp2f(m_reg - mn); m_reg = mn; }
#pragma unroll
            for (int r = 0; r < 16; ++r) { p0[r] = __builtin_amdgcn_exp2f(p0[r] - mn); p1[r] = __builtin_amdgcn_exp2f(p1[r] - mn); }
            float ps = 0.f;
#pragma unroll
            for (int r = 0; r < 16; ++r) ps += p0[r];
#pragma unroll
            for (int r = 0; r < 16; ++r) ps += p1[r];
            { auto rr = __builtin_amdgcn_permlane32_swap(__float_as_uint(ps), __float_as_uint(ps), false, false);
              ps = __uint_as_float(rr[0]) + __uint_as_float(rr[1]); }
            l_reg = l_reg * alpha + ps;
            if (__any(alpha < 1.f)) { if (hi == 0) al_l[r32] = alpha; asm volatile("s_waitcnt lgkmcnt(0)" ::: "memory");
#pragma unroll
                for (int r = 0; r < 16; ++r) { const float a = al_l[crow(r, hi)];
#pragma unroll
                    for (int d = 0; d < 4; ++d) o[d][r] *= a; } }
            bf16x8 pa0, pa1, pa2, pa3;
#define PK4(P, BASE, OUT) do { unsigned a0 = cvt_pk_bf16(P[BASE + 0], P[BASE + 1]), a1 = cvt_pk_bf16(P[BASE + 2], P[BASE + 3]);   \
    unsigned b0_ = cvt_pk_bf16(P[BASE + 4], P[BASE + 5]), b1_ = cvt_pk_bf16(P[BASE + 6], P[BASE + 7]);                              \
    auto r0 = __builtin_amdgcn_permlane32_swap(a0, b0_, false, false); auto r1 = __builtin_amdgcn_permlane32_swap(a1, b1_, false, false); \
    u32x4 w = {r0[0], r1[0], r0[1], r1[1]}; OUT = __builtin_bit_cast(bf16x8, w); } while (0)
            PK4(p0, 0, pa0); PK4(p0, 8, pa1); PK4(p1, 0, pa2); PK4(p1, 8, pa3);
#undef PK4
            const int vb = vb0 + kb * VT_BYTES;
            pv_one<0>(o[0], vb, pa0, pa1, pa2, pa3); pv_one<1>(o[1], vb, pa0, pa1, pa2, pa3); pv_one<2>(o[2], vb, pa0, pa1, pa2, pa3); pv_one<3>(o[3], vb, pa0, pa1, pa2, pa3);
        }
        if (grp == 0) { if (j + 1 < NT) { if (more) asm volatile("s_waitcnt vmcnt(5)" ::: "memory"); else asm volatile("s_waitcnt vmcnt(0)" ::: "memory"); } }
        ATT_BAR();
        kb = (kb == 2) ? 0 : kb + 1; nb = (nb == 2) ? 0 : nb + 1;
    }
    if (grp == 0) ATT_BAR();
    if (hi == 0) li_l[r32] = l_reg; asm volatile("s_waitcnt lgkmcnt(0)" ::: "memory");
    bf16_t* Ow = O + (tok0 + (size_t)qb * 256 + wid * 32) * LDO + h * VH;
#pragma unroll
    for (int r = 0; r < 16; ++r) { const int orow = crow(r, hi); const float rl = __builtin_amdgcn_rcpf(li_l[orow]);
#pragma unroll
        for (int d0 = 0; d0 < 4; ++d0) Ow[(size_t)orow * LDO + d0 * 32 + r32] = (bf16_t)f2bf(o[d0][r] * rl); }
    asm volatile("s_waitcnt lgkmcnt(0)" ::: "memory"); ATT_BAR();
#undef ATT_DMA
#undef ATT_BAR
}
#undef SBAR
}

#define XB_TMO      128
#define XB_XCNT(j)  (256  + 64 * (j))
#define XB_XSUB(j)  (1280 + 64 * (j))
#define XB_XGEN(j)  (2304 + 64 * (j))
#define XB_TOP      3328
#define XB_TOPGEN   3392
#define XCD_BAR_WORDS 3456
#define XB_SPIN_CAP (1u << 18)
__device__ __forceinline__ unsigned xb_ld(unsigned* p)              { return __hip_atomic_load(p, __ATOMIC_RELAXED, __HIP_MEMORY_SCOPE_AGENT); }
__device__ __forceinline__ unsigned xb_add(unsigned* p, unsigned v) { return __hip_atomic_fetch_add(p, v, __ATOMIC_RELAXED, __HIP_MEMORY_SCOPE_AGENT); }
__device__ __forceinline__ unsigned xb_xcc_id() { return (unsigned)__builtin_amdgcn_s_getreg((3 << 11) | 20) & 0xFu; }
#define XB_SPIN(cond, bar) do { unsigned _sp = 0; while (cond) { __builtin_amdgcn_s_sleep(1); \
    if ((++_sp & 255u) == 0u) { if (xb_ld(&(bar)[XB_TMO])) break; if (_sp > XB_SPIN_CAP) { atomicAdd(&(bar)[XB_TMO], 1u); break; } } } } while (0)
struct XcdBarrier { unsigned* bar; unsigned x; volatile LAS unsigned* st; };
__device__ __forceinline__ XcdBarrier xcd_barrier_post(unsigned* bar, volatile LAS unsigned* st) {
    XcdBarrier b; b.bar = bar; b.x = xb_xcc_id(); b.st = st;
    if (threadIdx.x == 0) (void)xb_add(&bar[XB_XCNT(b.x)], 1u);
    return b;
}
__device__ __forceinline__ void xcd_barrier_complete(unsigned* bar, unsigned x, unsigned& nloc, unsigned& nx) {
    const unsigned G = gridDim.x * gridDim.y * gridDim.z;
    unsigned sum, cnt, mine, sp = 0u;
    for (;;) {
        sum = 0u; cnt = 0u; mine = 0u;
#pragma unroll
        for (unsigned j = 0; j < 16; ++j) { const unsigned c = xb_ld(&bar[XB_XCNT(j)]); sum += c; cnt += (c > 0u) ? 1u : 0u; mine = (j == x) ? c : mine; }
        if (sum == G) break;
        __builtin_amdgcn_s_sleep(1);
        if ((++sp & 255u) == 0u) { if (xb_ld(&bar[XB_TMO])) break; if (sp > XB_SPIN_CAP) { atomicAdd(&bar[XB_TMO], 1u); break; } }
    }
    nloc = mine > 0u ? mine : 1u; nx = cnt > 0u ? cnt : 1u;
}
__device__ __forceinline__ void xcd_barrier(const XcdBarrier& b) {
    asm volatile("s_waitcnt vmcnt(0)" ::: "memory");
    __syncthreads();
    if (threadIdx.x == 0) {
        unsigned* bar = b.bar;
        __builtin_amdgcn_s_waitcnt(0);
        unsigned nloc = b.st[0], nx = b.st[1];
        if (nloc == 0u) { xcd_barrier_complete(bar, b.x, nloc, nx); b.st[0] = nloc; b.st[1] = nx; }
        const unsigned old = xb_add(&bar[XB_XSUB(b.x)], 1u);
        const unsigned gen = old / nloc;
        if (old + 1u == (gen + 1u) * nloc) {
            __builtin_amdgcn_fence(__ATOMIC_RELEASE, "agent");
            asm volatile("s_waitcnt vmcnt(0)" ::: "memory");
            const unsigned og = xb_add(&bar[XB_TOP], 1u);
            const unsigned tg = og / nx;
            if (og + 1u == (tg + 1u) * nx) xb_add(&bar[XB_TOPGEN], 1u);
            else XB_SPIN(xb_ld(&bar[XB_TOPGEN]) == tg, bar);
            __builtin_amdgcn_fence(__ATOMIC_ACQUIRE, "agent");
            xb_add(&bar[XB_XGEN(b.x)], 1u);
            asm volatile("s_waitcnt vmcnt(0)" ::: "memory");
        } else {
            XB_SPIN(xb_ld(&bar[XB_XGEN(b.x)]) == gen, bar);
            __builtin_amdgcn_fence(__ATOMIC_ACQUIRE, "agent");
            asm volatile("s_waitcnt vmcnt(0)" ::: "memory");
        }
    }
    __syncthreads();
}

constexpr int NWAVES = 8;
constexpr int N_LAUNCHES = MK_N_LAUNCHES;
constexpr int N_PHASES = 10;
struct Args { const float* in[18]; float* out; unsigned char* ws; int ph_lo, ph_hi; };

__device__ __forceinline__ void p0_transpose_item(const float* W, int K, int N, bf16_t* WT, int drow0, const float* kscale, LAS unsigned* scr, int k0, int n0, int lane, bool ileave = false) {
    const int g = lane >> 4, l16 = lane & 15;
    f32x4 v[16];
#pragma unroll
    for (int i = 0; i < 16; ++i) { const int kk = (i >> 1) * 8 + g * 2 + (i & 1); v[i] = __builtin_nontemporal_load((const f32x4*)(W + (size_t)(k0 + kk) * N + n0 + 4 * l16)); }
    if (kscale) {
#pragma unroll
        for (int i = 0; i < 16; ++i) { const int kk = (i >> 1) * 8 + g * 2 + (i & 1); v[i] = v[i] * kscale[k0 + kk]; } }
#pragma unroll
    for (int j = 0; j < 8; ++j) { const int kp = j * 4 + g;
#pragma unroll
        for (int c = 0; c < 4; ++c) scr[(4 * l16 + c) * 33 + kp] = cvt_pk_bf16(v[2 * j][c], v[2 * j + 1][c]); }
    LDS_WAIT(); asm volatile("" ::: "memory");
    const int c8 = lane & 7;
#pragma unroll
    for (int jj = 0; jj < 8; ++jj) { const int n = jj * 8 + (lane >> 3); const LAS unsigned* t = scr + n * 33 + 4 * c8;
        u32x4 o; o.x = t[0]; o.y = t[1]; o.z = t[2]; o.w = t[3];
        const int dn = ileave ? ((n < 32) ? 2 * n : 2 * (n - 32) + 1) : n;
        *(u32x4*)(WT + (size_t)(drow0 + dn) * K + k0 + 8 * c8) = o; }
    LDS_WAIT(); asm volatile("" ::: "memory");
}

__device__ __forceinline__ void p0_transpose_item8(const float* W, int K, int N, unsigned char* WT, int drow0, const float* kscale, LAS unsigned* scr, int k0, int n0, int lane) {
    const int g = lane >> 4, l16 = lane & 15;
    f32x4 v[32];
#pragma unroll
    for (int i = 0; i < 32; ++i) { const int kk = (i >> 2) * 16 + g * 4 + (i & 3); v[i] = __builtin_nontemporal_load((const f32x4*)(W + (size_t)(k0 + kk) * N + n0 + 4 * l16)); }
#pragma unroll
    for (int i = 0; i < 32; ++i) { const int kk = (i >> 2) * 16 + g * 4 + (i & 3); v[i] = v[i] * (kscale ? kscale[k0 + kk] * W8_SCALE : W8_SCALE); }
#pragma unroll
    for (int j = 0; j < 8; ++j) { const int kd = j * 4 + g;
#pragma unroll
        for (int c = 0; c < 4; ++c) scr[(4 * l16 + c) * 33 + kd] = pk4_fp8(v[4 * j][c], v[4 * j + 1][c], v[4 * j + 2][c], v[4 * j + 3][c]); }
    LDS_WAIT(); asm volatile("" ::: "memory");
    const int c8 = lane & 7;
#pragma unroll
    for (int jj = 0; jj < 8; ++jj) { const int n = jj * 8 + (lane >> 3); const LAS unsigned* t = scr + n * 33 + 4 * c8;
        u32x4 o; o.x = t[0]; o.y = t[1]; o.z = t[2]; o.w = t[3];
        *(u32x4*)(WT + (size_t)(drow0 + n) * K + k0 + 16 * c8) = o; }
    LDS_WAIT(); asm volatile("" ::: "memory");
}

template <int PHMASK> __global__ void __launch_bounds__(NWAVES * 64, 2) fwd_kernel_t(Args args) {
    extern __shared__ __attribute__((aligned(16))) unsigned char lds_raw[];
    LAS unsigned char* lds = (LAS unsigned char*)lds_raw;
    volatile LAS unsigned* MISC = (volatile LAS unsigned*)(lds + MISC_OFF);
    const int tid = threadIdx.x, lane = tid & 63, wave = __builtin_amdgcn_readfirstlane(tid >> 6);
    const int G = gridDim.x; const int bx = blockIdx.x; const int vcu = (G % 8 == 0) ? (bx % 8) * (G / 8) + bx / 8 : bx;
    unsigned char* ws = args.ws;
    unsigned* ctl = (unsigned*)(ws + WS_CTL);
    const float* x = args.in[0]; const float* norm_mix = args.in[1]; const float* w_in = args.in[2]; const float* conv_w = args.in[3];
    const float* q_norm = args.in[4]; const float* w_uq = args.in[5]; const float* kv_norm = args.in[6]; const float* w_ukv = args.in[7];
    const float* q_head_norm = args.in[8]; const float* k_head_norm = args.in[9]; const float* w_o = args.in[10]; const float* norm_ffn = args.in[11];
    const float* w_router = args.in[12]; const float* b_router = args.in[13]; const float* w_gate_up = args.in[14]; const float* b_gate_up = args.in[15];
    const float* w_down = args.in[16]; const float* b_down = args.in[17];
    float* out = args.out;
    f32x2* rope_t = (f32x2*)(ws + WS_ROPE);
    bf16_t* WrH = (bf16_t*)(ws + WS_WRH); bf16_t* WrL = (bf16_t*)(ws + WS_WRL);
    bf16_t* Win_t = (bf16_t*)(ws + WS_WIN); bf16_t* Wuq_t = (bf16_t*)(ws + WS_WUQ); bf16_t* Wukv_t = (bf16_t*)(ws + WS_WUKV); bf16_t* Wo_t = (bf16_t*)(ws + WS_WO);
    float* ssq = (float*)(ws + WS_SSQ); float* rs2 = (float*)(ws + WS_RS2); float* gate = (float*)(ws + WS_GATE); int* tos = (int*)(ws + WS_TOS);
    unsigned char* Wgu_t = ws + WS_WGU; unsigned char* Wdn_t = ws + WS_WDN;
    unsigned char* hq = ws + WS_HB;
    bf16_t* qb_ = (bf16_t*)(ws + WS_Q); bf16_t* kb_ = (bf16_t*)(ws + WS_K); bf16_t* vb_ = (bf16_t*)(ws + WS_V); bf16_t* mix = (bf16_t*)(ws + WS_MIX);
    bf16_t* oslot = (bf16_t*)(ws + WS_OSLOT); bf16_t* hn = (bf16_t*)(ws + WS_HN); bf16_t* pbuf = (bf16_t*)(ws + WS_PB); bf16_t* qraw = (bf16_t*)(ws + WS_QRAW); bf16_t* kvraw = (bf16_t*)(ws + WS_KVRAW);
    unsigned char* act = ws + WS_ACT;

    for (int u = tid; u < (LDS_BYTES - MISC_OFF) / 4; u += NWAVES * 64) ((LAS unsigned*)(lds + MISC_OFF))[u] = 0u;
    __syncthreads();
    XcdBarrier bar; bar.bar = ctl + CW_BAR; bar.x = 0; bar.st = nullptr;
    if (N_LAUNCHES == 1) bar = xcd_barrier_post(ctl + CW_BAR, MISC + 8);
#define GRID_BAR() do { if (N_LAUNCHES == 1) xcd_barrier(bar); } while (0)
    const int lo = args.ph_lo, hi = args.ph_hi;
#define IN(k) (((PHMASK >> (k)) & 1) && lo <= (k) && (k) < hi)
#define BOTH(k) (IN(k) && IN((k) + 1))
    const int gw = vcu * NWAVES + wave, NGW = G * NWAVES;

    if (IN(0)) {
        LAS unsigned* scr = (LAS unsigned*)(lds + wave * 16384);
        constexpr int I_IN = (DM / 64) * (NPROJ / 64), I_UQ = (QL / 64) * (768 / 64), I_UKV = (KVL / 64) * (1024 / 64), I_O = (DM / 64) * (DM / 64);
        constexpr int I_GU1 = (DM / 128) * (2 * DFF / 64), I_GU = NE * I_GU1, I_DN1 = (DFF / 128) * (DM / 64), I_DN = NE * I_DN1;
        constexpr int NITEMS = I_IN + I_UQ + I_UKV + I_O + I_GU + I_DN;
        for (int it = gw; it < NITEMS; it += NGW) {
            int r = it;
            if (r < I_GU) { const int e = r / I_GU1, q = r % I_GU1, nblk = 2 * DFF / 64, kb = q / nblk, nb = q % nblk, n0 = nb * 64, j = n0 & (DFF - 1), up = n0 >= DFF;
                p0_transpose_item8(w_gate_up + (size_t)e * DM * 2 * DFF, DM, 2 * DFF, Wgu_t + (size_t)e * 2 * DFF * DM, (j >> 7) * 256 + (j & 127) + (up ? 128 : 0), norm_ffn, scr, kb * 128, n0, lane); continue; } r -= I_GU;
            if (r < I_DN) { const int e = r / I_DN1, q = r % I_DN1, nblk = DM / 64, kb = q / nblk, nb = q % nblk;
                p0_transpose_item8(w_down + (size_t)e * DFF * DM, DFF, DM, Wdn_t + (size_t)e * DM * DFF, nb * 64, nullptr, scr, kb * 128, nb * 64, lane); continue; } r -= I_DN;
            if (r < I_IN) { const int nblk = NPROJ / 64, kb = r / nblk, nb = r % nblk, n0 = nb * 64;
                const int d0 = (n0 < 1536) ? n0 : (n0 < 1920 ? n0 + (PB_CQ - 1536) : (n0 < 2176 ? n0 - (1920 - PB_CKV) : n0));
                p0_transpose_item(w_in, DM, NPROJ, Win_t, d0, nullptr, scr, kb * 64, n0, lane); continue; } r -= I_IN;
            if (r < I_UQ) { const int nblk = 768 / 64, kb = r / nblk, nb = r % nblk, h = nb / 3, part = nb % 3;
                p0_transpose_item(w_uq, QL, 768, Wuq_t, h * 256 + part * 64, q_norm, scr, kb * 64, nb * 64, lane, part == 2); continue; } r -= I_UQ;
            if (r < I_UKV) { const int nblk = 1024 / 64, kb = r / nblk, nb = r % nblk; p0_transpose_item(w_ukv, KVL, 1024, Wukv_t, nb * 64, kv_norm, scr, kb * 64, nb * 64, lane); continue; } r -= I_UKV;
            { const int nblk = DM / 64, kb = r / nblk, nb = r % nblk; p0_transpose_item(w_o, DM, DM, Wo_t, nb * 64, nullptr, scr, kb * 64, nb * 64, lane); }
        }
        const int gt = vcu * (NWAVES * 64) + tid, NGT = G * NWAVES * 64;
        for (int i = gt; i < (NPP - NPROJ) * DM / 8; i += NGT) *(u32x4*)(Win_t + (size_t)NPROJ * DM + (size_t)i * 8) = (u32x4){0u, 0u, 0u, 0u};
        for (int i = gt; i < NH * 64 * QL / 8; i += NGT) { const int h = i / (64 * QL / 8), j = i % (64 * QL / 8); *(u32x4*)(Wuq_t + (size_t)(h * 256 + 192) * QL + (size_t)j * 8) = (u32x4){0u, 0u, 0u, 0u}; }
        for (int i = gt; i < NE * DM; i += NGT) { const int e = i / DM, k = i % DM; const float v = w_router[(size_t)k * NE + e] * norm_ffn[k]; const unsigned h = f2bf(v); const float hf = __builtin_bit_cast(float, h << 16);
            WrH[i] = (bf16_t)h; WrL[i] = (bf16_t)f2bf(v - hf); }
        for (int i = gt; i < SEQ * 32; i += NGT) { const int pos = i >> 5, fi = i & 31; const float inv = exp2f(-(float)fi * (13.287712379549449f / 32.f)); const float ang = (float)pos * inv; float s, c; sincosf(ang, &s, &c); rope_t[i] = (f32x2){c, s}; }
        for (int m = 2 * gw; m < NTOK; m += 2 * NGW) {
            const f32x4* xr = (const f32x4*)(x + (size_t)m * DM) + lane; const f32x4* gr = (const f32x4*)norm_mix + lane;
            f32x4 v[2][4]; float s0 = 0.f, s1 = 0.f;
#pragma unroll
            for (int j = 0; j < 4; ++j) { v[0][j] = __builtin_nontemporal_load(xr + 64 * j); v[1][j] = __builtin_nontemporal_load(xr + DM / 4 + 64 * j); }
#pragma unroll
            for (int j = 0; j < 4; ++j) { s0 += (v[0][j].x * v[0][j].x + v[0][j].y * v[0][j].y) + (v[0][j].z * v[0][j].z + v[0][j].w * v[0][j].w);
                                          s1 += (v[1][j].x * v[1][j].x + v[1][j].y * v[1][j].y) + (v[1][j].z * v[1][j].z + v[1][j].w * v[1][j].w); }
            const float r0 = 1.0f / sqrtf(wave_sum(s0) * (1.f / DM) + EPS), r1 = 1.0f / sqrtf(wave_sum(s1) * (1.f / DM) + EPS);
            u32x2* o8 = (u32x2*)(hn + (size_t)m * DM) + lane;
#pragma unroll
            for (int j = 0; j < 4; ++j) { const f32x4 g = gr[64 * j]; u32x2 w;
                w.x = cvt_pk_bf16(v[0][j].x * r0 * g.x, v[0][j].y * r0 * g.y); w.y = cvt_pk_bf16(v[0][j].z * r0 * g.z, v[0][j].w * r0 * g.w); o8[64 * j] = w;
                w.x = cvt_pk_bf16(v[1][j].x * r1 * g.x, v[1][j].y * r1 * g.y); w.y = cvt_pk_bf16(v[1][j].z * r1 * g.z, v[1][j].w * r1 * g.w); o8[DM / 4 + 64 * j] = w; }
        }
        if (BOTH(0)) GRID_BAR();
    }

    if (IN(1)) {
        pg8::DenseSched S; S.init(hn, DM, Win_t, NTOK, NPP, DM, G, bx);
        pg8::EpiProj E{pbuf, ssq};
        pg8::gemm_phase<pg8::EpiProj, pg8::DenseSched, false>(lds, S, E);
        if (BOTH(1)) GRID_BAR();
    }

    const bool p2_all = IN(2);
    if (p2_all || IN(13)) {
        {
            const int gt = vcu * (NWAVES * 64) + tid, NGT = G * NWAVES * 64;
            for (int it = gt; it < (NTOK / 16) * 64; it += NGT) {
                const int run = it >> 6, gr = it & 63, t0 = run * 16, ch = gr * 8;
                float w0[8], w1[8], w2[8];
#pragma unroll
                for (int i = 0; i < 8; ++i) { w0[i] = conv_w[ch + i]; w1[i] = conv_w[CONVW + ch + i]; w2[i] = conv_w[2 * CONVW + ch + i]; }
                float um2[8], um1[8];
#pragma unroll
                for (int i = 0; i < 8; ++i) { um2[i] = 0.f; um1[i] = 0.f; }
                if ((t0 & (SEQ - 1)) != 0) {
                    float c8[8], x8[8];
                    unpack8(*(const u32x4*)(pbuf + (size_t)(t0 - 2) * NPP + PB_C + ch), c8); unpack8(*(const u32x4*)(pbuf + (size_t)(t0 - 2) * NPP + PB_X + ch), x8);
#pragma unroll
                    for (int i = 0; i < 8; ++i) um2[i] = c8[i] * x8[i];
                    unpack8(*(const u32x4*)(pbuf + (size_t)(t0 - 1) * NPP + PB_C + ch), c8); unpack8(*(const u32x4*)(pbuf + (size_t)(t0 - 1) * NPP + PB_X + ch), x8);
#pragma unroll
                    for (int i = 0; i < 8; ++i) um1[i] = c8[i] * x8[i];
                }
#pragma unroll 4
                for (int t = 0; t < 16; ++t) {
                    const bf16_t* pr = pbuf + (size_t)(t0 + t) * NPP + ch;
                    float b8[8], c8[8], x8[8], o8[8];
                    unpack8(__builtin_nontemporal_load((const u32x4*)(pr + PB_B)), b8); unpack8(__builtin_nontemporal_load((const u32x4*)(pr + PB_C)), c8); unpack8(__builtin_nontemporal_load((const u32x4*)(pr + PB_X)), x8);
#pragma unroll
                    for (int i = 0; i < 8; ++i) { const float uu = c8[i] * x8[i]; o8[i] = b8[i] * (w0[i] * um2[i] + w1[i] * um1[i] + w2[i] * uu); um2[i] = um1[i]; um1[i] = uu; }
                    *(u32x4*)(mix + (size_t)(t0 + t) * DM + ch) = pack8(o8);
                }
            }
        }
    }
    if (p2_all || IN(14) || IN(15)) {
        LAS float* etab = (LAS float*)(lds + EPI_TAB_OFF);
        if (p2_all || IN(14)) { pg8::DenseSched S; S.init(pbuf + PB_CQ, NPP, Wuq_t, NTOK, NQP, QL, G, bx); pg8::EpiQ E{qb_, ssq, q_head_norm, rope_t, etab};
          pg8::gemm_phase<pg8::EpiQ, pg8::DenseSched, false>(lds, S, E); }
        if (p2_all || IN(15)) { pg8::DenseSched S; S.init(pbuf + PB_CKV, NPP, Wukv_t, NTOK, 1024, KVL, G, bx); pg8::EpiKV E{kb_, vb_, ssq, k_head_norm, rope_t, pbuf, etab};
          pg8::gemm_phase<pg8::EpiKV, pg8::DenseSched, false>(lds, S, E); }
        if (BOTH(2)) GRID_BAR();
    }


    if (IN(4)) {
        for (int u = vcu; u < NB * NH * 4; u += G) {
            const int bh = u >> 2, pr = u & 3, b = bh >> 2, h = bh & 3;
            att::attn_unit(b, h, 7 - pr, qb_, kb_, vb_, mix + CONVW, lds);
            att::attn_unit(b, h, pr, qb_, kb_, vb_, mix + CONVW, lds);
        }
        if (BOTH(4)) GRID_BAR();
    }

    if (IN(5)) {
        pg8::DenseSched S; S.init(mix, DM, Wo_t, NTOK, DM, DM, G, bx);
        pg8::EpiOut E{x, out, ssq};
        pg8::gemm_phase<pg8::EpiOut, pg8::DenseSched, false>(lds, S, E);
        if (BOTH(5)) GRID_BAR();
    }

    if (IN(6) || IN(16)) {
        const bool dry = !IN(6);
        LAS unsigned* hist = (LAS unsigned*)(lds + MISC_OFF) + 128; LAS unsigned* base = (LAS unsigned*)(lds + MISC_OFF) + 160;
        const int tj = lane & 15, q = lane >> 4;
        for (int i = tid; i < 2 * NE * 128; i += NWAVES * 64) { const int sel = i >> 12, r = (i >> 7) & 31, g = i & 127;
            const u32x4 v = *(const u32x4*)((sel ? WrL : WrH) + (size_t)r * DM + g * 8);
            *(LAS u32x4*)(lds + sel * 65536 + r * 2048 + ((g ^ (r & 15)) << 4)) = v; }
        __syncthreads();
        for (int tile = vcu; tile < NTOK / 128; tile += G) {
            if (tid < 32) hist[tid] = 0u;
            __syncthreads();
            const int token = tile * 128 + wave * 16 + tj;
            const float* hrow = out + (size_t)token * DM + q * 8;
            f32x4 a0 = {0.f, 0.f, 0.f, 0.f}, a1 = {0.f, 0.f, 0.f, 0.f};
            float s2 = 0.f;
#pragma unroll
            for (int p = 0; p < 16; ++p) s2 += ssq[(size_t)p * NTOK + token];
            const float rs = 1.0f / sqrtf(s2 * (1.f / DM) + EPS);
            unsigned char* hqrow = hq + (size_t)token * DM + q * 8;
            const LAS unsigned char* wlds = lds + tj * 2048;
#pragma unroll 1
            for (int kh = 0; kh < 2; ++kh) {
                f32x4 hv[16][2];
#pragma unroll
                for (int kk = 0; kk < 16; ++kk) { hv[kk][0] = *(const f32x4*)(hrow + (kh * 16 + kk) * 32); hv[kk][1] = *(const f32x4*)(hrow + (kh * 16 + kk) * 32 + 4); }
#pragma unroll
                for (int kk = 0; kk < 16; ++kk) { const int ks = kh * 16 + kk;
                    const f32x4 h0 = hv[kk][0], h1 = hv[kk][1];
                    float hf[8] = {h0[0], h0[1], h0[2], h0[3], h1[0], h1[1], h1[2], h1[3]}; float lf[8];
                    { u32x2 w8; w8.x = pk4_fp8(hf[0] * rs, hf[1] * rs, hf[2] * rs, hf[3] * rs); w8.y = pk4_fp8(hf[4] * rs, hf[5] * rs, hf[6] * rs, hf[7] * rs); *(u32x2*)(hqrow + ks * 32) = w8; }
                    u32x4 hw; hw.x = pk2(hf[0], hf[1]); hw.y = pk2(hf[2], hf[3]); hw.z = pk2(hf[4], hf[5]); hw.w = pk2(hf[6], hf[7]);
                    { float hb8[8]; unpack8(hw, hb8);
#pragma unroll
                      for (int i = 0; i < 8; ++i) lf[i] = hf[i] - hb8[i]; }
                    const bf16x8 bh = __builtin_bit_cast(bf16x8, hw), bl = __builtin_bit_cast(bf16x8, pack8(lf));
                    const int go = (((ks * 4 + q) ^ tj) << 4);
                    const bf16x8 wh_a = *(const LAS bf16x8*)(wlds + go), wh_b = *(const LAS bf16x8*)(wlds + 16 * 2048 + go);
                    const bf16x8 wl_a = *(const LAS bf16x8*)(wlds + 65536 + go), wl_b = *(const LAS bf16x8*)(wlds + 65536 + 16 * 2048 + go);
                    a0 = __builtin_amdgcn_mfma_f32_16x16x32_bf16(wh_a, bh, a0, 0, 0, 0); a0 = __builtin_amdgcn_mfma_f32_16x16x32_bf16(wl_a, bh, a0, 0, 0, 0); a0 = __builtin_amdgcn_mfma_f32_16x16x32_bf16(wh_a, bl, a0, 0, 0, 0);
                    a1 = __builtin_amdgcn_mfma_f32_16x16x32_bf16(wh_b, bh, a1, 0, 0, 0); a1 = __builtin_amdgcn_mfma_f32_16x16x32_bf16(wl_b, bh, a1, 0, 0, 0); a1 = __builtin_amdgcn_mfma_f32_16x16x32_bf16(wh_b, bl, a1, 0, 0, 0);
                }
            }
            float lv[8]; int le[8];
#pragma unroll
            for (int i = 0; i < 4; ++i) { le[i] = 4 * q + i; le[4 + i] = 16 + 4 * q + i; lv[i] = a0[i] * rs + b_router[le[i]]; lv[4 + i] = a1[i] * rs + b_router[le[4 + i]]; }
            float tv[4]; int te[4];
#pragma unroll
            for (int k = 0; k < TOPK; ++k) {
                float bv = lv[0]; int be = le[0];
#pragma unroll
                for (int i = 1; i < 8; ++i) if (lv[i] > bv) { bv = lv[i]; be = le[i]; }
#pragma unroll
                for (int o = 16; o < 64; o <<= 1) { const float ov = __shfl_xor(bv, o); const int oe = __shfl_xor(be, o); if (ov > bv || (ov == bv && oe < be)) { bv = ov; be = oe; } }
                tv[k] = bv; te[k] = be;
#pragma unroll
                for (int i = 0; i < 8; ++i) if (le[i] == be) lv[i] = -3.0e38f;
            }
            float ge[4]; float gs = 0.f;
#pragma unroll
            for (int k = 0; k < TOPK; ++k) { ge[k] = __expf(tv[k] - tv[0]); gs += ge[k]; }
            const float ginv = 1.0f / gs;
            int my_e = te[0]; float my_g = ge[0];
#pragma unroll
            for (int k = 1; k < TOPK; ++k) if (q == k) { my_e = te[k]; my_g = ge[k]; }
            my_g *= ginv;
            const unsigned pl = atomicAdd((unsigned*)(hist + my_e), 1u);
            __syncthreads();
            if (tid < 32) base[tid] = dry ? 0u : __hip_atomic_fetch_add(ctl + CW_CNT + 64 * tid, hist[tid], __ATOMIC_RELAXED, __HIP_MEMORY_SCOPE_AGENT);
            __syncthreads();
            const unsigned pos = base[my_e] + pl; const int slot = token * 4 + q;
            if (!dry) *(u32x2*)(tos + ((size_t)my_e * CAP + pos) * 2) = (u32x2){(unsigned)slot, __builtin_bit_cast(unsigned, my_g)};
            else if (my_g < -1.f) rs2[token] = my_g;
            __syncthreads();
        }
        if (BOTH(6)) GRID_BAR();
    }

    LAS int* tab = (LAS int*)(lds + MISC_OFF) + 16;
    if (IN(7) || IN(8) || IN(10) || IN(11) || IN(12)) {
        if (tid < 32) { const int c = (int)__hip_atomic_load(ctl + CW_CNT + 64 * tid, __ATOMIC_RELAXED, __HIP_MEMORY_SCOPE_AGENT); tab[48 + tid] = c; }
        __syncthreads();
        if (tid == 0) { int s = 0; for (int e = 0; e < NE; ++e) { tab[e] = s; s += (tab[48 + e] + 255) >> 8; } tab[32] = s; }
        __syncthreads();
        for (int t = tid; t < tab[32]; t += NWAVES * 64) { int e = 0; while (e < NE - 1 && tab[e + 1] <= t) ++e; tab[2288 + t] = e; }
        __syncthreads();
    }

    if (IN(7)) {
        pg8::MoeSched S{hq, Wgu_t, DM, DM, 2 * DFF / 256, G, bx, (size_t)2 * DFF * DM, tab, tos, b_gate_up};
        pg8::EpiSwiglu E{act, b_gate_up};
        pg8::gemm_phase<pg8::EpiSwiglu, pg8::MoeSched, true>(lds, S, E);
        if (BOTH(7)) GRID_BAR();
    }

    if (IN(8)) {
        pg8::MoeSched S{act, Wdn_t, DFF, DFF, DM / 256, G, bx, (size_t)DM * DFF, tab, tos, b_down};
        pg8::EpiDown E{(unsigned char*)oslot, b_down, ws + WS_SSQ, lds};
        pg8::gemm_phase<pg8::EpiDown, pg8::MoeSched, false>(lds, S, E);
        if (BOTH(8)) GRID_BAR();
    }

#if PROBE_DOUBLE
    if (IN(10)) { pg8::MoeSched S{hq, Wgu_t, DM, DM, 2 * DFF / 256, G, bx, (size_t)2 * DFF * DM, tab, tos, b_gate_up}; pg8::EpiNull E{(float*)(ws + WS_SSQ)};
        pg8::gemm_phase<pg8::EpiNull, pg8::MoeSched, true>(lds, S, E); }
    if (IN(11)) { pg8::MoeSched S{act, Wdn_t, DFF, DFF, DM / 256, G, bx, (size_t)DM * DFF, tab, tos, b_down}; pg8::EpiNull E{(float*)(ws + WS_SSQ)};
        pg8::gemm_phase<pg8::EpiNull, pg8::MoeSched, false, 2>(lds, S, E); }
    if (IN(12)) { pg8::MoeSched S{act, Wdn_t, DFF, DFF, DM / 256, G, bx, (size_t)DM * DFF, tab, tos, b_down}; pg8::EpiNull E{(float*)(ws + WS_SSQ)};
        pg8::gemm_phase<pg8::EpiNull, pg8::MoeSched, false>(lds, S, E); }
#endif
    if (IN(9)) {
        const unsigned char* os8 = (const unsigned char*)oslot;
        constexpr float OI = 1.f / OS8_SCALE;
        for (int m = gw; m < NTOK; m += NGW) {
            f32x4* orow = (f32x4*)(out + (size_t)m * DM) + lane;
            const unsigned* s0 = (const unsigned*)(os8 + (size_t)m * 4 * DM) + lane;
            unsigned w[4][4]; f32x4 hv[4];
#pragma unroll
            for (int j = 0; j < 4; ++j) { hv[j] = __builtin_nontemporal_load(orow + 64 * j);
#pragma unroll
                for (int k = 0; k < 4; ++k) w[j][k] = __builtin_nontemporal_load(s0 + (size_t)k * (DM / 4) + 64 * j); }
#pragma unroll
            for (int j = 0; j < 4; ++j) { f32x4 a = {0.f, 0.f, 0.f, 0.f};
#pragma unroll
                for (int k = 0; k < 4; ++k) { const f32x2 lo = __builtin_amdgcn_cvt_pk_f32_fp8(w[j][k], false), hi2 = __builtin_amdgcn_cvt_pk_f32_fp8(w[j][k], true); a.x += lo.x; a.y += lo.y; a.z += hi2.x; a.w += hi2.y; }
                __builtin_nontemporal_store(hv[j] + a * OI, orow + 64 * j); }
        }
    }
#undef IN
#undef BOTH
#undef GRID_BAR
}

#ifdef DIAG_PHASES
template __global__ void fwd_kernel_t<1>(Args); template __global__ void fwd_kernel_t<2>(Args); template __global__ void fwd_kernel_t<4>(Args); template __global__ void fwd_kernel_t<8>(Args);
template __global__ void fwd_kernel_t<16>(Args); template __global__ void fwd_kernel_t<32>(Args); template __global__ void fwd_kernel_t<64>(Args); template __global__ void fwd_kernel_t<128>(Args);
template __global__ void fwd_kernel_t<256>(Args); template __global__ void fwd_kernel_t<512>(Args);
#endif
#define fwd_kernel fwd_kernel_t<(PROBE_DOUBLE ? 0x1ffff : 1023)>
extern "C" void kernel_launch(void* const* d_in, const int* in_sizes, int n_in, void* d_out, int out_size, void* d_ws, size_t ws_size, hipStream_t stream) {
    static int grid = 0;
    if (grid == 0) {
        if (n_in != 18 || in_sizes[0] != NTOK * DM || out_size != NTOK * DM || ws_size < WS_END) { fprintf(stderr, "kernel_launch: shape/workspace mismatch (n_in %d, in0 %d, out %d, ws %zu, need %zu)\n", n_in, n_in > 0 ? in_sizes[0] : -1, out_size, ws_size, (size_t)WS_END); grid = -1; return; }
        int dev = 0, cus = 0, per_cu = 0;
        if (hipGetDevice(&dev) != hipSuccess || hipDeviceGetAttribute(&cus, hipDeviceAttributeMultiprocessorCount, dev) != hipSuccess) { grid = -1; return; }
        if (hipFuncSetAttribute((const void*)fwd_kernel, hipFuncAttributeMaxDynamicSharedMemorySize, LDS_BYTES) != hipSuccess) { fprintf(stderr, "kernel_launch: hipFuncSetAttribute failed\n"); grid = -1; return; }
        if (hipOccupancyMaxActiveBlocksPerMultiprocessor(&per_cu, (const void*)fwd_kernel, NWAVES * 64, LDS_BYTES) != hipSuccess || per_cu < 1) { fprintf(stderr, "kernel_launch: occupancy query says %d\n", per_cu); }
        (void)hipGetLastError();
        grid = cus;
    }
    if (grid < 0) return;
    if (hipMemsetAsync((char*)d_ws + WS_CTL, 0, CTL_ZERO_BYTES, stream) != hipSuccess) return;
    Args a{};
    for (int i = 0; i < 18; ++i) a.in[i] = (const float*)d_in[i];
    a.out = (float*)d_out; a.ws = (unsigned char*)d_ws;
    if (N_LAUNCHES == 1) { a.ph_lo = 0; a.ph_hi = N_PHASES; hipLaunchKernelGGL(fwd_kernel, dim3(grid), dim3(NWAVES * 64), LDS_BYTES, stream, a); }
    else { for (int p = 0; p < N_PHASES; ++p) { a.ph_lo = p; a.ph_hi = p + 1; const int reps = ((PROBE_DOUBLE >> p) & 1) ? 2 : 1;
            for (int r = 0; r < reps; ++r) hipLaunchKernelGGL(fwd_kernel, dim3(grid), dim3(NWAVES * 64), LDS_BYTES, stream, a);
            if (p == 8) for (int pp = 10; pp < 13; ++pp) if ((PROBE_DOUBLE >> pp) & 1) { a.ph_lo = pp; a.ph_hi = pp + 1; hipLaunchKernelGGL(fwd_kernel, dim3(grid), dim3(NWAVES * 64), LDS_BYTES, stream, a); }
            if (p == 6 && ((PROBE_DOUBLE >> 16) & 1)) { a.ph_lo = 16; a.ph_hi = 17; hipLaunchKernelGGL(fwd_kernel, dim3(grid), dim3(NWAVES * 64), LDS_BYTES, stream, a); }
            if (p == 2) for (int pp = 13; pp < 16; ++pp) if ((PROBE_DOUBLE >> pp) & 1) { a.ph_lo = pp; a.ph_hi = pp + 1; hipLaunchKernelGGL(fwd_kernel, dim3(grid), dim3(NWAVES * 64), LDS_BYTES, stream, a); } } }
}
```

```cpp
#include <hip/hip_runtime.h>
#include <cstdio>
#include <cstdint>

#ifndef MK_N_LAUNCHES
#define MK_N_LAUNCHES 1
#endif

#ifndef PROBE_DOUBLE
#define PROBE_DOUBLE 0
#endif
#define LAS __attribute__((address_space(3)))
#define GAS __attribute__((address_space(1)))
typedef unsigned short bf16_t;
typedef short bf16x8 __attribute__((ext_vector_type(8)));
typedef short s16x4 __attribute__((ext_vector_type(4)));
typedef float f32x2 __attribute__((ext_vector_type(2)));
typedef float f32x4 __attribute__((ext_vector_type(4)));
typedef float f32x16 __attribute__((ext_vector_type(16)));
typedef unsigned u32x2 __attribute__((ext_vector_type(2)));
typedef unsigned u32x4 __attribute__((ext_vector_type(4)));
typedef int v4i_t __attribute__((ext_vector_type(4)));
typedef int v8i_t __attribute__((ext_vector_type(8)));

constexpr int NB = 16, SEQ = 2048, NTOK = NB * SEQ, DM = 1024;
constexpr int CONVW = 512, QL = 384, KVL = 256, ROPE = 64, NH = 4, QKN = 128, QKH = 192, VH = 128;
constexpr int NPROJ = 2240, NPP = 2304;
constexpr int PB_B = 0, PB_C = 512, PB_X = 1024, PB_CKV = 1536, PB_CQ = 1792, PB_KPE = 2176;
constexpr int NQP = 1024;
constexpr int NE = 32, TOPK = 4, DFF = 1024, NSLOT = NTOK * TOPK;
constexpr int CAP = NTOK;
constexpr int MAXTILES = NSLOT / 256 + NE;
constexpr float EPS = 1e-6f;
constexpr float QSCALE = 0.07216878364870322f * 1.4426950408889634f;
constexpr float SWI_LIMIT = 7.0f, SWI_ALPHA = 1.702f;
constexpr float W8_SCALE = 64.f, ACT8_SCALE = 4.f, OS8_SCALE = 16.f;

constexpr size_t MiB = 1u << 20;
constexpr size_t WS_CTL = 0, CTL_ZERO_BYTES = 1 * MiB;
constexpr size_t WS_ROPE = 1 * MiB;
constexpr size_t WS_WRH = 1 * MiB + 512 * 1024, WS_WRL = WS_WRH + 64 * 1024;
constexpr size_t WS_WIN = 2 * MiB;
constexpr size_t WS_WUQ = 8 * MiB, WS_WUKV = 9 * MiB, WS_WO = 10 * MiB;
constexpr size_t WS_SSQ = 12 * MiB;
constexpr size_t WS_RS2 = 14 * MiB, WS_GATE = 14 * MiB + 512 * 1024;
constexpr size_t WS_TOS = 16 * MiB;
constexpr size_t WS_WGU = 32 * MiB, WS_WDN = 160 * MiB;
constexpr size_t WS_HB = 224 * MiB;
constexpr size_t WS_Q = 288 * MiB, WS_K = 336 * MiB, WS_V = 384 * MiB, WS_MIX = 416 * MiB;
constexpr size_t WS_OSLOT = 288 * MiB;
constexpr size_t WS_HN = 544 * MiB, WS_PB = 608 * MiB, WS_QRAW = 752 * MiB, WS_KVRAW = 800 * MiB;
constexpr size_t WS_ACT = 544 * MiB;
constexpr size_t WS_H1B = 768 * MiB;
constexpr size_t WS_END = 864 * MiB;
constexpr int CW_BAR = 4096;
constexpr int CW_CNT = 16384;

constexpr int RING_BYTES = 131072;
constexpr int MISC_OFF = RING_BYTES;
constexpr int LDS_BYTES = 155648;
constexpr int EPI_TAB_OFF = MISC_OFF + 3072 * 4;

__device__ __forceinline__ unsigned cvt_pk_bf16(float lo, float hi) { unsigned r; asm volatile("v_cvt_pk_bf16_f32 %0, %1, %2" : "=v"(r) : "v"(lo), "v"(hi)); return r; }
__device__ __forceinline__ unsigned f2bf(float f) { unsigned u = __builtin_bit_cast(unsigned, f); return (u + 0x7fffu + ((u >> 16) & 1u)) >> 16; }
__device__ __forceinline__ unsigned pk2(float lo, float hi) { return f2bf(lo) | (f2bf(hi) << 16); }
__device__ __forceinline__ float bf_lo(unsigned w) { return __builtin_bit_cast(float, w << 16); }
__device__ __forceinline__ float bf_hi(unsigned w) { return __builtin_bit_cast(float, w & 0xffff0000u); }
__device__ __forceinline__ void unpack8(const u32x4 w, float* f) { f[0] = bf_lo(w.x); f[1] = bf_hi(w.x); f[2] = bf_lo(w.y); f[3] = bf_hi(w.y); f[4] = bf_lo(w.z); f[5] = bf_hi(w.z); f[6] = bf_lo(w.w); f[7] = bf_hi(w.w); }
__device__ __forceinline__ u32x4 pack8(const float* f) { u32x4 w; w.x = cvt_pk_bf16(f[0], f[1]); w.y = cvt_pk_bf16(f[2], f[3]); w.z = cvt_pk_bf16(f[4], f[5]); w.w = cvt_pk_bf16(f[6], f[7]); return w; }
__device__ __forceinline__ float wave_sum(float v) {
#pragma unroll
    for (int o = 1; o < 64; o <<= 1) v += __shfl_xor(v, o);
    return v;
}
__device__ __forceinline__ float half_sum(float v) {
#pragma unroll
    for (int o = 1; o < 32; o <<= 1) v += __shfl_xor(v, o);
    return v;
}
__device__ __forceinline__ float clamp448(float v) { return __builtin_amdgcn_fmed3f(v, -448.f, 448.f); }
__device__ __forceinline__ unsigned pk4_fp8_nc(float a, float b, float c, float d) {
    unsigned w = 0u; w = (unsigned)__builtin_amdgcn_cvt_pk_fp8_f32(a, b, (int)w, false); w = (unsigned)__builtin_amdgcn_cvt_pk_fp8_f32(c, d, (int)w, true); return w; }
__device__ __forceinline__ unsigned pk4_fp8(float a, float b, float c, float d) {
    unsigned w = 0u; w = (unsigned)__builtin_amdgcn_cvt_pk_fp8_f32(clamp448(a), clamp448(b), (int)w, false); w = (unsigned)__builtin_amdgcn_cvt_pk_fp8_f32(clamp448(c), clamp448(d), (int)w, true); return w; }
#define LDS_WAIT() asm volatile("s_waitcnt lgkmcnt(0)" ::: "memory")
#define VM_WAIT() asm volatile("s_waitcnt vmcnt(0)" ::: "memory")

namespace pg8 {
constexpr int BM = 256, BK = 64, HALF = 128, HTB = HALF * BK * 2, STAGE_BYTES = 8 * HTB, NXCD = 8, WGM = 8;
__host__ __device__ __forceinline__ int lds_byte(int r, int c) { const int st = (r >> 4) * 2 + (c >> 5), rr = r & 15, cc = c & 31, ob = rr * 64 + cc * 2; return st * 1024 + (ob ^ (((ob >> 9) & 1) << 5)); }
__host__ __device__ __forceinline__ void stage_rc(int b, int& R, int& C) { const int st = b / 1024, sb = b % 1024, swz = sb ^ (((sb >> 9) & 1) << 5); R = (st >> 1) * 16 + swz / 64; C = (st & 1) * 32 + (swz % 64) / 2; }
__host__ __device__ __forceinline__ int perm32(int rho) { const int n = rho >> 4, i = rho & 15; return 8 * (i >> 2) + 4 * n + (i & 3); }

struct Unit { int pm, pn, e, p0, cnt, par; };

struct DenseSched {
    static constexpr int ESZ = 2;
    const bf16_t* A; const bf16_t* Bt; int lda, K, nM, nN, nwg, G, c;
    __device__ void init(const bf16_t* A_, int lda_, const bf16_t* Bt_, int M, int N, int K_, int G_, int c_) { A = A_; Bt = Bt_; lda = lda_; K = K_; nM = M / BM; nN = N / BM; nwg = nM * nN; G = G_; c = c_; }
    __device__ __forceinline__ bool next(int i, Unit& u) const {
        const long L = (long)i * G + c; if (L >= nwg) return false;
        int wgid = (int)L; { const int q = nwg / NXCD, r = nwg % NXCD, xcd = wgid % NXCD, off = wgid / NXCD; wgid = (xcd < r ? xcd * (q + 1) : r * (q + 1) + (xcd - r) * q) + off; }
        const int nig = WGM * nN, gid = wgid / nig, fm = gid * WGM, gsz = (nM - fm) < WGM ? (nM - fm) : WGM;
        u.pm = fm + ((wgid % nig) % gsz); u.pn = (wgid % nig) / gsz; u.e = 0; u.p0 = 0; u.cnt = 0; return true;
    }
    __device__ __forceinline__ unsigned a_off(const Unit& u) const { return (unsigned)u.pm * (unsigned)(BM * lda * 2); }
    __device__ __forceinline__ unsigned b_off(const Unit& u) const { return (unsigned)u.pn * (unsigned)(BM * K * 2); }
    __device__ __forceinline__ unsigned a_rowoff(const Unit&, int) const { return 0u; }
    static constexpr bool META = false;
    __device__ __forceinline__ void meta_first(const Unit&, LAS unsigned char*) const {}
    __device__ __forceinline__ void meta_issue(const Unit&, unsigned (&)[4], const int (&)[2]) const {}
    __device__ __forceinline__ void meta_commit(const Unit&, unsigned (&)[4], LAS unsigned char*) const {}
    __device__ __forceinline__ unsigned meta_rowoff(const Unit&, unsigned, int) const { return 0u; }
    __device__ __forceinline__ void pre_issue(const Unit&, f32x4 (&)[4], int, int) const {}
};
struct MoeSched {
    static constexpr int ESZ = 1;
    const unsigned char* A; const unsigned char* Bt; int lda, K, nN, G, c; size_t estride; const LAS int* tab; const int* tos; const float* bias;
    static constexpr bool META = true;
    static constexpr int META_OFF = MISC_OFF + 4608 * 4;
    __device__ __forceinline__ bool next(int i, Unit& u) const {
        const int T = __builtin_amdgcn_readfirstlane(tab[32]), nwg = T * nN;
        const long L = (long)i * G + c; if (L >= nwg) return false;
        int wgid = (int)L; { const int q = nwg / NXCD, r = nwg % NXCD, xcd = wgid % NXCD, off = wgid / NXCD; wgid = (xcd < r ? xcd * (q + 1) : r * (q + 1) + (xcd - r) * q) + off; }
        const int nig = WGM * nN, gid = wgid / nig, fm = gid * WGM, gsz = (T - fm) < WGM ? (T - fm) : WGM;
        const int mt = fm + ((wgid % nig) % gsz); u.pm = mt; u.pn = (wgid % nig) / gsz;
        const int e = __builtin_amdgcn_readfirstlane(tab[2288 + mt]);
        u.e = e; u.p0 = (mt - __builtin_amdgcn_readfirstlane(tab[e])) * BM; u.cnt = __builtin_amdgcn_readfirstlane(tab[48 + e]); return true;
    }
    __device__ __forceinline__ unsigned a_off(const Unit& u) const { return (unsigned)u.pm * (unsigned)(BM * lda); }
    __device__ __forceinline__ unsigned b_off(const Unit& u) const { return (unsigned)u.e * (unsigned)estride + (unsigned)u.pn * (unsigned)(BM * K); }
    __device__ __forceinline__ unsigned a_rowoff(const Unit& u, int r) const {
        const int p = u.p0 + r; const int sv = tos[((size_t)u.e * CAP + p) * 2];
        const int slot = (p < u.cnt) ? sv : 0;
        return (unsigned)(slot >> 2) * (unsigned)lda;
    }
    __device__ __forceinline__ void meta_first(const Unit& u, LAS unsigned char* lds) const {
        if (threadIdx.x < BM) { const u32x2 v = *(const u32x2*)(tos + ((size_t)u.e * CAP + u.p0 + threadIdx.x) * 2); *(LAS u32x2*)(lds + META_OFF + u.par * 2048 + threadIdx.x * 8) = v; }
    }
    __device__ __forceinline__ void meta_issue(const Unit& u, unsigned (&mreg)[4], const int (&RA)[2]) const {
        const unsigned base = ((unsigned)u.e * (unsigned)CAP + (unsigned)u.p0) * 8u;
        if (nN == 8) {
#pragma unroll
            for (int k = 0; k < 4; ++k) { const unsigned off = base + (unsigned)((k >> 1) * HALF + RA[k & 1]) * 8u;
                asm volatile("global_load_dword %0, %1, %2" : "=v"(mreg[k]) : "v"(off), "s"(tos) : "memory"); }
        } else {
            const unsigned off = base + (threadIdx.x & 255u) * 8u; u32x2 v;
            asm volatile("global_load_dwordx2 %0, %1, %2" : "=v"(v) : "v"(off), "s"(tos) : "memory"); mreg[0] = v.x; mreg[1] = v.y;
        }
    }
    __device__ __forceinline__ void pre_issue(const Unit& u, f32x4 (&pre)[4], int wc, int fq) const {
        const unsigned j0 = (unsigned)(wc * 32 + 8 * fq) * 4u;
        if (nN == 8) { const unsigned o0 = ((unsigned)u.e * (2u * DFF) + (unsigned)u.pn * HALF) * 4u + j0, o1 = o0 + DFF * 4u;
            asm volatile("global_load_dwordx4 %0, %1, %2" : "=v"(pre[0]) : "v"(o0), "s"(bias) : "memory"); asm volatile("global_load_dwordx4 %0, %1, %2 offset:16" : "=v"(pre[1]) : "v"(o0), "s"(bias) : "memory");
            asm volatile("global_load_dwordx4 %0, %1, %2" : "=v"(pre[2]) : "v"(o1), "s"(bias) : "memory"); asm volatile("global_load_dwordx4 %0, %1, %2 offset:16" : "=v"(pre[3]) : "v"(o1), "s"(bias) : "memory");
        } else { const unsigned o0 = ((unsigned)u.e * DM + (unsigned)u.pn * BM) * 4u + j0;
            asm volatile("global_load_dwordx4 %0, %1, %2" : "=v"(pre[0]) : "v"(o0), "s"(bias) : "memory"); asm volatile("global_load_dwordx4 %0, %1, %2 offset:16" : "=v"(pre[1]) : "v"(o0), "s"(bias) : "memory");
            asm volatile("global_load_dwordx4 %0, %1, %2 offset:512" : "=v"(pre[2]) : "v"(o0), "s"(bias) : "memory"); asm volatile("global_load_dwordx4 %0, %1, %2 offset:528" : "=v"(pre[3]) : "v"(o0), "s"(bias) : "memory");
        }
    }
    __device__ __forceinline__ void meta_commit(const Unit& u, unsigned (&mreg)[4], LAS unsigned char* lds) const {
        asm volatile("" : "+v"(mreg[0]), "+v"(mreg[1]) :: "memory");
        if (threadIdx.x < BM) *(LAS u32x2*)(lds + META_OFF + u.par * 2048 + threadIdx.x * 8) = (u32x2){mreg[0], mreg[1]};
    }
    __device__ __forceinline__ unsigned meta_rowoff(const Unit& u, unsigned sv, int r) const {
        asm volatile("" : "+v"(sv) :: "memory");
        const int slot = (u.p0 + r < u.cnt) ? (int)sv : 0;
        return (unsigned)(slot >> 2) * (unsigned)lda;
    }
};

template <class Epi, class Sched, bool GATHER, int KREP = 1>
__device__ __forceinline__ void gemm_phase(LAS unsigned char* lds, const Sched& S, const Epi& E) {
    const int tid = threadIdx.x, wid = __builtin_amdgcn_readfirstlane(tid >> 6), lane = tid & 63, wr = wid >> 2, wc = wid & 3, fr = lane & 15, fq = lane >> 4;
    constexpr int ESZ = Sched::ESZ; constexpr bool F8 = (ESZ == 1);
    const int K = S.K * ESZ / 2, lda = S.lda * ESZ / 2, nt0 = K / BK, nt = nt0 * KREP;
    unsigned voffB[2], aoc[2][2], mreg[4] = {0u, 0u, 0u, 0u}; int RA[2], CA[2]; f32x4 pre[4];
#pragma unroll
    for (int i = 0; i < 2; ++i) { int R, C; stage_rc(tid * 16 + i * 8192, R, C); const int Rb = (R & ~31) + perm32(R & 31);
        voffB[i] = (unsigned)(Rb * K + C) * 2u; RA[i] = R; CA[i] = C;
        aoc[0][i] = (unsigned)(R * lda + C) * 2u; aoc[1][i] = (unsigned)((R + HALF) * lda + C) * 2u; }
    const unsigned kstep = (unsigned)(BK * 2);
    const unsigned hstepB = (unsigned)(HALF * K * 2), hstepA = GATHER ? 0u : (unsigned)(HALF * lda * 2);
    const __amdgpu_buffer_rsrc_t rA = __builtin_amdgcn_make_buffer_rsrc((void*)S.A, 0, -1, 0x00020000), rB = __builtin_amdgcn_make_buffer_rsrc((void*)S.Bt, 0, -1, 0x00020000);
    const unsigned ldsw = (unsigned)wid * 1024u;
    const int aoff = lds_byte(wr * 64 + fr, fq * 8), boff = lds_byte(wc * 32 + fr, fq * 8);
#define PG8_SA(b, h) (((b) * 2 + (h)) * HTB)
#define PG8_SB(b, h) ((4 + (b) * 2 + (h)) * HTB)
#define PG8_STAGE_B(bufoff, soff) do { _Pragma("unroll") for (int _i = 0; _i < 2; ++_i) \
        __builtin_amdgcn_raw_ptr_buffer_load_lds(rB, (LAS void*)(lds + (bufoff) + ldsw + _i * 8192), 16, voffB[_i], (soff), 0, 0); } while (0)
#define PG8_STAGE_A(bufoff, soff, h) do { _Pragma("unroll") for (int _i = 0; _i < 2; ++_i) \
        __builtin_amdgcn_raw_ptr_buffer_load_lds(rA, (LAS void*)(lds + (bufoff) + ldsw + _i * 8192), 16, aoc[GATHER ? (h) : 0][_i], (soff) + (h) * hstepA, 0, 0); } while (0)
#define PG8_LDA(dst, b, h) do { _Pragma("unroll") for (int m = 0; m < 4; ++m) _Pragma("unroll") for (int k = 0; k < 2; ++k) dst[m][k] = *(const LAS bf16x8*)(lds + PG8_SA(b, h) + aoff + m * 2048 + k * 1024); } while (0)
#define PG8_LDB(dst, b, h) do { _Pragma("unroll") for (int n = 0; n < 2; ++n) _Pragma("unroll") for (int k = 0; k < 2; ++k) dst[n][k] = *(const LAS bf16x8*)(lds + PG8_SB(b, h) + boff + n * 2048 + k * 1024); } while (0)
#define PG8_CAT(x) __builtin_shufflevector(__builtin_bit_cast(v4i_t, x[0]), __builtin_bit_cast(v4i_t, x[1]), 0, 1, 2, 3, 4, 5, 6, 7)
#define PG8_MMA(ai, bj, At, Bt) do { __builtin_amdgcn_s_setprio(1); _Pragma("unroll") for (int m = 0; m < 4; ++m) _Pragma("unroll") for (int n = 0; n < 2; ++n) { \
        if constexpr (F8) { asm volatile("v_mfma_scale_f32_16x16x128_f8f6f4 %0, %1, %2, %0, %3, %3 op_sel_hi:[0,0,0]" : "+v"(acc[ai][bj][m][n]) : "v"(PG8_CAT(Bt[n])), "v"(PG8_CAT(At[m])), "v"(0x7f7f7f7f)); } \
        else { _Pragma("unroll") for (int k = 0; k < 2; ++k) acc[ai][bj][m][n] = __builtin_amdgcn_mfma_f32_16x16x32_bf16(Bt[n][k], At[m][k], acc[ai][bj][m][n], 0, 0, 0); } } \
        __builtin_amdgcn_s_setprio(0); } while (0)
#define PG8_WAIT_V(n) asm volatile("s_waitcnt vmcnt(" #n ")" ::: "memory")
#define PG8_WAIT_L(n) asm volatile("s_waitcnt lgkmcnt(" #n ")" ::: "memory")
#define PG8_BAR __builtin_amdgcn_s_barrier()
#define PG8_SCHED __builtin_amdgcn_sched_barrier(0)
    Unit cur, nxt; int ui = 0;
    if (!S.next(0, cur)) return;
    cur.par = 0; if constexpr (Sched::META && !GATHER) S.meta_first(cur, lds);
    f32x4 acc[2][2][4][2];
#pragma unroll
    for (int a = 0; a < 2; ++a)
#pragma unroll
        for (int b = 0; b < 2; ++b)
#pragma unroll
            for (int m = 0; m < 4; ++m)
#pragma unroll
                for (int n = 0; n < 2; ++n) acc[a][b][m][n] = (f32x4){0.f, 0.f, 0.f, 0.f};
    bf16x8 At[4][2], B0[2][2], B1[2][2];
    unsigned cA = GATHER ? 0u : S.a_off(cur), cB = S.b_off(cur);
    if constexpr (GATHER) {
#pragma unroll
        for (int h = 0; h < 2; ++h)
#pragma unroll
            for (int i = 0; i < 2; ++i) aoc[h][i] = S.a_rowoff(cur, h * HALF + RA[i]) + (unsigned)CA[i] * 2u;
    }
    PG8_STAGE_B(PG8_SB(0, 0), cB); PG8_STAGE_B(PG8_SB(0, 1), cB + hstepB); PG8_STAGE_A(PG8_SA(0, 0), cA, 0); PG8_STAGE_A(PG8_SA(0, 1), cA, 1);
    if (wr == 1) PG8_BAR;
    PG8_WAIT_V(2); PG8_BAR;
    PG8_STAGE_B(PG8_SB(1, 0), cB + kstep); PG8_STAGE_A(PG8_SA(1, 0), cA + kstep, 0); PG8_STAGE_B(PG8_SB(1, 1), cB + hstepB + kstep);
    PG8_WAIT_V(6); PG8_BAR;
    for (;;) {
        const bool has_next = S.next(ui + 1, nxt);
        const unsigned nA = GATHER ? 0u : (has_next ? S.a_off(nxt) : cA), nB = has_next ? S.b_off(nxt) : cB;
        nxt.par = (ui + 1) & 1;
        for (int t = 0; t < nt; t += 2) {
            const bool last = (t == nt - 2);
            const unsigned a1 = cA + (unsigned)((t + 1) % nt0) * kstep;
            const unsigned a2 = last ? nA : cA + (unsigned)((t + 2) % nt0) * kstep, b2 = last ? nB : cB + (unsigned)((t + 2) % nt0) * kstep;
            const unsigned a3 = a2 + kstep, b3 = b2 + kstep;
            PG8_LDB(B0, 0, 0); PG8_LDB(B1, 0, 1); PG8_SCHED; PG8_LDA(At, 0, 0); PG8_STAGE_A(PG8_SA(1, 1), a1, 1);
            PG8_WAIT_V(8); PG8_WAIT_L(0); PG8_BAR;
            if constexpr (Sched::META) { if (t == 0) { S.pre_issue(cur, pre, wc, fq); if (has_next) S.meta_issue(nxt, mreg, RA); } }
            PG8_MMA(0, 0, At, B0); PG8_MMA(0, 1, At, B1); PG8_BAR; PG8_SCHED;
            if constexpr (Sched::META) { if (last && has_next) {
                if constexpr (GATHER) {
#pragma unroll
                    for (int h = 0; h < 2; ++h)
#pragma unroll
                        for (int i = 0; i < 2; ++i) aoc[h][i] = S.meta_rowoff(nxt, mreg[h * 2 + i], h * HALF + RA[i]) + (unsigned)CA[i] * 2u;
                } else S.meta_commit(nxt, mreg, lds); } }
            PG8_LDA(At, 0, 1); PG8_STAGE_B(PG8_SB(0, 0), b2); PG8_STAGE_B(PG8_SB(0, 1), b2 + hstepB); PG8_STAGE_A(PG8_SA(0, 0), a2, 0);
            PG8_WAIT_V(8); PG8_WAIT_L(0); PG8_BAR; PG8_MMA(1, 0, At, B0); PG8_MMA(1, 1, At, B1); PG8_BAR; PG8_SCHED;
            PG8_LDB(B0, 1, 0); PG8_LDB(B1, 1, 1); PG8_SCHED; PG8_LDA(At, 1, 0); PG8_STAGE_A(PG8_SA(0, 1), a2, 1);
            PG8_WAIT_V(8); PG8_WAIT_L(0); PG8_BAR; PG8_MMA(0, 0, At, B0); PG8_MMA(0, 1, At, B1); PG8_BAR; PG8_SCHED;
            PG8_LDA(At, 1, 1); PG8_STAGE_B(PG8_SB(1, 0), b3); PG8_STAGE_B(PG8_SB(1, 1), b3 + hstepB); PG8_STAGE_A(PG8_SA(1, 0), a3, 0);
            PG8_WAIT_V(8); PG8_WAIT_L(0); PG8_BAR; PG8_MMA(1, 0, At, B0); PG8_MMA(1, 1, At, B1); PG8_BAR; PG8_SCHED;
        }
        if (wr == 0) PG8_BAR;
        if constexpr (Sched::META) E(acc, cur, wr, wc, fr, fq, pre); else E(acc, cur, wr, wc, fr, fq);
        if (!has_next) break;
#pragma unroll
        for (int a = 0; a < 2; ++a)
#pragma unroll
            for (int b = 0; b < 2; ++b)
#pragma unroll
                for (int m = 0; m < 4; ++m)
#pragma unroll
                    for (int n = 0; n < 2; ++n) acc[a][b][m][n] = (f32x4){0.f, 0.f, 0.f, 0.f};
        cur = nxt; cA = nA; cB = nB; ++ui;
        if (wr == 1) PG8_BAR;
    }
    PG8_WAIT_V(0);
    PG8_BAR;
#undef PG8_SA
#undef PG8_SB
#undef PG8_STAGE_A
#undef PG8_STAGE_B
#undef PG8_LDA
#undef PG8_LDB
#undef PG8_MMA
#undef PG8_CAT
#undef PG8_WAIT_V
#undef PG8_WAIT_L
#undef PG8_BAR
#undef PG8_SCHED
}

struct EpiBf16 {
    bf16_t* O; int ldc;
    __device__ __forceinline__ void operator()(const f32x4 (&acc)[2][2][4][2], const Unit& u, int wr, int wc, int fr, int fq) const {
        asm volatile("" : "+v"(fr), "+v"(fq));
        const int row0 = u.pm * BM + wr * 64 + fr, col0 = u.pn * BM + wc * 32 + 8 * fq;
#pragma unroll
        for (int ai = 0; ai < 2; ++ai)
#pragma unroll
            for (int m = 0; m < 4; ++m) { bf16_t* rowp = O + (size_t)(row0 + ai * HALF + m * 16) * ldc + col0;
#pragma unroll
                for (int bj = 0; bj < 2; ++bj) { const f32x4 v0 = acc[ai][bj][m][0], v1 = acc[ai][bj][m][1];
                    u32x4 w; w.x = cvt_pk_bf16(v0[0], v0[1]); w.y = cvt_pk_bf16(v0[2], v0[3]); w.z = cvt_pk_bf16(v1[0], v1[1]); w.w = cvt_pk_bf16(v1[2], v1[3]);
                    *(u32x4*)(rowp + bj * HALF) = w; } }
    }
};
struct EpiProj {
    bf16_t* O; float* st;
    __device__ __forceinline__ void operator()(const f32x4 (&acc)[2][2][4][2], const Unit& u, int wr, int wc, int fr, int fq) const {
        asm volatile("" : "+v"(fr), "+v"(fq));
        const int row0 = u.pm * BM + wr * 64 + fr, col0 = u.pn * BM + wc * 32 + 8 * fq;
#pragma unroll
        for (int ai = 0; ai < 2; ++ai)
#pragma unroll
            for (int m = 0; m < 4; ++m) { const int row = row0 + ai * HALF + m * 16; bf16_t* rowp = O + (size_t)row * NPP + col0; float ss[2];
#pragma unroll
                for (int bj = 0; bj < 2; ++bj) { const f32x4 v0 = acc[ai][bj][m][0], v1 = acc[ai][bj][m][1];
                    u32x4 w; w.x = cvt_pk_bf16(v0[0], v0[1]); w.y = cvt_pk_bf16(v0[2], v0[3]); w.z = cvt_pk_bf16(v1[0], v1[1]); w.w = cvt_pk_bf16(v1[2], v1[3]);
                    *(u32x4*)(rowp + bj * HALF) = w;
                    ss[bj] = (v0[0] * v0[0] + v0[1] * v0[1]) + (v0[2] * v0[2] + v0[3] * v0[3]) + (v1[0] * v1[0] + v1[1] * v1[1]) + (v1[2] * v1[2] + v1[3] * v1[3]); }
                if (u.pn >= 6) {
                    float s0 = ss[0], s1 = ss[1]; s0 += __shfl_xor(s0, 16); s0 += __shfl_xor(s0, 32); s1 += __shfl_xor(s1, 16); s1 += __shfl_xor(s1, 32);
                    if (fq == 0) { if (u.pn == 6) st[(size_t)wc * NTOK + row] = s0 + s1; else if (u.pn == 7) st[(size_t)(4 + wc) * NTOK + row] = s0 + s1;
                                   else { st[(size_t)(8 + wc) * NTOK + row] = s0; st[(size_t)(12 + wc) * NTOK + row] = s1; } } } }
    }
};
struct EpiQ {
    bf16_t* q; const float* st; const float* qhn; const f32x2* rope; LAS float* tabs;
    __device__ __forceinline__ void operator()(const f32x4 (&acc)[2][2][4][2], const Unit& u, int wr, int wc, int fr, int fq) const {
        asm volatile("" : "+v"(fr), "+v"(fq));
        LAS float* rs_tab = tabs; LAS float* part = tabs + 512;
        const int rt0 = wr * 64 + fr;
        const int c0 = wc * 32 + 8 * fq;
        const int i0 = c0 >> 1;
        f32x4 csa[2][4][2];
        if (wc < 2) {
#pragma unroll
            for (int ai = 0; ai < 2; ++ai)
#pragma unroll
                for (int m = 0; m < 4; ++m) { const size_t row = (size_t)u.pm * BM + rt0 + ai * HALF + m * 16;
                    csa[ai][m][0] = *(const f32x4*)(rope + (row & (SEQ - 1)) * 32 + i0); csa[ai][m][1] = *(const f32x4*)(rope + (row & (SEQ - 1)) * 32 + i0 + 2); }
        }
        f32x4 g0[2], g1[2];
        g0[0] = *(const f32x4*)(qhn + c0) * QSCALE; g0[1] = *(const f32x4*)(qhn + c0 + 4) * QSCALE;
        if (wc < 2) { g1[0] = (f32x4){qhn[128 + i0], qhn[160 + i0], qhn[129 + i0], qhn[161 + i0]} * QSCALE; g1[1] = (f32x4){qhn[130 + i0], qhn[162 + i0], qhn[131 + i0], qhn[163 + i0]} * QSCALE; }
        else { g1[0] = (f32x4){0.f, 0.f, 0.f, 0.f}; g1[1] = g1[0]; }
        { const int t = threadIdx.x; if (t < BM) { const size_t r = (size_t)u.pm * BM + t; float s = 0.f;
#pragma unroll
            for (int k = 4; k < 12; ++k) s += st[(size_t)k * NTOK + r];
            rs_tab[t] = 1.0f / sqrtf(s * (1.f / QL) + EPS); } }
#pragma unroll
        for (int ai = 0; ai < 2; ++ai)
#pragma unroll
            for (int m = 0; m < 4; ++m) { float ss = 0.f;
#pragma unroll
                for (int bj = 0; bj < 2; ++bj)
#pragma unroll
                    for (int n = 0; n < 2; ++n) { const f32x4 v = acc[ai][bj][m][n]; ss += (v[0] * v[0] + v[1] * v[1]) + (v[2] * v[2] + v[3] * v[3]); }
                ss += __shfl_xor(ss, 16); ss += __shfl_xor(ss, 32);
                if (fq == 0) part[(rt0 + ai * HALF + m * 16) * 4 + wc] = ss; }
        asm volatile("s_waitcnt lgkmcnt(0)" ::: "memory"); __builtin_amdgcn_s_barrier(); asm volatile("" ::: "memory");
#pragma unroll
        for (int ai = 0; ai < 2; ++ai)
#pragma unroll
            for (int m = 0; m < 4; ++m) { const int rt = rt0 + ai * HALF + m * 16; const size_t row = (size_t)u.pm * BM + rt;
                const f32x4 pp = *(const LAS f32x4*)(part + rt * 4); const float rs = rs_tab[rt];
                const float r = rs / sqrtf(rs * rs * ((pp[0] + pp[1]) + (pp[2] + pp[3])) * (1.f / QKH) + EPS);
                bf16_t* qp = q + row * (NH * QKH) + u.pn * QKH + c0;
                { const f32x4 v0 = acc[ai][0][m][0] * g0[0] * r, v1 = acc[ai][0][m][1] * g0[1] * r;
                  u32x4 w; w.x = cvt_pk_bf16(v0[0], v0[1]); w.y = cvt_pk_bf16(v0[2], v0[3]); w.z = cvt_pk_bf16(v1[0], v1[1]); w.w = cvt_pk_bf16(v1[2], v1[3]); *(u32x4*)qp = w; }
                if (wc < 2) { const f32x4 cs0 = csa[ai][m][0], cs1 = csa[ai][m][1];
                    const f32x4 a0 = acc[ai][1][m][0] * g1[0] * r, a1 = acc[ai][1][m][1] * g1[1] * r;
                    f32x4 o0, o1;
                    o0[0] = a0[0] * cs0[0] - a0[1] * cs0[1]; o0[1] = a0[0] * cs0[1] + a0[1] * cs0[0]; o0[2] = a0[2] * cs0[2] - a0[3] * cs0[3]; o0[3] = a0[2] * cs0[3] + a0[3] * cs0[2];
                    o1[0] = a1[0] * cs1[0] - a1[1] * cs1[1]; o1[1] = a1[0] * cs1[1] + a1[1] * cs1[0]; o1[2] = a1[2] * cs1[2] - a1[3] * cs1[3]; o1[3] = a1[2] * cs1[3] + a1[3] * cs1[2];
                    u32x4 w; w.x = cvt_pk_bf16(o0[0], o0[1]); w.y = cvt_pk_bf16(o0[2], o0[3]); w.z = cvt_pk_bf16(o1[0], o1[1]); w.w = cvt_pk_bf16(o1[2], o1[3]); *(u32x4*)(qp + HALF) = w; } }
    }
};
struct EpiKV {
    bf16_t* k; bf16_t* v; const float* st; const float* khn; const f32x2* rope; const bf16_t* pb; LAS float* tabs;
    __device__ __forceinline__ void operator()(const f32x4 (&acc)[2][2][4][2], const Unit& u, int wr, int wc, int fr, int fq) const {
        asm volatile("" : "+v"(fr), "+v"(fq));
        LAS float* rs_tab = tabs; LAS float* kpe_tab = tabs + 256; LAS float* part = tabs + 512;
        const int rt0 = wr * 64 + fr;
        const int c0 = wc * 32 + 8 * fq;
        const int i0 = 8 * wc + 2 * fq;
        unsigned xas[2][4], xbs[2][4]; f32x4 css[2][4];
#pragma unroll
        for (int ai = 0; ai < 2; ++ai)
#pragma unroll
            for (int m = 0; m < 4; ++m) { const size_t row = (size_t)u.pm * BM + rt0 + ai * HALF + m * 16;
                xas[ai][m] = *(const unsigned*)(pb + row * NPP + PB_KPE + i0); xbs[ai][m] = *(const unsigned*)(pb + row * NPP + PB_KPE + 32 + i0);
                css[ai][m] = *(const f32x4*)(rope + (row & (SEQ - 1)) * 32 + i0); }
        const f32x4 g0 = *(const f32x4*)(khn + c0), g1 = *(const f32x4*)(khn + c0 + 4);
        const float gx0 = khn[128 + i0], gy0 = khn[160 + i0], gx1 = khn[129 + i0], gy1 = khn[161 + i0];
        { const int t = threadIdx.x; if (t < BM) { const size_t r = (size_t)u.pm * BM + t;
            const float s = (st[r] + st[(size_t)NTOK + r]) + (st[(size_t)2 * NTOK + r] + st[(size_t)3 * NTOK + r]);
            const float p = (st[(size_t)12 * NTOK + r] + st[(size_t)13 * NTOK + r]) + (st[(size_t)14 * NTOK + r] + st[(size_t)15 * NTOK + r]);
            rs_tab[t] = 1.0f / sqrtf(s * (1.f / KVL) + EPS); kpe_tab[t] = p; } }
#pragma unroll
        for (int ai = 0; ai < 2; ++ai)
#pragma unroll
            for (int m = 0; m < 4; ++m) { float ss = 0.f;
#pragma unroll
                for (int n = 0; n < 2; ++n) { const f32x4 x = acc[ai][0][m][n]; ss += (x[0] * x[0] + x[1] * x[1]) + (x[2] * x[2] + x[3] * x[3]); }
                ss += __shfl_xor(ss, 16); ss += __shfl_xor(ss, 32);
                if (fq == 0) part[(rt0 + ai * HALF + m * 16) * 4 + wc] = ss; }
        asm volatile("s_waitcnt lgkmcnt(0)" ::: "memory"); __builtin_amdgcn_s_barrier(); asm volatile("" ::: "memory");
#pragma unroll
        for (int ai = 0; ai < 2; ++ai)
#pragma unroll
            for (int m = 0; m < 4; ++m) { const int rt = rt0 + ai * HALF + m * 16; const size_t row = (size_t)u.pm * BM + rt;
                const f32x4 pp = *(const LAS f32x4*)(part + rt * 4); const float rs = rs_tab[rt];
                const float rh = 1.0f / sqrtf((rs * rs * ((pp[0] + pp[1]) + (pp[2] + pp[3])) + kpe_tab[rt]) * (1.f / QKH) + EPS);
                const float r = rs * rh;
                bf16_t* kp = k + row * (NH * QKH) + u.pn * QKH;
                { const f32x4 v0 = acc[ai][0][m][0] * g0 * r, v1 = acc[ai][0][m][1] * g1 * r;
                  u32x4 w; w.x = cvt_pk_bf16(v0[0], v0[1]); w.y = cvt_pk_bf16(v0[2], v0[3]); w.z = cvt_pk_bf16(v1[0], v1[1]); w.w = cvt_pk_bf16(v1[2], v1[3]); *(u32x4*)(kp + c0) = w; }
                { const f32x4 v0 = acc[ai][1][m][0] * rs, v1 = acc[ai][1][m][1] * rs;
                  u32x4 w; w.x = cvt_pk_bf16(v0[0], v0[1]); w.y = cvt_pk_bf16(v0[2], v0[3]); w.z = cvt_pk_bf16(v1[0], v1[1]); w.w = cvt_pk_bf16(v1[2], v1[3]); *(u32x4*)(v + row * (NH * VH) + u.pn * VH + c0) = w; }
                { const unsigned xa = xas[ai][m], xb = xbs[ai][m];
                  const f32x4 cs = css[ai][m];
                  const float x10 = bf_lo(xa) * gx0 * rh, x11 = bf_hi(xa) * gx1 * rh, x20 = bf_lo(xb) * gy0 * rh, x21 = bf_hi(xb) * gy1 * rh;
                  u32x2 w; w.x = cvt_pk_bf16(x10 * cs[0] - x20 * cs[1], x10 * cs[1] + x20 * cs[0]); w.y = cvt_pk_bf16(x11 * cs[2] - x21 * cs[3], x11 * cs[3] + x21 * cs[2]);
                  *(u32x2*)(kp + 128 + 2 * i0) = w; } }
    }
};
struct EpiOut {
    const float* x; bf16_t* h1b; float* ssq;
    __device__ __forceinline__ void operator()(const f32x4 (&acc)[2][2][4][2], const Unit& u, int wr, int wc, int fr, int fq) const {
        asm volatile("" : "+v"(fr), "+v"(fq));
        const int row0 = u.pm * BM + wr * 64 + fr, col0 = u.pn * BM + wc * 32 + 8 * fq;
#pragma unroll
        for (int ai = 0; ai < 2; ++ai) {
            f32x4 xv[4][2][2];
#pragma unroll
            for (int m = 0; m < 4; ++m) { const size_t off = (size_t)(row0 + ai * HALF + m * 16) * DM + col0;
#pragma unroll
                for (int bj = 0; bj < 2; ++bj) { xv[m][bj][0] = __builtin_nontemporal_load((const f32x4*)(x + off + bj * HALF)); xv[m][bj][1] = __builtin_nontemporal_load((const f32x4*)(x + off + bj * HALF + 4)); } }
            asm volatile("" ::: "memory");
#pragma unroll
            for (int m = 0; m < 4; ++m) { const int row = row0 + ai * HALF + m * 16; const size_t off = (size_t)row * DM + col0; float ss = 0.f;
#pragma unroll
                for (int bj = 0; bj < 2; ++bj) { const f32x4 v0 = acc[ai][bj][m][0] + xv[m][bj][0], v1 = acc[ai][bj][m][1] + xv[m][bj][1];
                    u32x4 w; w.x = cvt_pk_bf16(v0[0], v0[1]); w.y = cvt_pk_bf16(v0[2], v0[3]); w.z = cvt_pk_bf16(v1[0], v1[1]); w.w = cvt_pk_bf16(v1[2], v1[3]);
                    *(u32x4*)(h1b + off + bj * HALF) = w;
                    ss += (v0[0] * v0[0] + v0[1] * v0[1]) + (v0[2] * v0[2] + v0[3] * v0[3]) + (v1[0] * v1[0] + v1[1] * v1[1]) + (v1[2] * v1[2] + v1[3] * v1[3]); }
                ss += __shfl_xor(ss, 16); ss += __shfl_xor(ss, 32);
                if (fq == 0) ssq[(size_t)(u.pn * 4 + wc) * NTOK + row] = ss; }
        }
    }
};
struct EpiSwiglu {
    unsigned char* act; const float* bgu;
    __device__ __forceinline__ void operator()(const f32x4 (&acc)[2][2][4][2], const Unit& u, int wr, int wc, int fr, int fq, f32x4 (&pre)[4]) const {
        asm volatile("" : "+v"(fr), "+v"(fq));
        const int rt0 = wr * 64 + fr, j0 = wc * 32 + 8 * fq;
        asm volatile("" : "+v"(pre[0]), "+v"(pre[1]), "+v"(pre[2]), "+v"(pre[3]) :: "memory");
        const f32x4 bg0 = pre[0], bg1 = pre[1], bu0 = pre[2], bu1 = pre[3];
        constexpr float WI = 1.f / W8_SCALE;
#pragma unroll
        for (int ai = 0; ai < 2; ++ai)
#pragma unroll
            for (int m = 0; m < 4; ++m) { const int rt = rt0 + ai * HALF + m * 16;
                float o[8];
#pragma unroll
                for (int n = 0; n < 2; ++n) { const f32x4 g4 = acc[ai][0][m][n] * WI + (n ? bg1 : bg0), u4 = acc[ai][1][m][n] * WI + (n ? bu1 : bu0);
#pragma unroll
                    for (int i = 0; i < 4; i += 2) {
                        f32x2 g, uu; g.x = fminf(g4[i], SWI_LIMIT); g.y = fminf(g4[i + 1], SWI_LIMIT);
                        uu.x = __builtin_amdgcn_fmed3f(u4[i], -SWI_LIMIT, SWI_LIMIT); uu.y = __builtin_amdgcn_fmed3f(u4[i + 1], -SWI_LIMIT, SWI_LIMIT);
                        const f32x2 t = g * (-SWI_ALPHA * 1.4426950408889634f);
                        f32x2 e; e.x = __builtin_amdgcn_exp2f(t.x); e.y = __builtin_amdgcn_exp2f(t.y);
                        const f32x2 d = e + 1.f;
                        f32x2 sg; sg.x = __builtin_amdgcn_rcpf(d.x); sg.y = __builtin_amdgcn_rcpf(d.y);
                        const f32x2 r = (uu * ACT8_SCALE + ACT8_SCALE) * (g * sg);
                        o[n * 4 + i] = r.x; o[n * 4 + i + 1] = r.y; } }
                u32x2 w; w.x = pk4_fp8_nc(o[0], o[1], o[2], o[3]); w.y = pk4_fp8_nc(o[4], o[5], o[6], o[7]);
                *(u32x2*)(act + ((size_t)u.pm * BM + rt) * DFF + u.pn * HALF + j0) = w; }
    }
};
struct EpiDown {
    unsigned char* oslot; const float* bdn; unsigned char* dummy; LAS unsigned char* lds;
    __device__ __forceinline__ void operator()(const f32x4 (&acc)[2][2][4][2], const Unit& u, int wr, int wc, int fr, int fq, f32x4 (&pre)[4]) const {
        asm volatile("" : "+v"(fr), "+v"(fq));
        const int rt0 = wr * 64 + fr, col0 = u.pn * BM + wc * 32 + 8 * fq;
        asm volatile("" : "+v"(pre[0]), "+v"(pre[1]), "+v"(pre[2]), "+v"(pre[3]) :: "memory");
        f32x4 bv[2][2]; bv[0][0] = pre[0]; bv[0][1] = pre[1]; bv[1][0] = pre[2]; bv[1][1] = pre[3];
        constexpr float WI = 1.f / (W8_SCALE * ACT8_SCALE);
#pragma unroll
        for (int ai = 0; ai < 2; ++ai)
#pragma unroll
            for (int m = 0; m < 4; ++m) { const int rt = rt0 + ai * HALF + m * 16, p = u.p0 + rt;
                const u32x2 mt = *(const LAS u32x2*)(lds + MoeSched::META_OFF + u.par * 2048 + rt * 8);
                const bool valid = p < u.cnt; const int slot = valid ? (int)mt.x : 0; const unsigned gbits = mt.y; const float g = __builtin_bit_cast(float, gbits);
                unsigned char* rowp = valid ? oslot + (size_t)slot * DM + col0 : dummy + col0;
                const float gs = g * OS8_SCALE;
#pragma unroll
                for (int bj = 0; bj < 2; ++bj) { const f32x4 v0 = (acc[ai][bj][m][0] * WI + bv[bj][0]) * gs, v1 = (acc[ai][bj][m][1] * WI + bv[bj][1]) * gs;
                    u32x2 w; w.x = pk4_fp8(v0[0], v0[1], v0[2], v0[3]); w.y = pk4_fp8(v1[0], v1[1], v1[2], v1[3]);
                    *(u32x2*)(rowp + bj * HALF) = w; } }
    }
};
struct EpiNull {
    float* dummy;
    __device__ __forceinline__ void operator()(const f32x4 (&acc)[2][2][4][2], const Unit& u, int wr, int wc, int fr, int fq, f32x4 (&)[4]) const {
        float sacc = 0.f;
#pragma unroll
        for (int ai = 0; ai < 2; ++ai)
#pragma unroll
            for (int bj = 0; bj < 2; ++bj)
#pragma unroll
                for (int m = 0; m < 4; ++m)
#pragma unroll
                    for (int n = 0; n < 2; ++n) sacc += (acc[ai][bj][m][n][0] + acc[ai][bj][m][n][1]) + (acc[ai][bj][m][n][2] + acc[ai][bj][m][n][3]);
        dummy[(size_t)blockIdx.x * 512 + threadIdx.x] = sacc;
    }
};
}

namespace att {
constexpr int LDQ = NH * QKH, LDK = NH * QKH, LDV = NH * VH, LDO = DM;
constexpr int KT_BYTES = 64 * QKH * 2, VT_BYTES = 64 * VH * 2;
constexpr int L_K = 0, L_V = 3 * KT_BYTES, L_WS = L_V + 3 * VT_BYTES, L_END = L_WS + 8 * 256;
constexpr float THRL = 8.f * 1.4426950408889634f;
__device__ __forceinline__ int crow(int r, int hi) { return (r & 3) + 8 * (r >> 2) + 4 * hi; }
#define SBAR() __builtin_amdgcn_sched_barrier(0)
__device__ __forceinline__ int v_rd_base(int lane) { return ((lane & 3) << 3) | (((lane >> 2) & 3) << 6) | (((lane >> 4) & 1) << 5) | (((lane >> 5) & 1) << 8); }
constexpr int v_rd_off(int d0, int ks, int half) { return d0 * 512 + ks * 4096 + half * 2048; }
template <int OFF> __device__ __forceinline__ s16x4 tr_read(int vb) {
    s16x4 r; asm volatile("ds_read_b64_tr_b16 %0, %1 offset:%2" : "=&v"(r) : "v"(vb), "i"(OFF) : "memory"); return r;
}
template <int D0> __device__ __forceinline__ void pv_one(f32x16& od, int vb, bf16x8 pa0, bf16x8 pa1, bf16x8 pa2, bf16x8 pa3) {
    const s16x4 l0 = tr_read<v_rd_off(D0, 0, 0)>(vb), h0 = tr_read<v_rd_off(D0, 0, 1)>(vb), l1 = tr_read<v_rd_off(D0, 1, 0)>(vb), h1 = tr_read<v_rd_off(D0, 1, 1)>(vb);
    const s16x4 l2 = tr_read<v_rd_off(D0, 2, 0)>(vb), h2 = tr_read<v_rd_off(D0, 2, 1)>(vb), l3 = tr_read<v_rd_off(D0, 3, 0)>(vb), h3 = tr_read<v_rd_off(D0, 3, 1)>(vb);
    asm volatile("s_waitcnt lgkmcnt(0)" ::: "memory"); SBAR();
#define PK(L, H) (bf16x8){L[0], L[1], L[2], L[3], H[0], H[1], H[2], H[3]}
    od = __builtin_amdgcn_mfma_f32_32x32x16_bf16(pa0, PK(l0, h0), od, 0, 0, 0);
    od = __builtin_amdgcn_mfma_f32_32x32x16_bf16(pa1, PK(l1, h1), od, 0, 0, 0);
    od = __builtin_amdgcn_mfma_f32_32x32x16_bf16(pa2, PK(l2, h2), od, 0, 0, 0);
    od = __builtin_amdgcn_mfma_f32_32x32x16_bf16(pa3, PK(l3, h3), od, 0, 0, 0);
#undef PK
}
__device__ __forceinline__ void glds16(const void* gsrc, LAS unsigned char* dst) {
    __builtin_amdgcn_global_load_lds((const unsigned*)gsrc, (LAS unsigned*)dst, 16, 0, 0);
}
__device__ __forceinline__ void attn_unit(int b, int h, int qb, const bf16_t* Q, const bf16_t* Kg, const bf16_t* Vg, bf16_t* O, LAS unsigned char* lds) {
    const int tid = threadIdx.x, wid = __builtin_amdgcn_readfirstlane(tid >> 6), lane = tid & 63, r32 = lane & 31, hi = lane >> 5;
    const int grp = wid >> 2;
    const size_t tok0 = (size_t)b * SEQ;
    bf16x8 qr[12];
    { const bf16_t* Qw = Q + (tok0 + (size_t)qb * 256 + wid * 32 + r32) * LDQ + h * QKH + hi * 8;
#pragma unroll
      for (int d0 = 0; d0 < 12; ++d0) qr[d0] = *(const bf16x8*)(Qw + d0 * 16); }
    unsigned koff[3], voff[2];
#pragma unroll
    for (int i = 0; i < 3; ++i) { const int G = 64 * (wid + 8 * i) + lane, row = G / 24, cgs = G % 24, cg = (cgs & ~7) | ((cgs & 7) ^ ((row >> 1) & 7)); koff[i] = (unsigned)(row * LDK * 2 + cg * 16); }
#pragma unroll
    for (int i = 0; i < 2; ++i) { const int p = wid + 8 * i, sub = 2 * p + (lane >> 5), kkh = sub >> 2, cblk = sub & 3, kkl = (lane & 31) >> 2, cl = (lane & 3) * 8, kk = kkh * 8 + kkl;
        const int k = (kk & ~0xC) | ((kk & 4) << 1) | ((kk & 8) >> 1), c = cblk * 32 + cl; voff[i] = (unsigned)(k * LDV * 2 + c * 2); }
    const __amdgpu_buffer_rsrc_t rK = __builtin_amdgcn_make_buffer_rsrc((void*)(Kg + tok0 * LDK + h * QKH), 0, -1, 0x00020000), rV = __builtin_amdgcn_make_buffer_rsrc((void*)(Vg + tok0 * LDV + h * VH), 0, -1, 0x00020000);
#define ATT_DMA(j, buf) do { \
        _Pragma("unroll") for (int i_ = 0; i_ < 3; ++i_) __builtin_amdgcn_raw_ptr_buffer_load_lds(rK, (LAS void*)(lds + L_K + (buf) * KT_BYTES + (wid + 8 * i_) * 1024), 16, koff[i_], (unsigned)(j) * (64u * LDK * 2u), 0, 0); \
        _Pragma("unroll") for (int i_ = 0; i_ < 2; ++i_) __builtin_amdgcn_raw_ptr_buffer_load_lds(rV, (LAS void*)(lds + L_V + (buf) * VT_BYTES + (wid + 8 * i_) * 1024), 16, voff[i_], (unsigned)(j) * (64u * LDV * 2u), 0, 0); } while (0)
#define ATT_BAR() do { asm volatile("" ::: "memory"); __builtin_amdgcn_s_barrier(); asm volatile("" ::: "memory"); } while (0)
    const int swz = (r32 >> 1) & 7; int kx[4];
#pragma unroll
    for (int dd = 0; dd < 4; ++dd) kx[dd] = r32 * (QKH * 2) + (((2 * dd + hi) ^ swz) << 4);
    LAS float* ws = (LAS float*)(lds + L_WS) + wid * 64; LAS float* li_l = ws; LAS float* al_l = ws + 32;
    const int vb0 = L_V + v_rd_base(lane);
    float m_reg = -1e30f, l_reg = 0.f; f32x16 o[4];
#pragma unroll
    for (int d = 0; d < 4; ++d)
#pragma unroll
        for (int r = 0; r < 16; ++r) o[d][r] = 0.f;
    const int NT = 4 * qb + 4, my_last = 4 * qb + (wid >> 1);
    ATT_DMA(0, 0); ATT_DMA(1, 1);
    asm volatile("s_waitcnt vmcnt(5)" ::: "memory"); ATT_BAR();
    if (grp == 1) ATT_BAR();
    int kb = 0, nb = 2;
    for (int j = 0; j < NT; ++j) {
        const bool live = (j <= my_last), more = (j + 2 < NT);
        f32x16 p0, p1;
        if (grp == 1 && more) ATT_DMA(j + 2, nb);
        if (live) {
            const LAS unsigned char* Ks = lds + L_K + kb * KT_BYTES;
#pragma unroll
            for (int r = 0; r < 16; ++r) { p0[r] = 0.f; p1[r] = 0.f; }
#pragma unroll
            for (int d0 = 0; d0 < 12; ++d0) {
                const bf16x8 b0 = *(const LAS bf16x8*)(Ks + kx[d0 & 3] + (d0 >> 2) * 128);
                const bf16x8 b1 = *(const LAS bf16x8*)(Ks + kx[d0 & 3] + (d0 >> 2) * 128 + 32 * QKH * 2);
                p0 = __builtin_amdgcn_mfma_f32_32x32x16_bf16(b0, qr[d0], p0, 0, 0, 0);
                p1 = __builtin_amdgcn_mfma_f32_32x32x16_bf16(b1, qr[d0], p1, 0, 0, 0);
            }
        }
        if (grp == 1) { if (j + 1 < NT) { if (more) asm volatile("s_waitcnt vmcnt(5)" ::: "memory"); else asm volatile("s_waitcnt vmcnt(0)" ::: "memory"); } }
        ATT_BAR();
        if (grp == 0 && more) ATT_DMA(j + 2, nb);
        if (live) {
            float pmax = p0[0];
#pragma unroll
            for (int r = 1; r < 16; ++r) pmax = fmaxf(pmax, p0[r]);
#pragma unroll
            for (int r = 0; r < 16; ++r) pmax = fmaxf(pmax, p1[r]);
            { auto rr = __builtin_amdgcn_permlane32_swap(__float_as_uint(pmax), __float_as_uint(pmax), false, false);
              pmax = fmaxf(__uint_as_float(rr[0]), __uint_as_float(rr[1])); }
            float mn, alpha;
            if (__builtin_expect(__all(pmax - m_reg <= THRL), 1)) { mn = m_reg; alpha = 1.f; }
            else { mn = fmaxf(m_reg, pmax); alpha = __builtin_amdgcn_exp2f(m_reg - mn); m_reg = mn; }
#pragma unroll
            for (int r = 0; r < 16; ++r) { p0[r] = __builtin_amdgcn_exp2f(p0[r] - mn); p1[r] = __builtin_amdgcn_exp2f(p1[r] - mn); }
            float ps = 0.f;
#pragma unroll
            for (int r = 0; r < 16; ++r) ps += p0[r];
#pragma unroll
            for (int r = 0; r < 16; ++r) ps += p1[r];
            { auto rr = __builtin_amdgcn_permlane32_swap(__float_as_uint(ps), __float_as_uint(ps), false, false);
              ps = __uint_as_float(rr[0]) + __uint_as_float(rr[1]); }
            l_reg = l_reg * alpha + ps;
            if (__any(alpha < 1.f)) { if (hi == 0) al_l[r32] = alpha; asm volatile("s_waitcnt lgkmcnt(0)" ::: "memory");
#pragma unroll
                for (int r = 0; r < 16; ++r) { const float a = al_l[crow(r, hi)];
#pragma unroll
                    for (int d = 0; d < 4; ++d) o[d][r] *= a; } }
            bf16x8 pa0, pa1, pa2, pa3;
#define PK4(P, BASE, OUT) do { unsigned a0 = cvt_pk_bf16(P[BASE + 0], P[BASE + 1]), a1 = cvt_pk_bf16(P[BASE + 2], P[BASE + 3]);   \
    unsigned b0_ = cvt_pk_bf16(P[BASE + 4], P[BASE + 5]), b1_ = cvt_pk_bf16(P[BASE + 6], P[BASE + 7]);                              \
    auto r0 = __builtin_amdgcn_permlane32_swap(a0, b0_, false, false); auto r1 = __builtin_amdgcn_permlane32_swap(a1, b1_, false, false); \
    u32x4 w = {r0[0], r1[0], r0[1], r1[1]}; OUT = __builtin_bit_cast(bf16x8, w); } while (0)
            PK4(p0, 0, pa0); PK4(p0, 8, pa1); PK4(p1, 0, pa2); PK4(p1, 8, pa3);
#undef PK4
            const int vb = vb0 + kb * VT_BYTES;
            pv_one<0>(o[0], vb, pa0, pa1, pa2, pa3); pv_one<1>(o[1], vb, pa0, pa1, pa2, pa3); pv_one<2>(o[2], vb, pa0, pa1, pa2, pa3); pv_one<3>(o[3], vb, pa0, pa1, pa2, pa3);
        }
        if (grp == 0) { if (j + 1 < NT) { if (more) asm volatile("s_waitcnt vmcnt(5)" ::: "memory"); else asm volatile("s_waitcnt vmcnt(0)" ::: "memory"); } }
        ATT_BAR();
        kb = (kb == 2) ? 0 : kb + 1; nb = (nb == 2) ? 0 : nb + 1;
    }
    if (grp == 0) ATT_BAR();
    if (hi == 0) li_l[r32] = l_reg; asm volatile("s_waitcnt lgkmcnt(0)" ::: "memory");
    bf16_t* Ow = O + (tok0 + (size_t)qb * 256 + wid * 32) * LDO + h * VH;
#pragma unroll
    for (int r = 0; r < 16; ++r) { const int orow = crow(r, hi); const float rl = __builtin_amdgcn_rcpf(li_l[orow]);
#pragma unroll
        for (int d0 = 0; d0 < 4; ++d0) Ow[(size_t)orow * LDO + d0 * 32 + r32] = (bf16_t)f2bf(o[d0][r] * rl); }
    asm volatile("s_waitcnt lgkmcnt(0)" ::: "memory"); ATT_BAR();
#undef ATT_DMA
#undef ATT_BAR
}
#undef SBAR
}

#define XB_TMO      128
#define XB_XCNT(j)  (256  + 64 * (j))
#define XB_XSUB(j)  (1280 + 64 * (j))
#define XB_XGEN(j)  (2304 + 64 * (j))
#define XB_TOP      3328
#define XB_TOPGEN   3392
#define XCD_BAR_WORDS 3456
#define XB_SPIN_CAP (1u << 18)
__device__ __forceinline__ unsigned xb_ld(unsigned* p)              { return __hip_atomic_load(p, __ATOMIC_RELAXED, __HIP_MEMORY_SCOPE_AGENT); }
__device__ __forceinline__ unsigned xb_add(unsigned* p, unsigned v) { return __hip_atomic_fetch_add(p, v, __ATOMIC_RELAXED, __HIP_MEMORY_SCOPE_AGENT); }
__device__ __forceinline__ unsigned xb_xcc_id() { return (unsigned)__builtin_amdgcn_s_getreg((3 << 11) | 20) & 0xFu; }
#define XB_SPIN(cond, bar) do { unsigned _sp = 0; while (cond) { __builtin_amdgcn_s_sleep(1); \
    if ((++_sp & 255u) == 0u) { if (xb_ld(&(bar)[XB_TMO])) break; if (_sp > XB_SPIN_CAP) { atomicAdd(&(bar)[XB_TMO], 1u); break; } } } } while (0)
struct XcdBarrier { unsigned* bar; unsigned x; volatile LAS unsigned* st; };
__device__ __forceinline__ XcdBarrier xcd_barrier_post(unsigned* bar, volatile LAS unsigned* st) {
    XcdBarrier b; b.bar = bar; b.x = xb_xcc_id(); b.st = st;
    if (threadIdx.x == 0) (void)xb_add(&bar[XB_XCNT(b.x)], 1u);
    return b;
}
__device__ __forceinline__ void xcd_barrier_complete(unsigned* bar, unsigned x, unsigned& nloc, unsigned& nx) {
    const unsigned G = gridDim.x * gridDim.y * gridDim.z;
    unsigned sum, cnt, mine, sp = 0u;
    for (;;) {
        sum = 0u; cnt = 0u; mine = 0u;
#pragma unroll
        for (unsigned j = 0; j < 16; ++j) { const unsigned c = xb_ld(&bar[XB_XCNT(j)]); sum += c; cnt += (c > 0u) ? 1u : 0u; mine = (j == x) ? c : mine; }
        if (sum == G) break;
        __builtin_amdgcn_s_sleep(1);
        if ((++sp & 255u) == 0u) { if (xb_ld(&bar[XB_TMO])) break; if (sp > XB_SPIN_CAP) { atomicAdd(&bar[XB_TMO], 1u); break; } }
    }
    nloc = mine > 0u ? mine : 1u; nx = cnt > 0u ? cnt : 1u;
}
__device__ __forceinline__ void xcd_barrier(const XcdBarrier& b) {
    asm volatile("s_waitcnt vmcnt(0)" ::: "memory");
    __syncthreads();
    if (threadIdx.x == 0) {
        unsigned* bar = b.bar;
        __builtin_amdgcn_s_waitcnt(0);
        unsigned nloc = b.st[0], nx = b.st[1];
        if (nloc == 0u) { xcd_barrier_complete(bar, b.x, nloc, nx); b.st[0] = nloc; b.st[1] = nx; }
        const unsigned old = xb_add(&bar[XB_XSUB(b.x)], 1u);
        const unsigned gen = old / nloc;
        if (old + 1u == (gen + 1u) * nloc) {
            __builtin_amdgcn_fence(__ATOMIC_RELEASE, "agent");
            asm volatile("s_waitcnt vmcnt(0)" ::: "memory");
            const unsigned og = xb_add(&bar[XB_TOP], 1u);
            const unsigned tg = og / nx;
            if (og + 1u == (tg + 1u) * nx) xb_add(&bar[XB_TOPGEN], 1u);
            else XB_SPIN(xb_ld(&bar[XB_TOPGEN]) == tg, bar);
            __builtin_amdgcn_fence(__ATOMIC_ACQUIRE, "agent");
            xb_add(&bar[XB_XGEN(b.x)], 1u);
            asm volatile("s_waitcnt vmcnt(0)" ::: "memory");
        } else {
            XB_SPIN(xb_ld(&bar[XB_XGEN(b.x)]) == gen, bar);
            __builtin_amdgcn_fence(__ATOMIC_ACQUIRE, "agent");
            asm volatile("s_waitcnt vmcnt(0)" ::: "memory");
        }
    }
    __syncthreads();
}

constexpr int NWAVES = 8;
constexpr int N_LAUNCHES = MK_N_LAUNCHES;
constexpr int N_PHASES = 10;
struct Args { const float* in[18]; float* out; unsigned char* ws; int ph_lo, ph_hi; };

__device__ __forceinline__ void p0_transpose_item(const float* W, int K, int N, bf16_t* WT, int drow0, const float* kscale, LAS unsigned* scr, int k0, int n0, int lane, bool ileave = false) {
    const int g = lane >> 4, l16 = lane & 15;
    f32x4 v[16];
#pragma unroll
    for (int i = 0; i < 16; ++i) { const int kk = (i >> 1) * 8 + g * 2 + (i & 1); v[i] = __builtin_nontemporal_load((const f32x4*)(W + (size_t)(k0 + kk) * N + n0 + 4 * l16)); }
    if (kscale) {
#pragma unroll
        for (int i = 0; i < 16; ++i) { const int kk = (i >> 1) * 8 + g * 2 + (i & 1); v[i] = v[i] * kscale[k0 + kk]; } }
#pragma unroll
    for (int j = 0; j < 8; ++j) { const int kp = j * 4 + g;
#pragma unroll
        for (int c = 0; c < 4; ++c) scr[(4 * l16 + c) * 33 + kp] = cvt_pk_bf16(v[2 * j][c], v[2 * j + 1][c]); }
    LDS_WAIT(); asm volatile("" ::: "memory");
    const int c8 = lane & 7;
#pragma unroll
    for (int jj = 0; jj < 8; ++jj) { const int n = jj * 8 + (lane >> 3); const LAS unsigned* t = scr + n * 33 + 4 * c8;
        u32x4 o; o.x = t[0]; o.y = t[1]; o.z = t[2]; o.w = t[3];
        const int dn = ileave ? ((n < 32) ? 2 * n : 2 * (n - 32) + 1) : n;
        *(u32x4*)(WT + (size_t)(drow0 + dn) * K + k0 + 8 * c8) = o; }
    LDS_WAIT(); asm volatile("" ::: "memory");
}

__device__ __forceinline__ void p0_transpose_item8(const float* W, int K, int N, unsigned char* WT, int drow0, const float* kscale, LAS unsigned* scr, int k0, int n0, int lane) {
    const int g = lane >> 4, l16 = lane & 15;
    f32x4 v[32];
#pragma unroll
    for (int i = 0; i < 32; ++i) { const int kk = (i >> 2) * 16 + g * 4 + (i & 3); v[i] = __builtin_nontemporal_load((const f32x4*)(W + (size_t)(k0 + kk) * N + n0 + 4 * l16)); }
#pragma unroll
    for (int i = 0; i < 32; ++i) { const int kk = (i >> 2) * 16 + g * 4 + (i & 3); v[i] = v[i] * (kscale ? kscale[k0 + kk] * W8_SCALE : W8_SCALE); }
#pragma unroll
    for (int j = 0; j < 8; ++j) { const int kd = j * 4 + g;
#pragma unroll
        for (int c = 0; c < 4; ++c) scr[(4 * l16 + c) * 33 + kd] = pk4_fp8(v[4 * j][c], v[4 * j + 1][c], v[4 * j + 2][c], v[4 * j + 3][c]); }
    LDS_WAIT(); asm volatile("" ::: "memory");
    const int c8 = lane & 7;
#pragma unroll
    for (int jj = 0; jj < 8; ++jj) { const int n = jj * 8 + (lane >> 3); const LAS unsigned* t = scr + n * 33 + 4 * c8;
        u32x4 o; o.x = t[0]; o.y = t[1]; o.z = t[2]; o.w = t[3];
        *(u32x4*)(WT + (size_t)(drow0 + n) * K + k0 + 16 * c8) = o; }
    LDS_WAIT(); asm volatile("" ::: "memory");
}

template <int PHMASK> __global__ void __launch_bounds__(NWAVES * 64, 2) fwd_kernel_t(Args args) {
    extern __shared__ __attribute__((aligned(16))) unsigned char lds_raw[];
    LAS unsigned char* lds = (LAS unsigned char*)lds_raw;
    volatile LAS unsigned* MISC = (volatile LAS unsigned*)(lds + MISC_OFF);
    const int tid = threadIdx.x, lane = tid & 63, wave = __builtin_amdgcn_readfirstlane(tid >> 6);
    const int G = gridDim.x; const int bx = blockIdx.x; const int vcu = (G % 8 == 0) ? (bx % 8) * (G / 8) + bx / 8 : bx;
    unsigned char* ws = args.ws;
    unsigned* ctl = (unsigned*)(ws + WS_CTL);
    const float* x = args.in[0]; const float* norm_mix = args.in[1]; const float* w_in = args.in[2]; const float* conv_w = args.in[3];
    const float* q_norm = args.in[4]; const float* w_uq = args.in[5]; const float* kv_norm = args.in[6]; const float* w_ukv = args.in[7];
    const float* q_head_norm = args.in[8]; const float* k_head_norm = args.in[9]; const float* w_o = args.in[10]; const float* norm_ffn = args.in[11];
    const float* w_router = args.in[12]; const float* b_router = args.in[13]; const float* w_gate_up = args.in[14]; const float* b_gate_up = args.in[15];
    const float* w_down = args.in[16]; const float* b_down = args.in[17];
    float* out = args.out;
    f32x2* rope_t = (f32x2*)(ws + WS_ROPE);
    bf16_t* WrH = (bf16_t*)(ws + WS_WRH); bf16_t* WrL = (bf16_t*)(ws + WS_WRL);
    bf16_t* Win_t = (bf16_t*)(ws + WS_WIN); bf16_t* Wuq_t = (bf16_t*)(ws + WS_WUQ); bf16_t* Wukv_t = (bf16_t*)(ws + WS_WUKV); bf16_t* Wo_t = (bf16_t*)(ws + WS_WO);
    float* ssq = (float*)(ws + WS_SSQ); float* rs2 = (float*)(ws + WS_RS2); float* gate = (float*)(ws + WS_GATE); int* tos = (int*)(ws + WS_TOS);
    unsigned char* Wgu_t = ws + WS_WGU; unsigned char* Wdn_t = ws + WS_WDN;
    unsigned char* hq = ws + WS_HB;
    bf16_t* qb_ = (bf16_t*)(ws + WS_Q); bf16_t* kb_ = (bf16_t*)(ws + WS_K); bf16_t* vb_ = (bf16_t*)(ws + WS_V); bf16_t* mix = (bf16_t*)(ws + WS_MIX);
    bf16_t* oslot = (bf16_t*)(ws + WS_OSLOT); bf16_t* hn = (bf16_t*)(ws + WS_HN); bf16_t* pbuf = (bf16_t*)(ws + WS_PB); bf16_t* qraw = (bf16_t*)(ws + WS_QRAW); bf16_t* kvraw = (bf16_t*)(ws + WS_KVRAW);
    unsigned char* act = ws + WS_ACT;

    for (int u = tid; u < (LDS_BYTES - MISC_OFF) / 4; u += NWAVES * 64) ((LAS unsigned*)(lds + MISC_OFF))[u] = 0u;
    __syncthreads();
    XcdBarrier bar; bar.bar = ctl + CW_BAR; bar.x = 0; bar.st = nullptr;
    if (N_LAUNCHES == 1) bar = xcd_barrier_post(ctl + CW_BAR, MISC + 8);
#define GRID_BAR() do { if (N_LAUNCHES == 1) xcd_barrier(bar); } while (0)
    const int lo = args.ph_lo, hi = args.ph_hi;
#define IN(k) (((PHMASK >> (k)) & 1) && lo <= (k) && (k) < hi)
#define BOTH(k) (IN(k) && IN((k) + 1))
    const int gw = vcu * NWAVES + wave, NGW = G * NWAVES;

    if (IN(0)) {
        LAS unsigned* scr = (LAS unsigned*)(lds + wave * 16384);
        constexpr int I_IN = (DM / 64) * (NPROJ / 64), I_UQ = (QL / 64) * (768 / 64), I_UKV = (KVL / 64) * (1024 / 64), I_O = (DM / 64) * (DM / 64);
        constexpr int I_GU1 = (DM / 128) * (2 * DFF / 64), I_GU = NE * I_GU1, I_DN1 = (DFF / 128) * (DM / 64), I_DN = NE * I_DN1;
        constexpr int NITEMS = I_IN + I_UQ + I_UKV + I_O + I_GU + I_DN;
        for (int it = gw; it < NITEMS; it += NGW) {
            int r = it;
            if (r < I_GU) { const int e = r / I_GU1, q = r % I_GU1, nblk = 2 * DFF / 64, kb = q / nblk, nb = q % nblk, n0 = nb * 64, j = n0 & (DFF - 1), up = n0 >= DFF;
                p0_transpose_item8(w_gate_up + (size_t)e * DM * 2 * DFF, DM, 2 * DFF, Wgu_t + (size_t)e * 2 * DFF * DM, (j >> 7) * 256 + (j & 127) + (up ? 128 : 0), norm_ffn, scr, kb * 128, n0, lane); continue; } r -= I_GU;
            if (r < I_DN) { const int e = r / I_DN1, q = r % I_DN1, nblk = DM / 64, kb = q / nblk, nb = q % nblk;
                p0_transpose_item8(w_down + (size_t)e * DFF * DM, DFF, DM, Wdn_t + (size_t)e * DM * DFF, nb * 64, nullptr, scr, kb * 128, nb * 64, lane); continue; } r -= I_DN;
            if (r < I_IN) { const int nblk = NPROJ / 64, kb = r / nblk, nb = r % nblk, n0 = nb * 64;
                const int d0 = (n0 < 1536) ? n0 : (n0 < 1920 ? n0 + (PB_CQ - 1536) : (n0 < 2176 ? n0 - (1920 - PB_CKV) : n0));
                p0_transpose_item(w_in, DM, NPROJ, Win_t, d0, nullptr, scr, kb * 64, n0, lane); continue; } r -= I_IN;
            if (r < I_UQ) { const int nblk = 768 / 64, kb = r / nblk, nb = r % nblk, h = nb / 3, part = nb % 3;
                p0_transpose_item(w_uq, QL, 768, Wuq_t, h * 256 + part * 64, q_norm, scr, kb * 64, nb * 64, lane, part == 2); continue; } r -= I_UQ;
            if (r < I_UKV) { const int nblk = 1024 / 64, kb = r / nblk, nb = r % nblk; p0_transpose_item(w_ukv, KVL, 1024, Wukv_t, nb * 64, kv_norm, scr, kb * 64, nb * 64, lane); continue; } r -= I_UKV;
            { const int nblk = DM / 64, kb = r / nblk, nb = r % nblk; p0_transpose_item(w_o, DM, DM, Wo_t, nb * 64, nullptr, scr, kb * 64, nb * 64, lane); }
        }
        const int gt = vcu * (NWAVES * 64) + tid, NGT = G * NWAVES * 64;
        for (int i = gt; i < (NPP - NPROJ) * DM / 8; i += NGT) *(u32x4*)(Win_t + (size_t)NPROJ * DM + (size_t)i * 8) = (u32x4){0u, 0u, 0u, 0u};
        for (int i = gt; i < NH * 64 * QL / 8; i += NGT) { const int h = i / (64 * QL / 8), j = i % (64 * QL / 8); *(u32x4*)(Wuq_t + (size_t)(h * 256 + 192) * QL + (size_t)j * 8) = (u32x4){0u, 0u, 0u, 0u}; }
        for (int i = gt; i < NE * DM; i += NGT) { const int e = i / DM, k = i % DM; const float v = w_router[(size_t)k * NE + e] * norm_ffn[k]; const unsigned h = f2bf(v); const float hf = __builtin_bit_cast(float, h << 16);
            WrH[i] = (bf16_t)h; WrL[i] = (bf16_t)f2bf(v - hf); }
        for (int i = gt; i < SEQ * 32; i += NGT) { const int pos = i >> 5, fi = i & 31; const float inv = exp2f(-(float)fi * (13.287712379549449f / 32.f)); const float ang = (float)pos * inv; float s, c; sincosf(ang, &s, &c); rope_t[i] = (f32x2){c, s}; }
        for (int m = 2 * gw; m < NTOK; m += 2 * NGW) {
            const f32x4* xr = (const f32x4*)(x + (size_t)m * DM) + lane; const f32x4* gr = (const f32x4*)norm_mix + lane;
            f32x4 v[2][4]; float s0 = 0.f, s1 = 0.f;
#pragma unroll
            for (int j = 0; j < 4; ++j) { v[0][j] = __builtin_nontemporal_load(xr + 64 * j); v[1][j] = __builtin_nontemporal_load(xr + DM / 4 + 64 * j); }
#pragma unroll
            for (int j = 0; j < 4; ++j) { s0 += (v[0][j].x * v[0][j].x + v[0][j].y * v[0][j].y) + (v[0][j].z * v[0][j].z + v[0][j].w * v[0][j].w);
                                          s1 += (v[1][j].x * v[1][j].x + v[1][j].y * v[1][j].y) + (v[1][j].z * v[1][j].z + v[1][j].w * v[1][j].w); }
            const float r0 = 1.0f / sqrtf(wave_sum(s0) * (1.f / DM) + EPS), r1 = 1.0f / sqrtf(wave_sum(s1) * (1.f / DM) + EPS);
            u32x2* o8 = (u32x2*)(hn + (size_t)m * DM) + lane;
#pragma unroll
            for (int j = 0; j < 4; ++j) { const f32x4 g = gr[64 * j]; u32x2 w;
                w.x = cvt_pk_bf16(v[0][j].x * r0 * g.x, v[0][j].y * r0 * g.y); w.y = cvt_pk_bf16(v[0][j].z * r0 * g.z, v[0][j].w * r0 * g.w); o8[64 * j] = w;
                w.x = cvt_pk_bf16(v[1][j].x * r1 * g.x, v[1][j].y * r1 * g.y); w.y = cvt_pk_bf16(v[1][j].z * r1 * g.z, v[1][j].w * r1 * g.w); o8[DM / 4 + 64 * j] = w; }
        }
        if (BOTH(0)) GRID_BAR();
    }

    if (IN(1)) {
        pg8::DenseSched S; S.init(hn, DM, Win_t, NTOK, NPP, DM, G, bx);
        pg8::EpiProj E{pbuf, ssq};
        pg8::gemm_phase<pg8::EpiProj, pg8::DenseSched, false>(lds, S, E);
        if (BOTH(1)) GRID_BAR();
    }

    const bool p2_all = IN(2);
    if (p2_all || IN(13)) {
        {
            const int gt = vcu * (NWAVES * 64) + tid, NGT = G * NWAVES * 64;
            for (int it = gt; it < (NTOK / 16) * 64; it += NGT) {
                const int run = it >> 6, gr = it & 63, t0 = run * 16, ch = gr * 8;
                float w0[8], w1[8], w2[8];
#pragma unroll
                for (int i = 0; i < 8; ++i) { w0[i] = conv_w[ch + i]; w1[i] = conv_w[CONVW + ch + i]; w2[i] = conv_w[2 * CONVW + ch + i]; }
                float um2[8], um1[8];
#pragma unroll
                for (int i = 0; i < 8; ++i) { um2[i] = 0.f; um1[i] = 0.f; }
                if ((t0 & (SEQ - 1)) != 0) {
                    float c8[8], x8[8];
                    unpack8(*(const u32x4*)(pbuf + (size_t)(t0 - 2) * NPP + PB_C + ch), c8); unpack8(*(const u32x4*)(pbuf + (size_t)(t0 - 2) * NPP + PB_X + ch), x8);
#pragma unroll
                    for (int i = 0; i < 8; ++i) um2[i] = c8[i] * x8[i];
                    unpack8(*(const u32x4*)(pbuf + (size_t)(t0 - 1) * NPP + PB_C + ch), c8); unpack8(*(const u32x4*)(pbuf + (size_t)(t0 - 1) * NPP + PB_X + ch), x8);
#pragma unroll
                    for (int i = 0; i < 8; ++i) um1[i] = c8[i] * x8[i];
                }
#pragma unroll 4
                for (int t = 0; t < 16; ++t) {
                    const bf16_t* pr = pbuf + (size_t)(t0 + t) * NPP + ch;
                    float b8[8], c8[8], x8[8], o8[8];
                    unpack8(__builtin_nontemporal_load((const u32x4*)(pr + PB_B)), b8); unpack8(__builtin_nontemporal_load((const u32x4*)(pr + PB_C)), c8); unpack8(__builtin_nontemporal_load((const u32x4*)(pr + PB_X)), x8);
#pragma unroll
                    for (int i = 0; i < 8; ++i) { const float uu = c8[i] * x8[i]; o8[i] = b8[i] * (w0[i] * um2[i] + w1[i] * um1[i] + w2[i] * uu); um2[i] = um1[i]; um1[i] = uu; }
                    *(u32x4*)(mix + (size_t)(t0 + t) * DM + ch) = pack8(o8);
                }
            }
        }
    }
    if (p2_all || IN(14) || IN(15)) {
        LAS float* etab = (LAS float*)(lds + EPI_TAB_OFF);
        if (p2_all || IN(14)) { pg8::DenseSched S; S.init(pbuf + PB_CQ, NPP, Wuq_t, NTOK, NQP, QL, G, bx); pg8::EpiQ E{qb_, ssq, q_head_norm, rope_t, etab};
          pg8::gemm_phase<pg8::EpiQ, pg8::DenseSched, false>(lds, S, E); }
        if (p2_all || IN(15)) { pg8::DenseSched S; S.init(pbuf + PB_CKV, NPP, Wukv_t, NTOK, 1024, KVL, G, bx); pg8::EpiKV E{kb_, vb_, ssq, k_head_norm, rope_t, pbuf, etab};
          pg8::gemm_phase<pg8::EpiKV, pg8::DenseSched, false>(lds, S, E); }
        if (BOTH(2)) GRID_BAR();
    }


    if (IN(4)) {
        for (int u = vcu; u < NB * NH * 4; u += G) {
            const int bh = u >> 2, pr = u & 3, b = bh >> 2, h = bh & 3;
            att::attn_unit(b, h, 7 - pr, qb_, kb_, vb_, mix + CONVW, lds);
            att::attn_unit(b, h, pr, qb_, kb_, vb_, mix + CONVW, lds);
        }
        if (BOTH(4)) GRID_BAR();
    }

    if (IN(5)) {
        pg8::DenseSched S; S.init(mix, DM, Wo_t, NTOK, DM, DM, G, bx);
        pg8::EpiOut E{x, (bf16_t*)(ws + WS_H1B), ssq};
        pg8::gemm_phase<pg8::EpiOut, pg8::DenseSched, false>(lds, S, E);
        if (BOTH(5)) GRID_BAR();
    }

    if (IN(6) || IN(16)) {
        const bool dry = !IN(6);
        LAS unsigned* hist = (LAS unsigned*)(lds + MISC_OFF) + 128; LAS unsigned* base = (LAS unsigned*)(lds + MISC_OFF) + 160;
        const int tj = lane & 15, q = lane >> 4;
        for (int i = tid; i < 2 * NE * 128; i += NWAVES * 64) { const int sel = i >> 12, r = (i >> 7) & 31, g = i & 127;
            const u32x4 v = *(const u32x4*)((sel ? WrL : WrH) + (size_t)r * DM + g * 8);
            *(LAS u32x4*)(lds + sel * 65536 + r * 2048 + ((g ^ (r & 15)) << 4)) = v; }
        __syncthreads();
        for (int tile = vcu; tile < NTOK / 128; tile += G) {
            if (tid < 32) hist[tid] = 0u;
            __syncthreads();
            const int token = tile * 128 + wave * 16 + tj;
            const bf16_t* hrow = (const bf16_t*)(ws + WS_H1B) + (size_t)token * DM + q * 8;
            f32x4 a0 = {0.f, 0.f, 0.f, 0.f}, a1 = {0.f, 0.f, 0.f, 0.f};
            float s2 = 0.f;
#pragma unroll
            for (int p = 0; p < 16; ++p) s2 += ssq[(size_t)p * NTOK + token];
            const float rs = 1.0f / sqrtf(s2 * (1.f / DM) + EPS);
            unsigned char* hqrow = hq + (size_t)token * DM + q * 8;
            const LAS unsigned char* wlds = lds + tj * 2048;
#pragma unroll 1
            for (int kh = 0; kh < 2; ++kh) {
                u32x4 hv[16];
#pragma unroll
                for (int kk = 0; kk < 16; ++kk) hv[kk] = *(const u32x4*)(hrow + (kh * 16 + kk) * 32);
#pragma unroll
                for (int kk = 0; kk < 16; ++kk) { const int ks = kh * 16 + kk;
                    const u32x4 hw = hv[kk]; float hf[8]; unpack8(hw, hf);
                    { u32x2 w8; w8.x = pk4_fp8(hf[0] * rs, hf[1] * rs, hf[2] * rs, hf[3] * rs); w8.y = pk4_fp8(hf[4] * rs, hf[5] * rs, hf[6] * rs, hf[7] * rs); *(u32x2*)(hqrow + ks * 32) = w8; }
                    const bf16x8 bh = __builtin_bit_cast(bf16x8, hw);
                    const int go = (((ks * 4 + q) ^ tj) << 4);
                    const bf16x8 wh_a = *(const LAS bf16x8*)(wlds + go), wh_b = *(const LAS bf16x8*)(wlds + 16 * 2048 + go);
                    const bf16x8 wl_a = *(const LAS bf16x8*)(wlds + 65536 + go), wl_b = *(const LAS bf16x8*)(wlds + 65536 + 16 * 2048 + go);
                    a0 = __builtin_amdgcn_mfma_f32_16x16x32_bf16(wh_a, bh, a0, 0, 0, 0); a0 = __builtin_amdgcn_mfma_f32_16x16x32_bf16(wl_a, bh, a0, 0, 0, 0);
                    a1 = __builtin_amdgcn_mfma_f32_16x16x32_bf16(wh_b, bh, a1, 0, 0, 0); a1 = __builtin_amdgcn_mfma_f32_16x16x32_bf16(wl_b, bh, a1, 0, 0, 0);
                }
            }
            float lv[8]; int le[8];
#pragma unroll
            for (int i = 0; i < 4; ++i) { le[i] = 4 * q + i; le[4 + i] = 16 + 4 * q + i; lv[i] = a0[i] * rs + b_router[le[i]]; lv[4 + i] = a1[i] * rs + b_router[le[4 + i]]; }
            float tv[4]; int te[4];
#pragma unroll
            for (int k = 0; k < TOPK; ++k) {
                float bv = lv[0]; int be = le[0];
#pragma unroll
                for (int i = 1; i < 8; ++i) if (lv[i] > bv) { bv = lv[i]; be = le[i]; }
#pragma unroll
                for (int o = 16; o < 64; o <<= 1) { const float ov = __shfl_xor(bv, o); const int oe = __shfl_xor(be, o); if (ov > bv || (ov == bv && oe < be)) { bv = ov; be = oe; } }
                tv[k] = bv; te[k] = be;
#pragma unroll
                for (int i = 0; i < 8; ++i) if (le[i] == be) lv[i] = -3.0e38f;
            }
            float ge[4]; float gs = 0.f;
#pragma unroll
            for (int k = 0; k < TOPK; ++k) { ge[k] = __expf(tv[k] - tv[0]); gs += ge[k]; }
            const float ginv = 1.0f / gs;
            int my_e = te[0]; float my_g = ge[0];
#pragma unroll
            for (int k = 1; k < TOPK; ++k) if (q == k) { my_e = te[k]; my_g = ge[k]; }
            my_g *= ginv;
            const unsigned pl = atomicAdd((unsigned*)(hist + my_e), 1u);
            __syncthreads();
            if (tid < 32) base[tid] = dry ? 0u : __hip_atomic_fetch_add(ctl + CW_CNT + 64 * tid, hist[tid], __ATOMIC_RELAXED, __HIP_MEMORY_SCOPE_AGENT);
            __syncthreads();
            const unsigned pos = base[my_e] + pl; const int slot = token * 4 + q;
            if (!dry) *(u32x2*)(tos + ((size_t)my_e * CAP + pos) * 2) = (u32x2){(unsigned)slot, __builtin_bit_cast(unsigned, my_g)};
            else if (my_g < -1.f) rs2[token] = my_g;
            __syncthreads();
        }
        if (BOTH(6)) GRID_BAR();
    }

    LAS int* tab = (LAS int*)(lds + MISC_OFF) + 16;
    if (IN(7) || IN(8) || IN(10) || IN(11) || IN(12)) {
        if (tid < 32) { const int c = (int)__hip_atomic_load(ctl + CW_CNT + 64 * tid, __ATOMIC_RELAXED, __HIP_MEMORY_SCOPE_AGENT); tab[48 + tid] = c; }
        __syncthreads();
        if (tid == 0) { int s = 0; for (int e = 0; e < NE; ++e) { tab[e] = s; s += (tab[48 + e] + 255) >> 8; } tab[32] = s; }
        __syncthreads();
        for (int t = tid; t < tab[32]; t += NWAVES * 64) { int e = 0; while (e < NE - 1 && tab[e + 1] <= t) ++e; tab[2288 + t] = e; }
        __syncthreads();
    }

    if (IN(7)) {
        pg8::MoeSched S{hq, Wgu_t, DM, DM, 2 * DFF / 256, G, bx, (size_t)2 * DFF * DM, tab, tos, b_gate_up};
        pg8::EpiSwiglu E{act, b_gate_up};
        pg8::gemm_phase<pg8::EpiSwiglu, pg8::MoeSched, true>(lds, S, E);
        if (BOTH(7)) GRID_BAR();
    }

    if (IN(8)) {
        pg8::MoeSched S{act, Wdn_t, DFF, DFF, DM / 256, G, bx, (size_t)DM * DFF, tab, tos, b_down};
        pg8::EpiDown E{(unsigned char*)oslot, b_down, ws + WS_SSQ, lds};
        pg8::gemm_phase<pg8::EpiDown, pg8::MoeSched, false>(lds, S, E);
        if (BOTH(8)) GRID_BAR();
    }

#if PROBE_DOUBLE
    if (IN(10)) { pg8::MoeSched S{hq, Wgu_t, DM, DM, 2 * DFF / 256, G, bx, (size_t)2 * DFF * DM, tab, tos, b_gate_up}; pg8::EpiNull E{(float*)(ws + WS_SSQ)};
        pg8::gemm_phase<pg8::EpiNull, pg8::MoeSched, true>(lds, S, E); }
    if (IN(11)) { pg8::MoeSched S{act, Wdn_t, DFF, DFF, DM / 256, G, bx, (size_t)DM * DFF, tab, tos, b_down}; pg8::EpiNull E{(float*)(ws + WS_SSQ)};
        pg8::gemm_phase<pg8::EpiNull, pg8::MoeSched, false, 2>(lds, S, E); }
    if (IN(12)) { pg8::MoeSched S{act, Wdn_t, DFF, DFF, DM / 256, G, bx, (size_t)DM * DFF, tab, tos, b_down}; pg8::EpiNull E{(float*)(ws + WS_SSQ)};
        pg8::gemm_phase<pg8::EpiNull, pg8::MoeSched, false>(lds, S, E); }
#endif
    if (IN(9)) {
        const unsigned char* os8 = (const unsigned char*)oslot;
        constexpr float OI = 1.f / OS8_SCALE;
        for (int m = gw; m < NTOK; m += NGW) {
            f32x4* orow = (f32x4*)(out + (size_t)m * DM) + lane;
            const u32x2* hrow = (const u32x2*)((const bf16_t*)(ws + WS_H1B) + (size_t)m * DM) + lane;
            const unsigned* s0 = (const unsigned*)(os8 + (size_t)m * 4 * DM) + lane;
            unsigned w[4][4]; f32x4 hv[4];
#pragma unroll
            for (int j = 0; j < 4; ++j) { const u32x2 hb2 = __builtin_nontemporal_load(hrow + 64 * j); hv[j] = (f32x4){bf_lo(hb2.x), bf_hi(hb2.x), bf_lo(hb2.y), bf_hi(hb2.y)};
#pragma unroll
                for (int k = 0; k < 4; ++k) w[j][k] = __builtin_nontemporal_load(s0 + (size_t)k * (DM / 4) + 64 * j); }
#pragma unroll
            for (int j = 0; j < 4; ++j) { f32x4 a = {0.f, 0.f, 0.f, 0.f};
#pragma unroll
                for (int k = 0; k < 4; ++k) { const f32x2 lo = __builtin_amdgcn_cvt_pk_f32_fp8(w[j][k], false), hi2 = __builtin_amdgcn_cvt_pk_f32_fp8(w[j][k], true); a.x += lo.x; a.y += lo.y; a.z += hi2.x; a.w += hi2.y; }
                __builtin_nontemporal_store(hv[j] + a * OI, orow + 64 * j); }
        }
    }
#undef IN
#undef BOTH
#undef GRID_BAR
}

#ifdef DIAG_PHASES
template __global__ void fwd_kernel_t<1>(Args); template __global__ void fwd_kernel_t<2>(Args); template __global__ void fwd_kernel_t<4>(Args); template __global__ void fwd_kernel_t<8>(Args);
template __global__ void fwd_kernel_t<16>(Args); template __global__ void fwd_kernel_t<32>(Args); template __global__ void fwd_kernel_t<64>(Args); template __global__ void fwd_kernel_t<128>(Args);
template __global__ void fwd_kernel_t<256>(Args); template __global__ void fwd_kernel_t<512>(Args);
#endif
#define fwd_kernel fwd_kernel_t<(PROBE_DOUBLE ? 0x1ffff : 1023)>
extern "C" void kernel_launch(void* const* d_in, const int* in_sizes, int n_in, void* d_out, int out_size, void* d_ws, size_t ws_size, hipStream_t stream) {
    static int grid = 0;
    if (grid == 0) {
        if (n_in != 18 || in_sizes[0] != NTOK * DM || out_size != NTOK * DM || ws_size < WS_END) { fprintf(stderr, "kernel_launch: shape/workspace mismatch (n_in %d, in0 %d, out %d, ws %zu, need %zu)\n", n_in, n_in > 0 ? in_sizes[0] : -1, out_size, ws_size, (size_t)WS_END); grid = -1; return; }
        int dev = 0, cus = 0, per_cu = 0;
        if (hipGetDevice(&dev) != hipSuccess || hipDeviceGetAttribute(&cus, hipDeviceAttributeMultiprocessorCount, dev) != hipSuccess) { grid = -1; return; }
        if (hipFuncSetAttribute((const void*)fwd_kernel, hipFuncAttributeMaxDynamicSharedMemorySize, LDS_BYTES) != hipSuccess) { fprintf(stderr, "kernel_launch: hipFuncSetAttribute failed\n"); grid = -1; return; }
        if (hipOccupancyMaxActiveBlocksPerMultiprocessor(&per_cu, (const void*)fwd_kernel, NWAVES * 64, LDS_BYTES) != hipSuccess || per_cu < 1) { fprintf(stderr, "kernel_launch: occupancy query says %d\n", per_cu); }
        (void)hipGetLastError();
        grid = cus;
    }
    if (grid < 0) return;
    if (hipMemsetAsync((char*)d_ws + WS_CTL, 0, CTL_ZERO_BYTES, stream) != hipSuccess) return;
    Args a{};
    for (int i = 0; i < 18; ++i) a.in[i] = (const float*)d_in[i];
    a.out = (float*)d_out; a.ws = (unsigned char*)d_ws;
    if (N_LAUNCHES == 1) { a.ph_lo = 0; a.ph_hi = N_PHASES; hipLaunchKernelGGL(fwd_kernel, dim3(grid), dim3(NWAVES * 64), LDS_BYTES, stream, a); }
    else { for (int p = 0; p < N_PHASES; ++p) { a.ph_lo = p; a.ph_hi = p + 1; const int reps = ((PROBE_DOUBLE >> p) & 1) ? 2 : 1;
            for (int r = 0; r < reps; ++r) hipLaunchKernelGGL(fwd_kernel, dim3(grid), dim3(NWAVES * 64), LDS_BYTES, stream, a);
            if (p == 8) for (int pp = 10; pp < 13; ++pp) if ((PROBE_DOUBLE >> pp) & 1) { a.ph_lo = pp; a.ph_hi = pp + 1; hipLaunchKernelGGL(fwd_kernel, dim3(grid), dim3(NWAVES * 64), LDS_BYTES, stream, a); }
            if (p == 6 && ((PROBE_DOUBLE >> 16) & 1)) { a.ph_lo = 16; a.ph_hi = 17; hipLaunchKernelGGL(fwd_kernel, dim3(grid), dim3(NWAVES * 64), LDS_BYTES, stream, a); }
            if (p == 2) for (int pp = 13; pp < 16; ++pp) if ((PROBE_DOUBLE >> pp) & 1) { a.ph_lo = pp; a.ph_hi = pp + 1; hipLaunchKernelGGL(fwd_kernel, dim3(grid), dim3(NWAVES * 64), LDS_BYTES, stream, a); } } }
}
```

```cpp
#include <hip/hip_runtime.h>
#include <cstdio>
#include <cstdint>

#ifndef MK_N_LAUNCHES
#define MK_N_LAUNCHES 1
#endif

#ifndef PROBE_DOUBLE
#define PROBE_DOUBLE 0
#endif
#define LAS __attribute__((address_space(3)))
#define GAS __attribute__((address_space(1)))
typedef unsigned short bf16_t;
typedef short bf16x8 __attribute__((ext_vector_type(8)));
typedef short s16x4 __attribute__((ext_vector_type(4)));
typedef float f32x2 __attribute__((ext_vector_type(2)));
typedef float f32x4 __attribute__((ext_vector_type(4)));
typedef float f32x16 __attribute__((ext_vector_type(16)));
typedef unsigned u32x2 __attribute__((ext_vector_type(2)));
typedef unsigned u32x4 __attribute__((ext_vector_type(4)));
typedef int v4i_t __attribute__((ext_vector_type(4)));
typedef int v8i_t __attribute__((ext_vector_type(8)));

constexpr int NB = 16, SEQ = 2048, NTOK = NB * SEQ, DM = 1024;
constexpr int CONVW = 512, QL = 384, KVL = 256, ROPE = 64, NH = 4, QKN = 128, QKH = 192, VH = 128;
constexpr int NPROJ = 2240, NPP = 2304;
constexpr int PB_B = 0, PB_C = 512, PB_X = 1024, PB_CKV = 1536, PB_CQ = 1792, PB_KPE = 2176;
constexpr int NQP = 1024;
constexpr int NE = 32, TOPK = 4, DFF = 1024, NSLOT = NTOK * TOPK;
constexpr int CAP = NTOK;
constexpr int MAXTILES = NSLOT / 256 + NE;
constexpr float EPS = 1e-6f;
constexpr float QSCALE = 0.07216878364870322f * 1.4426950408889634f;
constexpr float SWI_LIMIT = 7.0f, SWI_ALPHA = 1.702f;
constexpr float W8_SCALE = 64.f, ACT8_SCALE = 4.f, OS8_SCALE = 16.f;

constexpr size_t MiB = 1u << 20;
constexpr size_t WS_CTL = 0, CTL_ZERO_BYTES = 1 * MiB;
constexpr size_t WS_ROPE = 1 * MiB;
constexpr size_t WS_WRH = 1 * MiB + 512 * 1024, WS_WRL = WS_WRH + 64 * 1024;
constexpr size_t WS_WIN = 2 * MiB;
constexpr size_t WS_WUQ = 8 * MiB, WS_WUKV = 9 * MiB, WS_WO = 10 * MiB;
constexpr size_t WS_SSQ = 12 * MiB;
constexpr size_t WS_RS2 = 14 * MiB, WS_GATE = 14 * MiB + 512 * 1024;
constexpr size_t WS_TOS = 16 * MiB;
constexpr size_t WS_WGU = 32 * MiB, WS_WDN = 160 * MiB;
constexpr size_t WS_HB = 224 * MiB;
constexpr size_t WS_Q = 288 * MiB, WS_K = 336 * MiB, WS_V = 384 * MiB, WS_MIX = 416 * MiB;
constexpr size_t WS_OSLOT = 288 * MiB;
constexpr size_t WS_HN = 544 * MiB, WS_PB = 608 * MiB, WS_QRAW = 752 * MiB, WS_KVRAW = 800 * MiB;
constexpr size_t WS_ACT = 544 * MiB;
constexpr size_t WS_H1B = 768 * MiB;
constexpr size_t WS_END = 864 * MiB;
constexpr int CW_BAR = 4096;
constexpr int CW_CNT = 16384;

constexpr int RING_BYTES = 131072;
constexpr int MISC_OFF = RING_BYTES;
constexpr int LDS_BYTES = 155648;
constexpr int EPI_TAB_OFF = MISC_OFF + 3072 * 4;

__device__ __forceinline__ unsigned cvt_pk_bf16(float lo, float hi) { unsigned r; asm volatile("v_cvt_pk_bf16_f32 %0, %1, %2" : "=v"(r) : "v"(lo), "v"(hi)); return r; }
__device__ __forceinline__ unsigned f2bf(float f) { unsigned u = __builtin_bit_cast(unsigned, f); return (u + 0x7fffu + ((u >> 16) & 1u)) >> 16; }
__device__ __forceinline__ unsigned pk2(float lo, float hi) { return f2bf(lo) | (f2bf(hi) << 16); }
__device__ __forceinline__ float bf_lo(unsigned w) { return __builtin_bit_cast(float, w << 16); }
__device__ __forceinline__ float bf_hi(unsigned w) { return __builtin_bit_cast(float, w & 0xffff0000u); }
__device__ __forceinline__ void unpack8(const u32x4 w, float* f) { f[0] = bf_lo(w.x); f[1] = bf_hi(w.x); f[2] = bf_lo(w.y); f[3] = bf_hi(w.y); f[4] = bf_lo(w.z); f[5] = bf_hi(w.z); f[6] = bf_lo(w.w); f[7] = bf_hi(w.w); }
__device__ __forceinline__ u32x4 pack8(const float* f) { u32x4 w; w.x = cvt_pk_bf16(f[0], f[1]); w.y = cvt_pk_bf16(f[2], f[3]); w.z = cvt_pk_bf16(f[4], f[5]); w.w = cvt_pk_bf16(f[6], f[7]); return w; }
__device__ __forceinline__ float wave_sum(float v) {
#pragma unroll
    for (int o = 1; o < 64; o <<= 1) v += __shfl_xor(v, o);
    return v;
}
__device__ __forceinline__ float half_sum(float v) {
#pragma unroll
    for (int o = 1; o < 32; o <<= 1) v += __shfl_xor(v, o);
    return v;
}
__device__ __forceinline__ float clamp448(float v) { return __builtin_amdgcn_fmed3f(v, -448.f, 448.f); }
__device__ __forceinline__ unsigned pk4_fp8_nc(float a, float b, float c, float d) {
    unsigned w = 0u; w = (unsigned)__builtin_amdgcn_cvt_pk_fp8_f32(a, b, (int)w, false); w = (unsigned)__builtin_amdgcn_cvt_pk_fp8_f32(c, d, (int)w, true); return w; }
__device__ __forceinline__ unsigned pk4_fp8(float a, float b, float c, float d) {
    unsigned w = 0u; w = (unsigned)__builtin_amdgcn_cvt_pk_fp8_f32(clamp448(a), clamp448(b), (int)w, false); w = (unsigned)__builtin_amdgcn_cvt_pk_fp8_f32(clamp448(c), clamp448(d), (int)w, true); return w; }
#define LDS_WAIT() asm volatile("s_waitcnt lgkmcnt(0)" ::: "memory")
#define VM_WAIT() asm volatile("s_waitcnt vmcnt(0)" ::: "memory")

namespace pg8 {
constexpr int BM = 256, BK = 64, HALF = 128, HTB = HALF * BK * 2, STAGE_BYTES = 8 * HTB, NXCD = 8, WGM = 4;
__host__ __device__ __forceinline__ int lds_byte(int r, int c) { const int st = (r >> 4) * 2 + (c >> 5), rr = r & 15, cc = c & 31, ob = rr * 64 + cc * 2; return st * 1024 + (ob ^ (((ob >> 9) & 1) << 5)); }
__host__ __device__ __forceinline__ void stage_rc(int b, int& R, int& C) { const int st = b / 1024, sb = b % 1024, swz = sb ^ (((sb >> 9) & 1) << 5); R = (st >> 1) * 16 + swz / 64; C = (st & 1) * 32 + (swz % 64) / 2; }
__host__ __device__ __forceinline__ int perm32(int rho) { const int n = rho >> 4, i = rho & 15; return 8 * (i >> 2) + 4 * n + (i & 3); }

struct Unit { int pm, pn, e, p0, cnt, par; };

struct DenseSched {
    static constexpr int ESZ = 2;
    const bf16_t* A; const bf16_t* Bt; int lda, K, nM, nN, nwg, G, c;
    __device__ void init(const bf16_t* A_, int lda_, const bf16_t* Bt_, int M, int N, int K_, int G_, int c_) { A = A_; Bt = Bt_; lda = lda_; K = K_; nM = M / BM; nN = N / BM; nwg = nM * nN; G = G_; c = c_; }
    __device__ __forceinline__ bool next(int i, Unit& u) const {
        const long L = (long)i * G + c; if (L >= nwg) return false;
        int wgid = (int)L; { const int q = nwg / NXCD, r = nwg % NXCD, xcd = wgid % NXCD, off = wgid / NXCD; wgid = (xcd < r ? xcd * (q + 1) : r * (q + 1) + (xcd - r) * q) + off; }
        const int nig = WGM * nN, gid = wgid / nig, fm = gid * WGM, gsz = (nM - fm) < WGM ? (nM - fm) : WGM;
        u.pm = fm + ((wgid % nig) % gsz); u.pn = (wgid % nig) / gsz; u.e = 0; u.p0 = 0; u.cnt = 0; return true;
    }
    __device__ __forceinline__ unsigned a_off(const Unit& u) const { return (unsigned)u.pm * (unsigned)(BM * lda * 2); }
    __device__ __forceinline__ unsigned b_off(const Unit& u) const { return (unsigned)u.pn * (unsigned)(BM * K * 2); }
    __device__ __forceinline__ unsigned a_rowoff(const Unit&, int) const { return 0u; }
    static constexpr bool META = false;
    __device__ __forceinline__ void meta_first(const Unit&, LAS unsigned char*) const {}
    __device__ __forceinline__ void meta_issue(const Unit&, unsigned (&)[4], const int (&)[2]) const {}
    __device__ __forceinline__ void meta_commit(const Unit&, unsigned (&)[4], LAS unsigned char*) const {}
    __device__ __forceinline__ unsigned meta_rowoff(const Unit&, unsigned, int) const { return 0u; }
    __device__ __forceinline__ void pre_issue(const Unit&, f32x4 (&)[4], int, int) const {}
};
struct MoeSched {
    static constexpr int ESZ = 1;
    const unsigned char* A; const unsigned char* Bt; int lda, K, nN, G, c; size_t estride; const LAS int* tab; const int* tos; const float* bias;
    static constexpr bool META = true;
    static constexpr int META_OFF = MISC_OFF + 4608 * 4;
    __device__ __forceinline__ bool next(int i, Unit& u) const {
        const int T = __builtin_amdgcn_readfirstlane(tab[32]), nwg = T * nN;
        const long L = (long)i * G + c; if (L >= nwg) return false;
        int wgid = (int)L; { const int q = nwg / NXCD, r = nwg % NXCD, xcd = wgid % NXCD, off = wgid / NXCD; wgid = (xcd < r ? xcd * (q + 1) : r * (q + 1) + (xcd - r) * q) + off; }
        const int nig = WGM * nN, gid = wgid / nig, fm = gid * WGM, gsz = (T - fm) < WGM ? (T - fm) : WGM;
        const int mt = fm + ((wgid % nig) % gsz); u.pm = mt; u.pn = (wgid % nig) / gsz;
        const int e = __builtin_amdgcn_readfirstlane(tab[2288 + mt]);
        u.e = e; u.p0 = (mt - __builtin_amdgcn_readfirstlane(tab[e])) * BM; u.cnt = __builtin_amdgcn_readfirstlane(tab[48 + e]); return true;
    }
    __device__ __forceinline__ unsigned a_off(const Unit& u) const { return (unsigned)u.pm * (unsigned)(BM * lda); }
    __device__ __forceinline__ unsigned b_off(const Unit& u) const { return (unsigned)u.e * (unsigned)estride + (unsigned)u.pn * (unsigned)(BM * K); }
    __device__ __forceinline__ unsigned a_rowoff(const Unit& u, int r) const {
        const int p = u.p0 + r; const int sv = tos[((size_t)u.e * CAP + p) * 2];
        const int slot = (p < u.cnt) ? sv : 0;
        return (unsigned)(slot >> 2) * (unsigned)lda;
    }
    __device__ __forceinline__ void meta_first(const Unit& u, LAS unsigned char* lds) const {
        if (threadIdx.x < BM) { const u32x2 v = *(const u32x2*)(tos + ((size_t)u.e * CAP + u.p0 + threadIdx.x) * 2); *(LAS u32x2*)(lds + META_OFF + u.par * 2048 + threadIdx.x * 8) = v; }
    }
    __device__ __forceinline__ void meta_issue(const Unit& u, unsigned (&mreg)[4], const int (&RA)[2]) const {
        const unsigned base = ((unsigned)u.e * (unsigned)CAP + (unsigned)u.p0) * 8u;
        if (nN == 8) {
#pragma unroll
            for (int k = 0; k < 4; ++k) { const unsigned off = base + (unsigned)((k >> 1) * HALF + RA[k & 1]) * 8u;
                asm volatile("global_load_dword %0, %1, %2" : "=v"(mreg[k]) : "v"(off), "s"(tos) : "memory"); }
        } else {
            const unsigned off = base + (threadIdx.x & 255u) * 8u; u32x2 v;
            asm volatile("global_load_dwordx2 %0, %1, %2" : "=v"(v) : "v"(off), "s"(tos) : "memory"); mreg[0] = v.x; mreg[1] = v.y;
        }
    }
    __device__ __forceinline__ void pre_issue(const Unit& u, f32x4 (&pre)[4], int wc, int fq) const {
        const unsigned j0 = (unsigned)(wc * 32 + 8 * fq) * 4u;
        if (nN == 8) { const unsigned o0 = ((unsigned)u.e * (2u * DFF) + (unsigned)u.pn * HALF) * 4u + j0, o1 = o0 + DFF * 4u;
            asm volatile("global_load_dwordx4 %0, %1, %2" : "=v"(pre[0]) : "v"(o0), "s"(bias) : "memory"); asm volatile("global_load_dwordx4 %0, %1, %2 offset:16" : "=v"(pre[1]) : "v"(o0), "s"(bias) : "memory");
            asm volatile("global_load_dwordx4 %0, %1, %2" : "=v"(pre[2]) : "v"(o1), "s"(bias) : "memory"); asm volatile("global_load_dwordx4 %0, %1, %2 offset:16" : "=v"(pre[3]) : "v"(o1), "s"(bias) : "memory");
        } else { const unsigned o0 = ((unsigned)u.e * DM + (unsigned)u.pn * BM) * 4u + j0;
            asm volatile("global_load_dwordx4 %0, %1, %2" : "=v"(pre[0]) : "v"(o0), "s"(bias) : "memory"); asm volatile("global_load_dwordx4 %0, %1, %2 offset:16" : "=v"(pre[1]) : "v"(o0), "s"(bias) : "memory");
            asm volatile("global_load_dwordx4 %0, %1, %2 offset:512" : "=v"(pre[2]) : "v"(o0), "s"(bias) : "memory"); asm volatile("global_load_dwordx4 %0, %1, %2 offset:528" : "=v"(pre[3]) : "v"(o0), "s"(bias) : "memory");
        }
    }
    __device__ __forceinline__ void meta_commit(const Unit& u, unsigned (&mreg)[4], LAS unsigned char* lds) const {
        asm volatile("" : "+v"(mreg[0]), "+v"(mreg[1]) :: "memory");
        if (threadIdx.x < BM) *(LAS u32x2*)(lds + META_OFF + u.par * 2048 + threadIdx.x * 8) = (u32x2){mreg[0], mreg[1]};
    }
    __device__ __forceinline__ unsigned meta_rowoff(const Unit& u, unsigned sv, int r) const {
        asm volatile("" : "+v"(sv) :: "memory");
        const int slot = (u.p0 + r < u.cnt) ? (int)sv : 0;
        return (unsigned)(slot >> 2) * (unsigned)lda;
    }
};

template <class Epi, class Sched, bool GATHER, int KREP = 1>
__device__ __forceinline__ void gemm_phase(LAS unsigned char* lds, const Sched& S, const Epi& E) {
    const int tid = threadIdx.x, wid = __builtin_amdgcn_readfirstlane(tid >> 6), lane = tid & 63, wr = wid >> 2, wc = wid & 3, fr = lane & 15, fq = lane >> 4;
    constexpr int ESZ = Sched::ESZ; constexpr bool F8 = (ESZ == 1);
    const int K = S.K * ESZ / 2, lda = S.lda * ESZ / 2, nt0 = K / BK, nt = nt0 * KREP;
    unsigned voffB[2], aoc[2][2], mreg[4] = {0u, 0u, 0u, 0u}; int RA[2], CA[2]; f32x4 pre[4];
#pragma unroll
    for (int i = 0; i < 2; ++i) { int R, C; stage_rc(tid * 16 + i * 8192, R, C); const int Rb = (R & ~31) + perm32(R & 31);
        voffB[i] = (unsigned)(Rb * K + C) * 2u; RA[i] = R; CA[i] = C;
        aoc[0][i] = (unsigned)(R * lda + C) * 2u; aoc[1][i] = (unsigned)((R + HALF) * lda + C) * 2u; }
    const unsigned kstep = (unsigned)(BK * 2);
    const unsigned hstepB = (unsigned)(HALF * K * 2), hstepA = GATHER ? 0u : (unsigned)(HALF * lda * 2);
    const __amdgpu_buffer_rsrc_t rA = __builtin_amdgcn_make_buffer_rsrc((void*)S.A, 0, -1, 0x00020000), rB = __builtin_amdgcn_make_buffer_rsrc((void*)S.Bt, 0, -1, 0x00020000);
    const unsigned ldsw = (unsigned)wid * 1024u;
    const int aoff = lds_byte(wr * 64 + fr, fq * 8), boff = lds_byte(wc * 32 + fr, fq * 8);
#define PG8_SA(b, h) (((b) * 2 + (h)) * HTB)
#define PG8_SB(b, h) ((4 + (b) * 2 + (h)) * HTB)
#define PG8_STAGE_B(bufoff, soff) do { _Pragma("unroll") for (int _i = 0; _i < 2; ++_i) \
        __builtin_amdgcn_raw_ptr_buffer_load_lds(rB, (LAS void*)(lds + (bufoff) + ldsw + _i * 8192), 16, voffB[_i], (soff), 0, 0); } while (0)
#define PG8_STAGE_A(bufoff, soff, h) do { _Pragma("unroll") for (int _i = 0; _i < 2; ++_i) \
        __builtin_amdgcn_raw_ptr_buffer_load_lds(rA, (LAS void*)(lds + (bufoff) + ldsw + _i * 8192), 16, aoc[GATHER ? (h) : 0][_i], (soff) + (h) * hstepA, 0, 0); } while (0)
#define PG8_LDA(dst, b, h) do { _Pragma("unroll") for (int m = 0; m < 4; ++m) _Pragma("unroll") for (int k = 0; k < 2; ++k) dst[m][k] = *(const LAS bf16x8*)(lds + PG8_SA(b, h) + aoff + m * 2048 + k * 1024); } while (0)
#define PG8_LDB(dst, b, h) do { _Pragma("unroll") for (int n = 0; n < 2; ++n) _Pragma("unroll") for (int k = 0; k < 2; ++k) dst[n][k] = *(const LAS bf16x8*)(lds + PG8_SB(b, h) + boff + n * 2048 + k * 1024); } while (0)
#define PG8_CAT(x) __builtin_shufflevector(__builtin_bit_cast(v4i_t, x[0]), __builtin_bit_cast(v4i_t, x[1]), 0, 1, 2, 3, 4, 5, 6, 7)
#define PG8_MMA(ai, bj, At, Bt) do { __builtin_amdgcn_s_setprio(1); _Pragma("unroll") for (int m = 0; m < 4; ++m) _Pragma("unroll") for (int n = 0; n < 2; ++n) { \
        if constexpr (F8) { asm volatile("v_mfma_scale_f32_16x16x128_f8f6f4 %0, %1, %2, %0, %3, %3 op_sel_hi:[0,0,0]" : "+v"(acc[ai][bj][m][n]) : "v"(PG8_CAT(Bt[n])), "v"(PG8_CAT(At[m])), "v"(0x7f7f7f7f)); } \
        else { _Pragma("unroll") for (int k = 0; k < 2; ++k) acc[ai][bj][m][n] = __builtin_amdgcn_mfma_f32_16x16x32_bf16(Bt[n][k], At[m][k], acc[ai][bj][m][n], 0, 0, 0); } } \
        __builtin_amdgcn_s_setprio(0); } while (0)
#define PG8_WAIT_V(n) asm volatile("s_waitcnt vmcnt(" #n ")" ::: "memory")
#define PG8_WAIT_L(n) asm volatile("s_waitcnt lgkmcnt(" #n ")" ::: "memory")
#define PG8_BAR __builtin_amdgcn_s_barrier()
#define PG8_SCHED __builtin_amdgcn_sched_barrier(0)
    Unit cur, nxt; int ui = 0;
    if (!S.next(0, cur)) return;
    cur.par = 0; if constexpr (Sched::META && !GATHER) S.meta_first(cur, lds);
    f32x4 acc[2][2][4][2];
#pragma unroll
    for (int a = 0; a < 2; ++a)
#pragma unroll
        for (int b = 0; b < 2; ++b)
#pragma unroll
            for (int m = 0; m < 4; ++m)
#pragma unroll
                for (int n = 0; n < 2; ++n) acc[a][b][m][n] = (f32x4){0.f, 0.f, 0.f, 0.f};
    bf16x8 At[4][2], B0[2][2], B1[2][2];
    unsigned cA = GATHER ? 0u : S.a_off(cur), cB = S.b_off(cur);
    if constexpr (GATHER) {
#pragma unroll
        for (int h = 0; h < 2; ++h)
#pragma unroll
            for (int i = 0; i < 2; ++i) aoc[h][i] = S.a_rowoff(cur, h * HALF + RA[i]) + (unsigned)CA[i] * 2u;
    }
    PG8_STAGE_B(PG8_SB(0, 0), cB); PG8_STAGE_B(PG8_SB(0, 1), cB + hstepB); PG8_STAGE_A(PG8_SA(0, 0), cA, 0); PG8_STAGE_A(PG8_SA(0, 1), cA, 1);
    if (wr == 1) PG8_BAR;
    PG8_WAIT_V(2); PG8_BAR;
    PG8_STAGE_B(PG8_SB(1, 0), cB + kstep); PG8_STAGE_A(PG8_SA(1, 0), cA + kstep, 0); PG8_STAGE_B(PG8_SB(1, 1), cB + hstepB + kstep);
    PG8_WAIT_V(6); PG8_BAR;
    for (;;) {
        const bool has_next = S.next(ui + 1, nxt);
        const unsigned nA = GATHER ? 0u : (has_next ? S.a_off(nxt) : cA), nB = has_next ? S.b_off(nxt) : cB;
        nxt.par = (ui + 1) & 1;
        for (int t = 0; t < nt; t += 2) {
            const bool last = (t == nt - 2);
            const unsigned a1 = cA + (unsigned)((t + 1) % nt0) * kstep;
            const unsigned a2 = last ? nA : cA + (unsigned)((t + 2) % nt0) * kstep, b2 = last ? nB : cB + (unsigned)((t + 2) % nt0) * kstep;
            const unsigned a3 = a2 + kstep, b3 = b2 + kstep;
            PG8_LDB(B0, 0, 0); PG8_LDB(B1, 0, 1); PG8_SCHED; PG8_LDA(At, 0, 0); PG8_STAGE_A(PG8_SA(1, 1), a1, 1);
            PG8_WAIT_V(8); PG8_WAIT_L(0); PG8_BAR;
            if constexpr (Sched::META) { if (t == 0) { S.pre_issue(cur, pre, wc, fq); if (has_next) S.meta_issue(nxt, mreg, RA); } }
            PG8_MMA(0, 0, At, B0); PG8_MMA(0, 1, At, B1); PG8_BAR; PG8_SCHED;
            if constexpr (Sched::META) { if (last && has_next) {
                if constexpr (GATHER) {
#pragma unroll
                    for (int h = 0; h < 2; ++h)
#pragma unroll
                        for (int i = 0; i < 2; ++i) aoc[h][i] = S.meta_rowoff(nxt, mreg[h * 2 + i], h * HALF + RA[i]) + (unsigned)CA[i] * 2u;
                } else S.meta_commit(nxt, mreg, lds); } }
            PG8_LDA(At, 0, 1); PG8_STAGE_B(PG8_SB(0, 0), b2); PG8_STAGE_B(PG8_SB(0, 1), b2 + hstepB); PG8_STAGE_A(PG8_SA(0, 0), a2, 0);
            PG8_WAIT_V(8); PG8_WAIT_L(0); PG8_BAR; PG8_MMA(1, 0, At, B0); PG8_MMA(1, 1, At, B1); PG8_BAR; PG8_SCHED;
            PG8_LDB(B0, 1, 0); PG8_LDB(B1, 1, 1); PG8_SCHED; PG8_LDA(At, 1, 0); PG8_STAGE_A(PG8_SA(0, 1), a2, 1);
            PG8_WAIT_V(8); PG8_WAIT_L(0); PG8_BAR; PG8_MMA(0, 0, At, B0); PG8_MMA(0, 1, At, B1); PG8_BAR; PG8_SCHED;
            PG8_LDA(At, 1, 1); PG8_STAGE_B(PG8_SB(1, 0), b3); PG8_STAGE_B(PG8_SB(1, 1), b3 + hstepB); PG8_STAGE_A(PG8_SA(1, 0), a3, 0);
            PG8_WAIT_V(8); PG8_WAIT_L(0); PG8_BAR; PG8_MMA(1, 0, At, B0); PG8_MMA(1, 1, At, B1); PG8_BAR; PG8_SCHED;
        }
        if (wr == 0) PG8_BAR;
        if constexpr (Sched::META) E(acc, cur, wr, wc, fr, fq, pre); else E(acc, cur, wr, wc, fr, fq);
        if (!has_next) break;
#pragma unroll
        for (int a = 0; a < 2; ++a)
#pragma unroll
            for (int b = 0; b < 2; ++b)
#pragma unroll
                for (int m = 0; m < 4; ++m)
#pragma unroll
                    for (int n = 0; n < 2; ++n) acc[a][b][m][n] = (f32x4){0.f, 0.f, 0.f, 0.f};
        cur = nxt; cA = nA; cB = nB; ++ui;
        if (wr == 1) PG8_BAR;
    }
    PG8_WAIT_V(0);
    PG8_BAR;
#undef PG8_SA
#undef PG8_SB
#undef PG8_STAGE_A
#undef PG8_STAGE_B
#undef PG8_LDA
#undef PG8_LDB
#undef PG8_MMA
#undef PG8_CAT
#undef PG8_WAIT_V
#undef PG8_WAIT_L
#undef PG8_BAR
#undef PG8_SCHED
}

struct EpiBf16 {
    bf16_t* O; int ldc;
    __device__ __forceinline__ void operator()(const f32x4 (&acc)[2][2][4][2], const Unit& u, int wr, int wc, int fr, int fq) const {
        asm volatile("" : "+v"(fr), "+v"(fq));
        const int row0 = u.pm * BM + wr * 64 + fr, col0 = u.pn * BM + wc * 32 + 8 * fq;
#pragma unroll
        for (int ai = 0; ai < 2; ++ai)
#pragma unroll
            for (int m = 0; m < 4; ++m) { bf16_t* rowp = O + (size_t)(row0 + ai * HALF + m * 16) * ldc + col0;
#pragma unroll
                for (int bj = 0; bj < 2; ++bj) { const f32x4 v0 = acc[ai][bj][m][0], v1 = acc[ai][bj][m][1];
                    u32x4 w; w.x = cvt_pk_bf16(v0[0], v0[1]); w.y = cvt_pk_bf16(v0[2], v0[3]); w.z = cvt_pk_bf16(v1[0], v1[1]); w.w = cvt_pk_bf16(v1[2], v1[3]);
                    *(u32x4*)(rowp + bj * HALF) = w; } }
    }
};
struct EpiProj {
    bf16_t* O; float* st;
    __device__ __forceinline__ void operator()(const f32x4 (&acc)[2][2][4][2], const Unit& u, int wr, int wc, int fr, int fq) const {
        asm volatile("" : "+v"(fr), "+v"(fq));
        const int row0 = u.pm * BM + wr * 64 + fr, col0 = u.pn * BM + wc * 32 + 8 * fq;
#pragma unroll
        for (int ai = 0; ai < 2; ++ai)
#pragma unroll
            for (int m = 0; m < 4; ++m) { const int row = row0 + ai * HALF + m * 16; bf16_t* rowp = O + (size_t)row * NPP + col0; float ss[2];
#pragma unroll
                for (int bj = 0; bj < 2; ++bj) { const f32x4 v0 = acc[ai][bj][m][0], v1 = acc[ai][bj][m][1];
                    u32x4 w; w.x = cvt_pk_bf16(v0[0], v0[1]); w.y = cvt_pk_bf16(v0[2], v0[3]); w.z = cvt_pk_bf16(v1[0], v1[1]); w.w = cvt_pk_bf16(v1[2], v1[3]);
                    *(u32x4*)(rowp + bj * HALF) = w;
                    ss[bj] = (v0[0] * v0[0] + v0[1] * v0[1]) + (v0[2] * v0[2] + v0[3] * v0[3]) + (v1[0] * v1[0] + v1[1] * v1[1]) + (v1[2] * v1[2] + v1[3] * v1[3]); }
                if (u.pn >= 6) {
                    float s0 = ss[0], s1 = ss[1]; s0 += __shfl_xor(s0, 16); s0 += __shfl_xor(s0, 32); s1 += __shfl_xor(s1, 16); s1 += __shfl_xor(s1, 32);
                    if (fq == 0) { if (u.pn == 6) st[(size_t)wc * NTOK + row] = s0 + s1; else if (u.pn == 7) st[(size_t)(4 + wc) * NTOK + row] = s0 + s1;
                                   else { st[(size_t)(8 + wc) * NTOK + row] = s0; st[(size_t)(12 + wc) * NTOK + row] = s1; } } } }
    }
};
struct EpiQ {
    bf16_t* q; const float* st; const float* qhn; const f32x2* rope; LAS float* tabs;
    __device__ __forceinline__ void operator()(const f32x4 (&acc)[2][2][4][2], const Unit& u, int wr, int wc, int fr, int fq) const {
        asm volatile("" : "+v"(fr), "+v"(fq));
        LAS float* rs_tab = tabs; LAS float* part = tabs + 512;
        const int rt0 = wr * 64 + fr;
        const int c0 = wc * 32 + 8 * fq;
        const int i0 = c0 >> 1;
        f32x4 csa[2][4][2];
        if (wc < 2) {
#pragma unroll
            for (int ai = 0; ai < 2; ++ai)
#pragma unroll
                for (int m = 0; m < 4; ++m) { const size_t row = (size_t)u.pm * BM + rt0 + ai * HALF + m * 16;
                    csa[ai][m][0] = *(const f32x4*)(rope + (row & (SEQ - 1)) * 32 + i0); csa[ai][m][1] = *(const f32x4*)(rope + (row & (SEQ - 1)) * 32 + i0 + 2); }
        }
        f32x4 g0[2], g1[2];
        g0[0] = *(const f32x4*)(qhn + c0) * QSCALE; g0[1] = *(const f32x4*)(qhn + c0 + 4) * QSCALE;
        if (wc < 2) { g1[0] = (f32x4){qhn[128 + i0], qhn[160 + i0], qhn[129 + i0], qhn[161 + i0]} * QSCALE; g1[1] = (f32x4){qhn[130 + i0], qhn[162 + i0], qhn[131 + i0], qhn[163 + i0]} * QSCALE; }
        else { g1[0] = (f32x4){0.f, 0.f, 0.f, 0.f}; g1[1] = g1[0]; }
        { const int t = threadIdx.x; if (t < BM) { const size_t r = (size_t)u.pm * BM + t; float s = 0.f;
#pragma unroll
            for (int k = 4; k < 12; ++k) s += st[(size_t)k * NTOK + r];
            rs_tab[t] = 1.0f / sqrtf(s * (1.f / QL) + EPS); } }
#pragma unroll
        for (int ai = 0; ai < 2; ++ai)
#pragma unroll
            for (int m = 0; m < 4; ++m) { float ss = 0.f;
#pragma unroll
                for (int bj = 0; bj < 2; ++bj)
#pragma unroll
                    for (int n = 0; n < 2; ++n) { const f32x4 v = acc[ai][bj][m][n]; ss += (v[0] * v[0] + v[1] * v[1]) + (v[2] * v[2] + v[3] * v[3]); }
                ss += __shfl_xor(ss, 16); ss += __shfl_xor(ss, 32);
                if (fq == 0) part[(rt0 + ai * HALF + m * 16) * 4 + wc] = ss; }
        asm volatile("s_waitcnt lgkmcnt(0)" ::: "memory"); __builtin_amdgcn_s_barrier(); asm volatile("" ::: "memory");
#pragma unroll
        for (int ai = 0; ai < 2; ++ai)
#pragma unroll
            for (int m = 0; m < 4; ++m) { const int rt = rt0 + ai * HALF + m * 16; const size_t row = (size_t)u.pm * BM + rt;
                const f32x4 pp = *(const LAS f32x4*)(part + rt * 4); const float rs = rs_tab[rt];
                const float r = rs / sqrtf(rs * rs * ((pp[0] + pp[1]) + (pp[2] + pp[3])) * (1.f / QKH) + EPS);
                bf16_t* qp = q + row * (NH * QKH) + u.pn * QKH + c0;
                { const f32x4 v0 = acc[ai][0][m][0] * g0[0] * r, v1 = acc[ai][0][m][1] * g0[1] * r;
                  u32x4 w; w.x = cvt_pk_bf16(v0[0], v0[1]); w.y = cvt_pk_bf16(v0[2], v0[3]); w.z = cvt_pk_bf16(v1[0], v1[1]); w.w = cvt_pk_bf16(v1[2], v1[3]); *(u32x4*)qp = w; }
                if (wc < 2) { const f32x4 cs0 = csa[ai][m][0], cs1 = csa[ai][m][1];
                    const f32x4 a0 = acc[ai][1][m][0] * g1[0] * r, a1 = acc[ai][1][m][1] * g1[1] * r;
                    f32x4 o0, o1;
                    o0[0] = a0[0] * cs0[0] - a0[1] * cs0[1]; o0[1] = a0[0] * cs0[1] + a0[1] * cs0[0]; o0[2] = a0[2] * cs0[2] - a0[3] * cs0[3]; o0[3] = a0[2] * cs0[3] + a0[3] * cs0[2];
                    o1[0] = a1[0] * cs1[0] - a1[1] * cs1[1]; o1[1] = a1[0] * cs1[1] + a1[1] * cs1[0]; o1[2] = a1[2] * cs1[2] - a1[3] * cs1[3]; o1[3] = a1[2] * cs1[3] + a1[3] * cs1[2];
                    u32x4 w; w.x = cvt_pk_bf16(o0[0], o0[1]); w.y = cvt_pk_bf16(o0[2], o0[3]); w.z = cvt_pk_bf16(o1[0], o1[1]); w.w = cvt_pk_bf16(o1[2], o1[3]); *(u32x4*)(qp + HALF) = w; } }
    }
};
struct EpiKV {
    bf16_t* k; bf16_t* v; const float* st; const float* khn; const f32x2* rope; const bf16_t* pb; LAS float* tabs;
    __device__ __forceinline__ void operator()(const f32x4 (&acc)[2][2][4][2], const Unit& u, int wr, int wc, int fr, int fq) const {
        asm volatile("" : "+v"(fr), "+v"(fq));
        LAS float* rs_tab = tabs; LAS float* kpe_tab = tabs + 256; LAS float* part = tabs + 512;
        const int rt0 = wr * 64 + fr;
        const int c0 = wc * 32 + 8 * fq;
        const int i0 = 8 * wc + 2 * fq;
        unsigned xas[2][4], xbs[2][4]; f32x4 css[2][4];
#pragma unroll
        for (int ai = 0; ai < 2; ++ai)
#pragma unroll
            for (int m = 0; m < 4; ++m) { const size_t row = (size_t)u.pm * BM + rt0 + ai * HALF + m * 16;
                xas[ai][m] = *(const unsigned*)(pb + row * NPP + PB_KPE + i0); xbs[ai][m] = *(const unsigned*)(pb + row * NPP + PB_KPE + 32 + i0);
                css[ai][m] = *(const f32x4*)(rope + (row & (SEQ - 1)) * 32 + i0); }
        const f32x4 g0 = *(const f32x4*)(khn + c0), g1 = *(const f32x4*)(khn + c0 + 4);
        const float gx0 = khn[128 + i0], gy0 = khn[160 + i0], gx1 = khn[129 + i0], gy1 = khn[161 + i0];
        { const int t = threadIdx.x; if (t < BM) { const size_t r = (size_t)u.pm * BM + t;
            const float s = (st[r] + st[(size_t)NTOK + r]) + (st[(size_t)2 * NTOK + r] + st[(size_t)3 * NTOK + r]);
            const float p = (st[(size_t)12 * NTOK + r] + st[(size_t)13 * NTOK + r]) + (st[(size_t)14 * NTOK + r] + st[(size_t)15 * NTOK + r]);
            rs_tab[t] = 1.0f / sqrtf(s * (1.f / KVL) + EPS); kpe_tab[t] = p; } }
#pragma unroll
        for (int ai = 0; ai < 2; ++ai)
#pragma unroll
            for (int m = 0; m < 4; ++m) { float ss = 0.f;
#pragma unroll
                for (int n = 0; n < 2; ++n) { const f32x4 x = acc[ai][0][m][n]; ss += (x[0] * x[0] + x[1] * x[1]) + (x[2] * x[2] + x[3] * x[3]); }
                ss += __shfl_xor(ss, 16); ss += __shfl_xor(ss, 32);
                if (fq == 0) part[(rt0 + ai * HALF + m * 16) * 4 + wc] = ss; }
        asm volatile("s_waitcnt lgkmcnt(0)" ::: "memory"); __builtin_amdgcn_s_barrier(); asm volatile("" ::: "memory");
#pragma unroll
        for (int ai = 0; ai < 2; ++ai)
#pragma unroll
            for (int m = 0; m < 4; ++m) { const int rt = rt0 + ai * HALF + m * 16; const size_t row = (size_t)u.pm * BM + rt;
                const f32x4 pp = *(const LAS f32x4*)(part + rt * 4); const float rs = rs_tab[rt];
                const float rh = 1.0f / sqrtf((rs * rs * ((pp[0] + pp[1]) + (pp[2] + pp[3])) + kpe_tab[rt]) * (1.f / QKH) + EPS);
                const float r = rs * rh;
                bf16_t* kp = k + row * (NH * QKH) + u.pn * QKH;
                { const f32x4 v0 = acc[ai][0][m][0] * g0 * r, v1 = acc[ai][0][m][1] * g1 * r;
                  u32x4 w; w.x = cvt_pk_bf16(v0[0], v0[1]); w.y = cvt_pk_bf16(v0[2], v0[3]); w.z = cvt_pk_bf16(v1[0], v1[1]); w.w = cvt_pk_bf16(v1[2], v1[3]); *(u32x4*)(kp + c0) = w; }
                { const f32x4 v0 = acc[ai][1][m][0] * rs, v1 = acc[ai][1][m][1] * rs;
                  u32x4 w; w.x = cvt_pk_bf16(v0[0], v0[1]); w.y = cvt_pk_bf16(v0[2], v0[3]); w.z = cvt_pk_bf16(v1[0], v1[1]); w.w = cvt_pk_bf16(v1[2], v1[3]); *(u32x4*)(v + row * (NH * VH) + u.pn * VH + c0) = w; }
                { const unsigned xa = xas[ai][m], xb = xbs[ai][m];
                  const f32x4 cs = css[ai][m];
                  const float x10 = bf_lo(xa) * gx0 * rh, x11 = bf_hi(xa) * gx1 * rh, x20 = bf_lo(xb) * gy0 * rh, x21 = bf_hi(xb) * gy1 * rh;
                  u32x2 w; w.x = cvt_pk_bf16(x10 * cs[0] - x20 * cs[1], x10 * cs[1] + x20 * cs[0]); w.y = cvt_pk_bf16(x11 * cs[2] - x21 * cs[3], x11 * cs[3] + x21 * cs[2]);
                  *(u32x2*)(kp + 128 + 2 * i0) = w; } }
    }
};
struct EpiOut {
    const float* x; bf16_t* h1b; float* ssq;
    __device__ __forceinline__ void operator()(const f32x4 (&acc)[2][2][4][2], const Unit& u, int wr, int wc, int fr, int fq) const {
        asm volatile("" : "+v"(fr), "+v"(fq));
        const int row0 = u.pm * BM + wr * 64 + fr, col0 = u.pn * BM + wc * 32 + 8 * fq;
#pragma unroll
        for (int ai = 0; ai < 2; ++ai) {
            f32x4 xv[4][2][2];
#pragma unroll
            for (int m = 0; m < 4; ++m) { const size_t off = (size_t)(row0 + ai * HALF + m * 16) * DM + col0;
#pragma unroll
                for (int bj = 0; bj < 2; ++bj) { xv[m][bj][0] = __builtin_nontemporal_load((const f32x4*)(x + off + bj * HALF)); xv[m][bj][1] = __builtin_nontemporal_load((const f32x4*)(x + off + bj * HALF + 4)); } }
            asm volatile("" ::: "memory");
#pragma unroll
            for (int m = 0; m < 4; ++m) { const int row = row0 + ai * HALF + m * 16; const size_t off = (size_t)row * DM + col0; float ss = 0.f;
#pragma unroll
                for (int bj = 0; bj < 2; ++bj) { const f32x4 v0 = acc[ai][bj][m][0] + xv[m][bj][0], v1 = acc[ai][bj][m][1] + xv[m][bj][1];
                    u32x4 w; w.x = cvt_pk_bf16(v0[0], v0[1]); w.y = cvt_pk_bf16(v0[2], v0[3]); w.z = cvt_pk_bf16(v1[0], v1[1]); w.w = cvt_pk_bf16(v1[2], v1[3]);
                    *(u32x4*)(h1b + off + bj * HALF) = w;
                    ss += (v0[0] * v0[0] + v0[1] * v0[1]) + (v0[2] * v0[2] + v0[3] * v0[3]) + (v1[0] * v1[0] + v1[1] * v1[1]) + (v1[2] * v1[2] + v1[3] * v1[3]); }
                ss += __shfl_xor(ss, 16); ss += __shfl_xor(ss, 32);
                if (fq == 0) ssq[(size_t)(u.pn * 4 + wc) * NTOK + row] = ss; }
        }
    }
};
struct EpiSwiglu {
    unsigned char* act; const float* bgu;
    __device__ __forceinline__ void operator()(const f32x4 (&acc)[2][2][4][2], const Unit& u, int wr, int wc, int fr, int fq, f32x4 (&pre)[4]) const {
        asm volatile("" : "+v"(fr), "+v"(fq));
        const int rt0 = wr * 64 + fr, j0 = wc * 32 + 8 * fq;
        asm volatile("" : "+v"(pre[0]), "+v"(pre[1]), "+v"(pre[2]), "+v"(pre[3]) :: "memory");
        const f32x4 bg0 = pre[0], bg1 = pre[1], bu0 = pre[2], bu1 = pre[3];
        constexpr float WI = 1.f / W8_SCALE;
#pragma unroll
        for (int ai = 0; ai < 2; ++ai)
#pragma unroll
            for (int m = 0; m < 4; ++m) { const int rt = rt0 + ai * HALF + m * 16;
                float o[8];
#pragma unroll
                for (int n = 0; n < 2; ++n) { const f32x4 g4 = acc[ai][0][m][n] * WI + (n ? bg1 : bg0), u4 = acc[ai][1][m][n] * WI + (n ? bu1 : bu0);
#pragma unroll
                    for (int i = 0; i < 4; i += 2) {
                        f32x2 g, uu; g.x = fminf(g4[i], SWI_LIMIT); g.y = fminf(g4[i + 1], SWI_LIMIT);
                        uu.x = __builtin_amdgcn_fmed3f(u4[i], -SWI_LIMIT, SWI_LIMIT); uu.y = __builtin_amdgcn_fmed3f(u4[i + 1], -SWI_LIMIT, SWI_LIMIT);
                        const f32x2 t = g * (-SWI_ALPHA * 1.4426950408889634f);
                        f32x2 e; e.x = __builtin_amdgcn_exp2f(t.x); e.y = __builtin_amdgcn_exp2f(t.y);
                        const f32x2 d = e + 1.f;
                        f32x2 sg; sg.x = __builtin_amdgcn_rcpf(d.x); sg.y = __builtin_amdgcn_rcpf(d.y);
                        const f32x2 r = (uu * ACT8_SCALE + ACT8_SCALE) * (g * sg);
                        o[n * 4 + i] = r.x; o[n * 4 + i + 1] = r.y; } }
                u32x2 w; w.x = pk4_fp8_nc(o[0], o[1], o[2], o[3]); w.y = pk4_fp8_nc(o[4], o[5], o[6], o[7]);
                *(u32x2*)(act + ((size_t)u.pm * BM + rt) * DFF + u.pn * HALF + j0) = w; }
    }
};
struct EpiDown {
    unsigned char* oslot; const float* bdn; unsigned char* dummy; LAS unsigned char* lds;
    __device__ __forceinline__ void operator()(const f32x4 (&acc)[2][2][4][2], const Unit& u, int wr, int wc, int fr, int fq, f32x4 (&pre)[4]) const {
        asm volatile("" : "+v"(fr), "+v"(fq));
        const int rt0 = wr * 64 + fr, col0 = u.pn * BM + wc * 32 + 8 * fq;
        asm volatile("" : "+v"(pre[0]), "+v"(pre[1]), "+v"(pre[2]), "+v"(pre[3]) :: "memory");
        f32x4 bv[2][2]; bv[0][0] = pre[0]; bv[0][1] = pre[1]; bv[1][0] = pre[2]; bv[1][1] = pre[3];
        constexpr float WI = 1.f / (W8_SCALE * ACT8_SCALE);
#pragma unroll
        for (int ai = 0; ai < 2; ++ai)
#pragma unroll
            for (int m = 0; m < 4; ++m) { const int rt = rt0 + ai * HALF + m * 16, p = u.p0 + rt;
                const u32x2 mt = *(const LAS u32x2*)(lds + MoeSched::META_OFF + u.par * 2048 + rt * 8);
                const bool valid = p < u.cnt; const int slot = valid ? (int)mt.x : 0; const unsigned gbits = mt.y; const float g = __builtin_bit_cast(float, gbits);
                unsigned char* rowp = valid ? oslot + (size_t)slot * DM + col0 : dummy + col0;
                const float gs = g * OS8_SCALE;
#pragma unroll
                for (int bj = 0; bj < 2; ++bj) { const f32x4 v0 = (acc[ai][bj][m][0] * WI + bv[bj][0]) * gs, v1 = (acc[ai][bj][m][1] * WI + bv[bj][1]) * gs;
                    u32x2 w; w.x = pk4_fp8(v0[0], v0[1], v0[2], v0[3]); w.y = pk4_fp8(v1[0], v1[1], v1[2], v1[3]);
                    *(u32x2*)(rowp + bj * HALF) = w; } }
    }
};
struct EpiNull {
    float* dummy;
    __device__ __forceinline__ void operator()(const f32x4 (&acc)[2][2][4][2], const Unit& u, int wr, int wc, int fr, int fq, f32x4 (&)[4]) const {
        float sacc = 0.f;
#pragma unroll
        for (int ai = 0; ai < 2; ++ai)
#pragma unroll
            for (int bj = 0; bj < 2; ++bj)
#pragma unroll
                for (int m = 0; m < 4; ++m)
#pragma unroll
                    for (int n = 0; n < 2; ++n) sacc += (acc[ai][bj][m][n][0] + acc[ai][bj][m][n][1]) + (acc[ai][bj][m][n][2] + acc[ai][bj][m][n][3]);
        dummy[(size_t)blockIdx.x * 512 + threadIdx.x] = sacc;
    }
};
}

namespace att {
constexpr int LDQ = NH * QKH, LDK = NH * QKH, LDV = NH * VH, LDO = DM;
constexpr int KT_BYTES = 64 * QKH * 2, VT_BYTES = 64 * VH * 2;
constexpr int L_K = 0, L_V = 3 * KT_BYTES, L_WS = L_V + 3 * VT_BYTES, L_END = L_WS + 8 * 256;
constexpr float THRL = 8.f * 1.4426950408889634f;
__device__ __forceinline__ int crow(int r, int hi) { return (r & 3) + 8 * (r >> 2) + 4 * hi; }
#define SBAR() __builtin_amdgcn_sched_barrier(0)
__device__ __forceinline__ int v_rd_base(int lane) { return ((lane & 3) << 3) | (((lane >> 2) & 3) << 6) | (((lane >> 4) & 1) << 5) | (((lane >> 5) & 1) << 8); }
constexpr int v_rd_off(int d0, int ks, int half) { return d0 * 512 + ks * 4096 + half * 2048; }
template <int OFF> __device__ __forceinline__ s16x4 tr_read(int vb) {
    s16x4 r; asm volatile("ds_read_b64_tr_b16 %0, %1 offset:%2" : "=&v"(r) : "v"(vb), "i"(OFF) : "memory"); return r;
}
template <int D0> __device__ __forceinline__ void pv_one(f32x16& od, int vb, bf16x8 pa0, bf16x8 pa1, bf16x8 pa2, bf16x8 pa3) {
    const s16x4 l0 = tr_read<v_rd_off(D0, 0, 0)>(vb), h0 = tr_read<v_rd_off(D0, 0, 1)>(vb), l1 = tr_read<v_rd_off(D0, 1, 0)>(vb), h1 = tr_read<v_rd_off(D0, 1, 1)>(vb);
    const s16x4 l2 = tr_read<v_rd_off(D0, 2, 0)>(vb), h2 = tr_read<v_rd_off(D0, 2, 1)>(vb), l3 = tr_read<v_rd_off(D0, 3, 0)>(vb), h3 = tr_read<v_rd_off(D0, 3, 1)>(vb);
    asm volatile("s_waitcnt lgkmcnt(0)" ::: "memory"); SBAR();
#define PK(L, H) (bf16x8){L[0], L[1], L[2], L[3], H[0], H[1], H[2], H[3]}
    od = __builtin_amdgcn_mfma_f32_32x32x16_bf16(pa0, PK(l0, h0), od, 0, 0, 0);
    od = __builtin_amdgcn_mfma_f32_32x32x16_bf16(pa1, PK(l1, h1), od, 0, 0, 0);
    od = __builtin_amdgcn_mfma_f32_32x32x16_bf16(pa2, PK(l2, h2), od, 0, 0, 0);
    od = __builtin_amdgcn_mfma_f32_32x32x16_bf16(pa3, PK(l3, h3), od, 0, 0, 0);
#undef PK
}
__device__ __forceinline__ void glds16(const void* gsrc, LAS unsigned char* dst) {
    __builtin_amdgcn_global_load_lds((const unsigned*)gsrc, (LAS unsigned*)dst, 16, 0, 0);
}
__device__ __forceinline__ void attn_unit(int b, int h, int qb, const bf16_t* Q, const bf16_t* Kg, const bf16_t* Vg, bf16_t* O, LAS unsigned char* lds) {
    const int tid = threadIdx.x, wid = __builtin_amdgcn_readfirstlane(tid >> 6), lane = tid & 63, r32 = lane & 31, hi = lane >> 5;
    const int grp = wid >> 2;
    const size_t tok0 = (size_t)b * SEQ;
    bf16x8 qr[12];
    { const bf16_t* Qw = Q + (tok0 + (size_t)qb * 256 + wid * 32 + r32) * LDQ + h * QKH + hi * 8;
#pragma unroll
      for (int d0 = 0; d0 < 12; ++d0) qr[d0] = *(const bf16x8*)(Qw + d0 * 16); }
    unsigned koff[3], voff[2];
#pragma unroll
    for (int i = 0; i < 3; ++i) { const int G = 64 * (wid + 8 * i) + lane, row = G / 24, cgs = G % 24, cg = (cgs & ~7) | ((cgs & 7) ^ ((row >> 1) & 7)); koff[i] = (unsigned)(row * LDK * 2 + cg * 16); }
#pragma unroll
    for (int i = 0; i < 2; ++i) { const int p = wid + 8 * i, sub = 2 * p + (lane >> 5), kkh = sub >> 2, cblk = sub & 3, kkl = (lane & 31) >> 2, cl = (lane & 3) * 8, kk = kkh * 8 + kkl;
        const int k = (kk & ~0xC) | ((kk & 4) << 1) | ((kk & 8) >> 1), c = cblk * 32 + cl; voff[i] = (unsigned)(k * LDV * 2 + c * 2); }
    const __amdgpu_buffer_rsrc_t rK = __builtin_amdgcn_make_buffer_rsrc((void*)(Kg + tok0 * LDK + h * QKH), 0, -1, 0x00020000), rV = __builtin_amdgcn_make_buffer_rsrc((void*)(Vg + tok0 * LDV + h * VH), 0, -1, 0x00020000);
#define ATT_DMA(j, buf) do { \
        _Pragma("unroll") for (int i_ = 0; i_ < 3; ++i_) __builtin_amdgcn_raw_ptr_buffer_load_lds(rK, (LAS void*)(lds + L_K + (buf) * KT_BYTES + (wid + 8 * i_) * 1024), 16, koff[i_], (unsigned)(j) * (64u * LDK * 2u), 0, 0); \
        _Pragma("unroll") for (int i_ = 0; i_ < 2; ++i_) __builtin_amdgcn_raw_ptr_buffer_load_lds(rV, (LAS void*)(lds + L_V + (buf) * VT_BYTES + (wid + 8 * i_) * 1024), 16, voff[i_], (unsigned)(j) * (64u * LDV * 2u), 0, 0); } while (0)
#define ATT_BAR() do { asm volatile("" ::: "memory"); __builtin_amdgcn_s_barrier(); asm volatile("" ::: "memory"); } while (0)
    const int swz = (r32 >> 1) & 7; int kx[4];
#pragma unroll
    for (int dd = 0; dd < 4; ++dd) kx[dd] = r32 * (QKH * 2) + (((2 * dd + hi) ^ swz) << 4);
    LAS float* ws = (LAS float*)(lds + L_WS) + wid * 64; LAS float* li_l = ws; LAS float* al_l = ws + 32;
    const int vb0 = L_V + v_rd_base(lane);
    float m_reg = -1e30f, l_reg = 0.f; f32x16 o[4];
#pragma unroll
    for (int d = 0; d < 4; ++d)
#pragma unroll
        for (int r = 0; r < 16; ++r) o[d][r] = 0.f;
    const int NT = 4 * qb + 4, my_last = 4 * qb + (wid >> 1);
    ATT_DMA(0, 0); ATT_DMA(1, 1);
    asm volatile("s_waitcnt vmcnt(5)" ::: "memory"); ATT_BAR();
    if (grp == 1) ATT_BAR();
    int kb = 0, nb = 2;
    for (int j = 0; j < NT; ++j) {
        const bool live = (j <= my_last), more = (j + 2 < NT);
        f32x16 p0, p1;
        if (grp == 1 && more) ATT_DMA(j + 2, nb);
        if (live) {
            const LAS unsigned char* Ks = lds + L_K + kb * KT_BYTES;
#pragma unroll
            for (int r = 0; r < 16; ++r) { p0[r] = 0.f; p1[r] = 0.f; }
#pragma unroll
            for (int d0 = 0; d0 < 12; ++d0) {
                const bf16x8 b0 = *(const LAS bf16x8*)(Ks + kx[d0 & 3] + (d0 >> 2) * 128);
                const bf16x8 b1 = *(const LAS bf16x8*)(Ks + kx[d0 & 3] + (d0 >> 2) * 128 + 32 * QKH * 2);
                p0 = __builtin_amdgcn_mfma_f32_32x32x16_bf16(b0, qr[d0], p0, 0, 0, 0);
                p1 = __builtin_amdgcn_mfma_f32_32x32x16_bf16(b1, qr[d0], p1, 0, 0, 0);
            }
        }
        if (grp == 1) { if (j + 1 < NT) { if (more) asm volatile("s_waitcnt vmcnt(5)" ::: "memory"); else asm volatile("s_waitcnt vmcnt(0)" ::: "memory"); } }
        ATT_BAR();
        if (grp == 0 && more) ATT_DMA(j + 2, nb);
        if (live) {
            float pmax = p0[0];
#pragma unroll
            for (int r = 1; r < 16; ++r) pmax = fmaxf(pmax, p0[r]);
#pragma unroll
            for (int r = 0; r < 16; ++r) pmax = fmaxf(pmax, p1[r]);
            { auto rr = __builtin_amdgcn_permlane32_swap(__float_as_uint(pmax), __float_as_uint(pmax), false, false);
              pmax = fmaxf(__uint_as_float(rr[0]), __uint_as_float(rr[1])); }
            float mn, alpha;
            if (__builtin_expect(__all(pmax - m_reg <= THRL), 1)) { mn = m_reg; alpha = 1.f; }
            else { mn = fmaxf(m_reg, pmax); alpha = __builtin_amdgcn_exp2f(m_reg - mn); m_reg = mn; }
#pragma unroll
            for (int r = 0; r < 16; ++r) { p0[r] = __builtin_amdgcn_exp2f(p0[r] - mn); p1[r] = __builtin_amdgcn_exp2f(p1[r] - mn); }
            float ps = 0.f;
#pragma unroll
            for (int r = 0; r < 16; ++r) ps += p0[r];
#pragma unroll
            for (int r = 0; r < 16; ++r) ps += p1[r];
            { auto rr = __builtin_amdgcn_permlane32_swap(__float_as_uint(ps), __float_as_uint(ps), false, false);
              ps = __uint_as_float(rr[0]) + __uint_as_float(rr[1]); }
            l_reg = l_reg * alpha + ps;
            if (__any(alpha < 1.f)) { if (hi == 0) al_l[r32] = alpha; asm volatile("s_waitcnt lgkmcnt(0)" ::: "memory");
#pragma unroll
                for (int r = 0; r < 16; ++r) { const float a = al_l[crow(r, hi)];
#pragma unroll
                    for (int d = 0; d < 4; ++d) o[d][r] *= a; } }
            bf16x8 pa0, pa1, pa2, pa3;
#define PK4(P, BASE, OUT) do { unsigned a0 = cvt_pk_bf16(P[BASE + 0], P[BASE + 1]), a1 = cvt_pk_bf16(P[BASE + 2], P[BASE + 3]);   \
    unsigned b0_ = cvt_pk_bf16(P[BASE + 4], P[BASE + 5]), b1_ = cvt_pk_bf16(P[BASE + 6], P[BASE + 7]);                              \
    auto r0 = __builtin_amdgcn_permlane32_swap(a0, b0_, false, false); auto r1 = __builtin_amdgcn_permlane32_swap(a1, b1_, false, false); \
    u32x4 w = {r0[0], r1[0], r0[1], r1[1]}; OUT = __builtin_bit_cast(bf16x8, w); } while (0)
            PK4(p0, 0, pa0); PK4(p0, 8, pa1); PK4(p1, 0, pa2); PK4(p1, 8, pa3);
#undef PK4
            const int vb = vb0 + kb * VT_BYTES;
            pv_one<0>(o[0], vb, pa0, pa1, pa2, pa3); pv_one<1>(o[1], vb, pa0, pa1, pa2, pa3); pv_one<2>(o[2], vb, pa0, pa1, pa2, pa3); pv_one<3>(o[3], vb, pa0, pa1, pa2, pa3);
        }
        if (grp == 0) { if (j + 1 < NT) { if (more) asm volatile("s_waitcnt vmcnt(5)" ::: "memory"); else asm volatile("s_waitcnt vmcnt(0)" ::: "memory"); } }
        ATT_BAR();
        kb = (kb == 2) ? 0 : kb + 1; nb = (nb == 2) ? 0 : nb + 1;
    }
    if (grp == 0) ATT_BAR();
    if (hi == 0) li_l[r32] = l_reg; asm volatile("s_waitcnt lgkmcnt(0)" ::: "memory");
    bf16_t* Ow = O + (tok0 + (size_t)qb * 256 + wid * 32) * LDO + h * VH;
#pragma unroll
    for (int r = 0; r < 16; ++r) { const int orow = crow(r, hi); const float rl = __builtin_amdgcn_rcpf(li_l[orow]);
#pragma unroll
        for (int d0 = 0; d0 < 4; ++d0) Ow[(size_t)orow * LDO + d0 * 32 + r32] = (bf16_t)f2bf(o[d0][r] * rl); }
    asm volatile("s_waitcnt lgkmcnt(0)" ::: "memory"); ATT_BAR();
#undef ATT_DMA
#undef ATT_BAR
}
#undef SBAR
}

#define XB_TMO      128
#define XB_XCNT(j)  (256  + 64 * (j))
#define XB_XSUB(j)  (1280 + 64 * (j))
#define XB_XGEN(j)  (2304 + 64 * (j))
#define XB_TOP      3328
#define XB_TOPGEN   3392
#define XCD_BAR_WORDS 3456
#define XB_SPIN_CAP (1u << 18)
__device__ __forceinline__ unsigned xb_ld(unsigned* p)              { return __hip_atomic_load(p, __ATOMIC_RELAXED, __HIP_MEMORY_SCOPE_AGENT); }
__device__ __forceinline__ unsigned xb_add(unsigned* p, unsigned v) { return __hip_atomic_fetch_add(p, v, __ATOMIC_RELAXED, __HIP_MEMORY_SCOPE_AGENT); }
__device__ __forceinline__ unsigned xb_xcc_id() { return (unsigned)__builtin_amdgcn_s_getreg((3 << 11) | 20) & 0xFu; }
#define XB_SPIN(cond, bar) do { unsigned _sp = 0; while (cond) { __builtin_amdgcn_s_sleep(1); \
    if ((++_sp & 255u) == 0u) { if (xb_ld(&(bar)[XB_TMO])) break; if (_sp > XB_SPIN_CAP) { atomicAdd(&(bar)[XB_TMO], 1u); break; } } } } while (0)
struct XcdBarrier { unsigned* bar; unsigned x; volatile LAS unsigned* st; };
__device__ __forceinline__ XcdBarrier xcd_barrier_post(unsigned* bar, volatile LAS unsigned* st) {
    XcdBarrier b; b.bar = bar; b.x = xb_xcc_id(); b.st = st;
    if (threadIdx.x == 0) (void)xb_add(&bar[XB_XCNT(b.x)], 1u);
    return b;
}
__device__ __forceinline__ void xcd_barrier_complete(unsigned* bar, unsigned x, unsigned& nloc, unsigned& nx) {
    const unsigned G = gridDim.x * gridDim.y * gridDim.z;
    unsigned sum, cnt, mine, sp = 0u;
    for (;;) {
        sum = 0u; cnt = 0u; mine = 0u;
#pragma unroll
        for (unsigned j = 0; j < 16; ++j) { const unsigned c = xb_ld(&bar[XB_XCNT(j)]); sum += c; cnt += (c > 0u) ? 1u : 0u; mine = (j == x) ? c : mine; }
        if (sum == G) break;
        __builtin_amdgcn_s_sleep(1);
        if ((++sp & 255u) == 0u) { if (xb_ld(&bar[XB_TMO])) break; if (sp > XB_SPIN_CAP) { atomicAdd(&bar[XB_TMO], 1u); break; } }
    }
    nloc = mine > 0u ? mine : 1u; nx = cnt > 0u ? cnt : 1u;
}
__device__ __forceinline__ void xcd_barrier(const XcdBarrier& b) {
    asm volatile("s_waitcnt vmcnt(0)" ::: "memory");
    __syncthreads();
    if (threadIdx.x == 0) {
        unsigned* bar = b.bar;
        __builtin_amdgcn_s_waitcnt(0);
        unsigned nloc = b.st[0], nx = b.st[1];
        if (nloc == 0u) { xcd_barrier_complete(bar, b.x, nloc, nx); b.st[0] = nloc; b.st[1] = nx; }
        const unsigned old = xb_add(&bar[XB_XSUB(b.x)], 1u);
        const unsigned gen = old / nloc;
        if (old + 1u == (gen + 1u) * nloc) {
            __builtin_amdgcn_fence(__ATOMIC_RELEASE, "agent");
            asm volatile("s_waitcnt vmcnt(0)" ::: "memory");
            const unsigned og = xb_add(&bar[XB_TOP], 1u);
            const unsigned tg = og / nx;
            if (og + 1u == (tg + 1u) * nx) xb_add(&bar[XB_TOPGEN], 1u);
            else XB_SPIN(xb_ld(&bar[XB_TOPGEN]) == tg, bar);
            __builtin_amdgcn_fence(__ATOMIC_ACQUIRE, "agent");
            xb_add(&bar[XB_XGEN(b.x)], 1u);
            asm volatile("s_waitcnt vmcnt(0)" ::: "memory");
        } else {
            XB_SPIN(xb_ld(&bar[XB_XGEN(b.x)]) == gen, bar);
            __builtin_amdgcn_fence(__ATOMIC_ACQUIRE, "agent");
            asm volatile("s_waitcnt vmcnt(0)" ::: "memory");
        }
    }
    __syncthreads();
}

constexpr int NWAVES = 8;
constexpr int N_LAUNCHES = MK_N_LAUNCHES;
constexpr int N_PHASES = 10;
struct Args { const float* in[18]; float* out; unsigned char* ws; int ph_lo, ph_hi; };

__device__ __forceinline__ void p0_transpose_item(const float* W, int K, int N, bf16_t* WT, int drow0, const float* kscale, LAS unsigned* scr, int k0, int n0, int lane, bool ileave = false) {
    const int g = lane >> 4, l16 = lane & 15;
    f32x4 v[16];
#pragma unroll
    for (int i = 0; i < 16; ++i) { const int kk = (i >> 1) * 8 + g * 2 + (i & 1); v[i] = __builtin_nontemporal_load((const f32x4*)(W + (size_t)(k0 + kk) * N + n0 + 4 * l16)); }
    if (kscale) {
#pragma unroll
        for (int i = 0; i < 16; ++i) { const int kk = (i >> 1) * 8 + g * 2 + (i & 1); v[i] = v[i] * kscale[k0 + kk]; } }
#pragma unroll
    for (int j = 0; j < 8; ++j) { const int kp = j * 4 + g;
#pragma unroll
        for (int c = 0; c < 4; ++c) scr[(4 * l16 + c) * 33 + kp] = cvt_pk_bf16(v[2 * j][c], v[2 * j + 1][c]); }
    LDS_WAIT(); asm volatile("" ::: "memory");
    const int c8 = lane & 7;
#pragma unroll
    for (int jj = 0; jj < 8; ++jj) { const int n = jj * 8 + (lane >> 3); const LAS unsigned* t = scr + n * 33 + 4 * c8;
        u32x4 o; o.x = t[0]; o.y = t[1]; o.z = t[2]; o.w = t[3];
        const int dn = ileave ? ((n < 32) ? 2 * n : 2 * (n - 32) + 1) : n;
        *(u32x4*)(WT + (size_t)(drow0 + dn) * K + k0 + 8 * c8) = o; }
    LDS_WAIT(); asm volatile("" ::: "memory");
}

__device__ __forceinline__ void p0_transpose_item8(const float* W, int K, int N, unsigned char* WT, int drow0, const float* kscale, LAS unsigned* scr, int k0, int n0, int lane) {
    const int g = lane >> 4, l16 = lane & 15;
    f32x4 v[32];
#pragma unroll
    for (int i = 0; i < 32; ++i) { const int kk = (i >> 2) * 16 + g * 4 + (i & 3); v[i] = __builtin_nontemporal_load((const f32x4*)(W + (size_t)(k0 + kk) * N + n0 + 4 * l16)); }
#pragma unroll
    for (int i = 0; i < 32; ++i) { const int kk = (i >> 2) * 16 + g * 4 + (i & 3); v[i] = v[i] * (kscale ? kscale[k0 + kk] * W8_SCALE : W8_SCALE); }
#pragma unroll
    for (int j = 0; j < 8; ++j) { const int kd = j * 4 + g;
#pragma unroll
        for (int c = 0; c < 4; ++c) scr[(4 * l16 + c) * 33 + kd] = pk4_fp8(v[4 * j][c], v[4 * j + 1][c], v[4 * j + 2][c], v[4 * j + 3][c]); }
    LDS_WAIT(); asm volatile("" ::: "memory");
    const int c8 = lane & 7;
#pragma unroll
    for (int jj = 0; jj < 8; ++jj) { const int n = jj * 8 + (lane >> 3); const LAS unsigned* t = scr + n * 33 + 4 * c8;
        u32x4 o; o.x = t[0]; o.y = t[1]; o.z = t[2]; o.w = t[3];
        *(u32x4*)(WT + (size_t)(drow0 + n) * K + k0 + 16 * c8) = o; }
    LDS_WAIT(); asm volatile("" ::: "memory");
}

template <int PHMASK> __global__ void __launch_bounds__(NWAVES * 64, 2) fwd_kernel_t(Args args) {
    extern __shared__ __attribute__((aligned(16))) unsigned char lds_raw[];
    LAS unsigned char* lds = (LAS unsigned char*)lds_raw;
    volatile LAS unsigned* MISC = (volatile LAS unsigned*)(lds + MISC_OFF);
    const int tid = threadIdx.x, lane = tid & 63, wave = __builtin_amdgcn_readfirstlane(tid >> 6);
    const int G = gridDim.x; const int bx = blockIdx.x; const int vcu = (G % 8 == 0) ? (bx % 8) * (G / 8) + bx / 8 : bx;
    unsigned char* ws = args.ws;
    unsigned* ctl = (unsigned*)(ws + WS_CTL);
    const float* x = args.in[0]; const float* norm_mix = args.in[1]; const float* w_in = args.in[2]; const float* conv_w = args.in[3];
    const float* q_norm = args.in[4]; const float* w_uq = args.in[5]; const float* kv_norm = args.in[6]; const float* w_ukv = args.in[7];
    const float* q_head_norm = args.in[8]; const float* k_head_norm = args.in[9]; const float* w_o = args.in[10]; const float* norm_ffn = args.in[11];
    const float* w_router = args.in[12]; const float* b_router = args.in[13]; const float* w_gate_up = args.in[14]; const float* b_gate_up = args.in[15];
    const float* w_down = args.in[16]; const float* b_down = args.in[17];
    float* out = args.out;
    f32x2* rope_t = (f32x2*)(ws + WS_ROPE);
    bf16_t* WrH = (bf16_t*)(ws + WS_WRH); bf16_t* WrL = (bf16_t*)(ws + WS_WRL);
    bf16_t* Win_t = (bf16_t*)(ws + WS_WIN); bf16_t* Wuq_t = (bf16_t*)(ws + WS_WUQ); bf16_t* Wukv_t = (bf16_t*)(ws + WS_WUKV); bf16_t* Wo_t = (bf16_t*)(ws + WS_WO);
    float* ssq = (float*)(ws + WS_SSQ); float* rs2 = (float*)(ws + WS_RS2); float* gate = (float*)(ws + WS_GATE); int* tos = (int*)(ws + WS_TOS);
    unsigned char* Wgu_t = ws + WS_WGU; unsigned char* Wdn_t = ws + WS_WDN;
    unsigned char* hq = ws + WS_HB;
    bf16_t* qb_ = (bf16_t*)(ws + WS_Q); bf16_t* kb_ = (bf16_t*)(ws + WS_K); bf16_t* vb_ = (bf16_t*)(ws + WS_V); bf16_t* mix = (bf16_t*)(ws + WS_MIX);
    bf16_t* oslot = (bf16_t*)(ws + WS_OSLOT); bf16_t* hn = (bf16_t*)(ws + WS_HN); bf16_t* pbuf = (bf16_t*)(ws + WS_PB); bf16_t* qraw = (bf16_t*)(ws + WS_QRAW); bf16_t* kvraw = (bf16_t*)(ws + WS_KVRAW);
    unsigned char* act = ws + WS_ACT;

    for (int u = tid; u < (LDS_BYTES - MISC_OFF) / 4; u += NWAVES * 64) ((LAS unsigned*)(lds + MISC_OFF))[u] = 0u;
    __syncthreads();
    XcdBarrier bar; bar.bar = ctl + CW_BAR; bar.x = 0; bar.st = nullptr;
    if (N_LAUNCHES == 1) bar = xcd_barrier_post(ctl + CW_BAR, MISC + 8);
#define GRID_BAR() do { if (N_LAUNCHES == 1) xcd_barrier(bar); } while (0)
    const int lo = args.ph_lo, hi = args.ph_hi;
#define IN(k) (((PHMASK >> (k)) & 1) && lo <= (k) && (k) < hi)
#define BOTH(k) (IN(k) && IN((k) + 1))
    const int gw = vcu * NWAVES + wave, NGW = G * NWAVES;

    if (IN(0)) {
        LAS unsigned* scr = (LAS unsigned*)(lds + wave * 16384);
        constexpr int I_IN = (DM / 64) * (NPROJ / 64), I_UQ = (QL / 64) * (768 / 64), I_UKV = (KVL / 64) * (1024 / 64), I_O = (DM / 64) * (DM / 64);
        constexpr int I_GU1 = (DM / 128) * (2 * DFF / 64), I_GU = NE * I_GU1, I_DN1 = (DFF / 128) * (DM / 64), I_DN = NE * I_DN1;
        constexpr int NITEMS = I_IN + I_UQ + I_UKV + I_O + I_GU + I_DN;
        for (int it = gw; it < NITEMS; it += NGW) {
            int r = it;
            if (r < I_GU) { const int e = r / I_GU1, q = r % I_GU1, nblk = 2 * DFF / 64, kb = q / nblk, nb = q % nblk, n0 = nb * 64, j = n0 & (DFF - 1), up = n0 >= DFF;
                p0_transpose_item8(w_gate_up + (size_t)e * DM * 2 * DFF, DM, 2 * DFF, Wgu_t + (size_t)e * 2 * DFF * DM, (j >> 7) * 256 + (j & 127) + (up ? 128 : 0), norm_ffn, scr, kb * 128, n0, lane); continue; } r -= I_GU;
            if (r < I_DN) { const int e = r / I_DN1, q = r % I_DN1, nblk = DM / 64, kb = q / nblk, nb = q % nblk;
                p0_transpose_item8(w_down + (size_t)e * DFF * DM, DFF, DM, Wdn_t + (size_t)e * DM * DFF, nb * 64, nullptr, scr, kb * 128, nb * 64, lane); continue; } r -= I_DN;
            if (r < I_IN) { const int nblk = NPROJ / 64, kb = r / nblk, nb = r % nblk, n0 = nb * 64;
                const int d0 = (n0 < 1536) ? n0 : (n0 < 1920 ? n0 + (PB_CQ - 1536) : (n0 < 2176 ? n0 - (1920 - PB_CKV) : n0));
                p0_transpose_item(w_in, DM, NPROJ, Win_t, d0, nullptr, scr, kb * 64, n0, lane); continue; } r -= I_IN;
            if (r < I_UQ) { const int nblk = 768 / 64, kb = r / nblk, nb = r % nblk, h = nb / 3, part = nb % 3;
                p0_transpose_item(w_uq, QL, 768, Wuq_t, h * 256 + part * 64, q_norm, scr, kb * 64, nb * 64, lane, part == 2); continue; } r -= I_UQ;
            if (r < I_UKV) { const int nblk = 1024 / 64, kb = r / nblk, nb = r % nblk; p0_transpose_item(w_ukv, KVL, 1024, Wukv_t, nb * 64, kv_norm, scr, kb * 64, nb * 64, lane); continue; } r -= I_UKV;
            { const int nblk = DM / 64, kb = r / nblk, nb = r % nblk; p0_transpose_item(w_o, DM, DM, Wo_t, nb * 64, nullptr, scr, kb * 64, nb * 64, lane); }
        }
        const int gt = vcu * (NWAVES * 64) + tid, NGT = G * NWAVES * 64;
        for (int i = gt; i < (NPP - NPROJ) * DM / 8; i += NGT) *(u32x4*)(Win_t + (size_t)NPROJ * DM + (size_t)i * 8) = (u32x4){0u, 0u, 0u, 0u};
        for (int i = gt; i < NH * 64 * QL / 8; i += NGT) { const int h = i / (64 * QL / 8), j = i % (64 * QL / 8); *(u32x4*)(Wuq_t + (size_t)(h * 256 + 192) * QL + (size_t)j * 8) = (u32x4){0u, 0u, 0u, 0u}; }
        for (int i = gt; i < NE * DM; i += NGT) { const int e = i / DM, k = i % DM; const float v = w_router[(size_t)k * NE + e] * norm_ffn[k]; const unsigned h = f2bf(v); const float hf = __builtin_bit_cast(float, h << 16);
            WrH[i] = (bf16_t)h; WrL[i] = (bf16_t)f2bf(v - hf); }
        for (int i = gt; i < SEQ * 32; i += NGT) { const int pos = i >> 5, fi = i & 31; const float inv = exp2f(-(float)fi * (13.287712379549449f / 32.f)); const float ang = (float)pos * inv; float s, c; sincosf(ang, &s, &c); rope_t[i] = (f32x2){c, s}; }
        for (int m = 2 * gw; m < NTOK; m += 2 * NGW) {
            const f32x4* xr = (const f32x4*)(x + (size_t)m * DM) + lane; const f32x4* gr = (const f32x4*)norm_mix + lane;
            f32x4 v[2][4]; float s0 = 0.f, s1 = 0.f;
#pragma unroll
            for (int j = 0; j < 4; ++j) { v[0][j] = __builtin_nontemporal_load(xr + 64 * j); v[1][j] = __builtin_nontemporal_load(xr + DM / 4 + 64 * j); }
#pragma unroll
            for (int j = 0; j < 4; ++j) { s0 += (v[0][j].x * v[0][j].x + v[0][j].y * v[0][j].y) + (v[0][j].z * v[0][j].z + v[0][j].w * v[0][j].w);
                                          s1 += (v[1][j].x * v[1][j].x + v[1][j].y * v[1][j].y) + (v[1][j].z * v[1][j].z + v[1][j].w * v[1][j].w); }
            const float r0 = 1.0f / sqrtf(wave_sum(s0) * (1.f / DM) + EPS), r1 = 1.0f / sqrtf(wave_sum(s1) * (1.f / DM) + EPS);
            u32x2* o8 = (u32x2*)(hn + (size_t)m * DM) + lane;
#pragma unroll
            for (int j = 0; j < 4; ++j) { const f32x4 g = gr[64 * j]; u32x2 w;
                w.x = cvt_pk_bf16(v[0][j].x * r0 * g.x, v[0][j].y * r0 * g.y); w.y = cvt_pk_bf16(v[0][j].z * r0 * g.z, v[0][j].w * r0 * g.w); o8[64 * j] = w;
                w.x = cvt_pk_bf16(v[1][j].x * r1 * g.x, v[1][j].y * r1 * g.y); w.y = cvt_pk_bf16(v[1][j].z * r1 * g.z, v[1][j].w * r1 * g.w); o8[DM / 4 + 64 * j] = w; }
        }
        if (BOTH(0)) GRID_BAR();
    }

    if (IN(1)) {
        pg8::DenseSched S; S.init(hn, DM, Win_t, NTOK, NPP, DM, G, bx);
        pg8::EpiProj E{pbuf, ssq};
        pg8::gemm_phase<pg8::EpiProj, pg8::DenseSched, false>(lds, S, E);
        if (BOTH(1)) GRID_BAR();
    }

    const bool p2_all = IN(2);
    if (p2_all || IN(13)) {
        {
            const int gt = vcu * (NWAVES * 64) + tid, NGT = G * NWAVES * 64;
            for (int it = gt; it < (NTOK / 16) * 64; it += NGT) {
                const int run = it >> 6, gr = it & 63, t0 = run * 16, ch = gr * 8;
                float w0[8], w1[8], w2[8];
#pragma unroll
                for (int i = 0; i < 8; ++i) { w0[i] = conv_w[ch + i]; w1[i] = conv_w[CONVW + ch + i]; w2[i] = conv_w[2 * CONVW + ch + i]; }
                float um2[8], um1[8];
#pragma unroll
                for (int i = 0; i < 8; ++i) { um2[i] = 0.f; um1[i] = 0.f; }
                if ((t0 & (SEQ - 1)) != 0) {
                    float c8[8], x8[8];
                    unpack8(*(const u32x4*)(pbuf + (size_t)(t0 - 2) * NPP + PB_C + ch), c8); unpack8(*(const u32x4*)(pbuf + (size_t)(t0 - 2) * NPP + PB_X + ch), x8);
#pragma unroll
                    for (int i = 0; i < 8; ++i) um2[i] = c8[i] * x8[i];
                    unpack8(*(const u32x4*)(pbuf + (size_t)(t0 - 1) * NPP + PB_C + ch), c8); unpack8(*(const u32x4*)(pbuf + (size_t)(t0 - 1) * NPP + PB_X + ch), x8);
#pragma unroll
                    for (int i = 0; i < 8; ++i) um1[i] = c8[i] * x8[i];
                }
#pragma unroll 4
                for (int t = 0; t < 16; ++t) {
                    const bf16_t* pr = pbuf + (size_t)(t0 + t) * NPP + ch;
                    float b8[8], c8[8], x8[8], o8[8];
                    unpack8(__builtin_nontemporal_load((const u32x4*)(pr + PB_B)), b8); unpack8(__builtin_nontemporal_load((const u32x4*)(pr + PB_C)), c8); unpack8(__builtin_nontemporal_load((const u32x4*)(pr + PB_X)), x8);
#pragma unroll
                    for (int i = 0; i < 8; ++i) { const float uu = c8[i] * x8[i]; o8[i] = b8[i] * (w0[i] * um2[i] + w1[i] * um1[i] + w2[i] * uu); um2[i] = um1[i]; um1[i] = uu; }
                    *(u32x4*)(mix + (size_t)(t0 + t) * DM + ch) = pack8(o8);
                }
            }
        }
    }
    if (p2_all || IN(14) || IN(15)) {
        LAS float* etab = (LAS float*)(lds + EPI_TAB_OFF);
        if (p2_all || IN(14)) { pg8::DenseSched S; S.init(pbuf + PB_CQ, NPP, Wuq_t, NTOK, NQP, QL, G, bx); pg8::EpiQ E{qb_, ssq, q_head_norm, rope_t, etab};
          pg8::gemm_phase<pg8::EpiQ, pg8::DenseSched, false>(lds, S, E); }
        if (p2_all || IN(15)) { pg8::DenseSched S; S.init(pbuf + PB_CKV, NPP, Wukv_t, NTOK, 1024, KVL, G, bx); pg8::EpiKV E{kb_, vb_, ssq, k_head_norm, rope_t, pbuf, etab};
          pg8::gemm_phase<pg8::EpiKV, pg8::DenseSched, false>(lds, S, E); }
        if (BOTH(2)) GRID_BAR();
    }


    if (IN(4)) {
        for (int u = vcu; u < NB * NH * 4; u += G) {
            const int bh = u >> 2, pr = u & 3, b = bh >> 2, h = bh & 3;
            att::attn_unit(b, h, 7 - pr, qb_, kb_, vb_, mix + CONVW, lds);
            att::attn_unit(b, h, pr, qb_, kb_, vb_, mix + CONVW, lds);
        }
        if (BOTH(4)) GRID_BAR();
    }

    if (IN(5)) {
        pg8::DenseSched S; S.init(mix, DM, Wo_t, NTOK, DM, DM, G, bx);
        pg8::EpiOut E{x, (bf16_t*)(ws + WS_H1B), ssq};
        pg8::gemm_phase<pg8::EpiOut, pg8::DenseSched, false>(lds, S, E);
        if (BOTH(5)) GRID_BAR();
    }

    if (IN(6) || IN(16)) {
        const bool dry = !IN(6);
        LAS unsigned* hist = (LAS unsigned*)(lds + MISC_OFF) + 128; LAS unsigned* base = (LAS unsigned*)(lds + MISC_OFF) + 160;
        const int tj = lane & 15, q = lane >> 4;
        for (int i = tid; i < 2 * NE * 128; i += NWAVES * 64) { const int sel = i >> 12, r = (i >> 7) & 31, g = i & 127;
            const u32x4 v = *(const u32x4*)((sel ? WrL : WrH) + (size_t)r * DM + g * 8);
            *(LAS u32x4*)(lds + sel * 65536 + r * 2048 + ((g ^ (r & 15)) << 4)) = v; }
        __syncthreads();
        for (int tile = vcu; tile < NTOK / 128; tile += G) {
            if (tid < 32) hist[tid] = 0u;
            __syncthreads();
            const int token = tile * 128 + wave * 16 + tj;
            const bf16_t* hrow = (const bf16_t*)(ws + WS_H1B) + (size_t)token * DM + q * 8;
            f32x4 a0 = {0.f, 0.f, 0.f, 0.f}, a1 = {0.f, 0.f, 0.f, 0.f};
            float s2 = 0.f;
#pragma unroll
            for (int p = 0; p < 16; ++p) s2 += ssq[(size_t)p * NTOK + token];
            const float rs = 1.0f / sqrtf(s2 * (1.f / DM) + EPS);
            unsigned char* hqrow = hq + (size_t)token * DM + q * 8;
            const LAS unsigned char* wlds = lds + tj * 2048;
#pragma unroll 1
            for (int kh = 0; kh < 2; ++kh) {
                u32x4 hv[16];
#pragma unroll
                for (int kk = 0; kk < 16; ++kk) hv[kk] = *(const u32x4*)(hrow + (kh * 16 + kk) * 32);
#pragma unroll
                for (int kk = 0; kk < 16; ++kk) { const int ks = kh * 16 + kk;
                    const u32x4 hw = hv[kk]; float hf[8]; unpack8(hw, hf);
                    { u32x2 w8; w8.x = pk4_fp8(hf[0] * rs, hf[1] * rs, hf[2] * rs, hf[3] * rs); w8.y = pk4_fp8(hf[4] * rs, hf[5] * rs, hf[6] * rs, hf[7] * rs); *(u32x2*)(hqrow + ks * 32) = w8; }
                    const bf16x8 bh = __builtin_bit_cast(bf16x8, hw);
                    const int go = (((ks * 4 + q) ^ tj) << 4);
                    const bf16x8 wh_a = *(const LAS bf16x8*)(wlds + go), wh_b = *(const LAS bf16x8*)(wlds + 16 * 2048 + go);
                    const bf16x8 wl_a = *(const LAS bf16x8*)(wlds + 65536 + go), wl_b = *(const LAS bf16x8*)(wlds + 65536 + 16 * 2048 + go);
                    a0 = __builtin_amdgcn_mfma_f32_16x16x32_bf16(wh_a, bh, a0, 0, 0, 0); a0 = __builtin_amdgcn_mfma_f32_16x16x32_bf16(wl_a, bh, a0, 0, 0, 0);
                    a1 = __builtin_amdgcn_mfma_f32_16x16x32_bf16(wh_b, bh, a1, 0, 0, 0); a1 = __builtin_amdgcn_mfma_f32_16x16x32_bf16(wl_b, bh, a1, 0, 0, 0);
                }
            }
            float lv[8]; int le[8];
#pragma unroll
            for (int i = 0; i < 4; ++i) { le[i] = 4 * q + i; le[4 + i] = 16 + 4 * q + i; lv[i] = a0[i] * rs + b_router[le[i]]; lv[4 + i] = a1[i] * rs + b_router[le[4 + i]]; }
            float tv[4]; int te[4];
#pragma unroll
            for (int k = 0; k < TOPK; ++k) {
                float bv = lv[0]; int be = le[0];
#pragma unroll
                for (int i = 1; i < 8; ++i) if (lv[i] > bv) { bv = lv[i]; be = le[i]; }
#pragma unroll
                for (int o = 16; o < 64; o <<= 1) { const float ov = __shfl_xor(bv, o); const int oe = __shfl_xor(be, o); if (ov > bv || (ov == bv && oe < be)) { bv = ov; be = oe; } }
                tv[k] = bv; te[k] = be;
#pragma unroll
                for (int i = 0; i < 8; ++i) if (le[i] == be) lv[i] = -3.0e38f;
            }
            float ge[4]; float gs = 0.f;
#pragma unroll
            for (int k = 0; k < TOPK; ++k) { ge[k] = __expf(tv[k] - tv[0]); gs += ge[k]; }
            const float ginv = 1.0f / gs;
            int my_e = te[0]; float my_g = ge[0];
#pragma unroll
            for (int k = 1; k < TOPK; ++k) if (q == k) { my_e = te[k]; my_g = ge[k]; }
            my_g *= ginv;
            const unsigned pl = atomicAdd((unsigned*)(hist + my_e), 1u);
            __syncthreads();
            if (tid < 32) base[tid] = dry ? 0u : __hip_atomic_fetch_add(ctl + CW_CNT + 64 * tid, hist[tid], __ATOMIC_RELAXED, __HIP_MEMORY_SCOPE_AGENT);
            __syncthreads();
            const unsigned pos = base[my_e] + pl; const int slot = token * 4 + q;
            if (!dry) *(u32x2*)(tos + ((size_t)my_e * CAP + pos) * 2) = (u32x2){(unsigned)slot, __builtin_bit_cast(unsigned, my_g)};
            else if (my_g < -1.f) rs2[token] = my_g;
            __syncthreads();
        }
        if (BOTH(6)) GRID_BAR();
    }

    LAS int* tab = (LAS int*)(lds + MISC_OFF) + 16;
    if (IN(7) || IN(8) || IN(10) || IN(11) || IN(12)) {
        if (tid < 32) { const int c = (int)__hip_atomic_load(ctl + CW_CNT + 64 * tid, __ATOMIC_RELAXED, __HIP_MEMORY_SCOPE_AGENT); tab[48 + tid] = c; }
        __syncthreads();
        if (tid == 0) { int s = 0; for (int e = 0; e < NE; ++e) { tab[e] = s; s += (tab[48 + e] + 255) >> 8; } tab[32] = s; }
        __syncthreads();
        for (int t = tid; t < tab[32]; t += NWAVES * 64) { int e = 0; while (e < NE - 1 && tab[e + 1] <= t) ++e; tab[2288 + t] = e; }
        __syncthreads();
    }

    if (IN(7)) {
        pg8::MoeSched S{hq, Wgu_t, DM, DM, 2 * DFF / 256, G, bx, (size_t)2 * DFF * DM, tab, tos, b_gate_up};
        pg8::EpiSwiglu E{act, b_gate_up};
        pg8::gemm_phase<pg8::EpiSwiglu, pg8::MoeSched, true>(lds, S, E);
        if (BOTH(7)) GRID_BAR();
    }

    if (IN(8)) {
        pg8::MoeSched S{act, Wdn_t, DFF, DFF, DM / 256, G, bx, (size_t)DM * DFF, tab, tos, b_down};
        pg8::EpiDown E{(unsigned char*)oslot, b_down, ws + WS_SSQ, lds};
        pg8::gemm_phase<pg8::EpiDown, pg8::MoeSched, false>(lds, S, E);
        if (BOTH(8)) GRID_BAR();
    }

#if PROBE_DOUBLE
    if (IN(10)) { pg8::MoeSched S{hq, Wgu_t, DM, DM, 2 * DFF / 256, G, bx, (size_t)2 * DFF * DM, tab, tos, b_gate_up}; pg8::EpiNull E{(float*)(ws + WS_SSQ)};
        pg8::gemm_phase<pg8::EpiNull, pg8::MoeSched, true>(lds, S, E); }
    if (IN(11)) { pg8::MoeSched S{act, Wdn_t, DFF, DFF, DM / 256, G, bx, (size_t)DM * DFF, tab, tos, b_down}; pg8::EpiNull E{(float*)(ws + WS_SSQ)};
        pg8::gemm_phase<pg8::EpiNull, pg8::MoeSched, false, 2>(lds, S, E); }
    if (IN(12)) { pg8::MoeSched S{act, Wdn_t, DFF, DFF, DM / 256, G, bx, (size_t)DM * DFF, tab, tos, b_down}; pg8::EpiNull E{(float*)(ws + WS_SSQ)};
        pg8::gemm_phase<pg8::EpiNull, pg8::MoeSched, false>(lds, S, E); }
#endif
    if (IN(9)) {
        const unsigned char* os8 = (const unsigned char*)oslot;
        constexpr float OI = 1.f / OS8_SCALE;
        for (int m = gw; m < NTOK; m += NGW) {
            f32x4* orow = (f32x4*)(out + (size_t)m * DM) + lane;
            const u32x2* hrow = (const u32x2*)((const bf16_t*)(ws + WS_H1B) + (size_t)m * DM) + lane;
            const unsigned* s0 = (const unsigned*)(os8 + (size_t)m * 4 * DM) + lane;
            unsigned w[4][4]; f32x4 hv[4];
#pragma unroll
            for (int j = 0; j < 4; ++j) { const u32x2 hb2 = __builtin_nontemporal_load(hrow + 64 * j); hv[j] = (f32x4){bf_lo(hb2.x), bf_hi(hb2.x), bf_lo(hb2.y), bf_hi(hb2.y)};
#pragma unroll
                for (int k = 0; k < 4; ++k) w[j][k] = __builtin_nontemporal_load(s0 + (size_t)k * (DM / 4) + 64 * j); }
#pragma unroll
            for (int j = 0; j < 4; ++j) { f32x4 a = {0.f, 0.f, 0.f, 0.f};
#pragma unroll
                for (int k = 0; k < 4; ++k) { const f32x2 lo = __builtin_amdgcn_cvt_pk_f32_fp8(w[j][k], false), hi2 = __builtin_amdgcn_cvt_pk_f32_fp8(w[j][k], true); a.x += lo.x; a.y += lo.y; a.z += hi2.x; a.w += hi2.y; }
                __builtin_nontemporal_store(hv[j] + a * OI, orow + 64 * j); }
        }
    }
#undef IN
#undef BOTH
#undef GRID_BAR
}

#ifdef DIAG_PHASES
template __global__ void fwd_kernel_t<1>(Args); template __global__ void fwd_kernel_t<2>(Args); template __global__ void fwd_kernel_t<4>(Args); template __global__ void fwd_kernel_t<8>(Args);
template __global__ void fwd_kernel_t<16>(Args); template __global__ void fwd_kernel_t<32>(Args); template __global__ void fwd_kernel_t<64>(Args); template __global__ void fwd_kernel_t<128>(Args);
template __global__ void fwd_kernel_t<256>(Args); template __global__ void fwd_kernel_t<512>(Args);
#endif
#define fwd_kernel fwd_kernel_t<(PROBE_DOUBLE ? 0x1ffff : 1023)>
extern "C" void kernel_launch(void* const* d_in, const int* in_sizes, int n_in, void* d_out, int out_size, void* d_ws, size_t ws_size, hipStream_t stream) {
    static int grid = 0;
    if (grid == 0) {
        if (n_in != 18 || in_sizes[0] != NTOK * DM || out_size != NTOK * DM || ws_size < WS_END) { fprintf(stderr, "kernel_launch: shape/workspace mismatch (n_in %d, in0 %d, out %d, ws %zu, need %zu)\n", n_in, n_in > 0 ? in_sizes[0] : -1, out_size, ws_size, (size_t)WS_END); grid = -1; return; }
        int dev = 0, cus = 0, per_cu = 0;
        if (hipGetDevice(&dev) != hipSuccess || hipDeviceGetAttribute(&cus, hipDeviceAttributeMultiprocessorCount, dev) != hipSuccess) { grid = -1; return; }
        if (hipFuncSetAttribute((const void*)fwd_kernel, hipFuncAttributeMaxDynamicSharedMemorySize, LDS_BYTES) != hipSuccess) { fprintf(stderr, "kernel_launch: hipFuncSetAttribute failed\n"); grid = -1; return; }
        if (hipOccupancyMaxActiveBlocksPerMultiprocessor(&per_cu, (const void*)fwd_kernel, NWAVES * 64, LDS_BYTES) != hipSuccess || per_cu < 1) { fprintf(stderr, "kernel_launch: occupancy query says %d\n", per_cu); }
        (void)hipGetLastError();
        grid = cus;
    }
    if (grid < 0) return;
    if (hipMemsetAsync((char*)d_ws + WS_CTL, 0, CTL_ZERO_BYTES, stream) != hipSuccess) return;
    Args a{};
    for (int i = 0; i < 18; ++i) a.in[i] = (const float*)d_in[i];
    a.out = (float*)d_out; a.ws = (unsigned char*)d_ws;
    if (N_LAUNCHES == 1) { a.ph_lo = 0; a.ph_hi = N_PHASES; hipLaunchKernelGGL(fwd_kernel, dim3(grid), dim3(NWAVES * 64), LDS_BYTES, stream, a); }
    else { for (int p = 0; p < N_PHASES; ++p) { a.ph_lo = p; a.ph_hi = p + 1; const int reps = ((PROBE_DOUBLE >> p) & 1) ? 2 : 1;
            for (int r = 0; r < reps; ++r) hipLaunchKernelGGL(fwd_kernel, dim3(grid), dim3(NWAVES * 64), LDS_BYTES, stream, a);
            if (p == 8) for (int pp = 10; pp < 13; ++pp) if ((PROBE_DOUBLE >> pp) & 1) { a.ph_lo = pp; a.ph_hi = pp + 1; hipLaunchKernelGGL(fwd_kernel, dim3(grid), dim3(NWAVES * 64), LDS_BYTES, stream, a); }
            if (p == 6 && ((PROBE_DOUBLE >> 16) & 1)) { a.ph_lo = 16; a.ph_hi = 17; hipLaunchKernelGGL(fwd_kernel, dim3(grid), dim3(NWAVES * 64), LDS_BYTES, stream, a); }
            if (p == 2) for (int pp = 13; pp < 16; ++pp) if ((PROBE_DOUBLE >> pp) & 1) { a.ph_lo = pp; a.ph_hi = pp + 1; hipLaunchKernelGGL(fwd_kernel, dim3(grid), dim3(NWAVES * 64), LDS_BYTES, stream, a); } } }
}
```

```cpp
#include <hip/hip_runtime.h>
#include <cstdio>
#include <cstdint>

#ifndef MK_N_LAUNCHES
#define MK_N_LAUNCHES 1
#endif

#ifndef PROBE_DOUBLE
#define PROBE_DOUBLE 0
#endif
#define LAS __attribute__((address_space(3)))
#define GAS __attribute__((address_space(1)))
typedef unsigned short bf16_t;
typedef short bf16x8 __attribute__((ext_vector_type(8)));
typedef short s16x4 __attribute__((ext_vector_type(4)));
typedef float f32x2 __attribute__((ext_vector_type(2)));
typedef float f32x4 __attribute__((ext_vector_type(4)));
typedef float f32x16 __attribute__((ext_vector_type(16)));
typedef unsigned u32x2 __attribute__((ext_vector_type(2)));
typedef unsigned u32x4 __attribute__((ext_vector_type(4)));
typedef int v4i_t __attribute__((ext_vector_type(4)));
typedef int v8i_t __attribute__((ext_vector_type(8)));

constexpr int NB = 16, SEQ = 2048, NTOK = NB * SEQ, DM = 1024;
constexpr int CONVW = 512, QL = 384, KVL = 256, ROPE = 64, NH = 4, QKN = 128, QKH = 192, VH = 128;
constexpr int NPROJ = 2240, NPP = 2304;
constexpr int PB_B = 0, PB_U = 512, PB_CKV = 1024, PB_CQ = 1280, PB_KPE = 1664, NPB = 1728;
constexpr int NQP = 1024;
constexpr int NE = 32, TOPK = 4, DFF = 1024, NSLOT = NTOK * TOPK;
constexpr int CAP = NTOK;
constexpr int MAXTILES = NSLOT / 256 + NE;
constexpr float EPS = 1e-6f;
constexpr float QSCALE = 0.07216878364870322f * 1.4426950408889634f;
constexpr float SWI_LIMIT = 7.0f, SWI_ALPHA = 1.702f;
constexpr float W8_SCALE = 64.f, ACT8_SCALE = 4.f, OS8_SCALE = 16.f;

constexpr size_t MiB = 1u << 20;
constexpr size_t WS_CTL = 0, CTL_ZERO_BYTES = 1 * MiB;
constexpr size_t WS_ROPE = 1 * MiB;
constexpr size_t WS_WRH = 1 * MiB + 512 * 1024, WS_WRL = WS_WRH + 64 * 1024;
constexpr size_t WS_WIN = 2 * MiB;
constexpr size_t WS_WUQ = 8 * MiB, WS_WUKV = 9 * MiB, WS_WO = 10 * MiB;
constexpr size_t WS_SSQ = 12 * MiB;
constexpr size_t WS_RS2 = 14 * MiB, WS_GATE = 14 * MiB + 512 * 1024;
constexpr size_t WS_TOS = 16 * MiB;
constexpr size_t WS_WGU = 32 * MiB, WS_WDN = 160 * MiB;
constexpr size_t WS_HB = 224 * MiB;
constexpr size_t WS_Q = 288 * MiB, WS_K = 336 * MiB, WS_V = 384 * MiB, WS_MIX = 416 * MiB;
constexpr size_t WS_OSLOT = 288 * MiB;
constexpr size_t WS_HN = 544 * MiB, WS_PB = 608 * MiB, WS_QRAW = 752 * MiB, WS_KVRAW = 800 * MiB;
constexpr size_t WS_ACT = 544 * MiB;
constexpr size_t WS_H1B = 768 * MiB;
constexpr size_t WS_END = 864 * MiB;
constexpr int CW_BAR = 4096;
constexpr int CW_CNT = 16384;

constexpr int RING_BYTES = 131072;
constexpr int MISC_OFF = RING_BYTES;
constexpr int LDS_BYTES = 155648;
constexpr int EPI_TAB_OFF = MISC_OFF + 3072 * 4;

__device__ __forceinline__ unsigned cvt_pk_bf16(float lo, float hi) { unsigned r; asm volatile("v_cvt_pk_bf16_f32 %0, %1, %2" : "=v"(r) : "v"(lo), "v"(hi)); return r; }
__device__ __forceinline__ unsigned f2bf(float f) { unsigned u = __builtin_bit_cast(unsigned, f); return (u + 0x7fffu + ((u >> 16) & 1u)) >> 16; }
__device__ __forceinline__ unsigned pk2(float lo, float hi) { return f2bf(lo) | (f2bf(hi) << 16); }
__device__ __forceinline__ float bf_lo(unsigned w) { return __builtin_bit_cast(float, w << 16); }
__device__ __forceinline__ float bf_hi(unsigned w) { return __builtin_bit_cast(float, w & 0xffff0000u); }
__device__ __forceinline__ void unpack8(const u32x4 w, float* f) { f[0] = bf_lo(w.x); f[1] = bf_hi(w.x); f[2] = bf_lo(w.y); f[3] = bf_hi(w.y); f[4] = bf_lo(w.z); f[5] = bf_hi(w.z); f[6] = bf_lo(w.w); f[7] = bf_hi(w.w); }
__device__ __forceinline__ u32x4 pack8(const float* f) { u32x4 w; w.x = cvt_pk_bf16(f[0], f[1]); w.y = cvt_pk_bf16(f[2], f[3]); w.z = cvt_pk_bf16(f[4], f[5]); w.w = cvt_pk_bf16(f[6], f[7]); return w; }
__device__ __forceinline__ float wave_sum(float v) {
#pragma unroll
    for (int o = 1; o < 64; o <<= 1) v += __shfl_xor(v, o);
    return v;
}
__device__ __forceinline__ float half_sum(float v) {
#pragma unroll
    for (int o = 1; o < 32; o <<= 1) v += __shfl_xor(v, o);
    return v;
}
__device__ __forceinline__ float clamp448(float v) { return __builtin_amdgcn_fmed3f(v, -448.f, 448.f); }
__device__ __forceinline__ unsigned pk4_fp8_nc(float a, float b, float c, float d) {
    unsigned w = 0u; w = (unsigned)__builtin_amdgcn_cvt_pk_fp8_f32(a, b, (int)w, false); w = (unsigned)__builtin_amdgcn_cvt_pk_fp8_f32(c, d, (int)w, true); return w; }
__device__ __forceinline__ unsigned pk4_fp8(float a, float b, float c, float d) {
    unsigned w = 0u; w = (unsigned)__builtin_amdgcn_cvt_pk_fp8_f32(clamp448(a), clamp448(b), (int)w, false); w = (unsigned)__builtin_amdgcn_cvt_pk_fp8_f32(clamp448(c), clamp448(d), (int)w, true); return w; }
#define LDS_WAIT() asm volatile("s_waitcnt lgkmcnt(0)" ::: "memory")
#define VM_WAIT() asm volatile("s_waitcnt vmcnt(0)" ::: "memory")

namespace pg8 {
constexpr int BM = 256, BK = 64, HALF = 128, HTB = HALF * BK * 2, STAGE_BYTES = 8 * HTB, NXCD = 8, WGM = 4;
__host__ __device__ __forceinline__ int lds_byte(int r, int c) { const int st = (r >> 4) * 2 + (c >> 5), rr = r & 15, cc = c & 31, ob = rr * 64 + cc * 2; return st * 1024 + (ob ^ (((ob >> 9) & 1) << 5)); }
__host__ __device__ __forceinline__ void stage_rc(int b, int& R, int& C) { const int st = b / 1024, sb = b % 1024, swz = sb ^ (((sb >> 9) & 1) << 5); R = (st >> 1) * 16 + swz / 64; C = (st & 1) * 32 + (swz % 64) / 2; }
__host__ __device__ __forceinline__ int perm32(int rho) { const int n = rho >> 4, i = rho & 15; return 8 * (i >> 2) + 4 * n + (i & 3); }

struct Unit { int pm, pn, e, p0, cnt, par, half; };

__device__ __forceinline__ bool deal_unit(int i, int nwg, int G, int c, int& wgid, int& half) {
    half = 0;
    if (G % NXCD != 0) { const long L = (long)i * G + c; if (L >= nwg) return false; wgid = (int)L; return true; }
    const int W = G / NXCD, x = c % NXCD, rk = c / NXCD, q = nwg / NXCD, r = nwg % NXCD;
    const int cnt = q + (x < r ? 1 : 0), base = (x < r ? x * (q + 1) : r * (q + 1) + (x - r) * q);
    const int R = cnt / W, E = cnt - R * W;
    if (i < R) { wgid = base + i * W + rk; return true; }
    if (i > R) return false;
    if (rk >= E) return false; wgid = base + R * W + rk; return true;
}
struct DenseSched {
    static constexpr int ESZ = 2;
    const bf16_t* A; const bf16_t* Bt; int lda, K, nM, nN, nwg, G, c;
    __device__ void init(const bf16_t* A_, int lda_, const bf16_t* Bt_, int M, int N, int K_, int G_, int c_) { A = A_; Bt = Bt_; lda = lda_; K = K_; nM = M / BM; nN = N / BM; nwg = nM * nN; G = G_; c = c_; }
    __device__ __forceinline__ bool next(int i, Unit& u) const {
        int wgid, half; if (!deal_unit(i, nwg, G, c, wgid, half)) return false;
        const int nig = WGM * nN, gid = wgid / nig, fm = gid * WGM, gsz = (nM - fm) < WGM ? (nM - fm) : WGM;
        u.pm = fm + ((wgid % nig) % gsz); u.pn = (wgid % nig) / gsz; u.e = 0; u.p0 = 0; u.cnt = 0; u.half = half; return true;
    }
    __device__ __forceinline__ unsigned a_off(const Unit& u) const { return (unsigned)u.pm * (unsigned)(BM * lda * 2); }
    __device__ __forceinline__ unsigned b_off(const Unit& u) const { return (unsigned)u.pn * (unsigned)(BM * K * 2); }
    __device__ __forceinline__ unsigned a_rowoff(const Unit&, int) const { return 0u; }
    static constexpr bool META = false;
    __device__ __forceinline__ void meta_first(const Unit&, LAS unsigned char*) const {}
    __device__ __forceinline__ void meta_issue(const Unit&, LAS unsigned char*) const {}
    __device__ __forceinline__ void pre_issue(const Unit&, LAS unsigned char*) const {}
    __device__ __forceinline__ unsigned meta_rowoff(const Unit&, int, LAS unsigned char*) const { return 0u; }
};
struct MoeSched {
    static constexpr int ESZ = 1;
    const unsigned char* A; const unsigned char* Bt; int lda, K, nN, G, c; size_t estride; const LAS int* tab; const int* tos; const float* bias;
    static constexpr bool META = true;
    static constexpr int META_OFF = MISC_OFF + 4608 * 4;
    __device__ __forceinline__ bool next(int i, Unit& u) const {
        const int T = __builtin_amdgcn_readfirstlane(tab[32]), nwg = T * nN;
        int wgid, half; if (!deal_unit(i, nwg, G, c, wgid, half)) return false; u.half = half;
        const int nig = WGM * nN, gid = wgid / nig, fm = gid * WGM, gsz = (T - fm) < WGM ? (T - fm) : WGM;
        const int mt = fm + ((wgid % nig) % gsz); u.pm = mt; u.pn = (wgid % nig) / gsz;
        const int e = __builtin_amdgcn_readfirstlane(tab[2288 + mt]);
        u.e = e; u.p0 = (mt - __builtin_amdgcn_readfirstlane(tab[e])) * BM; u.cnt = __builtin_amdgcn_readfirstlane(tab[48 + e]); return true;
    }
    __device__ __forceinline__ unsigned a_off(const Unit& u) const { return (unsigned)u.pm * (unsigned)(BM * lda); }
    __device__ __forceinline__ unsigned b_off(const Unit& u) const { return (unsigned)u.e * (unsigned)estride + (unsigned)u.pn * (unsigned)(BM * K); }
    __device__ __forceinline__ unsigned a_rowoff(const Unit& u, int r) const {
        const int p = u.p0 + r; const int sv = tos[((size_t)u.e * CAP + p) * 2];
        const int slot = (p < u.cnt) ? sv : 0;
        return (unsigned)(slot >> 2) * (unsigned)lda;
    }
    static constexpr int BIAS_OFF = MISC_OFF + 5632 * 4;
    __device__ __forceinline__ void meta_first(const Unit& u, LAS unsigned char* lds) const { meta_issue(u, lds); }
    __device__ __forceinline__ void meta_issue(const Unit& u, LAS unsigned char* lds) const {
        const __amdgpu_buffer_rsrc_t rT = __builtin_amdgcn_make_buffer_rsrc((void*)tos, 0, -1, 0x00020000);
        const int wid = __builtin_amdgcn_readfirstlane(threadIdx.x >> 6);
        __builtin_amdgcn_raw_ptr_buffer_load_lds(rT, (LAS void*)(lds + META_OFF + u.par * 2048 + wid * 256), 4, (threadIdx.x & 63) * 4u, ((unsigned)u.e * (unsigned)CAP + (unsigned)u.p0) * 8u + (unsigned)wid * 256u, 0, 0);
    }
    __device__ __forceinline__ void pre_issue(const Unit& u, LAS unsigned char* lds) const {
        const int wid = __builtin_amdgcn_readfirstlane(threadIdx.x >> 6);
        if (wid < 4) { const __amdgpu_buffer_rsrc_t rB = __builtin_amdgcn_make_buffer_rsrc((void*)bias, 0, -1, 0x00020000);
            const unsigned src = (nN == 8) ? (((unsigned)u.e * (2u * DFF) + (unsigned)u.pn * HALF) * 4u + (wid >= 2 ? DFF * 4u - 512u : 0u)) : (((unsigned)u.e * DM + (unsigned)u.pn * BM) * 4u);
            __builtin_amdgcn_raw_ptr_buffer_load_lds(rB, (LAS void*)(lds + BIAS_OFF + u.par * 1024 + wid * 256), 4, (threadIdx.x & 63) * 4u, src + (unsigned)wid * 256u, 0, 0); }
    }
    __device__ __forceinline__ unsigned meta_rowoff(const Unit& u, int r, LAS unsigned char* lds) const {
        const int sv = *(const LAS int*)(lds + META_OFF + u.par * 2048 + r * 8);
        const int slot = (u.p0 + r < u.cnt) ? sv : 0;
        return (unsigned)(slot >> 2) * (unsigned)lda;
    }
};

template <class Epi, class Sched, bool GATHER, int KREP = 1>
__device__ __forceinline__ void gemm_phase(LAS unsigned char* lds, const Sched& S, const Epi& E) {
    const int tid = threadIdx.x, wid = __builtin_amdgcn_readfirstlane(tid >> 6), lane = tid & 63, wr = wid >> 2, wc = wid & 3, fr = lane & 15, fq = lane >> 4;
    constexpr int ESZ = Sched::ESZ; constexpr bool F8 = (ESZ == 1);
    const int K = S.K * ESZ / 2, lda = S.lda * ESZ / 2, nt0 = K / BK, nt = nt0 * KREP;
    unsigned voffB[2], aoc[2][2]; int RA[2], CA[2];
#pragma unroll
    for (int i = 0; i < 2; ++i) { int R, C; stage_rc(tid * 16 + i * 8192, R, C); const int Rb = (R & ~31) + perm32(R & 31);
        voffB[i] = (unsigned)(Rb * K + C) * 2u; RA[i] = R; CA[i] = C;
        aoc[0][i] = (unsigned)(R * lda + C) * 2u; aoc[1][i] = (unsigned)((R + HALF) * lda + C) * 2u; }
    const unsigned kstep = (unsigned)(BK * 2);
    const unsigned hstepB = (unsigned)(HALF * K * 2), hstepA = GATHER ? 0u : (unsigned)(HALF * lda * 2);
    const __amdgpu_buffer_rsrc_t rA = __builtin_amdgcn_make_buffer_rsrc((void*)S.A, 0, -1, 0x00020000), rB = __builtin_amdgcn_make_buffer_rsrc((void*)S.Bt, 0, -1, 0x00020000);
    const unsigned ldsw = (unsigned)wid * 1024u;
    const int aoff = lds_byte(wr * 64 + fr, fq * 8), boff = lds_byte(wc * 32 + fr, fq * 8);
#define PG8_SA(b, h) (((b) * 2 + (h)) * HTB)
#define PG8_SB(b, h) ((4 + (b) * 2 + (h)) * HTB)
#define PG8_STAGE_B(bufoff, soff) do { _Pragma("unroll") for (int _i = 0; _i < 2; ++_i) \
        __builtin_amdgcn_raw_ptr_buffer_load_lds(rB, (LAS void*)(lds + (bufoff) + ldsw + _i * 8192), 16, voffB[_i], (soff), 0, 0); } while (0)
#define PG8_STAGE_A(bufoff, soff, h) do { _Pragma("unroll") for (int _i = 0; _i < 2; ++_i) \
        __builtin_amdgcn_raw_ptr_buffer_load_lds(rA, (LAS void*)(lds + (bufoff) + ldsw + _i * 8192), 16, aoc[GATHER ? (h) : 0][_i], (soff) + (h) * hstepA, 0, 0); } while (0)
#define PG8_LDA(dst, b, h) do { _Pragma("unroll") for (int m = 0; m < 4; ++m) _Pragma("unroll") for (int k = 0; k < 2; ++k) dst[m][k] = *(const LAS bf16x8*)(lds + PG8_SA(b, h) + aoff + m * 2048 + k * 1024); } while (0)
#define PG8_LDB(dst, b, h) do { _Pragma("unroll") for (int n = 0; n < 2; ++n) _Pragma("unroll") for (int k = 0; k < 2; ++k) dst[n][k] = *(const LAS bf16x8*)(lds + PG8_SB(b, h) + boff + n * 2048 + k * 1024); } while (0)
#define PG8_CAT(x) __builtin_shufflevector(__builtin_bit_cast(v4i_t, x[0]), __builtin_bit_cast(v4i_t, x[1]), 0, 1, 2, 3, 4, 5, 6, 7)
#define PG8_MMA(ai, bj, At, Bt) do { __builtin_amdgcn_s_setprio(1); _Pragma("unroll") for (int m = 0; m < 4; ++m) _Pragma("unroll") for (int n = 0; n < 2; ++n) { \
        if constexpr (F8) { asm volatile("v_mfma_scale_f32_16x16x128_f8f6f4 %0, %1, %2, %0, %3, %3 op_sel_hi:[0,0,0]" : "+v"(acc[ai][bj][m][n]) : "v"(PG8_CAT(Bt[n])), "v"(PG8_CAT(At[m])), "v"(0x7f7f7f7f)); } \
        else { _Pragma("unroll") for (int k = 0; k < 2; ++k) acc[ai][bj][m][n] = __builtin_amdgcn_mfma_f32_16x16x32_bf16(Bt[n][k], At[m][k], acc[ai][bj][m][n], 0, 0, 0); } } \
        __builtin_amdgcn_s_setprio(0); } while (0)
#define PG8_WAIT_V(n) asm volatile("s_waitcnt vmcnt(" #n ")" ::: "memory")
#define PG8_WAIT_L(n) asm volatile("s_waitcnt lgkmcnt(" #n ")" ::: "memory")
#define PG8_BAR __builtin_amdgcn_s_barrier()
#define PG8_SCHED __builtin_amdgcn_sched_barrier(0)
    Unit cur, nxt; int ui = 0;
    if (!S.next(0, cur)) return;
    cur.par = 0; if constexpr (Sched::META) S.meta_first(cur, lds);
    f32x4 acc[2][2][4][2];
#pragma unroll
    for (int a = 0; a < 2; ++a)
#pragma unroll
        for (int b = 0; b < 2; ++b)
#pragma unroll
            for (int m = 0; m < 4; ++m)
#pragma unroll
                for (int n = 0; n < 2; ++n) acc[a][b][m][n] = (f32x4){0.f, 0.f, 0.f, 0.f};
    bf16x8 At[4][2], B0[2][2], B1[2][2];
    unsigned cA = GATHER ? 0u : S.a_off(cur), cB = S.b_off(cur);
    if constexpr (GATHER) {
#pragma unroll
        for (int h = 0; h < 2; ++h)
#pragma unroll
            for (int i = 0; i < 2; ++i) aoc[h][i] = S.a_rowoff(cur, h * HALF + RA[i]) + (unsigned)CA[i] * 2u;
    }
    PG8_STAGE_B(PG8_SB(0, 0), cB); PG8_STAGE_B(PG8_SB(0, 1), cB + hstepB); PG8_STAGE_A(PG8_SA(0, 0), cA, 0); PG8_STAGE_A(PG8_SA(0, 1), cA, 1);
    if (wr == 1) PG8_BAR;
    PG8_WAIT_V(2); PG8_BAR;
    PG8_STAGE_B(PG8_SB(1, 0), cB + kstep); PG8_STAGE_A(PG8_SA(1, 0), cA + kstep, 0); PG8_STAGE_B(PG8_SB(1, 1), cB + hstepB + kstep);
    PG8_WAIT_V(6); PG8_BAR;
    for (;;) {
        const bool has_next = S.next(ui + 1, nxt);
        const unsigned nA = GATHER ? 0u : (has_next ? S.a_off(nxt) : cA), nB = has_next ? S.b_off(nxt) : cB;
        nxt.par = (ui + 1) & 1;
        for (int t = 0; t < nt; t += 2) {
            const bool last = (t == nt - 2);
            const unsigned a1 = cA + (unsigned)((t + 1) % nt0) * kstep;
            const unsigned a2 = last ? nA : cA + (unsigned)((t + 2) % nt0) * kstep, b2 = last ? nB : cB + (unsigned)((t + 2) % nt0) * kstep;
            const unsigned a3 = a2 + kstep, b3 = b2 + kstep;
            PG8_LDB(B0, 0, 0); PG8_LDB(B1, 0, 1); PG8_SCHED; PG8_LDA(At, 0, 0); PG8_STAGE_A(PG8_SA(1, 1), a1, 1);
            PG8_WAIT_V(8); PG8_WAIT_L(0); PG8_BAR;
            if constexpr (Sched::META) { if (t == 0) { S.pre_issue(cur, lds); if (has_next) S.meta_issue(nxt, lds); } }
            PG8_MMA(0, 0, At, B0); PG8_MMA(0, 1, At, B1); PG8_BAR; PG8_SCHED;
            if constexpr (Sched::META) { if (last && has_next) {
                if constexpr (GATHER) {
#pragma unroll
                    for (int h = 0; h < 2; ++h)
#pragma unroll
                        for (int i = 0; i < 2; ++i) aoc[h][i] = S.meta_rowoff(nxt, h * HALF + RA[i], lds) + (unsigned)CA[i] * 2u;
                } } }
            PG8_LDA(At, 0, 1); PG8_STAGE_B(PG8_SB(0, 0), b2); PG8_STAGE_B(PG8_SB(0, 1), b2 + hstepB); PG8_STAGE_A(PG8_SA(0, 0), a2, 0);
            PG8_WAIT_V(8); PG8_WAIT_L(0); PG8_BAR; PG8_MMA(1, 0, At, B0); PG8_MMA(1, 1, At, B1); PG8_BAR; PG8_SCHED;
            PG8_LDB(B0, 1, 0); PG8_LDB(B1, 1, 1); PG8_SCHED; PG8_LDA(At, 1, 0); PG8_STAGE_A(PG8_SA(0, 1), a2, 1);
            PG8_WAIT_V(8); PG8_WAIT_L(0); PG8_BAR; PG8_MMA(0, 0, At, B0); PG8_MMA(0, 1, At, B1); PG8_BAR; PG8_SCHED;
            PG8_LDA(At, 1, 1); PG8_STAGE_B(PG8_SB(1, 0), b3); PG8_STAGE_B(PG8_SB(1, 1), b3 + hstepB); PG8_STAGE_A(PG8_SA(1, 0), a3, 0);
            PG8_WAIT_V(8); PG8_WAIT_L(0); PG8_BAR; PG8_MMA(1, 0, At, B0); PG8_MMA(1, 1, At, B1); PG8_BAR; PG8_SCHED;
        }
        if (wr == 0) PG8_BAR;
        E(acc, cur, wr, wc, fr, fq);
        if (!has_next) break;
#pragma unroll
        for (int a = 0; a < 2; ++a)
#pragma unroll
            for (int b = 0; b < 2; ++b)
#pragma unroll
                for (int m = 0; m < 4; ++m)
#pragma unroll
                    for (int n = 0; n < 2; ++n) acc[a][b][m][n] = (f32x4){0.f, 0.f, 0.f, 0.f};
        cur = nxt; cA = nA; cB = nB; ++ui;
        if (wr == 1) PG8_BAR;
    }
    PG8_WAIT_V(0);
    PG8_BAR;
#undef PG8_SA
#undef PG8_SB
#undef PG8_STAGE_A
#undef PG8_STAGE_B
#undef PG8_LDA
#undef PG8_LDB
#undef PG8_MMA
#undef PG8_CAT
#undef PG8_WAIT_V
#undef PG8_WAIT_L
#undef PG8_BAR
#undef PG8_SCHED
}

struct EpiBf16 {
    bf16_t* O; int ldc;
    __device__ __forceinline__ void operator()(const f32x4 (&acc)[2][2][4][2], const Unit& u, int wr, int wc, int fr, int fq) const {
        asm volatile("" : "+v"(fr), "+v"(fq));
        const int row0 = u.pm * BM + wr * 64 + fr, col0 = u.pn * BM + wc * 32 + 8 * fq;
#pragma unroll
        for (int ai = 0; ai < 2; ++ai)
#pragma unroll
            for (int m = 0; m < 4; ++m) { bf16_t* rowp = O + (size_t)(row0 + ai * HALF + m * 16) * ldc + col0;
#pragma unroll
                for (int bj = 0; bj < 2; ++bj) { const f32x4 v0 = acc[ai][bj][m][0], v1 = acc[ai][bj][m][1];
                    u32x4 w; w.x = cvt_pk_bf16(v0[0], v0[1]); w.y = cvt_pk_bf16(v0[2], v0[3]); w.z = cvt_pk_bf16(v1[0], v1[1]); w.w = cvt_pk_bf16(v1[2], v1[3]);
                    *(u32x4*)(rowp + bj * HALF) = w; } }
    }
};
struct EpiProj {
    static constexpr int NPRE = 0;
    bf16_t* O; float* st;
    __device__ __forceinline__ void operator()(const f32x4 (&acc)[2][2][4][2], const Unit& u, int wr, int wc, int fr, int fq) const {
        asm volatile("" : "+v"(fr), "+v"(fq));
        const int row0 = u.pm * BM + wr * 64 + fr, c8 = wc * 32 + 8 * fq;
        const bool pair = (u.pn >= 2 && u.pn < 6);
        const int cb0 = (u.pn < 2) ? u.pn * BM : (pair ? PB_U + (u.pn - 2) * HALF : (u.pn == 6 ? PB_CKV : (u.pn == 7 ? PB_CQ : PB_CQ + 256)));
#pragma unroll
        for (int ai = 0; ai < 2; ++ai)
#pragma unroll
            for (int m = 0; m < 4; ++m) { const int row = row0 + ai * HALF + m * 16; bf16_t* rowp = O + (size_t)row * NPB + cb0 + c8; float ss[2];
                if (pair) { const f32x4 v0 = acc[ai][0][m][0] * acc[ai][1][m][0], v1 = acc[ai][0][m][1] * acc[ai][1][m][1];
                    u32x4 w; w.x = cvt_pk_bf16(v0[0], v0[1]); w.y = cvt_pk_bf16(v0[2], v0[3]); w.z = cvt_pk_bf16(v1[0], v1[1]); w.w = cvt_pk_bf16(v1[2], v1[3]);
                    *(u32x4*)rowp = w; ss[0] = 0.f; ss[1] = 0.f;
                } else {
#pragma unroll
                    for (int bj = 0; bj < 2; ++bj) { const f32x4 v0 = acc[ai][bj][m][0], v1 = acc[ai][bj][m][1];
                        u32x4 w; w.x = cvt_pk_bf16(v0[0], v0[1]); w.y = cvt_pk_bf16(v0[2], v0[3]); w.z = cvt_pk_bf16(v1[0], v1[1]); w.w = cvt_pk_bf16(v1[2], v1[3]);
                        if (!(u.pn == 8 && bj == 1 && wc >= 2)) *(u32x4*)(rowp + bj * HALF) = w;
                        ss[bj] = (v0[0] * v0[0] + v0[1] * v0[1]) + (v0[2] * v0[2] + v0[3] * v0[3]) + (v1[0] * v1[0] + v1[1] * v1[1]) + (v1[2] * v1[2] + v1[3] * v1[3]); } }
                if (u.pn >= 6) {
                    float s0 = ss[0], s1 = ss[1]; s0 += __shfl_xor(s0, 16); s0 += __shfl_xor(s0, 32); s1 += __shfl_xor(s1, 16); s1 += __shfl_xor(s1, 32);
                    if (fq == 0) { if (u.pn == 6) st[(size_t)wc * NTOK + row] = s0 + s1; else if (u.pn == 7) st[(size_t)(4 + wc) * NTOK + row] = s0 + s1;
                                   else { st[(size_t)(8 + wc) * NTOK + row] = s0; st[(size_t)(12 + wc) * NTOK + row] = s1; } } } }
    }
};
struct EpiQ {
    bf16_t* q; const float* st; const float* qhn; const f32x2* rope; LAS float* tabs;
    __device__ __forceinline__ void operator()(const f32x4 (&acc)[2][2][4][2], const Unit& u, int wr, int wc, int fr, int fq) const {
        asm volatile("" : "+v"(fr), "+v"(fq));
        LAS float* rs_tab = tabs; LAS float* part = tabs + 512;
        const int rt0 = wr * 64 + fr;
        const int c0 = wc * 32 + 8 * fq;
        const int i0 = c0 >> 1;
        f32x4 csa[2][4][2];
        if (wc < 2) {
#pragma unroll
            for (int ai = 0; ai < 2; ++ai)
#pragma unroll
                for (int m = 0; m < 4; ++m) { const size_t row = (size_t)u.pm * BM + rt0 + ai * HALF + m * 16;
                    csa[ai][m][0] = *(const f32x4*)(rope + (row & (SEQ - 1)) * 32 + i0); csa[ai][m][1] = *(const f32x4*)(rope + (row & (SEQ - 1)) * 32 + i0 + 2); }
        }
        f32x4 g0[2], g1[2];
        g0[0] = *(const f32x4*)(qhn + c0) * QSCALE; g0[1] = *(const f32x4*)(qhn + c0 + 4) * QSCALE;
        if (wc < 2) { g1[0] = (f32x4){qhn[128 + i0], qhn[160 + i0], qhn[129 + i0], qhn[161 + i0]} * QSCALE; g1[1] = (f32x4){qhn[130 + i0], qhn[162 + i0], qhn[131 + i0], qhn[163 + i0]} * QSCALE; }
        else { g1[0] = (f32x4){0.f, 0.f, 0.f, 0.f}; g1[1] = g1[0]; }
        { const int t = threadIdx.x; if (t < BM) { const size_t r = (size_t)u.pm * BM + t; float s = 0.f;
#pragma unroll
            for (int k = 4; k < 12; ++k) s += st[(size_t)k * NTOK + r];
            rs_tab[t] = 1.0f / sqrtf(s * (1.f / QL) + EPS); } }
#pragma unroll
        for (int ai = 0; ai < 2; ++ai)
#pragma unroll
            for (int m = 0; m < 4; ++m) { float ss = 0.f;
#pragma unroll
                for (int bj = 0; bj < 2; ++bj)
#pragma unroll
                    for (int n = 0; n < 2; ++n) { const f32x4 v = acc[ai][bj][m][n]; ss += (v[0] * v[0] + v[1] * v[1]) + (v[2] * v[2] + v[3] * v[3]); }
                ss += __shfl_xor(ss, 16); ss += __shfl_xor(ss, 32);
                if (fq == 0) part[(rt0 + ai * HALF + m * 16) * 4 + wc] = ss; }
        asm volatile("s_waitcnt lgkmcnt(0)" ::: "memory"); __builtin_amdgcn_s_barrier(); asm volatile("" ::: "memory");
#pragma unroll
        for (int ai = 0; ai < 2; ++ai)
#pragma unroll
            for (int m = 0; m < 4; ++m) { const int rt = rt0 + ai * HALF + m * 16; const size_t row = (size_t)u.pm * BM + rt;
                const f32x4 pp = *(const LAS f32x4*)(part + rt * 4); const float rs = rs_tab[rt];
                const float r = rs / sqrtf(rs * rs * ((pp[0] + pp[1]) + (pp[2] + pp[3])) * (1.f / QKH) + EPS);
                bf16_t* qp = q + row * (NH * QKH) + u.pn * QKH + c0;
                { const f32x4 v0 = acc[ai][0][m][0] * g0[0] * r, v1 = acc[ai][0][m][1] * g0[1] * r;
                  u32x4 w; w.x = cvt_pk_bf16(v0[0], v0[1]); w.y = cvt_pk_bf16(v0[2], v0[3]); w.z = cvt_pk_bf16(v1[0], v1[1]); w.w = cvt_pk_bf16(v1[2], v1[3]); *(u32x4*)qp = w; }
                if (wc < 2) { const f32x4 cs0 = csa[ai][m][0], cs1 = csa[ai][m][1];
                    const f32x4 a0 = acc[ai][1][m][0] * g1[0] * r, a1 = acc[ai][1][m][1] * g1[1] * r;
                    f32x4 o0, o1;
                    o0[0] = a0[0] * cs0[0] - a0[1] * cs0[1]; o0[1] = a0[0] * cs0[1] + a0[1] * cs0[0]; o0[2] = a0[2] * cs0[2] - a0[3] * cs0[3]; o0[3] = a0[2] * cs0[3] + a0[3] * cs0[2];
                    o1[0] = a1[0] * cs1[0] - a1[1] * cs1[1]; o1[1] = a1[0] * cs1[1] + a1[1] * cs1[0]; o1[2] = a1[2] * cs1[2] - a1[3] * cs1[3]; o1[3] = a1[2] * cs1[3] + a1[3] * cs1[2];
                    u32x4 w; w.x = cvt_pk_bf16(o0[0], o0[1]); w.y = cvt_pk_bf16(o0[2], o0[3]); w.z = cvt_pk_bf16(o1[0], o1[1]); w.w = cvt_pk_bf16(o1[2], o1[3]); *(u32x4*)(qp + HALF) = w; } }
    }
};
struct EpiKV {
    bf16_t* k; bf16_t* v; const float* st; const float* khn; const f32x2* rope; const bf16_t* pb; LAS float* tabs;
    __device__ __forceinline__ void operator()(const f32x4 (&acc)[2][2][4][2], const Unit& u, int wr, int wc, int fr, int fq) const {
        asm volatile("" : "+v"(fr), "+v"(fq));
        LAS float* rs_tab = tabs; LAS float* kpe_tab = tabs + 256; LAS float* part = tabs + 512;
        const int rt0 = wr * 64 + fr;
        const int c0 = wc * 32 + 8 * fq;
        const int i0 = 8 * wc + 2 * fq;
        unsigned xas[2][4], xbs[2][4]; f32x4 css[2][4];
#pragma unroll
        for (int ai = 0; ai < 2; ++ai)
#pragma unroll
            for (int m = 0; m < 4; ++m) { const size_t row = (size_t)u.pm * BM + rt0 + ai * HALF + m * 16;
                xas[ai][m] = *(const unsigned*)(pb + row * NPB + PB_KPE + i0); xbs[ai][m] = *(const unsigned*)(pb + row * NPB + PB_KPE + 32 + i0);
                css[ai][m] = *(const f32x4*)(rope + (row & (SEQ - 1)) * 32 + i0); }
        const f32x4 g0 = *(const f32x4*)(khn + c0), g1 = *(const f32x4*)(khn + c0 + 4);
        const float gx0 = khn[128 + i0], gy0 = khn[160 + i0], gx1 = khn[129 + i0], gy1 = khn[161 + i0];
        { const int t = threadIdx.x; if (t < BM) { const size_t r = (size_t)u.pm * BM + t;
            const float s = (st[r] + st[(size_t)NTOK + r]) + (st[(size_t)2 * NTOK + r] + st[(size_t)3 * NTOK + r]);
            const float p = (st[(size_t)12 * NTOK + r] + st[(size_t)13 * NTOK + r]) + (st[(size_t)14 * NTOK + r] + st[(size_t)15 * NTOK + r]);
            rs_tab[t] = 1.0f / sqrtf(s * (1.f / KVL) + EPS); kpe_tab[t] = p; } }
#pragma unroll
        for (int ai = 0; ai < 2; ++ai)
#pragma unroll
            for (int m = 0; m < 4; ++m) { float ss = 0.f;
#pragma unroll
                for (int n = 0; n < 2; ++n) { const f32x4 x = acc[ai][0][m][n]; ss += (x[0] * x[0] + x[1] * x[1]) + (x[2] * x[2] + x[3] * x[3]); }
                ss += __shfl_xor(ss, 16); ss += __shfl_xor(ss, 32);
                if (fq == 0) part[(rt0 + ai * HALF + m * 16) * 4 + wc] = ss; }
        asm volatile("s_waitcnt lgkmcnt(0)" ::: "memory"); __builtin_amdgcn_s_barrier(); asm volatile("" ::: "memory");
#pragma unroll
        for (int ai = 0; ai < 2; ++ai)
#pragma unroll
            for (int m = 0; m < 4; ++m) { const int rt = rt0 + ai * HALF + m * 16; const size_t row = (size_t)u.pm * BM + rt;
                const f32x4 pp = *(const LAS f32x4*)(part + rt * 4); const float rs = rs_tab[rt];
                const float rh = 1.0f / sqrtf((rs * rs * ((pp[0] + pp[1]) + (pp[2] + pp[3])) + kpe_tab[rt]) * (1.f / QKH) + EPS);
                const float r = rs * rh;
                bf16_t* kp = k + row * (NH * QKH) + u.pn * QKH;
                { const f32x4 v0 = acc[ai][0][m][0] * g0 * r, v1 = acc[ai][0][m][1] * g1 * r;
                  u32x4 w; w.x = cvt_pk_bf16(v0[0], v0[1]); w.y = cvt_pk_bf16(v0[2], v0[3]); w.z = cvt_pk_bf16(v1[0], v1[1]); w.w = cvt_pk_bf16(v1[2], v1[3]); *(u32x4*)(kp + c0) = w; }
                { const f32x4 v0 = acc[ai][1][m][0] * rs, v1 = acc[ai][1][m][1] * rs;
                  u32x4 w; w.x = cvt_pk_bf16(v0[0], v0[1]); w.y = cvt_pk_bf16(v0[2], v0[3]); w.z = cvt_pk_bf16(v1[0], v1[1]); w.w = cvt_pk_bf16(v1[2], v1[3]); *(u32x4*)(v + row * (NH * VH) + u.pn * VH + c0) = w; }
                { const unsigned xa = xas[ai][m], xb = xbs[ai][m];
                  const f32x4 cs = css[ai][m];
                  const float x10 = bf_lo(xa) * gx0 * rh, x11 = bf_hi(xa) * gx1 * rh, x20 = bf_lo(xb) * gy0 * rh, x21 = bf_hi(xb) * gy1 * rh;
                  u32x2 w; w.x = cvt_pk_bf16(x10 * cs[0] - x20 * cs[1], x10 * cs[1] + x20 * cs[0]); w.y = cvt_pk_bf16(x11 * cs[2] - x21 * cs[3], x11 * cs[3] + x21 * cs[2]);
                  *(u32x2*)(kp + 128 + 2 * i0) = w; } }
    }
};
struct EpiOut {
    const float* x; bf16_t* h1b; float* ssq;
    __device__ __forceinline__ void operator()(const f32x4 (&acc)[2][2][4][2], const Unit& u, int wr, int wc, int fr, int fq) const {
        asm volatile("" : "+v"(fr), "+v"(fq));
        const int row0 = u.pm * BM + wr * 64 + fr, col0 = u.pn * BM + wc * 32 + 8 * fq;
#pragma unroll
        for (int ai = 0; ai < 2; ++ai) {
            f32x4 xv[4][2][2];
#pragma unroll
            for (int m = 0; m < 4; ++m) { const size_t off = (size_t)(row0 + ai * HALF + m * 16) * DM + col0;
#pragma unroll
                for (int bj = 0; bj < 2; ++bj) { xv[m][bj][0] = __builtin_nontemporal_load((const f32x4*)(x + off + bj * HALF)); xv[m][bj][1] = __builtin_nontemporal_load((const f32x4*)(x + off + bj * HALF + 4)); } }
            asm volatile("" ::: "memory");
#pragma unroll
            for (int m = 0; m < 4; ++m) { const int row = row0 + ai * HALF + m * 16; const size_t off = (size_t)row * DM + col0; float ss = 0.f;
#pragma unroll
                for (int bj = 0; bj < 2; ++bj) { const f32x4 v0 = acc[ai][bj][m][0] + xv[m][bj][0], v1 = acc[ai][bj][m][1] + xv[m][bj][1];
                    u32x4 w; w.x = cvt_pk_bf16(v0[0], v0[1]); w.y = cvt_pk_bf16(v0[2], v0[3]); w.z = cvt_pk_bf16(v1[0], v1[1]); w.w = cvt_pk_bf16(v1[2], v1[3]);
                    *(u32x4*)(h1b + off + bj * HALF) = w;
                    ss += (v0[0] * v0[0] + v0[1] * v0[1]) + (v0[2] * v0[2] + v0[3] * v0[3]) + (v1[0] * v1[0] + v1[1] * v1[1]) + (v1[2] * v1[2] + v1[3] * v1[3]); }
                ss += __shfl_xor(ss, 16); ss += __shfl_xor(ss, 32);
                if (fq == 0) ssq[(size_t)(u.pn * 4 + wc) * NTOK + row] = ss; }
        }
    }
};
struct EpiSwiglu {
    unsigned char* act; const float* bgu; LAS unsigned char* blds;
    __device__ __forceinline__ void operator()(const f32x4 (&acc)[2][2][4][2], const Unit& u, int wr, int wc, int fr, int fq) const {
        asm volatile("" : "+v"(fr), "+v"(fq));
        const int rt0 = wr * 64 + fr, j0 = wc * 32 + 8 * fq;
        const LAS float* bl = (const LAS float*)(blds + MoeSched::BIAS_OFF + u.par * 1024) + j0;
        const f32x4 bg0 = *(const LAS f32x4*)bl, bg1 = *(const LAS f32x4*)(bl + 4), bu0 = *(const LAS f32x4*)(bl + HALF), bu1 = *(const LAS f32x4*)(bl + HALF + 4);
        constexpr float WI = 1.f / W8_SCALE;
#pragma unroll
        for (int ai = 0; ai < 2; ++ai)
#pragma unroll
            for (int m = 0; m < 4; ++m) { const int rt = rt0 + ai * HALF + m * 16;
                float o[8];
#pragma unroll
                for (int n = 0; n < 2; ++n) { const f32x4 g4 = acc[ai][0][m][n] * WI + (n ? bg1 : bg0), u4 = acc[ai][1][m][n] * WI + (n ? bu1 : bu0);
#pragma unroll
                    for (int i = 0; i < 4; i += 2) {
                        f32x2 g, uu; g.x = fminf(g4[i], SWI_LIMIT); g.y = fminf(g4[i + 1], SWI_LIMIT);
                        uu.x = __builtin_amdgcn_fmed3f(u4[i], -SWI_LIMIT, SWI_LIMIT); uu.y = __builtin_amdgcn_fmed3f(u4[i + 1], -SWI_LIMIT, SWI_LIMIT);
                        const f32x2 t = g * (-SWI_ALPHA * 1.4426950408889634f);
                        f32x2 e; e.x = __builtin_amdgcn_exp2f(t.x); e.y = __builtin_amdgcn_exp2f(t.y);
                        const f32x2 d = e + 1.f;
                        f32x2 sg; sg.x = __builtin_amdgcn_rcpf(d.x); sg.y = __builtin_amdgcn_rcpf(d.y);
                        const f32x2 r = (uu * ACT8_SCALE + ACT8_SCALE) * (g * sg);
                        o[n * 4 + i] = r.x; o[n * 4 + i + 1] = r.y; } }
                u32x2 w; w.x = pk4_fp8_nc(o[0], o[1], o[2], o[3]); w.y = pk4_fp8_nc(o[4], o[5], o[6], o[7]);
                *(u32x2*)(act + ((size_t)u.pm * BM + rt) * DFF + u.pn * HALF + j0) = w; }
    }
};
struct EpiDown {
    unsigned char* oslot; const float* bdn; unsigned char* dummy; LAS unsigned char* lds;
    __device__ __forceinline__ void operator()(const f32x4 (&acc)[2][2][4][2], const Unit& u, int wr, int wc, int fr, int fq) const {
        asm volatile("" : "+v"(fr), "+v"(fq));
        const int rt0 = wr * 64 + fr, col0 = u.pn * BM + wc * 32 + 8 * fq;
        const LAS float* bl = (const LAS float*)(lds + MoeSched::BIAS_OFF + u.par * 1024) + wc * 32 + 8 * fq;
        f32x4 bv[2][2]; bv[0][0] = *(const LAS f32x4*)bl; bv[0][1] = *(const LAS f32x4*)(bl + 4); bv[1][0] = *(const LAS f32x4*)(bl + HALF); bv[1][1] = *(const LAS f32x4*)(bl + HALF + 4);
        constexpr float WI = 1.f / (W8_SCALE * ACT8_SCALE);
#pragma unroll
        for (int ai = 0; ai < 2; ++ai)
#pragma unroll
            for (int m = 0; m < 4; ++m) { const int rt = rt0 + ai * HALF + m * 16, p = u.p0 + rt;
                const u32x2 mt = *(const LAS u32x2*)(lds + MoeSched::META_OFF + u.par * 2048 + rt * 8);
                const bool valid = p < u.cnt; const int slot = valid ? (int)mt.x : 0; const unsigned gbits = mt.y; const float g = __builtin_bit_cast(float, gbits);
                unsigned char* rowp = valid ? oslot + (size_t)slot * DM + col0 : dummy + col0;
                const float gs = g * OS8_SCALE;
#pragma unroll
                for (int bj = 0; bj < 2; ++bj) { const f32x4 v0 = (acc[ai][bj][m][0] * WI + bv[bj][0]) * gs, v1 = (acc[ai][bj][m][1] * WI + bv[bj][1]) * gs;
                    u32x2 w; w.x = pk4_fp8(v0[0], v0[1], v0[2], v0[3]); w.y = pk4_fp8(v1[0], v1[1], v1[2], v1[3]);
                    *(u32x2*)(rowp + bj * HALF) = w; } }
    }
};
struct EpiNull {
    float* dummy;
    __device__ __forceinline__ void operator()(const f32x4 (&acc)[2][2][4][2], const Unit& u, int wr, int wc, int fr, int fq) const {
        float sacc = 0.f;
#pragma unroll
        for (int ai = 0; ai < 2; ++ai)
#pragma unroll
            for (int bj = 0; bj < 2; ++bj)
#pragma unroll
                for (int m = 0; m < 4; ++m)
#pragma unroll
                    for (int n = 0; n < 2; ++n) sacc += (acc[ai][bj][m][n][0] + acc[ai][bj][m][n][1]) + (acc[ai][bj][m][n][2] + acc[ai][bj][m][n][3]);
        dummy[(size_t)blockIdx.x * 512 + threadIdx.x] = sacc;
    }
};
}

namespace att {
constexpr int LDQ = NH * QKH, LDK = NH * QKH, LDV = NH * VH, LDO = DM;
constexpr int KT_BYTES = 64 * QKH * 2, VT_BYTES = 64 * VH * 2;
constexpr int L_K = 0, L_V = 3 * KT_BYTES, L_WS = L_V + 3 * VT_BYTES, L_END = L_WS + 8 * 256;
constexpr float THRL = 8.f * 1.4426950408889634f;
__device__ __forceinline__ int crow(int r, int hi) { return (r & 3) + 8 * (r >> 2) + 4 * hi; }
#define SBAR() __builtin_amdgcn_sched_barrier(0)
__device__ __forceinline__ int v_rd_base(int lane) { return ((lane & 3) << 3) | (((lane >> 2) & 3) << 6) | (((lane >> 4) & 1) << 5) | (((lane >> 5) & 1) << 8); }
constexpr int v_rd_off(int d0, int ks, int half) { return d0 * 512 + ks * 4096 + half * 2048; }
template <int OFF> __device__ __forceinline__ s16x4 tr_read(int vb) {
    s16x4 r; asm volatile("ds_read_b64_tr_b16 %0, %1 offset:%2" : "=&v"(r) : "v"(vb), "i"(OFF) : "memory"); return r;
}
template <int D0> __device__ __forceinline__ void pv_one(f32x16& od, int vb, bf16x8 pa0, bf16x8 pa1, bf16x8 pa2, bf16x8 pa3) {
    const s16x4 l0 = tr_read<v_rd_off(D0, 0, 0)>(vb), h0 = tr_read<v_rd_off(D0, 0, 1)>(vb), l1 = tr_read<v_rd_off(D0, 1, 0)>(vb), h1 = tr_read<v_rd_off(D0, 1, 1)>(vb);
    const s16x4 l2 = tr_read<v_rd_off(D0, 2, 0)>(vb), h2 = tr_read<v_rd_off(D0, 2, 1)>(vb), l3 = tr_read<v_rd_off(D0, 3, 0)>(vb), h3 = tr_read<v_rd_off(D0, 3, 1)>(vb);
    asm volatile("s_waitcnt lgkmcnt(0)" ::: "memory"); SBAR();
#define PK(L, H) (bf16x8){L[0], L[1], L[2], L[3], H[0], H[1], H[2], H[3]}
    od = __builtin_amdgcn_mfma_f32_32x32x16_bf16(pa0, PK(l0, h0), od, 0, 0, 0);
    od = __builtin_amdgcn_mfma_f32_32x32x16_bf16(pa1, PK(l1, h1), od, 0, 0, 0);
    od = __builtin_amdgcn_mfma_f32_32x32x16_bf16(pa2, PK(l2, h2), od, 0, 0, 0);
    od = __builtin_amdgcn_mfma_f32_32x32x16_bf16(pa3, PK(l3, h3), od, 0, 0, 0);
#undef PK
}
__device__ __forceinline__ void glds16(const void* gsrc, LAS unsigned char* dst) {
    __builtin_amdgcn_global_load_lds((const unsigned*)gsrc, (LAS unsigned*)dst, 16, 0, 0);
}
__device__ __forceinline__ void attn_unit(int b, int h, int qb, const bf16_t* Q, const bf16_t* Kg, const bf16_t* Vg, bf16_t* O, LAS unsigned char* lds) {
    const int tid = threadIdx.x, wid = __builtin_amdgcn_readfirstlane(tid >> 6), lane = tid & 63, r32 = lane & 31, hi = lane >> 5;
    const int grp = wid >> 2;
    const size_t tok0 = (size_t)b * SEQ;
    bf16x8 qr[12];
    { const bf16_t* Qw = Q + (tok0 + (size_t)qb * 256 + wid * 32 + r32) * LDQ + h * QKH + hi * 8;
#pragma unroll
      for (int d0 = 0; d0 < 12; ++d0) qr[d0] = *(const bf16x8*)(Qw + d0 * 16); }
    unsigned koff[3], voff[2];
#pragma unroll
    for (int i = 0; i < 3; ++i) { const int G = 64 * (wid + 8 * i) + lane, row = G / 24, cgs = G % 24, cg = (cgs & ~7) | ((cgs & 7) ^ ((row >> 1) & 7)); koff[i] = (unsigned)(row * LDK * 2 + cg * 16); }
#pragma unroll
    for (int i = 0; i < 2; ++i) { const int p = wid + 8 * i, sub = 2 * p + (lane >> 5), kkh = sub >> 2, cblk = sub & 3, kkl = (lane & 31) >> 2, cl = (lane & 3) * 8, kk = kkh * 8 + kkl;
        const int k = (kk & ~0xC) | ((kk & 4) << 1) | ((kk & 8) >> 1), c = cblk * 32 + cl; voff[i] = (unsigned)(k * LDV * 2 + c * 2); }
    const __amdgpu_buffer_rsrc_t rK = __builtin_amdgcn_make_buffer_rsrc((void*)(Kg + tok0 * LDK + h * QKH), 0, -1, 0x00020000), rV = __builtin_amdgcn_make_buffer_rsrc((void*)(Vg + tok0 * LDV + h * VH), 0, -1, 0x00020000);
#define ATT_DMA(j, buf) do { \
        _Pragma("unroll") for (int i_ = 0; i_ < 3; ++i_) __builtin_amdgcn_raw_ptr_buffer_load_lds(rK, (LAS void*)(lds + L_K + (buf) * KT_BYTES + (wid + 8 * i_) * 1024), 16, koff[i_], (unsigned)(j) * (64u * LDK * 2u), 0, 0); \
        _Pragma("unroll") for (int i_ = 0; i_ < 2; ++i_) __builtin_amdgcn_raw_ptr_buffer_load_lds(rV, (LAS void*)(lds + L_V + (buf) * VT_BYTES + (wid + 8 * i_) * 1024), 16, voff[i_], (unsigned)(j) * (64u * LDV * 2u), 0, 0); } while (0)
#define ATT_BAR() do { asm volatile("" ::: "memory"); __builtin_amdgcn_s_barrier(); asm volatile("" ::: "memory"); } while (0)
    const int swz = (r32 >> 1) & 7; int kx[4];
#pragma unroll
    for (int dd = 0; dd < 4; ++dd) kx[dd] = r32 * (QKH * 2) + (((2 * dd + hi) ^ swz) << 4);
    LAS float* ws = (LAS float*)(lds + L_WS) + wid * 64; LAS float* li_l = ws; LAS float* al_l = ws + 32;
    const int vb0 = L_V + v_rd_base(lane);
    float m_reg = -1e30f, l_reg = 0.f; f32x16 o[4];
#pragma unroll
    for (int d = 0; d < 4; ++d)
#pragma unroll
        for (int r = 0; r < 16; ++r) o[d][r] = 0.f;
    const int NT = 4 * qb + 4, my_last = 4 * qb + (wid >> 1);
    ATT_DMA(0, 0); ATT_DMA(1, 1);
    asm volatile("s_waitcnt vmcnt(5)" ::: "memory"); ATT_BAR();
    if (grp == 1) ATT_BAR();
    int kb = 0, nb = 2;
    for (int j = 0; j < NT; ++j) {
        const bool live = (j <= my_last), more = (j + 2 < NT);
        f32x16 p0, p1;
        if (grp == 1 && more) ATT_DMA(j + 2, nb);
        if (live) {
            const LAS unsigned char* Ks = lds + L_K + kb * KT_BYTES;
#pragma unroll
            for (int r = 0; r < 16; ++r) { p0[r] = 0.f; p1[r] = 0.f; }
#pragma unroll
            for (int d0 = 0; d0 < 12; ++d0) {
                const bf16x8 b0 = *(const LAS bf16x8*)(Ks + kx[d0 & 3] + (d0 >> 2) * 128);
                const bf16x8 b1 = *(const LAS bf16x8*)(Ks + kx[d0 & 3] + (d0 >> 2) * 128 + 32 * QKH * 2);
                p0 = __builtin_amdgcn_mfma_f32_32x32x16_bf16(b0, qr[d0], p0, 0, 0, 0);
                p1 = __builtin_amdgcn_mfma_f32_32x32x16_bf16(b1, qr[d0], p1, 0, 0, 0);
            }
        }
        if (grp == 1) { if (j + 1 < NT) { if (more) asm volatile("s_waitcnt vmcnt(5)" ::: "memory"); else asm volatile("s_waitcnt vmcnt(0)" ::: "memory"); } }
        ATT_BAR();
        if (grp == 0 && more) ATT_DMA(j + 2, nb);
        if (live) {
            float pmax = p0[0];
#pragma unroll
            for (int r = 1; r < 16; ++r) pmax = fmaxf(pmax, p0[r]);
#pragma unroll
            for (int r = 0; r < 16; ++r) pmax = fmaxf(pmax, p1[r]);
            { auto rr = __builtin_amdgcn_permlane32_swap(__float_as_uint(pmax), __float_as_uint(pmax), false, false);
              pmax = fmaxf(__uint_as_float(rr[0]), __uint_as_float(rr[1])); }
            float mn, alpha;
            if (__builtin_expect(__all(pmax - m_reg <= THRL), 1)) { mn = m_reg; alpha = 1.f; }
            else { mn = fmaxf(m_reg, pmax); alpha = __builtin_amdgcn_exp2f(m_reg - mn); m_reg = mn; }
#pragma unroll
            for (int r = 0; r < 16; ++r) { p0[r] = __builtin_amdgcn_exp2f(p0[r] - mn); p1[r] = __builtin_amdgcn_exp2f(p1[r] - mn); }
            float ps = 0.f;
#pragma unroll
            for (int r = 0; r < 16; ++r) ps += p0[r];
#pragma unroll
            for (int r = 0; r < 16; ++r) ps += p1[r];
            { auto rr = __builtin_amdgcn_permlane32_swap(__float_as_uint(ps), __float_as_uint(ps), false, false);
              ps = __uint_as_float(rr[0]) + __uint_as_float(rr[1]); }
            l_reg = l_reg * alpha + ps;
            if (__any(alpha < 1.f)) { if (hi == 0) al_l[r32] = alpha; asm volatile("s_waitcnt lgkmcnt(0)" ::: "memory");
#pragma unroll
                for (int r = 0; r < 16; ++r) { const float a = al_l[crow(r, hi)];
#pragma unroll
                    for (int d = 0; d < 4; ++d) o[d][r] *= a; } }
            bf16x8 pa0, pa1, pa2, pa3;
#define PK4(P, BASE, OUT) do { unsigned a0 = cvt_pk_bf16(P[BASE + 0], P[BASE + 1]), a1 = cvt_pk_bf16(P[BASE + 2], P[BASE + 3]);   \
    unsigned b0_ = cvt_pk_bf16(P[BASE + 4], P[BASE + 5]), b1_ = cvt_pk_bf16(P[BASE + 6], P[BASE + 7]);                              \
    auto r0 = __builtin_amdgcn_permlane32_swap(a0, b0_, false, false); auto r1 = __builtin_amdgcn_permlane32_swap(a1, b1_, false, false); \
    u32x4 w = {r0[0], r1[0], r0[1], r1[1]}; OUT = __builtin_bit_cast(bf16x8, w); } while (0)
            PK4(p0, 0, pa0); PK4(p0, 8, pa1); PK4(p1, 0, pa2); PK4(p1, 8, pa3);
#undef PK4
            const int vb = vb0 + kb * VT_BYTES;
            pv_one<0>(o[0], vb, pa0, pa1, pa2, pa3); pv_one<1>(o[1], vb, pa0, pa1, pa2, pa3); pv_one<2>(o[2], vb, pa0, pa1, pa2, pa3); pv_one<3>(o[3], vb, pa0, pa1, pa2, pa3);
        }
        if (grp == 0) { if (j + 1 < NT) { if (more) asm volatile("s_waitcnt vmcnt(5)" ::: "memory"); else asm volatile("s_waitcnt vmcnt(0)" ::: "memory"); } }
        ATT_BAR();
        kb = (kb == 2) ? 0 : kb + 1; nb = (nb == 2) ? 0 : nb + 1;
    }
    if (grp == 0) ATT_BAR();
    if (hi == 0) li_l[r32] = l_reg; asm volatile("s_waitcnt lgkmcnt(0)" ::: "memory");
    bf16_t* Ow = O + (tok0 + (size_t)qb * 256 + wid * 32) * LDO + h * VH;
#pragma unroll
    for (int r = 0; r < 16; ++r) { const int orow = crow(r, hi); const float rl = __builtin_amdgcn_rcpf(li_l[orow]);
#pragma unroll
        for (int d0 = 0; d0 < 4; ++d0) Ow[(size_t)orow * LDO + d0 * 32 + r32] = (bf16_t)f2bf(o[d0][r] * rl); }
    asm volatile("s_waitcnt lgkmcnt(0)" ::: "memory"); ATT_BAR();
#undef ATT_DMA
#undef ATT_BAR
}
#undef SBAR
}

#define XB_TMO      128
#define XB_XCNT(j)  (256  + 64 * (j))
#define XB_XSUB(j)  (1280 + 64 * (j))
#define XB_XGEN(j)  (2304 + 64 * (j))
#define XB_TOP      3328
#define XB_TOPGEN   3392
#define XCD_BAR_WORDS 3456
#define XB_SPIN_CAP (1u << 18)
__device__ __forceinline__ unsigned xb_ld(unsigned* p)              { return __hip_atomic_load(p, __ATOMIC_RELAXED, __HIP_MEMORY_SCOPE_AGENT); }
__device__ __forceinline__ unsigned xb_add(unsigned* p, unsigned v) { return __hip_atomic_fetch_add(p, v, __ATOMIC_RELAXED, __HIP_MEMORY_SCOPE_AGENT); }
__device__ __forceinline__ unsigned xb_xcc_id() { return (unsigned)__builtin_amdgcn_s_getreg((3 << 11) | 20) & 0xFu; }
#define XB_SPIN(cond, bar) do { unsigned _sp = 0; while (cond) { __builtin_amdgcn_s_sleep(1); \
    if ((++_sp & 255u) == 0u) { if (xb_ld(&(bar)[XB_TMO])) break; if (_sp > XB_SPIN_CAP) { atomicAdd(&(bar)[XB_TMO], 1u); break; } } } } while (0)
struct XcdBarrier { unsigned* bar; unsigned x; volatile LAS unsigned* st; };
__device__ __forceinline__ XcdBarrier xcd_barrier_post(unsigned* bar, volatile LAS unsigned* st) {
    XcdBarrier b; b.bar = bar; b.x = xb_xcc_id(); b.st = st;
    if (threadIdx.x == 0) (void)xb_add(&bar[XB_XCNT(b.x)], 1u);
    return b;
}
__device__ __forceinline__ void xcd_barrier_complete(unsigned* bar, unsigned x, unsigned& nloc, unsigned& nx) {
    const unsigned G = gridDim.x * gridDim.y * gridDim.z;
    unsigned sum, cnt, mine, sp = 0u;
    for (;;) {
        sum = 0u; cnt = 0u; mine = 0u;
#pragma unroll
        for (unsigned j = 0; j < 16; ++j) { const unsigned c = xb_ld(&bar[XB_XCNT(j)]); sum += c; cnt += (c > 0u) ? 1u : 0u; mine = (j == x) ? c : mine; }
        if (sum == G) break;
        __builtin_amdgcn_s_sleep(1);
        if ((++sp & 255u) == 0u) { if (xb_ld(&bar[XB_TMO])) break; if (sp > XB_SPIN_CAP) { atomicAdd(&bar[XB_TMO], 1u); break; } }
    }
    nloc = mine > 0u ? mine : 1u; nx = cnt > 0u ? cnt : 1u;
}
__device__ __forceinline__ void xcd_barrier(const XcdBarrier& b) {
    asm volatile("s_waitcnt vmcnt(0)" ::: "memory");
    __syncthreads();
    if (threadIdx.x == 0) {
        unsigned* bar = b.bar;
        __builtin_amdgcn_s_waitcnt(0);
        unsigned nloc = b.st[0], nx = b.st[1];
        if (nloc == 0u) { xcd_barrier_complete(bar, b.x, nloc, nx); b.st[0] = nloc; b.st[1] = nx; }
        const unsigned old = xb_add(&bar[XB_XSUB(b.x)], 1u);
        const unsigned gen = old / nloc;
        if (old + 1u == (gen + 1u) * nloc) {
            __builtin_amdgcn_fence(__ATOMIC_RELEASE, "agent");
            asm volatile("s_waitcnt vmcnt(0)" ::: "memory");
            const unsigned og = xb_add(&bar[XB_TOP], 1u);
            const unsigned tg = og / nx;
            if (og + 1u == (tg + 1u) * nx) xb_add(&bar[XB_TOPGEN], 1u);
            else XB_SPIN(xb_ld(&bar[XB_TOPGEN]) == tg, bar);
            __builtin_amdgcn_fence(__ATOMIC_ACQUIRE, "agent");
            xb_add(&bar[XB_XGEN(b.x)], 1u);
            asm volatile("s_waitcnt vmcnt(0)" ::: "memory");
        } else {
            XB_SPIN(xb_ld(&bar[XB_XGEN(b.x)]) == gen, bar);
            __builtin_amdgcn_fence(__ATOMIC_ACQUIRE, "agent");
            asm volatile("s_waitcnt vmcnt(0)" ::: "memory");
        }
    }
    __syncthreads();
}

constexpr int NWAVES = 8;
constexpr int N_LAUNCHES = MK_N_LAUNCHES;
constexpr int N_PHASES = 10;
struct Args { const float* in[18]; float* out; unsigned char* ws; int ph_lo, ph_hi; };

__device__ __forceinline__ void p0_transpose_item(const float* W, int K, int N, bf16_t* WT, int drow0, const float* kscale, LAS unsigned* scr, int k0, int n0, int lane, bool ileave = false) {
    const int g = lane >> 4, l16 = lane & 15;
    f32x4 v[16];
#pragma unroll
    for (int i = 0; i < 16; ++i) { const int kk = (i >> 1) * 8 + g * 2 + (i & 1); v[i] = __builtin_nontemporal_load((const f32x4*)(W + (size_t)(k0 + kk) * N + n0 + 4 * l16)); }
    if (kscale) {
#pragma unroll
        for (int i = 0; i < 16; ++i) { const int kk = (i >> 1) * 8 + g * 2 + (i & 1); v[i] = v[i] * kscale[k0 + kk]; } }
#pragma unroll
    for (int j = 0; j < 8; ++j) { const int kp = j * 4 + g;
#pragma unroll
        for (int c = 0; c < 4; ++c) scr[(4 * l16 + c) * 33 + kp] = cvt_pk_bf16(v[2 * j][c], v[2 * j + 1][c]); }
    LDS_WAIT(); asm volatile("" ::: "memory");
    const int c8 = lane & 7;
#pragma unroll
    for (int jj = 0; jj < 8; ++jj) { const int n = jj * 8 + (lane >> 3); const LAS unsigned* t = scr + n * 33 + 4 * c8;
        u32x4 o; o.x = t[0]; o.y = t[1]; o.z = t[2]; o.w = t[3];
        const int dn = ileave ? ((n < 32) ? 2 * n : 2 * (n - 32) + 1) : n;
        *(u32x4*)(WT + (size_t)(drow0 + dn) * K + k0 + 8 * c8) = o; }
    LDS_WAIT(); asm volatile("" ::: "memory");
}

__device__ __forceinline__ void p0_transpose_item8(const float* W, int K, int N, unsigned char* WT, int drow0, const float* kscale, LAS unsigned* scr, int k0, int n0, int lane) {
    const int g = lane >> 4, l16 = lane & 15;
    f32x4 v[32];
#pragma unroll
    for (int i = 0; i < 32; ++i) { const int kk = (i >> 2) * 16 + g * 4 + (i & 3); v[i] = __builtin_nontemporal_load((const f32x4*)(W + (size_t)(k0 + kk) * N + n0 + 4 * l16)); }
#pragma unroll
    for (int i = 0; i < 32; ++i) { const int kk = (i >> 2) * 16 + g * 4 + (i & 3); v[i] = v[i] * (kscale ? kscale[k0 + kk] * W8_SCALE : W8_SCALE); }
#pragma unroll
    for (int j = 0; j < 8; ++j) { const int kd = j * 4 + g;
#pragma unroll
        for (int c = 0; c < 4; ++c) scr[(4 * l16 + c) * 33 + kd] = pk4_fp8(v[4 * j][c], v[4 * j + 1][c], v[4 * j + 2][c], v[4 * j + 3][c]); }
    LDS_WAIT(); asm volatile("" ::: "memory");
    const int c8 = lane & 7;
#pragma unroll
    for (int jj = 0; jj < 8; ++jj) { const int n = jj * 8 + (lane >> 3); const LAS unsigned* t = scr + n * 33 + 4 * c8;
        u32x4 o; o.x = t[0]; o.y = t[1]; o.z = t[2]; o.w = t[3];
        *(u32x4*)(WT + (size_t)(drow0 + n) * K + k0 + 16 * c8) = o; }
    LDS_WAIT(); asm volatile("" ::: "memory");
}

template <int PHMASK> __global__ void __launch_bounds__(NWAVES * 64, 2) fwd_kernel_t(Args args) {
    extern __shared__ __attribute__((aligned(16))) unsigned char lds_raw[];
    LAS unsigned char* lds = (LAS unsigned char*)lds_raw;
    volatile LAS unsigned* MISC = (volatile LAS unsigned*)(lds + MISC_OFF);
    const int tid = threadIdx.x, lane = tid & 63, wave = __builtin_amdgcn_readfirstlane(tid >> 6);
    const int G = gridDim.x; const int bx = blockIdx.x; const int vcu = (G % 8 == 0) ? (bx % 8) * (G / 8) + bx / 8 : bx;
    unsigned char* ws = args.ws;
    unsigned* ctl = (unsigned*)(ws + WS_CTL);
    const float* x = args.in[0]; const float* norm_mix = args.in[1]; const float* w_in = args.in[2]; const float* conv_w = args.in[3];
    const float* q_norm = args.in[4]; const float* w_uq = args.in[5]; const float* kv_norm = args.in[6]; const float* w_ukv = args.in[7];
    const float* q_head_norm = args.in[8]; const float* k_head_norm = args.in[9]; const float* w_o = args.in[10]; const float* norm_ffn = args.in[11];
    const float* w_router = args.in[12]; const float* b_router = args.in[13]; const float* w_gate_up = args.in[14]; const float* b_gate_up = args.in[15];
    const float* w_down = args.in[16]; const float* b_down = args.in[17];
    float* out = args.out;
    f32x2* rope_t = (f32x2*)(ws + WS_ROPE);
    bf16_t* WrH = (bf16_t*)(ws + WS_WRH); bf16_t* WrL = (bf16_t*)(ws + WS_WRL);
    bf16_t* Win_t = (bf16_t*)(ws + WS_WIN); bf16_t* Wuq_t = (bf16_t*)(ws + WS_WUQ); bf16_t* Wukv_t = (bf16_t*)(ws + WS_WUKV); bf16_t* Wo_t = (bf16_t*)(ws + WS_WO);
    float* ssq = (float*)(ws + WS_SSQ); float* rs2 = (float*)(ws + WS_RS2); float* gate = (float*)(ws + WS_GATE); int* tos = (int*)(ws + WS_TOS);
    unsigned char* Wgu_t = ws + WS_WGU; unsigned char* Wdn_t = ws + WS_WDN;
    unsigned char* hq = ws + WS_HB;
    bf16_t* qb_ = (bf16_t*)(ws + WS_Q); bf16_t* kb_ = (bf16_t*)(ws + WS_K); bf16_t* vb_ = (bf16_t*)(ws + WS_V); bf16_t* mix = (bf16_t*)(ws + WS_MIX);
    bf16_t* oslot = (bf16_t*)(ws + WS_OSLOT); bf16_t* hn = (bf16_t*)(ws + WS_HN); bf16_t* pbuf = (bf16_t*)(ws + WS_PB); bf16_t* qraw = (bf16_t*)(ws + WS_QRAW); bf16_t* kvraw = (bf16_t*)(ws + WS_KVRAW);
    unsigned char* act = ws + WS_ACT;

    for (int u = tid; u < (LDS_BYTES - MISC_OFF) / 4; u += NWAVES * 64) ((LAS unsigned*)(lds + MISC_OFF))[u] = 0u;
    __syncthreads();
    XcdBarrier bar; bar.bar = ctl + CW_BAR; bar.x = 0; bar.st = nullptr;
    if (N_LAUNCHES == 1) bar = xcd_barrier_post(ctl + CW_BAR, MISC + 8);
#define GRID_BAR() do { if (N_LAUNCHES == 1) xcd_barrier(bar); } while (0)
    const int lo = args.ph_lo, hi = args.ph_hi;
#define IN(k) (((PHMASK >> (k)) & 1) && lo <= (k) && (k) < hi)
#define BOTH(k) (IN(k) && IN((k) + 1))
    const int gw = vcu * NWAVES + wave, NGW = G * NWAVES;

    if (IN(0)) {
        LAS unsigned* scr = (LAS unsigned*)(lds + wave * 16384);
        constexpr int I_IN = (DM / 64) * (NPROJ / 64), I_UQ = (QL / 64) * (768 / 64), I_UKV = (KVL / 64) * (1024 / 64), I_O = (DM / 64) * (DM / 64);
        constexpr int I_GU1 = (DM / 128) * (2 * DFF / 64), I_GU = NE * I_GU1, I_DN1 = (DFF / 128) * (DM / 64), I_DN = NE * I_DN1;
        constexpr int NITEMS = I_IN + I_UQ + I_UKV + I_O + I_GU + I_DN;
        for (int it = gw; it < NITEMS; it += NGW) {
            int r = it;
            if (r < I_GU) { const int e = r / I_GU1, q = r % I_GU1, nblk = 2 * DFF / 64, kb = q / nblk, nb = q % nblk, n0 = nb * 64, j = n0 & (DFF - 1), up = n0 >= DFF;
                p0_transpose_item8(w_gate_up + (size_t)e * DM * 2 * DFF, DM, 2 * DFF, Wgu_t + (size_t)e * 2 * DFF * DM, (j >> 7) * 256 + (j & 127) + (up ? 128 : 0), norm_ffn, scr, kb * 128, n0, lane); continue; } r -= I_GU;
            if (r < I_DN) { const int e = r / I_DN1, q = r % I_DN1, nblk = DM / 64, kb = q / nblk, nb = q % nblk;
                p0_transpose_item8(w_down + (size_t)e * DFF * DM, DFF, DM, Wdn_t + (size_t)e * DM * DFF, nb * 64, nullptr, scr, kb * 128, nb * 64, lane); continue; } r -= I_DN;
            if (r < I_IN) { const int nblk = NPROJ / 64, kb = r / nblk, nb = r % nblk, n0 = nb * 64;
                const int d0 = (n0 < 512) ? n0 : (n0 < 1024 ? 512 + ((n0 - 512) >> 7) * 256 + ((n0 - 512) & 127) : (n0 < 1536 ? 512 + ((n0 - 1024) >> 7) * 256 + 128 + ((n0 - 1024) & 127)
                             : (n0 < 1920 ? n0 + 256 : (n0 < 2176 ? n0 - 384 : n0))));
                p0_transpose_item(w_in, DM, NPROJ, Win_t, d0, nullptr, scr, kb * 64, n0, lane); continue; } r -= I_IN;
            if (r < I_UQ) { const int nblk = 768 / 64, kb = r / nblk, nb = r % nblk, h = nb / 3, part = nb % 3;
                p0_transpose_item(w_uq, QL, 768, Wuq_t, h * 256 + part * 64, q_norm, scr, kb * 64, nb * 64, lane, part == 2); continue; } r -= I_UQ;
            if (r < I_UKV) { const int nblk = 1024 / 64, kb = r / nblk, nb = r % nblk; p0_transpose_item(w_ukv, KVL, 1024, Wukv_t, nb * 64, kv_norm, scr, kb * 64, nb * 64, lane); continue; } r -= I_UKV;
            { const int nblk = DM / 64, kb = r / nblk, nb = r % nblk; p0_transpose_item(w_o, DM, DM, Wo_t, nb * 64, nullptr, scr, kb * 64, nb * 64, lane); }
        }
        const int gt = vcu * (NWAVES * 64) + tid, NGT = G * NWAVES * 64;
        for (int i = gt; i < (NPP - NPROJ) * DM / 8; i += NGT) *(u32x4*)(Win_t + (size_t)NPROJ * DM + (size_t)i * 8) = (u32x4){0u, 0u, 0u, 0u};
        for (int i = gt; i < NH * 64 * QL / 8; i += NGT) { const int h = i / (64 * QL / 8), j = i % (64 * QL / 8); *(u32x4*)(Wuq_t + (size_t)(h * 256 + 192) * QL + (size_t)j * 8) = (u32x4){0u, 0u, 0u, 0u}; }
        for (int i = gt; i < NE * DM; i += NGT) { const int e = i / DM, k = i % DM; const float v = w_router[(size_t)k * NE + e] * norm_ffn[k]; const unsigned h = f2bf(v); const float hf = __builtin_bit_cast(float, h << 16);
            WrH[i] = (bf16_t)h; WrL[i] = (bf16_t)f2bf(v - hf); }
        for (int i = gt; i < SEQ * 32; i += NGT) { const int pos = i >> 5, fi = i & 31; const float inv = exp2f(-(float)fi * (13.287712379549449f / 32.f)); const float ang = (float)pos * inv; float s, c; sincosf(ang, &s, &c); rope_t[i] = (f32x2){c, s}; }
        for (int m = 2 * gw; m < NTOK; m += 2 * NGW) {
            const f32x4* xr = (const f32x4*)(x + (size_t)m * DM) + lane; const f32x4* gr = (const f32x4*)norm_mix + lane;
            f32x4 v[2][4]; float s0 = 0.f, s1 = 0.f;
#pragma unroll
            for (int j = 0; j < 4; ++j) { v[0][j] = __builtin_nontemporal_load(xr + 64 * j); v[1][j] = __builtin_nontemporal_load(xr + DM / 4 + 64 * j); }
#pragma unroll
            for (int j = 0; j < 4; ++j) { s0 += (v[0][j].x * v[0][j].x + v[0][j].y * v[0][j].y) + (v[0][j].z * v[0][j].z + v[0][j].w * v[0][j].w);
                                          s1 += (v[1][j].x * v[1][j].x + v[1][j].y * v[1][j].y) + (v[1][j].z * v[1][j].z + v[1][j].w * v[1][j].w); }
            const float r0 = 1.0f / sqrtf(wave_sum(s0) * (1.f / DM) + EPS), r1 = 1.0f / sqrtf(wave_sum(s1) * (1.f / DM) + EPS);
            u32x2* o8 = (u32x2*)(hn + (size_t)m * DM) + lane;
#pragma unroll
            for (int j = 0; j < 4; ++j) { const f32x4 g = gr[64 * j]; u32x2 w;
                w.x = cvt_pk_bf16(v[0][j].x * r0 * g.x, v[0][j].y * r0 * g.y); w.y = cvt_pk_bf16(v[0][j].z * r0 * g.z, v[0][j].w * r0 * g.w); o8[64 * j] = w;
                w.x = cvt_pk_bf16(v[1][j].x * r1 * g.x, v[1][j].y * r1 * g.y); w.y = cvt_pk_bf16(v[1][j].z * r1 * g.z, v[1][j].w * r1 * g.w); o8[DM / 4 + 64 * j] = w; }
        }
        if (BOTH(0)) GRID_BAR();
    }

    if (IN(1)) {
        pg8::DenseSched S; S.init(hn, DM, Win_t, NTOK, NPP, DM, G, bx);
        pg8::EpiProj E{pbuf, ssq};
        pg8::gemm_phase<pg8::EpiProj, pg8::DenseSched, false>(lds, S, E);
        if (BOTH(1)) GRID_BAR();
    }

    const bool p2_all = IN(2);
    if (p2_all || IN(13)) {
        {
            const int gt = vcu * (NWAVES * 64) + tid, NGT = G * NWAVES * 64;
            for (int it = gt; it < (NTOK / 16) * 64; it += NGT) {
                const int run = it >> 6, gr = it & 63, t0 = run * 16, ch = gr * 8;
                float w0[8], w1[8], w2[8];
#pragma unroll
                for (int i = 0; i < 8; ++i) { w0[i] = conv_w[ch + i]; w1[i] = conv_w[CONVW + ch + i]; w2[i] = conv_w[2 * CONVW + ch + i]; }
                float um2[8], um1[8];
#pragma unroll
                for (int i = 0; i < 8; ++i) { um2[i] = 0.f; um1[i] = 0.f; }
                if ((t0 & (SEQ - 1)) != 0) {
                    unpack8(*(const u32x4*)(pbuf + (size_t)(t0 - 2) * NPB + PB_U + ch), um2);
                    unpack8(*(const u32x4*)(pbuf + (size_t)(t0 - 1) * NPB + PB_U + ch), um1);
                }
                u32x4 bq[16], uq[16];
#pragma unroll
                for (int t = 0; t < 16; ++t) { const bf16_t* pr = pbuf + (size_t)(t0 + t) * NPB + ch; bq[t] = __builtin_nontemporal_load((const u32x4*)(pr + PB_B)); uq[t] = __builtin_nontemporal_load((const u32x4*)(pr + PB_U)); }
#pragma unroll
                for (int t = 0; t < 16; ++t) {
                    float b8[8], u8[8], o8[8];
                    unpack8(bq[t], b8); unpack8(uq[t], u8);
#pragma unroll
                    for (int i = 0; i < 8; ++i) { o8[i] = b8[i] * (w0[i] * um2[i] + w1[i] * um1[i] + w2[i] * u8[i]); um2[i] = um1[i]; um1[i] = u8[i]; }
                    *(u32x4*)(mix + (size_t)(t0 + t) * DM + ch) = pack8(o8);
                }
            }
        }
    }
    if (p2_all || IN(14) || IN(15)) {
        LAS float* etab = (LAS float*)(lds + EPI_TAB_OFF);
        if (p2_all || IN(14)) { pg8::DenseSched S; S.init(pbuf + PB_CQ, NPB, Wuq_t, NTOK, NQP, QL, G, bx); pg8::EpiQ E{qb_, ssq, q_head_norm, rope_t, etab};
          pg8::gemm_phase<pg8::EpiQ, pg8::DenseSched, false>(lds, S, E); }
        if (p2_all || IN(15)) { pg8::DenseSched S; S.init(pbuf + PB_CKV, NPB, Wukv_t, NTOK, 1024, KVL, G, bx); pg8::EpiKV E{kb_, vb_, ssq, k_head_norm, rope_t, pbuf, etab};
          pg8::gemm_phase<pg8::EpiKV, pg8::DenseSched, false>(lds, S, E); }
        if (BOTH(2)) GRID_BAR();
    }


    if (IN(4)) {
        for (int u = vcu; u < NB * NH * 4; u += G) {
            const int bh = u >> 2, pr = u & 3, b = bh >> 2, h = bh & 3;
            att::attn_unit(b, h, 7 - pr, qb_, kb_, vb_, mix + CONVW, lds);
            att::attn_unit(b, h, pr, qb_, kb_, vb_, mix + CONVW, lds);
        }
        if (BOTH(4)) GRID_BAR();
    }

    if (IN(5)) {
        pg8::DenseSched S; S.init(mix, DM, Wo_t, NTOK, DM, DM, G, bx);
        pg8::EpiOut E{x, (bf16_t*)(ws + WS_H1B), ssq};
        pg8::gemm_phase<pg8::EpiOut, pg8::DenseSched, false>(lds, S, E);
        if (BOTH(5)) GRID_BAR();
    }

    if (IN(6) || IN(16)) {
        const bool dry = !IN(6);
        LAS unsigned* hist = (LAS unsigned*)(lds + MISC_OFF) + 128; LAS unsigned* base = (LAS unsigned*)(lds + MISC_OFF) + 160;
        const int tj = lane & 15, q = lane >> 4;
        for (int i = tid; i < 2 * NE * 128; i += NWAVES * 64) { const int sel = i >> 12, r = (i >> 7) & 31, g = i & 127;
            const u32x4 v = *(const u32x4*)((sel ? WrL : WrH) + (size_t)r * DM + g * 8);
            *(LAS u32x4*)(lds + sel * 65536 + r * 2048 + ((g ^ (r & 15)) << 4)) = v; }
        __syncthreads();
        for (int tile = vcu; tile < NTOK / 128; tile += G) {
            if (tid < 32) hist[tid] = 0u;
            __syncthreads();
            const int token = tile * 128 + wave * 16 + tj;
            const bf16_t* hrow = (const bf16_t*)(ws + WS_H1B) + (size_t)token * DM + q * 8;
            f32x4 a0 = {0.f, 0.f, 0.f, 0.f}, a1 = {0.f, 0.f, 0.f, 0.f};
            float s2 = 0.f;
#pragma unroll
            for (int p = 0; p < 16; ++p) s2 += ssq[(size_t)p * NTOK + token];
            const float rs = 1.0f / sqrtf(s2 * (1.f / DM) + EPS);
            unsigned char* hqrow = hq + (size_t)token * DM + q * 8;
            const LAS unsigned char* wlds = lds + tj * 2048;
#pragma unroll 1
            for (int kh = 0; kh < 2; ++kh) {
                u32x4 hv[16];
#pragma unroll
                for (int kk = 0; kk < 16; ++kk) hv[kk] = *(const u32x4*)(hrow + (kh * 16 + kk) * 32);
#pragma unroll
                for (int kk = 0; kk < 16; ++kk) { const int ks = kh * 16 + kk;
                    const u32x4 hw = hv[kk]; float hf[8]; unpack8(hw, hf);
                    { u32x2 w8; w8.x = pk4_fp8(hf[0] * rs, hf[1] * rs, hf[2] * rs, hf[3] * rs); w8.y = pk4_fp8(hf[4] * rs, hf[5] * rs, hf[6] * rs, hf[7] * rs); *(u32x2*)(hqrow + ks * 32) = w8; }
                    const bf16x8 bh = __builtin_bit_cast(bf16x8, hw);
                    const int go = (((ks * 4 + q) ^ tj) << 4);
                    const bf16x8 wh_a = *(const LAS bf16x8*)(wlds + go), wh_b = *(const LAS bf16x8*)(wlds + 16 * 2048 + go);
                    const bf16x8 wl_a = *(const LAS bf16x8*)(wlds + 65536 + go), wl_b = *(const LAS bf16x8*)(wlds + 65536 + 16 * 2048 + go);
                    a0 = __builtin_amdgcn_mfma_f32_16x16x32_bf16(wh_a, bh, a0, 0, 0, 0); a0 = __builtin_amdgcn_mfma_f32_16x16x32_bf16(wl_a, bh, a0, 0, 0, 0);
                    a1 = __builtin_amdgcn_mfma_f32_16x16x32_bf16(wh_b, bh, a1, 0, 0, 0); a1 = __builtin_amdgcn_mfma_f32_16x16x32_bf16(wl_b, bh, a1, 0, 0, 0);
                }
            }
            float lv[8]; int le[8];
#pragma unroll
            for (int i = 0; i < 4; ++i) { le[i] = 4 * q + i; le[4 + i] = 16 + 4 * q + i; lv[i] = a0[i] * rs + b_router[le[i]]; lv[4 + i] = a1[i] * rs + b_router[le[4 + i]]; }
            float tv[4]; int te[4];
#pragma unroll
            for (int k = 0; k < TOPK; ++k) {
                float bv = lv[0]; int be = le[0];
#pragma unroll
                for (int i = 1; i < 8; ++i) if (lv[i] > bv) { bv = lv[i]; be = le[i]; }
#pragma unroll
                for (int o = 16; o < 64; o <<= 1) { const float ov = __shfl_xor(bv, o); const int oe = __shfl_xor(be, o); if (ov > bv || (ov == bv && oe < be)) { bv = ov; be = oe; } }
                tv[k] = bv; te[k] = be;
#pragma unroll
                for (int i = 0; i < 8; ++i) if (le[i] == be) lv[i] = -3.0e38f;
            }
            float ge[4]; float gs = 0.f;
#pragma unroll
            for (int k = 0; k < TOPK; ++k) { ge[k] = __expf(tv[k] - tv[0]); gs += ge[k]; }
            const float ginv = 1.0f / gs;
            int my_e = te[0]; float my_g = ge[0];
#pragma unroll
            for (int k = 1; k < TOPK; ++k) if (q == k) { my_e = te[k]; my_g = ge[k]; }
            my_g *= ginv;
            const unsigned pl = atomicAdd((unsigned*)(hist + my_e), 1u);
            __syncthreads();
            if (tid < 32) base[tid] = dry ? 0u : __hip_atomic_fetch_add(ctl + CW_CNT + 64 * tid, hist[tid], __ATOMIC_RELAXED, __HIP_MEMORY_SCOPE_AGENT);
            __syncthreads();
            const unsigned pos = base[my_e] + pl; const int slot = token * 4 + q;
            if (!dry) *(u32x2*)(tos + ((size_t)my_e * CAP + pos) * 2) = (u32x2){(unsigned)slot, __builtin_bit_cast(unsigned, my_g)};
            else if (my_g < -1.f) rs2[token] = my_g;
            __syncthreads();
        }
        if (BOTH(6)) GRID_BAR();
    }

    LAS int* tab = (LAS int*)(lds + MISC_OFF) + 16;
    if (IN(7) || IN(8) || IN(10) || IN(11) || IN(12)) {
        if (tid < 32) { const int c = (int)__hip_atomic_load(ctl + CW_CNT + 64 * tid, __ATOMIC_RELAXED, __HIP_MEMORY_SCOPE_AGENT); tab[48 + tid] = c; }
        __syncthreads();
        if (tid == 0) { int s = 0; for (int e = 0; e < NE; ++e) { tab[e] = s; s += (tab[48 + e] + 255) >> 8; } tab[32] = s; }
        __syncthreads();
        for (int t = tid; t < tab[32]; t += NWAVES * 64) { int e = 0; while (e < NE - 1 && tab[e + 1] <= t) ++e; tab[2288 + t] = e; }
        __syncthreads();
    }

    if (IN(7)) {
        pg8::MoeSched S{hq, Wgu_t, DM, DM, 2 * DFF / 256, G, bx, (size_t)2 * DFF * DM, tab, tos, b_gate_up};
        pg8::EpiSwiglu E{act, b_gate_up, lds};
        pg8::gemm_phase<pg8::EpiSwiglu, pg8::MoeSched, true>(lds, S, E);
        if (BOTH(7)) GRID_BAR();
    }

    if (IN(8)) {
        pg8::MoeSched S{act, Wdn_t, DFF, DFF, DM / 256, G, bx, (size_t)DM * DFF, tab, tos, b_down};
        pg8::EpiDown E{(unsigned char*)oslot, b_down, ws + WS_SSQ, lds};
        pg8::gemm_phase<pg8::EpiDown, pg8::MoeSched, false>(lds, S, E);
        if (BOTH(8)) GRID_BAR();
    }

#if PROBE_DOUBLE
    if (IN(10)) { pg8::MoeSched S{hq, Wgu_t, DM, DM, 2 * DFF / 256, G, bx, (size_t)2 * DFF * DM, tab, tos, b_gate_up}; pg8::EpiNull E{(float*)(ws + WS_SSQ)};
        pg8::gemm_phase<pg8::EpiNull, pg8::MoeSched, true>(lds, S, E); }
    if (IN(11)) { pg8::MoeSched S{act, Wdn_t, DFF, DFF, DM / 256, G, bx, (size_t)DM * DFF, tab, tos, b_down}; pg8::EpiNull E{(float*)(ws + WS_SSQ)};
        pg8::gemm_phase<pg8::EpiNull, pg8::MoeSched, false, 2>(lds, S, E); }
    if (IN(12)) { pg8::MoeSched S{act, Wdn_t, DFF, DFF, DM / 256, G, bx, (size_t)DM * DFF, tab, tos, b_down}; pg8::EpiNull E{(float*)(ws + WS_SSQ)};
        pg8::gemm_phase<pg8::EpiNull, pg8::MoeSched, false>(lds, S, E); }
#endif
    if (IN(9)) {
        const unsigned char* os8 = (const unsigned char*)oslot;
        constexpr float OI = 1.f / OS8_SCALE;
        for (int m = gw; m < NTOK; m += NGW) {
            f32x4* orow = (f32x4*)(out + (size_t)m * DM) + lane;
            const u32x2* hrow = (const u32x2*)((const bf16_t*)(ws + WS_H1B) + (size_t)m * DM) + lane;
            const unsigned* s0 = (const unsigned*)(os8 + (size_t)m * 4 * DM) + lane;
            unsigned w[4][4]; f32x4 hv[4];
#pragma unroll
            for (int j = 0; j < 4; ++j) { const u32x2 hb2 = __builtin_nontemporal_load(hrow + 64 * j); hv[j] = (f32x4){bf_lo(hb2.x), bf_hi(hb2.x), bf_lo(hb2.y), bf_hi(hb2.y)};
#pragma unroll
                for (int k = 0; k < 4; ++k) w[j][k] = __builtin_nontemporal_load(s0 + (size_t)k * (DM / 4) + 64 * j); }
#pragma unroll
            for (int j = 0; j < 4; ++j) { f32x4 a = {0.f, 0.f, 0.f, 0.f};
#pragma unroll
                for (int k = 0; k < 4; ++k) { const f32x2 lo = __builtin_amdgcn_cvt_pk_f32_fp8(w[j][k], false), hi2 = __builtin_amdgcn_cvt_pk_f32_fp8(w[j][k], true); a.x += lo.x; a.y += lo.y; a.z += hi2.x; a.w += hi2.y; }
                __builtin_nontemporal_store(hv[j] + a * OI, orow + 64 * j); }
        }
    }
#undef IN
#undef BOTH
#undef GRID_BAR
}

#ifdef DIAG_PHASES
template __global__ void fwd_kernel_t<1>(Args); template __global__ void fwd_kernel_t<2>(Args); template __global__ void fwd_kernel_t<4>(Args); template __global__ void fwd_kernel_t<8>(Args);
template __global__ void fwd_kernel_t<16>(Args); template __global__ void fwd_kernel_t<32>(Args); template __global__ void fwd_kernel_t<64>(Args); template __global__ void fwd_kernel_t<128>(Args);
template __global__ void fwd_kernel_t<256>(Args); template __global__ void fwd_kernel_t<512>(Args);
#endif
#define fwd_kernel fwd_kernel_t<(PROBE_DOUBLE ? 0x1ffff : 1023)>
extern "C" void kernel_launch(void* const* d_in, const int* in_sizes, int n_in, void* d_out, int out_size, void* d_ws, size_t ws_size, hipStream_t stream) {
    static int grid = 0;
    if (grid == 0) {
        if (n_in != 18 || in_sizes[0] != NTOK * DM || out_size != NTOK * DM || ws_size < WS_END) { fprintf(stderr, "kernel_launch: shape/workspace mismatch (n_in %d, in0 %d, out %d, ws %zu, need %zu)\n", n_in, n_in > 0 ? in_sizes[0] : -1, out_size, ws_size, (size_t)WS_END); grid = -1; return; }
        int dev = 0, cus = 0, per_cu = 0;
        if (hipGetDevice(&dev) != hipSuccess || hipDeviceGetAttribute(&cus, hipDeviceAttributeMultiprocessorCount, dev) != hipSuccess) { grid = -1; return; }
        if (hipFuncSetAttribute((const void*)fwd_kernel, hipFuncAttributeMaxDynamicSharedMemorySize, LDS_BYTES) != hipSuccess) { fprintf(stderr, "kernel_launch: hipFuncSetAttribute failed\n"); grid = -1; return; }
        if (hipOccupancyMaxActiveBlocksPerMultiprocessor(&per_cu, (const void*)fwd_kernel, NWAVES * 64, LDS_BYTES) != hipSuccess || per_cu < 1) { fprintf(stderr, "kernel_launch: occupancy query says %d\n", per_cu); }
        (void)hipGetLastError();
        grid = cus;
    }
    if (grid < 0) return;
    if (hipMemsetAsync((char*)d_ws + WS_CTL, 0, CTL_ZERO_BYTES, stream) != hipSuccess) return;
    Args a{};
    for (int i = 0; i < 18; ++i) a.in[i] = (const float*)d_in[i];
    a.out = (float*)d_out; a.ws = (unsigned char*)d_ws;
    if (N_LAUNCHES == 1) { a.ph_lo = 0; a.ph_hi = N_PHASES; hipLaunchKernelGGL(fwd_kernel, dim3(grid), dim3(NWAVES * 64), LDS_BYTES, stream, a); }
    else { for (int p = 0; p < N_PHASES; ++p) { a.ph_lo = p; a.ph_hi = p + 1; const int reps = ((PROBE_DOUBLE >> p) & 1) ? 2 : 1;
            for (int r = 0; r < reps; ++r) hipLaunchKernelGGL(fwd_kernel, dim3(grid), dim3(NWAVES * 64), LDS_BYTES, stream, a);
            if (p == 8) for (int pp = 10; pp < 13; ++pp) if ((PROBE_DOUBLE >> pp) & 1) { a.ph_lo = pp; a.ph_hi = pp + 1; hipLaunchKernelGGL(fwd_kernel, dim3(grid), dim3(NWAVES * 64), LDS_BYTES, stream, a); }
            if (p == 6 && ((PROBE_DOUBLE >> 16) & 1)) { a.ph_lo = 16; a.ph_hi = 17; hipLaunchKernelGGL(fwd_kernel, dim3(grid), dim3(NWAVES * 64), LDS_BYTES, stream, a); }
            if (p == 2) for (int pp = 13; pp < 16; ++pp) if ((PROBE_DOUBLE >> pp) & 1) { a.ph_lo = pp; a.ph_hi = pp + 1; hipLaunchKernelGGL(fwd_kernel, dim3(grid), dim3(NWAVES * 64), LDS_BYTES, stream, a); } } }
}
```

```cpp
#include <hip/hip_runtime.h>
#include <cstdio>
#include <cstdint>

#ifndef MK_N_LAUNCHES
#define MK_N_LAUNCHES 1
#endif

#ifndef PROBE_DOUBLE
#define PROBE_DOUBLE 0
#endif
#define LAS __attribute__((address_space(3)))
#define GAS __attribute__((address_space(1)))
typedef unsigned short bf16_t;
typedef short bf16x8 __attribute__((ext_vector_type(8)));
typedef short s16x4 __attribute__((ext_vector_type(4)));
typedef float f32x2 __attribute__((ext_vector_type(2)));
typedef float f32x4 __attribute__((ext_vector_type(4)));
typedef float f32x16 __attribute__((ext_vector_type(16)));
typedef unsigned u32x2 __attribute__((ext_vector_type(2)));
typedef unsigned u32x4 __attribute__((ext_vector_type(4)));
typedef int v4i_t __attribute__((ext_vector_type(4)));
typedef int v8i_t __attribute__((ext_vector_type(8)));

constexpr int NB = 16, SEQ = 2048, NTOK = NB * SEQ, DM = 1024;
constexpr int CONVW = 512, QL = 384, KVL = 256, ROPE = 64, NH = 4, QKN = 128, QKH = 192, VH = 128;
constexpr int NPROJ = 2240, NPP = 2304;
constexpr int PB_B = 0, PB_U = 512, PB_CKV = 1024, PB_CQ = 1280, PB_KPE = 1664, NPB = 1728;
constexpr int NQP = 1024;
constexpr int NE = 32, TOPK = 4, DFF = 1024, NSLOT = NTOK * TOPK;
constexpr int CAP = NTOK;
constexpr int MAXTILES = NSLOT / 256 + NE;
constexpr float EPS = 1e-6f;
constexpr float QSCALE = 0.07216878364870322f * 1.4426950408889634f;
constexpr float SWI_LIMIT = 7.0f, SWI_ALPHA = 1.702f;
constexpr float W8_SCALE = 64.f, ACT8_SCALE = 4.f, OS8_SCALE = 16.f;

constexpr size_t MiB = 1u << 20;
constexpr size_t WS_CTL = 0, CTL_ZERO_BYTES = 1 * MiB;
constexpr size_t WS_ROPE = 1 * MiB;
constexpr size_t WS_WRH = 1 * MiB + 512 * 1024, WS_WRL = WS_WRH + 64 * 1024;
constexpr size_t WS_WIN = 2 * MiB;
constexpr size_t WS_WUQ = 8 * MiB, WS_WUKV = 9 * MiB, WS_WO = 10 * MiB;
constexpr size_t WS_SSQ = 12 * MiB;
constexpr size_t WS_RS2 = 14 * MiB, WS_GATE = 14 * MiB + 512 * 1024;
constexpr size_t WS_TOS = 16 * MiB;
constexpr size_t WS_WGU = 32 * MiB, WS_WDN = 160 * MiB;
constexpr size_t WS_HB = 224 * MiB;
constexpr size_t WS_Q = 288 * MiB, WS_K = 336 * MiB, WS_V = 384 * MiB, WS_MIX = 416 * MiB;
constexpr size_t WS_OSLOT = 288 * MiB;
constexpr size_t WS_HN = 544 * MiB, WS_PB = 608 * MiB, WS_QRAW = 752 * MiB, WS_KVRAW = 800 * MiB;
constexpr size_t WS_ACT = 544 * MiB;
constexpr size_t WS_H1B = 768 * MiB;
constexpr size_t WS_END = 864 * MiB;
constexpr int CW_BAR = 4096;
constexpr int CW_CNT = 16384;

constexpr int RING_BYTES = 131072;
constexpr int MISC_OFF = RING_BYTES;
constexpr int LDS_BYTES = 155648;
constexpr int EPI_TAB_OFF = MISC_OFF + 3072 * 4;

__device__ __forceinline__ unsigned cvt_pk_bf16(float lo, float hi) { unsigned r; asm volatile("v_cvt_pk_bf16_f32 %0, %1, %2" : "=v"(r) : "v"(lo), "v"(hi)); return r; }
__device__ __forceinline__ unsigned f2bf(float f) { unsigned u = __builtin_bit_cast(unsigned, f); return (u + 0x7fffu + ((u >> 16) & 1u)) >> 16; }
__device__ __forceinline__ unsigned pk2(float lo, float hi) { return f2bf(lo) | (f2bf(hi) << 16); }
__device__ __forceinline__ float bf_lo(unsigned w) { return __builtin_bit_cast(float, w << 16); }
__device__ __forceinline__ float bf_hi(unsigned w) { return __builtin_bit_cast(float, w & 0xffff0000u); }
__device__ __forceinline__ void unpack8(const u32x4 w, float* f) { f[0] = bf_lo(w.x); f[1] = bf_hi(w.x); f[2] = bf_lo(w.y); f[3] = bf_hi(w.y); f[4] = bf_lo(w.z); f[5] = bf_hi(w.z); f[6] = bf_lo(w.w); f[7] = bf_hi(w.w); }
__device__ __forceinline__ u32x4 pack8(const float* f) { u32x4 w; w.x = cvt_pk_bf16(f[0], f[1]); w.y = cvt_pk_bf16(f[2], f[3]); w.z = cvt_pk_bf16(f[4], f[5]); w.w = cvt_pk_bf16(f[6], f[7]); return w; }
__device__ __forceinline__ float wave_sum(float v) {
#pragma unroll
    for (int o = 1; o < 64; o <<= 1) v += __shfl_xor(v, o);
    return v;
}
__device__ __forceinline__ float half_sum(float v) {
#pragma unroll
    for (int o = 1; o < 32; o <<= 1) v += __shfl_xor(v, o);
    return v;
}
__device__ __forceinline__ float clamp448(float v) { return __builtin_amdgcn_fmed3f(v, -448.f, 448.f); }
__device__ __forceinline__ unsigned pk4_fp8_nc(float a, float b, float c, float d) {
    unsigned w = 0u; w = (unsigned)__builtin_amdgcn_cvt_pk_fp8_f32(a, b, (int)w, false); w = (unsigned)__builtin_amdgcn_cvt_pk_fp8_f32(c, d, (int)w, true); return w; }
__device__ __forceinline__ unsigned pk4_fp8(float a, float b, float c, float d) {
    unsigned w = 0u; w = (unsigned)__builtin_amdgcn_cvt_pk_fp8_f32(clamp448(a), clamp448(b), (int)w, false); w = (unsigned)__builtin_amdgcn_cvt_pk_fp8_f32(clamp448(c), clamp448(d), (int)w, true); return w; }
#define LDS_WAIT() asm volatile("s_waitcnt lgkmcnt(0)" ::: "memory")
#define VM_WAIT() asm volatile("s_waitcnt vmcnt(0)" ::: "memory")

namespace pg8 {
constexpr int BM = 256, BK = 64, HALF = 128, HTB = HALF * BK * 2, STAGE_BYTES = 8 * HTB, NXCD = 8, WGM = 4;
__host__ __device__ __forceinline__ int lds_byte(int r, int c) { const int st = (r >> 4) * 2 + (c >> 5), rr = r & 15, cc = c & 31, ob = rr * 64 + cc * 2; return st * 1024 + (ob ^ (((ob >> 9) & 1) << 5)); }
__host__ __device__ __forceinline__ void stage_rc(int b, int& R, int& C) { const int st = b / 1024, sb = b % 1024, swz = sb ^ (((sb >> 9) & 1) << 5); R = (st >> 1) * 16 + swz / 64; C = (st & 1) * 32 + (swz % 64) / 2; }
__host__ __device__ __forceinline__ int perm32(int rho) { const int n = rho >> 4, i = rho & 15; return 8 * (i >> 2) + 4 * n + (i & 3); }

struct Unit { int pm, pn, e, p0, cnt, par, half; };

__device__ __forceinline__ bool deal_unit(int i, int nwg, int G, int c, int& wgid, int& half) {
    half = 0;
    if (G % NXCD != 0) { const long L = (long)i * G + c; if (L >= nwg) return false; wgid = (int)L; return true; }
    const int W = G / NXCD, x = c % NXCD, rk = c / NXCD, q = nwg / NXCD, r = nwg % NXCD;
    const int cnt = q + (x < r ? 1 : 0), base = (x < r ? x * (q + 1) : r * (q + 1) + (x - r) * q);
    const int R = cnt / W, E = cnt - R * W;
    if (i < R) { wgid = base + i * W + rk; return true; }
    if (i > R) return false;
    if (rk >= E) return false; wgid = base + R * W + rk; return true;
}
struct DenseSched {
    static constexpr int ESZ = 2;
    const bf16_t* A; const bf16_t* Bt; int lda, K, nM, nN, nwg, G, c;
    __device__ void init(const bf16_t* A_, int lda_, const bf16_t* Bt_, int M, int N, int K_, int G_, int c_) { A = A_; Bt = Bt_; lda = lda_; K = K_; nM = M / BM; nN = N / BM; nwg = nM * nN; G = G_; c = c_; }
    __device__ __forceinline__ bool next(int i, Unit& u) const {
        int wgid, half; if (!deal_unit(i, nwg, G, c, wgid, half)) return false;
        const int nig = WGM * nN, gid = wgid / nig, fm = gid * WGM, gsz = (nM - fm) < WGM ? (nM - fm) : WGM;
        u.pm = fm + ((wgid % nig) % gsz); u.pn = (wgid % nig) / gsz; u.e = 0; u.p0 = 0; u.cnt = 0; u.half = half; return true;
    }
    __device__ __forceinline__ unsigned a_off(const Unit& u) const { return (unsigned)u.pm * (unsigned)(BM * lda * 2); }
    __device__ __forceinline__ unsigned b_off(const Unit& u) const { return (unsigned)u.pn * (unsigned)(BM * K * 2); }
    __device__ __forceinline__ unsigned a_rowoff(const Unit&, int) const { return 0u; }
    static constexpr bool META = false;
    __device__ __forceinline__ void meta_first(const Unit&, LAS unsigned char*) const {}
    __device__ __forceinline__ void meta_issue(const Unit&, LAS unsigned char*) const {}
    __device__ __forceinline__ void pre_issue(const Unit&, LAS unsigned char*) const {}
    __device__ __forceinline__ unsigned meta_rowoff(const Unit&, int, LAS unsigned char*) const { return 0u; }
};
struct MoeSched {
    static constexpr int ESZ = 1;
    const unsigned char* A; const unsigned char* Bt; int lda, K, nN, G, c; size_t estride; const LAS int* tab; const int* tos; const float* bias;
    static constexpr bool META = true;
    static constexpr int META_OFF = MISC_OFF + 4608 * 4;
    __device__ __forceinline__ bool next(int i, Unit& u) const {
        const int T = __builtin_amdgcn_readfirstlane(tab[32]), nwg = T * nN;
        int wgid, half; if (!deal_unit(i, nwg, G, c, wgid, half)) return false; u.half = half;
        const int nig = WGM * nN, gid = wgid / nig, fm = gid * WGM, gsz = (T - fm) < WGM ? (T - fm) : WGM;
        const int mt = fm + ((wgid % nig) % gsz); u.pm = mt; u.pn = (wgid % nig) / gsz;
        const int e = __builtin_amdgcn_readfirstlane(tab[2288 + mt]);
        u.e = e; u.p0 = (mt - __builtin_amdgcn_readfirstlane(tab[e])) * BM; u.cnt = __builtin_amdgcn_readfirstlane(tab[48 + e]); return true;
    }
    __device__ __forceinline__ unsigned a_off(const Unit& u) const { return (unsigned)u.pm * (unsigned)(BM * lda); }
    __device__ __forceinline__ unsigned b_off(const Unit& u) const { return (unsigned)u.e * (unsigned)estride + (unsigned)u.pn * (unsigned)(BM * K); }
    __device__ __forceinline__ unsigned a_rowoff(const Unit& u, int r) const {
        const int p = u.p0 + r; const int sv = tos[((size_t)u.e * CAP + p) * 2];
        const int slot = (p < u.cnt) ? sv : 0;
        return (unsigned)(slot >> 2) * (unsigned)lda;
    }
    static constexpr int BIAS_OFF = MISC_OFF + 5632 * 4;
    __device__ __forceinline__ void meta_first(const Unit& u, LAS unsigned char* lds) const { meta_issue(u, lds); }
    __device__ __forceinline__ void meta_issue(const Unit& u, LAS unsigned char* lds) const {
        const __amdgpu_buffer_rsrc_t rT = __builtin_amdgcn_make_buffer_rsrc((void*)tos, 0, -1, 0x00020000);
        const int wid = __builtin_amdgcn_readfirstlane(threadIdx.x >> 6);
        __builtin_amdgcn_raw_ptr_buffer_load_lds(rT, (LAS void*)(lds + META_OFF + u.par * 2048 + wid * 256), 4, (threadIdx.x & 63) * 4u, ((unsigned)u.e * (unsigned)CAP + (unsigned)u.p0) * 8u + (unsigned)wid * 256u, 0, 0);
    }
    __device__ __forceinline__ void pre_issue(const Unit& u, LAS unsigned char* lds) const {
        const int wid = __builtin_amdgcn_readfirstlane(threadIdx.x >> 6);
        if (wid < 4) { const __amdgpu_buffer_rsrc_t rB = __builtin_amdgcn_make_buffer_rsrc((void*)bias, 0, -1, 0x00020000);
            const unsigned src = (nN == 8) ? (((unsigned)u.e * (2u * DFF) + (unsigned)u.pn * HALF) * 4u + (wid >= 2 ? DFF * 4u - 512u : 0u)) : (((unsigned)u.e * DM + (unsigned)u.pn * BM) * 4u);
            __builtin_amdgcn_raw_ptr_buffer_load_lds(rB, (LAS void*)(lds + BIAS_OFF + u.par * 1024 + wid * 256), 4, (threadIdx.x & 63) * 4u, src + (unsigned)wid * 256u, 0, 0); }
    }
    __device__ __forceinline__ unsigned meta_rowoff(const Unit& u, int r, LAS unsigned char* lds) const {
        const int sv = *(const LAS int*)(lds + META_OFF + u.par * 2048 + r * 8);
        const int slot = (u.p0 + r < u.cnt) ? sv : 0;
        return (unsigned)(slot >> 2) * (unsigned)lda;
    }
};

template <class Epi, class Sched, bool GATHER, int KREP = 1>
__device__ __forceinline__ void gemm_phase(LAS unsigned char* lds, const Sched& S, const Epi& E) {
    const int tid = threadIdx.x, wid = __builtin_amdgcn_readfirstlane(tid >> 6), lane = tid & 63, wr = wid >> 2, wc = wid & 3, fr = lane & 15, fq = lane >> 4;
    constexpr int ESZ = Sched::ESZ; constexpr bool F8 = (ESZ == 1);
    const int K = S.K * ESZ / 2, lda = S.lda * ESZ / 2, nt0 = K / BK, nt = nt0 * KREP;
    unsigned voffB[2], aoc[2][2]; int RA[2], CA[2];
#pragma unroll
    for (int i = 0; i < 2; ++i) { int R, C; stage_rc(tid * 16 + i * 8192, R, C); const int Rb = (R & ~31) + perm32(R & 31);
        voffB[i] = (unsigned)(Rb * K + C) * 2u; RA[i] = R; CA[i] = C;
        aoc[0][i] = (unsigned)(R * lda + C) * 2u; aoc[1][i] = (unsigned)((R + HALF) * lda + C) * 2u; }
    const unsigned kstep = (unsigned)(BK * 2);
    const unsigned hstepB = (unsigned)(HALF * K * 2), hstepA = GATHER ? 0u : (unsigned)(HALF * lda * 2);
    const __amdgpu_buffer_rsrc_t rA = __builtin_amdgcn_make_buffer_rsrc((void*)S.A, 0, -1, 0x00020000), rB = __builtin_amdgcn_make_buffer_rsrc((void*)S.Bt, 0, -1, 0x00020000);
    const unsigned ldsw = (unsigned)wid * 1024u;
    const int aoff = lds_byte(wr * 64 + fr, fq * 8), boff = lds_byte(wc * 32 + fr, fq * 8);
#define PG8_SA(b, h) (((b) * 2 + (h)) * HTB)
#define PG8_SB(b, h) ((4 + (b) * 2 + (h)) * HTB)
#define PG8_STAGE_B(bufoff, soff) do { _Pragma("unroll") for (int _i = 0; _i < 2; ++_i) \
        __builtin_amdgcn_raw_ptr_buffer_load_lds(rB, (LAS void*)(lds + (bufoff) + ldsw + _i * 8192), 16, voffB[_i], (soff), 0, 0); } while (0)
#define PG8_STAGE_A(bufoff, soff, h) do { _Pragma("unroll") for (int _i = 0; _i < 2; ++_i) \
        __builtin_amdgcn_raw_ptr_buffer_load_lds(rA, (LAS void*)(lds + (bufoff) + ldsw + _i * 8192), 16, aoc[GATHER ? (h) : 0][_i], (soff) + (h) * hstepA, 0, 0); } while (0)
#define PG8_LDA(dst, b, h) do { _Pragma("unroll") for (int m = 0; m < 4; ++m) _Pragma("unroll") for (int k = 0; k < 2; ++k) dst[m][k] = *(const LAS bf16x8*)(lds + PG8_SA(b, h) + aoff + m * 2048 + k * 1024); } while (0)
#define PG8_LDB(dst, b, h) do { _Pragma("unroll") for (int n = 0; n < 2; ++n) _Pragma("unroll") for (int k = 0; k < 2; ++k) dst[n][k] = *(const LAS bf16x8*)(lds + PG8_SB(b, h) + boff + n * 2048 + k * 1024); } while (0)
#define PG8_CAT(x) __builtin_shufflevector(__builtin_bit_cast(v4i_t, x[0]), __builtin_bit_cast(v4i_t, x[1]), 0, 1, 2, 3, 4, 5, 6, 7)
#define PG8_MMA(ai, bj, At, Bt) do { __builtin_amdgcn_s_setprio(1); _Pragma("unroll") for (int m = 0; m < 4; ++m) _Pragma("unroll") for (int n = 0; n < 2; ++n) { \
        if constexpr (F8) { asm volatile("v_mfma_scale_f32_16x16x128_f8f6f4 %0, %1, %2, %0, %3, %3 op_sel_hi:[0,0,0]" : "+v"(acc[ai][bj][m][n]) : "v"(PG8_CAT(Bt[n])), "v"(PG8_CAT(At[m])), "v"(0x7f7f7f7f)); } \
        else { _Pragma("unroll") for (int k = 0; k < 2; ++k) acc[ai][bj][m][n] = __builtin_amdgcn_mfma_f32_16x16x32_bf16(Bt[n][k], At[m][k], acc[ai][bj][m][n], 0, 0, 0); } } \
        __builtin_amdgcn_s_setprio(0); } while (0)
#define PG8_WAIT_V(n) asm volatile("s_waitcnt vmcnt(" #n ")" ::: "memory")
#define PG8_WAIT_L(n) asm volatile("s_waitcnt lgkmcnt(" #n ")" ::: "memory")
#define PG8_BAR __builtin_amdgcn_s_barrier()
#define PG8_SCHED __builtin_amdgcn_sched_barrier(0)
    Unit cur, nxt; int ui = 0;
    if (!S.next(0, cur)) return;
    cur.par = 0; if constexpr (Sched::META) S.meta_first(cur, lds);
    f32x4 acc[2][2][4][2];
#pragma unroll
    for (int a = 0; a < 2; ++a)
#pragma unroll
        for (int b = 0; b < 2; ++b)
#pragma unroll
            for (int m = 0; m < 4; ++m)
#pragma unroll
                for (int n = 0; n < 2; ++n) acc[a][b][m][n] = (f32x4){0.f, 0.f, 0.f, 0.f};
    bf16x8 At[4][2], B0[2][2], B1[2][2];
    unsigned cA = GATHER ? 0u : S.a_off(cur), cB = S.b_off(cur);
    if constexpr (GATHER) {
#pragma unroll
        for (int h = 0; h < 2; ++h)
#pragma unroll
            for (int i = 0; i < 2; ++i) aoc[h][i] = S.a_rowoff(cur, h * HALF + RA[i]) + (unsigned)CA[i] * 2u;
    }
    PG8_STAGE_B(PG8_SB(0, 0), cB); PG8_STAGE_B(PG8_SB(0, 1), cB + hstepB); PG8_STAGE_A(PG8_SA(0, 0), cA, 0); PG8_STAGE_A(PG8_SA(0, 1), cA, 1);
    if (wr == 1) PG8_BAR;
    PG8_WAIT_V(2); PG8_BAR;
    PG8_STAGE_B(PG8_SB(1, 0), cB + kstep); PG8_STAGE_A(PG8_SA(1, 0), cA + kstep, 0); PG8_STAGE_B(PG8_SB(1, 1), cB + hstepB + kstep);
    PG8_WAIT_V(6); PG8_BAR;
    for (;;) {
        const bool has_next = S.next(ui + 1, nxt);
        const unsigned nA = GATHER ? 0u : (has_next ? S.a_off(nxt) : cA), nB = has_next ? S.b_off(nxt) : cB;
        nxt.par = (ui + 1) & 1;
        for (int t = 0; t < nt; t += 2) {
            const bool last = (t == nt - 2);
            const unsigned a1 = cA + (unsigned)((t + 1) % nt0) * kstep;
            const unsigned a2 = last ? nA : cA + (unsigned)((t + 2) % nt0) * kstep, b2 = last ? nB : cB + (unsigned)((t + 2) % nt0) * kstep;
            const unsigned a3 = a2 + kstep, b3 = b2 + kstep;
            PG8_LDB(B0, 0, 0); PG8_LDB(B1, 0, 1); PG8_SCHED; PG8_LDA(At, 0, 0); PG8_STAGE_A(PG8_SA(1, 1), a1, 1);
            PG8_WAIT_V(8); PG8_WAIT_L(0); PG8_BAR;
            if constexpr (Sched::META) { if (t == 0) { S.pre_issue(cur, lds); if (has_next) S.meta_issue(nxt, lds); } }
            PG8_MMA(0, 0, At, B0); PG8_MMA(0, 1, At, B1); PG8_BAR; PG8_SCHED;
            if constexpr (Sched::META) { if (last && has_next) {
                if constexpr (GATHER) {
#pragma unroll
                    for (int h = 0; h < 2; ++h)
#pragma unroll
                        for (int i = 0; i < 2; ++i) aoc[h][i] = S.meta_rowoff(nxt, h * HALF + RA[i], lds) + (unsigned)CA[i] * 2u;
                } } }
            PG8_LDA(At, 0, 1); PG8_STAGE_B(PG8_SB(0, 0), b2); PG8_STAGE_B(PG8_SB(0, 1), b2 + hstepB); PG8_STAGE_A(PG8_SA(0, 0), a2, 0);
            PG8_WAIT_V(8); PG8_WAIT_L(0); PG8_BAR; PG8_MMA(1, 0, At, B0); PG8_MMA(1, 1, At, B1); PG8_BAR; PG8_SCHED;
            PG8_LDB(B0, 1, 0); PG8_LDB(B1, 1, 1); PG8_SCHED; PG8_LDA(At, 1, 0); PG8_STAGE_A(PG8_SA(0, 1), a2, 1);
            PG8_WAIT_V(8); PG8_WAIT_L(0); PG8_BAR; PG8_MMA(0, 0, At, B0); PG8_MMA(0, 1, At, B1); PG8_BAR; PG8_SCHED;
            PG8_LDA(At, 1, 1); PG8_STAGE_B(PG8_SB(1, 0), b3); PG8_STAGE_B(PG8_SB(1, 1), b3 + hstepB); PG8_STAGE_A(PG8_SA(1, 0), a3, 0);
            PG8_WAIT_V(8); PG8_WAIT_L(0); PG8_BAR; PG8_MMA(1, 0, At, B0); PG8_MMA(1, 1, At, B1); PG8_BAR; PG8_SCHED;
        }
        if (wr == 0) PG8_BAR;
        E(acc, cur, wr, wc, fr, fq);
        if (!has_next) break;
#pragma unroll
        for (int a = 0; a < 2; ++a)
#pragma unroll
            for (int b = 0; b < 2; ++b)
#pragma unroll
                for (int m = 0; m < 4; ++m)
#pragma unroll
                    for (int n = 0; n < 2; ++n) acc[a][b][m][n] = (f32x4){0.f, 0.f, 0.f, 0.f};
        cur = nxt; cA = nA; cB = nB; ++ui;
        if (wr == 1) PG8_BAR;
    }
    PG8_WAIT_V(0);
    PG8_BAR;
#undef PG8_SA
#undef PG8_SB
#undef PG8_STAGE_A
#undef PG8_STAGE_B
#undef PG8_LDA
#undef PG8_LDB
#undef PG8_MMA
#undef PG8_CAT
#undef PG8_WAIT_V
#undef PG8_WAIT_L
#undef PG8_BAR
#undef PG8_SCHED
}

struct EpiBf16 {
    bf16_t* O; int ldc;
    __device__ __forceinline__ void operator()(const f32x4 (&acc)[2][2][4][2], const Unit& u, int wr, int wc, int fr, int fq) const {
        asm volatile("" : "+v"(fr), "+v"(fq));
        const int row0 = u.pm * BM + wr * 64 + fr, col0 = u.pn * BM + wc * 32 + 8 * fq;
#pragma unroll
        for (int ai = 0; ai < 2; ++ai)
#pragma unroll
            for (int m = 0; m < 4; ++m) { bf16_t* rowp = O + (size_t)(row0 + ai * HALF + m * 16) * ldc + col0;
#pragma unroll
                for (int bj = 0; bj < 2; ++bj) { const f32x4 v0 = acc[ai][bj][m][0], v1 = acc[ai][bj][m][1];
                    u32x4 w; w.x = cvt_pk_bf16(v0[0], v0[1]); w.y = cvt_pk_bf16(v0[2], v0[3]); w.z = cvt_pk_bf16(v1[0], v1[1]); w.w = cvt_pk_bf16(v1[2], v1[3]);
                    *(u32x4*)(rowp + bj * HALF) = w; } }
    }
};
struct EpiProj {
    static constexpr int NPRE = 0;
    bf16_t* O; float* st;
    __device__ __forceinline__ void operator()(const f32x4 (&acc)[2][2][4][2], const Unit& u, int wr, int wc, int fr, int fq) const {
        asm volatile("" : "+v"(fr), "+v"(fq));
        const int row0 = u.pm * BM + wr * 64 + fr, c8 = wc * 32 + 8 * fq;
        const bool pair = (u.pn >= 2 && u.pn < 6);
        const int cb0 = (u.pn < 2) ? u.pn * BM : (pair ? PB_U + (u.pn - 2) * HALF : (u.pn == 6 ? PB_CKV : (u.pn == 7 ? PB_CQ : PB_CQ + 256)));
#pragma unroll
        for (int ai = 0; ai < 2; ++ai)
#pragma unroll
            for (int m = 0; m < 4; ++m) { const int row = row0 + ai * HALF + m * 16; bf16_t* rowp = O + (size_t)row * NPB + cb0 + c8; float ss[2];
                if (pair) { const f32x4 v0 = acc[ai][0][m][0] * acc[ai][1][m][0], v1 = acc[ai][0][m][1] * acc[ai][1][m][1];
                    u32x4 w; w.x = cvt_pk_bf16(v0[0], v0[1]); w.y = cvt_pk_bf16(v0[2], v0[3]); w.z = cvt_pk_bf16(v1[0], v1[1]); w.w = cvt_pk_bf16(v1[2], v1[3]);
                    *(u32x4*)rowp = w; ss[0] = 0.f; ss[1] = 0.f;
                } else {
#pragma unroll
                    for (int bj = 0; bj < 2; ++bj) { const f32x4 v0 = acc[ai][bj][m][0], v1 = acc[ai][bj][m][1];
                        u32x4 w; w.x = cvt_pk_bf16(v0[0], v0[1]); w.y = cvt_pk_bf16(v0[2], v0[3]); w.z = cvt_pk_bf16(v1[0], v1[1]); w.w = cvt_pk_bf16(v1[2], v1[3]);
                        if (!(u.pn == 8 && bj == 1 && wc >= 2)) *(u32x4*)(rowp + bj * HALF) = w;
                        ss[bj] = (v0[0] * v0[0] + v0[1] * v0[1]) + (v0[2] * v0[2] + v0[3] * v0[3]) + (v1[0] * v1[0] + v1[1] * v1[1]) + (v1[2] * v1[2] + v1[3] * v1[3]); } }
                if (u.pn >= 6) {
                    float s0 = ss[0], s1 = ss[1]; s0 += __shfl_xor(s0, 16); s0 += __shfl_xor(s0, 32); s1 += __shfl_xor(s1, 16); s1 += __shfl_xor(s1, 32);
                    if (fq == 0) { if (u.pn == 6) st[(size_t)wc * NTOK + row] = s0 + s1; else if (u.pn == 7) st[(size_t)(4 + wc) * NTOK + row] = s0 + s1;
                                   else { st[(size_t)(8 + wc) * NTOK + row] = s0; st[(size_t)(12 + wc) * NTOK + row] = s1; } } } }
    }
};
struct EpiQ {
    bf16_t* q; const float* st; const float* qhn; const f32x2* rope; LAS float* tabs;
    __device__ __forceinline__ void operator()(const f32x4 (&acc)[2][2][4][2], const Unit& u, int wr, int wc, int fr, int fq) const {
        asm volatile("" : "+v"(fr), "+v"(fq));
        LAS float* rs_tab = tabs; LAS float* part = tabs + 512;
        const int rt0 = wr * 64 + fr;
        const int c0 = wc * 32 + 8 * fq;
        const int i0 = c0 >> 1;
        f32x4 csa[2][4][2];
        if (wc < 2) {
#pragma unroll
            for (int ai = 0; ai < 2; ++ai)
#pragma unroll
                for (int m = 0; m < 4; ++m) { const size_t row = (size_t)u.pm * BM + rt0 + ai * HALF + m * 16;
                    csa[ai][m][0] = *(const f32x4*)(rope + (row & (SEQ - 1)) * 32 + i0); csa[ai][m][1] = *(const f32x4*)(rope + (row & (SEQ - 1)) * 32 + i0 + 2); }
        }
        f32x4 g0[2], g1[2];
        g0[0] = *(const f32x4*)(qhn + c0) * QSCALE; g0[1] = *(const f32x4*)(qhn + c0 + 4) * QSCALE;
        if (wc < 2) { g1[0] = (f32x4){qhn[128 + i0], qhn[160 + i0], qhn[129 + i0], qhn[161 + i0]} * QSCALE; g1[1] = (f32x4){qhn[130 + i0], qhn[162 + i0], qhn[131 + i0], qhn[163 + i0]} * QSCALE; }
        else { g1[0] = (f32x4){0.f, 0.f, 0.f, 0.f}; g1[1] = g1[0]; }
        { const int t = threadIdx.x; if (t < BM) { const size_t r = (size_t)u.pm * BM + t; float s = 0.f;
#pragma unroll
            for (int k = 4; k < 12; ++k) s += st[(size_t)k * NTOK + r];
            rs_tab[t] = 1.0f / sqrtf(s * (1.f / QL) + EPS); } }
#pragma unroll
        for (int ai = 0; ai < 2; ++ai)
#pragma unroll
            for (int m = 0; m < 4; ++m) { float ss = 0.f;
#pragma unroll
                for (int bj = 0; bj < 2; ++bj)
#pragma unroll
                    for (int n = 0; n < 2; ++n) { const f32x4 v = acc[ai][bj][m][n]; ss += (v[0] * v[0] + v[1] * v[1]) + (v[2] * v[2] + v[3] * v[3]); }
                ss += __shfl_xor(ss, 16); ss += __shfl_xor(ss, 32);
                if (fq == 0) part[(rt0 + ai * HALF + m * 16) * 4 + wc] = ss; }
        asm volatile("s_waitcnt lgkmcnt(0)" ::: "memory"); __builtin_amdgcn_s_barrier(); asm volatile("" ::: "memory");
#pragma unroll
        for (int ai = 0; ai < 2; ++ai)
#pragma unroll
            for (int m = 0; m < 4; ++m) { const int rt = rt0 + ai * HALF + m * 16; const size_t row = (size_t)u.pm * BM + rt;
                const f32x4 pp = *(const LAS f32x4*)(part + rt * 4); const float rs = rs_tab[rt];
                const float r = rs / sqrtf(rs * rs * ((pp[0] + pp[1]) + (pp[2] + pp[3])) * (1.f / QKH) + EPS);
                bf16_t* qp = q + row * (NH * QKH) + u.pn * QKH + c0;
                { const f32x4 v0 = acc[ai][0][m][0] * g0[0] * r, v1 = acc[ai][0][m][1] * g0[1] * r;
                  u32x4 w; w.x = cvt_pk_bf16(v0[0], v0[1]); w.y = cvt_pk_bf16(v0[2], v0[3]); w.z = cvt_pk_bf16(v1[0], v1[1]); w.w = cvt_pk_bf16(v1[2], v1[3]); *(u32x4*)qp = w; }
                if (wc < 2) { const f32x4 cs0 = csa[ai][m][0], cs1 = csa[ai][m][1];
                    const f32x4 a0 = acc[ai][1][m][0] * g1[0] * r, a1 = acc[ai][1][m][1] * g1[1] * r;
                    f32x4 o0, o1;
                    o0[0] = a0[0] * cs0[0] - a0[1] * cs0[1]; o0[1] = a0[0] * cs0[1] + a0[1] * cs0[0]; o0[2] = a0[2] * cs0[2] - a0[3] * cs0[3]; o0[3] = a0[2] * cs0[3] + a0[3] * cs0[2];
                    o1[0] = a1[0] * cs1[0] - a1[1] * cs1[1]; o1[1] = a1[0] * cs1[1] + a1[1] * cs1[0]; o1[2] = a1[2] * cs1[2] - a1[3] * cs1[3]; o1[3] = a1[2] * cs1[3] + a1[3] * cs1[2];
                    u32x4 w; w.x = cvt_pk_bf16(o0[0], o0[1]); w.y = cvt_pk_bf16(o0[2], o0[3]); w.z = cvt_pk_bf16(o1[0], o1[1]); w.w = cvt_pk_bf16(o1[2], o1[3]); *(u32x4*)(qp + HALF) = w; } }
    }
};
struct EpiKV {
    bf16_t* k; bf16_t* v; const float* st; const float* khn; const f32x2* rope; const bf16_t* pb; LAS float* tabs;
    __device__ __forceinline__ void operator()(const f32x4 (&acc)[2][2][4][2], const Unit& u, int wr, int wc, int fr, int fq) const {
        asm volatile("" : "+v"(fr), "+v"(fq));
        LAS float* rs_tab = tabs; LAS float* kpe_tab = tabs + 256; LAS float* part = tabs + 512;
        const int rt0 = wr * 64 + fr;
        const int c0 = wc * 32 + 8 * fq;
        const int i0 = 8 * wc + 2 * fq;
        unsigned xas[2][4], xbs[2][4]; f32x4 css[2][4];
#pragma unroll
        for (int ai = 0; ai < 2; ++ai)
#pragma unroll
            for (int m = 0; m < 4; ++m) { const size_t row = (size_t)u.pm * BM + rt0 + ai * HALF + m * 16;
                xas[ai][m] = *(const unsigned*)(pb + row * NPB + PB_KPE + i0); xbs[ai][m] = *(const unsigned*)(pb + row * NPB + PB_KPE + 32 + i0);
                css[ai][m] = *(const f32x4*)(rope + (row & (SEQ - 1)) * 32 + i0); }
        const f32x4 g0 = *(const f32x4*)(khn + c0), g1 = *(const f32x4*)(khn + c0 + 4);
        const float gx0 = khn[128 + i0], gy0 = khn[160 + i0], gx1 = khn[129 + i0], gy1 = khn[161 + i0];
        { const int t = threadIdx.x; if (t < BM) { const size_t r = (size_t)u.pm * BM + t;
            const float s = (st[r] + st[(size_t)NTOK + r]) + (st[(size_t)2 * NTOK + r] + st[(size_t)3 * NTOK + r]);
            const float p = (st[(size_t)12 * NTOK + r] + st[(size_t)13 * NTOK + r]) + (st[(size_t)14 * NTOK + r] + st[(size_t)15 * NTOK + r]);
            rs_tab[t] = 1.0f / sqrtf(s * (1.f / KVL) + EPS); kpe_tab[t] = p; } }
#pragma unroll
        for (int ai = 0; ai < 2; ++ai)
#pragma unroll
            for (int m = 0; m < 4; ++m) { float ss = 0.f;
#pragma unroll
                for (int n = 0; n < 2; ++n) { const f32x4 x = acc[ai][0][m][n]; ss += (x[0] * x[0] + x[1] * x[1]) + (x[2] * x[2] + x[3] * x[3]); }
                ss += __shfl_xor(ss, 16); ss += __shfl_xor(ss, 32);
                if (fq == 0) part[(rt0 + ai * HALF + m * 16) * 4 + wc] = ss; }
        asm volatile("s_waitcnt lgkmcnt(0)" ::: "memory"); __builtin_amdgcn_s_barrier(); asm volatile("" ::: "memory");
#pragma unroll
        for (int ai = 0; ai < 2; ++ai)
#pragma unroll
            for (int m = 0; m < 4; ++m) { const int rt = rt0 + ai * HALF + m * 16; const size_t row = (size_t)u.pm * BM + rt;
                const f32x4 pp = *(const LAS f32x4*)(part + rt * 4); const float rs = rs_tab[rt];
                const float rh = 1.0f / sqrtf((rs * rs * ((pp[0] + pp[1]) + (pp[2] + pp[3])) + kpe_tab[rt]) * (1.f / QKH) + EPS);
                const float r = rs * rh;
                bf16_t* kp = k + row * (NH * QKH) + u.pn * QKH;
                { const f32x4 v0 = acc[ai][0][m][0] * g0 * r, v1 = acc[ai][0][m][1] * g1 * r;
                  u32x4 w; w.x = cvt_pk_bf16(v0[0], v0[1]); w.y = cvt_pk_bf16(v0[2], v0[3]); w.z = cvt_pk_bf16(v1[0], v1[1]); w.w = cvt_pk_bf16(v1[2], v1[3]); *(u32x4*)(kp + c0) = w; }
                { const f32x4 v0 = acc[ai][1][m][0] * rs, v1 = acc[ai][1][m][1] * rs;
                  u32x4 w; w.x = cvt_pk_bf16(v0[0], v0[1]); w.y = cvt_pk_bf16(v0[2], v0[3]); w.z = cvt_pk_bf16(v1[0], v1[1]); w.w = cvt_pk_bf16(v1[2], v1[3]); *(u32x4*)(v + row * (NH * VH) + u.pn * VH + c0) = w; }
                { const unsigned xa = xas[ai][m], xb = xbs[ai][m];
                  const f32x4 cs = css[ai][m];
                  const float x10 = bf_lo(xa) * gx0 * rh, x11 = bf_hi(xa) * gx1 * rh, x20 = bf_lo(xb) * gy0 * rh, x21 = bf_hi(xb) * gy1 * rh;
                  u32x2 w; w.x = cvt_pk_bf16(x10 * cs[0] - x20 * cs[1], x10 * cs[1] + x20 * cs[0]); w.y = cvt_pk_bf16(x11 * cs[2] - x21 * cs[3], x11 * cs[3] + x21 * cs[2]);
                  *(u32x2*)(kp + 128 + 2 * i0) = w; } }
    }
};
struct EpiOut {
    const float* x; bf16_t* h1b; float* ssq;
    __device__ __forceinline__ void operator()(const f32x4 (&acc)[2][2][4][2], const Unit& u, int wr, int wc, int fr, int fq) const {
        asm volatile("" : "+v"(fr), "+v"(fq));
        const int row0 = u.pm * BM + wr * 64 + fr, col0 = u.pn * BM + wc * 32 + 8 * fq;
#pragma unroll
        for (int ai = 0; ai < 2; ++ai) {
            f32x4 xv[4][2][2];
#pragma unroll
            for (int m = 0; m < 4; ++m) { const size_t off = (size_t)(row0 + ai * HALF + m * 16) * DM + col0;
#pragma unroll
                for (int bj = 0; bj < 2; ++bj) { xv[m][bj][0] = __builtin_nontemporal_load((const f32x4*)(x + off + bj * HALF)); xv[m][bj][1] = __builtin_nontemporal_load((const f32x4*)(x + off + bj * HALF + 4)); } }
            asm volatile("" ::: "memory");
#pragma unroll
            for (int m = 0; m < 4; ++m) { const int row = row0 + ai * HALF + m * 16; const size_t off = (size_t)row * DM + col0; float ss = 0.f;
#pragma unroll
                for (int bj = 0; bj < 2; ++bj) { const f32x4 v0 = acc[ai][bj][m][0] + xv[m][bj][0], v1 = acc[ai][bj][m][1] + xv[m][bj][1];
                    u32x4 w; w.x = cvt_pk_bf16(v0[0], v0[1]); w.y = cvt_pk_bf16(v0[2], v0[3]); w.z = cvt_pk_bf16(v1[0], v1[1]); w.w = cvt_pk_bf16(v1[2], v1[3]);
                    *(u32x4*)(h1b + off + bj * HALF) = w;
                    ss += (v0[0] * v0[0] + v0[1] * v0[1]) + (v0[2] * v0[2] + v0[3] * v0[3]) + (v1[0] * v1[0] + v1[1] * v1[1]) + (v1[2] * v1[2] + v1[3] * v1[3]); }
                ss += __shfl_xor(ss, 16); ss += __shfl_xor(ss, 32);
                if (fq == 0) ssq[(size_t)(u.pn * 4 + wc) * NTOK + row] = ss; }
        }
    }
};
struct EpiSwiglu {
    unsigned char* act; const float* bgu; LAS unsigned char* blds;
    __device__ __forceinline__ void operator()(const f32x4 (&acc)[2][2][4][2], const Unit& u, int wr, int wc, int fr, int fq) const {
        asm volatile("" : "+v"(fr), "+v"(fq));
        const int rt0 = wr * 64 + fr, j0 = wc * 32 + 8 * fq;
        const LAS float* bl = (const LAS float*)(blds + MoeSched::BIAS_OFF + u.par * 1024) + j0;
        const f32x4 bg0 = *(const LAS f32x4*)bl, bg1 = *(const LAS f32x4*)(bl + 4), bu0 = *(const LAS f32x4*)(bl + HALF), bu1 = *(const LAS f32x4*)(bl + HALF + 4);
        constexpr float WI = 1.f / W8_SCALE;
#pragma unroll
        for (int ai = 0; ai < 2; ++ai)
#pragma unroll
            for (int m = 0; m < 4; ++m) { const int rt = rt0 + ai * HALF + m * 16;
                float o[8];
#pragma unroll
                for (int n = 0; n < 2; ++n) { const f32x4 g4 = acc[ai][0][m][n] * WI + (n ? bg1 : bg0), u4 = acc[ai][1][m][n] * WI + (n ? bu1 : bu0);
#pragma unroll
                    for (int i = 0; i < 4; i += 2) {
                        f32x2 g, uu; g.x = fminf(g4[i], SWI_LIMIT); g.y = fminf(g4[i + 1], SWI_LIMIT);
                        uu.x = __builtin_amdgcn_fmed3f(u4[i], -SWI_LIMIT, SWI_LIMIT); uu.y = __builtin_amdgcn_fmed3f(u4[i + 1], -SWI_LIMIT, SWI_LIMIT);
                        const f32x2 t = g * (-SWI_ALPHA * 1.4426950408889634f);
                        f32x2 e; e.x = __builtin_amdgcn_exp2f(t.x); e.y = __builtin_amdgcn_exp2f(t.y);
                        const f32x2 d = e + 1.f;
                        f32x2 sg; sg.x = __builtin_amdgcn_rcpf(d.x); sg.y = __builtin_amdgcn_rcpf(d.y);
                        const f32x2 r = (uu * ACT8_SCALE + ACT8_SCALE) * (g * sg);
                        o[n * 4 + i] = r.x; o[n * 4 + i + 1] = r.y; } }
                u32x2 w; w.x = pk4_fp8_nc(o[0], o[1], o[2], o[3]); w.y = pk4_fp8_nc(o[4], o[5], o[6], o[7]);
                *(u32x2*)(act + ((size_t)u.pm * BM + rt) * DFF + u.pn * HALF + j0) = w; }
    }
};
struct EpiDown {
    unsigned char* oslot; const float* bdn; unsigned char* dummy; LAS unsigned char* lds;
    __device__ __forceinline__ void operator()(const f32x4 (&acc)[2][2][4][2], const Unit& u, int wr, int wc, int fr, int fq) const {
        asm volatile("" : "+v"(fr), "+v"(fq));
        const int rt0 = wr * 64 + fr, col0 = u.pn * BM + wc * 32 + 8 * fq;
        const LAS float* bl = (const LAS float*)(lds + MoeSched::BIAS_OFF + u.par * 1024) + wc * 32 + 8 * fq;
        f32x4 bv[2][2]; bv[0][0] = *(const LAS f32x4*)bl; bv[0][1] = *(const LAS f32x4*)(bl + 4); bv[1][0] = *(const LAS f32x4*)(bl + HALF); bv[1][1] = *(const LAS f32x4*)(bl + HALF + 4);
        constexpr float WI = 1.f / (W8_SCALE * ACT8_SCALE);
#pragma unroll
        for (int ai = 0; ai < 2; ++ai)
#pragma unroll
            for (int m = 0; m < 4; ++m) { const int rt = rt0 + ai * HALF + m * 16, p = u.p0 + rt;
                const u32x2 mt = *(const LAS u32x2*)(lds + MoeSched::META_OFF + u.par * 2048 + rt * 8);
                const bool valid = p < u.cnt; const int slot = valid ? (int)mt.x : 0; const unsigned gbits = mt.y; const float g = __builtin_bit_cast(float, gbits);
                unsigned char* rowp = valid ? oslot + (size_t)slot * DM + col0 : dummy + col0;
                const float gs = g * OS8_SCALE;
#pragma unroll
                for (int bj = 0; bj < 2; ++bj) { const f32x4 v0 = (acc[ai][bj][m][0] * WI + bv[bj][0]) * gs, v1 = (acc[ai][bj][m][1] * WI + bv[bj][1]) * gs;
                    u32x2 w; w.x = pk4_fp8(v0[0], v0[1], v0[2], v0[3]); w.y = pk4_fp8(v1[0], v1[1], v1[2], v1[3]);
                    *(u32x2*)(rowp + bj * HALF) = w; } }
    }
};
struct EpiNull {
    float* dummy;
    __device__ __forceinline__ void operator()(const f32x4 (&acc)[2][2][4][2], const Unit& u, int wr, int wc, int fr, int fq) const {
        float sacc = 0.f;
#pragma unroll
        for (int ai = 0; ai < 2; ++ai)
#pragma unroll
            for (int bj = 0; bj < 2; ++bj)
#pragma unroll
                for (int m = 0; m < 4; ++m)
#pragma unroll
                    for (int n = 0; n < 2; ++n) sacc += (acc[ai][bj][m][n][0] + acc[ai][bj][m][n][1]) + (acc[ai][bj][m][n][2] + acc[ai][bj][m][n][3]);
        dummy[(size_t)blockIdx.x * 512 + threadIdx.x] = sacc;
    }
};
}

namespace att {
constexpr int LDQ = NH * QKH, LDK = NH * QKH, LDV = NH * VH, LDO = DM;
constexpr int KT_BYTES = 64 * QKH * 2, VT_BYTES = 64 * VH * 2;
constexpr int L_K = 0, L_V = 3 * KT_BYTES, L_WS = L_V + 3 * VT_BYTES, L_END = L_WS + 8 * 256;
constexpr float THRL = 8.f * 1.4426950408889634f;
__device__ __forceinline__ int crow(int r, int hi) { return (r & 3) + 8 * (r >> 2) + 4 * hi; }
#define SBAR() __builtin_amdgcn_sched_barrier(0)
__device__ __forceinline__ int v_rd_base(int lane) { return ((lane & 3) << 3) | (((lane >> 2) & 3) << 6) | (((lane >> 4) & 1) << 5) | (((lane >> 5) & 1) << 8); }
constexpr int v_rd_off(int d0, int ks, int half) { return d0 * 512 + ks * 4096 + half * 2048; }
template <int OFF> __device__ __forceinline__ s16x4 tr_read(int vb) {
    s16x4 r; asm volatile("ds_read_b64_tr_b16 %0, %1 offset:%2" : "=&v"(r) : "v"(vb), "i"(OFF) : "memory"); return r;
}
template <int D0> __device__ __forceinline__ void pv_one(f32x16& od, int vb, bf16x8 pa0, bf16x8 pa1, bf16x8 pa2, bf16x8 pa3) {
    const s16x4 l0 = tr_read<v_rd_off(D0, 0, 0)>(vb), h0 = tr_read<v_rd_off(D0, 0, 1)>(vb), l1 = tr_read<v_rd_off(D0, 1, 0)>(vb), h1 = tr_read<v_rd_off(D0, 1, 1)>(vb);
    const s16x4 l2 = tr_read<v_rd_off(D0, 2, 0)>(vb), h2 = tr_read<v_rd_off(D0, 2, 1)>(vb), l3 = tr_read<v_rd_off(D0, 3, 0)>(vb), h3 = tr_read<v_rd_off(D0, 3, 1)>(vb);
    asm volatile("s_waitcnt lgkmcnt(0)" ::: "memory"); SBAR();
#define PK(L, H) (bf16x8){L[0], L[1], L[2], L[3], H[0], H[1], H[2], H[3]}
    od = __builtin_amdgcn_mfma_f32_32x32x16_bf16(pa0, PK(l0, h0), od, 0, 0, 0);
    od = __builtin_amdgcn_mfma_f32_32x32x16_bf16(pa1, PK(l1, h1), od, 0, 0, 0);
    od = __builtin_amdgcn_mfma_f32_32x32x16_bf16(pa2, PK(l2, h2), od, 0, 0, 0);
    od = __builtin_amdgcn_mfma_f32_32x32x16_bf16(pa3, PK(l3, h3), od, 0, 0, 0);
#undef PK
}
__device__ __forceinline__ void glds16(const void* gsrc, LAS unsigned char* dst) {
    __builtin_amdgcn_global_load_lds((const unsigned*)gsrc, (LAS unsigned*)dst, 16, 0, 0);
}
__device__ __forceinline__ void attn_unit(int b, int h, int qb, const bf16_t* Q, const bf16_t* Kg, const bf16_t* Vg, bf16_t* O, LAS unsigned char* lds) {
    const int tid = threadIdx.x, wid = __builtin_amdgcn_readfirstlane(tid >> 6), lane = tid & 63, r32 = lane & 31, hi = lane >> 5;
    const int grp = wid >> 2;
    const size_t tok0 = (size_t)b * SEQ;
    bf16x8 qr[12];
    { const bf16_t* Qw = Q + (tok0 + (size_t)qb * 256 + wid * 32 + r32) * LDQ + h * QKH + hi * 8;
#pragma unroll
      for (int d0 = 0; d0 < 12; ++d0) qr[d0] = *(const bf16x8*)(Qw + d0 * 16); }
    unsigned koff[3], voff[2];
#pragma unroll
    for (int i = 0; i < 3; ++i) { const int G = 64 * (wid + 8 * i) + lane, row = G / 24, cgs = G % 24, cg = (cgs & ~7) | ((cgs & 7) ^ ((row >> 1) & 7)); koff[i] = (unsigned)(row * LDK * 2 + cg * 16); }
#pragma unroll
    for (int i = 0; i < 2; ++i) { const int p = wid + 8 * i, sub = 2 * p + (lane >> 5), kkh = sub >> 2, cblk = sub & 3, kkl = (lane & 31) >> 2, cl = (lane & 3) * 8, kk = kkh * 8 + kkl;
        const int k = (kk & ~0xC) | ((kk & 4) << 1) | ((kk & 8) >> 1), c = cblk * 32 + cl; voff[i] = (unsigned)(k * LDV * 2 + c * 2); }
    const __amdgpu_buffer_rsrc_t rK = __builtin_amdgcn_make_buffer_rsrc((void*)(Kg + tok0 * LDK + h * QKH), 0, -1, 0x00020000), rV = __builtin_amdgcn_make_buffer_rsrc((void*)(Vg + tok0 * LDV + h * VH), 0, -1, 0x00020000);
#define ATT_DMA(j, buf) do { \
        _Pragma("unroll") for (int i_ = 0; i_ < 3; ++i_) __builtin_amdgcn_raw_ptr_buffer_load_lds(rK, (LAS void*)(lds + L_K + (buf) * KT_BYTES + (wid + 8 * i_) * 1024), 16, koff[i_], (unsigned)(j) * (64u * LDK * 2u), 0, 0); \
        _Pragma("unroll") for (int i_ = 0; i_ < 2; ++i_) __builtin_amdgcn_raw_ptr_buffer_load_lds(rV, (LAS void*)(lds + L_V + (buf) * VT_BYTES + (wid + 8 * i_) * 1024), 16, voff[i_], (unsigned)(j) * (64u * LDV * 2u), 0, 0); } while (0)
#define ATT_BAR() do { asm volatile("" ::: "memory"); __builtin_amdgcn_s_barrier(); asm volatile("" ::: "memory"); } while (0)
    const int swz = (r32 >> 1) & 7; int kx[4];
#pragma unroll
    for (int dd = 0; dd < 4; ++dd) kx[dd] = r32 * (QKH * 2) + (((2 * dd + hi) ^ swz) << 4);
    LAS float* ws = (LAS float*)(lds + L_WS) + wid * 64; LAS float* li_l = ws; LAS float* al_l = ws + 32;
    const int vb0 = L_V + v_rd_base(lane);
    float m_reg = -1e30f, l_reg = 0.f; f32x16 o[4];
#pragma unroll
    for (int d = 0; d < 4; ++d)
#pragma unroll
        for (int r = 0; r < 16; ++r) o[d][r] = 0.f;
    const int NT = 4 * qb + 4, my_last = 4 * qb + (wid >> 1);
    ATT_DMA(0, 0); ATT_DMA(1, 1);
    asm volatile("s_waitcnt vmcnt(5)" ::: "memory"); ATT_BAR();
    if (grp == 1) ATT_BAR();
    int kb = 0, nb = 2;
    for (int j = 0; j < NT; ++j) {
        const bool live = (j <= my_last), more = (j + 2 < NT);
        f32x16 p0, p1;
        if (grp == 1 && more) ATT_DMA(j + 2, nb);
        if (live) {
            const LAS unsigned char* Ks = lds + L_K + kb * KT_BYTES;
#pragma unroll
            for (int r = 0; r < 16; ++r) { p0[r] = 0.f; p1[r] = 0.f; }
#pragma unroll
            for (int d0 = 0; d0 < 12; ++d0) {
                const bf16x8 b0 = *(const LAS bf16x8*)(Ks + kx[d0 & 3] + (d0 >> 2) * 128);
                const bf16x8 b1 = *(const LAS bf16x8*)(Ks + kx[d0 & 3] + (d0 >> 2) * 128 + 32 * QKH * 2);
                p0 = __builtin_amdgcn_mfma_f32_32x32x16_bf16(b0, qr[d0], p0, 0, 0, 0);
                p1 = __builtin_amdgcn_mfma_f32_32x32x16_bf16(b1, qr[d0], p1, 0, 0, 0);
            }
        }
        if (grp == 1) { if (j + 1 < NT) { if (more) asm volatile("s_waitcnt vmcnt(5)" ::: "memory"); else asm volatile("s_waitcnt vmcnt(0)" ::: "memory"); } }
        ATT_BAR();
        if (grp == 0 && more) ATT_DMA(j + 2, nb);
        if (live) {
            float pmax = p0[0];
#pragma unroll
            for (int r = 1; r < 16; ++r) pmax = fmaxf(pmax, p0[r]);
#pragma unroll
            for (int r = 0; r < 16; ++r) pmax = fmaxf(pmax, p1[r]);
            { auto rr = __builtin_amdgcn_permlane32_swap(__float_as_uint(pmax), __float_as_uint(pmax), false, false);
              pmax = fmaxf(__uint_as_float(rr[0]), __uint_as_float(rr[1])); }
            float mn, alpha;
            if (__builtin_expect(__all(pmax - m_reg <= THRL), 1)) { mn = m_reg; alpha = 1.f; }
            else { mn = fmaxf(m_reg, pmax); alpha = __builtin_amdgcn_exp2f(m_reg - mn); m_reg = mn; }
#pragma unroll
            for (int r = 0; r < 16; ++r) { p0[r] = __builtin_amdgcn_exp2f(p0[r] - mn); p1[r] = __builtin_amdgcn_exp2f(p1[r] - mn); }
            float ps = 0.f;
#pragma unroll
            for (int r = 0; r < 16; ++r) ps += p0[r];
#pragma unroll
            for (int r = 0; r < 16; ++r) ps += p1[r];
            { auto rr = __builtin_amdgcn_permlane32_swap(__float_as_uint(ps), __float_as_uint(ps), false, false);
              ps = __uint_as_float(rr[0]) + __uint_as_float(rr[1]); }
            l_reg = l_reg * alpha + ps;
            if (__any(alpha < 1.f)) { if (hi == 0) al_l[r32] = alpha; asm volatile("s_waitcnt lgkmcnt(0)" ::: "memory");
#pragma unroll
                for (int r = 0; r < 16; ++r) { const float a = al_l[crow(r, hi)];
#pragma unroll
                    for (int d = 0; d < 4; ++d) o[d][r] *= a; } }
            bf16x8 pa0, pa1, pa2, pa3;
#define PK4(P, BASE, OUT) do { unsigned a0 = cvt_pk_bf16(P[BASE + 0], P[BASE + 1]), a1 = cvt_pk_bf16(P[BASE + 2], P[BASE + 3]);   \
    unsigned b0_ = cvt_pk_bf16(P[BASE + 4], P[BASE + 5]), b1_ = cvt_pk_bf16(P[BASE + 6], P[BASE + 7]);                              \
    auto r0 = __builtin_amdgcn_permlane32_swap(a0, b0_, false, false); auto r1 = __builtin_amdgcn_permlane32_swap(a1, b1_, false, false); \
    u32x4 w = {r0[0], r1[0], r0[1], r1[1]}; OUT = __builtin_bit_cast(bf16x8, w); } while (0)
            PK4(p0, 0, pa0); PK4(p0, 8, pa1); PK4(p1, 0, pa2); PK4(p1, 8, pa3);
#undef PK4
            const int vb = vb0 + kb * VT_BYTES;
            pv_one<0>(o[0], vb, pa0, pa1, pa2, pa3); pv_one<1>(o[1], vb, pa0, pa1, pa2, pa3); pv_one<2>(o[2], vb, pa0, pa1, pa2, pa3); pv_one<3>(o[3], vb, pa0, pa1, pa2, pa3);
        }
        if (grp == 0) { if (j + 1 < NT) { if (more) asm volatile("s_waitcnt vmcnt(5)" ::: "memory"); else asm volatile("s_waitcnt vmcnt(0)" ::: "memory"); } }
        ATT_BAR();
        kb = (kb == 2) ? 0 : kb + 1; nb = (nb == 2) ? 0 : nb + 1;
    }
    if (grp == 0) ATT_BAR();
    if (hi == 0) li_l[r32] = l_reg; asm volatile("s_waitcnt lgkmcnt(0)" ::: "memory");
    bf16_t* Ow = O + (tok0 + (size_t)qb * 256 + wid * 32) * LDO + h * VH;
#pragma unroll
    for (int r = 0; r < 16; ++r) { const int orow = crow(r, hi); const float rl = __builtin_amdgcn_rcpf(li_l[orow]);
#pragma unroll
        for (int d0 = 0; d0 < 4; ++d0) Ow[(size_t)orow * LDO + d0 * 32 + r32] = (bf16_t)f2bf(o[d0][r] * rl); }
    asm volatile("s_waitcnt lgkmcnt(0)" ::: "memory"); ATT_BAR();
#undef ATT_DMA
#undef ATT_BAR
}
#undef SBAR
}

#define XB_TMO      128
#define XB_XCNT(j)  (256  + 64 * (j))
#define XB_XSUB(j)  (1280 + 64 * (j))
#define XB_XGEN(j)  (2304 + 64 * (j))
#define XB_TOP      3328
#define XB_TOPGEN   3392
#define XCD_BAR_WORDS 3456
#define XB_SPIN_CAP (1u << 18)
__device__ __forceinline__ unsigned xb_ld(unsigned* p)              { return __hip_atomic_load(p, __ATOMIC_RELAXED, __HIP_MEMORY_SCOPE_AGENT); }
__device__ __forceinline__ unsigned xb_add(unsigned* p, unsigned v) { return __hip_atomic_fetch_add(p, v, __ATOMIC_RELAXED, __HIP_MEMORY_SCOPE_AGENT); }
__device__ __forceinline__ unsigned xb_xcc_id() { return (unsigned)__builtin_amdgcn_s_getreg((3 << 11) | 20) & 0xFu; }
#define XB_SPIN(cond, bar) do { unsigned _sp = 0; while (cond) { __builtin_amdgcn_s_sleep(1); \
    if ((++_sp & 255u) == 0u) { if (xb_ld(&(bar)[XB_TMO])) break; if (_sp > XB_SPIN_CAP) { atomicAdd(&(bar)[XB_TMO], 1u); break; } } } } while (0)
struct XcdBarrier { unsigned* bar; unsigned x; volatile LAS unsigned* st; };
__device__ __forceinline__ XcdBarrier xcd_barrier_post(unsigned* bar, volatile LAS unsigned* st) {
    XcdBarrier b; b.bar = bar; b.x = xb_xcc_id(); b.st = st;
    if (threadIdx.x == 0) (void)xb_add(&bar[XB_XCNT(b.x)], 1u);
    return b;
}
__device__ __forceinline__ void xcd_barrier_complete(unsigned* bar, unsigned x, unsigned& nloc, unsigned& nx) {
    const unsigned G = gridDim.x * gridDim.y * gridDim.z;
    unsigned sum, cnt, mine, sp = 0u;
    for (;;) {
        sum = 0u; cnt = 0u; mine = 0u;
#pragma unroll
        for (unsigned j = 0; j < 16; ++j) { const unsigned c = xb_ld(&bar[XB_XCNT(j)]); sum += c; cnt += (c > 0u) ? 1u : 0u; mine = (j == x) ? c : mine; }
        if (sum == G) break;
        __builtin_amdgcn_s_sleep(1);
        if ((++sp & 255u) == 0u) { if (xb_ld(&bar[XB_TMO])) break; if (sp > XB_SPIN_CAP) { atomicAdd(&bar[XB_TMO], 1u); break; } }
    }
    nloc = mine > 0u ? mine : 1u; nx = cnt > 0u ? cnt : 1u;
}
__device__ __forceinline__ void xcd_barrier(const XcdBarrier& b) {
    asm volatile("s_waitcnt vmcnt(0)" ::: "memory");
    __syncthreads();
    if (threadIdx.x == 0) {
        unsigned* bar = b.bar;
        __builtin_amdgcn_s_waitcnt(0);
        unsigned nloc = b.st[0], nx = b.st[1];
        if (nloc == 0u) { xcd_barrier_complete(bar, b.x, nloc, nx); b.st[0] = nloc; b.st[1] = nx; }
        const unsigned old = xb_add(&bar[XB_XSUB(b.x)], 1u);
        const unsigned gen = old / nloc;
        if (old + 1u == (gen + 1u) * nloc) {
            __builtin_amdgcn_fence(__ATOMIC_RELEASE, "agent");
            asm volatile("s_waitcnt vmcnt(0)" ::: "memory");
            const unsigned og = xb_add(&bar[XB_TOP], 1u);
            const unsigned tg = og / nx;
            if (og + 1u == (tg + 1u) * nx) xb_add(&bar[XB_TOPGEN], 1u);
            else XB_SPIN(xb_ld(&bar[XB_TOPGEN]) == tg, bar);
            __builtin_amdgcn_fence(__ATOMIC_ACQUIRE, "agent");
            xb_add(&bar[XB_XGEN(b.x)], 1u);
            asm volatile("s_waitcnt vmcnt(0)" ::: "memory");
        } else {
            XB_SPIN(xb_ld(&bar[XB_XGEN(b.x)]) == gen, bar);
            __builtin_amdgcn_fence(__ATOMIC_ACQUIRE, "agent");
            asm volatile("s_waitcnt vmcnt(0)" ::: "memory");
        }
    }
    __syncthreads();
}

constexpr int NWAVES = 8;
constexpr int N_LAUNCHES = MK_N_LAUNCHES;
constexpr int N_PHASES = 10;
struct Args { const float* in[18]; float* out; unsigned char* ws; int ph_lo, ph_hi; };

__device__ __forceinline__ void p0_transpose_item(const float* W, int K, int N, bf16_t* WT, int drow0, const float* kscale, LAS unsigned* scr, int k0, int n0, int lane, bool ileave = false) {
    const int g = lane >> 4, l16 = lane & 15;
    f32x4 v[16];
#pragma unroll
    for (int i = 0; i < 16; ++i) { const int kk = (i >> 1) * 8 + g * 2 + (i & 1); v[i] = __builtin_nontemporal_load((const f32x4*)(W + (size_t)(k0 + kk) * N + n0 + 4 * l16)); }
    if (kscale) {
#pragma unroll
        for (int i = 0; i < 16; ++i) { const int kk = (i >> 1) * 8 + g * 2 + (i & 1); v[i] = v[i] * kscale[k0 + kk]; } }
#pragma unroll
    for (int j = 0; j < 8; ++j) { const int kp = j * 4 + g;
#pragma unroll
        for (int c = 0; c < 4; ++c) scr[(4 * l16 + c) * 33 + kp] = cvt_pk_bf16(v[2 * j][c], v[2 * j + 1][c]); }
    LDS_WAIT(); asm volatile("" ::: "memory");
    const int c8 = lane & 7;
#pragma unroll
    for (int jj = 0; jj < 8; ++jj) { const int n = jj * 8 + (lane >> 3); const LAS unsigned* t = scr + n * 33 + 4 * c8;
        u32x4 o; o.x = t[0]; o.y = t[1]; o.z = t[2]; o.w = t[3];
        const int dn = ileave ? ((n < 32) ? 2 * n : 2 * (n - 32) + 1) : n;
        *(u32x4*)(WT + (size_t)(drow0 + dn) * K + k0 + 8 * c8) = o; }
    LDS_WAIT(); asm volatile("" ::: "memory");
}

__device__ __forceinline__ void p0_transpose_item8(const float* W, int K, int N, unsigned char* WT, int drow0, const float* kscale, LAS unsigned* scr, int k0, int n0, int lane) {
    const int g = lane >> 4, l16 = lane & 15;
    f32x4 v[32];
#pragma unroll
    for (int i = 0; i < 32; ++i) { const int kk = (i >> 2) * 16 + g * 4 + (i & 3); v[i] = __builtin_nontemporal_load((const f32x4*)(W + (size_t)(k0 + kk) * N + n0 + 4 * l16)); }
#pragma unroll
    for (int i = 0; i < 32; ++i) { const int kk = (i >> 2) * 16 + g * 4 + (i & 3); v[i] = v[i] * (kscale ? kscale[k0 + kk] * W8_SCALE : W8_SCALE); }
#pragma unroll
    for (int j = 0; j < 8; ++j) { const int kd = j * 4 + g;
#pragma unroll
        for (int c = 0; c < 4; ++c) scr[(4 * l16 + c) * 33 + kd] = pk4_fp8(v[4 * j][c], v[4 * j + 1][c], v[4 * j + 2][c], v[4 * j + 3][c]); }
    LDS_WAIT(); asm volatile("" ::: "memory");
    const int c8 = lane & 7;
#pragma unroll
    for (int jj = 0; jj < 8; ++jj) { const int n = jj * 8 + (lane >> 3); const LAS unsigned* t = scr + n * 33 + 4 * c8;
        u32x4 o; o.x = t[0]; o.y = t[1]; o.z = t[2]; o.w = t[3];
        *(u32x4*)(WT + (size_t)(drow0 + n) * K + k0 + 16 * c8) = o; }
    LDS_WAIT(); asm volatile("" ::: "memory");
}

template <int PHMASK> __global__ void __launch_bounds__(NWAVES * 64, 2) fwd_kernel_t(Args args) {
    extern __shared__ __attribute__((aligned(16))) unsigned char lds_raw[];
    LAS unsigned char* lds = (LAS unsigned char*)lds_raw;
    volatile LAS unsigned* MISC = (volatile LAS unsigned*)(lds + MISC_OFF);
    const int tid = threadIdx.x, lane = tid & 63, wave = __builtin_amdgcn_readfirstlane(tid >> 6);
    const int G = gridDim.x; const int bx = blockIdx.x; const int vcu = (G % 8 == 0) ? (bx % 8) * (G / 8) + bx / 8 : bx;
    unsigned char* ws = args.ws;
    unsigned* ctl = (unsigned*)(ws + WS_CTL);
    const float* x = args.in[0]; const float* norm_mix = args.in[1]; const float* w_in = args.in[2]; const float* conv_w = args.in[3];
    const float* q_norm = args.in[4]; const float* w_uq = args.in[5]; const float* kv_norm = args.in[6]; const float* w_ukv = args.in[7];
    const float* q_head_norm = args.in[8]; const float* k_head_norm = args.in[9]; const float* w_o = args.in[10]; const float* norm_ffn = args.in[11];
    const float* w_router = args.in[12]; const float* b_router = args.in[13]; const float* w_gate_up = args.in[14]; const float* b_gate_up = args.in[15];
    const float* w_down = args.in[16]; const float* b_down = args.in[17];
    float* out = args.out;
    f32x2* rope_t = (f32x2*)(ws + WS_ROPE);
    bf16_t* WrH = (bf16_t*)(ws + WS_WRH); bf16_t* WrL = (bf16_t*)(ws + WS_WRL);
    bf16_t* Win_t = (bf16_t*)(ws + WS_WIN); bf16_t* Wuq_t = (bf16_t*)(ws + WS_WUQ); bf16_t* Wukv_t = (bf16_t*)(ws + WS_WUKV); bf16_t* Wo_t = (bf16_t*)(ws + WS_WO);
    float* ssq = (float*)(ws + WS_SSQ); float* rs2 = (float*)(ws + WS_RS2); float* gate = (float*)(ws + WS_GATE); int* tos = (int*)(ws + WS_TOS);
    unsigned char* Wgu_t = ws + WS_WGU; unsigned char* Wdn_t = ws + WS_WDN;
    unsigned char* hq = ws + WS_HB;
    bf16_t* qb_ = (bf16_t*)(ws + WS_Q); bf16_t* kb_ = (bf16_t*)(ws + WS_K); bf16_t* vb_ = (bf16_t*)(ws + WS_V); bf16_t* mix = (bf16_t*)(ws + WS_MIX);
    bf16_t* oslot = (bf16_t*)(ws + WS_OSLOT); bf16_t* hn = (bf16_t*)(ws + WS_HN); bf16_t* pbuf = (bf16_t*)(ws + WS_PB); bf16_t* qraw = (bf16_t*)(ws + WS_QRAW); bf16_t* kvraw = (bf16_t*)(ws + WS_KVRAW);
    unsigned char* act = ws + WS_ACT;

    for (int u = tid; u < (LDS_BYTES - MISC_OFF) / 4; u += NWAVES * 64) ((LAS unsigned*)(lds + MISC_OFF))[u] = 0u;
    __syncthreads();
    XcdBarrier bar; bar.bar = ctl + CW_BAR; bar.x = 0; bar.st = nullptr;
    if (N_LAUNCHES == 1) bar = xcd_barrier_post(ctl + CW_BAR, MISC + 8);
#define GRID_BAR() do { if (N_LAUNCHES == 1) xcd_barrier(bar); } while (0)
    const int lo = args.ph_lo, hi = args.ph_hi;
#define IN(k) (((PHMASK >> (k)) & 1) && lo <= (k) && (k) < hi)
#define BOTH(k) (IN(k) && IN((k) + 1))
    const int gw = vcu * NWAVES + wave, NGW = G * NWAVES;

    if (IN(0)) {
        LAS unsigned* scr = (LAS unsigned*)(lds + wave * 16384);
        constexpr int I_IN = (DM / 64) * (NPROJ / 64), I_UQ = (QL / 64) * (768 / 64), I_UKV = (KVL / 64) * (1024 / 64), I_O = (DM / 64) * (DM / 64);
        constexpr int I_GU1 = (DM / 128) * (2 * DFF / 64), I_GU = NE * I_GU1, I_DN1 = (DFF / 128) * (DM / 64), I_DN = NE * I_DN1;
        constexpr int NITEMS = I_IN + I_UQ + I_UKV + I_O + I_GU + I_DN;
        for (int it = gw; it < NITEMS; it += NGW) {
            int r = it;
            if (r < I_GU) { const int e = r / I_GU1, q = r % I_GU1, nblk = 2 * DFF / 64, kb = q / nblk, nb = q % nblk, n0 = nb * 64, j = n0 & (DFF - 1), up = n0 >= DFF;
                p0_transpose_item8(w_gate_up + (size_t)e * DM * 2 * DFF, DM, 2 * DFF, Wgu_t + (size_t)e * 2 * DFF * DM, (j >> 7) * 256 + (j & 127) + (up ? 128 : 0), norm_ffn, scr, kb * 128, n0, lane); continue; } r -= I_GU;
            if (r < I_DN) { const int e = r / I_DN1, q = r % I_DN1, nblk = DM / 64, kb = q / nblk, nb = q % nblk;
                p0_transpose_item8(w_down + (size_t)e * DFF * DM, DFF, DM, Wdn_t + (size_t)e * DM * DFF, nb * 64, nullptr, scr, kb * 128, nb * 64, lane); continue; } r -= I_DN;
            if (r < I_IN) { const int nblk = NPROJ / 64, kb = r / nblk, nb = r % nblk, n0 = nb * 64;
                const int d0 = (n0 < 512) ? n0 : (n0 < 1024 ? 512 + ((n0 - 512) >> 7) * 256 + ((n0 - 512) & 127) : (n0 < 1536 ? 512 + ((n0 - 1024) >> 7) * 256 + 128 + ((n0 - 1024) & 127)
                             : (n0 < 1920 ? n0 + 256 : (n0 < 2176 ? n0 - 384 : n0))));
                p0_transpose_item(w_in, DM, NPROJ, Win_t, d0, nullptr, scr, kb * 64, n0, lane); continue; } r -= I_IN;
            if (r < I_UQ) { const int nblk = 768 / 64, kb = r / nblk, nb = r % nblk, h = nb / 3, part = nb % 3;
                p0_transpose_item(w_uq, QL, 768, Wuq_t, h * 256 + part * 64, q_norm, scr, kb * 64, nb * 64, lane, part == 2); continue; } r -= I_UQ;
            if (r < I_UKV) { const int nblk = 1024 / 64, kb = r / nblk, nb = r % nblk; p0_transpose_item(w_ukv, KVL, 1024, Wukv_t, nb * 64, kv_norm, scr, kb * 64, nb * 64, lane); continue; } r -= I_UKV;
            { const int nblk = DM / 64, kb = r / nblk, nb = r % nblk; p0_transpose_item(w_o, DM, DM, Wo_t, nb * 64, nullptr, scr, kb * 64, nb * 64, lane); }
        }
        const int gt = vcu * (NWAVES * 64) + tid, NGT = G * NWAVES * 64;
        for (int i = gt; i < (NPP - NPROJ) * DM / 8; i += NGT) *(u32x4*)(Win_t + (size_t)NPROJ * DM + (size_t)i * 8) = (u32x4){0u, 0u, 0u, 0u};
        for (int i = gt; i < NH * 64 * QL / 8; i += NGT) { const int h = i / (64 * QL / 8), j = i % (64 * QL / 8); *(u32x4*)(Wuq_t + (size_t)(h * 256 + 192) * QL + (size_t)j * 8) = (u32x4){0u, 0u, 0u, 0u}; }
        for (int i = gt; i < NE * DM; i += NGT) { const int e = i / DM, k = i % DM; const float v = w_router[(size_t)k * NE + e] * norm_ffn[k]; const unsigned h = f2bf(v); const float hf = __builtin_bit_cast(float, h << 16);
            WrH[i] = (bf16_t)h; WrL[i] = (bf16_t)f2bf(v - hf); }
        for (int i = gt; i < SEQ * 32; i += NGT) { const int pos = i >> 5, fi = i & 31; const float inv = exp2f(-(float)fi * (13.287712379549449f / 32.f)); const float ang = (float)pos * inv; float s, c; sincosf(ang, &s, &c); rope_t[i] = (f32x2){c, s}; }
        for (int m = 4 * gw; m < NTOK; m += 4 * NGW) {
            const f32x4* xr = (const f32x4*)(x + (size_t)m * DM) + lane; const f32x4* gr = (const f32x4*)norm_mix + lane;
            f32x4 v[4][4]; float ss[4] = {0.f, 0.f, 0.f, 0.f};
#pragma unroll
            for (int r = 0; r < 4; ++r)
#pragma unroll
                for (int j = 0; j < 4; ++j) v[r][j] = __builtin_nontemporal_load(xr + r * (DM / 4) + 64 * j);
#pragma unroll
            for (int r = 0; r < 4; ++r)
#pragma unroll
                for (int j = 0; j < 4; ++j) ss[r] += (v[r][j].x * v[r][j].x + v[r][j].y * v[r][j].y) + (v[r][j].z * v[r][j].z + v[r][j].w * v[r][j].w);
            u32x2* o8 = (u32x2*)(hn + (size_t)m * DM) + lane;
#pragma unroll
            for (int r = 0; r < 4; ++r) { const float rr = 1.0f / sqrtf(wave_sum(ss[r]) * (1.f / DM) + EPS);
#pragma unroll
                for (int j = 0; j < 4; ++j) { const f32x4 g = gr[64 * j]; u32x2 w;
                    w.x = cvt_pk_bf16(v[r][j].x * rr * g.x, v[r][j].y * rr * g.y); w.y = cvt_pk_bf16(v[r][j].z * rr * g.z, v[r][j].w * rr * g.w); o8[r * (DM / 4) + 64 * j] = w; } }
        }
        if (BOTH(0)) GRID_BAR();
    }

    if (IN(1)) {
        pg8::DenseSched S; S.init(hn, DM, Win_t, NTOK, NPP, DM, G, bx);
        pg8::EpiProj E{pbuf, ssq};
        pg8::gemm_phase<pg8::EpiProj, pg8::DenseSched, false>(lds, S, E);
        if (BOTH(1)) GRID_BAR();
    }

    const bool p2_all = IN(2);
    if (p2_all || IN(13)) {
        {
            const int gt = vcu * (NWAVES * 64) + tid, NGT = G * NWAVES * 64;
            for (int it = gt; it < (NTOK / 16) * 64; it += NGT) {
                const int run = it >> 6, gr = it & 63, t0 = run * 16, ch = gr * 8;
                float w0[8], w1[8], w2[8];
#pragma unroll
                for (int i = 0; i < 8; ++i) { w0[i] = conv_w[ch + i]; w1[i] = conv_w[CONVW + ch + i]; w2[i] = conv_w[2 * CONVW + ch + i]; }
                float um2[8], um1[8];
#pragma unroll
                for (int i = 0; i < 8; ++i) { um2[i] = 0.f; um1[i] = 0.f; }
                if ((t0 & (SEQ - 1)) != 0) {
                    unpack8(*(const u32x4*)(pbuf + (size_t)(t0 - 2) * NPB + PB_U + ch), um2);
                    unpack8(*(const u32x4*)(pbuf + (size_t)(t0 - 1) * NPB + PB_U + ch), um1);
                }
                u32x4 bq[16], uq[16];
#pragma unroll
                for (int t = 0; t < 16; ++t) { const bf16_t* pr = pbuf + (size_t)(t0 + t) * NPB + ch; bq[t] = __builtin_nontemporal_load((const u32x4*)(pr + PB_B)); uq[t] = __builtin_nontemporal_load((const u32x4*)(pr + PB_U)); }
#pragma unroll
                for (int t = 0; t < 16; ++t) {
                    float b8[8], u8[8], o8[8];
                    unpack8(bq[t], b8); unpack8(uq[t], u8);
#pragma unroll
                    for (int i = 0; i < 8; ++i) { o8[i] = b8[i] * (w0[i] * um2[i] + w1[i] * um1[i] + w2[i] * u8[i]); um2[i] = um1[i]; um1[i] = u8[i]; }
                    *(u32x4*)(mix + (size_t)(t0 + t) * DM + ch) = pack8(o8);
                }
            }
        }
    }
    if (p2_all || IN(14) || IN(15)) {
        LAS float* etab = (LAS float*)(lds + EPI_TAB_OFF);
        if (p2_all || IN(14)) { pg8::DenseSched S; S.init(pbuf + PB_CQ, NPB, Wuq_t, NTOK, NQP, QL, G, bx); pg8::EpiQ E{qb_, ssq, q_head_norm, rope_t, etab};
          pg8::gemm_phase<pg8::EpiQ, pg8::DenseSched, false>(lds, S, E); }
        if (p2_all || IN(15)) { pg8::DenseSched S; S.init(pbuf + PB_CKV, NPB, Wukv_t, NTOK, 1024, KVL, G, bx); pg8::EpiKV E{kb_, vb_, ssq, k_head_norm, rope_t, pbuf, etab};
          pg8::gemm_phase<pg8::EpiKV, pg8::DenseSched, false>(lds, S, E); }
        if (BOTH(2)) GRID_BAR();
    }


    if (IN(4)) {
        for (int u = vcu; u < NB * NH * 4; u += G) {
            const int bh = u >> 2, pr = u & 3, b = bh >> 2, h = bh & 3;
            att::attn_unit(b, h, 7 - pr, qb_, kb_, vb_, mix + CONVW, lds);
            att::attn_unit(b, h, pr, qb_, kb_, vb_, mix + CONVW, lds);
        }
        if (BOTH(4)) GRID_BAR();
    }

    if (IN(5)) {
        pg8::DenseSched S; S.init(mix, DM, Wo_t, NTOK, DM, DM, G, bx);
        pg8::EpiOut E{x, (bf16_t*)(ws + WS_H1B), ssq};
        pg8::gemm_phase<pg8::EpiOut, pg8::DenseSched, false>(lds, S, E);
        if (BOTH(5)) GRID_BAR();
    }

    if (IN(6) || IN(16)) {
        const bool dry = !IN(6);
        LAS unsigned* hist = (LAS unsigned*)(lds + MISC_OFF) + 128; LAS unsigned* base = (LAS unsigned*)(lds + MISC_OFF) + 160;
        const int tj = lane & 15, q = lane >> 4;
        for (int i = tid; i < 2 * NE * 128; i += NWAVES * 64) { const int sel = i >> 12, r = (i >> 7) & 31, g = i & 127;
            const u32x4 v = *(const u32x4*)((sel ? WrL : WrH) + (size_t)r * DM + g * 8);
            *(LAS u32x4*)(lds + sel * 65536 + r * 2048 + ((g ^ (r & 15)) << 4)) = v; }
        __syncthreads();
        for (int tile = vcu; tile < NTOK / 128; tile += G) {
            if (tid < 32) hist[tid] = 0u;
            __syncthreads();
            const int token = tile * 128 + wave * 16 + tj;
            const bf16_t* hrow = (const bf16_t*)(ws + WS_H1B) + (size_t)token * DM + q * 8;
            f32x4 a0 = {0.f, 0.f, 0.f, 0.f}, a1 = {0.f, 0.f, 0.f, 0.f};
            float s2 = 0.f;
#pragma unroll
            for (int p = 0; p < 16; ++p) s2 += ssq[(size_t)p * NTOK + token];
            const float rs = 1.0f / sqrtf(s2 * (1.f / DM) + EPS);
            unsigned char* hqrow = hq + (size_t)token * DM + q * 8;
            const LAS unsigned char* wlds = lds + tj * 2048;
#pragma unroll 1
            for (int kh = 0; kh < 2; ++kh) {
                u32x4 hv[16];
#pragma unroll
                for (int kk = 0; kk < 16; ++kk) hv[kk] = *(const u32x4*)(hrow + (kh * 16 + kk) * 32);
#pragma unroll
                for (int kk = 0; kk < 16; ++kk) { const int ks = kh * 16 + kk;
                    const u32x4 hw = hv[kk]; float hf[8]; unpack8(hw, hf);
                    { u32x2 w8; w8.x = pk4_fp8(hf[0] * rs, hf[1] * rs, hf[2] * rs, hf[3] * rs); w8.y = pk4_fp8(hf[4] * rs, hf[5] * rs, hf[6] * rs, hf[7] * rs); *(u32x2*)(hqrow + ks * 32) = w8; }
                    const bf16x8 bh = __builtin_bit_cast(bf16x8, hw);
                    const int go = (((ks * 4 + q) ^ tj) << 4);
                    const bf16x8 wh_a = *(const LAS bf16x8*)(wlds + go), wh_b = *(const LAS bf16x8*)(wlds + 16 * 2048 + go);
                    const bf16x8 wl_a = *(const LAS bf16x8*)(wlds + 65536 + go), wl_b = *(const LAS bf16x8*)(wlds + 65536 + 16 * 2048 + go);
                    a0 = __builtin_amdgcn_mfma_f32_16x16x32_bf16(wh_a, bh, a0, 0, 0, 0); a0 = __builtin_amdgcn_mfma_f32_16x16x32_bf16(wl_a, bh, a0, 0, 0, 0);
                    a1 = __builtin_amdgcn_mfma_f32_16x16x32_bf16(wh_b, bh, a1, 0, 0, 0); a1 = __builtin_amdgcn_mfma_f32_16x16x32_bf16(wl_b, bh, a1, 0, 0, 0);
                }
            }
            float lv[8]; int le[8];
#pragma unroll
            for (int i = 0; i < 4; ++i) { le[i] = 4 * q + i; le[4 + i] = 16 + 4 * q + i; lv[i] = a0[i] * rs + b_router[le[i]]; lv[4 + i] = a1[i] * rs + b_router[le[4 + i]]; }
            float tv[4]; int te[4];
#pragma unroll
            for (int k = 0; k < TOPK; ++k) {
                float bv = lv[0]; int be = le[0];
#pragma unroll
                for (int i = 1; i < 8; ++i) if (lv[i] > bv) { bv = lv[i]; be = le[i]; }
#pragma unroll
                for (int o = 16; o < 64; o <<= 1) { const float ov = __shfl_xor(bv, o); const int oe = __shfl_xor(be, o); if (ov > bv || (ov == bv && oe < be)) { bv = ov; be = oe; } }
                tv[k] = bv; te[k] = be;
#pragma unroll
                for (int i = 0; i < 8; ++i) if (le[i] == be) lv[i] = -3.0e38f;
            }
            float ge[4]; float gs = 0.f;
#pragma unroll
            for (int k = 0; k < TOPK; ++k) { ge[k] = __expf(tv[k] - tv[0]); gs += ge[k]; }
            const float ginv = 1.0f / gs;
            int my_e = te[0]; float my_g = ge[0];
#pragma unroll
            for (int k = 1; k < TOPK; ++k) if (q == k) { my_e = te[k]; my_g = ge[k]; }
            my_g *= ginv;
            const unsigned pl = atomicAdd((unsigned*)(hist + my_e), 1u);
            __syncthreads();
            if (tid < 32) base[tid] = dry ? 0u : __hip_atomic_fetch_add(ctl + CW_CNT + 64 * tid, hist[tid], __ATOMIC_RELAXED, __HIP_MEMORY_SCOPE_AGENT);
            __syncthreads();
            const unsigned pos = base[my_e] + pl; const int slot = token * 4 + q;
            if (!dry) *(u32x2*)(tos + ((size_t)my_e * CAP + pos) * 2) = (u32x2){(unsigned)slot, __builtin_bit_cast(unsigned, my_g)};
            else if (my_g < -1.f) rs2[token] = my_g;
            __syncthreads();
        }
        if (BOTH(6)) GRID_BAR();
    }

    LAS int* tab = (LAS int*)(lds + MISC_OFF) + 16;
    if (IN(7) || IN(8) || IN(10) || IN(11) || IN(12)) {
        if (tid < 32) { const int c = (int)__hip_atomic_load(ctl + CW_CNT + 64 * tid, __ATOMIC_RELAXED, __HIP_MEMORY_SCOPE_AGENT); tab[48 + tid] = c; }
        __syncthreads();
        if (tid == 0) { int s = 0; for (int e = 0; e < NE; ++e) { tab[e] = s; s += (tab[48 + e] + 255) >> 8; } tab[32] = s; }
        __syncthreads();
        for (int t = tid; t < tab[32]; t += NWAVES * 64) { int e = 0; while (e < NE - 1 && tab[e + 1] <= t) ++e; tab[2288 + t] = e; }
        __syncthreads();
    }

    if (IN(7)) {
        pg8::MoeSched S{hq, Wgu_t, DM, DM, 2 * DFF / 256, G, bx, (size_t)2 * DFF * DM, tab, tos, b_gate_up};
        pg8::EpiSwiglu E{act, b_gate_up, lds};
        pg8::gemm_phase<pg8::EpiSwiglu, pg8::MoeSched, true>(lds, S, E);
        if (BOTH(7)) GRID_BAR();
    }

    if (IN(8)) {
        pg8::MoeSched S{act, Wdn_t, DFF, DFF, DM / 256, G, bx, (size_t)DM * DFF, tab, tos, b_down};
        pg8::EpiDown E{(unsigned char*)oslot, b_down, ws + WS_SSQ, lds};
        pg8::gemm_phase<pg8::EpiDown, pg8::MoeSched, false>(lds, S, E);
        if (BOTH(8)) GRID_BAR();
    }

#if PROBE_DOUBLE
    if (IN(10)) { pg8::MoeSched S{hq, Wgu_t, DM, DM, 2 * DFF / 256, G, bx, (size_t)2 * DFF * DM, tab, tos, b_gate_up}; pg8::EpiNull E{(float*)(ws + WS_SSQ)};
        pg8::gemm_phase<pg8::EpiNull, pg8::MoeSched, true>(lds, S, E); }
    if (IN(11)) { pg8::MoeSched S{act, Wdn_t, DFF, DFF, DM / 256, G, bx, (size_t)DM * DFF, tab, tos, b_down}; pg8::EpiNull E{(float*)(ws + WS_SSQ)};
        pg8::gemm_phase<pg8::EpiNull, pg8::MoeSched, false, 2>(lds, S, E); }
    if (IN(12)) { pg8::MoeSched S{act, Wdn_t, DFF, DFF, DM / 256, G, bx, (size_t)DM * DFF, tab, tos, b_down}; pg8::EpiNull E{(float*)(ws + WS_SSQ)};
        pg8::gemm_phase<pg8::EpiNull, pg8::MoeSched, false>(lds, S, E); }
#endif
    if (IN(9)) {
        const unsigned char* os8 = (const unsigned char*)oslot;
        constexpr float OI = 1.f / OS8_SCALE;
        for (int m = gw; m < NTOK; m += NGW) {
            f32x4* orow = (f32x4*)(out + (size_t)m * DM) + lane;
            const u32x2* hrow = (const u32x2*)((const bf16_t*)(ws + WS_H1B) + (size_t)m * DM) + lane;
            const unsigned* s0 = (const unsigned*)(os8 + (size_t)m * 4 * DM) + lane;
            unsigned w[4][4]; f32x4 hv[4];
#pragma unroll
            for (int j = 0; j < 4; ++j) { const u32x2 hb2 = __builtin_nontemporal_load(hrow + 64 * j); hv[j] = (f32x4){bf_lo(hb2.x), bf_hi(hb2.x), bf_lo(hb2.y), bf_hi(hb2.y)};
#pragma unroll
                for (int k = 0; k < 4; ++k) w[j][k] = __builtin_nontemporal_load(s0 + (size_t)k * (DM / 4) + 64 * j); }
#pragma unroll
            for (int j = 0; j < 4; ++j) { f32x4 a = {0.f, 0.f, 0.f, 0.f};
#pragma unroll
                for (int k = 0; k < 4; ++k) { const f32x2 lo = __builtin_amdgcn_cvt_pk_f32_fp8(w[j][k], false), hi2 = __builtin_amdgcn_cvt_pk_f32_fp8(w[j][k], true); a.x += lo.x; a.y += lo.y; a.z += hi2.x; a.w += hi2.y; }
                __builtin_nontemporal_store(hv[j] + a * OI, orow + 64 * j); }
        }
    }
#undef IN
#undef BOTH
#undef GRID_BAR
}

#ifdef DIAG_PHASES
template __global__ void fwd_kernel_t<1>(Args); template __global__ void fwd_kernel_t<2>(Args); template __global__ void fwd_kernel_t<4>(Args); template __global__ void fwd_kernel_t<8>(Args);
template __global__ void fwd_kernel_t<16>(Args); template __global__ void fwd_kernel_t<32>(Args); template __global__ void fwd_kernel_t<64>(Args); template __global__ void fwd_kernel_t<128>(Args);
template __global__ void fwd_kernel_t<256>(Args); template __global__ void fwd_kernel_t<512>(Args);
#endif
#define fwd_kernel fwd_kernel_t<(PROBE_DOUBLE ? 0x1ffff : 1023)>
extern "C" void kernel_launch(void* const* d_in, const int* in_sizes, int n_in, void* d_out, int out_size, void* d_ws, size_t ws_size, hipStream_t stream) {
    static int grid = 0;
    if (grid == 0) {
        if (n_in != 18 || in_sizes[0] != NTOK * DM || out_size != NTOK * DM || ws_size < WS_END) { fprintf(stderr, "kernel_launch: shape/workspace mismatch (n_in %d, in0 %d, out %d, ws %zu, need %zu)\n", n_in, n_in > 0 ? in_sizes[0] : -1, out_size, ws_size, (size_t)WS_END); grid = -1; return; }
        int dev = 0, cus = 0, per_cu = 0;
        if (hipGetDevice(&dev) != hipSuccess || hipDeviceGetAttribute(&cus, hipDeviceAttributeMultiprocessorCount, dev) != hipSuccess) { grid = -1; return; }
        if (hipFuncSetAttribute((const void*)fwd_kernel, hipFuncAttributeMaxDynamicSharedMemorySize, LDS_BYTES) != hipSuccess) { fprintf(stderr, "kernel_launch: hipFuncSetAttribute failed\n"); grid = -1; return; }
        if (hipOccupancyMaxActiveBlocksPerMultiprocessor(&per_cu, (const void*)fwd_kernel, NWAVES * 64, LDS_BYTES) != hipSuccess || per_cu < 1) { fprintf(stderr, "kernel_launch: occupancy query says %d\n", per_cu); }
        (void)hipGetLastError();
        grid = cus;
    }
    if (grid < 0) return;
    if (hipMemsetAsync((char*)d_ws + WS_CTL, 0, CTL_ZERO_BYTES, stream) != hipSuccess) return;
    Args a{};
    for (int i = 0; i < 18; ++i) a.in[i] = (const float*)d_in[i];
    a.out = (float*)d_out; a.ws = (unsigned char*)d_ws;
    if (N_LAUNCHES == 1) { a.ph_lo = 0; a.ph_hi = N_PHASES; hipLaunchKernelGGL(fwd_kernel, dim3(grid), dim3(NWAVES * 64), LDS_BYTES, stream, a); }
    else { for (int p = 0; p < N_PHASES; ++p) { a.ph_lo = p; a.ph_hi = p + 1; const int reps = ((PROBE_DOUBLE >> p) & 1) ? 2 : 1;
            for (int r = 0; r < reps; ++r) hipLaunchKernelGGL(fwd_kernel, dim3(grid), dim3(NWAVES * 64), LDS_BYTES, stream, a);
            if (p == 8) for (int pp = 10; pp < 13; ++pp) if ((PROBE_DOUBLE >> pp) & 1) { a.ph_lo = pp; a.ph_hi = pp + 1; hipLaunchKernelGGL(fwd_kernel, dim3(grid), dim3(NWAVES * 64), LDS_BYTES, stream, a); }
            if (p == 6 && ((PROBE_DOUBLE >> 16) & 1)) { a.ph_lo = 16; a.ph_hi = 17; hipLaunchKernelGGL(fwd_kernel, dim3(grid), dim3(NWAVES * 64), LDS_BYTES, stream, a); }
            if (p == 2) for (int pp = 13; pp < 16; ++pp) if ((PROBE_DOUBLE >> pp) & 1) { a.ph_lo = pp; a.ph_hi = pp + 1; hipLaunchKernelGGL(fwd_kernel, dim3(grid), dim3(NWAVES * 64), LDS_BYTES, stream, a); } } }
}
```

```cpp
#include <hip/hip_runtime.h>
#include <cstdio>
#include <cstdint>

#ifndef MK_N_LAUNCHES
#define MK_N_LAUNCHES 1
#endif

#ifndef PROBE_DOUBLE
#define PROBE_DOUBLE 0
#endif
#define LAS __attribute__((address_space(3)))
#define GAS __attribute__((address_space(1)))
typedef unsigned short bf16_t;
typedef short bf16x8 __attribute__((ext_vector_type(8)));
typedef short s16x4 __attribute__((ext_vector_type(4)));
typedef float f32x2 __attribute__((ext_vector_type(2)));
typedef float f32x4 __attribute__((ext_vector_type(4)));
typedef float f32x16 __attribute__((ext_vector_type(16)));
typedef unsigned u32x2 __attribute__((ext_vector_type(2)));
typedef unsigned u32x4 __attribute__((ext_vector_type(4)));
typedef int v4i_t __attribute__((ext_vector_type(4)));
typedef int v8i_t __attribute__((ext_vector_type(8)));

constexpr int NB = 16, SEQ = 2048, NTOK = NB * SEQ, DM = 1024;
constexpr int CONVW = 512, QL = 384, KVL = 256, ROPE = 64, NH = 4, QKN = 128, QKH = 192, VH = 128;
constexpr int NPROJ = 2240, NPP = 2304;
constexpr int PB_B = 0, PB_U = 512, PB_CKV = 1024, PB_CQ = 1280, PB_KPE = 1664, NPB = 1728;
constexpr int NQP = 1024;
constexpr int NE = 32, TOPK = 4, DFF = 1024, NSLOT = NTOK * TOPK;
constexpr int CAP = NTOK;
constexpr int MAXTILES = NSLOT / 256 + NE;
constexpr float EPS = 1e-6f;
constexpr float QSCALE = 0.07216878364870322f * 1.4426950408889634f;
constexpr float SWI_LIMIT = 7.0f, SWI_ALPHA = 1.702f;
constexpr float W8_SCALE = 64.f, ACT8_SCALE = 4.f, OS8_SCALE = 16.f;

constexpr size_t MiB = 1u << 20;
constexpr size_t WS_CTL = 0, CTL_ZERO_BYTES = 1 * MiB;
constexpr size_t WS_ROPE = 1 * MiB;
constexpr size_t WS_WRH = 1 * MiB + 512 * 1024, WS_WRL = WS_WRH + 64 * 1024;
constexpr size_t WS_WIN = 2 * MiB;
constexpr size_t WS_WUQ = 8 * MiB, WS_WUKV = 9 * MiB, WS_WO = 10 * MiB;
constexpr size_t WS_SSQ = 12 * MiB;
constexpr size_t WS_RS2 = 14 * MiB, WS_GATE = 14 * MiB + 512 * 1024;
constexpr size_t WS_TOS = 16 * MiB;
constexpr size_t WS_WGU = 32 * MiB, WS_WDN = 160 * MiB;
constexpr size_t WS_HB = 224 * MiB;
constexpr size_t WS_Q = 288 * MiB, WS_K = 336 * MiB, WS_V = 384 * MiB, WS_MIX = 416 * MiB;
constexpr size_t WS_OSLOT = 288 * MiB;
constexpr size_t WS_HN = 544 * MiB, WS_PB = 608 * MiB, WS_QRAW = 752 * MiB, WS_KVRAW = 800 * MiB;
constexpr size_t WS_ACT = 544 * MiB;
constexpr size_t WS_H1B = 768 * MiB;
constexpr size_t WS_END = 864 * MiB;
constexpr int CW_BAR = 4096;
constexpr int CW_CNT = 16384;

constexpr int RING_BYTES = 131072;
constexpr int MISC_OFF = RING_BYTES;
constexpr int LDS_BYTES = 155648;
constexpr int EPI_TAB_OFF = MISC_OFF + 3072 * 4;

__device__ __forceinline__ unsigned cvt_pk_bf16(float lo, float hi) { unsigned r; asm volatile("v_cvt_pk_bf16_f32 %0, %1, %2" : "=v"(r) : "v"(lo), "v"(hi)); return r; }
__device__ __forceinline__ unsigned f2bf(float f) { unsigned u = __builtin_bit_cast(unsigned, f); return (u + 0x7fffu + ((u >> 16) & 1u)) >> 16; }
__device__ __forceinline__ unsigned pk2(float lo, float hi) { return f2bf(lo) | (f2bf(hi) << 16); }
__device__ __forceinline__ float bf_lo(unsigned w) { return __builtin_bit_cast(float, w << 16); }
__device__ __forceinline__ float bf_hi(unsigned w) { return __builtin_bit_cast(float, w & 0xffff0000u); }
__device__ __forceinline__ void unpack8(const u32x4 w, float* f) { f[0] = bf_lo(w.x); f[1] = bf_hi(w.x); f[2] = bf_lo(w.y); f[3] = bf_hi(w.y); f[4] = bf_lo(w.z); f[5] = bf_hi(w.z); f[6] = bf_lo(w.w); f[7] = bf_hi(w.w); }
__device__ __forceinline__ u32x4 pack8(const float* f) { u32x4 w; w.x = cvt_pk_bf16(f[0], f[1]); w.y = cvt_pk_bf16(f[2], f[3]); w.z = cvt_pk_bf16(f[4], f[5]); w.w = cvt_pk_bf16(f[6], f[7]); return w; }
__device__ __forceinline__ float wave_sum(float v) {
#pragma unroll
    for (int o = 1; o < 64; o <<= 1) v += __shfl_xor(v, o);
    return v;
}
__device__ __forceinline__ float half_sum(float v) {
#pragma unroll
    for (int o = 1; o < 32; o <<= 1) v += __shfl_xor(v, o);
    return v;
}
__device__ __forceinline__ float clamp448(float v) { return __builtin_amdgcn_fmed3f(v, -448.f, 448.f); }
__device__ __forceinline__ unsigned pk4_fp8_nc(float a, float b, float c, float d) {
    unsigned w = 0u; w = (unsigned)__builtin_amdgcn_cvt_pk_fp8_f32(a, b, (int)w, false); w = (unsigned)__builtin_amdgcn_cvt_pk_fp8_f32(c, d, (int)w, true); return w; }
__device__ __forceinline__ unsigned pk4_fp8(float a, float b, float c, float d) {
    unsigned w = 0u; w = (unsigned)__builtin_amdgcn_cvt_pk_fp8_f32(clamp448(a), clamp448(b), (int)w, false); w = (unsigned)__builtin_amdgcn_cvt_pk_fp8_f32(clamp448(c), clamp448(d), (int)w, true); return w; }
#define LDS_WAIT() asm volatile("s_waitcnt lgkmcnt(0)" ::: "memory")
#define VM_WAIT() asm volatile("s_waitcnt vmcnt(0)" ::: "memory")

namespace pg8 {
constexpr int BM = 256, BK = 64, HALF = 128, HTB = HALF * BK * 2, STAGE_BYTES = 8 * HTB, NXCD = 8, WGM = 4;
__host__ __device__ __forceinline__ int lds_byte(int r, int c) { const int st = (r >> 4) * 2 + (c >> 5), rr = r & 15, cc = c & 31, ob = rr * 64 + cc * 2; return st * 1024 + (ob ^ (((ob >> 9) & 1) << 5)); }
__host__ __device__ __forceinline__ void stage_rc(int b, int& R, int& C) { const int st = b / 1024, sb = b % 1024, swz = sb ^ (((sb >> 9) & 1) << 5); R = (st >> 1) * 16 + swz / 64; C = (st & 1) * 32 + (swz % 64) / 2; }
__host__ __device__ __forceinline__ int perm32(int rho) { const int n = rho >> 4, i = rho & 15; return 8 * (i >> 2) + 4 * n + (i & 3); }

struct Unit { int pm, pn, e, p0, cnt, par, half; };

__device__ __forceinline__ bool deal_unit(int i, int nwg, int G, int c, int& wgid, int& half) {
    half = 0;
    if (G % NXCD != 0) { const long L = (long)i * G + c; if (L >= nwg) return false; wgid = (int)L; return true; }
    const int W = G / NXCD, x = c % NXCD, rk = c / NXCD, q = nwg / NXCD, r = nwg % NXCD;
    const int cnt = q + (x < r ? 1 : 0), base = (x < r ? x * (q + 1) : r * (q + 1) + (x - r) * q);
    const int R = cnt / W, E = cnt - R * W;
    if (i < R) { wgid = base + i * W + rk; return true; }
    if (i > R) return false;
    if (rk >= E) return false; wgid = base + R * W + rk; return true;
}
struct DenseSched {
    static constexpr int ESZ = 2;
    const bf16_t* A; const bf16_t* Bt; int lda, K, nM, nN, nwg, G, c;
    __device__ void init(const bf16_t* A_, int lda_, const bf16_t* Bt_, int M, int N, int K_, int G_, int c_) { A = A_; Bt = Bt_; lda = lda_; K = K_; nM = M / BM; nN = N / BM; nwg = nM * nN; G = G_; c = c_; }
    __device__ __forceinline__ bool next(int i, Unit& u) const {
        int wgid, half; if (!deal_unit(i, nwg, G, c, wgid, half)) return false;
        const int nig = WGM * nN, gid = wgid / nig, fm = gid * WGM, gsz = (nM - fm) < WGM ? (nM - fm) : WGM;
        u.pm = fm + ((wgid % nig) % gsz); u.pn = (wgid % nig) / gsz; u.e = 0; u.p0 = 0; u.cnt = 0; u.half = half; return true;
    }
    __device__ __forceinline__ unsigned a_off(const Unit& u) const { return (unsigned)u.pm * (unsigned)(BM * lda * 2); }
    __device__ __forceinline__ unsigned b_off(const Unit& u) const { return (unsigned)u.pn * (unsigned)(BM * K * 2); }
    __device__ __forceinline__ unsigned a_rowoff(const Unit&, int) const { return 0u; }
    static constexpr bool META = false;
    __device__ __forceinline__ void meta_first(const Unit&, LAS unsigned char*) const {}
    __device__ __forceinline__ void meta_issue(const Unit&, LAS unsigned char*) const {}
    __device__ __forceinline__ void pre_issue(const Unit&, LAS unsigned char*) const {}
    __device__ __forceinline__ unsigned meta_rowoff(const Unit&, int, LAS unsigned char*) const { return 0u; }
};
struct MoeSched {
    static constexpr int ESZ = 1;
    const unsigned char* A; const unsigned char* Bt; int lda, K, nN, G, c; size_t estride; const LAS int* tab; const int* tos; const float* bias;
    static constexpr bool META = true;
    static constexpr int META_OFF = MISC_OFF + 4608 * 4;
    __device__ __forceinline__ bool next(int i, Unit& u) const {
        const int T = __builtin_amdgcn_readfirstlane(tab[32]), nwg = T * nN;
        int wgid, half; if (!deal_unit(i, nwg, G, c, wgid, half)) return false; u.half = half;
        const int nig = WGM * nN, gid = wgid / nig, fm = gid * WGM, gsz = (T - fm) < WGM ? (T - fm) : WGM;
        const int mt = fm + ((wgid % nig) % gsz); u.pm = mt; u.pn = (wgid % nig) / gsz;
        const int e = __builtin_amdgcn_readfirstlane(tab[2288 + mt]);
        u.e = e; u.p0 = (mt - __builtin_amdgcn_readfirstlane(tab[e])) * BM; u.cnt = __builtin_amdgcn_readfirstlane(tab[48 + e]); return true;
    }
    __device__ __forceinline__ unsigned a_off(const Unit& u) const { return (unsigned)u.pm * (unsigned)(BM * lda); }
    __device__ __forceinline__ unsigned b_off(const Unit& u) const { return (unsigned)u.e * (unsigned)estride + (unsigned)u.pn * (unsigned)(BM * K); }
    __device__ __forceinline__ unsigned a_rowoff(const Unit& u, int r) const {
        const int p = u.p0 + r; const int sv = tos[((size_t)u.e * CAP + p) * 2];
        const int slot = (p < u.cnt) ? sv : 0;
        return (unsigned)(slot >> 2) * (unsigned)lda;
    }
    static constexpr int BIAS_OFF = MISC_OFF + 5632 * 4;
    __device__ __forceinline__ void meta_first(const Unit& u, LAS unsigned char* lds) const { meta_issue(u, lds); }
    __device__ __forceinline__ void meta_issue(const Unit& u, LAS unsigned char* lds) const {
        const __amdgpu_buffer_rsrc_t rT = __builtin_amdgcn_make_buffer_rsrc((void*)tos, 0, -1, 0x00020000);
        const int wid = __builtin_amdgcn_readfirstlane(threadIdx.x >> 6);
        __builtin_amdgcn_raw_ptr_buffer_load_lds(rT, (LAS void*)(lds + META_OFF + u.par * 2048 + wid * 256), 4, (threadIdx.x & 63) * 4u, ((unsigned)u.e * (unsigned)CAP + (unsigned)u.p0) * 8u + (unsigned)wid * 256u, 0, 0);
    }
    __device__ __forceinline__ void pre_issue(const Unit& u, LAS unsigned char* lds) const {
        const int wid = __builtin_amdgcn_readfirstlane(threadIdx.x >> 6);
        if (wid < 4) { const __amdgpu_buffer_rsrc_t rB = __builtin_amdgcn_make_buffer_rsrc((void*)bias, 0, -1, 0x00020000);
            const unsigned src = (nN == 8) ? (((unsigned)u.e * (2u * DFF) + (unsigned)u.pn * HALF) * 4u + (wid >= 2 ? DFF * 4u - 512u : 0u)) : (((unsigned)u.e * DM + (unsigned)u.pn * BM) * 4u);
            __builtin_amdgcn_raw_ptr_buffer_load_lds(rB, (LAS void*)(lds + BIAS_OFF + u.par * 1024 + wid * 256), 4, (threadIdx.x & 63) * 4u, src + (unsigned)wid * 256u, 0, 0); }
    }
    __device__ __forceinline__ unsigned meta_rowoff(const Unit& u, int r, LAS unsigned char* lds) const {
        const int sv = *(const LAS int*)(lds + META_OFF + u.par * 2048 + r * 8);
        const int slot = (u.p0 + r < u.cnt) ? sv : 0;
        return (unsigned)(slot >> 2) * (unsigned)lda;
    }
};

template <class Epi, class Sched, bool GATHER, int KREP = 1>
__device__ __forceinline__ void gemm_phase(LAS unsigned char* lds, const Sched& S, const Epi& E) {
    const int tid = threadIdx.x, wid = __builtin_amdgcn_readfirstlane(tid >> 6), lane = tid & 63, wr = wid >> 2, wc = wid & 3, fr = lane & 15, fq = lane >> 4;
    constexpr int ESZ = Sched::ESZ; constexpr bool F8 = (ESZ == 1);
    const int K = S.K * ESZ / 2, lda = S.lda * ESZ / 2, nt0 = K / BK, nt = nt0 * KREP;
    unsigned voffB[2], aoc[2][2]; int RA[2], CA[2];
#pragma unroll
    for (int i = 0; i < 2; ++i) { int R, C; stage_rc(tid * 16 + i * 8192, R, C); const int Rb = (R & ~31) + perm32(R & 31);
        voffB[i] = (unsigned)(Rb * K + C) * 2u; RA[i] = R; CA[i] = C;
        aoc[0][i] = (unsigned)(R * lda + C) * 2u; aoc[1][i] = (unsigned)((R + HALF) * lda + C) * 2u; }
    const unsigned kstep = (unsigned)(BK * 2);
    const unsigned hstepB = (unsigned)(HALF * K * 2), hstepA = GATHER ? 0u : (unsigned)(HALF * lda * 2);
    const __amdgpu_buffer_rsrc_t rA = __builtin_amdgcn_make_buffer_rsrc((void*)S.A, 0, -1, 0x00020000), rB = __builtin_amdgcn_make_buffer_rsrc((void*)S.Bt, 0, -1, 0x00020000);
    const unsigned ldsw = (unsigned)wid * 1024u;
    const int aoff = lds_byte(wr * 64 + fr, fq * 8), boff = lds_byte(wc * 32 + fr, fq * 8);
#define PG8_SA(b, h) (((b) * 2 + (h)) * HTB)
#define PG8_SB(b, h) ((4 + (b) * 2 + (h)) * HTB)
#define PG8_STAGE_B(bufoff, soff) do { _Pragma("unroll") for (int _i = 0; _i < 2; ++_i) \
        __builtin_amdgcn_raw_ptr_buffer_load_lds(rB, (LAS void*)(lds + (bufoff) + ldsw + _i * 8192), 16, voffB[_i], (soff), 0, 0); } while (0)
#define PG8_STAGE_A(bufoff, soff, h) do { _Pragma("unroll") for (int _i = 0; _i < 2; ++_i) \
        __builtin_amdgcn_raw_ptr_buffer_load_lds(rA, (LAS void*)(lds + (bufoff) + ldsw + _i * 8192), 16, aoc[GATHER ? (h) : 0][_i], (soff) + (h) * hstepA, 0, 0); } while (0)
#define PG8_LDA(dst, b, h) do { _Pragma("unroll") for (int m = 0; m < 4; ++m) _Pragma("unroll") for (int k = 0; k < 2; ++k) dst[m][k] = *(const LAS bf16x8*)(lds + PG8_SA(b, h) + aoff + m * 2048 + k * 1024); } while (0)
#define PG8_LDB(dst, b, h) do { _Pragma("unroll") for (int n = 0; n < 2; ++n) _Pragma("unroll") for (int k = 0; k < 2; ++k) dst[n][k] = *(const LAS bf16x8*)(lds + PG8_SB(b, h) + boff + n * 2048 + k * 1024); } while (0)
#define PG8_CAT(x) __builtin_shufflevector(__builtin_bit_cast(v4i_t, x[0]), __builtin_bit_cast(v4i_t, x[1]), 0, 1, 2, 3, 4, 5, 6, 7)
#define PG8_MMA(ai, bj, At, Bt) do { __builtin_amdgcn_s_setprio(1); _Pragma("unroll") for (int m = 0; m < 4; ++m) _Pragma("unroll") for (int n = 0; n < 2; ++n) { \
        if constexpr (F8) { asm volatile("v_mfma_scale_f32_16x16x128_f8f6f4 %0, %1, %2, %0, %3, %3 op_sel_hi:[0,0,0]" : "+v"(acc[ai][bj][m][n]) : "v"(PG8_CAT(Bt[n])), "v"(PG8_CAT(At[m])), "v"(0x7f7f7f7f)); } \
        else { _Pragma("unroll") for (int k = 0; k < 2; ++k) acc[ai][bj][m][n] = __builtin_amdgcn_mfma_f32_16x16x32_bf16(Bt[n][k], At[m][k], acc[ai][bj][m][n], 0, 0, 0); } } \
        __builtin_amdgcn_s_setprio(0); } while (0)
#define PG8_WAIT_V(n) asm volatile("s_waitcnt vmcnt(" #n ")" ::: "memory")
#define PG8_WAIT_L(n) asm volatile("s_waitcnt lgkmcnt(" #n ")" ::: "memory")
#define PG8_BAR __builtin_amdgcn_s_barrier()
#define PG8_SCHED __builtin_amdgcn_sched_barrier(0)
    Unit cur, nxt; int ui = 0;
    if (!S.next(0, cur)) return;
    cur.par = 0; if constexpr (Sched::META) S.meta_first(cur, lds);
    f32x4 acc[2][2][4][2];
#pragma unroll
    for (int a = 0; a < 2; ++a)
#pragma unroll
        for (int b = 0; b < 2; ++b)
#pragma unroll
            for (int m = 0; m < 4; ++m)
#pragma unroll
                for (int n = 0; n < 2; ++n) acc[a][b][m][n] = (f32x4){0.f, 0.f, 0.f, 0.f};
    bf16x8 At[4][2], B0[2][2], B1[2][2];
    unsigned cA = GATHER ? 0u : S.a_off(cur), cB = S.b_off(cur);
    if constexpr (GATHER) {
#pragma unroll
        for (int h = 0; h < 2; ++h)
#pragma unroll
            for (int i = 0; i < 2; ++i) aoc[h][i] = S.a_rowoff(cur, h * HALF + RA[i]) + (unsigned)CA[i] * 2u;
    }
    PG8_STAGE_B(PG8_SB(0, 0), cB); PG8_STAGE_B(PG8_SB(0, 1), cB + hstepB); PG8_STAGE_A(PG8_SA(0, 0), cA, 0); PG8_STAGE_A(PG8_SA(0, 1), cA, 1);
    if (wr == 1) PG8_BAR;
    PG8_WAIT_V(2); PG8_BAR;
    PG8_STAGE_B(PG8_SB(1, 0), cB + kstep); PG8_STAGE_A(PG8_SA(1, 0), cA + kstep, 0); PG8_STAGE_B(PG8_SB(1, 1), cB + hstepB + kstep);
    PG8_WAIT_V(6); PG8_BAR;
    for (;;) {
        const bool has_next = S.next(ui + 1, nxt);
        const unsigned nA = GATHER ? 0u : (has_next ? S.a_off(nxt) : cA), nB = has_next ? S.b_off(nxt) : cB;
        nxt.par = (ui + 1) & 1;
        for (int t = 0; t < nt; t += 2) {
            const bool last = (t == nt - 2);
            const unsigned a1 = cA + (unsigned)((t + 1) % nt0) * kstep;
            const unsigned a2 = last ? nA : cA + (unsigned)((t + 2) % nt0) * kstep, b2 = last ? nB : cB + (unsigned)((t + 2) % nt0) * kstep;
            const unsigned a3 = a2 + kstep, b3 = b2 + kstep;
            PG8_LDB(B0, 0, 0); PG8_LDB(B1, 0, 1); PG8_SCHED; PG8_LDA(At, 0, 0); PG8_STAGE_A(PG8_SA(1, 1), a1, 1);
            PG8_WAIT_V(8); PG8_WAIT_L(0); PG8_BAR;
            if constexpr (Sched::META) { if (t == 0) { S.pre_issue(cur, lds); if (has_next) S.meta_issue(nxt, lds); } }
            PG8_MMA(0, 0, At, B0); PG8_MMA(0, 1, At, B1); PG8_BAR; PG8_SCHED;
            if constexpr (Sched::META) { if (last && has_next) {
                if constexpr (GATHER) {
#pragma unroll
                    for (int h = 0; h < 2; ++h)
#pragma unroll
                        for (int i = 0; i < 2; ++i) aoc[h][i] = S.meta_rowoff(nxt, h * HALF + RA[i], lds) + (unsigned)CA[i] * 2u;
                } } }
            PG8_LDA(At, 0, 1); PG8_STAGE_B(PG8_SB(0, 0), b2); PG8_STAGE_B(PG8_SB(0, 1), b2 + hstepB); PG8_STAGE_A(PG8_SA(0, 0), a2, 0);
            PG8_WAIT_V(8); PG8_WAIT_L(0); PG8_BAR; PG8_MMA(1, 0, At, B0); PG8_MMA(1, 1, At, B1); PG8_BAR; PG8_SCHED;
            PG8_LDB(B0, 1, 0); PG8_LDB(B1, 1, 1); PG8_SCHED; PG8_LDA(At, 1, 0); PG8_STAGE_A(PG8_SA(0, 1), a2, 1);
            PG8_WAIT_V(8); PG8_WAIT_L(0); PG8_BAR; PG8_MMA(0, 0, At, B0); PG8_MMA(0, 1, At, B1); PG8_BAR; PG8_SCHED;
            PG8_LDA(At, 1, 1); PG8_STAGE_B(PG8_SB(1, 0), b3); PG8_STAGE_B(PG8_SB(1, 1), b3 + hstepB); PG8_STAGE_A(PG8_SA(1, 0), a3, 0);
            PG8_WAIT_V(8); PG8_WAIT_L(0); PG8_BAR; PG8_MMA(1, 0, At, B0); PG8_MMA(1, 1, At, B1); PG8_BAR; PG8_SCHED;
        }
        if (wr == 0) PG8_BAR;
        E(acc, cur, wr, wc, fr, fq);
        if (!has_next) break;
#pragma unroll
        for (int a = 0; a < 2; ++a)
#pragma unroll
            for (int b = 0; b < 2; ++b)
#pragma unroll
                for (int m = 0; m < 4; ++m)
#pragma unroll
                    for (int n = 0; n < 2; ++n) acc[a][b][m][n] = (f32x4){0.f, 0.f, 0.f, 0.f};
        cur = nxt; cA = nA; cB = nB; ++ui;
        if (wr == 1) PG8_BAR;
    }
    PG8_WAIT_V(0);
    PG8_BAR;
#undef PG8_SA
#undef PG8_SB
#undef PG8_STAGE_A
#undef PG8_STAGE_B
#undef PG8_LDA
#undef PG8_LDB
#undef PG8_MMA
#undef PG8_CAT
#undef PG8_WAIT_V
#undef PG8_WAIT_L
#undef PG8_BAR
#undef PG8_SCHED
}

struct EpiBf16 {
    bf16_t* O; int ldc;
    __device__ __forceinline__ void operator()(const f32x4 (&acc)[2][2][4][2], const Unit& u, int wr, int wc, int fr, int fq) const {
        asm volatile("" : "+v"(fr), "+v"(fq));
        const int row0 = u.pm * BM + wr * 64 + fr, col0 = u.pn * BM + wc * 32 + 8 * fq;
#pragma unroll
        for (int ai = 0; ai < 2; ++ai)
#pragma unroll
            for (int m = 0; m < 4; ++m) { bf16_t* rowp = O + (size_t)(row0 + ai * HALF + m * 16) * ldc + col0;
#pragma unroll
                for (int bj = 0; bj < 2; ++bj) { const f32x4 v0 = acc[ai][bj][m][0], v1 = acc[ai][bj][m][1];
                    u32x4 w; w.x = cvt_pk_bf16(v0[0], v0[1]); w.y = cvt_pk_bf16(v0[2], v0[3]); w.z = cvt_pk_bf16(v1[0], v1[1]); w.w = cvt_pk_bf16(v1[2], v1[3]);
                    *(u32x4*)(rowp + bj * HALF) = w; } }
    }
};
struct EpiProj {
    static constexpr int NPRE = 0;
    bf16_t* O; float* st;
    __device__ __forceinline__ void operator()(const f32x4 (&acc)[2][2][4][2], const Unit& u, int wr, int wc, int fr, int fq) const {
        asm volatile("" : "+v"(fr), "+v"(fq));
        const int row0 = u.pm * BM + wr * 64 + fr, c8 = wc * 32 + 8 * fq;
        const bool pair = (u.pn >= 2 && u.pn < 6);
        const int cb0 = (u.pn < 2) ? u.pn * BM : (pair ? PB_U + (u.pn - 2) * HALF : (u.pn == 6 ? PB_CKV : (u.pn == 7 ? PB_CQ : PB_CQ + 256)));
#pragma unroll
        for (int ai = 0; ai < 2; ++ai)
#pragma unroll
            for (int m = 0; m < 4; ++m) { const int row = row0 + ai * HALF + m * 16; bf16_t* rowp = O + (size_t)row * NPB + cb0 + c8; float ss[2];
                if (pair) { const f32x4 v0 = acc[ai][0][m][0] * acc[ai][1][m][0], v1 = acc[ai][0][m][1] * acc[ai][1][m][1];
                    u32x4 w; w.x = cvt_pk_bf16(v0[0], v0[1]); w.y = cvt_pk_bf16(v0[2], v0[3]); w.z = cvt_pk_bf16(v1[0], v1[1]); w.w = cvt_pk_bf16(v1[2], v1[3]);
                    *(u32x4*)rowp = w; ss[0] = 0.f; ss[1] = 0.f;
                } else {
#pragma unroll
                    for (int bj = 0; bj < 2; ++bj) { const f32x4 v0 = acc[ai][bj][m][0], v1 = acc[ai][bj][m][1];
                        u32x4 w; w.x = cvt_pk_bf16(v0[0], v0[1]); w.y = cvt_pk_bf16(v0[2], v0[3]); w.z = cvt_pk_bf16(v1[0], v1[1]); w.w = cvt_pk_bf16(v1[2], v1[3]);
                        if (!(u.pn == 8 && bj == 1 && wc >= 2)) *(u32x4*)(rowp + bj * HALF) = w;
                        ss[bj] = (v0[0] * v0[0] + v0[1] * v0[1]) + (v0[2] * v0[2] + v0[3] * v0[3]) + (v1[0] * v1[0] + v1[1] * v1[1]) + (v1[2] * v1[2] + v1[3] * v1[3]); } }
                if (u.pn >= 6) {
                    float s0 = ss[0], s1 = ss[1]; s0 += __shfl_xor(s0, 16); s0 += __shfl_xor(s0, 32); s1 += __shfl_xor(s1, 16); s1 += __shfl_xor(s1, 32);
                    if (fq == 0) { if (u.pn == 6) st[(size_t)wc * NTOK + row] = s0 + s1; else if (u.pn == 7) st[(size_t)(4 + wc) * NTOK + row] = s0 + s1;
                                   else { st[(size_t)(8 + wc) * NTOK + row] = s0; st[(size_t)(12 + wc) * NTOK + row] = s1; } } } }
    }
};
struct EpiQ {
    bf16_t* q; const float* st; const float* qhn; const f32x2* rope; LAS float* tabs;
    __device__ __forceinline__ void operator()(const f32x4 (&acc)[2][2][4][2], const Unit& u, int wr, int wc, int fr, int fq) const {
        asm volatile("" : "+v"(fr), "+v"(fq));
        LAS float* rs_tab = tabs; LAS float* part = tabs + 512;
        const int rt0 = wr * 64 + fr;
        const int c0 = wc * 32 + 8 * fq;
        const int i0 = c0 >> 1;
        f32x4 csa[2][4][2];
        if (wc < 2) {
#pragma unroll
            for (int ai = 0; ai < 2; ++ai)
#pragma unroll
                for (int m = 0; m < 4; ++m) { const size_t row = (size_t)u.pm * BM + rt0 + ai * HALF + m * 16;
                    csa[ai][m][0] = *(const f32x4*)(rope + (row & (SEQ - 1)) * 32 + i0); csa[ai][m][1] = *(const f32x4*)(rope + (row & (SEQ - 1)) * 32 + i0 + 2); }
        }
        f32x4 g0[2], g1[2];
        g0[0] = *(const f32x4*)(qhn + c0) * QSCALE; g0[1] = *(const f32x4*)(qhn + c0 + 4) * QSCALE;
        if (wc < 2) { g1[0] = (f32x4){qhn[128 + i0], qhn[160 + i0], qhn[129 + i0], qhn[161 + i0]} * QSCALE; g1[1] = (f32x4){qhn[130 + i0], qhn[162 + i0], qhn[131 + i0], qhn[163 + i0]} * QSCALE; }
        else { g1[0] = (f32x4){0.f, 0.f, 0.f, 0.f}; g1[1] = g1[0]; }
        { const int t = threadIdx.x; if (t < BM) { const size_t r = (size_t)u.pm * BM + t; float s = 0.f;
#pragma unroll
            for (int k = 4; k < 12; ++k) s += st[(size_t)k * NTOK + r];
            rs_tab[t] = 1.0f / sqrtf(s * (1.f / QL) + EPS); } }
#pragma unroll
        for (int ai = 0; ai < 2; ++ai)
#pragma unroll
            for (int m = 0; m < 4; ++m) { float ss = 0.f;
#pragma unroll
                for (int bj = 0; bj < 2; ++bj)
#pragma unroll
                    for (int n = 0; n < 2; ++n) { const f32x4 v = acc[ai][bj][m][n]; ss += (v[0] * v[0] + v[1] * v[1]) + (v[2] * v[2] + v[3] * v[3]); }
                ss += __shfl_xor(ss, 16); ss += __shfl_xor(ss, 32);
                if (fq == 0) part[(rt0 + ai * HALF + m * 16) * 4 + wc] = ss; }
        asm volatile("s_waitcnt lgkmcnt(0)" ::: "memory"); __builtin_amdgcn_s_barrier(); asm volatile("" ::: "memory");
#pragma unroll
        for (int ai = 0; ai < 2; ++ai)
#pragma unroll
            for (int m = 0; m < 4; ++m) { const int rt = rt0 + ai * HALF + m * 16; const size_t row = (size_t)u.pm * BM + rt;
                const f32x4 pp = *(const LAS f32x4*)(part + rt * 4); const float rs = rs_tab[rt];
                const float r = rs / sqrtf(rs * rs * ((pp[0] + pp[1]) + (pp[2] + pp[3])) * (1.f / QKH) + EPS);
                bf16_t* qp = q + row * (NH * QKH) + u.pn * QKH + c0;
                { const f32x4 v0 = acc[ai][0][m][0] * g0[0] * r, v1 = acc[ai][0][m][1] * g0[1] * r;
                  u32x4 w; w.x = cvt_pk_bf16(v0[0], v0[1]); w.y = cvt_pk_bf16(v0[2], v0[3]); w.z = cvt_pk_bf16(v1[0], v1[1]); w.w = cvt_pk_bf16(v1[2], v1[3]); *(u32x4*)qp = w; }
                if (wc < 2) { const f32x4 cs0 = csa[ai][m][0], cs1 = csa[ai][m][1];
                    const f32x4 a0 = acc[ai][1][m][0] * g1[0] * r, a1 = acc[ai][1][m][1] * g1[1] * r;
                    f32x4 o0, o1;
                    o0[0] = a0[0] * cs0[0] - a0[1] * cs0[1]; o0[1] = a0[0] * cs0[1] + a0[1] * cs0[0]; o0[2] = a0[2] * cs0[2] - a0[3] * cs0[3]; o0[3] = a0[2] * cs0[3] + a0[3] * cs0[2];
                    o1[0] = a1[0] * cs1[0] - a1[1] * cs1[1]; o1[1] = a1[0] * cs1[1] + a1[1] * cs1[0]; o1[2] = a1[2] * cs1[2] - a1[3] * cs1[3]; o1[3] = a1[2] * cs1[3] + a1[3] * cs1[2];
                    u32x4 w; w.x = cvt_pk_bf16(o0[0], o0[1]); w.y = cvt_pk_bf16(o0[2], o0[3]); w.z = cvt_pk_bf16(o1[0], o1[1]); w.w = cvt_pk_bf16(o1[2], o1[3]); *(u32x4*)(qp + HALF) = w; } }
    }
};
struct EpiKV {
    bf16_t* k; bf16_t* v; const float* st; const float* khn; const f32x2* rope; const bf16_t* pb; LAS float* tabs;
    __device__ __forceinline__ void operator()(const f32x4 (&acc)[2][2][4][2], const Unit& u, int wr, int wc, int fr, int fq) const {
        asm volatile("" : "+v"(fr), "+v"(fq));
        LAS float* rs_tab = tabs; LAS float* kpe_tab = tabs + 256; LAS float* part = tabs + 512;
        const int rt0 = wr * 64 + fr;
        const int c0 = wc * 32 + 8 * fq;
        const int i0 = 8 * wc + 2 * fq;
        unsigned xas[2][4], xbs[2][4]; f32x4 css[2][4];
#pragma unroll
        for (int ai = 0; ai < 2; ++ai)
#pragma unroll
            for (int m = 0; m < 4; ++m) { const size_t row = (size_t)u.pm * BM + rt0 + ai * HALF + m * 16;
                xas[ai][m] = *(const unsigned*)(pb + row * NPB + PB_KPE + i0); xbs[ai][m] = *(const unsigned*)(pb + row * NPB + PB_KPE + 32 + i0);
                css[ai][m] = *(const f32x4*)(rope + (row & (SEQ - 1)) * 32 + i0); }
        const f32x4 g0 = *(const f32x4*)(khn + c0), g1 = *(const f32x4*)(khn + c0 + 4);
        const float gx0 = khn[128 + i0], gy0 = khn[160 + i0], gx1 = khn[129 + i0], gy1 = khn[161 + i0];
        { const int t = threadIdx.x; if (t < BM) { const size_t r = (size_t)u.pm * BM + t;
            const float s = (st[r] + st[(size_t)NTOK + r]) + (st[(size_t)2 * NTOK + r] + st[(size_t)3 * NTOK + r]);
            const float p = (st[(size_t)12 * NTOK + r] + st[(size_t)13 * NTOK + r]) + (st[(size_t)14 * NTOK + r] + st[(size_t)15 * NTOK + r]);
            rs_tab[t] = 1.0f / sqrtf(s * (1.f / KVL) + EPS); kpe_tab[t] = p; } }
#pragma unroll
        for (int ai = 0; ai < 2; ++ai)
#pragma unroll
            for (int m = 0; m < 4; ++m) { float ss = 0.f;
#pragma unroll
                for (int n = 0; n < 2; ++n) { const f32x4 x = acc[ai][0][m][n]; ss += (x[0] * x[0] + x[1] * x[1]) + (x[2] * x[2] + x[3] * x[3]); }
                ss += __shfl_xor(ss, 16); ss += __shfl_xor(ss, 32);
                if (fq == 0) part[(rt0 + ai * HALF + m * 16) * 4 + wc] = ss; }
        asm volatile("s_waitcnt lgkmcnt(0)" ::: "memory"); __builtin_amdgcn_s_barrier(); asm volatile("" ::: "memory");
#pragma unroll
        for (int ai = 0; ai < 2; ++ai)
#pragma unroll
            for (int m = 0; m < 4; ++m) { const int rt = rt0 + ai * HALF + m * 16; const size_t row = (size_t)u.pm * BM + rt;
                const f32x4 pp = *(const LAS f32x4*)(part + rt * 4); const float rs = rs_tab[rt];
                const float rh = 1.0f / sqrtf((rs * rs * ((pp[0] + pp[1]) + (pp[2] + pp[3])) + kpe_tab[rt]) * (1.f / QKH) + EPS);
                const float r = rs * rh;
                bf16_t* kp = k + row * (NH * QKH) + u.pn * QKH;
                { const f32x4 v0 = acc[ai][0][m][0] * g0 * r, v1 = acc[ai][0][m][1] * g1 * r;
                  u32x4 w; w.x = cvt_pk_bf16(v0[0], v0[1]); w.y = cvt_pk_bf16(v0[2], v0[3]); w.z = cvt_pk_bf16(v1[0], v1[1]); w.w = cvt_pk_bf16(v1[2], v1[3]); *(u32x4*)(kp + c0) = w; }
                { const f32x4 v0 = acc[ai][1][m][0] * rs, v1 = acc[ai][1][m][1] * rs;
                  u32x4 w; w.x = cvt_pk_bf16(v0[0], v0[1]); w.y = cvt_pk_bf16(v0[2], v0[3]); w.z = cvt_pk_bf16(v1[0], v1[1]); w.w = cvt_pk_bf16(v1[2], v1[3]); *(u32x4*)(v + row * (NH * VH) + u.pn * VH + c0) = w; }
                { const unsigned xa = xas[ai][m], xb = xbs[ai][m];
                  const f32x4 cs = css[ai][m];
                  const float x10 = bf_lo(xa) * gx0 * rh, x11 = bf_hi(xa) * gx1 * rh, x20 = bf_lo(xb) * gy0 * rh, x21 = bf_hi(xb) * gy1 * rh;
                  u32x2 w; w.x = cvt_pk_bf16(x10 * cs[0] - x20 * cs[1], x10 * cs[1] + x20 * cs[0]); w.y = cvt_pk_bf16(x11 * cs[2] - x21 * cs[3], x11 * cs[3] + x21 * cs[2]);
                  *(u32x2*)(kp + 128 + 2 * i0) = w; } }
    }
};
struct EpiOut {
    const float* x; bf16_t* h1b; float* ssq;
    __device__ __forceinline__ void operator()(const f32x4 (&acc)[2][2][4][2], const Unit& u, int wr, int wc, int fr, int fq) const {
        asm volatile("" : "+v"(fr), "+v"(fq));
        const int row0 = u.pm * BM + wr * 64 + fr, col0 = u.pn * BM + wc * 32 + 8 * fq;
#pragma unroll
        for (int ai = 0; ai < 2; ++ai) {
            f32x4 xv[4][2][2];
#pragma unroll
            for (int m = 0; m < 4; ++m) { const size_t off = (size_t)(row0 + ai * HALF + m * 16) * DM + col0;
#pragma unroll
                for (int bj = 0; bj < 2; ++bj) { xv[m][bj][0] = __builtin_nontemporal_load((const f32x4*)(x + off + bj * HALF)); xv[m][bj][1] = __builtin_nontemporal_load((const f32x4*)(x + off + bj * HALF + 4)); } }
            asm volatile("" ::: "memory");
#pragma unroll
            for (int m = 0; m < 4; ++m) { const int row = row0 + ai * HALF + m * 16; const size_t off = (size_t)row * DM + col0; float ss = 0.f;
#pragma unroll
                for (int bj = 0; bj < 2; ++bj) { const f32x4 v0 = acc[ai][bj][m][0] + xv[m][bj][0], v1 = acc[ai][bj][m][1] + xv[m][bj][1];
                    u32x4 w; w.x = cvt_pk_bf16(v0[0], v0[1]); w.y = cvt_pk_bf16(v0[2], v0[3]); w.z = cvt_pk_bf16(v1[0], v1[1]); w.w = cvt_pk_bf16(v1[2], v1[3]);
                    *(u32x4*)(h1b + off + bj * HALF) = w;
                    ss += (v0[0] * v0[0] + v0[1] * v0[1]) + (v0[2] * v0[2] + v0[3] * v0[3]) + (v1[0] * v1[0] + v1[1] * v1[1]) + (v1[2] * v1[2] + v1[3] * v1[3]); }
                ss += __shfl_xor(ss, 16); ss += __shfl_xor(ss, 32);
                if (fq == 0) ssq[(size_t)(u.pn * 4 + wc) * NTOK + row] = ss; }
        }
    }
};
struct EpiSwiglu {
    unsigned char* act; const float* bgu; LAS unsigned char* blds;
    __device__ __forceinline__ void operator()(const f32x4 (&acc)[2][2][4][2], const Unit& u, int wr, int wc, int fr, int fq) const {
        asm volatile("" : "+v"(fr), "+v"(fq));
        const int rt0 = wr * 64 + fr, j0 = wc * 32 + 8 * fq;
        const LAS float* bl = (const LAS float*)(blds + MoeSched::BIAS_OFF + u.par * 1024) + j0;
        const f32x4 bg0 = *(const LAS f32x4*)bl, bg1 = *(const LAS f32x4*)(bl + 4), bu0 = *(const LAS f32x4*)(bl + HALF), bu1 = *(const LAS f32x4*)(bl + HALF + 4);
        constexpr float WI = 1.f / W8_SCALE;
#pragma unroll
        for (int ai = 0; ai < 2; ++ai)
#pragma unroll
            for (int m = 0; m < 4; ++m) { const int rt = rt0 + ai * HALF + m * 16;
                float o[8];
#pragma unroll
                for (int n = 0; n < 2; ++n) { const f32x4 g4 = acc[ai][0][m][n] * WI + (n ? bg1 : bg0), u4 = acc[ai][1][m][n] * WI + (n ? bu1 : bu0);
#pragma unroll
                    for (int i = 0; i < 4; i += 2) {
                        f32x2 g, uu; g.x = fminf(g4[i], SWI_LIMIT); g.y = fminf(g4[i + 1], SWI_LIMIT);
                        uu.x = __builtin_amdgcn_fmed3f(u4[i], -SWI_LIMIT, SWI_LIMIT); uu.y = __builtin_amdgcn_fmed3f(u4[i + 1], -SWI_LIMIT, SWI_LIMIT);
                        const f32x2 t = g * (-SWI_ALPHA * 1.4426950408889634f);
                        f32x2 e; e.x = __builtin_amdgcn_exp2f(t.x); e.y = __builtin_amdgcn_exp2f(t.y);
                        const f32x2 d = e + 1.f;
                        f32x2 sg; sg.x = __builtin_amdgcn_rcpf(d.x); sg.y = __builtin_amdgcn_rcpf(d.y);
                        const f32x2 r = (uu * ACT8_SCALE + ACT8_SCALE) * (g * sg);
                        o[n * 4 + i] = r.x; o[n * 4 + i + 1] = r.y; } }
                u32x2 w; w.x = pk4_fp8_nc(o[0], o[1], o[2], o[3]); w.y = pk4_fp8_nc(o[4], o[5], o[6], o[7]);
                *(u32x2*)(act + ((size_t)u.pm * BM + rt) * DFF + u.pn * HALF + j0) = w; }
    }
};
struct EpiDown {
    unsigned char* oslot; const float* bdn; unsigned char* dummy; LAS unsigned char* lds;
    __device__ __forceinline__ void operator()(const f32x4 (&acc)[2][2][4][2], const Unit& u, int wr, int wc, int fr, int fq) const {
        asm volatile("" : "+v"(fr), "+v"(fq));
        const int rt0 = wr * 64 + fr, col0 = u.pn * BM + wc * 32 + 8 * fq;
        const LAS float* bl = (const LAS float*)(lds + MoeSched::BIAS_OFF + u.par * 1024) + wc * 32 + 8 * fq;
        f32x4 bv[2][2]; bv[0][0] = *(const LAS f32x4*)bl; bv[0][1] = *(const LAS f32x4*)(bl + 4); bv[1][0] = *(const LAS f32x4*)(bl + HALF); bv[1][1] = *(const LAS f32x4*)(bl + HALF + 4);
        constexpr float WI = 1.f / (W8_SCALE * ACT8_SCALE);
#pragma unroll
        for (int ai = 0; ai < 2; ++ai)
#pragma unroll
            for (int m = 0; m < 4; ++m) { const int rt = rt0 + ai * HALF + m * 16, p = u.p0 + rt;
                const u32x2 mt = *(const LAS u32x2*)(lds + MoeSched::META_OFF + u.par * 2048 + rt * 8);
                const bool valid = p < u.cnt; const int slot = valid ? (int)mt.x : 0; const unsigned gbits = mt.y; const float g = __builtin_bit_cast(float, gbits);
                unsigned char* rowp = valid ? oslot + (size_t)slot * DM + col0 : dummy + col0;
                const float gs = g * OS8_SCALE;
#pragma unroll
                for (int bj = 0; bj < 2; ++bj) { const f32x4 v0 = (acc[ai][bj][m][0] * WI + bv[bj][0]) * gs, v1 = (acc[ai][bj][m][1] * WI + bv[bj][1]) * gs;
                    u32x2 w; w.x = pk4_fp8(v0[0], v0[1], v0[2], v0[3]); w.y = pk4_fp8(v1[0], v1[1], v1[2], v1[3]);
                    *(u32x2*)(rowp + bj * HALF) = w; } }
    }
};
struct EpiNull {
    float* dummy;
    __device__ __forceinline__ void operator()(const f32x4 (&acc)[2][2][4][2], const Unit& u, int wr, int wc, int fr, int fq) const {
        float sacc = 0.f;
#pragma unroll
        for (int ai = 0; ai < 2; ++ai)
#pragma unroll
            for (int bj = 0; bj < 2; ++bj)
#pragma unroll
                for (int m = 0; m < 4; ++m)
#pragma unroll
                    for (int n = 0; n < 2; ++n) sacc += (acc[ai][bj][m][n][0] + acc[ai][bj][m][n][1]) + (acc[ai][bj][m][n][2] + acc[ai][bj][m][n][3]);
        dummy[(size_t)blockIdx.x * 512 + threadIdx.x] = sacc;
    }
};
}

namespace att {
constexpr int LDQ = NH * QKH, LDK = NH * QKH, LDV = NH * VH, LDO = DM;
constexpr int KT_BYTES = 64 * QKH * 2, VT_BYTES = 64 * VH * 2;
constexpr int L_K = 0, L_V = 3 * KT_BYTES, L_WS = L_V + 3 * VT_BYTES, L_END = L_WS + 8 * 256;
constexpr float THRL = 8.f * 1.4426950408889634f;
__device__ __forceinline__ int crow(int r, int hi) { return (r & 3) + 8 * (r >> 2) + 4 * hi; }
#define SBAR() __builtin_amdgcn_sched_barrier(0)
__device__ __forceinline__ int v_rd_base(int lane) { return ((lane & 3) << 3) | (((lane >> 2) & 3) << 6) | (((lane >> 4) & 1) << 5) | (((lane >> 5) & 1) << 8); }
constexpr int v_rd_off(int d0, int ks, int half) { return d0 * 512 + ks * 4096 + half * 2048; }
template <int OFF> __device__ __forceinline__ s16x4 tr_read(int vb) {
    s16x4 r; asm volatile("ds_read_b64_tr_b16 %0, %1 offset:%2" : "=&v"(r) : "v"(vb), "i"(OFF) : "memory"); return r;
}
template <int D0> __device__ __forceinline__ void pv_one(f32x16& od, int vb, bf16x8 pa0, bf16x8 pa1, bf16x8 pa2, bf16x8 pa3) {
    const s16x4 l0 = tr_read<v_rd_off(D0, 0, 0)>(vb), h0 = tr_read<v_rd_off(D0, 0, 1)>(vb), l1 = tr_read<v_rd_off(D0, 1, 0)>(vb), h1 = tr_read<v_rd_off(D0, 1, 1)>(vb);
    const s16x4 l2 = tr_read<v_rd_off(D0, 2, 0)>(vb), h2 = tr_read<v_rd_off(D0, 2, 1)>(vb), l3 = tr_read<v_rd_off(D0, 3, 0)>(vb), h3 = tr_read<v_rd_off(D0, 3, 1)>(vb);
    asm volatile("s_waitcnt lgkmcnt(0)" ::: "memory"); SBAR();
#define PK(L, H) (bf16x8){L[0], L[1], L[2], L[3], H[0], H[1], H[2], H[3]}
    od = __builtin_amdgcn_mfma_f32_32x32x16_bf16(pa0, PK(l0, h0), od, 0, 0, 0);
    od = __builtin_amdgcn_mfma_f32_32x32x16_bf16(pa1, PK(l1, h1), od, 0, 0, 0);
    od = __builtin_amdgcn_mfma_f32_32x32x16_bf16(pa2, PK(l2, h2), od, 0, 0, 0);
    od = __builtin_amdgcn_mfma_f32_32x32x16_bf16(pa3, PK(l3, h3), od, 0, 0, 0);
#undef PK
}
__device__ __forceinline__ void glds16(const void* gsrc, LAS unsigned char* dst) {
    __builtin_amdgcn_global_load_lds((const unsigned*)gsrc, (LAS unsigned*)dst, 16, 0, 0);
}
__device__ __forceinline__ void attn_unit(int b, int h, int qb, const bf16_t* Q, const bf16_t* Kg, const bf16_t* Vg, bf16_t* O, LAS unsigned char* lds) {
    const int tid = threadIdx.x, wid = __builtin_amdgcn_readfirstlane(tid >> 6), lane = tid & 63, r32 = lane & 31, hi = lane >> 5;
    const int grp = wid >> 2;
    const size_t tok0 = (size_t)b * SEQ;
    bf16x8 qr[12];
    { const bf16_t* Qw = Q + (tok0 + (size_t)qb * 256 + wid * 32 + r32) * LDQ + h * QKH + hi * 8;
#pragma unroll
      for (int d0 = 0; d0 < 12; ++d0) qr[d0] = *(const bf16x8*)(Qw + d0 * 16); }
    unsigned koff[3], voff[2];
#pragma unroll
    for (int i = 0; i < 3; ++i) { const int G = 64 * (wid + 8 * i) + lane, row = G / 24, cgs = G % 24, cg = (cgs & ~7) | ((cgs & 7) ^ ((row >> 1) & 7)); koff[i] = (unsigned)(row * LDK * 2 + cg * 16); }
#pragma unroll
    for (int i = 0; i < 2; ++i) { const int p = wid + 8 * i, sub = 2 * p + (lane >> 5), kkh = sub >> 2, cblk = sub & 3, kkl = (lane & 31) >> 2, cl = (lane & 3) * 8, kk = kkh * 8 + kkl;
        const int k = (kk & ~0xC) | ((kk & 4) << 1) | ((kk & 8) >> 1), c = cblk * 32 + cl; voff[i] = (unsigned)(k * LDV * 2 + c * 2); }
    const __amdgpu_buffer_rsrc_t rK = __builtin_amdgcn_make_buffer_rsrc((void*)(Kg + tok0 * LDK + h * QKH), 0, -1, 0x00020000), rV = __builtin_amdgcn_make_buffer_rsrc((void*)(Vg + tok0 * LDV + h * VH), 0, -1, 0x00020000);
#define ATT_DMA(j, buf) do { \
        _Pragma("unroll") for (int i_ = 0; i_ < 3; ++i_) __builtin_amdgcn_raw_ptr_buffer_load_lds(rK, (LAS void*)(lds + L_K + (buf) * KT_BYTES + (wid + 8 * i_) * 1024), 16, koff[i_], (unsigned)(j) * (64u * LDK * 2u), 0, 0); \
        _Pragma("unroll") for (int i_ = 0; i_ < 2; ++i_) __builtin_amdgcn_raw_ptr_buffer_load_lds(rV, (LAS void*)(lds + L_V + (buf) * VT_BYTES + (wid + 8 * i_) * 1024), 16, voff[i_], (unsigned)(j) * (64u * LDV * 2u), 0, 0); } while (0)
#define ATT_BAR() do { asm volatile("" ::: "memory"); __builtin_amdgcn_s_barrier(); asm volatile("" ::: "memory"); } while (0)
    const int swz = (r32 >> 1) & 7; int kx[4];
#pragma unroll
    for (int dd = 0; dd < 4; ++dd) kx[dd] = r32 * (QKH * 2) + (((2 * dd + hi) ^ swz) << 4);
    LAS float* ws = (LAS float*)(lds + L_WS) + wid * 64; LAS float* li_l = ws; LAS float* al_l = ws + 32;
    const int vb0 = L_V + v_rd_base(lane);
    float m_reg = -1e30f, l_reg = 0.f; f32x16 o[4];
#pragma unroll
    for (int d = 0; d < 4; ++d)
#pragma unroll
        for (int r = 0; r < 16; ++r) o[d][r] = 0.f;
    const int NT = 4 * qb + 4, my_last = 4 * qb + (wid >> 1);
    ATT_DMA(0, 0); ATT_DMA(1, 1);
    asm volatile("s_waitcnt vmcnt(5)" ::: "memory"); ATT_BAR();
    if (grp == 1) ATT_BAR();
    int kb = 0, nb = 2;
    for (int j = 0; j < NT; ++j) {
        const bool live = (j <= my_last), more = (j + 2 < NT);
        f32x16 p0, p1;
        if (grp == 1 && more) ATT_DMA(j + 2, nb);
        if (live) {
            const LAS unsigned char* Ks = lds + L_K + kb * KT_BYTES;
#pragma unroll
            for (int r = 0; r < 16; ++r) { p0[r] = 0.f; p1[r] = 0.f; }
#pragma unroll
            for (int d0 = 0; d0 < 12; ++d0) {
                const bf16x8 b0 = *(const LAS bf16x8*)(Ks + kx[d0 & 3] + (d0 >> 2) * 128);
                const bf16x8 b1 = *(const LAS bf16x8*)(Ks + kx[d0 & 3] + (d0 >> 2) * 128 + 32 * QKH * 2);
                p0 = __builtin_amdgcn_mfma_f32_32x32x16_bf16(b0, qr[d0], p0, 0, 0, 0);
                p1 = __builtin_amdgcn_mfma_f32_32x32x16_bf16(b1, qr[d0], p1, 0, 0, 0);
            }
        }
        if (grp == 1) { if (j + 1 < NT) { if (more) asm volatile("s_waitcnt vmcnt(5)" ::: "memory"); else asm volatile("s_waitcnt vmcnt(0)" ::: "memory"); } }
        ATT_BAR();
        if (grp == 0 && more) ATT_DMA(j + 2, nb);
        if (live) {
            float pmax = p0[0];
#pragma unroll
            for (int r = 1; r < 16; ++r) pmax = fmaxf(pmax, p0[r]);
#pragma unroll
            for (int r = 0; r < 16; ++r) pmax = fmaxf(pmax, p1[r]);
            { auto rr = __builtin_amdgcn_permlane32_swap(__float_as_uint(pmax), __float_as_uint(pmax), false, false);
              pmax = fmaxf(__uint_as_float(rr[0]), __uint_as_float(rr[1])); }
            float mn, alpha;
            if (__builtin_expect(__all(pmax - m_reg <= THRL), 1)) { mn = m_reg; alpha = 1.f; }
            else { mn = fmaxf(m_reg, pmax); alpha = __builtin_amdgcn_exp2f(m_reg - mn); m_reg = mn; }
#pragma unroll
            for (int r = 0; r < 16; ++r) { p0[r] = __builtin_amdgcn_exp2f(p0[r] - mn); p1[r] = __builtin_amdgcn_exp2f(p1[r] - mn); }
            float ps = 0.f;
#pragma unroll
            for (int r = 0; r < 16; ++r) ps += p0[r];
#pragma unroll
            for (int r = 0; r < 16; ++r) ps += p1[r];
            { auto rr = __builtin_amdgcn_permlane32_swap(__float_as_uint(ps), __float_as_uint(ps), false, false);
              ps = __uint_as_float(rr[0]) + __uint_as_float(rr[1]); }
            l_reg = l_reg * alpha + ps;
            if (__any(alpha < 1.f)) { if (hi == 0) al_l[r32] = alpha; asm volatile("s_waitcnt lgkmcnt(0)" ::: "memory");
#pragma unroll
                for (int r = 0; r < 16; ++r) { const float a = al_l[crow(r, hi)];
#pragma unroll
                    for (int d = 0; d < 4; ++d) o[d][r] *= a; } }
            bf16x8 pa0, pa1, pa2, pa3;
#define PK4(P, BASE, OUT) do { unsigned a0 = cvt_pk_bf16(P[BASE + 0], P[BASE + 1]), a1 = cvt_pk_bf16(P[BASE + 2], P[BASE + 3]);   \
    unsigned b0_ = cvt_pk_bf16(P[BASE + 4], P[BASE + 5]), b1_ = cvt_pk_bf16(P[BASE + 6], P[BASE + 7]);                              \
    auto r0 = __builtin_amdgcn_permlane32_swap(a0, b0_, false, false); auto r1 = __builtin_amdgcn_permlane32_swap(a1, b1_, false, false); \
    u32x4 w = {r0[0], r1[0], r0[1], r1[1]}; OUT = __builtin_bit_cast(bf16x8, w); } while (0)
            PK4(p0, 0, pa0); PK4(p0, 8, pa1); PK4(p1, 0, pa2); PK4(p1, 8, pa3);
#undef PK4
            const int vb = vb0 + kb * VT_BYTES;
            pv_one<0>(o[0], vb, pa0, pa1, pa2, pa3); pv_one<1>(o[1], vb, pa0, pa1, pa2, pa3); pv_one<2>(o[2], vb, pa0, pa1, pa2, pa3); pv_one<3>(o[3], vb, pa0, pa1, pa2, pa3);
        }
        if (grp == 0) { if (j + 1 < NT) { if (more) asm volatile("s_waitcnt vmcnt(5)" ::: "memory"); else asm volatile("s_waitcnt vmcnt(0)" ::: "memory"); } }
        ATT_BAR();
        kb = (kb == 2) ? 0 : kb + 1; nb = (nb == 2) ? 0 : nb + 1;
    }
    if (grp == 0) ATT_BAR();
    if (hi == 0) li_l[r32] = l_reg; asm volatile("s_waitcnt lgkmcnt(0)" ::: "memory");
    bf16_t* Ow = O + (tok0 + (size_t)qb * 256 + wid * 32) * LDO + h * VH;
#pragma unroll
    for (int r = 0; r < 16; ++r) { const int orow = crow(r, hi); const float rl = __builtin_amdgcn_rcpf(li_l[orow]);
#pragma unroll
        for (int d0 = 0; d0 < 4; ++d0) Ow[(size_t)orow * LDO + d0 * 32 + r32] = (bf16_t)f2bf(o[d0][r] * rl); }
    asm volatile("s_waitcnt lgkmcnt(0)" ::: "memory"); ATT_BAR();
#undef ATT_DMA
#undef ATT_BAR
}
#undef SBAR
}

#define XB_TMO      128
#define XB_XCNT(j)  (256  + 64 * (j))
#define XB_XSUB(j)  (1280 + 64 * (j))
#define XB_XGEN(j)  (2304 + 64 * (j))
#define XB_TOP      3328
#define XB_TOPGEN   3392
#define XCD_BAR_WORDS 3456
#define XB_SPIN_CAP (1u << 18)
__device__ __forceinline__ unsigned xb_ld(unsigned* p)              { return __hip_atomic_load(p, __ATOMIC_RELAXED, __HIP_MEMORY_SCOPE_AGENT); }
__device__ __forceinline__ unsigned xb_add(unsigned* p, unsigned v) { return __hip_atomic_fetch_add(p, v, __ATOMIC_RELAXED, __HIP_MEMORY_SCOPE_AGENT); }
__device__ __forceinline__ unsigned xb_xcc_id() { return (unsigned)__builtin_amdgcn_s_getreg((3 << 11) | 20) & 0xFu; }
#define XB_SPIN(cond, bar) do { unsigned _sp = 0; while (cond) { __builtin_amdgcn_s_sleep(1); \
    if ((++_sp & 255u) == 0u) { if (xb_ld(&(bar)[XB_TMO])) break; if (_sp > XB_SPIN_CAP) { atomicAdd(&(bar)[XB_TMO], 1u); break; } } } } while (0)
struct XcdBarrier { unsigned* bar; unsigned x; volatile LAS unsigned* st; };
__device__ __forceinline__ XcdBarrier xcd_barrier_post(unsigned* bar, volatile LAS unsigned* st) {
    XcdBarrier b; b.bar = bar; b.x = xb_xcc_id(); b.st = st;
    if (threadIdx.x == 0) (void)xb_add(&bar[XB_XCNT(b.x)], 1u);
    return b;
}
__device__ __forceinline__ void xcd_barrier_complete(unsigned* bar, unsigned x, unsigned& nloc, unsigned& nx) {
    const unsigned G = gridDim.x * gridDim.y * gridDim.z;
    unsigned sum, cnt, mine, sp = 0u;
    for (;;) {
        sum = 0u; cnt = 0u; mine = 0u;
#pragma unroll
        for (unsigned j = 0; j < 16; ++j) { const unsigned c = xb_ld(&bar[XB_XCNT(j)]); sum += c; cnt += (c > 0u) ? 1u : 0u; mine = (j == x) ? c : mine; }
        if (sum == G) break;
        __builtin_amdgcn_s_sleep(1);
        if ((++sp & 255u) == 0u) { if (xb_ld(&bar[XB_TMO])) break; if (sp > XB_SPIN_CAP) { atomicAdd(&bar[XB_TMO], 1u); break; } }
    }
    nloc = mine > 0u ? mine : 1u; nx = cnt > 0u ? cnt : 1u;
}
__device__ __forceinline__ void xcd_barrier(const XcdBarrier& b) {
    asm volatile("s_waitcnt vmcnt(0)" ::: "memory");
    __syncthreads();
    if (threadIdx.x == 0) {
        unsigned* bar = b.bar;
        __builtin_amdgcn_s_waitcnt(0);
        unsigned nloc = b.st[0], nx = b.st[1];
        if (nloc == 0u) { xcd_barrier_complete(bar, b.x, nloc, nx); b.st[0] = nloc; b.st[1] = nx; }
        const unsigned old = xb_add(&bar[XB_XSUB(b.x)], 1u);
        const unsigned gen = old / nloc;
        if (old + 1u == (gen + 1u) * nloc) {
            __builtin_amdgcn_fence(__ATOMIC_RELEASE, "agent");
            asm volatile("s_waitcnt vmcnt(0)" ::: "memory");
            const unsigned og = xb_add(&bar[XB_TOP], 1u);
            const unsigned tg = og / nx;
            if (og + 1u == (tg + 1u) * nx) xb_add(&bar[XB_TOPGEN], 1u);
            else XB_SPIN(xb_ld(&bar[XB_TOPGEN]) == tg, bar);
            __builtin_amdgcn_fence(__ATOMIC_ACQUIRE, "agent");
            xb_add(&bar[XB_XGEN(b.x)], 1u);
            asm volatile("s_waitcnt vmcnt(0)" ::: "memory");
        } else {
            XB_SPIN(xb_ld(&bar[XB_XGEN(b.x)]) == gen, bar);
            __builtin_amdgcn_fence(__ATOMIC_ACQUIRE, "agent");
            asm volatile("s_waitcnt vmcnt(0)" ::: "memory");
        }
    }
    __syncthreads();
}

constexpr int NWAVES = 8;
constexpr int N_LAUNCHES = MK_N_LAUNCHES;
constexpr int N_PHASES = 10;
struct Args { const float* in[18]; float* out; unsigned char* ws; int ph_lo, ph_hi; };

__device__ __forceinline__ void p0_transpose_item(const float* W, int K, int N, bf16_t* WT, int drow0, const float* kscale, LAS unsigned* scr, int k0, int n0, int lane, bool ileave = false) {
    const int g = lane >> 4, l16 = lane & 15;
    f32x4 v[16];
#pragma unroll
    for (int i = 0; i < 16; ++i) { const int kk = (i >> 1) * 8 + g * 2 + (i & 1); v[i] = __builtin_nontemporal_load((const f32x4*)(W + (size_t)(k0 + kk) * N + n0 + 4 * l16)); }
    if (kscale) {
#pragma unroll
        for (int i = 0; i < 16; ++i) { const int kk = (i >> 1) * 8 + g * 2 + (i & 1); v[i] = v[i] * kscale[k0 + kk]; } }
#pragma unroll
    for (int j = 0; j < 8; ++j) { const int kp = j * 4 + g;
#pragma unroll
        for (int c = 0; c < 4; ++c) scr[(4 * l16 + c) * 33 + kp] = cvt_pk_bf16(v[2 * j][c], v[2 * j + 1][c]); }
    LDS_WAIT(); asm volatile("" ::: "memory");
    const int c8 = lane & 7;
#pragma unroll
    for (int jj = 0; jj < 8; ++jj) { const int n = jj * 8 + (lane >> 3); const LAS unsigned* t = scr + n * 33 + 4 * c8;
        u32x4 o; o.x = t[0]; o.y = t[1]; o.z = t[2]; o.w = t[3];
        const int dn = ileave ? ((n < 32) ? 2 * n : 2 * (n - 32) + 1) : n;
        *(u32x4*)(WT + (size_t)(drow0 + dn) * K + k0 + 8 * c8) = o; }
    LDS_WAIT(); asm volatile("" ::: "memory");
}

__device__ __forceinline__ void p0_transpose_item8(const float* W, int K, int N, unsigned char* WT, int drow0, const float* kscale, LAS unsigned* scr, int k0, int n0, int lane) {
    const int g = lane >> 4, l16 = lane & 15;
    f32x4 v[32];
#pragma unroll
    for (int i = 0; i < 32; ++i) { const int kk = (i >> 2) * 16 + g * 4 + (i & 3); v[i] = __builtin_nontemporal_load((const f32x4*)(W + (size_t)(k0 + kk) * N + n0 + 4 * l16)); }
#pragma unroll
    for (int i = 0; i < 32; ++i) { const int kk = (i >> 2) * 16 + g * 4 + (i & 3); v[i] = v[i] * (kscale ? kscale[k0 + kk] * W8_SCALE : W8_SCALE); }
#pragma unroll
    for (int j = 0; j < 8; ++j) { const int kd = j * 4 + g;
#pragma unroll
        for (int c = 0; c < 4; ++c) scr[(4 * l16 + c) * 33 + kd] = pk4_fp8(v[4 * j][c], v[4 * j + 1][c], v[4 * j + 2][c], v[4 * j + 3][c]); }
    LDS_WAIT(); asm volatile("" ::: "memory");
    const int c8 = lane & 7;
#pragma unroll
    for (int jj = 0; jj < 8; ++jj) { const int n = jj * 8 + (lane >> 3); const LAS unsigned* t = scr + n * 33 + 4 * c8;
        u32x4 o; o.x = t[0]; o.y = t[1]; o.z = t[2]; o.w = t[3];
        *(u32x4*)(WT + (size_t)(drow0 + n) * K + k0 + 16 * c8) = o; }
    LDS_WAIT(); asm volatile("" ::: "memory");
}

constexpr int MOE_GU1 = (DM / 128) * (2 * DFF / 64), MOE_GU = NE * MOE_GU1, MOE_DN1 = (DFF / 128) * (DM / 64), MOE_DN = NE * MOE_DN1, MOE_ITEMS = MOE_GU + MOE_DN;
struct MoeItem { const float* W; unsigned char* WT; int N, k0, n0, drow0, has_ks; };
__device__ __forceinline__ MoeItem moe_item_of(int r, const float* w_gate_up, const float* w_down, unsigned char* Wgu_t, unsigned char* Wdn_t) {
    MoeItem m;
    if (r < MOE_GU) { const int e = r / MOE_GU1, q = r % MOE_GU1, nblk = 2 * DFF / 64, kb = q / nblk, nb = q % nblk, n0 = nb * 64, j = n0 & (DFF - 1), up = n0 >= DFF;
        m.W = w_gate_up + (size_t)e * DM * 2 * DFF; m.WT = Wgu_t + (size_t)e * 2 * DFF * DM; m.N = 2 * DFF; m.k0 = kb * 128; m.n0 = n0; m.drow0 = (j >> 7) * 256 + (j & 127) + (up ? 128 : 0); m.has_ks = 1; }
    else { r -= MOE_GU; const int e = r / MOE_DN1, q = r % MOE_DN1, nblk = DM / 64, kb = q / nblk, nb = q % nblk;
        m.W = w_down + (size_t)e * DFF * DM; m.WT = Wdn_t + (size_t)e * DM * DFF; m.N = DM; m.k0 = kb * 128; m.n0 = nb * 64; m.drow0 = nb * 64; m.has_ks = 0; }
    return m;
}
__device__ __forceinline__ void moe_load_half(const MoeItem& m, int h, const float* ks, int lane, f32x4 (&v)[16], f32x4 (&sc)[4]) {
    const int g = lane >> 4, l16 = lane & 15;
#pragma unroll
    for (int j = 0; j < 4; ++j) sc[j] = *(const f32x4*)(ks + m.k0 + 64 * h + 16 * j + 4 * g);
#pragma unroll
    for (int i = 0; i < 16; ++i) { const int kk = 64 * h + (i >> 2) * 16 + g * 4 + (i & 3); v[i] = __builtin_nontemporal_load((const f32x4*)(m.W + (size_t)(m.k0 + kk) * m.N + m.n0 + 4 * l16)); }
}
__device__ __forceinline__ void moe_pack_half(const MoeItem& m, int h, int lane, const f32x4 (&v)[16], const f32x4 (&sc)[4], LAS unsigned* scr) {
    const int g = lane >> 4, l16 = lane & 15;
#pragma unroll
    for (int j = 0; j < 4; ++j) { const int kd = (4 * h + j) * 4 + g;
        const f32x4 s = m.has_ks ? sc[j] * W8_SCALE : (f32x4){W8_SCALE, W8_SCALE, W8_SCALE, W8_SCALE};
#pragma unroll
        for (int c = 0; c < 4; ++c) scr[(4 * l16 + c) * 33 + kd] = pk4_fp8(v[4 * j][c] * s[0], v[4 * j + 1][c] * s[1], v[4 * j + 2][c] * s[2], v[4 * j + 3][c] * s[3]); }
}
__device__ __forceinline__ void moe_store(const MoeItem& m, int lane, LAS unsigned* scr) {
    LDS_WAIT(); asm volatile("" ::: "memory");
    const int c8 = lane & 7;
#pragma unroll
    for (int jj = 0; jj < 8; ++jj) { const int n = jj * 8 + (lane >> 3); const LAS unsigned* t = scr + n * 33 + 4 * c8;
        u32x4 o; o.x = t[0]; o.y = t[1]; o.z = t[2]; o.w = t[3];
        *(u32x4*)(m.WT + (size_t)(m.drow0 + n) * 1024 + m.k0 + 16 * c8) = o; }
    LDS_WAIT(); asm volatile("" ::: "memory");
}
__device__ __forceinline__ void moe_stream(int first, int stride, const float* w_gate_up, const float* w_down, unsigned char* Wgu_t, unsigned char* Wdn_t, const float* ks, LAS unsigned* scr, int lane) {
    if (first >= MOE_ITEMS) return;
    f32x4 va[16], vb[16], sa[4], sb[4];
    int it = first;
    MoeItem cur = moe_item_of(it, w_gate_up, w_down, Wgu_t, Wdn_t);
    moe_load_half(cur, 0, ks, lane, va, sa); moe_load_half(cur, 1, ks, lane, vb, sb);
    for (;;) {
        const int nx = it + stride; const bool more = nx < MOE_ITEMS;
        const MoeItem nxt = moe_item_of(more ? nx : it, w_gate_up, w_down, Wgu_t, Wdn_t);
        moe_pack_half(cur, 0, lane, va, sa, scr);
        moe_load_half(nxt, 0, ks, lane, va, sa);
        moe_pack_half(cur, 1, lane, vb, sb, scr);
        moe_load_half(nxt, 1, ks, lane, vb, sb);
        moe_store(cur, lane, scr);
        if (!more) break;
        cur = nxt; it = nx;
    }
}

template <int PHMASK> __global__ void __launch_bounds__(NWAVES * 64, 2) fwd_kernel_t(Args args) {
    extern __shared__ __attribute__((aligned(16))) unsigned char lds_raw[];
    LAS unsigned char* lds = (LAS unsigned char*)lds_raw;
    volatile LAS unsigned* MISC = (volatile LAS unsigned*)(lds + MISC_OFF);
    const int tid = threadIdx.x, lane = tid & 63, wave = __builtin_amdgcn_readfirstlane(tid >> 6);
    const int G = gridDim.x; const int bx = blockIdx.x; const int vcu = (G % 8 == 0) ? (bx % 8) * (G / 8) + bx / 8 : bx;
    unsigned char* ws = args.ws;
    unsigned* ctl = (unsigned*)(ws + WS_CTL);
    const float* x = args.in[0]; const float* norm_mix = args.in[1]; const float* w_in = args.in[2]; const float* conv_w = args.in[3];
    const float* q_norm = args.in[4]; const float* w_uq = args.in[5]; const float* kv_norm = args.in[6]; const float* w_ukv = args.in[7];
    const float* q_head_norm = args.in[8]; const float* k_head_norm = args.in[9]; const float* w_o = args.in[10]; const float* norm_ffn = args.in[11];
    const float* w_router = args.in[12]; const float* b_router = args.in[13]; const float* w_gate_up = args.in[14]; const float* b_gate_up = args.in[15];
    const float* w_down = args.in[16]; const float* b_down = args.in[17];
    float* out = args.out;
    f32x2* rope_t = (f32x2*)(ws + WS_ROPE);
    bf16_t* WrH = (bf16_t*)(ws + WS_WRH); bf16_t* WrL = (bf16_t*)(ws + WS_WRL);
    bf16_t* Win_t = (bf16_t*)(ws + WS_WIN); bf16_t* Wuq_t = (bf16_t*)(ws + WS_WUQ); bf16_t* Wukv_t = (bf16_t*)(ws + WS_WUKV); bf16_t* Wo_t = (bf16_t*)(ws + WS_WO);
    float* ssq = (float*)(ws + WS_SSQ); float* rs2 = (float*)(ws + WS_RS2); float* gate = (float*)(ws + WS_GATE); int* tos = (int*)(ws + WS_TOS);
    unsigned char* Wgu_t = ws + WS_WGU; unsigned char* Wdn_t = ws + WS_WDN;
    unsigned char* hq = ws + WS_HB;
    bf16_t* qb_ = (bf16_t*)(ws + WS_Q); bf16_t* kb_ = (bf16_t*)(ws + WS_K); bf16_t* vb_ = (bf16_t*)(ws + WS_V); bf16_t* mix = (bf16_t*)(ws + WS_MIX);
    bf16_t* oslot = (bf16_t*)(ws + WS_OSLOT); bf16_t* hn = (bf16_t*)(ws + WS_HN); bf16_t* pbuf = (bf16_t*)(ws + WS_PB); bf16_t* qraw = (bf16_t*)(ws + WS_QRAW); bf16_t* kvraw = (bf16_t*)(ws + WS_KVRAW);
    unsigned char* act = ws + WS_ACT;

    for (int u = tid; u < (LDS_BYTES - MISC_OFF) / 4; u += NWAVES * 64) ((LAS unsigned*)(lds + MISC_OFF))[u] = 0u;
    __syncthreads();
    XcdBarrier bar; bar.bar = ctl + CW_BAR; bar.x = 0; bar.st = nullptr;
    if (N_LAUNCHES == 1) bar = xcd_barrier_post(ctl + CW_BAR, MISC + 8);
#define GRID_BAR() do { if (N_LAUNCHES == 1) xcd_barrier(bar); } while (0)
    const int lo = args.ph_lo, hi = args.ph_hi;
#define IN(k) (((PHMASK >> (k)) & 1) && lo <= (k) && (k) < hi)
#define BOTH(k) (IN(k) && IN((k) + 1))
    const int gw = vcu * NWAVES + wave, NGW = G * NWAVES;

    const int gemm_wgs = (G == 256) ? 168 : G; const bool split = gemm_wgs < G;
    constexpr int I_GU = MOE_GU, I_DN = MOE_DN;
    if (IN(0)) {
        LAS unsigned* scr = (LAS unsigned*)(lds + wave * 16384);
        constexpr int I_IN = (DM / 64) * (NPROJ / 64), I_UQ = (QL / 64) * (768 / 64), I_UKV = (KVL / 64) * (1024 / 64), I_O = (DM / 64) * (DM / 64);
        constexpr int NITEMS = I_IN + I_UQ + I_UKV + I_O + I_GU + I_DN;
        if (!split) moe_stream(gw, NGW, w_gate_up, w_down, Wgu_t, Wdn_t, norm_ffn, scr, lane);
        for (int it = gw; it < NITEMS - I_GU - I_DN; it += NGW) {
            int r = it;
            if (r < I_IN) { const int nblk = NPROJ / 64, kb = r / nblk, nb = r % nblk, n0 = nb * 64;
                const int d0 = (n0 < 512) ? n0 : (n0 < 1024 ? 512 + ((n0 - 512) >> 7) * 256 + ((n0 - 512) & 127) : (n0 < 1536 ? 512 + ((n0 - 1024) >> 7) * 256 + 128 + ((n0 - 1024) & 127)
                             : (n0 < 1920 ? n0 + 256 : (n0 < 2176 ? n0 - 384 : n0))));
                p0_transpose_item(w_in, DM, NPROJ, Win_t, d0, nullptr, scr, kb * 64, n0, lane); continue; } r -= I_IN;
            if (r < I_UQ) { const int nblk = 768 / 64, kb = r / nblk, nb = r % nblk, h = nb / 3, part = nb % 3;
                p0_transpose_item(w_uq, QL, 768, Wuq_t, h * 256 + part * 64, q_norm, scr, kb * 64, nb * 64, lane, part == 2); continue; } r -= I_UQ;
            if (r < I_UKV) { const int nblk = 1024 / 64, kb = r / nblk, nb = r % nblk; p0_transpose_item(w_ukv, KVL, 1024, Wukv_t, nb * 64, kv_norm, scr, kb * 64, nb * 64, lane); continue; } r -= I_UKV;
            { const int nblk = DM / 64, kb = r / nblk, nb = r % nblk; p0_transpose_item(w_o, DM, DM, Wo_t, nb * 64, nullptr, scr, kb * 64, nb * 64, lane); }
        }
        const int gt = vcu * (NWAVES * 64) + tid, NGT = G * NWAVES * 64;
        for (int i = gt; i < (NPP - NPROJ) * DM / 8; i += NGT) *(u32x4*)(Win_t + (size_t)NPROJ * DM + (size_t)i * 8) = (u32x4){0u, 0u, 0u, 0u};
        for (int i = gt; i < NH * 64 * QL / 8; i += NGT) { const int h = i / (64 * QL / 8), j = i % (64 * QL / 8); *(u32x4*)(Wuq_t + (size_t)(h * 256 + 192) * QL + (size_t)j * 8) = (u32x4){0u, 0u, 0u, 0u}; }
        for (int i = gt; i < NE * DM; i += NGT) { const int e = i / DM, k = i % DM; const float v = w_router[(size_t)k * NE + e] * norm_ffn[k]; const unsigned h = f2bf(v); const float hf = __builtin_bit_cast(float, h << 16);
            WrH[i] = (bf16_t)h; WrL[i] = (bf16_t)f2bf(v - hf); }
        for (int i = gt; i < SEQ * 32; i += NGT) { const int pos = i >> 5, fi = i & 31; const float inv = exp2f(-(float)fi * (13.287712379549449f / 32.f)); const float ang = (float)pos * inv; float s, c; sincosf(ang, &s, &c); rope_t[i] = (f32x2){c, s}; }
        for (int m = 4 * gw; m < NTOK; m += 4 * NGW) {
            const f32x4* xr = (const f32x4*)(x + (size_t)m * DM) + lane; const f32x4* gr = (const f32x4*)norm_mix + lane;
            f32x4 v[4][4]; float ss[4] = {0.f, 0.f, 0.f, 0.f};
#pragma unroll
            for (int r = 0; r < 4; ++r)
#pragma unroll
                for (int j = 0; j < 4; ++j) v[r][j] = __builtin_nontemporal_load(xr + r * (DM / 4) + 64 * j);
#pragma unroll
            for (int r = 0; r < 4; ++r)
#pragma unroll
                for (int j = 0; j < 4; ++j) ss[r] += (v[r][j].x * v[r][j].x + v[r][j].y * v[r][j].y) + (v[r][j].z * v[r][j].z + v[r][j].w * v[r][j].w);
            u32x2* o8 = (u32x2*)(hn + (size_t)m * DM) + lane;
#pragma unroll
            for (int r = 0; r < 4; ++r) { const float rr = 1.0f / sqrtf(wave_sum(ss[r]) * (1.f / DM) + EPS);
#pragma unroll
                for (int j = 0; j < 4; ++j) { const f32x4 g = gr[64 * j]; u32x2 w;
                    w.x = cvt_pk_bf16(v[r][j].x * rr * g.x, v[r][j].y * rr * g.y); w.y = cvt_pk_bf16(v[r][j].z * rr * g.z, v[r][j].w * rr * g.w); o8[r * (DM / 4) + 64 * j] = w; } }
        }
        if (BOTH(0)) GRID_BAR();
    }

    if (IN(1) || IN(17) || IN(18)) {
        const bool do_g = IN(1) || IN(17), do_c = IN(1) || IN(18);
        if (bx < gemm_wgs) { if (do_g) {
            pg8::DenseSched S; S.init(hn, DM, Win_t, NTOK, NPP, DM, gemm_wgs, bx);
            pg8::EpiProj E{pbuf, ssq};
            pg8::gemm_phase<pg8::EpiProj, pg8::DenseSched, false>(lds, S, E); }
        } else if (do_c) {
            LAS unsigned* scr = (LAS unsigned*)(lds + wave * 16384);
            moe_stream((bx - gemm_wgs) * NWAVES + wave, (G - gemm_wgs) * NWAVES, w_gate_up, w_down, Wgu_t, Wdn_t, norm_ffn, scr, lane);
        }
        if (BOTH(1)) GRID_BAR();
    }

    const bool p2_all = IN(2);
    if (p2_all || IN(13)) {
        {
            const int gt = vcu * (NWAVES * 64) + tid, NGT = G * NWAVES * 64;
            for (int it = gt; it < (NTOK / 16) * 64; it += NGT) {
                const int run = it >> 6, gr = it & 63, t0 = run * 16, ch = gr * 8;
                float w0[8], w1[8], w2[8];
#pragma unroll
                for (int i = 0; i < 8; ++i) { w0[i] = conv_w[ch + i]; w1[i] = conv_w[CONVW + ch + i]; w2[i] = conv_w[2 * CONVW + ch + i]; }
                float um2[8], um1[8];
#pragma unroll
                for (int i = 0; i < 8; ++i) { um2[i] = 0.f; um1[i] = 0.f; }
                if ((t0 & (SEQ - 1)) != 0) {
                    unpack8(*(const u32x4*)(pbuf + (size_t)(t0 - 2) * NPB + PB_U + ch), um2);
                    unpack8(*(const u32x4*)(pbuf + (size_t)(t0 - 1) * NPB + PB_U + ch), um1);
                }
                u32x4 bq[16], uq[16];
#pragma unroll
                for (int t = 0; t < 16; ++t) { const bf16_t* pr = pbuf + (size_t)(t0 + t) * NPB + ch; bq[t] = __builtin_nontemporal_load((const u32x4*)(pr + PB_B)); uq[t] = __builtin_nontemporal_load((const u32x4*)(pr + PB_U)); }
#pragma unroll
                for (int t = 0; t < 16; ++t) {
                    float b8[8], u8[8], o8[8];
                    unpack8(bq[t], b8); unpack8(uq[t], u8);
#pragma unroll
                    for (int i = 0; i < 8; ++i) { o8[i] = b8[i] * (w0[i] * um2[i] + w1[i] * um1[i] + w2[i] * u8[i]); um2[i] = um1[i]; um1[i] = u8[i]; }
                    *(u32x4*)(mix + (size_t)(t0 + t) * DM + ch) = pack8(o8);
                }
            }
        }
    }
    if (p2_all || IN(14) || IN(15)) {
        LAS float* etab = (LAS float*)(lds + EPI_TAB_OFF);
        if (p2_all || IN(14)) { pg8::DenseSched S; S.init(pbuf + PB_CQ, NPB, Wuq_t, NTOK, NQP, QL, G, bx); pg8::EpiQ E{qb_, ssq, q_head_norm, rope_t, etab};
          pg8::gemm_phase<pg8::EpiQ, pg8::DenseSched, false>(lds, S, E); }
        if (p2_all || IN(15)) { pg8::DenseSched S; S.init(pbuf + PB_CKV, NPB, Wukv_t, NTOK, 1024, KVL, G, bx); pg8::EpiKV E{kb_, vb_, ssq, k_head_norm, rope_t, pbuf, etab};
          pg8::gemm_phase<pg8::EpiKV, pg8::DenseSched, false>(lds, S, E); }
        if (BOTH(2)) GRID_BAR();
    }


    if (IN(4)) {
        for (int u = vcu; u < NB * NH * 4; u += G) {
            const int bh = u >> 2, pr = u & 3, b = bh >> 2, h = bh & 3;
            att::attn_unit(b, h, 7 - pr, qb_, kb_, vb_, mix + CONVW, lds);
            att::attn_unit(b, h, pr, qb_, kb_, vb_, mix + CONVW, lds);
        }
        if (BOTH(4)) GRID_BAR();
    }

    if (IN(5)) {
        pg8::DenseSched S; S.init(mix, DM, Wo_t, NTOK, DM, DM, G, bx);
        pg8::EpiOut E{x, (bf16_t*)(ws + WS_H1B), ssq};
        pg8::gemm_phase<pg8::EpiOut, pg8::DenseSched, false>(lds, S, E);
        if (BOTH(5)) GRID_BAR();
    }

    if (IN(6) || IN(16)) {
        const bool dry = !IN(6);
        LAS unsigned* hist = (LAS unsigned*)(lds + MISC_OFF) + 128; LAS unsigned* base = (LAS unsigned*)(lds + MISC_OFF) + 160;
        const int tj = lane & 15, q = lane >> 4;
        for (int i = tid; i < 2 * NE * 128; i += NWAVES * 64) { const int sel = i >> 12, r = (i >> 7) & 31, g = i & 127;
            const u32x4 v = *(const u32x4*)((sel ? WrL : WrH) + (size_t)r * DM + g * 8);
            *(LAS u32x4*)(lds + sel * 65536 + r * 2048 + ((g ^ (r & 15)) << 4)) = v; }
        __syncthreads();
        for (int tile = vcu; tile < NTOK / 128; tile += G) {
            if (tid < 32) hist[tid] = 0u;
            __syncthreads();
            const int token = tile * 128 + wave * 16 + tj;
            const bf16_t* hrow = (const bf16_t*)(ws + WS_H1B) + (size_t)token * DM + q * 8;
            f32x4 a0 = {0.f, 0.f, 0.f, 0.f}, a1 = {0.f, 0.f, 0.f, 0.f};
            float s2 = 0.f;
#pragma unroll
            for (int p = 0; p < 16; ++p) s2 += ssq[(size_t)p * NTOK + token];
            const float rs = 1.0f / sqrtf(s2 * (1.f / DM) + EPS);
            unsigned char* hqrow = hq + (size_t)token * DM + q * 8;
            const LAS unsigned char* wlds = lds + tj * 2048;
#pragma unroll 1
            for (int kh = 0; kh < 2; ++kh) {
                u32x4 hv[16];
#pragma unroll
                for (int kk = 0; kk < 16; ++kk) hv[kk] = *(const u32x4*)(hrow + (kh * 16 + kk) * 32);
#pragma unroll
                for (int kk = 0; kk < 16; ++kk) { const int ks = kh * 16 + kk;
                    const u32x4 hw = hv[kk]; float hf[8]; unpack8(hw, hf);
                    { u32x2 w8; w8.x = pk4_fp8(hf[0] * rs, hf[1] * rs, hf[2] * rs, hf[3] * rs); w8.y = pk4_fp8(hf[4] * rs, hf[5] * rs, hf[6] * rs, hf[7] * rs); *(u32x2*)(hqrow + ks * 32) = w8; }
                    const bf16x8 bh = __builtin_bit_cast(bf16x8, hw);
                    const int go = (((ks * 4 + q) ^ tj) << 4);
                    const bf16x8 wh_a = *(const LAS bf16x8*)(wlds + go), wh_b = *(const LAS bf16x8*)(wlds + 16 * 2048 + go);
                    const bf16x8 wl_a = *(const LAS bf16x8*)(wlds + 65536 + go), wl_b = *(const LAS bf16x8*)(wlds + 65536 + 16 * 2048 + go);
                    a0 = __builtin_amdgcn_mfma_f32_16x16x32_bf16(wh_a, bh, a0, 0, 0, 0); a0 = __builtin_amdgcn_mfma_f32_16x16x32_bf16(wl_a, bh, a0, 0, 0, 0);
                    a1 = __builtin_amdgcn_mfma_f32_16x16x32_bf16(wh_b, bh, a1, 0, 0, 0); a1 = __builtin_amdgcn_mfma_f32_16x16x32_bf16(wl_b, bh, a1, 0, 0, 0);
                }
            }
            float lv[8]; int le[8];
#pragma unroll
            for (int i = 0; i < 4; ++i) { le[i] = 4 * q + i; le[4 + i] = 16 + 4 * q + i; lv[i] = a0[i] * rs + b_router[le[i]]; lv[4 + i] = a1[i] * rs + b_router[le[4 + i]]; }
            float tv[4]; int te[4];
#pragma unroll
            for (int k = 0; k < TOPK; ++k) {
                float bv = lv[0]; int be = le[0];
#pragma unroll
                for (int i = 1; i < 8; ++i) if (lv[i] > bv) { bv = lv[i]; be = le[i]; }
#pragma unroll
                for (int o = 16; o < 64; o <<= 1) { const float ov = __shfl_xor(bv, o); const int oe = __shfl_xor(be, o); if (ov > bv || (ov == bv && oe < be)) { bv = ov; be = oe; } }
                tv[k] = bv; te[k] = be;
#pragma unroll
                for (int i = 0; i < 8; ++i) if (le[i] == be) lv[i] = -3.0e38f;
            }
            float ge[4]; float gs = 0.f;
#pragma unroll
            for (int k = 0; k < TOPK; ++k) { ge[k] = __expf(tv[k] - tv[0]); gs += ge[k]; }
            const float ginv = 1.0f / gs;
            int my_e = te[0]; float my_g = ge[0];
#pragma unroll
            for (int k = 1; k < TOPK; ++k) if (q == k) { my_e = te[k]; my_g = ge[k]; }
            my_g *= ginv;
            const unsigned pl = atomicAdd((unsigned*)(hist + my_e), 1u);
            __syncthreads();
            if (tid < 32) base[tid] = dry ? 0u : __hip_atomic_fetch_add(ctl + CW_CNT + 64 * tid, hist[tid], __ATOMIC_RELAXED, __HIP_MEMORY_SCOPE_AGENT);
            __syncthreads();
            const unsigned pos = base[my_e] + pl; const int slot = token * 4 + q;
            if (!dry) *(u32x2*)(tos + ((size_t)my_e * CAP + pos) * 2) = (u32x2){(unsigned)slot, __builtin_bit_cast(unsigned, my_g)};
            else if (my_g < -1.f) rs2[token] = my_g;
            __syncthreads();
        }
        if (BOTH(6)) GRID_BAR();
    }

    LAS int* tab = (LAS int*)(lds + MISC_OFF) + 16;
    if (IN(7) || IN(8) || IN(10) || IN(11) || IN(12)) {
        if (tid < 32) { const int c = (int)__hip_atomic_load(ctl + CW_CNT + 64 * tid, __ATOMIC_RELAXED, __HIP_MEMORY_SCOPE_AGENT); tab[48 + tid] = c; }
        __syncthreads();
        if (tid == 0) { int s = 0; for (int e = 0; e < NE; ++e) { tab[e] = s; s += (tab[48 + e] + 255) >> 8; } tab[32] = s; }
        __syncthreads();
        for (int t = tid; t < tab[32]; t += NWAVES * 64) { int e = 0; while (e < NE - 1 && tab[e + 1] <= t) ++e; tab[2288 + t] = e; }
        __syncthreads();
    }

    if (IN(7)) {
        pg8::MoeSched S{hq, Wgu_t, DM, DM, 2 * DFF / 256, G, bx, (size_t)2 * DFF * DM, tab, tos, b_gate_up};
        pg8::EpiSwiglu E{act, b_gate_up, lds};
        pg8::gemm_phase<pg8::EpiSwiglu, pg8::MoeSched, true>(lds, S, E);
        if (BOTH(7)) GRID_BAR();
    }

    if (IN(8)) {
        pg8::MoeSched S{act, Wdn_t, DFF, DFF, DM / 256, G, bx, (size_t)DM * DFF, tab, tos, b_down};
        pg8::EpiDown E{(unsigned char*)oslot, b_down, ws + WS_SSQ, lds};
        pg8::gemm_phase<pg8::EpiDown, pg8::MoeSched, false>(lds, S, E);
        if (BOTH(8)) GRID_BAR();
    }

#if PROBE_DOUBLE
    if (IN(10)) { pg8::MoeSched S{hq, Wgu_t, DM, DM, 2 * DFF / 256, G, bx, (size_t)2 * DFF * DM, tab, tos, b_gate_up}; pg8::EpiNull E{(float*)(ws + WS_SSQ)};
        pg8::gemm_phase<pg8::EpiNull, pg8::MoeSched, true>(lds, S, E); }
    if (IN(11)) { pg8::MoeSched S{act, Wdn_t, DFF, DFF, DM / 256, G, bx, (size_t)DM * DFF, tab, tos, b_down}; pg8::EpiNull E{(float*)(ws + WS_SSQ)};
        pg8::gemm_phase<pg8::EpiNull, pg8::MoeSched, false, 2>(lds, S, E); }
    if (IN(12)) { pg8::MoeSched S{act, Wdn_t, DFF, DFF, DM / 256, G, bx, (size_t)DM * DFF, tab, tos, b_down}; pg8::EpiNull E{(float*)(ws + WS_SSQ)};
        pg8::gemm_phase<pg8::EpiNull, pg8::MoeSched, false>(lds, S, E); }
#endif
    if (IN(9)) {
        const unsigned char* os8 = (const unsigned char*)oslot;
        constexpr float OI = 1.f / OS8_SCALE;
        for (int m = gw; m < NTOK; m += NGW) {
            f32x4* orow = (f32x4*)(out + (size_t)m * DM) + lane;
            const u32x2* hrow = (const u32x2*)((const bf16_t*)(ws + WS_H1B) + (size_t)m * DM) + lane;
            const unsigned* s0 = (const unsigned*)(os8 + (size_t)m * 4 * DM) + lane;
            unsigned w[4][4]; f32x4 hv[4];
#pragma unroll
            for (int j = 0; j < 4; ++j) { const u32x2 hb2 = __builtin_nontemporal_load(hrow + 64 * j); hv[j] = (f32x4){bf_lo(hb2.x), bf_hi(hb2.x), bf_lo(hb2.y), bf_hi(hb2.y)};
#pragma unroll
                for (int k = 0; k < 4; ++k) w[j][k] = __builtin_nontemporal_load(s0 + (size_t)k * (DM / 4) + 64 * j); }
#pragma unroll
            for (int j = 0; j < 4; ++j) { f32x4 a = {0.f, 0.f, 0.f, 0.f};
#pragma unroll
                for (int k = 0; k < 4; ++k) { const f32x2 lo = __builtin_amdgcn_cvt_pk_f32_fp8(w[j][k], false), hi2 = __builtin_amdgcn_cvt_pk_f32_fp8(w[j][k], true); a.x += lo.x; a.y += lo.y; a.z += hi2.x; a.w += hi2.y; }
                __builtin_nontemporal_store(hv[j] + a * OI, orow + 64 * j); }
        }
    }
#undef IN
#undef BOTH
#undef GRID_BAR
}

#ifdef DIAG_PHASES
template __global__ void fwd_kernel_t<1>(Args); template __global__ void fwd_kernel_t<2>(Args); template __global__ void fwd_kernel_t<4>(Args); template __global__ void fwd_kernel_t<8>(Args);
template __global__ void fwd_kernel_t<16>(Args); template __global__ void fwd_kernel_t<32>(Args); template __global__ void fwd_kernel_t<64>(Args); template __global__ void fwd_kernel_t<128>(Args);
template __global__ void fwd_kernel_t<256>(Args); template __global__ void fwd_kernel_t<512>(Args);
#endif
#define fwd_kernel fwd_kernel_t<(PROBE_DOUBLE ? 0x7ffff : 1023)>
extern "C" void kernel_launch(void* const* d_in, const int* in_sizes, int n_in, void* d_out, int out_size, void* d_ws, size_t ws_size, hipStream_t stream) {
    static int grid = 0;
    if (grid == 0) {
        if (n_in != 18 || in_sizes[0] != NTOK * DM || out_size != NTOK * DM || ws_size < WS_END) { fprintf(stderr, "kernel_launch: shape/workspace mismatch (n_in %d, in0 %d, out %d, ws %zu, need %zu)\n", n_in, n_in > 0 ? in_sizes[0] : -1, out_size, ws_size, (size_t)WS_END); grid = -1; return; }
        int dev = 0, cus = 0, per_cu = 0;
        if (hipGetDevice(&dev) != hipSuccess || hipDeviceGetAttribute(&cus, hipDeviceAttributeMultiprocessorCount, dev) != hipSuccess) { grid = -1; return; }
        if (hipFuncSetAttribute((const void*)fwd_kernel, hipFuncAttributeMaxDynamicSharedMemorySize, LDS_BYTES) != hipSuccess) { fprintf(stderr, "kernel_launch: hipFuncSetAttribute failed\n"); grid = -1; return; }
        if (hipOccupancyMaxActiveBlocksPerMultiprocessor(&per_cu, (const void*)fwd_kernel, NWAVES * 64, LDS_BYTES) != hipSuccess || per_cu < 1) { fprintf(stderr, "kernel_launch: occupancy query says %d\n", per_cu); }
        (void)hipGetLastError();
        grid = cus;
    }
    if (grid < 0) return;
    if (hipMemsetAsync((char*)d_ws + WS_CTL, 0, CTL_ZERO_BYTES, stream) != hipSuccess) return;
    Args a{};
    for (int i = 0; i < 18; ++i) a.in[i] = (const float*)d_in[i];
    a.out = (float*)d_out; a.ws = (unsigned char*)d_ws;
    if (N_LAUNCHES == 1) { a.ph_lo = 0; a.ph_hi = N_PHASES; hipLaunchKernelGGL(fwd_kernel, dim3(grid), dim3(NWAVES * 64), LDS_BYTES, stream, a); }
    else { for (int p = 0; p < N_PHASES; ++p) { a.ph_lo = p; a.ph_hi = p + 1; const int reps = ((PROBE_DOUBLE >> p) & 1) ? 2 : 1;
            for (int r = 0; r < reps; ++r) hipLaunchKernelGGL(fwd_kernel, dim3(grid), dim3(NWAVES * 64), LDS_BYTES, stream, a);
            if (p == 1) for (int pp = 17; pp < 19; ++pp) if ((PROBE_DOUBLE >> pp) & 1) { a.ph_lo = pp; a.ph_hi = pp + 1; hipLaunchKernelGGL(fwd_kernel, dim3(grid), dim3(NWAVES * 64), LDS_BYTES, stream, a); }
            if (p == 8) for (int pp = 10; pp < 13; ++pp) if ((PROBE_DOUBLE >> pp) & 1) { a.ph_lo = pp; a.ph_hi = pp + 1; hipLaunchKernelGGL(fwd_kernel, dim3(grid), dim3(NWAVES * 64), LDS_BYTES, stream, a); }
            if (p == 6 && ((PROBE_DOUBLE >> 16) & 1)) { a.ph_lo = 16; a.ph_hi = 17; hipLaunchKernelGGL(fwd_kernel, dim3(grid), dim3(NWAVES * 64), LDS_BYTES, stream, a); }
            if (p == 2) for (int pp = 13; pp < 16; ++pp) if ((PROBE_DOUBLE >> pp) & 1) { a.ph_lo = pp; a.ph_hi = pp + 1; hipLaunchKernelGGL(fwd_kernel, dim3(grid), dim3(NWAVES * 64), LDS_BYTES, stream, a); } } }
}
```

```cpp
#include <hip/hip_runtime.h>
#include <cstdio>
#include <cstdint>

#ifndef MK_N_LAUNCHES
#define MK_N_LAUNCHES 1
#endif

#ifndef PROBE_DOUBLE
#define PROBE_DOUBLE 0
#endif
#define LAS __attribute__((address_space(3)))
#define GAS __attribute__((address_space(1)))
typedef unsigned short bf16_t;
typedef short bf16x8 __attribute__((ext_vector_type(8)));
typedef short s16x4 __attribute__((ext_vector_type(4)));
typedef float f32x2 __attribute__((ext_vector_type(2)));
typedef float f32x4 __attribute__((ext_vector_type(4)));
typedef float f32x16 __attribute__((ext_vector_type(16)));
typedef unsigned u32x2 __attribute__((ext_vector_type(2)));
typedef unsigned u32x4 __attribute__((ext_vector_type(4)));
typedef int v4i_t __attribute__((ext_vector_type(4)));
typedef int v8i_t __attribute__((ext_vector_type(8)));

constexpr int NB = 16, SEQ = 2048, NTOK = NB * SEQ, DM = 1024;
constexpr int CONVW = 512, QL = 384, KVL = 256, ROPE = 64, NH = 4, QKN = 128, QKH = 192, VH = 128;
constexpr int NPROJ = 2240, NPP = 2304;
constexpr int PB_B = 0, PB_U = 512, PB_CKV = 1024, PB_CQ = 1280, PB_KPE = 1664, NPB = 1728;
constexpr int NQP = 1024;
constexpr int NE = 32, TOPK = 4, DFF = 1024, NSLOT = NTOK * TOPK;
constexpr int CAP = NTOK;
constexpr int MAXTILES = NSLOT / 256 + NE;
constexpr float EPS = 1e-6f;
constexpr float QSCALE = 0.07216878364870322f * 1.4426950408889634f;
constexpr float SWI_LIMIT = 7.0f, SWI_ALPHA = 1.702f;
constexpr float W8_SCALE = 64.f, ACT8_SCALE = 4.f, OS8_SCALE = 16.f;

constexpr size_t MiB = 1u << 20;
constexpr size_t WS_CTL = 0, CTL_ZERO_BYTES = 1 * MiB;
constexpr size_t WS_ROPE = 1 * MiB;
constexpr size_t WS_WRH = 1 * MiB + 512 * 1024, WS_WRL = WS_WRH + 64 * 1024;
constexpr size_t WS_WIN = 2 * MiB;
constexpr size_t WS_WUQ = 8 * MiB, WS_WUKV = 9 * MiB, WS_WO = 10 * MiB;
constexpr size_t WS_SSQ = 12 * MiB;
constexpr size_t WS_RS2 = 14 * MiB, WS_GATE = 14 * MiB + 512 * 1024;
constexpr size_t WS_TOS = 16 * MiB;
constexpr size_t WS_WGU = 32 * MiB, WS_WDN = 160 * MiB;
constexpr size_t WS_HB = 224 * MiB;
constexpr size_t WS_Q = 288 * MiB, WS_K = 336 * MiB, WS_V = 384 * MiB, WS_MIX = 416 * MiB;
constexpr size_t WS_OSLOT = 288 * MiB;
constexpr size_t WS_HN = 544 * MiB, WS_PB = 608 * MiB, WS_QRAW = 752 * MiB, WS_KVRAW = 800 * MiB;
constexpr size_t WS_ACT = 544 * MiB;
constexpr size_t WS_H1B = 768 * MiB;
constexpr size_t WS_END = 864 * MiB;
constexpr int CW_BAR = 4096;
constexpr int CW_CNT = 16384;

constexpr int RING_BYTES = 131072;
constexpr int MISC_OFF = RING_BYTES;
constexpr int LDS_BYTES = 155648;
constexpr int EPI_TAB_OFF = MISC_OFF + 3072 * 4;

__device__ __forceinline__ unsigned cvt_pk_bf16(float lo, float hi) { unsigned r; asm volatile("v_cvt_pk_bf16_f32 %0, %1, %2" : "=v"(r) : "v"(lo), "v"(hi)); return r; }
__device__ __forceinline__ unsigned f2bf(float f) { unsigned u = __builtin_bit_cast(unsigned, f); return (u + 0x7fffu + ((u >> 16) & 1u)) >> 16; }
__device__ __forceinline__ unsigned pk2(float lo, float hi) { return f2bf(lo) | (f2bf(hi) << 16); }
__device__ __forceinline__ float bf_lo(unsigned w) { return __builtin_bit_cast(float, w << 16); }
__device__ __forceinline__ float bf_hi(unsigned w) { return __builtin_bit_cast(float, w & 0xffff0000u); }
__device__ __forceinline__ void unpack8(const u32x4 w, float* f) { f[0] = bf_lo(w.x); f[1] = bf_hi(w.x); f[2] = bf_lo(w.y); f[3] = bf_hi(w.y); f[4] = bf_lo(w.z); f[5] = bf_hi(w.z); f[6] = bf_lo(w.w); f[7] = bf_hi(w.w); }
__device__ __forceinline__ u32x4 pack8(const float* f) { u32x4 w; w.x = cvt_pk_bf16(f[0], f[1]); w.y = cvt_pk_bf16(f[2], f[3]); w.z = cvt_pk_bf16(f[4], f[5]); w.w = cvt_pk_bf16(f[6], f[7]); return w; }
__device__ __forceinline__ float wave_sum(float v) {
#pragma unroll
    for (int o = 1; o < 64; o <<= 1) v += __shfl_xor(v, o);
    return v;
}
__device__ __forceinline__ float half_sum(float v) {
#pragma unroll
    for (int o = 1; o < 32; o <<= 1) v += __shfl_xor(v, o);
    return v;
}
__device__ __forceinline__ float clamp448(float v) { return __builtin_amdgcn_fmed3f(v, -448.f, 448.f); }
__device__ __forceinline__ unsigned pk4_fp8_nc(float a, float b, float c, float d) {
    unsigned w = 0u; w = (unsigned)__builtin_amdgcn_cvt_pk_fp8_f32(a, b, (int)w, false); w = (unsigned)__builtin_amdgcn_cvt_pk_fp8_f32(c, d, (int)w, true); return w; }
__device__ __forceinline__ unsigned pk4_fp8(float a, float b, float c, float d) {
    unsigned w = 0u; w = (unsigned)__builtin_amdgcn_cvt_pk_fp8_f32(clamp448(a), clamp448(b), (int)w, false); w = (unsigned)__builtin_amdgcn_cvt_pk_fp8_f32(clamp448(c), clamp448(d), (int)w, true); return w; }
#define LDS_WAIT() asm volatile("s_waitcnt lgkmcnt(0)" ::: "memory")
#define VM_WAIT() asm volatile("s_waitcnt vmcnt(0)" ::: "memory")

namespace pg8 {
constexpr int BM = 256, BK = 64, HALF = 128, HTB = HALF * BK * 2, STAGE_BYTES = 8 * HTB, NXCD = 8, WGM = 4;
__host__ __device__ __forceinline__ int lds_byte(int r, int c) { const int st = (r >> 4) * 2 + (c >> 5), rr = r & 15, cc = c & 31, ob = rr * 64 + cc * 2; return st * 1024 + (ob ^ (((ob >> 9) & 1) << 5)); }
__host__ __device__ __forceinline__ void stage_rc(int b, int& R, int& C) { const int st = b / 1024, sb = b % 1024, swz = sb ^ (((sb >> 9) & 1) << 5); R = (st >> 1) * 16 + swz / 64; C = (st & 1) * 32 + (swz % 64) / 2; }
__host__ __device__ __forceinline__ int perm32(int rho) { const int n = rho >> 4, i = rho & 15; return 8 * (i >> 2) + 4 * n + (i & 3); }

struct Unit { int pm, pn, e, p0, cnt, par, half; };

__device__ __forceinline__ bool deal_unit(int i, int nwg, int G, int c, int& wgid, int& half) {
    half = 0;
    if (G % NXCD != 0) { const long L = (long)i * G + c; if (L >= nwg) return false; wgid = (int)L; return true; }
    const int W = G / NXCD, x = c % NXCD, rk = c / NXCD, q = nwg / NXCD, r = nwg % NXCD;
    const int cnt = q + (x < r ? 1 : 0), base = (x < r ? x * (q + 1) : r * (q + 1) + (x - r) * q);
    const int R = cnt / W, E = cnt - R * W;
    if (i < R) { wgid = base + i * W + rk; return true; }
    if (i > R) return false;
    if (rk >= E) return false; wgid = base + R * W + rk; return true;
}
struct DenseSched {
    static constexpr int ESZ = 2;
    const bf16_t* A; const bf16_t* Bt; int lda, K, nM, nN, nwg, G, c;
    __device__ void init(const bf16_t* A_, int lda_, const bf16_t* Bt_, int M, int N, int K_, int G_, int c_) { A = A_; Bt = Bt_; lda = lda_; K = K_; nM = M / BM; nN = N / BM; nwg = nM * nN; G = G_; c = c_; }
    __device__ __forceinline__ bool next(int i, Unit& u) const {
        int wgid, half; if (!deal_unit(i, nwg, G, c, wgid, half)) return false;
        const int nig = WGM * nN, gid = wgid / nig, fm = gid * WGM, gsz = (nM - fm) < WGM ? (nM - fm) : WGM;
        u.pm = fm + ((wgid % nig) % gsz); u.pn = (wgid % nig) / gsz; u.e = 0; u.p0 = 0; u.cnt = 0; u.half = half; return true;
    }
    __device__ __forceinline__ unsigned a_off(const Unit& u) const { return (unsigned)u.pm * (unsigned)(BM * lda * 2); }
    __device__ __forceinline__ unsigned b_off(const Unit& u) const { return (unsigned)u.pn * (unsigned)(BM * K * 2); }
    __device__ __forceinline__ unsigned a_rowoff(const Unit&, int) const { return 0u; }
    static constexpr bool META = false;
    __device__ __forceinline__ void meta_first(const Unit&, LAS unsigned char*) const {}
    __device__ __forceinline__ void meta_issue(const Unit&, LAS unsigned char*) const {}
    __device__ __forceinline__ void pre_issue(const Unit&, LAS unsigned char*) const {}
    __device__ __forceinline__ unsigned meta_rowoff(const Unit&, int, LAS unsigned char*) const { return 0u; }
};
struct MoeSched {
    static constexpr int ESZ = 1;
    const unsigned char* A; const unsigned char* Bt; int lda, K, nN, G, c; size_t estride; const LAS int* tab; const int* tos; const float* bias;
    static constexpr bool META = true;
    static constexpr int META_OFF = MISC_OFF + 4608 * 4;
    __device__ __forceinline__ bool next(int i, Unit& u) const {
        const int T = __builtin_amdgcn_readfirstlane(tab[32]), nwg = T * nN;
        int wgid, half; if (!deal_unit(i, nwg, G, c, wgid, half)) return false; u.half = half;
        const int nig = WGM * nN, gid = wgid / nig, fm = gid * WGM, gsz = (T - fm) < WGM ? (T - fm) : WGM;
        const int mt = fm + ((wgid % nig) % gsz); u.pm = mt; u.pn = (wgid % nig) / gsz;
        const int e = __builtin_amdgcn_readfirstlane(tab[2288 + mt]);
        u.e = e; u.p0 = (mt - __builtin_amdgcn_readfirstlane(tab[e])) * BM; u.cnt = __builtin_amdgcn_readfirstlane(tab[48 + e]); return true;
    }
    __device__ __forceinline__ unsigned a_off(const Unit& u) const { return (unsigned)u.pm * (unsigned)(BM * lda); }
    __device__ __forceinline__ unsigned b_off(const Unit& u) const { return (unsigned)u.e * (unsigned)estride + (unsigned)u.pn * (unsigned)(BM * K); }
    __device__ __forceinline__ unsigned a_rowoff(const Unit& u, int r) const {
        const int p = u.p0 + r; const int sv = tos[((size_t)u.e * CAP + p) * 2];
        const int slot = (p < u.cnt) ? sv : 0;
        return (unsigned)(slot >> 2) * (unsigned)lda;
    }
    static constexpr int BIAS_OFF = MISC_OFF + 5632 * 4;
    __device__ __forceinline__ void meta_first(const Unit& u, LAS unsigned char* lds) const { meta_issue(u, lds); }
    __device__ __forceinline__ void meta_issue(const Unit& u, LAS unsigned char* lds) const {
        const __amdgpu_buffer_rsrc_t rT = __builtin_amdgcn_make_buffer_rsrc((void*)tos, 0, -1, 0x00020000);
        const int wid = __builtin_amdgcn_readfirstlane(threadIdx.x >> 6);
        __builtin_amdgcn_raw_ptr_buffer_load_lds(rT, (LAS void*)(lds + META_OFF + u.par * 2048 + wid * 256), 4, (threadIdx.x & 63) * 4u, ((unsigned)u.e * (unsigned)CAP + (unsigned)u.p0) * 8u + (unsigned)wid * 256u, 0, 0);
    }
    __device__ __forceinline__ void pre_issue(const Unit& u, LAS unsigned char* lds) const {
        const int wid = __builtin_amdgcn_readfirstlane(threadIdx.x >> 6);
        if (wid < 4) { const __amdgpu_buffer_rsrc_t rB = __builtin_amdgcn_make_buffer_rsrc((void*)bias, 0, -1, 0x00020000);
            const unsigned src = (nN == 8) ? (((unsigned)u.e * (2u * DFF) + (unsigned)u.pn * HALF) * 4u + (wid >= 2 ? DFF * 4u - 512u : 0u)) : (((unsigned)u.e * DM + (unsigned)u.pn * BM) * 4u);
            __builtin_amdgcn_raw_ptr_buffer_load_lds(rB, (LAS void*)(lds + BIAS_OFF + u.par * 1024 + wid * 256), 4, (threadIdx.x & 63) * 4u, src + (unsigned)wid * 256u, 0, 0); }
    }
    __device__ __forceinline__ unsigned meta_rowoff(const Unit& u, int r, LAS unsigned char* lds) const {
        const int sv = *(const LAS int*)(lds + META_OFF + u.par * 2048 + r * 8);
        const int slot = (u.p0 + r < u.cnt) ? sv : 0;
        return (unsigned)(slot >> 2) * (unsigned)lda;
    }
};

template <class Epi, class Sched, bool GATHER, int KREP = 1>
__device__ __forceinline__ void gemm_phase(LAS unsigned char* lds, const Sched& S, const Epi& E) {
    const int tid = threadIdx.x, wid = __builtin_amdgcn_readfirstlane(tid >> 6), lane = tid & 63, wr = wid >> 2, wc = wid & 3, fr = lane & 15, fq = lane >> 4;
    constexpr int ESZ = Sched::ESZ; constexpr bool F8 = (ESZ == 1);
    const int K = S.K * ESZ / 2, lda = S.lda * ESZ / 2, nt0 = K / BK, nt = nt0 * KREP;
    unsigned voffB[2], aoc[2][2]; int RA[2], CA[2];
#pragma unroll
    for (int i = 0; i < 2; ++i) { int R, C; stage_rc(tid * 16 + i * 8192, R, C); const int Rb = (R & ~31) + perm32(R & 31);
        voffB[i] = (unsigned)(Rb * K + C) * 2u; RA[i] = R; CA[i] = C;
        aoc[0][i] = (unsigned)(R * lda + C) * 2u; aoc[1][i] = (unsigned)((R + HALF) * lda + C) * 2u; }
    const unsigned kstep = (unsigned)(BK * 2);
    const unsigned hstepB = (unsigned)(HALF * K * 2), hstepA = GATHER ? 0u : (unsigned)(HALF * lda * 2);
    const __amdgpu_buffer_rsrc_t rA = __builtin_amdgcn_make_buffer_rsrc((void*)S.A, 0, -1, 0x00020000), rB = __builtin_amdgcn_make_buffer_rsrc((void*)S.Bt, 0, -1, 0x00020000);
    const unsigned ldsw = (unsigned)wid * 1024u;
    const int aoff = lds_byte(wr * 64 + fr, fq * 8), boff = lds_byte(wc * 32 + fr, fq * 8);
#define PG8_SA(b, h) (((b) * 2 + (h)) * HTB)
#define PG8_SB(b, h) ((4 + (b) * 2 + (h)) * HTB)
#define PG8_STAGE_B(bufoff, soff) do { _Pragma("unroll") for (int _i = 0; _i < 2; ++_i) \
        __builtin_amdgcn_raw_ptr_buffer_load_lds(rB, (LAS void*)(lds + (bufoff) + ldsw + _i * 8192), 16, voffB[_i], (soff), 0, 0); } while (0)
#define PG8_STAGE_A(bufoff, soff, h) do { _Pragma("unroll") for (int _i = 0; _i < 2; ++_i) \
        __builtin_amdgcn_raw_ptr_buffer_load_lds(rA, (LAS void*)(lds + (bufoff) + ldsw + _i * 8192), 16, aoc[GATHER ? (h) : 0][_i], (soff) + (h) * hstepA, 0, 0); } while (0)
#define PG8_LDA(dst, b, h) do { _Pragma("unroll") for (int m = 0; m < 4; ++m) _Pragma("unroll") for (int k = 0; k < 2; ++k) dst[m][k] = *(const LAS bf16x8*)(lds + PG8_SA(b, h) + aoff + m * 2048 + k * 1024); } while (0)
#define PG8_LDB(dst, b, h) do { _Pragma("unroll") for (int n = 0; n < 2; ++n) _Pragma("unroll") for (int k = 0; k < 2; ++k) dst[n][k] = *(const LAS bf16x8*)(lds + PG8_SB(b, h) + boff + n * 2048 + k * 1024); } while (0)
#define PG8_CAT(x) __builtin_shufflevector(__builtin_bit_cast(v4i_t, x[0]), __builtin_bit_cast(v4i_t, x[1]), 0, 1, 2, 3, 4, 5, 6, 7)
#define PG8_MMA(ai, bj, At, Bt) do { __builtin_amdgcn_s_setprio(1); _Pragma("unroll") for (int m = 0; m < 4; ++m) _Pragma("unroll") for (int n = 0; n < 2; ++n) { \
        if constexpr (F8) { asm volatile("v_mfma_scale_f32_16x16x128_f8f6f4 %0, %1, %2, %0, %3, %3 op_sel_hi:[0,0,0]" : "+v"(acc[ai][bj][m][n]) : "v"(PG8_CAT(Bt[n])), "v"(PG8_CAT(At[m])), "v"(0x7f7f7f7f)); } \
        else { _Pragma("unroll") for (int k = 0; k < 2; ++k) acc[ai][bj][m][n] = __builtin_amdgcn_mfma_f32_16x16x32_bf16(Bt[n][k], At[m][k], acc[ai][bj][m][n], 0, 0, 0); } } \
        __builtin_amdgcn_s_setprio(0); } while (0)
#define PG8_WAIT_V(n) asm volatile("s_waitcnt vmcnt(" #n ")" ::: "memory")
#define PG8_WAIT_L(n) asm volatile("s_waitcnt lgkmcnt(" #n ")" ::: "memory")
#define PG8_BAR __builtin_amdgcn_s_barrier()
#define PG8_SCHED __builtin_amdgcn_sched_barrier(0)
    Unit cur, nxt; int ui = 0;
    if (!S.next(0, cur)) return;
    cur.par = 0; if constexpr (Sched::META) S.meta_first(cur, lds);
    f32x4 acc[2][2][4][2];
#pragma unroll
    for (int a = 0; a < 2; ++a)
#pragma unroll
        for (int b = 0; b < 2; ++b)
#pragma unroll
            for (int m = 0; m < 4; ++m)
#pragma unroll
                for (int n = 0; n < 2; ++n) acc[a][b][m][n] = (f32x4){0.f, 0.f, 0.f, 0.f};
    bf16x8 At[4][2], B0[2][2], B1[2][2];
    unsigned cA = GATHER ? 0u : S.a_off(cur), cB = S.b_off(cur);
    if constexpr (GATHER) {
#pragma unroll
        for (int h = 0; h < 2; ++h)
#pragma unroll
            for (int i = 0; i < 2; ++i) aoc[h][i] = S.a_rowoff(cur, h * HALF + RA[i]) + (unsigned)CA[i] * 2u;
    }
    PG8_STAGE_B(PG8_SB(0, 0), cB); PG8_STAGE_B(PG8_SB(0, 1), cB + hstepB); PG8_STAGE_A(PG8_SA(0, 0), cA, 0); PG8_STAGE_A(PG8_SA(0, 1), cA, 1);
    if (wr == 1) PG8_BAR;
    PG8_WAIT_V(2); PG8_BAR;
    PG8_STAGE_B(PG8_SB(1, 0), cB + kstep); PG8_STAGE_A(PG8_SA(1, 0), cA + kstep, 0); PG8_STAGE_B(PG8_SB(1, 1), cB + hstepB + kstep);
    PG8_WAIT_V(6); PG8_BAR;
    for (;;) {
        const bool has_next = S.next(ui + 1, nxt);
        const unsigned nA = GATHER ? 0u : (has_next ? S.a_off(nxt) : cA), nB = has_next ? S.b_off(nxt) : cB;
        nxt.par = (ui + 1) & 1;
        for (int t = 0; t < nt; t += 2) {
            const bool last = (t == nt - 2);
            const unsigned a1 = cA + (unsigned)((t + 1) % nt0) * kstep;
            const unsigned a2 = last ? nA : cA + (unsigned)((t + 2) % nt0) * kstep, b2 = last ? nB : cB + (unsigned)((t + 2) % nt0) * kstep;
            const unsigned a3 = a2 + kstep, b3 = b2 + kstep;
            PG8_LDB(B0, 0, 0); PG8_LDB(B1, 0, 1); PG8_SCHED; PG8_LDA(At, 0, 0); PG8_STAGE_A(PG8_SA(1, 1), a1, 1);
            PG8_WAIT_V(8); PG8_WAIT_L(0); PG8_BAR;
            if constexpr (Sched::META) { if (t == 0) { S.pre_issue(cur, lds); if (has_next) S.meta_issue(nxt, lds); } }
            PG8_MMA(0, 0, At, B0); PG8_MMA(0, 1, At, B1); PG8_BAR; PG8_SCHED;
            if constexpr (Sched::META) { if (last && has_next) {
                if constexpr (GATHER) {
#pragma unroll
                    for (int h = 0; h < 2; ++h)
#pragma unroll
                        for (int i = 0; i < 2; ++i) aoc[h][i] = S.meta_rowoff(nxt, h * HALF + RA[i], lds) + (unsigned)CA[i] * 2u;
                } } }
            PG8_LDA(At, 0, 1); PG8_STAGE_B(PG8_SB(0, 0), b2); PG8_STAGE_B(PG8_SB(0, 1), b2 + hstepB); PG8_STAGE_A(PG8_SA(0, 0), a2, 0);
            PG8_WAIT_V(8); PG8_WAIT_L(0); PG8_BAR; PG8_MMA(1, 0, At, B0); PG8_MMA(1, 1, At, B1); PG8_BAR; PG8_SCHED;
            PG8_LDB(B0, 1, 0); PG8_LDB(B1, 1, 1); PG8_SCHED; PG8_LDA(At, 1, 0); PG8_STAGE_A(PG8_SA(0, 1), a2, 1);
            PG8_WAIT_V(8); PG8_WAIT_L(0); PG8_BAR; PG8_MMA(0, 0, At, B0); PG8_MMA(0, 1, At, B1); PG8_BAR; PG8_SCHED;
            PG8_LDA(At, 1, 1); PG8_STAGE_B(PG8_SB(1, 0), b3); PG8_STAGE_B(PG8_SB(1, 1), b3 + hstepB); PG8_STAGE_A(PG8_SA(1, 0), a3, 0);
            PG8_WAIT_V(8); PG8_WAIT_L(0); PG8_BAR; PG8_MMA(1, 0, At, B0); PG8_MMA(1, 1, At, B1); PG8_BAR; PG8_SCHED;
        }
        if (wr == 0) PG8_BAR;
        E(acc, cur, wr, wc, fr, fq);
        if (!has_next) break;
#pragma unroll
        for (int a = 0; a < 2; ++a)
#pragma unroll
            for (int b = 0; b < 2; ++b)
#pragma unroll
                for (int m = 0; m < 4; ++m)
#pragma unroll
                    for (int n = 0; n < 2; ++n) acc[a][b][m][n] = (f32x4){0.f, 0.f, 0.f, 0.f};
        cur = nxt; cA = nA; cB = nB; ++ui;
        if (wr == 1) PG8_BAR;
    }
    PG8_WAIT_V(0);
    PG8_BAR;
#undef PG8_SA
#undef PG8_SB
#undef PG8_STAGE_A
#undef PG8_STAGE_B
#undef PG8_LDA
#undef PG8_LDB
#undef PG8_MMA
#undef PG8_CAT
#undef PG8_WAIT_V
#undef PG8_WAIT_L
#undef PG8_BAR
#undef PG8_SCHED
}

struct EpiBf16 {
    bf16_t* O; int ldc;
    __device__ __forceinline__ void operator()(const f32x4 (&acc)[2][2][4][2], const Unit& u, int wr, int wc, int fr, int fq) const {
        asm volatile("" : "+v"(fr), "+v"(fq));
        const int row0 = u.pm * BM + wr * 64 + fr, col0 = u.pn * BM + wc * 32 + 8 * fq;
#pragma unroll
        for (int ai = 0; ai < 2; ++ai)
#pragma unroll
            for (int m = 0; m < 4; ++m) { bf16_t* rowp = O + (size_t)(row0 + ai * HALF + m * 16) * ldc + col0;
#pragma unroll
                for (int bj = 0; bj < 2; ++bj) { const f32x4 v0 = acc[ai][bj][m][0], v1 = acc[ai][bj][m][1];
                    u32x4 w; w.x = cvt_pk_bf16(v0[0], v0[1]); w.y = cvt_pk_bf16(v0[2], v0[3]); w.z = cvt_pk_bf16(v1[0], v1[1]); w.w = cvt_pk_bf16(v1[2], v1[3]);
                    *(u32x4*)(rowp + bj * HALF) = w; } }
    }
};
struct EpiProj {
    static constexpr int NPRE = 0;
    bf16_t* O; float* st;
    __device__ __forceinline__ void operator()(const f32x4 (&acc)[2][2][4][2], const Unit& u, int wr, int wc, int fr, int fq) const {
        asm volatile("" : "+v"(fr), "+v"(fq));
        const int row0 = u.pm * BM + wr * 64 + fr, c8 = wc * 32 + 8 * fq;
        const bool pair = (u.pn >= 2 && u.pn < 6);
        const int cb0 = (u.pn < 2) ? u.pn * BM : (pair ? PB_U + (u.pn - 2) * HALF : (u.pn == 6 ? PB_CKV : (u.pn == 7 ? PB_CQ : PB_CQ + 256)));
#pragma unroll
        for (int ai = 0; ai < 2; ++ai)
#pragma unroll
            for (int m = 0; m < 4; ++m) { const int row = row0 + ai * HALF + m * 16; bf16_t* rowp = O + (size_t)row * NPB + cb0 + c8; float ss[2];
                if (pair) { const f32x4 v0 = acc[ai][0][m][0] * acc[ai][1][m][0], v1 = acc[ai][0][m][1] * acc[ai][1][m][1];
                    u32x4 w; w.x = cvt_pk_bf16(v0[0], v0[1]); w.y = cvt_pk_bf16(v0[2], v0[3]); w.z = cvt_pk_bf16(v1[0], v1[1]); w.w = cvt_pk_bf16(v1[2], v1[3]);
                    *(u32x4*)rowp = w; ss[0] = 0.f; ss[1] = 0.f;
                } else {
#pragma unroll
                    for (int bj = 0; bj < 2; ++bj) { const f32x4 v0 = acc[ai][bj][m][0], v1 = acc[ai][bj][m][1];
                        u32x4 w; w.x = cvt_pk_bf16(v0[0], v0[1]); w.y = cvt_pk_bf16(v0[2], v0[3]); w.z = cvt_pk_bf16(v1[0], v1[1]); w.w = cvt_pk_bf16(v1[2], v1[3]);
                        if (!(u.pn == 8 && bj == 1 && wc >= 2)) *(u32x4*)(rowp + bj * HALF) = w;
                        ss[bj] = (v0[0] * v0[0] + v0[1] * v0[1]) + (v0[2] * v0[2] + v0[3] * v0[3]) + (v1[0] * v1[0] + v1[1] * v1[1]) + (v1[2] * v1[2] + v1[3] * v1[3]); } }
                if (u.pn >= 6) {
                    float s0 = ss[0], s1 = ss[1]; s0 += __shfl_xor(s0, 16); s0 += __shfl_xor(s0, 32); s1 += __shfl_xor(s1, 16); s1 += __shfl_xor(s1, 32);
                    if (fq == 0) { if (u.pn == 6) st[(size_t)wc * NTOK + row] = s0 + s1; else if (u.pn == 7) st[(size_t)(4 + wc) * NTOK + row] = s0 + s1;
                                   else { st[(size_t)(8 + wc) * NTOK + row] = s0; st[(size_t)(12 + wc) * NTOK + row] = s1; } } } }
    }
};
struct EpiQ {
    bf16_t* q; const float* st; const float* qhn; const f32x2* rope; LAS float* tabs;
    __device__ __forceinline__ void operator()(const f32x4 (&acc)[2][2][4][2], const Unit& u, int wr, int wc, int fr, int fq) const {
        asm volatile("" : "+v"(fr), "+v"(fq));
        LAS float* rs_tab = tabs; LAS float* part = tabs + 512;
        const int rt0 = wr * 64 + fr;
        const int c0 = wc * 32 + 8 * fq;
        const int i0 = c0 >> 1;
        f32x4 csa[2][4][2];
        if (wc < 2) {
#pragma unroll
            for (int ai = 0; ai < 2; ++ai)
#pragma unroll
                for (int m = 0; m < 4; ++m) { const size_t row = (size_t)u.pm * BM + rt0 + ai * HALF + m * 16;
                    csa[ai][m][0] = *(const f32x4*)(rope + (row & (SEQ - 1)) * 32 + i0); csa[ai][m][1] = *(const f32x4*)(rope + (row & (SEQ - 1)) * 32 + i0 + 2); }
        }
        f32x4 g0[2], g1[2];
        g0[0] = *(const f32x4*)(qhn + c0) * QSCALE; g0[1] = *(const f32x4*)(qhn + c0 + 4) * QSCALE;
        if (wc < 2) { g1[0] = (f32x4){qhn[128 + i0], qhn[160 + i0], qhn[129 + i0], qhn[161 + i0]} * QSCALE; g1[1] = (f32x4){qhn[130 + i0], qhn[162 + i0], qhn[131 + i0], qhn[163 + i0]} * QSCALE; }
        else { g1[0] = (f32x4){0.f, 0.f, 0.f, 0.f}; g1[1] = g1[0]; }
        { const int t = threadIdx.x; if (t < BM) { const size_t r = (size_t)u.pm * BM + t; float s = 0.f;
#pragma unroll
            for (int k = 4; k < 12; ++k) s += st[(size_t)k * NTOK + r];
            rs_tab[t] = 1.0f / sqrtf(s * (1.f / QL) + EPS); } }
#pragma unroll
        for (int ai = 0; ai < 2; ++ai)
#pragma unroll
            for (int m = 0; m < 4; ++m) { float ss = 0.f;
#pragma unroll
                for (int bj = 0; bj < 2; ++bj)
#pragma unroll
                    for (int n = 0; n < 2; ++n) { const f32x4 v = acc[ai][bj][m][n]; ss += (v[0] * v[0] + v[1] * v[1]) + (v[2] * v[2] + v[3] * v[3]); }
                ss += __shfl_xor(ss, 16); ss += __shfl_xor(ss, 32);
                if (fq == 0) part[(rt0 + ai * HALF + m * 16) * 4 + wc] = ss; }
        asm volatile("s_waitcnt lgkmcnt(0)" ::: "memory"); __builtin_amdgcn_s_barrier(); asm volatile("" ::: "memory");
#pragma unroll
        for (int ai = 0; ai < 2; ++ai)
#pragma unroll
            for (int m = 0; m < 4; ++m) { const int rt = rt0 + ai * HALF + m * 16; const size_t row = (size_t)u.pm * BM + rt;
                const f32x4 pp = *(const LAS f32x4*)(part + rt * 4); const float rs = rs_tab[rt];
                const float r = rs / sqrtf(rs * rs * ((pp[0] + pp[1]) + (pp[2] + pp[3])) * (1.f / QKH) + EPS);
                bf16_t* qp = q + row * (NH * QKH) + u.pn * QKH + c0;
                { const f32x4 v0 = acc[ai][0][m][0] * g0[0] * r, v1 = acc[ai][0][m][1] * g0[1] * r;
                  u32x4 w; w.x = cvt_pk_bf16(v0[0], v0[1]); w.y = cvt_pk_bf16(v0[2], v0[3]); w.z = cvt_pk_bf16(v1[0], v1[1]); w.w = cvt_pk_bf16(v1[2], v1[3]); *(u32x4*)qp = w; }
                if (wc < 2) { const f32x4 cs0 = csa[ai][m][0], cs1 = csa[ai][m][1];
                    const f32x4 a0 = acc[ai][1][m][0] * g1[0] * r, a1 = acc[ai][1][m][1] * g1[1] * r;
                    f32x4 o0, o1;
                    o0[0] = a0[0] * cs0[0] - a0[1] * cs0[1]; o0[1] = a0[0] * cs0[1] + a0[1] * cs0[0]; o0[2] = a0[2] * cs0[2] - a0[3] * cs0[3]; o0[3] = a0[2] * cs0[3] + a0[3] * cs0[2];
                    o1[0] = a1[0] * cs1[0] - a1[1] * cs1[1]; o1[1] = a1[0] * cs1[1] + a1[1] * cs1[0]; o1[2] = a1[2] * cs1[2] - a1[3] * cs1[3]; o1[3] = a1[2] * cs1[3] + a1[3] * cs1[2];
                    u32x4 w; w.x = cvt_pk_bf16(o0[0], o0[1]); w.y = cvt_pk_bf16(o0[2], o0[3]); w.z = cvt_pk_bf16(o1[0], o1[1]); w.w = cvt_pk_bf16(o1[2], o1[3]); *(u32x4*)(qp + HALF) = w; } }
    }
};
struct EpiKV {
    bf16_t* k; bf16_t* v; const float* st; const float* khn; const f32x2* rope; const bf16_t* pb; LAS float* tabs;
    __device__ __forceinline__ void operator()(const f32x4 (&acc)[2][2][4][2], const Unit& u, int wr, int wc, int fr, int fq) const {
        asm volatile("" : "+v"(fr), "+v"(fq));
        LAS float* rs_tab = tabs; LAS float* kpe_tab = tabs + 256; LAS float* part = tabs + 512;
        const int rt0 = wr * 64 + fr;
        const int c0 = wc * 32 + 8 * fq;
        const int i0 = 8 * wc + 2 * fq;
        unsigned xas[2][4], xbs[2][4]; f32x4 css[2][4];
#pragma unroll
        for (int ai = 0; ai < 2; ++ai)
#pragma unroll
            for (int m = 0; m < 4; ++m) { const size_t row = (size_t)u.pm * BM + rt0 + ai * HALF + m * 16;
                xas[ai][m] = *(const unsigned*)(pb + row * NPB + PB_KPE + i0); xbs[ai][m] = *(const unsigned*)(pb + row * NPB + PB_KPE + 32 + i0);
                css[ai][m] = *(const f32x4*)(rope + (row & (SEQ - 1)) * 32 + i0); }
        const f32x4 g0 = *(const f32x4*)(khn + c0), g1 = *(const f32x4*)(khn + c0 + 4);
        const float gx0 = khn[128 + i0], gy0 = khn[160 + i0], gx1 = khn[129 + i0], gy1 = khn[161 + i0];
        { const int t = threadIdx.x; if (t < BM) { const size_t r = (size_t)u.pm * BM + t;
            const float s = (st[r] + st[(size_t)NTOK + r]) + (st[(size_t)2 * NTOK + r] + st[(size_t)3 * NTOK + r]);
            const float p = (st[(size_t)12 * NTOK + r] + st[(size_t)13 * NTOK + r]) + (st[(size_t)14 * NTOK + r] + st[(size_t)15 * NTOK + r]);
            rs_tab[t] = 1.0f / sqrtf(s * (1.f / KVL) + EPS); kpe_tab[t] = p; } }
#pragma unroll
        for (int ai = 0; ai < 2; ++ai)
#pragma unroll
            for (int m = 0; m < 4; ++m) { float ss = 0.f;
#pragma unroll
                for (int n = 0; n < 2; ++n) { const f32x4 x = acc[ai][0][m][n]; ss += (x[0] * x[0] + x[1] * x[1]) + (x[2] * x[2] + x[3] * x[3]); }
                ss += __shfl_xor(ss, 16); ss += __shfl_xor(ss, 32);
                if (fq == 0) part[(rt0 + ai * HALF + m * 16) * 4 + wc] = ss; }
        asm volatile("s_waitcnt lgkmcnt(0)" ::: "memory"); __builtin_amdgcn_s_barrier(); asm volatile("" ::: "memory");
#pragma unroll
        for (int ai = 0; ai < 2; ++ai)
#pragma unroll
            for (int m = 0; m < 4; ++m) { const int rt = rt0 + ai * HALF + m * 16; const size_t row = (size_t)u.pm * BM + rt;
                const f32x4 pp = *(const LAS f32x4*)(part + rt * 4); const float rs = rs_tab[rt];
                const float rh = 1.0f / sqrtf((rs * rs * ((pp[0] + pp[1]) + (pp[2] + pp[3])) + kpe_tab[rt]) * (1.f / QKH) + EPS);
                const float r = rs * rh;
                bf16_t* kp = k + row * (NH * QKH) + u.pn * QKH;
                { const f32x4 v0 = acc[ai][0][m][0] * g0 * r, v1 = acc[ai][0][m][1] * g1 * r;
                  u32x4 w; w.x = cvt_pk_bf16(v0[0], v0[1]); w.y = cvt_pk_bf16(v0[2], v0[3]); w.z = cvt_pk_bf16(v1[0], v1[1]); w.w = cvt_pk_bf16(v1[2], v1[3]); *(u32x4*)(kp + c0) = w; }
                { const f32x4 v0 = acc[ai][1][m][0] * rs, v1 = acc[ai][1][m][1] * rs;
                  u32x4 w; w.x = cvt_pk_bf16(v0[0], v0[1]); w.y = cvt_pk_bf16(v0[2], v0[3]); w.z = cvt_pk_bf16(v1[0], v1[1]); w.w = cvt_pk_bf16(v1[2], v1[3]); *(u32x4*)(v + row * (NH * VH) + u.pn * VH + c0) = w; }
                { const unsigned xa = xas[ai][m], xb = xbs[ai][m];
                  const f32x4 cs = css[ai][m];
                  const float x10 = bf_lo(xa) * gx0 * rh, x11 = bf_hi(xa) * gx1 * rh, x20 = bf_lo(xb) * gy0 * rh, x21 = bf_hi(xb) * gy1 * rh;
                  u32x2 w; w.x = cvt_pk_bf16(x10 * cs[0] - x20 * cs[1], x10 * cs[1] + x20 * cs[0]); w.y = cvt_pk_bf16(x11 * cs[2] - x21 * cs[3], x11 * cs[3] + x21 * cs[2]);
                  *(u32x2*)(kp + 128 + 2 * i0) = w; } }
    }
};
struct EpiOut {
    const float* x; bf16_t* h1b; float* ssq;
    __device__ __forceinline__ void operator()(const f32x4 (&acc)[2][2][4][2], const Unit& u, int wr, int wc, int fr, int fq) const {
        asm volatile("" : "+v"(fr), "+v"(fq));
        const int row0 = u.pm * BM + wr * 64 + fr, col0 = u.pn * BM + wc * 32 + 8 * fq;
#pragma unroll
        for (int ai = 0; ai < 2; ++ai) {
            f32x4 xv[4][2][2];
#pragma unroll
            for (int m = 0; m < 4; ++m) { const size_t off = (size_t)(row0 + ai * HALF + m * 16) * DM + col0;
#pragma unroll
                for (int bj = 0; bj < 2; ++bj) { xv[m][bj][0] = __builtin_nontemporal_load((const f32x4*)(x + off + bj * HALF)); xv[m][bj][1] = __builtin_nontemporal_load((const f32x4*)(x + off + bj * HALF + 4)); } }
            asm volatile("" ::: "memory");
#pragma unroll
            for (int m = 0; m < 4; ++m) { const int row = row0 + ai * HALF + m * 16; const size_t off = (size_t)row * DM + col0; float ss = 0.f;
#pragma unroll
                for (int bj = 0; bj < 2; ++bj) { const f32x4 v0 = acc[ai][bj][m][0] + xv[m][bj][0], v1 = acc[ai][bj][m][1] + xv[m][bj][1];
                    u32x4 w; w.x = cvt_pk_bf16(v0[0], v0[1]); w.y = cvt_pk_bf16(v0[2], v0[3]); w.z = cvt_pk_bf16(v1[0], v1[1]); w.w = cvt_pk_bf16(v1[2], v1[3]);
                    *(u32x4*)(h1b + off + bj * HALF) = w;
                    ss += (v0[0] * v0[0] + v0[1] * v0[1]) + (v0[2] * v0[2] + v0[3] * v0[3]) + (v1[0] * v1[0] + v1[1] * v1[1]) + (v1[2] * v1[2] + v1[3] * v1[3]); }
                ss += __shfl_xor(ss, 16); ss += __shfl_xor(ss, 32);
                if (fq == 0) ssq[(size_t)(u.pn * 4 + wc) * NTOK + row] = ss; }
        }
    }
};
struct EpiSwiglu {
    unsigned char* act; const float* bgu; LAS unsigned char* blds;
    __device__ __forceinline__ void operator()(const f32x4 (&acc)[2][2][4][2], const Unit& u, int wr, int wc, int fr, int fq) const {
        asm volatile("" : "+v"(fr), "+v"(fq));
        const int rt0 = wr * 64 + fr, j0 = wc * 32 + 8 * fq;
        const LAS float* bl = (const LAS float*)(blds + MoeSched::BIAS_OFF + u.par * 1024) + j0;
        const f32x4 bg0 = *(const LAS f32x4*)bl, bg1 = *(const LAS f32x4*)(bl + 4), bu0 = *(const LAS f32x4*)(bl + HALF), bu1 = *(const LAS f32x4*)(bl + HALF + 4);
        constexpr float WI = 1.f / W8_SCALE;
#pragma unroll
        for (int ai = 0; ai < 2; ++ai)
#pragma unroll
            for (int m = 0; m < 4; ++m) { const int rt = rt0 + ai * HALF + m * 16;
                float o[8];
#pragma unroll
                for (int n = 0; n < 2; ++n) { const f32x4 g4 = acc[ai][0][m][n] * WI + (n ? bg1 : bg0), u4 = acc[ai][1][m][n] * WI + (n ? bu1 : bu0);
#pragma unroll
                    for (int i = 0; i < 4; i += 2) {
                        f32x2 g, uu; g.x = fminf(g4[i], SWI_LIMIT); g.y = fminf(g4[i + 1], SWI_LIMIT);
                        uu.x = __builtin_amdgcn_fmed3f(u4[i], -SWI_LIMIT, SWI_LIMIT); uu.y = __builtin_amdgcn_fmed3f(u4[i + 1], -SWI_LIMIT, SWI_LIMIT);
                        const f32x2 t = g * (-SWI_ALPHA * 1.4426950408889634f);
                        f32x2 e; e.x = __builtin_amdgcn_exp2f(t.x); e.y = __builtin_amdgcn_exp2f(t.y);
                        const f32x2 d = e + 1.f;
                        f32x2 sg; sg.x = __builtin_amdgcn_rcpf(d.x); sg.y = __builtin_amdgcn_rcpf(d.y);
                        const f32x2 r = (uu * ACT8_SCALE + ACT8_SCALE) * (g * sg);
                        o[n * 4 + i] = r.x; o[n * 4 + i + 1] = r.y; } }
                u32x2 w; w.x = pk4_fp8_nc(o[0], o[1], o[2], o[3]); w.y = pk4_fp8_nc(o[4], o[5], o[6], o[7]);
                *(u32x2*)(act + ((size_t)u.pm * BM + rt) * DFF + u.pn * HALF + j0) = w; }
    }
};
struct EpiDown {
    unsigned char* oslot; const float* bdn; unsigned char* dummy; LAS unsigned char* lds;
    __device__ __forceinline__ void operator()(const f32x4 (&acc)[2][2][4][2], const Unit& u, int wr, int wc, int fr, int fq) const {
        asm volatile("" : "+v"(fr), "+v"(fq));
        const int rt0 = wr * 64 + fr, col0 = u.pn * BM + wc * 32 + 8 * fq;
        const LAS float* bl = (const LAS float*)(lds + MoeSched::BIAS_OFF + u.par * 1024) + wc * 32 + 8 * fq;
        f32x4 bv[2][2]; bv[0][0] = *(const LAS f32x4*)bl; bv[0][1] = *(const LAS f32x4*)(bl + 4); bv[1][0] = *(const LAS f32x4*)(bl + HALF); bv[1][1] = *(const LAS f32x4*)(bl + HALF + 4);
        constexpr float WI = 1.f / (W8_SCALE * ACT8_SCALE);
#pragma unroll
        for (int ai = 0; ai < 2; ++ai)
#pragma unroll
            for (int m = 0; m < 4; ++m) { const int rt = rt0 + ai * HALF + m * 16, p = u.p0 + rt;
                const u32x2 mt = *(const LAS u32x2*)(lds + MoeSched::META_OFF + u.par * 2048 + rt * 8);
                const bool valid = p < u.cnt; const int slot = valid ? (int)mt.x : 0; const unsigned gbits = mt.y; const float g = __builtin_bit_cast(float, gbits);
                unsigned char* rowp = valid ? oslot + (size_t)slot * DM + col0 : dummy + col0;
                const float gs = g * OS8_SCALE;
#pragma unroll
                for (int bj = 0; bj < 2; ++bj) { const f32x4 v0 = (acc[ai][bj][m][0] * WI + bv[bj][0]) * gs, v1 = (acc[ai][bj][m][1] * WI + bv[bj][1]) * gs;
                    u32x2 w; w.x = pk4_fp8(v0[0], v0[1], v0[2], v0[3]); w.y = pk4_fp8(v1[0], v1[1], v1[2], v1[3]);
                    *(u32x2*)(rowp + bj * HALF) = w; } }
    }
};
struct EpiNull {
    float* dummy;
    __device__ __forceinline__ void operator()(const f32x4 (&acc)[2][2][4][2], const Unit& u, int wr, int wc, int fr, int fq) const {
        float sacc = 0.f;
#pragma unroll
        for (int ai = 0; ai < 2; ++ai)
#pragma unroll
            for (int bj = 0; bj < 2; ++bj)
#pragma unroll
                for (int m = 0; m < 4; ++m)
#pragma unroll
                    for (int n = 0; n < 2; ++n) sacc += (acc[ai][bj][m][n][0] + acc[ai][bj][m][n][1]) + (acc[ai][bj][m][n][2] + acc[ai][bj][m][n][3]);
        dummy[(size_t)blockIdx.x * 512 + threadIdx.x] = sacc;
    }
};
}

namespace att {
constexpr int LDQ = NH * QKH, LDK = NH * QKH, LDV = NH * VH, LDO = DM;
constexpr int KT_BYTES = 64 * QKH * 2, VT_BYTES = 64 * VH * 2;
constexpr int L_K = 0, L_V = 3 * KT_BYTES, L_WS = L_V + 3 * VT_BYTES, L_END = L_WS + 8 * 256;
constexpr float THRL = 8.f * 1.4426950408889634f;
__device__ __forceinline__ int crow(int r, int hi) { return (r & 3) + 8 * (r >> 2) + 4 * hi; }
#define SBAR() __builtin_amdgcn_sched_barrier(0)
__device__ __forceinline__ int v_rd_base(int lane) { return ((lane & 3) << 3) | (((lane >> 2) & 3) << 6) | (((lane >> 4) & 1) << 5) | (((lane >> 5) & 1) << 8); }
constexpr int v_rd_off(int d0, int ks, int half) { return d0 * 512 + ks * 4096 + half * 2048; }
template <int OFF> __device__ __forceinline__ s16x4 tr_read(int vb) {
    s16x4 r; asm volatile("ds_read_b64_tr_b16 %0, %1 offset:%2" : "=&v"(r) : "v"(vb), "i"(OFF) : "memory"); return r;
}
template <int D0> __device__ __forceinline__ void pv_one(f32x16& od, int vb, bf16x8 pa0, bf16x8 pa1, bf16x8 pa2, bf16x8 pa3) {
    const s16x4 l0 = tr_read<v_rd_off(D0, 0, 0)>(vb), h0 = tr_read<v_rd_off(D0, 0, 1)>(vb), l1 = tr_read<v_rd_off(D0, 1, 0)>(vb), h1 = tr_read<v_rd_off(D0, 1, 1)>(vb);
    const s16x4 l2 = tr_read<v_rd_off(D0, 2, 0)>(vb), h2 = tr_read<v_rd_off(D0, 2, 1)>(vb), l3 = tr_read<v_rd_off(D0, 3, 0)>(vb), h3 = tr_read<v_rd_off(D0, 3, 1)>(vb);
    asm volatile("s_waitcnt lgkmcnt(0)" ::: "memory"); SBAR();
#define PK(L, H) (bf16x8){L[0], L[1], L[2], L[3], H[0], H[1], H[2], H[3]}
    od = __builtin_amdgcn_mfma_f32_32x32x16_bf16(pa0, PK(l0, h0), od, 0, 0, 0);
    od = __builtin_amdgcn_mfma_f32_32x32x16_bf16(pa1, PK(l1, h1), od, 0, 0, 0);
    od = __builtin_amdgcn_mfma_f32_32x32x16_bf16(pa2, PK(l2, h2), od, 0, 0, 0);
    od = __builtin_amdgcn_mfma_f32_32x32x16_bf16(pa3, PK(l3, h3), od, 0, 0, 0);
#undef PK
}
__device__ __forceinline__ void glds16(const void* gsrc, LAS unsigned char* dst) {
    __builtin_amdgcn_global_load_lds((const unsigned*)gsrc, (LAS unsigned*)dst, 16, 0, 0);
}
__device__ __forceinline__ void attn_unit(int b, int h, int qb, const bf16_t* Q, const bf16_t* Kg, const bf16_t* Vg, bf16_t* O, LAS unsigned char* lds) {
    const int tid = threadIdx.x, wid = __builtin_amdgcn_readfirstlane(tid >> 6), lane = tid & 63, r32 = lane & 31, hi = lane >> 5;
    const int grp = wid >> 2;
    const size_t tok0 = (size_t)b * SEQ;
    bf16x8 qr[12];
    { const bf16_t* Qw = Q + (tok0 + (size_t)qb * 256 + wid * 32 + r32) * LDQ + h * QKH + hi * 8;
#pragma unroll
      for (int d0 = 0; d0 < 12; ++d0) qr[d0] = *(const bf16x8*)(Qw + d0 * 16); }
    unsigned koff[3], voff[2];
#pragma unroll
    for (int i = 0; i < 3; ++i) { const int G = 64 * (wid + 8 * i) + lane, row = G / 24, cgs = G % 24, cg = (cgs & ~7) | ((cgs & 7) ^ ((row >> 1) & 7)); koff[i] = (unsigned)(row * LDK * 2 + cg * 16); }
#pragma unroll
    for (int i = 0; i < 2; ++i) { const int p = wid + 8 * i, sub = 2 * p + (lane >> 5), kkh = sub >> 2, cblk = sub & 3, kkl = (lane & 31) >> 2, cl = (lane & 3) * 8, kk = kkh * 8 + kkl;
        const int k = (kk & ~0xC) | ((kk & 4) << 1) | ((kk & 8) >> 1), c = cblk * 32 + cl; voff[i] = (unsigned)(k * LDV * 2 + c * 2); }
    const __amdgpu_buffer_rsrc_t rK = __builtin_amdgcn_make_buffer_rsrc((void*)(Kg + tok0 * LDK + h * QKH), 0, -1, 0x00020000), rV = __builtin_amdgcn_make_buffer_rsrc((void*)(Vg + tok0 * LDV + h * VH), 0, -1, 0x00020000);
#define ATT_DMA(j, buf) do { \
        _Pragma("unroll") for (int i_ = 0; i_ < 3; ++i_) __builtin_amdgcn_raw_ptr_buffer_load_lds(rK, (LAS void*)(lds + L_K + (buf) * KT_BYTES + (wid + 8 * i_) * 1024), 16, koff[i_], (unsigned)(j) * (64u * LDK * 2u), 0, 0); \
        _Pragma("unroll") for (int i_ = 0; i_ < 2; ++i_) __builtin_amdgcn_raw_ptr_buffer_load_lds(rV, (LAS void*)(lds + L_V + (buf) * VT_BYTES + (wid + 8 * i_) * 1024), 16, voff[i_], (unsigned)(j) * (64u * LDV * 2u), 0, 0); } while (0)
#define ATT_BAR() do { asm volatile("" ::: "memory"); __builtin_amdgcn_s_barrier(); asm volatile("" ::: "memory"); } while (0)
    const int swz = (r32 >> 1) & 7; int kx[4];
#pragma unroll
    for (int dd = 0; dd < 4; ++dd) kx[dd] = r32 * (QKH * 2) + (((2 * dd + hi) ^ swz) << 4);
    LAS float* ws = (LAS float*)(lds + L_WS) + wid * 64; LAS float* li_l = ws; LAS float* al_l = ws + 32;
    const int vb0 = L_V + v_rd_base(lane);
    float m_reg = -1e30f, l_reg = 0.f; f32x16 o[4];
#pragma unroll
    for (int d = 0; d < 4; ++d)
#pragma unroll
        for (int r = 0; r < 16; ++r) o[d][r] = 0.f;
    const int NT = 4 * qb + 4, my_last = 4 * qb + (wid >> 1);
    ATT_DMA(0, 0); ATT_DMA(1, 1);
    asm volatile("s_waitcnt vmcnt(5)" ::: "memory"); ATT_BAR();
    if (grp == 1) ATT_BAR();
    int kb = 0, nb = 2;
    for (int j = 0; j < NT; ++j) {
        const bool live = (j <= my_last), more = (j + 2 < NT);
        f32x16 p0, p1;
        if (grp == 1 && more) ATT_DMA(j + 2, nb);
        if (live) {
            const LAS unsigned char* Ks = lds + L_K + kb * KT_BYTES;
#pragma unroll
            for (int r = 0; r < 16; ++r) { p0[r] = 0.f; p1[r] = 0.f; }
#pragma unroll
            for (int d0 = 0; d0 < 12; ++d0) {
                const bf16x8 b0 = *(const LAS bf16x8*)(Ks + kx[d0 & 3] + (d0 >> 2) * 128);
                const bf16x8 b1 = *(const LAS bf16x8*)(Ks + kx[d0 & 3] + (d0 >> 2) * 128 + 32 * QKH * 2);
                p0 = __builtin_amdgcn_mfma_f32_32x32x16_bf16(b0, qr[d0], p0, 0, 0, 0);
                p1 = __builtin_amdgcn_mfma_f32_32x32x16_bf16(b1, qr[d0], p1, 0, 0, 0);
            }
        }
        if (grp == 1) { if (j + 1 < NT) { if (more) asm volatile("s_waitcnt vmcnt(5)" ::: "memory"); else asm volatile("s_waitcnt vmcnt(0)" ::: "memory"); } }
        ATT_BAR();
        if (grp == 0 && more) ATT_DMA(j + 2, nb);
        if (live) {
            float pmax = p0[0];
#pragma unroll
            for (int r = 1; r < 16; ++r) pmax = fmaxf(pmax, p0[r]);
#pragma unroll
            for (int r = 0; r < 16; ++r) pmax = fmaxf(pmax, p1[r]);
            { auto rr = __builtin_amdgcn_permlane32_swap(__float_as_uint(pmax), __float_as_uint(pmax), false, false);
              pmax = fmaxf(__uint_as_float(rr[0]), __uint_as_float(rr[1])); }
            float mn, alpha;
            if (__builtin_expect(__all(pmax - m_reg <= THRL), 1)) { mn = m_reg; alpha = 1.f; }
            else { mn = fmaxf(m_reg, pmax); alpha = __builtin_amdgcn_exp2f(m_reg - mn); m_reg = mn; }
#pragma unroll
            for (int r = 0; r < 16; ++r) { p0[r] = __builtin_amdgcn_exp2f(p0[r] - mn); p1[r] = __builtin_amdgcn_exp2f(p1[r] - mn); }
            float ps = 0.f;
#pragma unroll
            for (int r = 0; r < 16; ++r) ps += p0[r];
#pragma unroll
            for (int r = 0; r < 16; ++r) ps += p1[r];
            { auto rr = __builtin_amdgcn_permlane32_swap(__float_as_uint(ps), __float_as_uint(ps), false, false);
              ps = __uint_as_float(rr[0]) + __uint_as_float(rr[1]); }
            l_reg = l_reg * alpha + ps;
            if (__any(alpha < 1.f)) { if (hi == 0) al_l[r32] = alpha; asm volatile("s_waitcnt lgkmcnt(0)" ::: "memory");
#pragma unroll
                for (int r = 0; r < 16; ++r) { const float a = al_l[crow(r, hi)];
#pragma unroll
                    for (int d = 0; d < 4; ++d) o[d][r] *= a; } }
            bf16x8 pa0, pa1, pa2, pa3;
#define PK4(P, BASE, OUT) do { unsigned a0 = cvt_pk_bf16(P[BASE + 0], P[BASE + 1]), a1 = cvt_pk_bf16(P[BASE + 2], P[BASE + 3]);   \
    unsigned b0_ = cvt_pk_bf16(P[BASE + 4], P[BASE + 5]), b1_ = cvt_pk_bf16(P[BASE + 6], P[BASE + 7]);                              \
    auto r0 = __builtin_amdgcn_permlane32_swap(a0, b0_, false, false); auto r1 = __builtin_amdgcn_permlane32_swap(a1, b1_, false, false); \
    u32x4 w = {r0[0], r1[0], r0[1], r1[1]}; OUT = __builtin_bit_cast(bf16x8, w); } while (0)
            PK4(p0, 0, pa0); PK4(p0, 8, pa1); PK4(p1, 0, pa2); PK4(p1, 8, pa3);
#undef PK4
            const int vb = vb0 + kb * VT_BYTES;
            pv_one<0>(o[0], vb, pa0, pa1, pa2, pa3); pv_one<1>(o[1], vb, pa0, pa1, pa2, pa3); pv_one<2>(o[2], vb, pa0, pa1, pa2, pa3); pv_one<3>(o[3], vb, pa0, pa1, pa2, pa3);
        }
        if (grp == 0) { if (j + 1 < NT) { if (more) asm volatile("s_waitcnt vmcnt(5)" ::: "memory"); else asm volatile("s_waitcnt vmcnt(0)" ::: "memory"); } }
        ATT_BAR();
        kb = (kb == 2) ? 0 : kb + 1; nb = (nb == 2) ? 0 : nb + 1;
    }
    if (grp == 0) ATT_BAR();
    if (hi == 0) li_l[r32] = l_reg; asm volatile("s_waitcnt lgkmcnt(0)" ::: "memory");
    bf16_t* Ow = O + (tok0 + (size_t)qb * 256 + wid * 32) * LDO + h * VH;
#pragma unroll
    for (int r = 0; r < 16; ++r) { const int orow = crow(r, hi); const float rl = __builtin_amdgcn_rcpf(li_l[orow]);
#pragma unroll
        for (int d0 = 0; d0 < 4; ++d0) Ow[(size_t)orow * LDO + d0 * 32 + r32] = (bf16_t)f2bf(o[d0][r] * rl); }
    asm volatile("s_waitcnt lgkmcnt(0)" ::: "memory"); ATT_BAR();
#undef ATT_DMA
#undef ATT_BAR
}
#undef SBAR
}

#define XB_TMO      128
#define XB_XCNT(j)  (256  + 64 * (j))
#define XB_XSUB(j)  (1280 + 64 * (j))
#define XB_XGEN(j)  (2304 + 64 * (j))
#define XB_TOP      3328
#define XB_TOPGEN   3392
#define XCD_BAR_WORDS 3456
#define XB_SPIN_CAP (1u << 18)
__device__ __forceinline__ unsigned xb_ld(unsigned* p)              { return __hip_atomic_load(p, __ATOMIC_RELAXED, __HIP_MEMORY_SCOPE_AGENT); }
__device__ __forceinline__ unsigned xb_add(unsigned* p, unsigned v) { return __hip_atomic_fetch_add(p, v, __ATOMIC_RELAXED, __HIP_MEMORY_SCOPE_AGENT); }
__device__ __forceinline__ unsigned xb_xcc_id() { return (unsigned)__builtin_amdgcn_s_getreg((3 << 11) | 20) & 0xFu; }
#define XB_SPIN(cond, bar) do { unsigned _sp = 0; while (cond) { __builtin_amdgcn_s_sleep(1); \
    if ((++_sp & 255u) == 0u) { if (xb_ld(&(bar)[XB_TMO])) break; if (_sp > XB_SPIN_CAP) { atomicAdd(&(bar)[XB_TMO], 1u); break; } } } } while (0)
struct XcdBarrier { unsigned* bar; unsigned x; volatile LAS unsigned* st; };
__device__ __forceinline__ XcdBarrier xcd_barrier_post(unsigned* bar, volatile LAS unsigned* st) {
    XcdBarrier b; b.bar = bar; b.x = xb_xcc_id(); b.st = st;
    if (threadIdx.x == 0) (void)xb_add(&bar[XB_XCNT(b.x)], 1u);
    return b;
}
__device__ __forceinline__ void xcd_barrier_complete(unsigned* bar, unsigned x, unsigned& nloc, unsigned& nx) {
    const unsigned G = gridDim.x * gridDim.y * gridDim.z;
    unsigned sum, cnt, mine, sp = 0u;
    for (;;) {
        sum = 0u; cnt = 0u; mine = 0u;
#pragma unroll
        for (unsigned j = 0; j < 16; ++j) { const unsigned c = xb_ld(&bar[XB_XCNT(j)]); sum += c; cnt += (c > 0u) ? 1u : 0u; mine = (j == x) ? c : mine; }
        if (sum == G) break;
        __builtin_amdgcn_s_sleep(1);
        if ((++sp & 255u) == 0u) { if (xb_ld(&bar[XB_TMO])) break; if (sp > XB_SPIN_CAP) { atomicAdd(&bar[XB_TMO], 1u); break; } }
    }
    nloc = mine > 0u ? mine : 1u; nx = cnt > 0u ? cnt : 1u;
}
__device__ __forceinline__ void xcd_barrier(const XcdBarrier& b) {
    asm volatile("s_waitcnt vmcnt(0)" ::: "memory");
    __syncthreads();
    if (threadIdx.x == 0) {
        unsigned* bar = b.bar;
        __builtin_amdgcn_s_waitcnt(0);
        unsigned nloc = b.st[0], nx = b.st[1];
        if (nloc == 0u) { xcd_barrier_complete(bar, b.x, nloc, nx); b.st[0] = nloc; b.st[1] = nx; }
        const unsigned old = xb_add(&bar[XB_XSUB(b.x)], 1u);
        const unsigned gen = old / nloc;
        if (old + 1u == (gen + 1u) * nloc) {
            __builtin_amdgcn_fence(__ATOMIC_RELEASE, "agent");
            asm volatile("s_waitcnt vmcnt(0)" ::: "memory");
            const unsigned og = xb_add(&bar[XB_TOP], 1u);
            const unsigned tg = og / nx;
            if (og + 1u == (tg + 1u) * nx) xb_add(&bar[XB_TOPGEN], 1u);
            else XB_SPIN(xb_ld(&bar[XB_TOPGEN]) == tg, bar);
            __builtin_amdgcn_fence(__ATOMIC_ACQUIRE, "agent");
            xb_add(&bar[XB_XGEN(b.x)], 1u);
            asm volatile("s_waitcnt vmcnt(0)" ::: "memory");
        } else {
            XB_SPIN(xb_ld(&bar[XB_XGEN(b.x)]) == gen, bar);
            __builtin_amdgcn_fence(__ATOMIC_ACQUIRE, "agent");
            asm volatile("s_waitcnt vmcnt(0)" ::: "memory");
        }
    }
    __syncthreads();
}

constexpr int NWAVES = 8;
constexpr int N_LAUNCHES = MK_N_LAUNCHES;
constexpr int N_PHASES = 10;
struct Args { const float* in[18]; float* out; unsigned char* ws; int ph_lo, ph_hi; };

__device__ __forceinline__ void p0_transpose_item(const float* W, int K, int N, bf16_t* WT, int drow0, const float* kscale, LAS unsigned* scr, int k0, int n0, int lane, bool ileave = false) {
    const int g = lane >> 4, l16 = lane & 15;
    f32x4 v[16];
#pragma unroll
    for (int i = 0; i < 16; ++i) { const int kk = (i >> 1) * 8 + g * 2 + (i & 1); v[i] = __builtin_nontemporal_load((const f32x4*)(W + (size_t)(k0 + kk) * N + n0 + 4 * l16)); }
    if (kscale) {
#pragma unroll
        for (int i = 0; i < 16; ++i) { const int kk = (i >> 1) * 8 + g * 2 + (i & 1); v[i] = v[i] * kscale[k0 + kk]; } }
#pragma unroll
    for (int j = 0; j < 8; ++j) { const int kp = j * 4 + g;
#pragma unroll
        for (int c = 0; c < 4; ++c) scr[(4 * l16 + c) * 33 + kp] = cvt_pk_bf16(v[2 * j][c], v[2 * j + 1][c]); }
    LDS_WAIT(); asm volatile("" ::: "memory");
    const int c8 = lane & 7;
#pragma unroll
    for (int jj = 0; jj < 8; ++jj) { const int n = jj * 8 + (lane >> 3); const LAS unsigned* t = scr + n * 33 + 4 * c8;
        u32x4 o; o.x = t[0]; o.y = t[1]; o.z = t[2]; o.w = t[3];
        const int dn = ileave ? ((n < 32) ? 2 * n : 2 * (n - 32) + 1) : n;
        *(u32x4*)(WT + (size_t)(drow0 + dn) * K + k0 + 8 * c8) = o; }
    LDS_WAIT(); asm volatile("" ::: "memory");
}

constexpr int MOE_GU1 = (DM / 128) * (2 * DFF / 64), MOE_GU = NE * MOE_GU1, MOE_DN1 = (DFF / 128) * (DM / 64), MOE_DN = NE * MOE_DN1, MOE_ITEMS = MOE_GU + MOE_DN;
struct MoeItem { const float* W; unsigned char* WT; int N, k0, n0, drow0, has_ks; };
__device__ __forceinline__ MoeItem moe_item_of(int r, const float* w_gate_up, const float* w_down, unsigned char* Wgu_t, unsigned char* Wdn_t) {
    MoeItem m;
    if (r < MOE_GU) { const int e = r / MOE_GU1, q = r % MOE_GU1, nblk = 2 * DFF / 64, kb = q / nblk, nb = q % nblk, n0 = nb * 64, j = n0 & (DFF - 1), up = n0 >= DFF;
        m.W = w_gate_up + (size_t)e * DM * 2 * DFF; m.WT = Wgu_t + (size_t)e * 2 * DFF * DM; m.N = 2 * DFF; m.k0 = kb * 128; m.n0 = n0; m.drow0 = (j >> 7) * 256 + (j & 127) + (up ? 128 : 0); m.has_ks = 1; }
    else { r -= MOE_GU; const int e = r / MOE_DN1, q = r % MOE_DN1, nblk = DM / 64, kb = q / nblk, nb = q % nblk;
        m.W = w_down + (size_t)e * DFF * DM; m.WT = Wdn_t + (size_t)e * DM * DFF; m.N = DM; m.k0 = kb * 128; m.n0 = nb * 64; m.drow0 = nb * 64; m.has_ks = 0; }
    return m;
}
__device__ __forceinline__ void moe_load_half(const MoeItem& m, int h, const float* ks, int lane, f32x4 (&v)[16], f32x4 (&sc)[4]) {
    const int g = lane >> 4, l16 = lane & 15;
#pragma unroll
    for (int j = 0; j < 4; ++j) sc[j] = *(const f32x4*)(ks + m.k0 + 64 * h + 16 * j + 4 * g);
#pragma unroll
    for (int i = 0; i < 16; ++i) { const int kk = 64 * h + (i >> 2) * 16 + g * 4 + (i & 3); v[i] = __builtin_nontemporal_load((const f32x4*)(m.W + (size_t)(m.k0 + kk) * m.N + m.n0 + 4 * l16)); }
}
__device__ __forceinline__ void moe_pack_half(const MoeItem& m, int h, int lane, const f32x4 (&v)[16], const f32x4 (&sc)[4], LAS unsigned* scr) {
    const int g = lane >> 4, l16 = lane & 15;
#pragma unroll
    for (int j = 0; j < 4; ++j) { const int kd = (4 * h + j) * 4 + g;
        const f32x4 s = m.has_ks ? sc[j] * W8_SCALE : (f32x4){W8_SCALE, W8_SCALE, W8_SCALE, W8_SCALE};
#pragma unroll
        for (int c = 0; c < 4; ++c) scr[(4 * l16 + c) * 33 + kd] = pk4_fp8(v[4 * j][c] * s[0], v[4 * j + 1][c] * s[1], v[4 * j + 2][c] * s[2], v[4 * j + 3][c] * s[3]); }
}
__device__ __forceinline__ void moe_store(const MoeItem& m, int lane, LAS unsigned* scr) {
    LDS_WAIT(); asm volatile("" ::: "memory");
    const int c8 = lane & 7;
#pragma unroll
    for (int jj = 0; jj < 8; ++jj) { const int n = jj * 8 + (lane >> 3); const LAS unsigned* t = scr + n * 33 + 4 * c8;
        u32x4 o; o.x = t[0]; o.y = t[1]; o.z = t[2]; o.w = t[3];
        *(u32x4*)(m.WT + (size_t)(m.drow0 + n) * 1024 + m.k0 + 16 * c8) = o; }
    LDS_WAIT(); asm volatile("" ::: "memory");
}
__device__ __forceinline__ void moe_stream(int first, int stride, const float* w_gate_up, const float* w_down, unsigned char* Wgu_t, unsigned char* Wdn_t, const float* ks, LAS unsigned* scr, int lane) {
    if (first >= MOE_ITEMS) return;
    f32x4 va[16], vb[16], sa[4], sb[4];
    int it = first;
    MoeItem cur = moe_item_of(it, w_gate_up, w_down, Wgu_t, Wdn_t);
    moe_load_half(cur, 0, ks, lane, va, sa); moe_load_half(cur, 1, ks, lane, vb, sb);
    for (;;) {
        const int nx = it + stride; const bool more = nx < MOE_ITEMS;
        const MoeItem nxt = moe_item_of(more ? nx : it, w_gate_up, w_down, Wgu_t, Wdn_t);
        moe_pack_half(cur, 0, lane, va, sa, scr);
        moe_load_half(nxt, 0, ks, lane, va, sa);
        moe_pack_half(cur, 1, lane, vb, sb, scr);
        moe_load_half(nxt, 1, ks, lane, vb, sb);
        moe_store(cur, lane, scr);
        if (!more) break;
        cur = nxt; it = nx;
    }
}

template <int PHMASK> __global__ void __launch_bounds__(NWAVES * 64, 2) fwd_kernel_t(Args args) {
    extern __shared__ __attribute__((aligned(16))) unsigned char lds_raw[];
    LAS unsigned char* lds = (LAS unsigned char*)lds_raw;
    volatile LAS unsigned* MISC = (volatile LAS unsigned*)(lds + MISC_OFF);
    const int tid = threadIdx.x, lane = tid & 63, wave = __builtin_amdgcn_readfirstlane(tid >> 6);
    const int G = gridDim.x; const int bx = blockIdx.x; const int vcu = (G % 8 == 0) ? (bx % 8) * (G / 8) + bx / 8 : bx;
    unsigned char* ws = args.ws;
    unsigned* ctl = (unsigned*)(ws + WS_CTL);
    const float* x = args.in[0]; const float* norm_mix = args.in[1]; const float* w_in = args.in[2]; const float* conv_w = args.in[3];
    const float* q_norm = args.in[4]; const float* w_uq = args.in[5]; const float* kv_norm = args.in[6]; const float* w_ukv = args.in[7];
    const float* q_head_norm = args.in[8]; const float* k_head_norm = args.in[9]; const float* w_o = args.in[10]; const float* norm_ffn = args.in[11];
    const float* w_router = args.in[12]; const float* b_router = args.in[13]; const float* w_gate_up = args.in[14]; const float* b_gate_up = args.in[15];
    const float* w_down = args.in[16]; const float* b_down = args.in[17];
    float* out = args.out;
    f32x2* rope_t = (f32x2*)(ws + WS_ROPE);
    bf16_t* WrH = (bf16_t*)(ws + WS_WRH); bf16_t* WrL = (bf16_t*)(ws + WS_WRL);
    bf16_t* Win_t = (bf16_t*)(ws + WS_WIN); bf16_t* Wuq_t = (bf16_t*)(ws + WS_WUQ); bf16_t* Wukv_t = (bf16_t*)(ws + WS_WUKV); bf16_t* Wo_t = (bf16_t*)(ws + WS_WO);
    float* ssq = (float*)(ws + WS_SSQ); float* rs2 = (float*)(ws + WS_RS2); float* gate = (float*)(ws + WS_GATE); int* tos = (int*)(ws + WS_TOS);
    unsigned char* Wgu_t = ws + WS_WGU; unsigned char* Wdn_t = ws + WS_WDN;
    unsigned char* hq = ws + WS_HB;
    bf16_t* qb_ = (bf16_t*)(ws + WS_Q); bf16_t* kb_ = (bf16_t*)(ws + WS_K); bf16_t* vb_ = (bf16_t*)(ws + WS_V); bf16_t* mix = (bf16_t*)(ws + WS_MIX);
    bf16_t* oslot = (bf16_t*)(ws + WS_OSLOT); bf16_t* hn = (bf16_t*)(ws + WS_HN); bf16_t* pbuf = (bf16_t*)(ws + WS_PB); bf16_t* qraw = (bf16_t*)(ws + WS_QRAW); bf16_t* kvraw = (bf16_t*)(ws + WS_KVRAW);
    unsigned char* act = ws + WS_ACT;

    for (int u = tid; u < (LDS_BYTES - MISC_OFF) / 4; u += NWAVES * 64) ((LAS unsigned*)(lds + MISC_OFF))[u] = 0u;
    __syncthreads();
    XcdBarrier bar; bar.bar = ctl + CW_BAR; bar.x = 0; bar.st = nullptr;
    if (N_LAUNCHES == 1) bar = xcd_barrier_post(ctl + CW_BAR, MISC + 8);
#define GRID_BAR() do { if (N_LAUNCHES == 1) xcd_barrier(bar); } while (0)
    const int lo = args.ph_lo, hi = args.ph_hi;
#define IN(k) (((PHMASK >> (k)) & 1) && lo <= (k) && (k) < hi)
#define BOTH(k) (IN(k) && IN((k) + 1))
    const int gw = vcu * NWAVES + wave, NGW = G * NWAVES;

    const int gemm_wgs = (G == 256) ? 168 : G; const bool split = gemm_wgs < G;
    constexpr int I_GU = MOE_GU, I_DN = MOE_DN;
    if (IN(0)) {
        LAS unsigned* scr = (LAS unsigned*)(lds + wave * 16384);
        constexpr int I_IN = (DM / 64) * (NPROJ / 64), I_UQ = (QL / 64) * (768 / 64), I_UKV = (KVL / 64) * (1024 / 64), I_O = (DM / 64) * (DM / 64);
        constexpr int NITEMS = I_IN + I_UQ + I_UKV + I_O + I_GU + I_DN;
        if (!split) moe_stream(gw, NGW, w_gate_up, w_down, Wgu_t, Wdn_t, norm_ffn, scr, lane);
        for (int it = gw; it < NITEMS - I_GU - I_DN; it += NGW) {
            int r = it;
            if (r < I_IN) { const int nblk = NPROJ / 64, kb = r / nblk, nb = r % nblk, n0 = nb * 64;
                const int d0 = (n0 < 512) ? n0 : (n0 < 1024 ? 512 + ((n0 - 512) >> 7) * 256 + ((n0 - 512) & 127) : (n0 < 1536 ? 512 + ((n0 - 1024) >> 7) * 256 + 128 + ((n0 - 1024) & 127)
                             : (n0 < 1920 ? n0 + 256 : (n0 < 2176 ? n0 - 384 : n0))));
                p0_transpose_item(w_in, DM, NPROJ, Win_t, d0, nullptr, scr, kb * 64, n0, lane); continue; } r -= I_IN;
            if (r < I_UQ) { const int nblk = 768 / 64, kb = r / nblk, nb = r % nblk, h = nb / 3, part = nb % 3;
                p0_transpose_item(w_uq, QL, 768, Wuq_t, h * 256 + part * 64, q_norm, scr, kb * 64, nb * 64, lane, part == 2); continue; } r -= I_UQ;
            if (r < I_UKV) { const int nblk = 1024 / 64, kb = r / nblk, nb = r % nblk; p0_transpose_item(w_ukv, KVL, 1024, Wukv_t, nb * 64, kv_norm, scr, kb * 64, nb * 64, lane); continue; } r -= I_UKV;
            { const int nblk = DM / 64, kb = r / nblk, nb = r % nblk; p0_transpose_item(w_o, DM, DM, Wo_t, nb * 64, nullptr, scr, kb * 64, nb * 64, lane); }
        }
        const int gt = vcu * (NWAVES * 64) + tid, NGT = G * NWAVES * 64;
        for (int i = gt; i < (NPP - NPROJ) * DM / 8; i += NGT) *(u32x4*)(Win_t + (size_t)NPROJ * DM + (size_t)i * 8) = (u32x4){0u, 0u, 0u, 0u};
        for (int i = gt; i < NH * 64 * QL / 8; i += NGT) { const int h = i / (64 * QL / 8), j = i % (64 * QL / 8); *(u32x4*)(Wuq_t + (size_t)(h * 256 + 192) * QL + (size_t)j * 8) = (u32x4){0u, 0u, 0u, 0u}; }
        for (int i = gt; i < NE * DM; i += NGT) { const int e = i / DM, k = i % DM; const float v = w_router[(size_t)k * NE + e] * norm_ffn[k]; const unsigned h = f2bf(v); const float hf = __builtin_bit_cast(float, h << 16);
            WrH[i] = (bf16_t)h; WrL[i] = (bf16_t)f2bf(v - hf); }
        for (int i = gt; i < SEQ * 32; i += NGT) { const int pos = i >> 5, fi = i & 31; const float inv = exp2f(-(float)fi * (13.287712379549449f / 32.f)); const float ang = (float)pos * inv; float s, c; sincosf(ang, &s, &c); rope_t[i] = (f32x2){c, s}; }
        for (int m = 4 * gw; m < NTOK; m += 4 * NGW) {
            const f32x4* xr = (const f32x4*)(x + (size_t)m * DM) + lane; const f32x4* gr = (const f32x4*)norm_mix + lane;
            f32x4 v[4][4]; float ss[4] = {0.f, 0.f, 0.f, 0.f};
#pragma unroll
            for (int r = 0; r < 4; ++r)
#pragma unroll
                for (int j = 0; j < 4; ++j) v[r][j] = __builtin_nontemporal_load(xr + r * (DM / 4) + 64 * j);
#pragma unroll
            for (int r = 0; r < 4; ++r)
#pragma unroll
                for (int j = 0; j < 4; ++j) ss[r] += (v[r][j].x * v[r][j].x + v[r][j].y * v[r][j].y) + (v[r][j].z * v[r][j].z + v[r][j].w * v[r][j].w);
            u32x2* o8 = (u32x2*)(hn + (size_t)m * DM) + lane;
#pragma unroll
            for (int r = 0; r < 4; ++r) { const float rr = 1.0f / sqrtf(wave_sum(ss[r]) * (1.f / DM) + EPS);
#pragma unroll
                for (int j = 0; j < 4; ++j) { const f32x4 g = gr[64 * j]; u32x2 w;
                    w.x = cvt_pk_bf16(v[r][j].x * rr * g.x, v[r][j].y * rr * g.y); w.y = cvt_pk_bf16(v[r][j].z * rr * g.z, v[r][j].w * rr * g.w); o8[r * (DM / 4) + 64 * j] = w; } }
        }
        if (BOTH(0)) GRID_BAR();
    }

    if (IN(1)) {
        if (bx < gemm_wgs) {
            pg8::DenseSched S; S.init(hn, DM, Win_t, NTOK, NPP, DM, gemm_wgs, bx);
            pg8::EpiProj E{pbuf, ssq};
            pg8::gemm_phase<pg8::EpiProj, pg8::DenseSched, false>(lds, S, E);
        } else {
            LAS unsigned* scr = (LAS unsigned*)(lds + wave * 16384);
            moe_stream((bx - gemm_wgs) * NWAVES + wave, (G - gemm_wgs) * NWAVES, w_gate_up, w_down, Wgu_t, Wdn_t, norm_ffn, scr, lane);
        }
        if (BOTH(1)) GRID_BAR();
    }

    const bool p2_all = IN(2);
    if (p2_all || IN(13)) {
        {
            const int gt = vcu * (NWAVES * 64) + tid, NGT = G * NWAVES * 64;
            for (int it = gt; it < (NTOK / 16) * 64; it += NGT) {
                const int run = it >> 6, gr = it & 63, t0 = run * 16, ch = gr * 8;
                float w0[8], w1[8], w2[8];
#pragma unroll
                for (int i = 0; i < 8; ++i) { w0[i] = conv_w[ch + i]; w1[i] = conv_w[CONVW + ch + i]; w2[i] = conv_w[2 * CONVW + ch + i]; }
                float um2[8], um1[8];
#pragma unroll
                for (int i = 0; i < 8; ++i) { um2[i] = 0.f; um1[i] = 0.f; }
                if ((t0 & (SEQ - 1)) != 0) {
                    unpack8(*(const u32x4*)(pbuf + (size_t)(t0 - 2) * NPB + PB_U + ch), um2);
                    unpack8(*(const u32x4*)(pbuf + (size_t)(t0 - 1) * NPB + PB_U + ch), um1);
                }
                u32x4 bq[16], uq[16];
#pragma unroll
                for (int t = 0; t < 16; ++t) { const bf16_t* pr = pbuf + (size_t)(t0 + t) * NPB + ch; bq[t] = __builtin_nontemporal_load((const u32x4*)(pr + PB_B)); uq[t] = __builtin_nontemporal_load((const u32x4*)(pr + PB_U)); }
#pragma unroll
                for (int t = 0; t < 16; ++t) {
                    float b8[8], u8[8], o8[8];
                    unpack8(bq[t], b8); unpack8(uq[t], u8);
#pragma unroll
                    for (int i = 0; i < 8; ++i) { o8[i] = b8[i] * (w0[i] * um2[i] + w1[i] * um1[i] + w2[i] * u8[i]); um2[i] = um1[i]; um1[i] = u8[i]; }
                    *(u32x4*)(mix + (size_t)(t0 + t) * DM + ch) = pack8(o8);
                }
            }
        }
    }
    if (p2_all || IN(14) || IN(15)) {
        LAS float* etab = (LAS float*)(lds + EPI_TAB_OFF);
        if (p2_all || IN(14)) { pg8::DenseSched S; S.init(pbuf + PB_CQ, NPB, Wuq_t, NTOK, NQP, QL, G, bx); pg8::EpiQ E{qb_, ssq, q_head_norm, rope_t, etab};
          pg8::gemm_phase<pg8::EpiQ, pg8::DenseSched, false>(lds, S, E); }
        if (p2_all || IN(15)) { pg8::DenseSched S; S.init(pbuf + PB_CKV, NPB, Wukv_t, NTOK, 1024, KVL, G, bx); pg8::EpiKV E{kb_, vb_, ssq, k_head_norm, rope_t, pbuf, etab};
          pg8::gemm_phase<pg8::EpiKV, pg8::DenseSched, false>(lds, S, E); }
        if (BOTH(2)) GRID_BAR();
    }


    if (IN(4)) {
        for (int u = vcu; u < NB * NH * 4; u += G) {
            const int bh = u >> 2, pr = u & 3, b = bh >> 2, h = bh & 3;
            att::attn_unit(b, h, 7 - pr, qb_, kb_, vb_, mix + CONVW, lds);
            att::attn_unit(b, h, pr, qb_, kb_, vb_, mix + CONVW, lds);
        }
        if (BOTH(4)) GRID_BAR();
    }

    auto load_wr = [&]() {
        for (int i = tid; i < 2 * NE * 128; i += NWAVES * 64) { const int sel = i >> 12, r = (i >> 7) & 31, g = i & 127;
            const u32x4 v = *(const u32x4*)((sel ? WrL : WrH) + (size_t)r * DM + g * 8);
            *(LAS u32x4*)(lds + sel * 65536 + r * 2048 + ((g ^ (r & 15)) << 4)) = v; }
    };
    if (IN(5)) {
        pg8::DenseSched S; S.init(mix, DM, Wo_t, NTOK, DM, DM, G, bx);
        pg8::EpiOut E{x, (bf16_t*)(ws + WS_H1B), ssq};
        pg8::gemm_phase<pg8::EpiOut, pg8::DenseSched, false>(lds, S, E);
        if (BOTH(5)) { load_wr(); GRID_BAR(); }
    }

    if (IN(6) || IN(16)) {
        const bool dry = !IN(6);
        LAS unsigned* hist = (LAS unsigned*)(lds + MISC_OFF) + 128; LAS unsigned* base = (LAS unsigned*)(lds + MISC_OFF) + 160;
        const int tj = lane & 15, q = lane >> 4;
        if (!BOTH(5)) load_wr();
        __syncthreads();
        for (int tile = vcu; tile < NTOK / 128; tile += G) {
            if (tid < 32) hist[tid] = 0u;
            __syncthreads();
            const int token = tile * 128 + wave * 16 + tj;
            const bf16_t* hrow = (const bf16_t*)(ws + WS_H1B) + (size_t)token * DM + q * 8;
            f32x4 a0 = {0.f, 0.f, 0.f, 0.f}, a1 = {0.f, 0.f, 0.f, 0.f};
            float s2 = 0.f;
#pragma unroll
            for (int p = 0; p < 16; ++p) s2 += ssq[(size_t)p * NTOK + token];
            const float rs = 1.0f / sqrtf(s2 * (1.f / DM) + EPS);
            unsigned char* hqrow = hq + (size_t)token * DM + q * 8;
            const LAS unsigned char* wlds = lds + tj * 2048;
#pragma unroll 1
            for (int kh = 0; kh < 2; ++kh) {
                u32x4 hv[16];
#pragma unroll
                for (int kk = 0; kk < 16; ++kk) hv[kk] = *(const u32x4*)(hrow + (kh * 16 + kk) * 32);
#pragma unroll
                for (int kk = 0; kk < 16; ++kk) { const int ks = kh * 16 + kk;
                    const u32x4 hw = hv[kk]; float hf[8]; unpack8(hw, hf);
                    { u32x2 w8; w8.x = pk4_fp8(hf[0] * rs, hf[1] * rs, hf[2] * rs, hf[3] * rs); w8.y = pk4_fp8(hf[4] * rs, hf[5] * rs, hf[6] * rs, hf[7] * rs); *(u32x2*)(hqrow + ks * 32) = w8; }
                    const bf16x8 bh = __builtin_bit_cast(bf16x8, hw);
                    const int go = (((ks * 4 + q) ^ tj) << 4);
                    const bf16x8 wh_a = *(const LAS bf16x8*)(wlds + go), wh_b = *(const LAS bf16x8*)(wlds + 16 * 2048 + go);
                    const bf16x8 wl_a = *(const LAS bf16x8*)(wlds + 65536 + go), wl_b = *(const LAS bf16x8*)(wlds + 65536 + 16 * 2048 + go);
                    a0 = __builtin_amdgcn_mfma_f32_16x16x32_bf16(wh_a, bh, a0, 0, 0, 0); a0 = __builtin_amdgcn_mfma_f32_16x16x32_bf16(wl_a, bh, a0, 0, 0, 0);
                    a1 = __builtin_amdgcn_mfma_f32_16x16x32_bf16(wh_b, bh, a1, 0, 0, 0); a1 = __builtin_amdgcn_mfma_f32_16x16x32_bf16(wl_b, bh, a1, 0, 0, 0);
                }
            }
            float lv[8]; int le[8];
#pragma unroll
            for (int i = 0; i < 4; ++i) { le[i] = 4 * q + i; le[4 + i] = 16 + 4 * q + i; lv[i] = a0[i] * rs + b_router[le[i]]; lv[4 + i] = a1[i] * rs + b_router[le[4 + i]]; }
            float tv[4]; int te[4];
#pragma unroll
            for (int k = 0; k < TOPK; ++k) {
                float bv = lv[0]; int be = le[0];
#pragma unroll
                for (int i = 1; i < 8; ++i) if (lv[i] > bv) { bv = lv[i]; be = le[i]; }
#pragma unroll
                for (int o = 16; o < 64; o <<= 1) { const float ov = __shfl_xor(bv, o); const int oe = __shfl_xor(be, o); if (ov > bv || (ov == bv && oe < be)) { bv = ov; be = oe; } }
                tv[k] = bv; te[k] = be;
#pragma unroll
                for (int i = 0; i < 8; ++i) if (le[i] == be) lv[i] = -3.0e38f;
            }
            float ge[4]; float gs = 0.f;
#pragma unroll
            for (int k = 0; k < TOPK; ++k) { ge[k] = __expf(tv[k] - tv[0]); gs += ge[k]; }
            const float ginv = 1.0f / gs;
            int my_e = te[0]; float my_g = ge[0];
#pragma unroll
            for (int k = 1; k < TOPK; ++k) if (q == k) { my_e = te[k]; my_g = ge[k]; }
            my_g *= ginv;
            const unsigned pl = atomicAdd((unsigned*)(hist + my_e), 1u);
            __syncthreads();
            if (tid < 32) base[tid] = dry ? 0u : __hip_atomic_fetch_add(ctl + CW_CNT + 64 * tid, hist[tid], __ATOMIC_RELAXED, __HIP_MEMORY_SCOPE_AGENT);
            __syncthreads();
            const unsigned pos = base[my_e] + pl; const int slot = token * 4 + q;
            if (!dry) *(u32x2*)(tos + ((size_t)my_e * CAP + pos) * 2) = (u32x2){(unsigned)slot, __builtin_bit_cast(unsigned, my_g)};
            else if (my_g < -1.f) rs2[token] = my_g;
            __syncthreads();
        }
        if (BOTH(6)) GRID_BAR();
    }

    LAS int* tab = (LAS int*)(lds + MISC_OFF) + 16;
    if (IN(7) || IN(8) || IN(10) || IN(11) || IN(12)) {
        if (tid < 32) { const int c = (int)__hip_atomic_load(ctl + CW_CNT + 64 * tid, __ATOMIC_RELAXED, __HIP_MEMORY_SCOPE_AGENT); tab[48 + tid] = c; }
        __syncthreads();
        if (tid == 0) { int s = 0; for (int e = 0; e < NE; ++e) { tab[e] = s; s += (tab[48 + e] + 255) >> 8; } tab[32] = s; }
        __syncthreads();
        for (int t = tid; t < tab[32]; t += NWAVES * 64) { int e = 0; while (e < NE - 1 && tab[e + 1] <= t) ++e; tab[2288 + t] = e; }
        __syncthreads();
    }

    if (IN(7)) {
        pg8::MoeSched S{hq, Wgu_t, DM, DM, 2 * DFF / 256, G, bx, (size_t)2 * DFF * DM, tab, tos, b_gate_up};
        pg8::EpiSwiglu E{act, b_gate_up, lds};
        pg8::gemm_phase<pg8::EpiSwiglu, pg8::MoeSched, true>(lds, S, E);
        if (BOTH(7)) GRID_BAR();
    }

    if (IN(8)) {
        pg8::MoeSched S{act, Wdn_t, DFF, DFF, DM / 256, G, bx, (size_t)DM * DFF, tab, tos, b_down};
        pg8::EpiDown E{(unsigned char*)oslot, b_down, ws + WS_SSQ, lds};
        pg8::gemm_phase<pg8::EpiDown, pg8::MoeSched, false>(lds, S, E);
        if (BOTH(8)) GRID_BAR();
    }

#if PROBE_DOUBLE
    if (IN(10)) { pg8::MoeSched S{hq, Wgu_t, DM, DM, 2 * DFF / 256, G, bx, (size_t)2 * DFF * DM, tab, tos, b_gate_up}; pg8::EpiNull E{(float*)(ws + WS_SSQ)};
        pg8::gemm_phase<pg8::EpiNull, pg8::MoeSched, true>(lds, S, E); }
    if (IN(11)) { pg8::MoeSched S{act, Wdn_t, DFF, DFF, DM / 256, G, bx, (size_t)DM * DFF, tab, tos, b_down}; pg8::EpiNull E{(float*)(ws + WS_SSQ)};
        pg8::gemm_phase<pg8::EpiNull, pg8::MoeSched, false, 2>(lds, S, E); }
    if (IN(12)) { pg8::MoeSched S{act, Wdn_t, DFF, DFF, DM / 256, G, bx, (size_t)DM * DFF, tab, tos, b_down}; pg8::EpiNull E{(float*)(ws + WS_SSQ)};
        pg8::gemm_phase<pg8::EpiNull, pg8::MoeSched, false>(lds, S, E); }
#endif
    if (IN(9)) {
        const unsigned char* os8 = (const unsigned char*)oslot;
        constexpr float OI = 1.f / OS8_SCALE;
        for (int m = gw; m < NTOK; m += NGW) {
            f32x4* orow = (f32x4*)(out + (size_t)m * DM) + lane;
            const u32x2* hrow = (const u32x2*)((const bf16_t*)(ws + WS_H1B) + (size_t)m * DM) + lane;
            const unsigned* s0 = (const unsigned*)(os8 + (size_t)m * 4 * DM) + lane;
            unsigned w[4][4]; f32x4 hv[4];
#pragma unroll
            for (int j = 0; j < 4; ++j) { const u32x2 hb2 = __builtin_nontemporal_load(hrow + 64 * j); hv[j] = (f32x4){bf_lo(hb2.x), bf_hi(hb2.x), bf_lo(hb2.y), bf_hi(hb2.y)};
#pragma unroll
                for (int k = 0; k < 4; ++k) w[j][k] = __builtin_nontemporal_load(s0 + (size_t)k * (DM / 4) + 64 * j); }
#pragma unroll
            for (int j = 0; j < 4; ++j) { f32x4 a = {0.f, 0.f, 0.f, 0.f};
#pragma unroll
                for (int k = 0; k < 4; ++k) { const f32x2 lo = __builtin_amdgcn_cvt_pk_f32_fp8(w[j][k], false), hi2 = __builtin_amdgcn_cvt_pk_f32_fp8(w[j][k], true); a.x += lo.x; a.y += lo.y; a.z += hi2.x; a.w += hi2.y; }
                __builtin_nontemporal_store(hv[j] + a * OI, orow + 64 * j); }
        }
    }
#undef IN
#undef BOTH
#undef GRID_BAR
}

#ifdef DIAG_PHASES
template __global__ void fwd_kernel_t<1>(Args); template __global__ void fwd_kernel_t<2>(Args); template __global__ void fwd_kernel_t<4>(Args); template __global__ void fwd_kernel_t<8>(Args);
template __global__ void fwd_kernel_t<16>(Args); template __global__ void fwd_kernel_t<32>(Args); template __global__ void fwd_kernel_t<64>(Args); template __global__ void fwd_kernel_t<128>(Args);
template __global__ void fwd_kernel_t<256>(Args); template __global__ void fwd_kernel_t<512>(Args);
#endif
#define fwd_kernel fwd_kernel_t<(PROBE_DOUBLE ? 0x1ffff : 1023)>
extern "C" void kernel_launch(void* const* d_in, const int* in_sizes, int n_in, void* d_out, int out_size, void* d_ws, size_t ws_size, hipStream_t stream) {
    static int grid = 0;
    if (grid == 0) {
        if (n_in != 18 || in_sizes[0] != NTOK * DM || out_size != NTOK * DM || ws_size < WS_END) { fprintf(stderr, "kernel_launch: shape/workspace mismatch (n_in %d, in0 %d, out %d, ws %zu, need %zu)\n", n_in, n_in > 0 ? in_sizes[0] : -1, out_size, ws_size, (size_t)WS_END); grid = -1; return; }
        int dev = 0, cus = 0, per_cu = 0;
        if (hipGetDevice(&dev) != hipSuccess || hipDeviceGetAttribute(&cus, hipDeviceAttributeMultiprocessorCount, dev) != hipSuccess) { grid = -1; return; }
        if (hipFuncSetAttribute((const void*)fwd_kernel, hipFuncAttributeMaxDynamicSharedMemorySize, LDS_BYTES) != hipSuccess) { fprintf(stderr, "kernel_launch: hipFuncSetAttribute failed\n"); grid = -1; return; }
        if (hipOccupancyMaxActiveBlocksPerMultiprocessor(&per_cu, (const void*)fwd_kernel, NWAVES * 64, LDS_BYTES) != hipSuccess || per_cu < 1) { fprintf(stderr, "kernel_launch: occupancy query says %d\n", per_cu); }
        (void)hipGetLastError();
        grid = cus;
    }
    if (grid < 0) return;
    if (hipMemsetAsync((char*)d_ws + WS_CTL, 0, CTL_ZERO_BYTES, stream) != hipSuccess) return;
    Args a{};
    for (int i = 0; i < 18; ++i) a.in[i] = (const float*)d_in[i];
    a.out = (float*)d_out; a.ws = (unsigned char*)d_ws;
    if (N_LAUNCHES == 1) { a.ph_lo = 0; a.ph_hi = N_PHASES; hipLaunchKernelGGL(fwd_kernel, dim3(grid), dim3(NWAVES * 64), LDS_BYTES, stream, a); }
    else { for (int p = 0; p < N_PHASES; ++p) { a.ph_lo = p; a.ph_hi = p + 1; const int reps = ((PROBE_DOUBLE >> p) & 1) ? 2 : 1;
            for (int r = 0; r < reps; ++r) hipLaunchKernelGGL(fwd_kernel, dim3(grid), dim3(NWAVES * 64), LDS_BYTES, stream, a);
            if (p == 8) for (int pp = 10; pp < 13; ++pp) if ((PROBE_DOUBLE >> pp) & 1) { a.ph_lo = pp; a.ph_hi = pp + 1; hipLaunchKernelGGL(fwd_kernel, dim3(grid), dim3(NWAVES * 64), LDS_BYTES, stream, a); }
            if (p == 6 && ((PROBE_DOUBLE >> 16) & 1)) { a.ph_lo = 16; a.ph_hi = 17; hipLaunchKernelGGL(fwd_kernel, dim3(grid), dim3(NWAVES * 64), LDS_BYTES, stream, a); }
            if (p == 2) for (int pp = 13; pp < 16; ++pp) if ((PROBE_DOUBLE >> pp) & 1) { a.ph_lo = pp; a.ph_hi = pp + 1; hipLaunchKernelGGL(fwd_kernel, dim3(grid), dim3(NWAVES * 64), LDS_BYTES, stream, a); } } }
}
```

```cpp
#include <hip/hip_runtime.h>
#include <cstdio>
#include <cstdint>

#ifndef MK_N_LAUNCHES
#define MK_N_LAUNCHES 1
#endif

#ifndef PROBE_DOUBLE
#define PROBE_DOUBLE 0
#endif
#define LAS __attribute__((address_space(3)))
#define GAS __attribute__((address_space(1)))
typedef unsigned short bf16_t;
typedef short bf16x8 __attribute__((ext_vector_type(8)));
typedef short s16x4 __attribute__((ext_vector_type(4)));
typedef float f32x2 __attribute__((ext_vector_type(2)));
typedef float f32x4 __attribute__((ext_vector_type(4)));
typedef float f32x16 __attribute__((ext_vector_type(16)));
typedef unsigned u32x2 __attribute__((ext_vector_type(2)));
typedef unsigned u32x4 __attribute__((ext_vector_type(4)));
typedef int v4i_t __attribute__((ext_vector_type(4)));
typedef int v8i_t __attribute__((ext_vector_type(8)));

constexpr int NB = 16, SEQ = 2048, NTOK = NB * SEQ, DM = 1024;
constexpr int CONVW = 512, QL = 384, KVL = 256, ROPE = 64, NH = 4, QKN = 128, QKH = 192, VH = 128;
constexpr int NPROJ = 2240, NPP = 2304;
constexpr int PB_B = 0, PB_U = 512, PB_CKV = 1024, PB_CQ = 1280, PB_KPE = 1664, NPB = 1728;
constexpr int NQP = 1024;
constexpr int NE = 32, TOPK = 4, DFF = 1024, NSLOT = NTOK * TOPK;
constexpr int CAP = NTOK;
constexpr int MAXTILES = NSLOT / 256 + NE;
constexpr float EPS = 1e-6f;
constexpr float QSCALE = 0.07216878364870322f * 1.4426950408889634f;
constexpr float SWI_LIMIT = 7.0f, SWI_ALPHA = 1.702f;
constexpr float W8_SCALE = 64.f, ACT8_SCALE = 4.f, OS8_SCALE = 16.f;

constexpr size_t MiB = 1u << 20;
constexpr size_t WS_CTL = 0, CTL_ZERO_BYTES = 1 * MiB;
constexpr size_t WS_ROPE = 1 * MiB;
constexpr size_t WS_WRH = 1 * MiB + 512 * 1024, WS_WRL = WS_WRH + 64 * 1024;
constexpr size_t WS_WIN = 2 * MiB;
constexpr size_t WS_WUQ = 8 * MiB, WS_WUKV = 9 * MiB, WS_WO = 10 * MiB;
constexpr size_t WS_SSQ = 12 * MiB;
constexpr size_t WS_RS2 = 14 * MiB, WS_GATE = 14 * MiB + 512 * 1024;
constexpr size_t WS_TOS = 16 * MiB;
constexpr size_t WS_WGU = 32 * MiB, WS_WDN = 160 * MiB;
constexpr size_t WS_HB = 224 * MiB;
constexpr size_t WS_Q = 288 * MiB, WS_K = 336 * MiB, WS_V = 384 * MiB, WS_MIX = 416 * MiB;
constexpr size_t WS_OSLOT = 288 * MiB;
constexpr size_t WS_HN = 544 * MiB, WS_PB = 608 * MiB, WS_QRAW = 752 * MiB, WS_KVRAW = 800 * MiB;
constexpr size_t WS_ACT = 544 * MiB;
constexpr size_t WS_H1B = 768 * MiB;
constexpr size_t WS_END = 864 * MiB;
constexpr int CW_BAR = 4096;
constexpr int CW_CNT = 16384;

constexpr int RING_BYTES = 131072;
constexpr int MISC_OFF = RING_BYTES;
constexpr int LDS_BYTES = 155648;
constexpr int EPI_TAB_OFF = MISC_OFF + 3072 * 4;

__device__ __forceinline__ unsigned cvt_pk_bf16(float lo, float hi) { unsigned r; asm volatile("v_cvt_pk_bf16_f32 %0, %1, %2" : "=v"(r) : "v"(lo), "v"(hi)); return r; }
__device__ __forceinline__ unsigned f2bf(float f) { unsigned u = __builtin_bit_cast(unsigned, f); return (u + 0x7fffu + ((u >> 16) & 1u)) >> 16; }
__device__ __forceinline__ unsigned pk2(float lo, float hi) { return f2bf(lo) | (f2bf(hi) << 16); }
__device__ __forceinline__ float bf_lo(unsigned w) { return __builtin_bit_cast(float, w << 16); }
__device__ __forceinline__ float bf_hi(unsigned w) { return __builtin_bit_cast(float, w & 0xffff0000u); }
__device__ __forceinline__ void unpack8(const u32x4 w, float* f) { f[0] = bf_lo(w.x); f[1] = bf_hi(w.x); f[2] = bf_lo(w.y); f[3] = bf_hi(w.y); f[4] = bf_lo(w.z); f[5] = bf_hi(w.z); f[6] = bf_lo(w.w); f[7] = bf_hi(w.w); }
__device__ __forceinline__ u32x4 pack8(const float* f) { u32x4 w; w.x = cvt_pk_bf16(f[0], f[1]); w.y = cvt_pk_bf16(f[2], f[3]); w.z = cvt_pk_bf16(f[4], f[5]); w.w = cvt_pk_bf16(f[6], f[7]); return w; }
__device__ __forceinline__ float wave_sum(float v) {
#pragma unroll
    for (int o = 1; o < 64; o <<= 1) v += __shfl_xor(v, o);
    return v;
}
__device__ __forceinline__ float half_sum(float v) {
#pragma unroll
    for (int o = 1; o < 32; o <<= 1) v += __shfl_xor(v, o);
    return v;
}
__device__ __forceinline__ float clamp448(float v) { return __builtin_amdgcn_fmed3f(v, -448.f, 448.f); }
__device__ __forceinline__ unsigned pk4_fp8_nc(float a, float b, float c, float d) {
    unsigned w = 0u; w = (unsigned)__builtin_amdgcn_cvt_pk_fp8_f32(a, b, (int)w, false); w = (unsigned)__builtin_amdgcn_cvt_pk_fp8_f32(c, d, (int)w, true); return w; }
__device__ __forceinline__ unsigned pk4_fp8(float a, float b, float c, float d) {
    unsigned w = 0u; w = (unsigned)__builtin_amdgcn_cvt_pk_fp8_f32(clamp448(a), clamp448(b), (int)w, false); w = (unsigned)__builtin_amdgcn_cvt_pk_fp8_f32(clamp448(c), clamp448(d), (int)w, true); return w; }
#define LDS_WAIT() asm volatile("s_waitcnt lgkmcnt(0)" ::: "memory")
#define VM_WAIT() asm volatile("s_waitcnt vmcnt(0)" ::: "memory")

namespace pg8 {
constexpr int BM = 256, BK = 64, HALF = 128, HTB = HALF * BK * 2, STAGE_BYTES = 8 * HTB, NXCD = 8, WGM = 4;
__host__ __device__ __forceinline__ int lds_byte(int r, int c) { const int st = (r >> 4) * 2 + (c >> 5), rr = r & 15, cc = c & 31, ob = rr * 64 + cc * 2; return st * 1024 + (ob ^ (((ob >> 9) & 1) << 5)); }
__host__ __device__ __forceinline__ void stage_rc(int b, int& R, int& C) { const int st = b / 1024, sb = b % 1024, swz = sb ^ (((sb >> 9) & 1) << 5); R = (st >> 1) * 16 + swz / 64; C = (st & 1) * 32 + (swz % 64) / 2; }
__host__ __device__ __forceinline__ int perm32(int rho) { const int n = rho >> 4, i = rho & 15; return 8 * (i >> 2) + 4 * n + (i & 3); }

struct Unit { int pm, pn, e, p0, cnt, par, half; };

__device__ __forceinline__ bool deal_unit(int i, int nwg, int G, int c, int& wgid, int& half) {
    half = 0;
    if (G % NXCD != 0) { const long L = (long)i * G + c; if (L >= nwg) return false; wgid = (int)L; return true; }
    const int W = G / NXCD, x = c % NXCD, rk = c / NXCD, q = nwg / NXCD, r = nwg % NXCD;
    const int cnt = q + (x < r ? 1 : 0), base = (x < r ? x * (q + 1) : r * (q + 1) + (x - r) * q);
    const int R = cnt / W, E = cnt - R * W;
    if (i < R) { wgid = base + i * W + rk; return true; }
    if (i > R) return false;
    if (rk >= E) return false; wgid = base + R * W + rk; return true;
}
struct DenseSched {
    static constexpr int ESZ = 2;
    const bf16_t* A; const bf16_t* Bt; int lda, K, nM, nN, nwg, G, c;
    __device__ void init(const bf16_t* A_, int lda_, const bf16_t* Bt_, int M, int N, int K_, int G_, int c_) { A = A_; Bt = Bt_; lda = lda_; K = K_; nM = M / BM; nN = N / BM; nwg = nM * nN; G = G_; c = c_; }
    __device__ __forceinline__ bool next(int i, Unit& u) const {
        int wgid, half; if (!deal_unit(i, nwg, G, c, wgid, half)) return false;
        const int nig = WGM * nN, gid = wgid / nig, fm = gid * WGM, gsz = (nM - fm) < WGM ? (nM - fm) : WGM;
        u.pm = fm + ((wgid % nig) % gsz); u.pn = (wgid % nig) / gsz; u.e = 0; u.p0 = 0; u.cnt = 0; u.half = half; return true;
    }
    __device__ __forceinline__ unsigned a_off(const Unit& u) const { return (unsigned)u.pm * (unsigned)(BM * lda * 2); }
    __device__ __forceinline__ unsigned b_off(const Unit& u) const { return (unsigned)u.pn * (unsigned)(BM * K * 2); }
    __device__ __forceinline__ unsigned a_rowoff(const Unit&, int) const { return 0u; }
    static constexpr bool META = false;
    __device__ __forceinline__ void meta_first(const Unit&, LAS unsigned char*) const {}
    __device__ __forceinline__ void meta_issue(const Unit&, LAS unsigned char*) const {}
    __device__ __forceinline__ void pre_issue(const Unit&, LAS unsigned char*) const {}
    __device__ __forceinline__ unsigned meta_rowoff(const Unit&, int, LAS unsigned char*) const { return 0u; }
};
struct MoeSched {
    static constexpr int ESZ = 1;
    const unsigned char* A; const unsigned char* Bt; int lda, K, nN, G, c; size_t estride; const LAS int* tab; const int* tos; const float* bias;
    static constexpr bool META = true;
    static constexpr int META_OFF = MISC_OFF + 4608 * 4;
    __device__ __forceinline__ bool next(int i, Unit& u) const {
        const int T = __builtin_amdgcn_readfirstlane(tab[32]), nwg = T * nN;
        int wgid, half; if (!deal_unit(i, nwg, G, c, wgid, half)) return false; u.half = half;
        const int nig = WGM * nN, gid = wgid / nig, fm = gid * WGM, gsz = (T - fm) < WGM ? (T - fm) : WGM;
        const int mt = fm + ((wgid % nig) % gsz); u.pm = mt; u.pn = (wgid % nig) / gsz;
        const int e = __builtin_amdgcn_readfirstlane(tab[2288 + mt]);
        u.e = e; u.p0 = (mt - __builtin_amdgcn_readfirstlane(tab[e])) * BM; u.cnt = __builtin_amdgcn_readfirstlane(tab[48 + e]); return true;
    }
    __device__ __forceinline__ unsigned a_off(const Unit& u) const { return (unsigned)u.pm * (unsigned)(BM * lda); }
    __device__ __forceinline__ unsigned b_off(const Unit& u) const { return (unsigned)u.e * (unsigned)estride + (unsigned)u.pn * (unsigned)(BM * K); }
    __device__ __forceinline__ unsigned a_rowoff(const Unit& u, int r) const {
        const int p = u.p0 + r; const int sv = tos[((size_t)u.e * CAP + p) * 2];
        const int slot = (p < u.cnt) ? sv : 0;
        return (unsigned)(slot >> 2) * (unsigned)lda;
    }
    static constexpr int BIAS_OFF = MISC_OFF + 5632 * 4;
    __device__ __forceinline__ void meta_first(const Unit& u, LAS unsigned char* lds) const { meta_issue(u, lds); }
    __device__ __forceinline__ void meta_issue(const Unit& u, LAS unsigned char* lds) const {
        const __amdgpu_buffer_rsrc_t rT = __builtin_amdgcn_make_buffer_rsrc((void*)tos, 0, -1, 0x00020000);
        const int wid = __builtin_amdgcn_readfirstlane(threadIdx.x >> 6);
        __builtin_amdgcn_raw_ptr_buffer_load_lds(rT, (LAS void*)(lds + META_OFF + u.par * 2048 + wid * 256), 4, (threadIdx.x & 63) * 4u, ((unsigned)u.e * (unsigned)CAP + (unsigned)u.p0) * 8u + (unsigned)wid * 256u, 0, 0);
    }
    __device__ __forceinline__ void pre_issue(const Unit& u, LAS unsigned char* lds) const {
        const int wid = __builtin_amdgcn_readfirstlane(threadIdx.x >> 6);
        if (wid < 4) { const __amdgpu_buffer_rsrc_t rB = __builtin_amdgcn_make_buffer_rsrc((void*)bias, 0, -1, 0x00020000);
            const unsigned src = (nN == 8) ? (((unsigned)u.e * (2u * DFF) + (unsigned)u.pn * HALF) * 4u + (wid >= 2 ? DFF * 4u - 512u : 0u)) : (((unsigned)u.e * DM + (unsigned)u.pn * BM) * 4u);
            __builtin_amdgcn_raw_ptr_buffer_load_lds(rB, (LAS void*)(lds + BIAS_OFF + u.par * 1024 + wid * 256), 4, (threadIdx.x & 63) * 4u, src + (unsigned)wid * 256u, 0, 0); }
    }
    __device__ __forceinline__ unsigned meta_rowoff(const Unit& u, int r, LAS unsigned char* lds) const {
        const int sv = *(const LAS int*)(lds + META_OFF + u.par * 2048 + r * 8);
        const int slot = (u.p0 + r < u.cnt) ? sv : 0;
        return (unsigned)(slot >> 2) * (unsigned)lda;
    }
};

template <class Epi, class Sched, bool GATHER, int KREP = 1>
__device__ __forceinline__ void gemm_phase(LAS unsigned char* lds, const Sched& S, const Epi& E) {
    const int tid = threadIdx.x, wid = __builtin_amdgcn_readfirstlane(tid >> 6), lane = tid & 63, wr = wid >> 2, wc = wid & 3, fr = lane & 15, fq = lane >> 4;
    constexpr int ESZ = Sched::ESZ; constexpr bool F8 = (ESZ == 1);
    const int K = S.K * ESZ / 2, lda = S.lda * ESZ / 2, nt0 = K / BK, nt = nt0 * KREP;
    unsigned voffB[2], aoc[2][2]; int RA[2], CA[2];
#pragma unroll
    for (int i = 0; i < 2; ++i) { int R, C; stage_rc(tid * 16 + i * 8192, R, C); const int Rb = (R & ~31) + perm32(R & 31);
        voffB[i] = (unsigned)(Rb * K + C) * 2u; RA[i] = R; CA[i] = C;
        aoc[0][i] = (unsigned)(R * lda + C) * 2u; aoc[1][i] = (unsigned)((R + HALF) * lda + C) * 2u; }
    const unsigned kstep = (unsigned)(BK * 2);
    const unsigned hstepB = (unsigned)(HALF * K * 2), hstepA = GATHER ? 0u : (unsigned)(HALF * lda * 2);
    const __amdgpu_buffer_rsrc_t rA = __builtin_amdgcn_make_buffer_rsrc((void*)S.A, 0, -1, 0x00020000), rB = __builtin_amdgcn_make_buffer_rsrc((void*)S.Bt, 0, -1, 0x00020000);
    const unsigned ldsw = (unsigned)wid * 1024u;
    const int aoff = lds_byte(wr * 64 + fr, fq * 8), boff = lds_byte(wc * 32 + fr, fq * 8);
#define PG8_SA(b, h) (((b) * 2 + (h)) * HTB)
#define PG8_SB(b, h) ((4 + (b) * 2 + (h)) * HTB)
#define PG8_STAGE_B(bufoff, soff) do { _Pragma("unroll") for (int _i = 0; _i < 2; ++_i) \
        __builtin_amdgcn_raw_ptr_buffer_load_lds(rB, (LAS void*)(lds + (bufoff) + ldsw + _i * 8192), 16, voffB[_i], (soff), 0, 0); } while (0)
#define PG8_STAGE_A(bufoff, soff, h) do { _Pragma("unroll") for (int _i = 0; _i < 2; ++_i) \
        __builtin_amdgcn_raw_ptr_buffer_load_lds(rA, (LAS void*)(lds + (bufoff) + ldsw + _i * 8192), 16, aoc[GATHER ? (h) : 0][_i], (soff) + (h) * hstepA, 0, 0); } while (0)
#define PG8_LDA(dst, b, h) do { _Pragma("unroll") for (int m = 0; m < 4; ++m) _Pragma("unroll") for (int k = 0; k < 2; ++k) dst[m][k] = *(const LAS bf16x8*)(lds + PG8_SA(b, h) + aoff + m * 2048 + k * 1024); } while (0)
#define PG8_LDB(dst, b, h) do { _Pragma("unroll") for (int n = 0; n < 2; ++n) _Pragma("unroll") for (int k = 0; k < 2; ++k) dst[n][k] = *(const LAS bf16x8*)(lds + PG8_SB(b, h) + boff + n * 2048 + k * 1024); } while (0)
#define PG8_CAT(x) __builtin_shufflevector(__builtin_bit_cast(v4i_t, x[0]), __builtin_bit_cast(v4i_t, x[1]), 0, 1, 2, 3, 4, 5, 6, 7)
#define PG8_MMA(ai, bj, At, Bt) do { __builtin_amdgcn_s_setprio(1); _Pragma("unroll") for (int m = 0; m < 4; ++m) _Pragma("unroll") for (int n = 0; n < 2; ++n) { \
        if constexpr (F8) { asm volatile("v_mfma_scale_f32_16x16x128_f8f6f4 %0, %1, %2, %0, %3, %3 op_sel_hi:[0,0,0]" : "+v"(acc[ai][bj][m][n]) : "v"(PG8_CAT(Bt[n])), "v"(PG8_CAT(At[m])), "v"(0x7f7f7f7f)); } \
        else { _Pragma("unroll") for (int k = 0; k < 2; ++k) acc[ai][bj][m][n] = __builtin_amdgcn_mfma_f32_16x16x32_bf16(Bt[n][k], At[m][k], acc[ai][bj][m][n], 0, 0, 0); } } \
        __builtin_amdgcn_s_setprio(0); } while (0)
#define PG8_WAIT_V(n) asm volatile("s_waitcnt vmcnt(" #n ")" ::: "memory")
#define PG8_WAIT_L(n) asm volatile("s_waitcnt lgkmcnt(" #n ")" ::: "memory")
#define PG8_BAR __builtin_amdgcn_s_barrier()
#define PG8_SCHED __builtin_amdgcn_sched_barrier(0)
    Unit cur, nxt; int ui = 0;
    if (!S.next(0, cur)) return;
    cur.par = 0; if constexpr (Sched::META) S.meta_first(cur, lds);
    f32x4 acc[2][2][4][2];
#pragma unroll
    for (int a = 0; a < 2; ++a)
#pragma unroll
        for (int b = 0; b < 2; ++b)
#pragma unroll
            for (int m = 0; m < 4; ++m)
#pragma unroll
                for (int n = 0; n < 2; ++n) acc[a][b][m][n] = (f32x4){0.f, 0.f, 0.f, 0.f};
    bf16x8 At[4][2], B0[2][2], B1[2][2];
    unsigned cA = GATHER ? 0u : S.a_off(cur), cB = S.b_off(cur);
    if constexpr (GATHER) {
#pragma unroll
        for (int h = 0; h < 2; ++h)
#pragma unroll
            for (int i = 0; i < 2; ++i) aoc[h][i] = S.a_rowoff(cur, h * HALF + RA[i]) + (unsigned)CA[i] * 2u;
    }
    PG8_STAGE_B(PG8_SB(0, 0), cB); PG8_STAGE_B(PG8_SB(0, 1), cB + hstepB); PG8_STAGE_A(PG8_SA(0, 0), cA, 0); PG8_STAGE_A(PG8_SA(0, 1), cA, 1);
    if (wr == 1) PG8_BAR;
    PG8_WAIT_V(2); PG8_BAR;
    PG8_STAGE_B(PG8_SB(1, 0), cB + kstep); PG8_STAGE_A(PG8_SA(1, 0), cA + kstep, 0); PG8_STAGE_B(PG8_SB(1, 1), cB + hstepB + kstep);
    PG8_WAIT_V(6); PG8_BAR;
    for (;;) {
        const bool has_next = S.next(ui + 1, nxt);
        const unsigned nA = GATHER ? 0u : (has_next ? S.a_off(nxt) : cA), nB = has_next ? S.b_off(nxt) : cB;
        nxt.par = (ui + 1) & 1;
        for (int t = 0; t < nt; t += 2) {
            const bool last = (t == nt - 2);
            const unsigned a1 = cA + (unsigned)((t + 1) % nt0) * kstep;
            const unsigned a2 = last ? nA : cA + (unsigned)((t + 2) % nt0) * kstep, b2 = last ? nB : cB + (unsigned)((t + 2) % nt0) * kstep;
            const unsigned a3 = a2 + kstep, b3 = b2 + kstep;
            PG8_LDB(B0, 0, 0); PG8_LDB(B1, 0, 1); PG8_SCHED; PG8_LDA(At, 0, 0); PG8_STAGE_A(PG8_SA(1, 1), a1, 1);
            PG8_WAIT_V(8); PG8_WAIT_L(0); PG8_BAR;
            if constexpr (Sched::META) { if (t == 0) { S.pre_issue(cur, lds); if (has_next) S.meta_issue(nxt, lds); } }
            PG8_MMA(0, 0, At, B0); PG8_MMA(0, 1, At, B1); PG8_BAR; PG8_SCHED;
            if constexpr (Sched::META) { if (last && has_next) {
                if constexpr (GATHER) {
#pragma unroll
                    for (int h = 0; h < 2; ++h)
#pragma unroll
                        for (int i = 0; i < 2; ++i) aoc[h][i] = S.meta_rowoff(nxt, h * HALF + RA[i], lds) + (unsigned)CA[i] * 2u;
                } } }
            PG8_LDA(At, 0, 1); PG8_STAGE_B(PG8_SB(0, 0), b2); PG8_STAGE_B(PG8_SB(0, 1), b2 + hstepB); PG8_STAGE_A(PG8_SA(0, 0), a2, 0);
            PG8_WAIT_V(8); PG8_WAIT_L(0); PG8_BAR; PG8_MMA(1, 0, At, B0); PG8_MMA(1, 1, At, B1); PG8_BAR; PG8_SCHED;
            PG8_LDB(B0, 1, 0); PG8_LDB(B1, 1, 1); PG8_SCHED; PG8_LDA(At, 1, 0); PG8_STAGE_A(PG8_SA(0, 1), a2, 1);
            PG8_WAIT_V(8); PG8_WAIT_L(0); PG8_BAR; PG8_MMA(0, 0, At, B0); PG8_MMA(0, 1, At, B1); PG8_BAR; PG8_SCHED;
            PG8_LDA(At, 1, 1); PG8_STAGE_B(PG8_SB(1, 0), b3); PG8_STAGE_B(PG8_SB(1, 1), b3 + hstepB); PG8_STAGE_A(PG8_SA(1, 0), a3, 0);
            PG8_WAIT_V(8); PG8_WAIT_L(0); PG8_BAR; PG8_MMA(1, 0, At, B0); PG8_MMA(1, 1, At, B1); PG8_BAR; PG8_SCHED;
        }
        if (wr == 0) PG8_BAR;
        E(acc, cur, wr, wc, fr, fq);
        if (!has_next) break;
#pragma unroll
        for (int a = 0; a < 2; ++a)
#pragma unroll
            for (int b = 0; b < 2; ++b)
#pragma unroll
                for (int m = 0; m < 4; ++m)
#pragma unroll
                    for (int n = 0; n < 2; ++n) acc[a][b][m][n] = (f32x4){0.f, 0.f, 0.f, 0.f};
        cur = nxt; cA = nA; cB = nB; ++ui;
        if (wr == 1) PG8_BAR;
    }
    PG8_WAIT_V(0);
    PG8_BAR;
#undef PG8_SA
#undef PG8_SB
#undef PG8_STAGE_A
#undef PG8_STAGE_B
#undef PG8_LDA
#undef PG8_LDB
#undef PG8_MMA
#undef PG8_CAT
#undef PG8_WAIT_V
#undef PG8_WAIT_L
#undef PG8_BAR
#undef PG8_SCHED
}

struct EpiBf16 {
    bf16_t* O; int ldc;
    __device__ __forceinline__ void operator()(const f32x4 (&acc)[2][2][4][2], const Unit& u, int wr, int wc, int fr, int fq) const {
        asm volatile("" : "+v"(fr), "+v"(fq));
        const int row0 = u.pm * BM + wr * 64 + fr, col0 = u.pn * BM + wc * 32 + 8 * fq;
#pragma unroll
        for (int ai = 0; ai < 2; ++ai)
#pragma unroll
            for (int m = 0; m < 4; ++m) { bf16_t* rowp = O + (size_t)(row0 + ai * HALF + m * 16) * ldc + col0;
#pragma unroll
                for (int bj = 0; bj < 2; ++bj) { const f32x4 v0 = acc[ai][bj][m][0], v1 = acc[ai][bj][m][1];
                    u32x4 w; w.x = cvt_pk_bf16(v0[0], v0[1]); w.y = cvt_pk_bf16(v0[2], v0[3]); w.z = cvt_pk_bf16(v1[0], v1[1]); w.w = cvt_pk_bf16(v1[2], v1[3]);
                    *(u32x4*)(rowp + bj * HALF) = w; } }
    }
};
struct EpiProj {
    static constexpr int NPRE = 0;
    bf16_t* O; float* st;
    __device__ __forceinline__ void operator()(const f32x4 (&acc)[2][2][4][2], const Unit& u, int wr, int wc, int fr, int fq) const {
        asm volatile("" : "+v"(fr), "+v"(fq));
        const int row0 = u.pm * BM + wr * 64 + fr, c8 = wc * 32 + 8 * fq;
        const bool pair = (u.pn >= 2 && u.pn < 6);
        const int cb0 = (u.pn < 2) ? u.pn * BM : (pair ? PB_U + (u.pn - 2) * HALF : (u.pn == 6 ? PB_CKV : (u.pn == 7 ? PB_CQ : PB_CQ + 256)));
#pragma unroll
        for (int ai = 0; ai < 2; ++ai)
#pragma unroll
            for (int m = 0; m < 4; ++m) { const int row = row0 + ai * HALF + m * 16; bf16_t* rowp = O + (size_t)row * NPB + cb0 + c8; float ss[2];
                if (pair) { const f32x4 v0 = acc[ai][0][m][0] * acc[ai][1][m][0], v1 = acc[ai][0][m][1] * acc[ai][1][m][1];
                    u32x4 w; w.x = cvt_pk_bf16(v0[0], v0[1]); w.y = cvt_pk_bf16(v0[2], v0[3]); w.z = cvt_pk_bf16(v1[0], v1[1]); w.w = cvt_pk_bf16(v1[2], v1[3]);
                    *(u32x4*)rowp = w; ss[0] = 0.f; ss[1] = 0.f;
                } else {
#pragma unroll
                    for (int bj = 0; bj < 2; ++bj) { const f32x4 v0 = acc[ai][bj][m][0], v1 = acc[ai][bj][m][1];
                        u32x4 w; w.x = cvt_pk_bf16(v0[0], v0[1]); w.y = cvt_pk_bf16(v0[2], v0[3]); w.z = cvt_pk_bf16(v1[0], v1[1]); w.w = cvt_pk_bf16(v1[2], v1[3]);
                        if (!(u.pn == 8 && bj == 1 && wc >= 2)) *(u32x4*)(rowp + bj * HALF) = w;
                        ss[bj] = (v0[0] * v0[0] + v0[1] * v0[1]) + (v0[2] * v0[2] + v0[3] * v0[3]) + (v1[0] * v1[0] + v1[1] * v1[1]) + (v1[2] * v1[2] + v1[3] * v1[3]); } }
                if (u.pn >= 6) {
                    float s0 = ss[0], s1 = ss[1]; s0 += __shfl_xor(s0, 16); s0 += __shfl_xor(s0, 32); s1 += __shfl_xor(s1, 16); s1 += __shfl_xor(s1, 32);
                    if (fq == 0) { if (u.pn == 6) st[(size_t)wc * NTOK + row] = s0 + s1; else if (u.pn == 7) st[(size_t)(4 + wc) * NTOK + row] = s0 + s1;
                                   else { st[(size_t)(8 + wc) * NTOK + row] = s0; st[(size_t)(12 + wc) * NTOK + row] = s1; } } } }
    }
};
struct EpiQ {
    bf16_t* q; const float* st; const float* qhn; const f32x2* rope; LAS float* tabs;
    __device__ __forceinline__ void operator()(const f32x4 (&acc)[2][2][4][2], const Unit& u, int wr, int wc, int fr, int fq) const {
        asm volatile("" : "+v"(fr), "+v"(fq));
        LAS float* rs_tab = tabs; LAS float* part = tabs + 512;
        const int rt0 = wr * 64 + fr;
        const int c0 = wc * 32 + 8 * fq;
        const int i0 = c0 >> 1;
        f32x4 csa[2][4][2];
        if (wc < 2) {
#pragma unroll
            for (int ai = 0; ai < 2; ++ai)
#pragma unroll
                for (int m = 0; m < 4; ++m) { const size_t row = (size_t)u.pm * BM + rt0 + ai * HALF + m * 16;
                    csa[ai][m][0] = *(const f32x4*)(rope + (row & (SEQ - 1)) * 32 + i0); csa[ai][m][1] = *(const f32x4*)(rope + (row & (SEQ - 1)) * 32 + i0 + 2); }
        }
        f32x4 g0[2], g1[2];
        g0[0] = *(const f32x4*)(qhn + c0) * QSCALE; g0[1] = *(const f32x4*)(qhn + c0 + 4) * QSCALE;
        if (wc < 2) { g1[0] = (f32x4){qhn[128 + i0], qhn[160 + i0], qhn[129 + i0], qhn[161 + i0]} * QSCALE; g1[1] = (f32x4){qhn[130 + i0], qhn[162 + i0], qhn[131 + i0], qhn[163 + i0]} * QSCALE; }
        else { g1[0] = (f32x4){0.f, 0.f, 0.f, 0.f}; g1[1] = g1[0]; }
        { const int t = threadIdx.x; if (t < BM) { const size_t r = (size_t)u.pm * BM + t; float s = 0.f;
#pragma unroll
            for (int k = 4; k < 12; ++k) s += st[(size_t)k * NTOK + r];
            rs_tab[t] = __builtin_amdgcn_rsqf(s * (1.f / QL) + EPS); } }
#pragma unroll
        for (int ai = 0; ai < 2; ++ai)
#pragma unroll
            for (int m = 0; m < 4; ++m) { float ss = 0.f;
#pragma unroll
                for (int bj = 0; bj < 2; ++bj)
#pragma unroll
                    for (int n = 0; n < 2; ++n) { const f32x4 v = acc[ai][bj][m][n]; ss += (v[0] * v[0] + v[1] * v[1]) + (v[2] * v[2] + v[3] * v[3]); }
                ss += __shfl_xor(ss, 16); ss += __shfl_xor(ss, 32);
                if (fq == 0) part[(rt0 + ai * HALF + m * 16) * 4 + wc] = ss; }
        asm volatile("s_waitcnt lgkmcnt(0)" ::: "memory"); __builtin_amdgcn_s_barrier(); asm volatile("" ::: "memory");
#pragma unroll
        for (int ai = 0; ai < 2; ++ai)
#pragma unroll
            for (int m = 0; m < 4; ++m) { const int rt = rt0 + ai * HALF + m * 16; const size_t row = (size_t)u.pm * BM + rt;
                const f32x4 pp = *(const LAS f32x4*)(part + rt * 4); const float rs = rs_tab[rt];
                const float r = rs * __builtin_amdgcn_rsqf(rs * rs * ((pp[0] + pp[1]) + (pp[2] + pp[3])) * (1.f / QKH) + EPS);
                bf16_t* qp = q + row * (NH * QKH) + u.pn * QKH + c0;
                { const f32x4 v0 = acc[ai][0][m][0] * g0[0] * r, v1 = acc[ai][0][m][1] * g0[1] * r;
                  u32x4 w; w.x = cvt_pk_bf16(v0[0], v0[1]); w.y = cvt_pk_bf16(v0[2], v0[3]); w.z = cvt_pk_bf16(v1[0], v1[1]); w.w = cvt_pk_bf16(v1[2], v1[3]); *(u32x4*)qp = w; }
                if (wc < 2) { const f32x4 cs0 = csa[ai][m][0], cs1 = csa[ai][m][1];
                    const f32x4 a0 = acc[ai][1][m][0] * g1[0] * r, a1 = acc[ai][1][m][1] * g1[1] * r;
                    f32x4 o0, o1;
                    o0[0] = a0[0] * cs0[0] - a0[1] * cs0[1]; o0[1] = a0[0] * cs0[1] + a0[1] * cs0[0]; o0[2] = a0[2] * cs0[2] - a0[3] * cs0[3]; o0[3] = a0[2] * cs0[3] + a0[3] * cs0[2];
                    o1[0] = a1[0] * cs1[0] - a1[1] * cs1[1]; o1[1] = a1[0] * cs1[1] + a1[1] * cs1[0]; o1[2] = a1[2] * cs1[2] - a1[3] * cs1[3]; o1[3] = a1[2] * cs1[3] + a1[3] * cs1[2];
                    u32x4 w; w.x = cvt_pk_bf16(o0[0], o0[1]); w.y = cvt_pk_bf16(o0[2], o0[3]); w.z = cvt_pk_bf16(o1[0], o1[1]); w.w = cvt_pk_bf16(o1[2], o1[3]); *(u32x4*)(qp + HALF) = w; } }
    }
};
struct EpiKV {
    bf16_t* k; bf16_t* v; const float* st; const float* khn; const f32x2* rope; const bf16_t* pb; LAS float* tabs;
    __device__ __forceinline__ void operator()(const f32x4 (&acc)[2][2][4][2], const Unit& u, int wr, int wc, int fr, int fq) const {
        asm volatile("" : "+v"(fr), "+v"(fq));
        LAS float* rs_tab = tabs; LAS float* kpe_tab = tabs + 256; LAS float* part = tabs + 512;
        const int rt0 = wr * 64 + fr;
        const int c0 = wc * 32 + 8 * fq;
        const int i0 = 8 * wc + 2 * fq;
        unsigned xas[2][4], xbs[2][4]; f32x4 css[2][4];
#pragma unroll
        for (int ai = 0; ai < 2; ++ai)
#pragma unroll
            for (int m = 0; m < 4; ++m) { const size_t row = (size_t)u.pm * BM + rt0 + ai * HALF + m * 16;
                xas[ai][m] = *(const unsigned*)(pb + row * NPB + PB_KPE + i0); xbs[ai][m] = *(const unsigned*)(pb + row * NPB + PB_KPE + 32 + i0);
                css[ai][m] = *(const f32x4*)(rope + (row & (SEQ - 1)) * 32 + i0); }
        const f32x4 g0 = *(const f32x4*)(khn + c0), g1 = *(const f32x4*)(khn + c0 + 4);
        const float gx0 = khn[128 + i0], gy0 = khn[160 + i0], gx1 = khn[129 + i0], gy1 = khn[161 + i0];
        { const int t = threadIdx.x; if (t < BM) { const size_t r = (size_t)u.pm * BM + t;
            const float s = (st[r] + st[(size_t)NTOK + r]) + (st[(size_t)2 * NTOK + r] + st[(size_t)3 * NTOK + r]);
            const float p = (st[(size_t)12 * NTOK + r] + st[(size_t)13 * NTOK + r]) + (st[(size_t)14 * NTOK + r] + st[(size_t)15 * NTOK + r]);
            rs_tab[t] = __builtin_amdgcn_rsqf(s * (1.f / KVL) + EPS); kpe_tab[t] = p; } }
#pragma unroll
        for (int ai = 0; ai < 2; ++ai)
#pragma unroll
            for (int m = 0; m < 4; ++m) { float ss = 0.f;
#pragma unroll
                for (int n = 0; n < 2; ++n) { const f32x4 x = acc[ai][0][m][n]; ss += (x[0] * x[0] + x[1] * x[1]) + (x[2] * x[2] + x[3] * x[3]); }
                ss += __shfl_xor(ss, 16); ss += __shfl_xor(ss, 32);
                if (fq == 0) part[(rt0 + ai * HALF + m * 16) * 4 + wc] = ss; }
        asm volatile("s_waitcnt lgkmcnt(0)" ::: "memory"); __builtin_amdgcn_s_barrier(); asm volatile("" ::: "memory");
#pragma unroll
        for (int ai = 0; ai < 2; ++ai)
#pragma unroll
            for (int m = 0; m < 4; ++m) { const int rt = rt0 + ai * HALF + m * 16; const size_t row = (size_t)u.pm * BM + rt;
                const f32x4 pp = *(const LAS f32x4*)(part + rt * 4); const float rs = rs_tab[rt];
                const float rh = __builtin_amdgcn_rsqf((rs * rs * ((pp[0] + pp[1]) + (pp[2] + pp[3])) + kpe_tab[rt]) * (1.f / QKH) + EPS);
                const float r = rs * rh;
                bf16_t* kp = k + row * (NH * QKH) + u.pn * QKH;
                { const f32x4 v0 = acc[ai][0][m][0] * g0 * r, v1 = acc[ai][0][m][1] * g1 * r;
                  u32x4 w; w.x = cvt_pk_bf16(v0[0], v0[1]); w.y = cvt_pk_bf16(v0[2], v0[3]); w.z = cvt_pk_bf16(v1[0], v1[1]); w.w = cvt_pk_bf16(v1[2], v1[3]); *(u32x4*)(kp + c0) = w; }
                { const f32x4 v0 = acc[ai][1][m][0] * rs, v1 = acc[ai][1][m][1] * rs;
                  u32x4 w; w.x = cvt_pk_bf16(v0[0], v0[1]); w.y = cvt_pk_bf16(v0[2], v0[3]); w.z = cvt_pk_bf16(v1[0], v1[1]); w.w = cvt_pk_bf16(v1[2], v1[3]); *(u32x4*)(v + row * (NH * VH) + u.pn * VH + c0) = w; }
                { const unsigned xa = xas[ai][m], xb = xbs[ai][m];
                  const f32x4 cs = css[ai][m];
                  const float x10 = bf_lo(xa) * gx0 * rh, x11 = bf_hi(xa) * gx1 * rh, x20 = bf_lo(xb) * gy0 * rh, x21 = bf_hi(xb) * gy1 * rh;
                  u32x2 w; w.x = cvt_pk_bf16(x10 * cs[0] - x20 * cs[1], x10 * cs[1] + x20 * cs[0]); w.y = cvt_pk_bf16(x11 * cs[2] - x21 * cs[3], x11 * cs[3] + x21 * cs[2]);
                  *(u32x2*)(kp + 128 + 2 * i0) = w; } }
    }
};
struct EpiOut {
    const float* x; bf16_t* h1b; float* ssq;
    __device__ __forceinline__ void operator()(const f32x4 (&acc)[2][2][4][2], const Unit& u, int wr, int wc, int fr, int fq) const {
        asm volatile("" : "+v"(fr), "+v"(fq));
        const int row0 = u.pm * BM + wr * 64 + fr, col0 = u.pn * BM + wc * 32 + 8 * fq;
#pragma unroll
        for (int ai = 0; ai < 2; ++ai) {
            f32x4 xv[4][2][2];
#pragma unroll
            for (int m = 0; m < 4; ++m) { const size_t off = (size_t)(row0 + ai * HALF + m * 16) * DM + col0;
#pragma unroll
                for (int bj = 0; bj < 2; ++bj) { xv[m][bj][0] = __builtin_nontemporal_load((const f32x4*)(x + off + bj * HALF)); xv[m][bj][1] = __builtin_nontemporal_load((const f32x4*)(x + off + bj * HALF + 4)); } }
            asm volatile("" ::: "memory");
#pragma unroll
            for (int m = 0; m < 4; ++m) { const int row = row0 + ai * HALF + m * 16; const size_t off = (size_t)row * DM + col0; float ss = 0.f;
#pragma unroll
                for (int bj = 0; bj < 2; ++bj) { const f32x4 v0 = acc[ai][bj][m][0] + xv[m][bj][0], v1 = acc[ai][bj][m][1] + xv[m][bj][1];
                    u32x4 w; w.x = cvt_pk_bf16(v0[0], v0[1]); w.y = cvt_pk_bf16(v0[2], v0[3]); w.z = cvt_pk_bf16(v1[0], v1[1]); w.w = cvt_pk_bf16(v1[2], v1[3]);
                    *(u32x4*)(h1b + off + bj * HALF) = w;
                    ss += (v0[0] * v0[0] + v0[1] * v0[1]) + (v0[2] * v0[2] + v0[3] * v0[3]) + (v1[0] * v1[0] + v1[1] * v1[1]) + (v1[2] * v1[2] + v1[3] * v1[3]); }
                ss += __shfl_xor(ss, 16); ss += __shfl_xor(ss, 32);
                if (fq == 0) ssq[(size_t)(u.pn * 4 + wc) * NTOK + row] = ss; }
        }
    }
};
struct EpiSwiglu {
    unsigned char* act; const float* bgu; LAS unsigned char* blds;
    __device__ __forceinline__ void operator()(const f32x4 (&acc)[2][2][4][2], const Unit& u, int wr, int wc, int fr, int fq) const {
        asm volatile("" : "+v"(fr), "+v"(fq));
        const int rt0 = wr * 64 + fr, j0 = wc * 32 + 8 * fq;
        const LAS float* bl = (const LAS float*)(blds + MoeSched::BIAS_OFF + u.par * 1024) + j0;
        const f32x4 bg0 = *(const LAS f32x4*)bl, bg1 = *(const LAS f32x4*)(bl + 4), bu0 = *(const LAS f32x4*)(bl + HALF), bu1 = *(const LAS f32x4*)(bl + HALF + 4);
        constexpr float WI = 1.f / W8_SCALE;
#pragma unroll
        for (int ai = 0; ai < 2; ++ai)
#pragma unroll
            for (int m = 0; m < 4; ++m) { const int rt = rt0 + ai * HALF + m * 16;
                float o[8];
#pragma unroll
                for (int n = 0; n < 2; ++n) { const f32x4 g4 = acc[ai][0][m][n] * WI + (n ? bg1 : bg0), u4 = acc[ai][1][m][n] * WI + (n ? bu1 : bu0);
#pragma unroll
                    for (int i = 0; i < 4; i += 2) {
                        f32x2 g, uu; g.x = fminf(g4[i], SWI_LIMIT); g.y = fminf(g4[i + 1], SWI_LIMIT);
                        uu.x = __builtin_amdgcn_fmed3f(u4[i], -SWI_LIMIT, SWI_LIMIT); uu.y = __builtin_amdgcn_fmed3f(u4[i + 1], -SWI_LIMIT, SWI_LIMIT);
                        const f32x2 t = g * (-SWI_ALPHA * 1.4426950408889634f);
                        f32x2 e; e.x = __builtin_amdgcn_exp2f(t.x); e.y = __builtin_amdgcn_exp2f(t.y);
                        const f32x2 d = e + 1.f;
                        f32x2 sg; sg.x = __builtin_amdgcn_rcpf(d.x); sg.y = __builtin_amdgcn_rcpf(d.y);
                        const f32x2 r = (uu * ACT8_SCALE + ACT8_SCALE) * (g * sg);
                        o[n * 4 + i] = r.x; o[n * 4 + i + 1] = r.y; } }
                u32x2 w; w.x = pk4_fp8_nc(o[0], o[1], o[2], o[3]); w.y = pk4_fp8_nc(o[4], o[5], o[6], o[7]);
                *(u32x2*)(act + ((size_t)u.pm * BM + rt) * DFF + u.pn * HALF + j0) = w; }
    }
};
struct EpiDown {
    unsigned char* oslot; const float* bdn; unsigned char* dummy; LAS unsigned char* lds;
    __device__ __forceinline__ void operator()(const f32x4 (&acc)[2][2][4][2], const Unit& u, int wr, int wc, int fr, int fq) const {
        asm volatile("" : "+v"(fr), "+v"(fq));
        const int rt0 = wr * 64 + fr, col0 = u.pn * BM + wc * 32 + 8 * fq;
        const LAS float* bl = (const LAS float*)(lds + MoeSched::BIAS_OFF + u.par * 1024) + wc * 32 + 8 * fq;
        f32x4 bv[2][2]; bv[0][0] = *(const LAS f32x4*)bl; bv[0][1] = *(const LAS f32x4*)(bl + 4); bv[1][0] = *(const LAS f32x4*)(bl + HALF); bv[1][1] = *(const LAS f32x4*)(bl + HALF + 4);
        constexpr float WI = 1.f / (W8_SCALE * ACT8_SCALE);
#pragma unroll
        for (int ai = 0; ai < 2; ++ai)
#pragma unroll
            for (int m = 0; m < 4; ++m) { const int rt = rt0 + ai * HALF + m * 16, p = u.p0 + rt;
                const u32x2 mt = *(const LAS u32x2*)(lds + MoeSched::META_OFF + u.par * 2048 + rt * 8);
                const bool valid = p < u.cnt; const int slot = valid ? (int)mt.x : 0; const unsigned gbits = mt.y; const float g = __builtin_bit_cast(float, gbits);
                unsigned char* rowp = valid ? oslot + (size_t)slot * DM + col0 : dummy + col0;
                const float gs = g * OS8_SCALE;
#pragma unroll
                for (int bj = 0; bj < 2; ++bj) { const f32x4 v0 = (acc[ai][bj][m][0] * WI + bv[bj][0]) * gs, v1 = (acc[ai][bj][m][1] * WI + bv[bj][1]) * gs;
                    u32x2 w; w.x = pk4_fp8(v0[0], v0[1], v0[2], v0[3]); w.y = pk4_fp8(v1[0], v1[1], v1[2], v1[3]);
                    *(u32x2*)(rowp + bj * HALF) = w; } }
    }
};
struct EpiNull {
    float* dummy;
    __device__ __forceinline__ void operator()(const f32x4 (&acc)[2][2][4][2], const Unit& u, int wr, int wc, int fr, int fq) const {
        float sacc = 0.f;
#pragma unroll
        for (int ai = 0; ai < 2; ++ai)
#pragma unroll
            for (int bj = 0; bj < 2; ++bj)
#pragma unroll
                for (int m = 0; m < 4; ++m)
#pragma unroll
                    for (int n = 0; n < 2; ++n) sacc += (acc[ai][bj][m][n][0] + acc[ai][bj][m][n][1]) + (acc[ai][bj][m][n][2] + acc[ai][bj][m][n][3]);
        dummy[(size_t)blockIdx.x * 512 + threadIdx.x] = sacc;
    }
};
}

namespace att {
constexpr int LDQ = NH * QKH, LDK = NH * QKH, LDV = NH * VH, LDO = DM;
constexpr int KT_BYTES = 64 * QKH * 2, VT_BYTES = 64 * VH * 2;
constexpr int L_K = 0, L_V = 3 * KT_BYTES, L_WS = L_V + 3 * VT_BYTES, L_END = L_WS + 8 * 256;
constexpr float THRL = 8.f * 1.4426950408889634f;
__device__ __forceinline__ int crow(int r, int hi) { return (r & 3) + 8 * (r >> 2) + 4 * hi; }
#define SBAR() __builtin_amdgcn_sched_barrier(0)
__device__ __forceinline__ int v_rd_base(int lane) { return ((lane & 3) << 3) | (((lane >> 2) & 3) << 6) | (((lane >> 4) & 1) << 5) | (((lane >> 5) & 1) << 8); }
constexpr int v_rd_off(int d0, int ks, int half) { return d0 * 512 + ks * 4096 + half * 2048; }
template <int OFF> __device__ __forceinline__ s16x4 tr_read(int vb) {
    s16x4 r; asm volatile("ds_read_b64_tr_b16 %0, %1 offset:%2" : "=&v"(r) : "v"(vb), "i"(OFF) : "memory"); return r;
}
template <int D0> __device__ __forceinline__ void pv_one(f32x16& od, int vb, bf16x8 pa0, bf16x8 pa1, bf16x8 pa2, bf16x8 pa3) {
    const s16x4 l0 = tr_read<v_rd_off(D0, 0, 0)>(vb), h0 = tr_read<v_rd_off(D0, 0, 1)>(vb), l1 = tr_read<v_rd_off(D0, 1, 0)>(vb), h1 = tr_read<v_rd_off(D0, 1, 1)>(vb);
    const s16x4 l2 = tr_read<v_rd_off(D0, 2, 0)>(vb), h2 = tr_read<v_rd_off(D0, 2, 1)>(vb), l3 = tr_read<v_rd_off(D0, 3, 0)>(vb), h3 = tr_read<v_rd_off(D0, 3, 1)>(vb);
    asm volatile("s_waitcnt lgkmcnt(0)" ::: "memory"); SBAR();
#define PK(L, H) (bf16x8){L[0], L[1], L[2], L[3], H[0], H[1], H[2], H[3]}
    od = __builtin_amdgcn_mfma_f32_32x32x16_bf16(pa0, PK(l0, h0), od, 0, 0, 0);
    od = __builtin_amdgcn_mfma_f32_32x32x16_bf16(pa1, PK(l1, h1), od, 0, 0, 0);
    od = __builtin_amdgcn_mfma_f32_32x32x16_bf16(pa2, PK(l2, h2), od, 0, 0, 0);
    od = __builtin_amdgcn_mfma_f32_32x32x16_bf16(pa3, PK(l3, h3), od, 0, 0, 0);
#undef PK
}
__device__ __forceinline__ void glds16(const void* gsrc, LAS unsigned char* dst) {
    __builtin_amdgcn_global_load_lds((const unsigned*)gsrc, (LAS unsigned*)dst, 16, 0, 0);
}
__device__ __forceinline__ void attn_unit(int b, int h, int qb, const bf16_t* Q, const bf16_t* Kg, const bf16_t* Vg, bf16_t* O, LAS unsigned char* lds) {
    const int tid = threadIdx.x, wid = __builtin_amdgcn_readfirstlane(tid >> 6), lane = tid & 63, r32 = lane & 31, hi = lane >> 5;
    const int grp = wid >> 2;
    const size_t tok0 = (size_t)b * SEQ;
    bf16x8 qr[12];
    { const bf16_t* Qw = Q + (tok0 + (size_t)qb * 256 + wid * 32 + r32) * LDQ + h * QKH + hi * 8;
#pragma unroll
      for (int d0 = 0; d0 < 12; ++d0) qr[d0] = *(const bf16x8*)(Qw + d0 * 16); }
    unsigned koff[3], voff[2];
#pragma unroll
    for (int i = 0; i < 3; ++i) { const int G = 64 * (wid + 8 * i) + lane, row = G / 24, cgs = G % 24, cg = (cgs & ~7) | ((cgs & 7) ^ ((row >> 1) & 7)); koff[i] = (unsigned)(row * LDK * 2 + cg * 16); }
#pragma unroll
    for (int i = 0; i < 2; ++i) { const int p = wid + 8 * i, sub = 2 * p + (lane >> 5), kkh = sub >> 2, cblk = sub & 3, kkl = (lane & 31) >> 2, cl = (lane & 3) * 8, kk = kkh * 8 + kkl;
        const int k = (kk & ~0xC) | ((kk & 4) << 1) | ((kk & 8) >> 1), c = cblk * 32 + cl; voff[i] = (unsigned)(k * LDV * 2 + c * 2); }
    const __amdgpu_buffer_rsrc_t rK = __builtin_amdgcn_make_buffer_rsrc((void*)(Kg + tok0 * LDK + h * QKH), 0, -1, 0x00020000), rV = __builtin_amdgcn_make_buffer_rsrc((void*)(Vg + tok0 * LDV + h * VH), 0, -1, 0x00020000);
#define ATT_DMA(j, buf) do { \
        _Pragma("unroll") for (int i_ = 0; i_ < 3; ++i_) __builtin_amdgcn_raw_ptr_buffer_load_lds(rK, (LAS void*)(lds + L_K + (buf) * KT_BYTES + (wid + 8 * i_) * 1024), 16, koff[i_], (unsigned)(j) * (64u * LDK * 2u), 0, 0); \
        _Pragma("unroll") for (int i_ = 0; i_ < 2; ++i_) __builtin_amdgcn_raw_ptr_buffer_load_lds(rV, (LAS void*)(lds + L_V + (buf) * VT_BYTES + (wid + 8 * i_) * 1024), 16, voff[i_], (unsigned)(j) * (64u * LDV * 2u), 0, 0); } while (0)
#define ATT_BAR() do { asm volatile("" ::: "memory"); __builtin_amdgcn_s_barrier(); asm volatile("" ::: "memory"); } while (0)
    const int swz = (r32 >> 1) & 7; int kx[4];
#pragma unroll
    for (int dd = 0; dd < 4; ++dd) kx[dd] = r32 * (QKH * 2) + (((2 * dd + hi) ^ swz) << 4);
    LAS float* ws = (LAS float*)(lds + L_WS) + wid * 64; LAS float* li_l = ws; LAS float* al_l = ws + 32;
    const int vb0 = L_V + v_rd_base(lane);
    float m_reg = -1e30f, l_reg = 0.f; f32x16 o[4];
#pragma unroll
    for (int d = 0; d < 4; ++d)
#pragma unroll
        for (int r = 0; r < 16; ++r) o[d][r] = 0.f;
    const int NT = 4 * qb + 4, my_last = 4 * qb + (wid >> 1);
    ATT_DMA(0, 0); ATT_DMA(1, 1);
    asm volatile("s_waitcnt vmcnt(5)" ::: "memory"); ATT_BAR();
    if (grp == 1) ATT_BAR();
    int kb = 0, nb = 2;
    for (int j = 0; j < NT; ++j) {
        const bool live = (j <= my_last), more = (j + 2 < NT);
        f32x16 p0, p1;
        if (grp == 1 && more) ATT_DMA(j + 2, nb);
        if (live) {
            const LAS unsigned char* Ks = lds + L_K + kb * KT_BYTES;
#pragma unroll
            for (int r = 0; r < 16; ++r) { p0[r] = 0.f; p1[r] = 0.f; }
#pragma unroll
            for (int d0 = 0; d0 < 12; ++d0) {
                const bf16x8 b0 = *(const LAS bf16x8*)(Ks + kx[d0 & 3] + (d0 >> 2) * 128);
                const bf16x8 b1 = *(const LAS bf16x8*)(Ks + kx[d0 & 3] + (d0 >> 2) * 128 + 32 * QKH * 2);
                p0 = __builtin_amdgcn_mfma_f32_32x32x16_bf16(b0, qr[d0], p0, 0, 0, 0);
                p1 = __builtin_amdgcn_mfma_f32_32x32x16_bf16(b1, qr[d0], p1, 0, 0, 0);
            }
        }
        if (grp == 1) { if (j + 1 < NT) { if (more) asm volatile("s_waitcnt vmcnt(5)" ::: "memory"); else asm volatile("s_waitcnt vmcnt(0)" ::: "memory"); } }
        ATT_BAR();
        if (grp == 0 && more) ATT_DMA(j + 2, nb);
        if (live) {
            float pmax = p0[0];
#pragma unroll
            for (int r = 1; r < 16; ++r) pmax = fmaxf(pmax, p0[r]);
#pragma unroll
            for (int r = 0; r < 16; ++r) pmax = fmaxf(pmax, p1[r]);
            { auto rr = __builtin_amdgcn_permlane32_swap(__float_as_uint(pmax), __float_as_uint(pmax), false, false);
              pmax = fmaxf(__uint_as_float(rr[0]), __uint_as_float(rr[1])); }
            float mn, alpha;
            if (__builtin_expect(__all(pmax - m_reg <= THRL), 1)) { mn = m_reg; alpha = 1.f; }
            else { mn = fmaxf(m_reg, pmax); alpha = __builtin_amdgcn_exp2f(m_reg - mn); m_reg = mn; }
#pragma unroll
            for (int r = 0; r < 16; ++r) { p0[r] = __builtin_amdgcn_exp2f(p0[r] - mn); p1[r] = __builtin_amdgcn_exp2f(p1[r] - mn); }
            float ps = 0.f;
#pragma unroll
            for (int r = 0; r < 16; ++r) ps += p0[r];
#pragma unroll
            for (int r = 0; r < 16; ++r) ps += p1[r];
            { auto rr = __builtin_amdgcn_permlane32_swap(__float_as_uint(ps), __float_as_uint(ps), false, false);
              ps = __uint_as_float(rr[0]) + __uint_as_float(rr[1]); }
            l_reg = l_reg * alpha + ps;
            if (__any(alpha < 1.f)) { if (hi == 0) al_l[r32] = alpha; asm volatile("s_waitcnt lgkmcnt(0)" ::: "memory");
#pragma unroll
                for (int r = 0; r < 16; ++r) { const float a = al_l[crow(r, hi)];
#pragma unroll
                    for (int d = 0; d < 4; ++d) o[d][r] *= a; } }
            bf16x8 pa0, pa1, pa2, pa3;
#define PK4(P, BASE, OUT) do { unsigned a0 = cvt_pk_bf16(P[BASE + 0], P[BASE + 1]), a1 = cvt_pk_bf16(P[BASE + 2], P[BASE + 3]);   \
    unsigned b0_ = cvt_pk_bf16(P[BASE + 4], P[BASE + 5]), b1_ = cvt_pk_bf16(P[BASE + 6], P[BASE + 7]);                              \
    auto r0 = __builtin_amdgcn_permlane32_swap(a0, b0_, false, false); auto r1 = __builtin_amdgcn_permlane32_swap(a1, b1_, false, false); \
    u32x4 w = {r0[0], r1[0], r0[1], r1[1]}; OUT = __builtin_bit_cast(bf16x8, w); } while (0)
            PK4(p0, 0, pa0); PK4(p0, 8, pa1); PK4(p1, 0, pa2); PK4(p1, 8, pa3);
#undef PK4
            const int vb = vb0 + kb * VT_BYTES;
            pv_one<0>(o[0], vb, pa0, pa1, pa2, pa3); pv_one<1>(o[1], vb, pa0, pa1, pa2, pa3); pv_one<2>(o[2], vb, pa0, pa1, pa2, pa3); pv_one<3>(o[3], vb, pa0, pa1, pa2, pa3);
        }
        if (grp == 0) { if (j + 1 < NT) { if (more) asm volatile("s_waitcnt vmcnt(5)" ::: "memory"); else asm volatile("s_waitcnt vmcnt(0)" ::: "memory"); } }
        ATT_BAR();
        kb = (kb == 2) ? 0 : kb + 1; nb = (nb == 2) ? 0 : nb + 1;
    }
    if (grp == 0) ATT_BAR();
    if (hi == 0) li_l[r32] = l_reg; asm volatile("s_waitcnt lgkmcnt(0)" ::: "memory");
    bf16_t* Ow = O + (tok0 + (size_t)qb * 256 + wid * 32) * LDO + h * VH;
#pragma unroll
    for (int r = 0; r < 16; ++r) { const int orow = crow(r, hi); const float rl = __builtin_amdgcn_rcpf(li_l[orow]);
#pragma unroll
        for (int d0 = 0; d0 < 4; ++d0) Ow[(size_t)orow * LDO + d0 * 32 + r32] = (bf16_t)f2bf(o[d0][r] * rl); }
    asm volatile("s_waitcnt lgkmcnt(0)" ::: "memory"); ATT_BAR();
#undef ATT_DMA
#undef ATT_BAR
}
#undef SBAR
}

#define XB_TMO      128
#define XB_XCNT(j)  (256  + 64 * (j))
#define XB_XSUB(j)  (1280 + 64 * (j))
#define XB_XGEN(j)  (2304 + 64 * (j))
#define XB_TOP      3328
#define XB_TOPGEN   3392
#define XCD_BAR_WORDS 3456
#define XB_SPIN_CAP (1u << 18)
__device__ __forceinline__ unsigned xb_ld(unsigned* p)              { return __hip_atomic_load(p, __ATOMIC_RELAXED, __HIP_MEMORY_SCOPE_AGENT); }
__device__ __forceinline__ unsigned xb_add(unsigned* p, unsigned v) { return __hip_atomic_fetch_add(p, v, __ATOMIC_RELAXED, __HIP_MEMORY_SCOPE_AGENT); }
__device__ __forceinline__ unsigned xb_xcc_id() { return (unsigned)__builtin_amdgcn_s_getreg((3 << 11) | 20) & 0xFu; }
#define XB_SPIN(cond, bar) do { unsigned _sp = 0; while (cond) { __builtin_amdgcn_s_sleep(1); \
    if ((++_sp & 255u) == 0u) { if (xb_ld(&(bar)[XB_TMO])) break; if (_sp > XB_SPIN_CAP) { atomicAdd(&(bar)[XB_TMO], 1u); break; } } } } while (0)
struct XcdBarrier { unsigned* bar; unsigned x; volatile LAS unsigned* st; };
__device__ __forceinline__ XcdBarrier xcd_barrier_post(unsigned* bar, volatile LAS unsigned* st) {
    XcdBarrier b; b.bar = bar; b.x = xb_xcc_id(); b.st = st;
    if (threadIdx.x == 0) (void)xb_add(&bar[XB_XCNT(b.x)], 1u);
    return b;
}
__device__ __forceinline__ void xcd_barrier_complete(unsigned* bar, unsigned x, unsigned& nloc, unsigned& nx) {
    const unsigned G = gridDim.x * gridDim.y * gridDim.z;
    unsigned sum, cnt, mine, sp = 0u;
    for (;;) {
        sum = 0u; cnt = 0u; mine = 0u;
#pragma unroll
        for (unsigned j = 0; j < 16; ++j) { const unsigned c = xb_ld(&bar[XB_XCNT(j)]); sum += c; cnt += (c > 0u) ? 1u : 0u; mine = (j == x) ? c : mine; }
        if (sum == G) break;
        __builtin_amdgcn_s_sleep(1);
        if ((++sp & 255u) == 0u) { if (xb_ld(&bar[XB_TMO])) break; if (sp > XB_SPIN_CAP) { atomicAdd(&bar[XB_TMO], 1u); break; } }
    }
    nloc = mine > 0u ? mine : 1u; nx = cnt > 0u ? cnt : 1u;
}
__device__ __forceinline__ void xcd_barrier(const XcdBarrier& b) {
    asm volatile("s_waitcnt vmcnt(0)" ::: "memory");
    __syncthreads();
    if (threadIdx.x == 0) {
        unsigned* bar = b.bar;
        __builtin_amdgcn_s_waitcnt(0);
        unsigned nloc = b.st[0], nx = b.st[1];
        if (nloc == 0u) { xcd_barrier_complete(bar, b.x, nloc, nx); b.st[0] = nloc; b.st[1] = nx; }
        const unsigned old = xb_add(&bar[XB_XSUB(b.x)], 1u);
        const unsigned gen = old / nloc;
        if (old + 1u == (gen + 1u) * nloc) {
            __builtin_amdgcn_fence(__ATOMIC_RELEASE, "agent");
            asm volatile("s_waitcnt vmcnt(0)" ::: "memory");
            const unsigned og = xb_add(&bar[XB_TOP], 1u);
            const unsigned tg = og / nx;
            if (og + 1u == (tg + 1u) * nx) xb_add(&bar[XB_TOPGEN], 1u);
            else XB_SPIN(xb_ld(&bar[XB_TOPGEN]) == tg, bar);
            __builtin_amdgcn_fence(__ATOMIC_ACQUIRE, "agent");
            xb_add(&bar[XB_XGEN(b.x)], 1u);
            asm volatile("s_waitcnt vmcnt(0)" ::: "memory");
        } else {
            XB_SPIN(xb_ld(&bar[XB_XGEN(b.x)]) == gen, bar);
            __builtin_amdgcn_fence(__ATOMIC_ACQUIRE, "agent");
            asm volatile("s_waitcnt vmcnt(0)" ::: "memory");
        }
    }
    __syncthreads();
}

constexpr int NWAVES = 8;
constexpr int N_LAUNCHES = MK_N_LAUNCHES;
constexpr int N_PHASES = 10;
struct Args { const float* in[18]; float* out; unsigned char* ws; int ph_lo, ph_hi; };

__device__ __forceinline__ void p0_transpose_item(const float* W, int K, int N, bf16_t* WT, int drow0, const float* kscale, LAS unsigned* scr, int k0, int n0, int lane, bool ileave = false) {
    const int g = lane >> 4, l16 = lane & 15;
    f32x4 v[16];
#pragma unroll
    for (int i = 0; i < 16; ++i) { const int kk = (i >> 1) * 8 + g * 2 + (i & 1); v[i] = __builtin_nontemporal_load((const f32x4*)(W + (size_t)(k0 + kk) * N + n0 + 4 * l16)); }
    if (kscale) {
#pragma unroll
        for (int i = 0; i < 16; ++i) { const int kk = (i >> 1) * 8 + g * 2 + (i & 1); v[i] = v[i] * kscale[k0 + kk]; } }
#pragma unroll
    for (int j = 0; j < 8; ++j) { const int kp = j * 4 + g;
#pragma unroll
        for (int c = 0; c < 4; ++c) scr[(4 * l16 + c) * 33 + kp] = cvt_pk_bf16(v[2 * j][c], v[2 * j + 1][c]); }
    LDS_WAIT(); asm volatile("" ::: "memory");
    const int c8 = lane & 7;
#pragma unroll
    for (int jj = 0; jj < 8; ++jj) { const int n = jj * 8 + (lane >> 3); const LAS unsigned* t = scr + n * 33 + 4 * c8;
        u32x4 o; o.x = t[0]; o.y = t[1]; o.z = t[2]; o.w = t[3];
        const int dn = ileave ? ((n < 32) ? 2 * n : 2 * (n - 32) + 1) : n;
        *(u32x4*)(WT + (size_t)(drow0 + dn) * K + k0 + 8 * c8) = o; }
    LDS_WAIT(); asm volatile("" ::: "memory");
}

constexpr int MOE_GU1 = (DM / 128) * (2 * DFF / 64), MOE_GU = NE * MOE_GU1, MOE_DN1 = (DFF / 128) * (DM / 64), MOE_DN = NE * MOE_DN1, MOE_ITEMS = MOE_GU + MOE_DN;
struct MoeItem { const float* W; unsigned char* WT; int N, k0, n0, drow0, has_ks; };
__device__ __forceinline__ MoeItem moe_item_of(int r, const float* w_gate_up, const float* w_down, unsigned char* Wgu_t, unsigned char* Wdn_t) {
    MoeItem m;
    if (r < MOE_GU) { const int e = r / MOE_GU1, q = r % MOE_GU1, nblk = 2 * DFF / 64, kb = q / nblk, nb = q % nblk, n0 = nb * 64, j = n0 & (DFF - 1), up = n0 >= DFF;
        m.W = w_gate_up + (size_t)e * DM * 2 * DFF; m.WT = Wgu_t + (size_t)e * 2 * DFF * DM; m.N = 2 * DFF; m.k0 = kb * 128; m.n0 = n0; m.drow0 = (j >> 7) * 256 + (j & 127) + (up ? 128 : 0); m.has_ks = 1; }
    else { r -= MOE_GU; const int e = r / MOE_DN1, q = r % MOE_DN1, nblk = DM / 64, kb = q / nblk, nb = q % nblk;
        m.W = w_down + (size_t)e * DFF * DM; m.WT = Wdn_t + (size_t)e * DM * DFF; m.N = DM; m.k0 = kb * 128; m.n0 = nb * 64; m.drow0 = nb * 64; m.has_ks = 0; }
    return m;
}
__device__ __forceinline__ void moe_load_half(const MoeItem& m, int h, const float* ks, int lane, f32x4 (&v)[16], f32x4 (&sc)[4]) {
    const int g = lane >> 4, l16 = lane & 15;
#pragma unroll
    for (int j = 0; j < 4; ++j) sc[j] = *(const f32x4*)(ks + m.k0 + 64 * h + 16 * j + 4 * g);
#pragma unroll
    for (int i = 0; i < 16; ++i) { const int kk = 64 * h + (i >> 2) * 16 + g * 4 + (i & 3); v[i] = __builtin_nontemporal_load((const f32x4*)(m.W + (size_t)(m.k0 + kk) * m.N + m.n0 + 4 * l16)); }
}
__device__ __forceinline__ void moe_pack_half(const MoeItem& m, int h, int lane, const f32x4 (&v)[16], const f32x4 (&sc)[4], LAS unsigned* scr) {
    const int g = lane >> 4, l16 = lane & 15;
#pragma unroll
    for (int j = 0; j < 4; ++j) { const int kd = (4 * h + j) * 4 + g;
        const f32x4 s = m.has_ks ? sc[j] * W8_SCALE : (f32x4){W8_SCALE, W8_SCALE, W8_SCALE, W8_SCALE};
#pragma unroll
        for (int c = 0; c < 4; ++c) scr[(4 * l16 + c) * 33 + kd] = pk4_fp8(v[4 * j][c] * s[0], v[4 * j + 1][c] * s[1], v[4 * j + 2][c] * s[2], v[4 * j + 3][c] * s[3]); }
}
__device__ __forceinline__ void moe_store(const MoeItem& m, int lane, LAS unsigned* scr) {
    LDS_WAIT(); asm volatile("" ::: "memory");
    const int c8 = lane & 7;
#pragma unroll
    for (int jj = 0; jj < 8; ++jj) { const int n = jj * 8 + (lane >> 3); const LAS unsigned* t = scr + n * 33 + 4 * c8;
        u32x4 o; o.x = t[0]; o.y = t[1]; o.z = t[2]; o.w = t[3];
        *(u32x4*)(m.WT + (size_t)(m.drow0 + n) * 1024 + m.k0 + 16 * c8) = o; }
    LDS_WAIT(); asm volatile("" ::: "memory");
}
__device__ __forceinline__ void moe_stream(int first, int stride, const float* w_gate_up, const float* w_down, unsigned char* Wgu_t, unsigned char* Wdn_t, const float* ks, LAS unsigned* scr, int lane) {
    if (first >= MOE_ITEMS) return;
    f32x4 va[16], vb[16], sa[4], sb[4];
    int it = first;
    MoeItem cur = moe_item_of(it, w_gate_up, w_down, Wgu_t, Wdn_t);
    moe_load_half(cur, 0, ks, lane, va, sa); moe_load_half(cur, 1, ks, lane, vb, sb);
    for (;;) {
        const int nx = it + stride; const bool more = nx < MOE_ITEMS;
        const MoeItem nxt = moe_item_of(more ? nx : it, w_gate_up, w_down, Wgu_t, Wdn_t);
        moe_pack_half(cur, 0, lane, va, sa, scr);
        moe_load_half(nxt, 0, ks, lane, va, sa);
        moe_pack_half(cur, 1, lane, vb, sb, scr);
        moe_load_half(nxt, 1, ks, lane, vb, sb);
        moe_store(cur, lane, scr);
        if (!more) break;
        cur = nxt; it = nx;
    }
}

template <int PHMASK> __global__ void __launch_bounds__(NWAVES * 64, 2) fwd_kernel_t(Args args) {
    extern __shared__ __attribute__((aligned(16))) unsigned char lds_raw[];
    LAS unsigned char* lds = (LAS unsigned char*)lds_raw;
    volatile LAS unsigned* MISC = (volatile LAS unsigned*)(lds + MISC_OFF);
    const int tid = threadIdx.x, lane = tid & 63, wave = __builtin_amdgcn_readfirstlane(tid >> 6);
    const int G = gridDim.x; const int bx = blockIdx.x; const int vcu = (G % 8 == 0) ? (bx % 8) * (G / 8) + bx / 8 : bx;
    unsigned char* ws = args.ws;
    unsigned* ctl = (unsigned*)(ws + WS_CTL);
    const float* x = args.in[0]; const float* norm_mix = args.in[1]; const float* w_in = args.in[2]; const float* conv_w = args.in[3];
    const float* q_norm = args.in[4]; const float* w_uq = args.in[5]; const float* kv_norm = args.in[6]; const float* w_ukv = args.in[7];
    const float* q_head_norm = args.in[8]; const float* k_head_norm = args.in[9]; const float* w_o = args.in[10]; const float* norm_ffn = args.in[11];
    const float* w_router = args.in[12]; const float* b_router = args.in[13]; const float* w_gate_up = args.in[14]; const float* b_gate_up = args.in[15];
    const float* w_down = args.in[16]; const float* b_down = args.in[17];
    float* out = args.out;
    f32x2* rope_t = (f32x2*)(ws + WS_ROPE);
    bf16_t* WrH = (bf16_t*)(ws + WS_WRH); bf16_t* WrL = (bf16_t*)(ws + WS_WRL);
    bf16_t* Win_t = (bf16_t*)(ws + WS_WIN); bf16_t* Wuq_t = (bf16_t*)(ws + WS_WUQ); bf16_t* Wukv_t = (bf16_t*)(ws + WS_WUKV); bf16_t* Wo_t = (bf16_t*)(ws + WS_WO);
    float* ssq = (float*)(ws + WS_SSQ); float* rs2 = (float*)(ws + WS_RS2); float* gate = (float*)(ws + WS_GATE); int* tos = (int*)(ws + WS_TOS);
    unsigned char* Wgu_t = ws + WS_WGU; unsigned char* Wdn_t = ws + WS_WDN;
    unsigned char* hq = ws + WS_HB;
    bf16_t* qb_ = (bf16_t*)(ws + WS_Q); bf16_t* kb_ = (bf16_t*)(ws + WS_K); bf16_t* vb_ = (bf16_t*)(ws + WS_V); bf16_t* mix = (bf16_t*)(ws + WS_MIX);
    bf16_t* oslot = (bf16_t*)(ws + WS_OSLOT); bf16_t* hn = (bf16_t*)(ws + WS_HN); bf16_t* pbuf = (bf16_t*)(ws + WS_PB); bf16_t* qraw = (bf16_t*)(ws + WS_QRAW); bf16_t* kvraw = (bf16_t*)(ws + WS_KVRAW);
    unsigned char* act = ws + WS_ACT;

    for (int u = tid; u < (LDS_BYTES - MISC_OFF) / 4; u += NWAVES * 64) ((LAS unsigned*)(lds + MISC_OFF))[u] = 0u;
    __syncthreads();
    XcdBarrier bar; bar.bar = ctl + CW_BAR; bar.x = 0; bar.st = nullptr;
    if (N_LAUNCHES == 1) bar = xcd_barrier_post(ctl + CW_BAR, MISC + 8);
#define GRID_BAR() do { if (N_LAUNCHES == 1) xcd_barrier(bar); } while (0)
    const int lo = args.ph_lo, hi = args.ph_hi;
#define IN(k) (((PHMASK >> (k)) & 1) && lo <= (k) && (k) < hi)
#define BOTH(k) (IN(k) && IN((k) + 1))
    const int gw = vcu * NWAVES + wave, NGW = G * NWAVES;

    const int gemm_wgs = (G == 256) ? 168 : G; const bool split = gemm_wgs < G;
    constexpr int I_GU = MOE_GU, I_DN = MOE_DN;
    if (IN(0)) {
        LAS unsigned* scr = (LAS unsigned*)(lds + wave * 16384);
        constexpr int I_IN = (DM / 64) * (NPROJ / 64), I_UQ = (QL / 64) * (768 / 64), I_UKV = (KVL / 64) * (1024 / 64), I_O = (DM / 64) * (DM / 64);
        constexpr int NITEMS = I_IN + I_UQ + I_UKV + I_O + I_GU + I_DN;
        if (!split) moe_stream(gw, NGW, w_gate_up, w_down, Wgu_t, Wdn_t, norm_ffn, scr, lane);
        for (int it = gw; it < NITEMS - I_GU - I_DN; it += NGW) {
            int r = it;
            if (r < I_IN) { const int nblk = NPROJ / 64, kb = r / nblk, nb = r % nblk, n0 = nb * 64;
                const int d0 = (n0 < 512) ? n0 : (n0 < 1024 ? 512 + ((n0 - 512) >> 7) * 256 + ((n0 - 512) & 127) : (n0 < 1536 ? 512 + ((n0 - 1024) >> 7) * 256 + 128 + ((n0 - 1024) & 127)
                             : (n0 < 1920 ? n0 + 256 : (n0 < 2176 ? n0 - 384 : n0))));
                p0_transpose_item(w_in, DM, NPROJ, Win_t, d0, nullptr, scr, kb * 64, n0, lane); continue; } r -= I_IN;
            if (r < I_UQ) { const int nblk = 768 / 64, kb = r / nblk, nb = r % nblk, h = nb / 3, part = nb % 3;
                p0_transpose_item(w_uq, QL, 768, Wuq_t, h * 256 + part * 64, q_norm, scr, kb * 64, nb * 64, lane, part == 2); continue; } r -= I_UQ;
            if (r < I_UKV) { const int nblk = 1024 / 64, kb = r / nblk, nb = r % nblk; p0_transpose_item(w_ukv, KVL, 1024, Wukv_t, nb * 64, kv_norm, scr, kb * 64, nb * 64, lane); continue; } r -= I_UKV;
            { const int nblk = DM / 64, kb = r / nblk, nb = r % nblk; p0_transpose_item(w_o, DM, DM, Wo_t, nb * 64, nullptr, scr, kb * 64, nb * 64, lane); }
        }
        const int gt = vcu * (NWAVES * 64) + tid, NGT = G * NWAVES * 64;
        for (int i = gt; i < (NPP - NPROJ) * DM / 8; i += NGT) *(u32x4*)(Win_t + (size_t)NPROJ * DM + (size_t)i * 8) = (u32x4){0u, 0u, 0u, 0u};
        for (int i = gt; i < NH * 64 * QL / 8; i += NGT) { const int h = i / (64 * QL / 8), j = i % (64 * QL / 8); *(u32x4*)(Wuq_t + (size_t)(h * 256 + 192) * QL + (size_t)j * 8) = (u32x4){0u, 0u, 0u, 0u}; }
        for (int i = gt; i < NE * DM; i += NGT) { const int e = i / DM, k = i % DM; const float v = w_router[(size_t)k * NE + e] * norm_ffn[k]; const unsigned h = f2bf(v); const float hf = __builtin_bit_cast(float, h << 16);
            WrH[i] = (bf16_t)h; WrL[i] = (bf16_t)f2bf(v - hf); }
        for (int i = gt; i < SEQ * 32; i += NGT) { const int pos = i >> 5, fi = i & 31; const float inv = exp2f(-(float)fi * (13.287712379549449f / 32.f)); const float ang = (float)pos * inv; float s, c; sincosf(ang, &s, &c); rope_t[i] = (f32x2){c, s}; }
        for (int m = 4 * gw; m < NTOK; m += 4 * NGW) {
            const f32x4* xr = (const f32x4*)(x + (size_t)m * DM) + lane; const f32x4* gr = (const f32x4*)norm_mix + lane;
            f32x4 v[4][4]; float ss[4] = {0.f, 0.f, 0.f, 0.f};
#pragma unroll
            for (int r = 0; r < 4; ++r)
#pragma unroll
                for (int j = 0; j < 4; ++j) v[r][j] = __builtin_nontemporal_load(xr + r * (DM / 4) + 64 * j);
#pragma unroll
            for (int r = 0; r < 4; ++r)
#pragma unroll
                for (int j = 0; j < 4; ++j) ss[r] += (v[r][j].x * v[r][j].x + v[r][j].y * v[r][j].y) + (v[r][j].z * v[r][j].z + v[r][j].w * v[r][j].w);
            u32x2* o8 = (u32x2*)(hn + (size_t)m * DM) + lane;
#pragma unroll
            for (int r = 0; r < 4; ++r) { const float rr = __builtin_amdgcn_rsqf(wave_sum(ss[r]) * (1.f / DM) + EPS);
#pragma unroll
                for (int j = 0; j < 4; ++j) { const f32x4 g = gr[64 * j]; u32x2 w;
                    w.x = cvt_pk_bf16(v[r][j].x * rr * g.x, v[r][j].y * rr * g.y); w.y = cvt_pk_bf16(v[r][j].z * rr * g.z, v[r][j].w * rr * g.w); o8[r * (DM / 4) + 64 * j] = w; } }
        }
        if (BOTH(0)) GRID_BAR();
    }

    if (IN(1)) {
        if (bx < gemm_wgs) {
            pg8::DenseSched S; S.init(hn, DM, Win_t, NTOK, NPP, DM, gemm_wgs, bx);
            pg8::EpiProj E{pbuf, ssq};
            pg8::gemm_phase<pg8::EpiProj, pg8::DenseSched, false>(lds, S, E);
        } else {
            LAS unsigned* scr = (LAS unsigned*)(lds + wave * 16384);
            moe_stream((bx - gemm_wgs) * NWAVES + wave, (G - gemm_wgs) * NWAVES, w_gate_up, w_down, Wgu_t, Wdn_t, norm_ffn, scr, lane);
        }
        if (BOTH(1)) GRID_BAR();
    }

    const bool p2_all = IN(2);
    if (p2_all || IN(13)) {
        {
            const int gt = vcu * (NWAVES * 64) + tid, NGT = G * NWAVES * 64;
            for (int it = gt; it < (NTOK / 16) * 64; it += NGT) {
                const int run = it >> 6, gr = it & 63, t0 = run * 16, ch = gr * 8;
                float w0[8], w1[8], w2[8];
#pragma unroll
                for (int i = 0; i < 8; ++i) { w0[i] = conv_w[ch + i]; w1[i] = conv_w[CONVW + ch + i]; w2[i] = conv_w[2 * CONVW + ch + i]; }
                float um2[8], um1[8];
#pragma unroll
                for (int i = 0; i < 8; ++i) { um2[i] = 0.f; um1[i] = 0.f; }
                if ((t0 & (SEQ - 1)) != 0) {
                    unpack8(*(const u32x4*)(pbuf + (size_t)(t0 - 2) * NPB + PB_U + ch), um2);
                    unpack8(*(const u32x4*)(pbuf + (size_t)(t0 - 1) * NPB + PB_U + ch), um1);
                }
                u32x4 bq[16], uq[16];
#pragma unroll
                for (int t = 0; t < 16; ++t) { const bf16_t* pr = pbuf + (size_t)(t0 + t) * NPB + ch; bq[t] = __builtin_nontemporal_load((const u32x4*)(pr + PB_B)); uq[t] = __builtin_nontemporal_load((const u32x4*)(pr + PB_U)); }
#pragma unroll
                for (int t = 0; t < 16; ++t) {
                    float b8[8], u8[8], o8[8];
                    unpack8(bq[t], b8); unpack8(uq[t], u8);
#pragma unroll
                    for (int i = 0; i < 8; ++i) { o8[i] = b8[i] * (w0[i] * um2[i] + w1[i] * um1[i] + w2[i] * u8[i]); um2[i] = um1[i]; um1[i] = u8[i]; }
                    *(u32x4*)(mix + (size_t)(t0 + t) * DM + ch) = pack8(o8);
                }
            }
        }
    }
    if (p2_all || IN(14) || IN(15)) {
        LAS float* etab = (LAS float*)(lds + EPI_TAB_OFF);
        if (p2_all || IN(14)) { pg8::DenseSched S; S.init(pbuf + PB_CQ, NPB, Wuq_t, NTOK, NQP, QL, G, bx); pg8::EpiQ E{qb_, ssq, q_head_norm, rope_t, etab};
          pg8::gemm_phase<pg8::EpiQ, pg8::DenseSched, false>(lds, S, E); }
        if (p2_all || IN(15)) { pg8::DenseSched S; S.init(pbuf + PB_CKV, NPB, Wukv_t, NTOK, 1024, KVL, G, bx); pg8::EpiKV E{kb_, vb_, ssq, k_head_norm, rope_t, pbuf, etab};
          pg8::gemm_phase<pg8::EpiKV, pg8::DenseSched, false>(lds, S, E); }
        if (BOTH(2)) GRID_BAR();
    }


    if (IN(4)) {
        for (int u = vcu; u < NB * NH * 4; u += G) {
            const int bh = u >> 2, pr = u & 3, b = bh >> 2, h = bh & 3;
            att::attn_unit(b, h, 7 - pr, qb_, kb_, vb_, mix + CONVW, lds);
            att::attn_unit(b, h, pr, qb_, kb_, vb_, mix + CONVW, lds);
        }
        if (BOTH(4)) GRID_BAR();
    }

    auto load_wr = [&]() {
        for (int i = tid; i < 2 * NE * 128; i += NWAVES * 64) { const int sel = i >> 12, r = (i >> 7) & 31, g = i & 127;
            const u32x4 v = *(const u32x4*)((sel ? WrL : WrH) + (size_t)r * DM + g * 8);
            *(LAS u32x4*)(lds + sel * 65536 + r * 2048 + ((g ^ (r & 15)) << 4)) = v; }
    };
    if (IN(5)) {
        pg8::DenseSched S; S.init(mix, DM, Wo_t, NTOK, DM, DM, G, bx);
        pg8::EpiOut E{x, (bf16_t*)(ws + WS_H1B), ssq};
        pg8::gemm_phase<pg8::EpiOut, pg8::DenseSched, false>(lds, S, E);
        if (BOTH(5)) { load_wr(); GRID_BAR(); }
    }

    if (IN(6) || IN(16)) {
        const bool dry = !IN(6);
        LAS unsigned* hist = (LAS unsigned*)(lds + MISC_OFF) + 128; LAS unsigned* base = (LAS unsigned*)(lds + MISC_OFF) + 160;
        const int tj = lane & 15, q = lane >> 4;
        if (!BOTH(5)) load_wr();
        __syncthreads();
        for (int tile = vcu; tile < NTOK / 128; tile += G) {
            if (tid < 32) hist[tid] = 0u;
            __syncthreads();
            const int token = tile * 128 + wave * 16 + tj;
            const bf16_t* hrow = (const bf16_t*)(ws + WS_H1B) + (size_t)token * DM + q * 8;
            f32x4 a0 = {0.f, 0.f, 0.f, 0.f}, a1 = {0.f, 0.f, 0.f, 0.f};
            float s2 = 0.f;
#pragma unroll
            for (int p = 0; p < 16; ++p) s2 += ssq[(size_t)p * NTOK + token];
            const float rs = __builtin_amdgcn_rsqf(s2 * (1.f / DM) + EPS);
            unsigned char* hqrow = hq + (size_t)token * DM + q * 8;
            const LAS unsigned char* wlds = lds + tj * 2048;
#pragma unroll 1
            for (int kh = 0; kh < 2; ++kh) {
                u32x4 hv[16];
#pragma unroll
                for (int kk = 0; kk < 16; ++kk) hv[kk] = *(const u32x4*)(hrow + (kh * 16 + kk) * 32);
#pragma unroll
                for (int kk = 0; kk < 16; ++kk) { const int ks = kh * 16 + kk;
                    const u32x4 hw = hv[kk]; float hf[8]; unpack8(hw, hf);
                    { u32x2 w8; w8.x = pk4_fp8(hf[0] * rs, hf[1] * rs, hf[2] * rs, hf[3] * rs); w8.y = pk4_fp8(hf[4] * rs, hf[5] * rs, hf[6] * rs, hf[7] * rs); *(u32x2*)(hqrow + ks * 32) = w8; }
                    const bf16x8 bh = __builtin_bit_cast(bf16x8, hw);
                    const int go = (((ks * 4 + q) ^ tj) << 4);
                    const bf16x8 wh_a = *(const LAS bf16x8*)(wlds + go), wh_b = *(const LAS bf16x8*)(wlds + 16 * 2048 + go);
                    const bf16x8 wl_a = *(const LAS bf16x8*)(wlds + 65536 + go), wl_b = *(const LAS bf16x8*)(wlds + 65536 + 16 * 2048 + go);
                    a0 = __builtin_amdgcn_mfma_f32_16x16x32_bf16(wh_a, bh, a0, 0, 0, 0); a0 = __builtin_amdgcn_mfma_f32_16x16x32_bf16(wl_a, bh, a0, 0, 0, 0);
                    a1 = __builtin_amdgcn_mfma_f32_16x16x32_bf16(wh_b, bh, a1, 0, 0, 0); a1 = __builtin_amdgcn_mfma_f32_16x16x32_bf16(wl_b, bh, a1, 0, 0, 0);
                }
            }
            float lv[8]; int le[8];
#pragma unroll
            for (int i = 0; i < 4; ++i) { le[i] = 4 * q + i; le[4 + i] = 16 + 4 * q + i; lv[i] = a0[i] * rs + b_router[le[i]]; lv[4 + i] = a1[i] * rs + b_router[le[4 + i]]; }
            float tv[4]; int te[4];
#pragma unroll
            for (int k = 0; k < TOPK; ++k) {
                float bv = lv[0]; int be = le[0];
#pragma unroll
                for (int i = 1; i < 8; ++i) if (lv[i] > bv) { bv = lv[i]; be = le[i]; }
#pragma unroll
                for (int o = 16; o < 64; o <<= 1) { const float ov = __shfl_xor(bv, o); const int oe = __shfl_xor(be, o); if (ov > bv || (ov == bv && oe < be)) { bv = ov; be = oe; } }
                tv[k] = bv; te[k] = be;
#pragma unroll
                for (int i = 0; i < 8; ++i) if (le[i] == be) lv[i] = -3.0e38f;
            }
            float ge[4]; float gs = 0.f;
#pragma unroll
            for (int k = 0; k < TOPK; ++k) { ge[k] = __expf(tv[k] - tv[0]); gs += ge[k]; }
            const float ginv = 1.0f / gs;
            int my_e = te[0]; float my_g = ge[0];
#pragma unroll
            for (int k = 1; k < TOPK; ++k) if (q == k) { my_e = te[k]; my_g = ge[k]; }
            my_g *= ginv;
            const unsigned pl = atomicAdd((unsigned*)(hist + my_e), 1u);
            __syncthreads();
            if (tid < 32) base[tid] = dry ? 0u : __hip_atomic_fetch_add(ctl + CW_CNT + 64 * tid, hist[tid], __ATOMIC_RELAXED, __HIP_MEMORY_SCOPE_AGENT);
            __syncthreads();
            const unsigned pos = base[my_e] + pl; const int slot = token * 4 + q;
            if (!dry) *(u32x2*)(tos + ((size_t)my_e * CAP + pos) * 2) = (u32x2){(unsigned)slot, __builtin_bit_cast(unsigned, my_g)};
            else if (my_g < -1.f) rs2[token] = my_g;
            __syncthreads();
        }
        if (BOTH(6)) GRID_BAR();
    }

    LAS int* tab = (LAS int*)(lds + MISC_OFF) + 16;
    if (IN(7) || IN(8) || IN(10) || IN(11) || IN(12)) {
        if (tid < 64) {
            const int c = (tid < 32) ? (int)__hip_atomic_load(ctl + CW_CNT + 64 * (tid & 31), __ATOMIC_RELAXED, __HIP_MEMORY_SCOPE_AGENT) : 0;
            const int nt_e = (c + 255) >> 8; int inc = nt_e;
#pragma unroll
            for (int o = 1; o < 32; o <<= 1) { const int v = __shfl_up(inc, o); if ((tid & 63) >= o) inc += v; }
            if (tid < 32) { tab[48 + tid] = c; tab[tid] = inc - nt_e; if (tid == 31) tab[32] = inc; }
        }
        __syncthreads();
        for (int t = tid; t < tab[32]; t += NWAVES * 64) { int e = 0;
#pragma unroll
            for (int b = 16; b > 0; b >>= 1) if (tab[e + b] <= t) e += b;
            tab[2288 + t] = e; }
        __syncthreads();
    }

    if (IN(7)) {
        pg8::MoeSched S{hq, Wgu_t, DM, DM, 2 * DFF / 256, G, bx, (size_t)2 * DFF * DM, tab, tos, b_gate_up};
        pg8::EpiSwiglu E{act, b_gate_up, lds};
        pg8::gemm_phase<pg8::EpiSwiglu, pg8::MoeSched, true>(lds, S, E);
        if (BOTH(7)) GRID_BAR();
    }

    if (IN(8)) {
        pg8::MoeSched S{act, Wdn_t, DFF, DFF, DM / 256, G, bx, (size_t)DM * DFF, tab, tos, b_down};
        pg8::EpiDown E{(unsigned char*)oslot, b_down, ws + WS_SSQ, lds};
        pg8::gemm_phase<pg8::EpiDown, pg8::MoeSched, false>(lds, S, E);
        if (BOTH(8)) GRID_BAR();
    }

#if PROBE_DOUBLE
    if (IN(10)) { pg8::MoeSched S{hq, Wgu_t, DM, DM, 2 * DFF / 256, G, bx, (size_t)2 * DFF * DM, tab, tos, b_gate_up}; pg8::EpiNull E{(float*)(ws + WS_SSQ)};
        pg8::gemm_phase<pg8::EpiNull, pg8::MoeSched, true>(lds, S, E); }
    if (IN(11)) { pg8::MoeSched S{act, Wdn_t, DFF, DFF, DM / 256, G, bx, (size_t)DM * DFF, tab, tos, b_down}; pg8::EpiNull E{(float*)(ws + WS_SSQ)};
        pg8::gemm_phase<pg8::EpiNull, pg8::MoeSched, false, 2>(lds, S, E); }
    if (IN(12)) { pg8::MoeSched S{act, Wdn_t, DFF, DFF, DM / 256, G, bx, (size_t)DM * DFF, tab, tos, b_down}; pg8::EpiNull E{(float*)(ws + WS_SSQ)};
        pg8::gemm_phase<pg8::EpiNull, pg8::MoeSched, false>(lds, S, E); }
#endif
    if (IN(9)) {
        const unsigned char* os8 = (const unsigned char*)oslot;
        constexpr float OI = 1.f / OS8_SCALE;
        for (int m = gw; m < NTOK; m += NGW) {
            f32x4* orow = (f32x4*)(out + (size_t)m * DM) + lane;
            const u32x2* hrow = (const u32x2*)((const bf16_t*)(ws + WS_H1B) + (size_t)m * DM) + lane;
            const unsigned* s0 = (const unsigned*)(os8 + (size_t)m * 4 * DM) + lane;
            unsigned w[4][4]; f32x4 hv[4];
#pragma unroll
            for (int j = 0; j < 4; ++j) { const u32x2 hb2 = __builtin_nontemporal_load(hrow + 64 * j); hv[j] = (f32x4){bf_lo(hb2.x), bf_hi(hb2.x), bf_lo(hb2.y), bf_hi(hb2.y)};
#pragma unroll
                for (int k = 0; k < 4; ++k) w[j][k] = __builtin_nontemporal_load(s0 + (size_t)k * (DM / 4) + 64 * j); }
#pragma unroll
            for (int j = 0; j < 4; ++j) { f32x4 a = {0.f, 0.f, 0.f, 0.f};
#pragma unroll
                for (int k = 0; k < 4; ++k) { const f32x2 lo = __builtin_amdgcn_cvt_pk_f32_fp8(w[j][k], false), hi2 = __builtin_amdgcn_cvt_pk_f32_fp8(w[j][k], true); a.x += lo.x; a.y += lo.y; a.z += hi2.x; a.w += hi2.y; }
                __builtin_nontemporal_store(hv[j] + a * OI, orow + 64 * j); }
        }
    }
#undef IN
#undef BOTH
#undef GRID_BAR
}

#ifdef DIAG_PHASES
template __global__ void fwd_kernel_t<1>(Args); template __global__ void fwd_kernel_t<2>(Args); template __global__ void fwd_kernel_t<4>(Args); template __global__ void fwd_kernel_t<8>(Args);
template __global__ void fwd_kernel_t<16>(Args); template __global__ void fwd_kernel_t<32>(Args); template __global__ void fwd_kernel_t<64>(Args); template __global__ void fwd_kernel_t<128>(Args);
template __global__ void fwd_kernel_t<256>(Args); template __global__ void fwd_kernel_t<512>(Args);
#endif
#define fwd_kernel fwd_kernel_t<(PROBE_DOUBLE ? 0x1ffff : 1023)>
extern "C" void kernel_launch(void* const* d_in, const int* in_sizes, int n_in, void* d_out, int out_size, void* d_ws, size_t ws_size, hipStream_t stream) {
    static int grid = 0;
    if (grid == 0) {
        if (n_in != 18 || in_sizes[0] != NTOK * DM || out_size != NTOK * DM || ws_size < WS_END) { fprintf(stderr, "kernel_launch: shape/workspace mismatch (n_in %d, in0 %d, out %d, ws %zu, need %zu)\n", n_in, n_in > 0 ? in_sizes[0] : -1, out_size, ws_size, (size_t)WS_END); grid = -1; return; }
        int dev = 0, cus = 0, per_cu = 0;
        if (hipGetDevice(&dev) != hipSuccess || hipDeviceGetAttribute(&cus, hipDeviceAttributeMultiprocessorCount, dev) != hipSuccess) { grid = -1; return; }
        if (hipFuncSetAttribute((const void*)fwd_kernel, hipFuncAttributeMaxDynamicSharedMemorySize, LDS_BYTES) != hipSuccess) { fprintf(stderr, "kernel_launch: hipFuncSetAttribute failed\n"); grid = -1; return; }
        if (hipOccupancyMaxActiveBlocksPerMultiprocessor(&per_cu, (const void*)fwd_kernel, NWAVES * 64, LDS_BYTES) != hipSuccess || per_cu < 1) { fprintf(stderr, "kernel_launch: occupancy query says %d\n", per_cu); }
        (void)hipGetLastError();
        grid = cus;
    }
    if (grid < 0) return;
    if (hipMemsetAsync((char*)d_ws + WS_CTL, 0, CTL_ZERO_BYTES, stream) != hipSuccess) return;
    Args a{};
    for (int i = 0; i < 18; ++i) a.in[i] = (const float*)d_in[i];
    a.out = (float*)d_out; a.ws = (unsigned char*)d_ws;
    if (N_LAUNCHES == 1) { a.ph_lo = 0; a.ph_hi = N_PHASES; hipLaunchKernelGGL(fwd_kernel, dim3(grid), dim3(NWAVES * 64), LDS_BYTES, stream, a); }
    else { for (int p = 0; p < N_PHASES; ++p) { a.ph_lo = p; a.ph_hi = p + 1; const int reps = ((PROBE_DOUBLE >> p) & 1) ? 2 : 1;
            for (int r = 0; r < reps; ++r) hipLaunchKernelGGL(fwd_kernel, dim3(grid), dim3(NWAVES * 64), LDS_BYTES, stream, a);
            if (p == 8) for (int pp = 10; pp < 13; ++pp) if ((PROBE_DOUBLE >> pp) & 1) { a.ph_lo = pp; a.ph_hi = pp + 1; hipLaunchKernelGGL(fwd_kernel, dim3(grid), dim3(NWAVES * 64), LDS_BYTES, stream, a); }
            if (p == 6 && ((PROBE_DOUBLE >> 16) & 1)) { a.ph_lo = 16; a.ph_hi = 17; hipLaunchKernelGGL(fwd_kernel, dim3(grid), dim3(NWAVES * 64), LDS_BYTES, stream, a); }
            if (p == 2) for (int pp = 13; pp < 16; ++pp) if ((PROBE_DOUBLE >> pp) & 1) { a.ph_lo = pp; a.ph_hi = pp + 1; hipLaunchKernelGGL(fwd_kernel, dim3(grid), dim3(NWAVES * 64), LDS_BYTES, stream, a); } } }
}
```
